# Optimizing an MI355X kernel written in HIP

```python
import jax, jax.numpy as jnp
from jax import lax
import numpy as np

D_MODEL = 2048
BATCH = 2
SEQ = 8192
DEPTH = 1

EPS = 1e-6
CHUNK = 64

A_HEADS = 8
A_DK = 128
A_DV = 128
A_WIDTH = A_HEADS * A_DV

B_QK_HEADS = 4
B_V_HEADS = 8
B_DK = 128
B_DV = 128
B_WIDTH = B_V_HEADS * B_DV
CONV = 4
B_CONV_CH = 2 * B_QK_HEADS * B_DK + B_WIDTH

MIX_WIDTH = A_WIDTH + B_WIDTH

IN_SIZES = (A_HEADS * A_DK, A_HEADS * A_DK, A_WIDTH, A_WIDTH,
            B_QK_HEADS * B_DK, B_QK_HEADS * B_DK, B_WIDTH, B_WIDTH,
            B_V_HEADS, B_V_HEADS)
IN_WIDTH = 4 * A_HEADS * A_DK + 2 * B_QK_HEADS * B_DK + 2 * B_WIDTH + 2 * B_V_HEADS

P_HEADS = 8
N_KEYS = 128
N_EXPERTS = N_KEYS * N_KEYS
P_DKEY = 256
P_TOPK = 16
P_BLOCK = 128

kernel_name = "hymba_hgrn2_gdn_peer"


def _rmsnorm(x, g):
    xf = x.astype(jnp.float32)
    y = xf * lax.rsqrt(jnp.mean(xf * xf, axis=-1, keepdims=True) + EPS)
    return (y * g.astype(jnp.float32)).astype(x.dtype)


def _gated_rmsnorm(o, z, g):
    of = o.astype(jnp.float32)
    y = of * lax.rsqrt(jnp.mean(of * of, axis=-1, keepdims=True) + EPS)
    return y * g.astype(jnp.float32) * jax.nn.silu(z.astype(jnp.float32))


def _l2norm(x):
    xf = x.astype(jnp.float32)
    return xf * lax.rsqrt(jnp.sum(xf * xf, axis=-1, keepdims=True) + EPS)


def _chunk(t):
    b, s, h = t.shape[:3]
    rest = t.shape[3:]
    t = t.reshape((b, s // CHUNK, CHUNK, h) + rest)
    return t.transpose((1, 0, 3, 2) + tuple(range(4, t.ndim)))


def _unchunk(t):
    n, b, h, c, d = t.shape
    return t.transpose(1, 0, 3, 2, 4).reshape(b, n * c, h, d)


def _causal_conv_silu(x, w):
    s = x.shape[1]
    xp = jnp.pad(x, ((0, 0), (CONV - 1, 0), (0, 0)))
    y = xp[:, 0:s, :] * w[0]
    for j in range(1, CONV):
        y = y + xp[:, j:j + s, :] * w[j]
    return jax.nn.silu(y)


def _hgrn2(q, f_logit, v, lb):
    q = q.astype(jnp.float32)
    z = f_logit.astype(jnp.float32)
    v = v.astype(jnp.float32)
    lb = lb.astype(jnp.float32)
    log_f = jnp.log(lb + (1.0 - lb) * jax.nn.sigmoid(z))
    k = (1.0 - lb) * jax.nn.sigmoid(-z)
    qc, kc, vc = _chunk(q), _chunk(k), _chunk(v)
    bc = jnp.cumsum(_chunk(log_f), axis=-2)
    causal = jnp.tril(jnp.ones((CHUNK, CHUNK), dtype=bool))

    def step(S, inp):
        q_c, k_c, v_c, b_c = inp
        diff = b_c[..., :, None, :] - b_c[..., None, :, :]
        decay = jnp.exp(jnp.where(causal[:, :, None], diff, -jnp.inf))
        att = jnp.einsum('bhtd,bhsd,bhtsd->bhts', q_c, k_c, decay)
        o = (jnp.einsum('bhtd,bhdv->bhtv', q_c * jnp.exp(b_c), S)
             + jnp.einsum('bhts,bhsv->bhtv', att, v_c))
        b_last = b_c[..., -1:, :]
        S = (S * jnp.exp(b_last[..., 0, :, None])
             + jnp.einsum('bhsd,bhsv->bhdv', k_c * jnp.exp(b_last - b_c), v_c))
        return S, o

    S0 = jnp.zeros((q.shape[0], q.shape[2], A_DK, A_DV), jnp.float32)
    _, o = lax.scan(step, S0, (qc, kc, vc, bc))
    return _unchunk(o)


def _gated_delta(q, k, v, beta, g):
    q = _chunk(q.astype(jnp.float32) * (B_DK ** -0.5))
    k = _chunk(k.astype(jnp.float32))
    v = _chunk(v.astype(jnp.float32))
    beta = _chunk(beta.astype(jnp.float32))
    gc = jnp.cumsum(_chunk(g.astype(jnp.float32)), axis=-1)
    incl = jnp.tril(jnp.ones((CHUNK, CHUNK), dtype=bool))
    strict = jnp.tril(jnp.ones((CHUNK, CHUNK), dtype=bool), k=-1)
    L = jnp.exp(jnp.where(incl, gc[..., :, None] - gc[..., None, :], -jnp.inf))
    kb = k * beta[..., None]
    M = jnp.eye(CHUNK, dtype=jnp.float32) + jnp.where(
        strict, jnp.einsum('...td,...sd->...ts', kb, k) * L, 0.0)
    u = lax.linalg.triangular_solve(M, v * beta[..., None], left_side=True,
                                    lower=True, unit_diagonal=True)
    w = lax.linalg.triangular_solve(M, kb * jnp.exp(gc)[..., None], left_side=True,
                                    lower=True, unit_diagonal=True)
    a_qk = jnp.einsum('...td,...sd->...ts', q, k) * L
    qg = q * jnp.exp(gc)[..., None]
    g_last = gc[..., -1:]
    kd = k * jnp.exp(g_last - gc)[..., None]
    dl = jnp.exp(g_last)[..., None]

    def step(S, inp):
        qg_c, kd_c, u_c, w_c, a_c, dl_c = inp
        v_new = u_c - jnp.einsum('bhtd,bhdv->bhtv', w_c, S)
        o = (jnp.einsum('bhtd,bhdv->bhtv', qg_c, S)
             + jnp.einsum('bhts,bhsv->bhtv', a_c, v_new))
        S = S * dl_c + jnp.einsum('bhsd,bhsv->bhdv', kd_c, v_new)
        return S, o

    S0 = jnp.zeros((qg.shape[1], qg.shape[2], B_DK, B_DV), jnp.float32)
    _, o = lax.scan(step, S0, (qg, kd, u, w, a_qk, dl))
    return _unchunk(o)


def _peer(xn, w_query, sub_keys, u_tab, v_tab):
    b, s, d = xn.shape
    t = b * s
    xt = xn.reshape(t, d)
    qry = jnp.einsum('td,dhk->thk', xt, w_query).astype(jnp.float32)
    half = P_DKEY // 2
    s1 = jnp.einsum('thk,hnk->thn', qry[..., :half], sub_keys[0].astype(jnp.float32))
    s2 = jnp.einsum('thk,hnk->thn', qry[..., half:], sub_keys[1].astype(jnp.float32))
    v1, i1 = lax.top_k(s1, P_TOPK)
    v2, i2 = lax.top_k(s2, P_TOPK)
    cand = (v1[..., :, None] + v2[..., None, :]).reshape(t, P_HEADS, P_TOPK * P_TOPK)
    best, pos = lax.top_k(cand, P_TOPK)
    expert = (jnp.take_along_axis(i1, pos // P_TOPK, axis=-1) * N_KEYS
              + jnp.take_along_axis(i2, pos % P_TOPK, axis=-1))
    gate = jax.nn.softmax(best, axis=-1)
    nblk = t // P_BLOCK

    def blk(args):
        xb, eb, gb = args
        hid = jax.nn.gelu(jnp.einsum('pd,phkd->phk', xb, u_tab[eb]).astype(jnp.float32),
                          approximate=False)
        return jnp.einsum('phk,phkd->pd', (gb * hid).astype(xb.dtype), v_tab[eb])

    y = lax.map(blk, (xt.reshape(nblk, P_BLOCK, d),
                      expert.reshape(nblk, P_BLOCK, P_HEADS, P_TOPK),
                      gate.reshape(nblk, P_BLOCK, P_HEADS, P_TOPK)))
    return y.reshape(b, s, d)


def setup_inputs(seed: int = 0) -> dict:
    key = jax.random.key(seed)
    ks = jax.random.split(key, 20)
    f32 = jnp.float32
    nrm = lambda k, shape, scale: jax.random.normal(k, shape, f32) * scale
    gain = lambda k, shape: 1.0 + 0.02 * jax.random.normal(k, shape, f32)
    dt = jnp.exp(jax.random.uniform(ks[8], (DEPTH, B_V_HEADS), f32,
                                    minval=np.log(1e-3), maxval=np.log(1e-1)))
    return {
        "x": nrm(ks[0], (BATCH, SEQ, D_MODEL), 1.0),
        "attn_norm_g": gain(ks[1], (DEPTH, D_MODEL)),
        "w_in": nrm(ks[2], (DEPTH, D_MODEL, IN_WIDTH), D_MODEL ** -0.5),
        "hgrn_lb_logits": nrm(ks[3], (DEPTH + 1, A_HEADS, A_DK), 0.1),
        "hgrn_norm_g": gain(ks[4], (DEPTH, A_DV)),
        "gdn_conv_w": nrm(ks[5], (DEPTH, CONV, B_CONV_CH), CONV ** -0.5),
        "gdn_A_log": jnp.log(jax.random.uniform(ks[6], (DEPTH, B_V_HEADS), f32,
                                                minval=1.0, maxval=16.0)),
        "gdn_dt_bias": dt + jnp.log(-jnp.expm1(-dt)),
        "gdn_norm_g": gain(ks[7], (DEPTH, B_DV)),
        "w_out": nrm(ks[9], (DEPTH, MIX_WIDTH, D_MODEL), MIX_WIDTH ** -0.5),
        "ffn_norm_g": gain(ks[10], (DEPTH, D_MODEL)),
        "peer_w_query": nrm(ks[11], (DEPTH, D_MODEL, P_HEADS, P_DKEY), D_MODEL ** -0.5),
        "peer_sub_keys": nrm(ks[12], (DEPTH, 2, P_HEADS, N_KEYS, P_DKEY // 2),
                             (P_DKEY // 2) ** -0.5),
        "peer_u": nrm(ks[13], (DEPTH, N_EXPERTS, D_MODEL), D_MODEL ** -0.5),
        "peer_v": nrm(ks[14], (DEPTH, N_EXPERTS, D_MODEL), P_HEADS ** -0.5),
        "final_norm_g": gain(ks[15], (D_MODEL,)),
    }


def reference(x, attn_norm_g, w_in, hgrn_lb_logits, hgrn_norm_g, gdn_conv_w, gdn_A_log,
              gdn_dt_bias, gdn_norm_g, w_out, ffn_norm_g, peer_w_query, peer_sub_keys,
              peer_u, peer_v, final_norm_g):
    b, s, _ = x.shape
    lb_all = jnp.cumsum(jax.nn.softmax(hgrn_lb_logits.astype(jnp.float32), axis=0), axis=0)
    offs = []
    acc = 0
    for n in IN_SIZES[:-1]:
        acc += n
        offs.append(acc)
    rep = B_V_HEADS // B_QK_HEADS
    h = x
    for l in range(DEPTH):
        xn = _rmsnorm(h, attn_norm_g[l])
        proj = xn @ w_in[l]
        a_q, a_f, a_i, a_g, b_q, b_k, b_v, b_z, b_b, b_a = jnp.split(proj, offs, axis=-1)
        o_a = _hgrn2(a_q.reshape(b, s, A_HEADS, A_DK), a_f.reshape(b, s, A_HEADS, A_DK),
                     a_i.reshape(b, s, A_HEADS, A_DV), lb_all[l])
        o_a = _gated_rmsnorm(o_a, a_g.reshape(b, s, A_HEADS, A_DV), hgrn_norm_g[l])
        qkv = _causal_conv_silu(jnp.concatenate([b_q, b_k, b_v], axis=-1), gdn_conv_w[l])
        nqk = B_QK_HEADS * B_DK
        gq = _l2norm(qkv[..., :nqk].reshape(b, s, B_QK_HEADS, B_DK))
        gk = _l2norm(qkv[..., nqk:2 * nqk].reshape(b, s, B_QK_HEADS, B_DK))
        gv = qkv[..., 2 * nqk:].reshape(b, s, B_V_HEADS, B_DV)
        gq = jnp.repeat(gq, rep, axis=2)
        gk = jnp.repeat(gk, rep, axis=2)
        beta = jax.nn.sigmoid(b_b.astype(jnp.float32))
        g = -jnp.exp(gdn_A_log[l].astype(jnp.float32)) * jax.nn.softplus(
            b_a.astype(jnp.float32) + gdn_dt_bias[l].astype(jnp.float32))
        o_b = _gated_delta(gq, gk, gv, beta, g)
        o_b = _gated_rmsnorm(o_b, b_z.reshape(b, s, B_V_HEADS, B_DV), gdn_norm_g[l])
        mix = jnp.concatenate([o_a.reshape(b, s, A_WIDTH), o_b.reshape(b, s, B_WIDTH)],
                              axis=-1).astype(x.dtype)
        h = h + mix @ w_out[l]
        hn = _rmsnorm(h, ffn_norm_g[l])
        h = h + _peer(hn, peer_w_query[l], peer_sub_keys[l], peer_u[l], peer_v[l])
    return _rmsnorm(h, final_norm_g)
```

```cpp
#include <hip/hip_runtime.h>
#include <stdint.h>

typedef unsigned short bf16_t;
typedef float f32x4 __attribute__((ext_vector_type(4)));

constexpr int T = 16384, SEQ = 8192, DM = 2048, INW = 7184, NPROJ = 7168;
constexpr float EPS = 1e-6f;
constexpr size_t MiB = 1u << 20;
constexpr size_t OFF_TAB = 1 * MiB;
constexpr size_t OFF_B = 65 * MiB;
constexpr size_t OFF_C = 289 * MiB;
constexpr size_t OFF_D = 317 * MiB;
constexpr size_t OFF_S = 509 * MiB;
constexpr int C_AQ = 0, C_AF = 1024, C_AI = 2048, C_AG = 3072, C_BQ = 4096, C_BK = 4608, C_BV = 5120, C_BZ = 6144;

__device__ __forceinline__ float bf2f(bf16_t v) { return __uint_as_float(((unsigned)v) << 16); }
__device__ __forceinline__ bf16_t f2bf(float f) { unsigned u = __float_as_uint(f); return (bf16_t)((u + 0x7fffu + ((u >> 16) & 1u)) >> 16); }
__device__ __forceinline__ float sigmoidf_(float x) { return 1.f / (1.f + __expf(-x)); }
__device__ __forceinline__ float siluf_(float x) { return x / (1.f + __expf(-x)); }
__device__ __forceinline__ float wave_sum(float v) {
#pragma unroll
    for (int o = 1; o < 64; o <<= 1) v += __shfl_xor(v, o);
    return v;
}
__device__ __forceinline__ float block_sum(float v, float* sh) {
    v = wave_sum(v);
    const int w = threadIdx.x >> 6, nw = blockDim.x >> 6;
    __syncthreads();
    if ((threadIdx.x & 63) == 0) sh[w] = v;
    __syncthreads();
    float r = 0.f;
    for (int i = 0; i < nw; ++i) r += sh[i];
    return r;
}

__global__ void __launch_bounds__(256) k_rmsnorm_x(const float* __restrict__ x, const float* __restrict__ g, const float* __restrict__ w_in,
                                                  bf16_t* __restrict__ xn, float* __restrict__ ba) {
    __shared__ float sh[8];
    __shared__ float sacc[4][16];
    const int t = blockIdx.x, tid = threadIdx.x;
    const float* xr = x + (size_t)t * DM;
    float v[8];
    float ss = 0.f;
#pragma unroll
    for (int i = 0; i < 8; ++i) { v[i] = xr[tid * 8 + i]; ss += v[i] * v[i]; }
    ss = block_sum(ss, sh);
    const float rstd = rsqrtf(ss * (1.f / DM) + EPS);
    float acc[16];
#pragma unroll
    for (int j = 0; j < 16; ++j) acc[j] = 0.f;
#pragma unroll
    for (int i = 0; i < 8; ++i) {
        const int d = tid * 8 + i;
        const float y = v[i] * rstd * g[d];
        xn[(size_t)t * DM + d] = f2bf(y);
        const float* wr = w_in + (size_t)d * INW + NPROJ;
#pragma unroll
        for (int j = 0; j < 16; ++j) acc[j] += y * wr[j];
    }
#pragma unroll
    for (int j = 0; j < 16; ++j) acc[j] = wave_sum(acc[j]);
    __syncthreads();
    if ((tid & 63) == 0) {
#pragma unroll
        for (int j = 0; j < 16; ++j) sacc[tid >> 6][j] = acc[j];
    }
    __syncthreads();
    if (tid < 16) ba[(size_t)t * 16 + tid] = sacc[0][tid] + sacc[1][tid] + sacc[2][tid] + sacc[3][tid];
}

template <int MODE>
__global__ void __launch_bounds__(256) k_gemm_naive(const bf16_t* __restrict__ A, const float* __restrict__ W, int ldw, int K, int N,
                                                   void* __restrict__ Cout, int ldc, const float* __restrict__ R) {
    __shared__ float As[16][68];
    __shared__ float Ws[16][68];
    const int tid = threadIdx.x, tx = tid & 15, ty = tid >> 4;
    const int m0 = blockIdx.y * 64, n0 = blockIdx.x * 64;
    float acc[4][4];
#pragma unroll
    for (int i = 0; i < 4; ++i)
#pragma unroll
        for (int j = 0; j < 4; ++j) acc[i][j] = 0.f;
    for (int k0 = 0; k0 < K; k0 += 16) {
        {
            const int r = tid >> 2, kk = (tid & 3) * 4;
            const bf16_t* ap = A + (size_t)(m0 + r) * K + k0 + kk;
#pragma unroll
            for (int i = 0; i < 4; ++i) As[kk + i][r] = bf2f(ap[i]);
        }
        {
            const int kk = tid >> 4, c = (tid & 15) * 4;
            const float* wp = W + (size_t)(k0 + kk) * ldw + n0 + c;
#pragma unroll
            for (int i = 0; i < 4; ++i) Ws[kk][c + i] = wp[i];
        }
        __syncthreads();
#pragma unroll
        for (int kk = 0; kk < 16; ++kk) {
            float a[4], b[4];
#pragma unroll
            for (int i = 0; i < 4; ++i) { a[i] = As[kk][ty * 4 + i]; b[i] = Ws[kk][tx * 4 + i]; }
#pragma unroll
            for (int i = 0; i < 4; ++i)
#pragma unroll
                for (int j = 0; j < 4; ++j) acc[i][j] += a[i] * b[j];
        }
        __syncthreads();
    }
#pragma unroll
    for (int i = 0; i < 4; ++i) {
        const int m = m0 + ty * 4 + i;
#pragma unroll
        for (int j = 0; j < 4; ++j) {
            const int n = n0 + tx * 4 + j;
            if (MODE == 0) ((bf16_t*)Cout)[(size_t)m * ldc + n] = f2bf(acc[i][j]);
            else if (MODE == 1) ((float*)Cout)[(size_t)m * ldc + n] = acc[i][j] + R[(size_t)m * ldc + n];
            else ((float*)Cout)[(size_t)m * ldc + n] = acc[i][j];
        }
    }
}

__global__ void __launch_bounds__(128) k_mixers_seq(const bf16_t* __restrict__ proj, const float* __restrict__ ba,
                                                   const float* __restrict__ lb_logits, const float* __restrict__ hgrn_g,
                                                   const float* __restrict__ conv_w, const float* __restrict__ A_log, const float* __restrict__ dt_bias,
                                                   const float* __restrict__ gdn_g, bf16_t* __restrict__ mix) {
    __shared__ float s0[128], s1[128], s2[128];
    __shared__ float sh[8];
    const int tid = threadIdx.x;
    float S[128];
#pragma unroll
    for (int d = 0; d < 128; ++d) S[d] = 0.f;
    if (blockIdx.x < 16) {
        const int b = blockIdx.x >> 3, h = blockIdx.x & 7;
        const float l0 = lb_logits[h * 128 + tid], l1 = lb_logits[1024 + h * 128 + tid];
        const float lb = 1.f / (1.f + __expf(l1 - l0));
        const float gn = hgrn_g[tid];
        for (int t = 0; t < SEQ; ++t) {
            const bf16_t* pr = proj + (size_t)(b * SEQ + t) * NPROJ;
            const float q = bf2f(pr[C_AQ + h * 128 + tid]), z = bf2f(pr[C_AF + h * 128 + tid]);
            const float f = lb + (1.f - lb) * sigmoidf_(z);
            __syncthreads();
            s0[tid] = q; s1[tid] = f; s2[tid] = 1.f - f;
            __syncthreads();
            const float vv = bf2f(pr[C_AI + h * 128 + tid]);
            float o = 0.f;
#pragma unroll
            for (int d = 0; d < 128; ++d) { S[d] = s1[d] * S[d] + s2[d] * vv; o += s0[d] * S[d]; }
            const float ss = block_sum(o * o, sh);
            const float rstd = rsqrtf(ss * (1.f / 128.f) + EPS);
            const float gate = bf2f(pr[C_AG + h * 128 + tid]);
            mix[(size_t)(b * SEQ + t) * DM + h * 128 + tid] = f2bf(o * rstd * gn * siluf_(gate));
        }
    } else {
        const int bb = blockIdx.x - 16, b = bb >> 3, vh = bb & 7, qh = vh >> 1;
        const int cq = qh * 128 + tid, ck = 512 + qh * 128 + tid, cv = 1024 + vh * 128 + tid;
        float wq[4], wk[4], wv[4];
#pragma unroll
        for (int j = 0; j < 4; ++j) { wq[j] = conv_w[j * 2048 + cq]; wk[j] = conv_w[j * 2048 + ck]; wv[j] = conv_w[j * 2048 + cv]; }
        float hq[3] = {0.f, 0.f, 0.f}, hk[3] = {0.f, 0.f, 0.f}, hv[3] = {0.f, 0.f, 0.f};
        const float Aexp = __expf(A_log[vh]), dtb = dt_bias[vh], gn = gdn_g[tid];
        for (int t = 0; t < SEQ; ++t) {
            const bf16_t* pr = proj + (size_t)(b * SEQ + t) * NPROJ;
            const float xq = bf2f(pr[C_BQ + qh * 128 + tid]), xk = bf2f(pr[C_BK + qh * 128 + tid]), xv = bf2f(pr[C_BV + vh * 128 + tid]);
            float q = wq[0] * hq[0] + wq[1] * hq[1] + wq[2] * hq[2] + wq[3] * xq;
            float k = wk[0] * hk[0] + wk[1] * hk[1] + wk[2] * hk[2] + wk[3] * xk;
            float v = wv[0] * hv[0] + wv[1] * hv[1] + wv[2] * hv[2] + wv[3] * xv;
            hq[0] = hq[1]; hq[1] = hq[2]; hq[2] = xq; hk[0] = hk[1]; hk[1] = hk[2]; hk[2] = xk; hv[0] = hv[1]; hv[1] = hv[2]; hv[2] = xv;
            q = siluf_(q); k = siluf_(k); v = siluf_(v);
            const float sq = block_sum(q * q, sh);
            const float sk = block_sum(k * k, sh);
            q = q * rsqrtf(sq + EPS) * 0.08838834764831845f;
            k = k * rsqrtf(sk + EPS);
            __syncthreads();
            s0[tid] = q; s1[tid] = k;
            __syncthreads();
            const float beta = sigmoidf_(ba[(size_t)(b * SEQ + t) * 16 + vh]);
            const float ax = ba[(size_t)(b * SEQ + t) * 16 + 8 + vh] + dtb;
            const float sp = ax > 20.f ? ax : log1pf(__expf(ax));
            const float eg = __expf(-Aexp * sp);
            float kS = 0.f;
#pragma unroll
            for (int d = 0; d < 128; ++d) { S[d] *= eg; kS += s1[d] * S[d]; }
            const float delta = beta * (v - kS);
            float o = 0.f;
#pragma unroll
            for (int d = 0; d < 128; ++d) { S[d] += s1[d] * delta; o += s0[d] * S[d]; }
            const float ss = block_sum(o * o, sh);
            const float rstd = rsqrtf(ss * (1.f / 128.f) + EPS);
            const float gate = bf2f(pr[C_BZ + vh * 128 + tid]);
            mix[(size_t)(b * SEQ + t) * DM + 1024 + vh * 128 + tid] = f2bf(o * rstd * gn * siluf_(gate));
        }
    }
}

__global__ void __launch_bounds__(256) k_rmsnorm_h(const float* __restrict__ h, const float* __restrict__ g, bf16_t* __restrict__ hn) {
    __shared__ float sh[8];
    const int t = blockIdx.x, tid = threadIdx.x;
    float v[8]; float ss = 0.f;
#pragma unroll
    for (int i = 0; i < 8; ++i) { v[i] = h[(size_t)t * DM + tid * 8 + i]; ss += v[i] * v[i]; }
    ss = block_sum(ss, sh);
    const float rstd = rsqrtf(ss * (1.f / DM) + EPS);
#pragma unroll
    for (int i = 0; i < 8; ++i) hn[(size_t)t * DM + tid * 8 + i] = f2bf(v[i] * rstd * g[tid * 8 + i]);
}

__global__ void __launch_bounds__(256) k_scores_naive(const float* __restrict__ qry, const float* __restrict__ sk, float* __restrict__ scores) {
    __shared__ float sq[2048];
    const int t = blockIdx.x, tid = threadIdx.x;
    for (int i = tid; i < 2048; i += 256) sq[i] = qry[(size_t)t * DM + i];
    __syncthreads();
    for (int c = tid; c < 2048; c += 256) {
        const int h = c >> 8, half = (c >> 7) & 1, n = c & 127;
        const float* kr = sk + (((size_t)half * 8 + h) * 128 + n) * 128;
        const float* qr = sq + h * 256 + half * 128;
        float a = 0.f;
        for (int k = 0; k < 128; ++k) a += qr[k] * kr[k];
        scores[(size_t)t * DM + c] = a;
    }
}

__device__ __forceinline__ void wave_argmax(float& m, int& idx) {
#pragma unroll
    for (int o = 1; o < 64; o <<= 1) {
        const float om = __shfl_xor(m, o); const int oi = __shfl_xor(idx, o);
        if (om > m || (om == m && oi < idx)) { m = om; idx = oi; }
    }
}
__device__ __forceinline__ void topk_head(const float* __restrict__ s, int lane, int& expert, float& gate) {
    float v1 = 0.f, v2 = 0.f; int i1 = 0, i2 = 0;
    {
        float a0 = s[lane], a1 = s[lane + 64];
        for (int it = 0; it < 16; ++it) {
            float m; int idx;
            if (a0 >= a1) { m = a0; idx = lane; } else { m = a1; idx = lane + 64; }
            wave_argmax(m, idx);
            if (idx == lane) a0 = -INFINITY;
            if (idx == lane + 64) a1 = -INFINITY;
            if (lane == it) { v1 = m; i1 = idx; }
        }
    }
    {
        float a0 = s[128 + lane], a1 = s[128 + lane + 64];
        for (int it = 0; it < 16; ++it) {
            float m; int idx;
            if (a0 >= a1) { m = a0; idx = lane; } else { m = a1; idx = lane + 64; }
            wave_argmax(m, idx);
            if (idx == lane) a0 = -INFINITY;
            if (idx == lane + 64) a1 = -INFINITY;
            if (lane == it) { v2 = m; i2 = idx; }
        }
    }
    float c[4];
    const float vi = __shfl(v1, lane >> 2);
#pragma unroll
    for (int cc = 0; cc < 4; ++cc) c[cc] = vi + __shfl(v2, (lane & 3) * 4 + cc);
    float best = 0.f; int pos = 0;
    for (int it = 0; it < 16; ++it) {
        float m = c[0]; int idx = lane * 4;
#pragma unroll
        for (int cc = 1; cc < 4; ++cc) if (c[cc] > m) { m = c[cc]; idx = lane * 4 + cc; }
        wave_argmax(m, idx);
#pragma unroll
        for (int cc = 0; cc < 4; ++cc) if (idx == lane * 4 + cc) c[cc] = -INFINITY;
        if (lane == it) { best = m; pos = idx; }
    }
    const int e1 = __shfl(i1, pos >> 4), e2 = __shfl(i2, pos & 15);
    expert = e1 * 128 + e2;
    const float mx = __shfl(best, 0);
    float ex = (lane < 16) ? __expf(best - mx) : 0.f;
    float sum = ex;
#pragma unroll
    for (int o = 1; o < 16; o <<= 1) sum += __shfl_xor(sum, o);
    gate = ex / sum;
}

__device__ __forceinline__ float gelu_erf(float x) { return 0.5f * x * (1.f + erff(x * 0.70710678118654752f)); }
__global__ void __launch_bounds__(256) k_peer_naive(const float* __restrict__ scores, const bf16_t* __restrict__ hn, const float* __restrict__ h,
                                                   const float* __restrict__ u_tab, const float* __restrict__ v_tab, const float* __restrict__ gfin,
                                                   float* __restrict__ out) {
    __shared__ int se[4][128];
    __shared__ float sg[4][128];
    const int w = threadIdx.x >> 6, lane = threadIdx.x & 63;
    const int t = blockIdx.x * 4 + w;
    for (int hd = 0; hd < 8; ++hd) {
        int e; float g;
        topk_head(scores + (size_t)t * DM + hd * 256, lane, e, g);
        if (lane < 16) { se[w][hd * 16 + lane] = e; sg[w][hd * 16 + lane] = g; }
    }
    __syncthreads();
    float xv[32], y[32];
#pragma unroll
    for (int j = 0; j < 8; ++j)
#pragma unroll
        for (int i = 0; i < 4; ++i) { xv[j * 4 + i] = bf2f(hn[(size_t)t * DM + j * 256 + lane * 4 + i]); y[j * 4 + i] = 0.f; }
    for (int k = 0; k < 128; ++k) {
        const int e = se[w][k]; const float g = sg[w][k];
        const float* ur = u_tab + (size_t)e * DM; const float* vr = v_tab + (size_t)e * DM;
        float p = 0.f;
#pragma unroll
        for (int j = 0; j < 8; ++j) {
            const f32x4 uu = *(const f32x4*)(ur + j * 256 + lane * 4);
            p += uu.x * xv[j * 4] + uu.y * xv[j * 4 + 1] + uu.z * xv[j * 4 + 2] + uu.w * xv[j * 4 + 3];
        }
        p = wave_sum(p);
        const float wgt = g * gelu_erf(p);
#pragma unroll
        for (int j = 0; j < 8; ++j) {
            const f32x4 vv = *(const f32x4*)(vr + j * 256 + lane * 4);
            y[j * 4] += wgt * vv.x; y[j * 4 + 1] += wgt * vv.y; y[j * 4 + 2] += wgt * vv.z; y[j * 4 + 3] += wgt * vv.w;
        }
    }
    float ss = 0.f;
#pragma unroll
    for (int j = 0; j < 8; ++j)
#pragma unroll
        for (int i = 0; i < 4; ++i) { y[j * 4 + i] += h[(size_t)t * DM + j * 256 + lane * 4 + i]; ss += y[j * 4 + i] * y[j * 4 + i]; }
    ss = wave_sum(ss);
    const float rstd = rsqrtf(ss * (1.f / DM) + EPS);
#pragma unroll
    for (int j = 0; j < 8; ++j)
#pragma unroll
        for (int i = 0; i < 4; ++i) out[(size_t)t * DM + j * 256 + lane * 4 + i] = y[j * 4 + i] * rstd * gfin[j * 256 + lane * 4 + i];
}

extern "C" void kernel_launch(void* const* d_in, const int* in_sizes, int n_in, void* d_out, int out_size, void* d_ws, size_t ws_size, hipStream_t stream) {
    const float* x = (const float*)d_in[0];
    const float* attn_g = (const float*)d_in[1];
    const float* w_in = (const float*)d_in[2];
    const float* lb_logits = (const float*)d_in[3];
    const float* hgrn_g = (const float*)d_in[4];
    const float* conv_w = (const float*)d_in[5];
    const float* A_log = (const float*)d_in[6];
    const float* dt_bias = (const float*)d_in[7];
    const float* gdn_g = (const float*)d_in[8];
    const float* w_out = (const float*)d_in[9];
    const float* ffn_g = (const float*)d_in[10];
    const float* w_query = (const float*)d_in[11];
    const float* sub_keys = (const float*)d_in[12];
    const float* peer_u = (const float*)d_in[13];
    const float* peer_v = (const float*)d_in[14];
    const float* fin_g = (const float*)d_in[15];
    unsigned char* ws = (unsigned char*)d_ws;
    bf16_t* xn = (bf16_t*)(ws + OFF_D);
    float* ba = (float*)(ws + OFF_S);
    bf16_t* proj = (bf16_t*)(ws + OFF_B);
    bf16_t* mix = (bf16_t*)(ws + OFF_D);
    float* hbuf = (float*)(ws + OFF_B);
    bf16_t* hn = (bf16_t*)(ws + OFF_D + 128 * MiB);
    float* qry = (float*)d_out;
    float* scores = (float*)(ws + OFF_D);
    float* out = (float*)d_out;

    k_rmsnorm_x<<<T, 256, 0, stream>>>(x, attn_g, w_in, xn, ba);
    k_gemm_naive<0><<<dim3(NPROJ / 64, T / 64), 256, 0, stream>>>(xn, w_in, INW, DM, NPROJ, proj, NPROJ, nullptr);
    k_mixers_seq<<<32, 128, 0, stream>>>(proj, ba, lb_logits, hgrn_g, conv_w, A_log, dt_bias, gdn_g, mix);
    k_gemm_naive<1><<<dim3(DM / 64, T / 64), 256, 0, stream>>>(mix, w_out, DM, DM, DM, hbuf, DM, x);
    k_rmsnorm_h<<<T, 256, 0, stream>>>(hbuf, ffn_g, hn);
    k_gemm_naive<2><<<dim3(DM / 64, T / 64), 256, 0, stream>>>(hn, w_query, DM, DM, DM, qry, DM, nullptr);
    k_scores_naive<<<T, 256, 0, stream>>>(qry, sub_keys, scores);
    k_peer_naive<<<T / 4, 256, 0, stream>>>(scores, hn, hbuf, peer_u, peer_v, fin_g, out);
}
```

```cpp
#include <hip/hip_runtime.h>
#include <hip/hip_cooperative_groups.h>
#include <cstdio>
namespace cg = cooperative_groups;
#include <stdint.h>

typedef unsigned short bf16_t;
typedef float f32x4 __attribute__((ext_vector_type(4)));

constexpr int T = 16384, SEQ = 8192, DM = 2048, INW = 7184, NPROJ = 7168;
constexpr float EPS = 1e-6f;
constexpr size_t MiB = 1u << 20;
constexpr size_t OFF_TAB = 1 * MiB;
constexpr size_t OFF_B = 65 * MiB;
constexpr size_t OFF_C = 289 * MiB;
constexpr size_t OFF_D = 305 * MiB;
constexpr size_t OFF_S = 500 * MiB;
constexpr int C_AQ = 0, C_AF = 1024, C_AI = 2048, C_AG = 3072, C_BQ = 4096, C_BK = 4608, C_BV = 5120, C_BZ = 6144;

__device__ __forceinline__ float bf2f(bf16_t v) { return __uint_as_float(((unsigned)v) << 16); }
__device__ __forceinline__ bf16_t f2bf(float f) { unsigned u = __float_as_uint(f); return (bf16_t)((u + 0x7fffu + ((u >> 16) & 1u)) >> 16); }
__device__ __forceinline__ float sigmoidf_(float x) { return 1.f / (1.f + __expf(-x)); }
__device__ __forceinline__ float siluf_(float x) { return x / (1.f + __expf(-x)); }
__device__ __forceinline__ float wave_sum(float v) {
#pragma unroll
    for (int o = 1; o < 64; o <<= 1) v += __shfl_xor(v, o);
    return v;
}
__device__ __forceinline__ float block_sum(float v, float* sh) {
    v = wave_sum(v);
    const int w = threadIdx.x >> 6, nw = blockDim.x >> 6;
    __syncthreads();
    if ((threadIdx.x & 63) == 0) sh[w] = v;
    __syncthreads();
    float r = 0.f;
    for (int i = 0; i < nw; ++i) r += sh[i];
    return r;
}

__global__ void __launch_bounds__(256) k_rmsnorm_x(const float* __restrict__ x, const float* __restrict__ g, const float* __restrict__ w_in,
                                                  bf16_t* __restrict__ xn, float* __restrict__ ba) {
    __shared__ float sh[8];
    __shared__ float sacc[4][16];
    const int t = blockIdx.x, tid = threadIdx.x;
    const float* xr = x + (size_t)t * DM;
    float v[8];
    float ss = 0.f;
#pragma unroll
    for (int i = 0; i < 8; ++i) { v[i] = xr[tid * 8 + i]; ss += v[i] * v[i]; }
    ss = block_sum(ss, sh);
    const float rstd = rsqrtf(ss * (1.f / DM) + EPS);
    float acc[16];
#pragma unroll
    for (int j = 0; j < 16; ++j) acc[j] = 0.f;
#pragma unroll
    for (int i = 0; i < 8; ++i) {
        const int d = tid * 8 + i;
        const float y = v[i] * rstd * g[d];
        xn[(size_t)t * DM + d] = f2bf(y);
        const float* wr = w_in + (size_t)d * INW + NPROJ;
#pragma unroll
        for (int j = 0; j < 16; ++j) acc[j] += y * wr[j];
    }
#pragma unroll
    for (int j = 0; j < 16; ++j) acc[j] = wave_sum(acc[j]);
    __syncthreads();
    if ((tid & 63) == 0) {
#pragma unroll
        for (int j = 0; j < 16; ++j) sacc[tid >> 6][j] = acc[j];
    }
    __syncthreads();
    if (tid < 16) ba[(size_t)t * 16 + tid] = sacc[0][tid] + sacc[1][tid] + sacc[2][tid] + sacc[3][tid];
}

template <int MODE>
__global__ void __launch_bounds__(256) k_gemm_naive(const bf16_t* __restrict__ A, const float* __restrict__ W, int ldw, int K, int N,
                                                   void* __restrict__ Cout, int ldc, const float* __restrict__ R) {
    __shared__ float As[16][68];
    __shared__ float Ws[16][68];
    const int tid = threadIdx.x, tx = tid & 15, ty = tid >> 4;
    const int m0 = blockIdx.y * 64, n0 = blockIdx.x * 64;
    float acc[4][4];
#pragma unroll
    for (int i = 0; i < 4; ++i)
#pragma unroll
        for (int j = 0; j < 4; ++j) acc[i][j] = 0.f;
    for (int k0 = 0; k0 < K; k0 += 16) {
        {
            const int r = tid >> 2, kk = (tid & 3) * 4;
            const bf16_t* ap = A + (size_t)(m0 + r) * K + k0 + kk;
#pragma unroll
            for (int i = 0; i < 4; ++i) As[kk + i][r] = bf2f(ap[i]);
        }
        {
            const int kk = tid >> 4, c = (tid & 15) * 4;
            const float* wp = W + (size_t)(k0 + kk) * ldw + n0 + c;
#pragma unroll
            for (int i = 0; i < 4; ++i) Ws[kk][c + i] = wp[i];
        }
        __syncthreads();
#pragma unroll
        for (int kk = 0; kk < 16; ++kk) {
            float a[4], b[4];
#pragma unroll
            for (int i = 0; i < 4; ++i) { a[i] = As[kk][ty * 4 + i]; b[i] = Ws[kk][tx * 4 + i]; }
#pragma unroll
            for (int i = 0; i < 4; ++i)
#pragma unroll
                for (int j = 0; j < 4; ++j) acc[i][j] += a[i] * b[j];
        }
        __syncthreads();
    }
#pragma unroll
    for (int i = 0; i < 4; ++i) {
        const int m = m0 + ty * 4 + i;
#pragma unroll
        for (int j = 0; j < 4; ++j) {
            const int n = n0 + tx * 4 + j;
            if (MODE == 0) ((bf16_t*)Cout)[(size_t)m * ldc + n] = f2bf(acc[i][j]);
            else if (MODE == 1) ((float*)Cout)[(size_t)m * ldc + n] = acc[i][j] + R[(size_t)m * ldc + n];
            else ((float*)Cout)[(size_t)m * ldc + n] = acc[i][j];
        }
    }
}

__global__ void __launch_bounds__(128) k_mixers_seq(const bf16_t* __restrict__ proj, const float* __restrict__ ba,
                                                   const float* __restrict__ lb_logits, const float* __restrict__ hgrn_g,
                                                   const float* __restrict__ conv_w, const float* __restrict__ A_log, const float* __restrict__ dt_bias,
                                                   const float* __restrict__ gdn_g, bf16_t* __restrict__ mix) {
    __shared__ float s0[128], s1[128], s2[128];
    __shared__ float sh[8];
    const int tid = threadIdx.x;
    float S[128];
#pragma unroll
    for (int d = 0; d < 128; ++d) S[d] = 0.f;
    if (blockIdx.x < 16) {
        const int b = blockIdx.x >> 3, h = blockIdx.x & 7;
        const float l0 = lb_logits[h * 128 + tid], l1 = lb_logits[1024 + h * 128 + tid];
        const float lb = 1.f / (1.f + __expf(l1 - l0));
        const float gn = hgrn_g[tid];
        for (int t = 0; t < SEQ; ++t) {
            const bf16_t* pr = proj + (size_t)(b * SEQ + t) * NPROJ;
            const float q = bf2f(pr[C_AQ + h * 128 + tid]), z = bf2f(pr[C_AF + h * 128 + tid]);
            const float f = lb + (1.f - lb) * sigmoidf_(z);
            __syncthreads();
            s0[tid] = q; s1[tid] = f; s2[tid] = 1.f - f;
            __syncthreads();
            const float vv = bf2f(pr[C_AI + h * 128 + tid]);
            float o = 0.f;
#pragma unroll
            for (int d = 0; d < 128; ++d) { S[d] = s1[d] * S[d] + s2[d] * vv; o += s0[d] * S[d]; }
            const float ss = block_sum(o * o, sh);
            const float rstd = rsqrtf(ss * (1.f / 128.f) + EPS);
            const float gate = bf2f(pr[C_AG + h * 128 + tid]);
            mix[(size_t)(b * SEQ + t) * DM + h * 128 + tid] = f2bf(o * rstd * gn * siluf_(gate));
        }
    } else {
        const int bb = blockIdx.x - 16, b = bb >> 3, vh = bb & 7, qh = vh >> 1;
        const int cq = qh * 128 + tid, ck = 512 + qh * 128 + tid, cv = 1024 + vh * 128 + tid;
        float wq[4], wk[4], wv[4];
#pragma unroll
        for (int j = 0; j < 4; ++j) { wq[j] = conv_w[j * 2048 + cq]; wk[j] = conv_w[j * 2048 + ck]; wv[j] = conv_w[j * 2048 + cv]; }
        float hq[3] = {0.f, 0.f, 0.f}, hk[3] = {0.f, 0.f, 0.f}, hv[3] = {0.f, 0.f, 0.f};
        const float Aexp = __expf(A_log[vh]), dtb = dt_bias[vh], gn = gdn_g[tid];
        for (int t = 0; t < SEQ; ++t) {
            const bf16_t* pr = proj + (size_t)(b * SEQ + t) * NPROJ;
            const float xq = bf2f(pr[C_BQ + qh * 128 + tid]), xk = bf2f(pr[C_BK + qh * 128 + tid]), xv = bf2f(pr[C_BV + vh * 128 + tid]);
            float q = wq[0] * hq[0] + wq[1] * hq[1] + wq[2] * hq[2] + wq[3] * xq;
            float k = wk[0] * hk[0] + wk[1] * hk[1] + wk[2] * hk[2] + wk[3] * xk;
            float v = wv[0] * hv[0] + wv[1] * hv[1] + wv[2] * hv[2] + wv[3] * xv;
            hq[0] = hq[1]; hq[1] = hq[2]; hq[2] = xq; hk[0] = hk[1]; hk[1] = hk[2]; hk[2] = xk; hv[0] = hv[1]; hv[1] = hv[2]; hv[2] = xv;
            q = siluf_(q); k = siluf_(k); v = siluf_(v);
            const float sq = block_sum(q * q, sh);
            const float sk = block_sum(k * k, sh);
            q = q * rsqrtf(sq + EPS) * 0.08838834764831845f;
            k = k * rsqrtf(sk + EPS);
            __syncthreads();
            s0[tid] = q; s1[tid] = k;
            __syncthreads();
            const float beta = sigmoidf_(ba[(size_t)(b * SEQ + t) * 16 + vh]);
            const float ax = ba[(size_t)(b * SEQ + t) * 16 + 8 + vh] + dtb;
            const float sp = ax > 20.f ? ax : log1pf(__expf(ax));
            const float eg = __expf(-Aexp * sp);
            float kS = 0.f;
#pragma unroll
            for (int d = 0; d < 128; ++d) { S[d] *= eg; kS += s1[d] * S[d]; }
            const float delta = beta * (v - kS);
            float o = 0.f;
#pragma unroll
            for (int d = 0; d < 128; ++d) { S[d] += s1[d] * delta; o += s0[d] * S[d]; }
            const float ss = block_sum(o * o, sh);
            const float rstd = rsqrtf(ss * (1.f / 128.f) + EPS);
            const float gate = bf2f(pr[C_BZ + vh * 128 + tid]);
            mix[(size_t)(b * SEQ + t) * DM + 1024 + vh * 128 + tid] = f2bf(o * rstd * gn * siluf_(gate));
        }
    }
}

__global__ void __launch_bounds__(256) k_rmsnorm_h(const float* __restrict__ h, const float* __restrict__ g, bf16_t* __restrict__ hn) {
    __shared__ float sh[8];
    const int t = blockIdx.x, tid = threadIdx.x;
    float v[8]; float ss = 0.f;
#pragma unroll
    for (int i = 0; i < 8; ++i) { v[i] = h[(size_t)t * DM + tid * 8 + i]; ss += v[i] * v[i]; }
    ss = block_sum(ss, sh);
    const float rstd = rsqrtf(ss * (1.f / DM) + EPS);
#pragma unroll
    for (int i = 0; i < 8; ++i) hn[(size_t)t * DM + tid * 8 + i] = f2bf(v[i] * rstd * g[tid * 8 + i]);
}

__global__ void __launch_bounds__(256) k_scores_naive(const float* __restrict__ qry, const float* __restrict__ sk, float* __restrict__ scores) {
    __shared__ float sq[2048];
    const int t = blockIdx.x, tid = threadIdx.x;
    for (int i = tid; i < 2048; i += 256) sq[i] = qry[(size_t)t * DM + i];
    __syncthreads();
    for (int c = tid; c < 2048; c += 256) {
        const int h = c >> 8, half = (c >> 7) & 1, n = c & 127;
        const float* kr = sk + (((size_t)half * 8 + h) * 128 + n) * 128;
        const float* qr = sq + h * 256 + half * 128;
        float a = 0.f;
        for (int k = 0; k < 128; ++k) a += qr[k] * kr[k];
        scores[(size_t)t * DM + c] = a;
    }
}

__device__ __forceinline__ void wave_argmax(float& m, int& idx) {
#pragma unroll
    for (int o = 1; o < 64; o <<= 1) {
        const float om = __shfl_xor(m, o); const int oi = __shfl_xor(idx, o);
        if (om > m || (om == m && oi < idx)) { m = om; idx = oi; }
    }
}
__device__ __forceinline__ void topk_head(const float* __restrict__ s, int lane, int& expert, float& gate) {
    float v1 = 0.f, v2 = 0.f; int i1 = 0, i2 = 0;
    {
        float a0 = s[lane], a1 = s[lane + 64];
        for (int it = 0; it < 16; ++it) {
            float m; int idx;
            if (a0 >= a1) { m = a0; idx = lane; } else { m = a1; idx = lane + 64; }
            wave_argmax(m, idx);
            if (idx == lane) a0 = -INFINITY;
            if (idx == lane + 64) a1 = -INFINITY;
            if (lane == it) { v1 = m; i1 = idx; }
        }
    }
    {
        float a0 = s[128 + lane], a1 = s[128 + lane + 64];
        for (int it = 0; it < 16; ++it) {
            float m; int idx;
            if (a0 >= a1) { m = a0; idx = lane; } else { m = a1; idx = lane + 64; }
            wave_argmax(m, idx);
            if (idx == lane) a0 = -INFINITY;
            if (idx == lane + 64) a1 = -INFINITY;
            if (lane == it) { v2 = m; i2 = idx; }
        }
    }
    float c[4];
    const float vi = __shfl(v1, lane >> 2);
#pragma unroll
    for (int cc = 0; cc < 4; ++cc) c[cc] = vi + __shfl(v2, (lane & 3) * 4 + cc);
    float best = 0.f; int pos = 0;
    for (int it = 0; it < 16; ++it) {
        float m = c[0]; int idx = lane * 4;
#pragma unroll
        for (int cc = 1; cc < 4; ++cc) if (c[cc] > m) { m = c[cc]; idx = lane * 4 + cc; }
        wave_argmax(m, idx);
#pragma unroll
        for (int cc = 0; cc < 4; ++cc) if (idx == lane * 4 + cc) c[cc] = -INFINITY;
        if (lane == it) { best = m; pos = idx; }
    }
    const int e1 = __shfl(i1, pos >> 4), e2 = __shfl(i2, pos & 15);
    expert = e1 * 128 + e2;
    const float mx = __shfl(best, 0);
    float ex = (lane < 16) ? __expf(best - mx) : 0.f;
    float sum = ex;
#pragma unroll
    for (int o = 1; o < 16; o <<= 1) sum += __shfl_xor(sum, o);
    gate = ex / sum;
}

__device__ __forceinline__ float gelu_erf(float x) { return 0.5f * x * (1.f + erff(x * 0.70710678118654752f)); }
__global__ void __launch_bounds__(256) k_peer_naive(const float* __restrict__ scores, const bf16_t* __restrict__ hn, const float* __restrict__ h,
                                                   const float* __restrict__ u_tab, const float* __restrict__ v_tab, const float* __restrict__ gfin,
                                                   float* __restrict__ out) {
    __shared__ int se[4][128];
    __shared__ float sg[4][128];
    const int w = threadIdx.x >> 6, lane = threadIdx.x & 63;
    const int t = blockIdx.x * 4 + w;
    for (int hd = 0; hd < 8; ++hd) {
        int e; float g;
        topk_head(scores + (size_t)t * DM + hd * 256, lane, e, g);
        if (lane < 16) { se[w][hd * 16 + lane] = e; sg[w][hd * 16 + lane] = g; }
    }
    __syncthreads();
    float xv[32], y[32];
#pragma unroll
    for (int j = 0; j < 8; ++j)
#pragma unroll
        for (int i = 0; i < 4; ++i) { xv[j * 4 + i] = bf2f(hn[(size_t)t * DM + j * 256 + lane * 4 + i]); y[j * 4 + i] = 0.f; }
    for (int k = 0; k < 128; ++k) {
        const int e = se[w][k]; const float g = sg[w][k];
        const float* ur = u_tab + (size_t)e * DM; const float* vr = v_tab + (size_t)e * DM;
        float p = 0.f;
#pragma unroll
        for (int j = 0; j < 8; ++j) {
            const f32x4 uu = *(const f32x4*)(ur + j * 256 + lane * 4);
            p += uu.x * xv[j * 4] + uu.y * xv[j * 4 + 1] + uu.z * xv[j * 4 + 2] + uu.w * xv[j * 4 + 3];
        }
        p = wave_sum(p);
        const float wgt = g * gelu_erf(p);
#pragma unroll
        for (int j = 0; j < 8; ++j) {
            const f32x4 vv = *(const f32x4*)(vr + j * 256 + lane * 4);
            y[j * 4] += wgt * vv.x; y[j * 4 + 1] += wgt * vv.y; y[j * 4 + 2] += wgt * vv.z; y[j * 4 + 3] += wgt * vv.w;
        }
    }
    float ss = 0.f;
#pragma unroll
    for (int j = 0; j < 8; ++j)
#pragma unroll
        for (int i = 0; i < 4; ++i) { y[j * 4 + i] += h[(size_t)t * DM + j * 256 + lane * 4 + i]; ss += y[j * 4 + i] * y[j * 4 + i]; }
    ss = wave_sum(ss);
    const float rstd = rsqrtf(ss * (1.f / DM) + EPS);
#pragma unroll
    for (int j = 0; j < 8; ++j)
#pragma unroll
        for (int i = 0; i < 4; ++i) out[(size_t)t * DM + j * 256 + lane * 4 + i] = y[j * 4 + i] * rstd * gfin[j * 256 + lane * 4 + i];
}

namespace pg8 {
#define PG8_LAS __attribute__((address_space(3)))
typedef unsigned short bf16_t;
typedef short bf16x8 __attribute__((ext_vector_type(8)));
typedef float f32x4 __attribute__((ext_vector_type(4)));
typedef unsigned u32x4 __attribute__((ext_vector_type(4)));
constexpr int BM = 256, BK = 64, HALF = 128, HTB = HALF * BK * 2  , STAGE_BYTES = 8 * HTB, NXCD = 8, WGM = 8;

__host__ __device__ __forceinline__ int lds_byte(int r, int c) { const int st = (r >> 4) * 2 + (c >> 5), rr = r & 15, cc = c & 31, ob = rr * 64 + cc * 2; return st * 1024 + (ob ^ (((ob >> 9) & 1) << 5)); }
__host__ __device__ __forceinline__ void stage_rc(int b, int& R, int& C) { const int st = b / 1024, sb = b % 1024, swz = sb ^ (((sb >> 9) & 1) << 5); R = (st >> 1) * 16 + swz / 64; C = (st & 1) * 32 + (swz % 64) / 2; }
__host__ __device__ __forceinline__ int perm32(int rho) { const int n = rho >> 4, i = rho & 15; return 8 * (i >> 2) + 4 * n + (i & 3); }

struct Unit { int pm, pn; };
struct Gemm { const bf16_t* A; const bf16_t* Bt; int M, N, K; };

struct StaticOrder {
    int nM, nN, nwg, G, c;
    __host__ __device__ void init(int M, int N, int G_, int c_) { nM = M / BM; nN = N / BM; nwg = nM * nN; G = G_; c = c_; }
    __host__ __device__ bool next(int i, Unit& u) const {
        const long L = (long)i * G + c; if (L >= nwg) return false;
        int wgid = (int)L; { const int q = nwg / NXCD, r = nwg % NXCD, xcd = wgid % NXCD, off = wgid / NXCD; wgid = (xcd < r ? xcd * (q + 1) : r * (q + 1) + (xcd - r) * q) + off; }
        const int nig = WGM * nN, gid = wgid / nig, fm = gid * WGM, gsz = (nM - fm) < WGM ? (nM - fm) : WGM;
        u.pm = fm + ((wgid % nig) % gsz); u.pn = (wgid % nig) / gsz; return true;
    }
    __device__ __forceinline__ void a_ready(const Unit&) const {}
    __device__ __forceinline__ void done(const Unit&) const {}
};

__device__ __forceinline__ unsigned cvt_pk_bf16(float lo, float hi) { unsigned r; asm volatile("v_cvt_pk_bf16_f32 %0, %1, %2" : "=v"(r) : "v"(lo), "v"(hi)); return r; }
typedef float f32x2 __attribute__((ext_vector_type(2)));
__device__ __forceinline__ f32x2 gelu_pk(f32x2 v) {
    const f32x2 av = __builtin_elementwise_abs(v), d = av * 0.2316418882f + 1.0f;
    f32x2 t; t.x = __builtin_amdgcn_rcpf(d.x); t.y = __builtin_amdgcn_rcpf(d.y);
    f32x2 q = t * 0.5307027145f + (-0.7265760135f); q = q * t + 0.7107068705f; q = q * t + (-0.142248368f); q = q * t + 0.127414796f; q = q * t;
    const f32x2 s = (v * v) * (-0.72134752044f);
    f32x2 e; e.x = __builtin_amdgcn_exp2f(s.x); e.y = __builtin_amdgcn_exp2f(s.y);
    const f32x2 m = v * (q * e), r = v - m;
    f32x2 o; o.x = v.x < 0.f ? m.x : r.x; o.y = v.y < 0.f ? m.y : r.y; return o;
}

template <int ACT  > struct EpiBf16 {
    static constexpr bool PERM = true, AFTER_DRAIN = false; static_assert(ACT == 0 || ACT == 1, "EpiBf16: ACT is 0 (none) or 1 (gelu_pk)");
    bf16_t* O; int ldc; const float* bias; int split_cols; size_t split_stride; float scale0;
    __device__ __forceinline__ void operator()(const f32x4 (&acc)[2][2][4][2], const Unit& u, int wr, int wc, int fr, int fq) const {
        const int row0 = u.pm * BM + wr * 64 + fr; int colt = u.pn * BM; bf16_t* base = O;
        float sc = 1.f; if (split_cols) { const int t = colt / split_cols; base += (size_t)t * split_stride; colt -= t * split_cols; if (t == 0) sc = scale0; }
        const int col0 = colt + wc * 32 + 8 * fq, bcol0 = u.pn * BM + wc * 32 + 8 * fq;
        f32x4 bv[2][2];
#pragma unroll
        for (int bj = 0; bj < 2; ++bj)
#pragma unroll
            for (int n = 0; n < 2; ++n) bv[bj][n] = bias ? *(const f32x4*)(bias + bcol0 + bj * HALF + 4 * n) : (f32x4){0.f, 0.f, 0.f, 0.f};
#pragma unroll
        for (int ai = 0; ai < 2; ++ai)
#pragma unroll
            for (int m = 0; m < 4; ++m) { bf16_t* rowp = base + (size_t)(row0 + ai * HALF + m * 16) * ldc + col0;
#pragma unroll
                for (int bj = 0; bj < 2; ++bj) { f32x4 v0 = acc[ai][bj][m][0] + bv[bj][0], v1 = acc[ai][bj][m][1] + bv[bj][1];
                    if (ACT == 1) { f32x2 a = gelu_pk((f32x2){v0[0], v0[1]}), b = gelu_pk((f32x2){v0[2], v0[3]}), c = gelu_pk((f32x2){v1[0], v1[1]}), d = gelu_pk((f32x2){v1[2], v1[3]});
                        v0 = (f32x4){a.x, a.y, b.x, b.y}; v1 = (f32x4){c.x, c.y, d.x, d.y}; }
                    v0 = v0 * sc; v1 = v1 * sc; u32x4 w; w.x = cvt_pk_bf16(v0[0], v0[1]); w.y = cvt_pk_bf16(v0[2], v0[3]); w.z = cvt_pk_bf16(v1[0], v1[1]); w.w = cvt_pk_bf16(v1[2], v1[3]);
                    *(u32x4*)(rowp + bj * HALF) = w; } }
    }
};
template <class Epi, class Sched, bool ALIGN_EPI = false, bool SP2 = false>
__device__ __forceinline__ void gemm_phase(PG8_LAS unsigned char* lds, const Gemm g, const Sched& S, const Epi& E) {
    const int tid = threadIdx.x, wid = __builtin_amdgcn_readfirstlane(tid >> 6), lane = tid & 63, wr = wid >> 2, wc = wid & 3, fr = lane & 15, fq = lane >> 4;
    const int K = g.K, nt = K / BK;
    unsigned voffA[2], voffB[2];
#pragma unroll
    for (int i = 0; i < 2; ++i) { int R, C; stage_rc(tid * 16 + i * 8192, R, C); const int Rb = Epi::PERM ? ((R & ~31) + perm32(R & 31)) : R;
        voffA[i] = (unsigned)(R * K + C) * 2u; voffB[i] = (unsigned)(Rb * K + C) * 2u; }
    const size_t kstep = (size_t)(BK * 2);
    const size_t hstep = (size_t)HALF * K * 2;
    const size_t tstep = 2 * hstep;
    const unsigned ldsw = (unsigned)wid * 1024u;
    const int aoff = lds_byte(wr * 64 + fr, fq * 8), boff = lds_byte(wc * 32 + fr, fq * 8);
#define PG8_SA(b, h) (((b) * 2 + (h)) * HTB)
#define PG8_SB(b, h) ((4 + (b) * 2 + (h)) * HTB)
#define PG8_STAGE(bufoff, gbase, voff) do { _Pragma("unroll") for (int _i = 0; _i < 2; ++_i) \
        __builtin_amdgcn_global_load_lds((const unsigned*)((const char*)(gbase) + (voff)[_i]), (PG8_LAS unsigned*)(lds + (bufoff) + ldsw + _i * 8192), 16, 0, 0); } while (0)
#define PG8_LDA(dst, b, h) do { _Pragma("unroll") for (int m = 0; m < 4; ++m) _Pragma("unroll") for (int k = 0; k < 2; ++k) dst[m][k] = *(const PG8_LAS bf16x8*)(lds + PG8_SA(b, h) + aoff + m * 2048 + k * 1024); } while (0)
#define PG8_LDB(dst, b, h) do { _Pragma("unroll") for (int n = 0; n < 2; ++n) _Pragma("unroll") for (int k = 0; k < 2; ++k) dst[n][k] = *(const PG8_LAS bf16x8*)(lds + PG8_SB(b, h) + boff + n * 2048 + k * 1024); } while (0)
#define PG8_MMA(ai, bj, At, Bt) do { __builtin_amdgcn_s_setprio(1); _Pragma("unroll") for (int m = 0; m < 4; ++m) _Pragma("unroll") for (int n = 0; n < 2; ++n) _Pragma("unroll") for (int k = 0; k < 2; ++k) \
        acc[ai][bj][m][n] = __builtin_amdgcn_mfma_f32_16x16x32_bf16(Bt[n][k], At[m][k], acc[ai][bj][m][n], 0, 0, 0); __builtin_amdgcn_s_setprio(0); } while (0)
#define PG8_WAIT_V(n) asm volatile("s_waitcnt vmcnt(" #n ")" ::: "memory")
#define PG8_WAIT_L(n) asm volatile("s_waitcnt lgkmcnt(" #n ")" ::: "memory")
#define PG8_BAR __builtin_amdgcn_s_barrier()
#define PG8_SCHED __builtin_amdgcn_sched_barrier(0)
    Unit cur, nxt; int ui = 0;
    if (!S.next(0, cur)) return;
    f32x4 acc[2][2][4][2];
#pragma unroll
    for (int a = 0; a < 2; ++a)
#pragma unroll
        for (int b = 0; b < 2; ++b)
#pragma unroll
            for (int m = 0; m < 4; ++m)
#pragma unroll
                for (int n = 0; n < 2; ++n) acc[a][b][m][n] = (f32x4){0.f, 0.f, 0.f, 0.f};
    bf16x8 At[4][2], B0[2][2], B1[2][2];
    const char* cA = (const char*)g.A + (size_t)cur.pm * tstep; const char* cB = (const char*)g.Bt + (size_t)cur.pn * tstep;
    S.a_ready(cur);
    if constexpr (SP2) {
        PG8_STAGE(PG8_SB(0, 0), cB, voffB); PG8_STAGE(PG8_SB(0, 1), cB + hstep, voffB); PG8_STAGE(PG8_SA(0, 0), cA, voffA); PG8_STAGE(PG8_SA(0, 1), cA + hstep, voffA);
        if (wr == 1) PG8_BAR;
        PG8_WAIT_V(2); PG8_BAR;
        PG8_STAGE(PG8_SB(1, 0), cB + kstep, voffB); PG8_STAGE(PG8_SA(1, 0), cA + kstep, voffA); PG8_STAGE(PG8_SB(1, 1), cB + hstep + kstep, voffB);
        PG8_WAIT_V(6); PG8_BAR;
    } else {
        PG8_STAGE(PG8_SB(0, 0), cB, voffB); PG8_STAGE(PG8_SA(0, 0), cA, voffA); PG8_STAGE(PG8_SB(0, 1), cB + hstep, voffB); PG8_STAGE(PG8_SA(0, 1), cA + hstep, voffA);
        if (wr == 1) PG8_BAR;
        PG8_WAIT_V(4); PG8_BAR;
        PG8_STAGE(PG8_SB(1, 0), cB + kstep, voffB); PG8_STAGE(PG8_SA(1, 0), cA + kstep, voffA); PG8_STAGE(PG8_SB(1, 1), cB + hstep + kstep, voffB);
        PG8_WAIT_V(6); PG8_BAR;
    }
    for (;;) {
        const bool has_next = S.next(ui + 1, nxt);
        const char* nA = has_next ? (const char*)g.A + (size_t)nxt.pm * tstep : cA; const char* nB = has_next ? (const char*)g.Bt + (size_t)nxt.pn * tstep : cB;
        for (int t = 0; t < nt; t += 2) {
            const bool last = (t == nt - 2);
            const char* a1 = cA + (size_t)(t + 1) * kstep;
            const char* a2 = last ? nA : cA + (size_t)(t + 2) * kstep; const char* b2 = last ? nB : cB + (size_t)(t + 2) * kstep;
            const char* a3 = a2 + kstep; const char* b3 = b2 + kstep;
            if (last && has_next) S.a_ready(nxt);
            if constexpr (SP2) {
            PG8_LDB(B0, 0, 0); PG8_LDB(B1, 0, 1); PG8_SCHED; PG8_LDA(At, 0, 0); PG8_STAGE(PG8_SA(1, 1), a1 + hstep, voffA);
            PG8_WAIT_V(8); PG8_WAIT_L(0); PG8_BAR; PG8_MMA(0, 0, At, B0); PG8_MMA(0, 1, At, B1); PG8_BAR; PG8_SCHED;
            PG8_LDA(At, 0, 1); PG8_STAGE(PG8_SB(0, 0), b2, voffB); PG8_STAGE(PG8_SB(0, 1), b2 + hstep, voffB); PG8_STAGE(PG8_SA(0, 0), a2, voffA);
            PG8_WAIT_V(8); PG8_WAIT_L(0); PG8_BAR; PG8_MMA(1, 0, At, B0); PG8_MMA(1, 1, At, B1); PG8_BAR; PG8_SCHED;
            PG8_LDB(B0, 1, 0); PG8_LDB(B1, 1, 1); PG8_SCHED; PG8_LDA(At, 1, 0); PG8_STAGE(PG8_SA(0, 1), a2 + hstep, voffA);
            PG8_WAIT_V(8); PG8_WAIT_L(0); PG8_BAR; PG8_MMA(0, 0, At, B0); PG8_MMA(0, 1, At, B1); PG8_BAR; PG8_SCHED;
            PG8_LDA(At, 1, 1); PG8_STAGE(PG8_SB(1, 0), b3, voffB); PG8_STAGE(PG8_SB(1, 1), b3 + hstep, voffB); PG8_STAGE(PG8_SA(1, 0), a3, voffA);
            PG8_WAIT_V(8); PG8_WAIT_L(0); PG8_BAR; PG8_MMA(1, 0, At, B0); PG8_MMA(1, 1, At, B1); PG8_BAR; PG8_SCHED;
            } else {
            PG8_LDB(B0, 0, 0); PG8_SCHED; PG8_LDA(At, 0, 0); PG8_STAGE(PG8_SA(1, 1), a1 + hstep, voffA);
            PG8_WAIT_L(8); PG8_BAR; PG8_WAIT_L(0); PG8_MMA(0, 0, At, B0); PG8_BAR; PG8_SCHED;
            PG8_LDB(B1, 0, 1); PG8_STAGE(PG8_SB(0, 0), b2, voffB);
            PG8_BAR; PG8_WAIT_L(0); PG8_MMA(0, 1, At, B1); PG8_BAR;
            PG8_LDA(At, 0, 1); PG8_STAGE(PG8_SA(0, 0), a2, voffA);
            PG8_BAR; PG8_WAIT_L(0); PG8_MMA(1, 0, At, B0); PG8_BAR; PG8_SCHED;
            PG8_STAGE(PG8_SB(0, 1), b2 + hstep, voffB);
            PG8_WAIT_V(6); PG8_BAR; PG8_MMA(1, 1, At, B1); PG8_BAR;
            PG8_LDB(B0, 1, 0); PG8_SCHED; PG8_LDA(At, 1, 0); PG8_STAGE(PG8_SA(0, 1), a2 + hstep, voffA);
            PG8_WAIT_L(8); PG8_BAR; PG8_WAIT_L(0); PG8_MMA(0, 0, At, B0); PG8_BAR; PG8_SCHED;
            PG8_LDB(B1, 1, 1); PG8_STAGE(PG8_SB(1, 0), b3, voffB);
            PG8_BAR; PG8_WAIT_L(0); PG8_MMA(0, 1, At, B1); PG8_BAR;
            PG8_LDA(At, 1, 1); PG8_STAGE(PG8_SA(1, 0), a3, voffA);
            PG8_BAR; PG8_WAIT_L(0); PG8_MMA(1, 0, At, B0); PG8_BAR; PG8_SCHED;
            PG8_STAGE(PG8_SB(1, 1), b3 + hstep, voffB);
            PG8_WAIT_V(6); PG8_BAR; PG8_MMA(1, 1, At, B1); PG8_BAR;
            }
        }
        if constexpr (ALIGN_EPI) { if (wr == 0) PG8_BAR; }
        if constexpr (!Epi::AFTER_DRAIN) { E(acc, cur, wr, wc, fr, fq); S.done(cur); }
        if (!has_next) break;
#pragma unroll
        for (int a = 0; a < 2; ++a)
#pragma unroll
            for (int b = 0; b < 2; ++b)
#pragma unroll
                for (int m = 0; m < 4; ++m)
#pragma unroll
                    for (int n = 0; n < 2; ++n) acc[a][b][m][n] = (f32x4){0.f, 0.f, 0.f, 0.f};
        cur = nxt; cA = nA; cB = nB; ++ui;
        if constexpr (ALIGN_EPI) { if (wr == 1) PG8_BAR; }
    }
    PG8_WAIT_V(0);
    if constexpr (!ALIGN_EPI) { if (wr == 0) PG8_BAR; }
    PG8_BAR;
    if constexpr (Epi::AFTER_DRAIN) { E.fused(acc, cur, wr, wc, fr, fq, lds, wid, lane); S.done(cur); }
#undef PG8_SA
#undef PG8_SB
#undef PG8_STAGE
#undef PG8_LDA
#undef PG8_LDB
#undef PG8_MMA
#undef PG8_WAIT_V
#undef PG8_WAIT_L
#undef PG8_BAR
#undef PG8_SCHED
}
}

namespace mk {
#define LAS __attribute__((address_space(3)))
#define GAS __attribute__((address_space(1)))
typedef unsigned v4u __attribute__((ext_vector_type(4)));
typedef unsigned v2u __attribute__((ext_vector_type(2)));
constexpr int NW = 8, NT = 512, LDS_BYTES = 147456, RING_BYTES = 131072;
#define LDS_WAIT() asm volatile("s_waitcnt lgkmcnt(0)" ::: "memory")
struct Args { const float* in[16]; float* out; unsigned char* ws; int ph_lo, ph_hi; };
__device__ __forceinline__ unsigned pk2(float lo, float hi) { return (unsigned)f2bf(lo) | ((unsigned)f2bf(hi) << 16); }

__device__ __forceinline__ void transpose_item(const float* W, int ld, int K, int ncols, bf16_t* WT, LAS float* scr, int item, int lane) {
    const int nblk = ncols / 32, kb = item / nblk, nb = item % nblk, k0 = 64 * kb, n0 = 32 * nb;
#pragma unroll 8
    for (int i = 0; i < 32; ++i) { const int kk = 2 * i + (lane >> 5); scr[kk * 33 + (lane & 31)] = W[(size_t)(k0 + kk) * ld + n0 + (lane & 31)]; }
    LDS_WAIT(); asm volatile("" ::: "memory");
    const int c = lane & 7;
#pragma unroll
    for (int j = 0; j < 4; ++j) { const int n = (lane >> 3) + 8 * j; const LAS float* s = scr + (8 * c) * 33 + n;
        v4u o; o.x = pk2(s[0 * 33], s[1 * 33]); o.y = pk2(s[2 * 33], s[3 * 33]); o.z = pk2(s[4 * 33], s[5 * 33]); o.w = pk2(s[6 * 33], s[7 * 33]);
        *(v4u*)(WT + (size_t)(n0 + n) * K + k0 + 8 * c) = o; }
    LDS_WAIT(); asm volatile("" ::: "memory");
}
template <bool WITH_BA>
__device__ __forceinline__ void norm_row(const float* xrow, const float* g, const float* w_in, bf16_t* orow, float* barow, int lane) {
    f32x4 v[8]; float ss = 0.f;
#pragma unroll
    for (int j = 0; j < 8; ++j) { v[j] = ((const f32x4*)xrow)[64 * j + lane]; ss += (v[j].x * v[j].x + v[j].y * v[j].y) + (v[j].z * v[j].z + v[j].w * v[j].w); }
    ss = wave_sum(ss);
    const float rstd = rsqrtf(ss * (1.f / DM) + EPS);
    float acc[16];
#pragma unroll
    for (int c = 0; c < 16; ++c) acc[c] = 0.f;
#pragma unroll
    for (int j = 0; j < 8; ++j) {
        const f32x4 gg = ((const f32x4*)g)[64 * j + lane];
        const f32x4 y = v[j] * rstd * gg;
        v2u o; o.x = pk2(y.x, y.y); o.y = pk2(y.z, y.w);
        ((v2u*)orow)[64 * j + lane] = o;
        if (WITH_BA) {
            const float* wr = w_in + (size_t)(4 * (64 * j + lane)) * INW + NPROJ;
#pragma unroll
            for (int i = 0; i < 4; ++i) {
                const float yi = (i == 0) ? y.x : (i == 1) ? y.y : (i == 2) ? y.z : y.w;
#pragma unroll
                for (int q4 = 0; q4 < 4; ++q4) { const f32x4 w4 = *(const f32x4*)(wr + (size_t)i * INW + 4 * q4);
                    acc[4 * q4] += yi * w4.x; acc[4 * q4 + 1] += yi * w4.y; acc[4 * q4 + 2] += yi * w4.z; acc[4 * q4 + 3] += yi * w4.w; }
            }
        }
    }
    if (WITH_BA) {
        float r = 0.f;
#pragma unroll
        for (int c = 0; c < 16; ++c) { const float s = wave_sum(acc[c]); if (lane == c) r = s; }
        if (lane < 16) barow[lane] = r;
    }
}
__device__ __forceinline__ void wqk_item(const float* Wq, const float* SK, bf16_t* Wqk, LAS float* lds, int item, int tid) {
    const int cbk = item >> 5, d0 = (item & 31) * 64, cb = cbk * 128, h = cbk >> 1, half = cbk & 1;
    LAS float* At = lds; LAS float* Bt = lds + 128 * 68;
    const float* skb = SK + ((size_t)(half * 8 + h) * 128) * 128;
#pragma unroll
    for (int i = 0; i < 4; ++i) { const int idx = tid + 512 * i, d = idx >> 5, k4 = idx & 31;
        const f32x4 w = *(const f32x4*)(Wq + (size_t)(d0 + d) * DM + cb + 4 * k4);
        At[(4 * k4 + 0) * 68 + d] = w.x; At[(4 * k4 + 1) * 68 + d] = w.y; At[(4 * k4 + 2) * 68 + d] = w.z; At[(4 * k4 + 3) * 68 + d] = w.w; }
#pragma unroll
    for (int i = 0; i < 8; ++i) { const int idx = tid + 512 * i, n = idx >> 5, k4 = idx & 31;
        const f32x4 w = *(const f32x4*)(skb + (size_t)n * 128 + 4 * k4);
        Bt[(4 * k4 + 0) * 132 + n] = w.x; Bt[(4 * k4 + 1) * 132 + n] = w.y; Bt[(4 * k4 + 2) * 132 + n] = w.z; Bt[(4 * k4 + 3) * 132 + n] = w.w; }
    __syncthreads();
    const int dy = tid >> 5, nx = tid & 31;
    float acc[4][4];
#pragma unroll
    for (int i = 0; i < 4; ++i)
#pragma unroll
        for (int j = 0; j < 4; ++j) acc[i][j] = 0.f;
#pragma unroll 4
    for (int kk = 0; kk < 128; ++kk) {
        const f32x4 a = *(const LAS f32x4*)(At + kk * 68 + 4 * dy), b = *(const LAS f32x4*)(Bt + kk * 132 + 4 * nx);
        acc[0][0] += a.x * b.x; acc[0][1] += a.x * b.y; acc[0][2] += a.x * b.z; acc[0][3] += a.x * b.w;
        acc[1][0] += a.y * b.x; acc[1][1] += a.y * b.y; acc[1][2] += a.y * b.z; acc[1][3] += a.y * b.w;
        acc[2][0] += a.z * b.x; acc[2][1] += a.z * b.y; acc[2][2] += a.z * b.z; acc[2][3] += a.z * b.w;
        acc[3][0] += a.w * b.x; acc[3][1] += a.w * b.y; acc[3][2] += a.w * b.z; acc[3][3] += a.w * b.w;
    }
#pragma unroll
    for (int j = 0; j < 4; ++j) { v2u o; o.x = pk2(acc[0][j], acc[1][j]); o.y = pk2(acc[2][j], acc[3][j]);
        *(v2u*)(Wqk + (size_t)(cb + 4 * nx + j) * DM + d0 + 4 * dy) = o; }
    __syncthreads();
}

__device__ __forceinline__ void table_row(const float* src, unsigned* dst, float* inv_scale, int lane) {
    f32x4 v[8]; float mx = 0.f;
#pragma unroll
    for (int j = 0; j < 8; ++j) { v[j] = ((const f32x4*)src)[64 * j + lane];
        mx = fmaxf(mx, fmaxf(fmaxf(fabsf(v[j].x), fabsf(v[j].y)), fmaxf(fabsf(v[j].z), fabsf(v[j].w)))); }
#pragma unroll
    for (int o = 1; o < 64; o <<= 1) mx = fmaxf(mx, __shfl_xor(mx, o));
    const float sc = mx > 0.f ? 128.f / mx : 1.f;
#pragma unroll
    for (int j = 0; j < 8; ++j) { int pk = __builtin_amdgcn_cvt_pk_fp8_f32(v[j].x * sc, v[j].y * sc, 0, false);
        pk = __builtin_amdgcn_cvt_pk_fp8_f32(v[j].z * sc, v[j].w * sc, pk, true); dst[64 * j + lane] = (unsigned)pk; }
    if (lane == 0) *inv_scale = mx > 0.f ? mx * (1.f / 128.f) : 1.f;
}
#ifndef PEER_FAST_REDUCE
#define PEER_FAST_REDUCE 1
#endif
typedef float f32x2 __attribute__((ext_vector_type(2)));
__device__ __forceinline__ float dpp_ror_add(float t, int) { return t; }
#define DPP_ROR_ADD(t, n) ((t) + __uint_as_float(__builtin_amdgcn_update_dpp(0u, __float_as_uint(t), 0x120 + (n), 0xf, 0xf, false)))
__device__ __forceinline__ float dot_row(const v4u& a, const v4u& b, const float (&xv)[32]) {
    float p = 0.f;
#pragma unroll
    for (int w = 0; w < 4; ++w) { const unsigned d = (w == 0) ? a.x : (w == 1) ? a.y : (w == 2) ? a.z : a.w;
        const f32x2 lo = __builtin_amdgcn_cvt_pk_f32_fp8(d, false), hi = __builtin_amdgcn_cvt_pk_f32_fp8(d, true);
        p += lo.x * xv[4 * w] + lo.y * xv[4 * w + 1] + hi.x * xv[4 * w + 2] + hi.y * xv[4 * w + 3]; }
#pragma unroll
    for (int w = 0; w < 4; ++w) { const unsigned d = (w == 0) ? b.x : (w == 1) ? b.y : (w == 2) ? b.z : b.w;
        const f32x2 lo = __builtin_amdgcn_cvt_pk_f32_fp8(d, false), hi = __builtin_amdgcn_cvt_pk_f32_fp8(d, true);
        p += lo.x * xv[16 + 4 * w] + lo.y * xv[16 + 4 * w + 1] + hi.x * xv[16 + 4 * w + 2] + hi.y * xv[16 + 4 * w + 3]; }
    return p;
}
__device__ __forceinline__ void axpy_row(const v4u& a, const v4u& b, float wgt, float (&y)[32]) {
#pragma unroll
    for (int w = 0; w < 4; ++w) { const unsigned d = (w == 0) ? a.x : (w == 1) ? a.y : (w == 2) ? a.z : a.w;
        const f32x2 lo = __builtin_amdgcn_cvt_pk_f32_fp8(d, false), hi = __builtin_amdgcn_cvt_pk_f32_fp8(d, true);
        y[4 * w] += wgt * lo.x; y[4 * w + 1] += wgt * lo.y; y[4 * w + 2] += wgt * hi.x; y[4 * w + 3] += wgt * hi.y; }
#pragma unroll
    for (int w = 0; w < 4; ++w) { const unsigned d = (w == 0) ? b.x : (w == 1) ? b.y : (w == 2) ? b.z : b.w;
        const f32x2 lo = __builtin_amdgcn_cvt_pk_f32_fp8(d, false), hi = __builtin_amdgcn_cvt_pk_f32_fp8(d, true);
        y[16 + 4 * w] += wgt * lo.x; y[16 + 4 * w + 1] += wgt * lo.y; y[16 + 4 * w + 2] += wgt * hi.x; y[16 + 4 * w + 3] += wgt * hi.y; }
}
#define PEER_LOAD(DST, TAB, b) do { _Pragma("unroll") for (int r_ = 0; r_ < 4; ++r_) { const unsigned char* rp_ = (TAB) + (size_t)(unsigned)__builtin_amdgcn_readfirstlane(se[4 * (b) + r_]) * 2048 + 16 * lane; \
        DST[r_][0] = *(const v4u*)rp_; DST[r_][1] = *(const v4u*)(rp_ + 1024); } } while (0)
__device__ __forceinline__ void peer_token(int t, const float* scores, const bf16_t* hn, const float* hbuf, const unsigned char* U8, const unsigned char* V8,
                                           const float* inv_su, const float* inv_sv, const float* gfin, float* out,
                                           LAS int* se, LAS float* sa, LAS float* sb, int lane) {
#pragma unroll 1
    for (int hd = 0; hd < 8; ++hd) {
        int e; float g;
        topk_head(scores + (size_t)t * DM + hd * 256, lane, e, g);
        if (lane < 16) { se[hd * 16 + lane] = e; sa[hd * 16 + lane] = inv_su[e]; sb[hd * 16 + lane] = g * inv_sv[e]; }
    }
    float xv[32], y[32];
#pragma unroll
    for (int j = 0; j < 2; ++j) {
        const v4u h0 = *(const v4u*)(hn + (size_t)t * DM + 1024 * j + 16 * lane), h1 = *(const v4u*)(hn + (size_t)t * DM + 1024 * j + 16 * lane + 8);
#pragma unroll
        for (int w = 0; w < 4; ++w) { const unsigned d0 = (w == 0) ? h0.x : (w == 1) ? h0.y : (w == 2) ? h0.z : h0.w, d1 = (w == 0) ? h1.x : (w == 1) ? h1.y : (w == 2) ? h1.z : h1.w;
            xv[16 * j + 2 * w] = __uint_as_float(d0 << 16); xv[16 * j + 2 * w + 1] = __uint_as_float(d0 & 0xffff0000u);
            xv[16 * j + 8 + 2 * w] = __uint_as_float(d1 << 16); xv[16 * j + 8 + 2 * w + 1] = __uint_as_float(d1 & 0xffff0000u); }
    }
#pragma unroll
    for (int i = 0; i < 32; ++i) y[i] = 0.f;
    v4u U[4][2], V[4][2];
    PEER_LOAD(U, U8, 0);
#pragma unroll 1
    for (int b = 0; b < 32; ++b) {
        PEER_LOAD(V, V8, b);
        float pr[4];
#pragma unroll
        for (int r = 0; r < 4; ++r) pr[r] = dot_row(U[r][0], U[r][1], xv);
        if (b + 1 < 32) PEER_LOAD(U, U8, b + 1);
        float wr_[4];
#if PEER_FAST_REDUCE
        float q2[2];
#pragma unroll
        for (int r = 0; r < 2; ++r) { auto sw = __builtin_amdgcn_permlane32_swap(__float_as_uint(pr[r]), __float_as_uint(pr[r + 2]), false, false); q2[r] = __uint_as_float(sw[0]) + __uint_as_float(sw[1]); }
        float tv;
        { auto sw = __builtin_amdgcn_permlane16_swap(__float_as_uint(q2[0]), __float_as_uint(q2[1]), false, false); tv = __uint_as_float(sw[0]) + __uint_as_float(sw[1]); }
        tv = DPP_ROR_ADD(tv, 8); tv = DPP_ROR_ADD(tv, 4); tv = DPP_ROR_ADD(tv, 2); tv = DPP_ROR_ADD(tv, 1);
        const int k = 4 * b + (lane >> 4);
        const float wc = gelu_erf(tv * sa[k]) * sb[k];
#pragma unroll
        for (int r = 0; r < 4; ++r) wr_[r] = __uint_as_float(__builtin_amdgcn_readlane(__float_as_uint(wc), 16 * r));
#else
#pragma unroll
        for (int r = 0; r < 4; ++r) { const float tv = wave_sum(pr[r]); wr_[r] = gelu_erf(tv * sa[4 * b + r]) * sb[4 * b + r]; }
#endif
#pragma unroll
        for (int r = 0; r < 4; ++r) axpy_row(V[r][0], V[r][1], wr_[r], y);
    }
    float ss = 0.f;
#pragma unroll
    for (int j = 0; j < 2; ++j)
#pragma unroll
        for (int w = 0; w < 4; ++w) { const f32x4 hv = *(const f32x4*)(hbuf + (size_t)t * DM + 1024 * j + 16 * lane + 4 * w);
            y[16 * j + 4 * w] += hv.x; y[16 * j + 4 * w + 1] += hv.y; y[16 * j + 4 * w + 2] += hv.z; y[16 * j + 4 * w + 3] += hv.w;
            ss += (y[16 * j + 4 * w] * y[16 * j + 4 * w] + y[16 * j + 4 * w + 1] * y[16 * j + 4 * w + 1]) + (y[16 * j + 4 * w + 2] * y[16 * j + 4 * w + 2] + y[16 * j + 4 * w + 3] * y[16 * j + 4 * w + 3]); }
    ss = wave_sum(ss);
    const float rstd = rsqrtf(ss * (1.f / DM) + EPS);
#pragma unroll
    for (int j = 0; j < 2; ++j)
#pragma unroll
        for (int w = 0; w < 4; ++w) { const f32x4 gg = *(const f32x4*)(gfin + 1024 * j + 16 * lane + 4 * w);
            f32x4 o; o.x = y[16 * j + 4 * w] * rstd * gg.x; o.y = y[16 * j + 4 * w + 1] * rstd * gg.y; o.z = y[16 * j + 4 * w + 2] * rstd * gg.z; o.w = y[16 * j + 4 * w + 3] * rstd * gg.w;
            *(f32x4*)(out + (size_t)t * DM + 1024 * j + 16 * lane + 4 * w) = o; }
}
typedef short bf16x8 __attribute__((ext_vector_type(8)));
__device__ __forceinline__ int pos32(int x) { const int g = x & ~31, l = x & 31; return g + 8 * ((l & 15) >> 2) + 4 * (l >> 4) + (l & 3); }
constexpr size_t PB_H_QG = 0, PB_H_KDT = 32 * MiB, PB_H_A = 64 * MiB;
constexpr size_t PB_G_QS = 80 * MiB, PB_G_KT = 96 * MiB;
constexpr size_t PB_G_W = 112 * MiB, PB_G_A = 144 * MiB, PB_G_U = 160 * MiB;
constexpr int SC_QG = 0, SC_WV = 17408, SC_KDT = 34816, SC_A = 53248, SC_BUF = 62464, SC_VEC = 2 * SC_BUF, SC_ROWSUM = SC_VEC + 2048;

__device__ __forceinline__ bf16x8 pack_frag(const f32x4& x0, const f32x4& x1) {
    v4u w; w.x = pk2(x0.x, x0.y); w.y = pk2(x0.z, x0.w); w.z = pk2(x1.x, x1.y); w.w = pk2(x1.z, x1.w);
    return __builtin_bit_cast(bf16x8, w);
}
#define MFMA16(a, b, c) __builtin_amdgcn_mfma_f32_16x16x32_bf16((a), (b), (c), 0, 0, 0)

__device__ __forceinline__ void hgrn_prep_item(int item, const bf16_t* proj, const float* lb_logits, unsigned char* pb, float* vecs, LAS unsigned char* lds, int tid) {
    const int c = item & 127, sq = item >> 7, b = sq >> 3, h = sq & 7, t0 = b * SEQ + c * 64;
    const int d = tid & 127, seg = tid >> 7, lane = tid & 63, wave = tid >> 6;
    LAS bf16_t* QGl = (LAS bf16_t*)lds; LAS bf16_t* KGl = (LAS bf16_t*)(lds + 17408); LAS float* segsum = (LAS float*)(lds + 34816);
    bf16_t* gQG = (bf16_t*)(pb + PB_H_QG) + (size_t)item * 8192;
    bf16_t* gKDT = (bf16_t*)(pb + PB_H_KDT) + (size_t)item * 8192;
    bf16_t* gA = (bf16_t*)(pb + PB_H_A) + (size_t)item * 4096;
    float* gvec = vecs + (size_t)item * 256;
    const float l0 = lb_logits[h * 128 + d], l1 = lb_logits[1024 + h * 128 + d];
    const float lb = 1.f / (1.f + __expf(l1 - l0));
    float lf[16], qv[16], kv[16];
#pragma unroll
    for (int i = 0; i < 16; ++i) {
        const bf16_t* pr = proj + (size_t)(t0 + 16 * seg + i) * NPROJ + h * 128 + d;
        const float z = bf2f(pr[C_AF]); qv[i] = bf2f(pr[C_AQ]);
        const float f = lb + (1.f - lb) * sigmoidf_(z);
        lf[i] = __logf(f); kv[i] = 1.f - f;
    }
    float run = 0.f;
#pragma unroll
    for (int i = 0; i < 16; ++i) { run += lf[i]; lf[i] = run; }
    segsum[seg * 128 + d] = run;
    __syncthreads();
    float off = 0.f, bl = 0.f;
#pragma unroll
    for (int s = 0; s < 4; ++s) { const float v = segsum[s * 128 + d]; bl += v; if (s < seg) off += v; }
    const int pd = pos32(d);
    float kd[16];
#pragma unroll
    for (int i = 0; i < 16; ++i) {
        const float bc = lf[i] + off; const int tl = 16 * seg + i;
        const float qg = qv[i] * __expf(bc), kg = kv[i] * __expf(-bc);
        kd[i] = kv[i] * __expf(bl - bc);
        const bf16_t qb = f2bf(qg);
        QGl[tl * 136 + d] = qb; KGl[tl * 136 + d] = f2bf(kg);
        gQG[tl * 128 + pd] = qb;
    }
#pragma unroll
    for (int ii = 0; ii < 4; ++ii) { v2u o; o.x = pk2(kd[4 * ii], kd[4 * ii + 1]); o.y = pk2(kd[4 * ii + 2], kd[4 * ii + 3]);
        *(v2u*)(gKDT + d * 64 + 32 * (seg >> 1) + 8 * ii + 4 * (seg & 1)) = o; }
    if (seg == 0) gvec[128 + d] = __expf(bl);
    __syncthreads();
    const int n = lane & 15, q = lane >> 4;
#pragma unroll
    for (int ti = 0; ti < 2; ++ti) {
        const int id = wave + 8 * ti, mt = id >> 2, ns = id & 3;
        f32x4 acc = {0.f, 0.f, 0.f, 0.f};
        if (ns <= mt) {
#pragma unroll
            for (int s4 = 0; s4 < 4; ++s4) {
                const bf16x8 a = *(const LAS bf16x8*)(QGl + (16 * mt + n) * 136 + 32 * s4 + 8 * q);
                const bf16x8 bb = *(const LAS bf16x8*)(KGl + (16 * ns + n) * 136 + 32 * s4 + 8 * q);
                acc = MFMA16(a, bb, acc);
            }
        }
        const int s = 16 * ns + n, ps = pos32(s);
#pragma unroll
        for (int r = 0; r < 4; ++r) { const int t = 16 * mt + 4 * q + r; const float v = (r == 0) ? acc.x : (r == 1) ? acc.y : (r == 2) ? acc.z : acc.w;
            gA[t * 64 + ps] = f2bf((s <= t) ? v : 0.f); }
    }
    __syncthreads();
}

constexpr int GP_QF = 0, GP_KF = 33024, GP_N = 0, GP_QB = 66048, GP_KB = 83456, GP_VB = 100864, GP_PART = 135680, GP_SB = 137728;
__device__ __forceinline__ void gdn_prep_item(int item, const bf16_t* proj, const float* ba, const float* conv_w, const float* A_log, const float* dt_bias,
                                              unsigned char* pb, float* vecs, LAS unsigned char* lds, int tid) {
    const int c = item & 127, bq = item >> 7, b = bq >> 2, qh = bq & 3, t0 = b * SEQ + c * 64;
    const int lane = tid & 63, wave = tid >> 6;
    LAS float* QF = (LAS float*)(lds + GP_QF); LAS float* KF = (LAS float*)(lds + GP_KF);
    LAS bf16_t* QB = (LAS bf16_t*)(lds + GP_QB); LAS bf16_t* KB = (LAS bf16_t*)(lds + GP_KB); LAS bf16_t* VB = (LAS bf16_t*)(lds + GP_VB);
    LAS float* PART = (LAS float*)(lds + GP_PART); LAS float* SBETA = (LAS float*)(lds + GP_SB); LAS float* SGC = SBETA + 128;
    LAS float* NM = (LAS float*)(lds + GP_N);
    {
        int col, wch; const int dd = tid & 127;
        if (tid < 128) { col = C_BQ + qh * 128 + dd; wch = qh * 128 + dd; }
        else if (tid < 256) { col = C_BK + qh * 128 + dd; wch = 512 + qh * 128 + dd; }
        else { const int vh = 2 * qh + ((tid - 256) >> 7); col = C_BV + vh * 128 + dd; wch = 1024 + vh * 128 + dd; }
        const float w0 = conv_w[wch], w1 = conv_w[2048 + wch], w2 = conv_w[4096 + wch], w3 = conv_w[6144 + wch];
        float h0 = 0.f, h1 = 0.f, h2 = 0.f;
        const bf16_t* pr = proj + (size_t)t0 * NPROJ + col;
        if (c > 0) { h0 = bf2f(pr[-3 * NPROJ]); h1 = bf2f(pr[-2 * NPROJ]); h2 = bf2f(pr[-1 * NPROJ]); }
#pragma unroll 8
        for (int t = 0; t < 64; ++t) {
            const float xx = bf2f(pr[(size_t)t * NPROJ]);
            const float yv = siluf_(w0 * h0 + w1 * h1 + w2 * h2 + w3 * xx);
            h0 = h1; h1 = h2; h2 = xx;
            if (tid < 128) QF[t * 129 + dd] = yv;
            else if (tid < 256) KF[t * 129 + dd] = yv;
            else VB[((tid - 256) >> 7) * 8704 + t * 136 + dd] = f2bf(yv);
        }
    }
    __syncthreads();
    {
        const int t = tid & 63, part = tid >> 6, which = part >> 2, sub = part & 3;
        const LAS float* src = (which ? KF : QF) + t * 129 + 32 * sub;
        float s = 0.f;
#pragma unroll
        for (int i = 0; i < 32; ++i) s += src[i] * src[i];
        PART[(which * 4 + sub) * 64 + t] = s;
    }
    if (wave < 2) {
        const int vh = 2 * qh + wave;
        const float ax = ba[(size_t)(t0 + lane) * 16 + 8 + vh] + dt_bias[vh];
        const float sp = ax > 20.f ? ax : log1pf(__expf(ax));
        float gc = -__expf(A_log[vh]) * sp;
#pragma unroll
        for (int o = 1; o < 64; o <<= 1) { const float up = __shfl_up(gc, o); if (lane >= o) gc += up; }
        const float gl = __shfl(gc, 63);
        const float beta = sigmoidf_(ba[(size_t)(t0 + lane) * 16 + vh]);
        SBETA[wave * 64 + lane] = beta; SGC[wave * 64 + lane] = gc;
        float* gvec = vecs + ((size_t)(16 + b * 8 + vh) * 128 + c) * 256;
        gvec[lane] = __expf(gc); gvec[64 + lane] = __expf(gl - gc);
        const float dl = __expf(gl); gvec[128 + lane] = dl; gvec[192 + lane] = dl;
    }
    __syncthreads();
    {
        const int d = tid & 127, seg = tid >> 7, pd = pos32(d);
        bf16_t* gQS = (bf16_t*)(pb + PB_G_QS) + (size_t)item * 8192;
        bf16_t* gKT = (bf16_t*)(pb + PB_G_KT) + (size_t)item * 8192;
        float kk[16];
#pragma unroll
        for (int i = 0; i < 16; ++i) {
            const int tl = 16 * seg + i;
            const float sq = PART[0 * 64 + tl] + PART[1 * 64 + tl] + PART[2 * 64 + tl] + PART[3 * 64 + tl];
            const float sk = PART[4 * 64 + tl] + PART[5 * 64 + tl] + PART[6 * 64 + tl] + PART[7 * 64 + tl];
            const bf16_t qb = f2bf(QF[tl * 129 + d] * rsqrtf(sq + EPS) * 0.08838834764831845f);
            const bf16_t kb = f2bf(KF[tl * 129 + d] * rsqrtf(sk + EPS));
            QB[tl * 136 + d] = qb; KB[tl * 136 + d] = kb; gQS[tl * 128 + pd] = qb; kk[i] = bf2f(kb);
        }
#pragma unroll
        for (int ii = 0; ii < 4; ++ii) { v2u o; o.x = pk2(kk[4 * ii], kk[4 * ii + 1]); o.y = pk2(kk[4 * ii + 2], kk[4 * ii + 3]);
            *(v2u*)(gKT + d * 64 + 32 * (seg >> 1) + 8 * ii + 4 * (seg & 1)) = o; }
    }
    __syncthreads();
    {
        const int n = lane & 15, q = lane >> 4;
#pragma unroll
        for (int ti = 0; ti < 2; ++ti) {
            const int id = 2 * wave + ti, mt = id >> 2, ns = id & 3;
            f32x4 akk = {0.f, 0.f, 0.f, 0.f}, aqk = {0.f, 0.f, 0.f, 0.f};
            if (ns <= mt) {
#pragma unroll
                for (int s4 = 0; s4 < 4; ++s4) {
                    const bf16x8 kb_ = *(const LAS bf16x8*)(KB + (16 * ns + n) * 136 + 32 * s4 + 8 * q);
                    const bf16x8 ka_ = *(const LAS bf16x8*)(KB + (16 * mt + n) * 136 + 32 * s4 + 8 * q);
                    const bf16x8 qa_ = *(const LAS bf16x8*)(QB + (16 * mt + n) * 136 + 32 * s4 + 8 * q);
                    akk = MFMA16(ka_, kb_, akk); aqk = MFMA16(qa_, kb_, aqk);
                }
            }
            const int s = 16 * ns + n, ps = pos32(s);
#pragma unroll
            for (int vl = 0; vl < 2; ++vl) {
                bf16_t* gA = (bf16_t*)(pb + PB_G_A) + ((size_t)((b * 8 + 2 * qh + vl) * 128 + c)) * 4096;
                const float gcs = SGC[vl * 64 + s];
#pragma unroll
                for (int r = 0; r < 4; ++r) {
                    const int t = 16 * mt + 4 * q + r;
                    const float vk = (r == 0) ? akk.x : (r == 1) ? akk.y : (r == 2) ? akk.z : akk.w;
                    const float vq = (r == 0) ? aqk.x : (r == 1) ? aqk.y : (r == 2) ? aqk.z : aqk.w;
                    const float ex = (s <= t) ? __expf(SGC[vl * 64 + t] - gcs) : 0.f;
                    NM[vl * 4096 + t * 64 + s] = (s < t) ? SBETA[vl * 64 + t] * vk * ex : 0.f;
                    gA[t * 64 + ps] = f2bf((s <= t) ? vq * ex : 0.f);
                }
            }
        }
    }
    __syncthreads();
    {
        const int vl = tid >> 8, colx = tid & 255;
        float x[64];
        if (colx < 128) {
#pragma unroll
            for (int t = 0; t < 64; ++t) x[t] = SBETA[vl * 64 + t] * bf2f(VB[vl * 8704 + t * 136 + colx]);
        } else {
#pragma unroll
            for (int t = 0; t < 64; ++t) x[t] = SBETA[vl * 64 + t] * __expf(SGC[vl * 64 + t]) * bf2f(KB[t * 136 + colx - 128]);
        }
        __syncthreads();
        const LAS float* Nv = NM + vl * 4096;
#pragma unroll
        for (int t = 1; t < 64; ++t) {
            float acc = x[t];
#pragma unroll
            for (int s4 = 0; s4 < (t + 3) / 4; ++s4) {
                const f32x4 nn = *(const LAS f32x4*)(Nv + t * 64 + 4 * s4);
                acc -= nn.x * x[4 * s4]; if (4 * s4 + 1 < t) acc -= nn.y * x[4 * s4 + 1]; if (4 * s4 + 2 < t) acc -= nn.z * x[4 * s4 + 2]; if (4 * s4 + 3 < t) acc -= nn.w * x[4 * s4 + 3];
            }
            x[t] = acc;
        }
        if (colx < 128) {
            bf16_t* gU = (bf16_t*)(pb + PB_G_U) + ((size_t)((b * 8 + 2 * qh + vl) * 128 + c)) * 8192;
            const int sl = colx >> 4, n = colx & 15;
#pragma unroll
            for (int mt = 0; mt < 4; ++mt)
#pragma unroll
                for (int q = 0; q < 4; ++q) { v2u o; o.x = pk2(x[16 * mt + 4 * q], x[16 * mt + 4 * q + 1]); o.y = pk2(x[16 * mt + 4 * q + 2], x[16 * mt + 4 * q + 3]);
                    *(v2u*)(gU + ((size_t)((sl * 4 + mt) * 64 + q * 16 + n)) * 4) = o; }
        } else {
            LAS bf16_t* WS = (LAS bf16_t*)(lds + GP_QB) + vl * 8704;
            const int pd = pos32(colx - 128);
#pragma unroll
            for (int t = 0; t < 64; ++t) WS[t * 136 + pd] = f2bf(-x[t]);
        }
    }
    __syncthreads();
    {
#pragma unroll
        for (int i = 0; i < 4; ++i) { const int p = tid + 512 * i, vl = p >> 10, row = (p >> 4) & 63, c16 = p & 15;
            bf16_t* gW = (bf16_t*)(pb + PB_G_W) + ((size_t)((b * 8 + 2 * qh + vl) * 128 + c)) * 8192;
            *(v4u*)(gW + row * 128 + c16 * 8) = *(const LAS v4u*)(lds + GP_QB + vl * 17408 + row * 272 + c16 * 16); }
    }
    __syncthreads();
}

struct ScanSrc { const unsigned char* qg; const unsigned char* wv; const unsigned char* kdt; const unsigned char* a; const float* vec; size_t wv_row; };
__device__ __forceinline__ void scan_issue(const ScanSrc& S, int tid, v4u (&G)[8]) {
#pragma unroll
    for (int i = 0; i < 2; ++i) { const int p = tid + 512 * i, row = p >> 4, c16 = p & 15;
        G[i] = *(const v4u*)(S.qg + row * 256 + c16 * 16);
        G[2 + i] = *(const v4u*)(S.wv + (size_t)row * S.wv_row + c16 * 16); }
#pragma unroll
    for (int i = 0; i < 2; ++i) { const int p = tid + 512 * i, row = p >> 3, c16 = p & 7; G[4 + i] = *(const v4u*)(S.kdt + row * 128 + c16 * 16); }
    { const int row = tid >> 3, c16 = tid & 7; G[6] = *(const v4u*)(S.a + row * 128 + c16 * 16); }
    if (tid < 64) G[7] = *(const v4u*)(S.vec + tid * 4);
}
__device__ __forceinline__ void scan_write(LAS unsigned char* buf, LAS unsigned char* vecb, int tid, const v4u (&G)[8]) {
#pragma unroll
    for (int i = 0; i < 2; ++i) { const int p = tid + 512 * i, row = p >> 4, c16 = p & 15;
        *(LAS v4u*)(buf + SC_QG + row * 272 + c16 * 16) = G[i]; *(LAS v4u*)(buf + SC_WV + row * 272 + c16 * 16) = G[2 + i]; }
#pragma unroll
    for (int i = 0; i < 2; ++i) { const int p = tid + 512 * i, row = p >> 3, c16 = p & 7; *(LAS v4u*)(buf + SC_KDT + row * 144 + c16 * 16) = G[4 + i]; }
    { const int row = tid >> 3, c16 = tid & 7; *(LAS v4u*)(buf + SC_A + row * 144 + c16 * 16) = G[6]; }
    if (tid < 64) *(LAS v4u*)(vecb + tid * 16) = G[7];
}
__device__ __forceinline__ void scan_block(int sq, const bf16_t* proj, const unsigned char* pb, const float* vecs, const float* hgrn_g, const float* gdn_g,
                                           bf16_t* mix, LAS unsigned char* lds, int tid) {
    const bool gdn = sq >= 16;
    const int b = (sq & 15) >> 3, hh = sq & 7, lane = tid & 63, sl = __builtin_amdgcn_readfirstlane(tid >> 6), n = lane & 15, q = lane >> 4;
    const unsigned char* bQG; const unsigned char* bWV; const unsigned char* bKDT; const unsigned char* bA; const unsigned char* bU = nullptr;
    size_t wv_row, wv_chunk; int gate_col, mix_col; const float* gain;
    if (!gdn) {
        const size_t s0 = (size_t)(b * 8 + hh) * 128;
        bQG = pb + PB_H_QG + s0 * 16384; bKDT = pb + PB_H_KDT + s0 * 16384; bA = pb + PB_H_A + s0 * 8192;
        bWV = (const unsigned char*)(proj + (size_t)(b * SEQ) * NPROJ + C_AI + hh * 128); wv_row = (size_t)NPROJ * 2; wv_chunk = (size_t)64 * NPROJ * 2;
        gate_col = C_AG + hh * 128; mix_col = hh * 128; gain = hgrn_g;
    } else {
        const size_t s0 = (size_t)(b * 8 + hh) * 128, q0 = (size_t)(b * 4 + (hh >> 1)) * 128;
        bQG = pb + PB_G_QS + q0 * 16384; bKDT = pb + PB_G_KT + q0 * 16384; bA = pb + PB_G_A + s0 * 8192;
        bWV = pb + PB_G_W + s0 * 16384; wv_row = 256; wv_chunk = 16384; bU = pb + PB_G_U + s0 * 16384;
        gate_col = C_BZ + hh * 128; mix_col = 1024 + hh * 128; gain = gdn_g;
    }
    const float* bvec = vecs + (size_t)sq * 128 * 256;
    const float gn = gain[16 * sl + n];
    LAS float* rowsum = (LAS float*)(lds + SC_ROWSUM);
    f32x4 S[8];
#pragma unroll
    for (int m = 0; m < 8; ++m) S[m] = (f32x4){0.f, 0.f, 0.f, 0.f};
    v4u G[8];
    {
        ScanSrc src{bQG, bWV, bKDT, bA, bvec, wv_row};
        scan_issue(src, tid, G);
        scan_write(lds, lds + SC_VEC, tid, G);
        if (tid < 192) rowsum[tid] = 0.f;
    }
    __syncthreads();
    for (int c = 0; c < 128; ++c) {
        const int cur = c & 1;
        LAS unsigned char* buf = lds + cur * SC_BUF;
        const LAS float* vec = (const LAS float*)(lds + SC_VEC + cur * 1024);
        const int t0 = b * SEQ + c * 64;
        if (c + 1 < 128) { ScanSrc src{bQG + (size_t)(c + 1) * 16384, bWV + (size_t)(c + 1) * wv_chunk, bKDT + (size_t)(c + 1) * 16384, bA + (size_t)(c + 1) * 8192, bvec + (size_t)(c + 1) * 256, wv_row};
            scan_issue(src, tid, G); }
        float gatev[16];
#pragma unroll
        for (int mt = 0; mt < 4; ++mt)
#pragma unroll
            for (int r = 0; r < 4; ++r) gatev[4 * mt + r] = bf2f(proj[(size_t)(t0 + 16 * mt + 4 * q + r) * NPROJ + gate_col + 16 * sl + n]);
        bf16x8 Sf[4];
#pragma unroll
        for (int s = 0; s < 4; ++s) Sf[s] = pack_frag(S[2 * s], S[2 * s + 1]);
        f32x4 O[4], VN[4];
        bf16x8 VNf[2], VNSf[2];
        if (gdn) {
            const unsigned char* up = bU + (size_t)c * 16384 + (size_t)(sl * 4) * 512 + lane * 8;
#pragma unroll
            for (int mt = 0; mt < 4; ++mt) { const v2u uu = *(const v2u*)(up + mt * 512);
                VN[mt] = (f32x4){__uint_as_float(uu.x << 16), __uint_as_float(uu.x & 0xffff0000u), __uint_as_float(uu.y << 16), __uint_as_float(uu.y & 0xffff0000u)}; }
#pragma unroll
            for (int mt = 0; mt < 4; ++mt)
#pragma unroll
                for (int s = 0; s < 4; ++s) { const bf16x8 a = *(const LAS bf16x8*)(buf + SC_WV + (16 * mt + n) * 272 + (32 * s + 8 * q) * 2); VN[mt] = MFMA16(a, Sf[s], VN[mt]); }
#pragma unroll
            for (int s2 = 0; s2 < 2; ++s2) VNf[s2] = pack_frag(VN[2 * s2], VN[2 * s2 + 1]);
#pragma unroll
            for (int s2 = 0; s2 < 2; ++s2) { const f32x4 e0 = *(const LAS f32x4*)(vec + 64 + 16 * (2 * s2) + 4 * q), e1 = *(const LAS f32x4*)(vec + 64 + 16 * (2 * s2 + 1) + 4 * q);
                VNSf[s2] = pack_frag(VN[2 * s2] * e0, VN[2 * s2 + 1] * e1); }
        } else {
#pragma unroll
            for (int s2 = 0; s2 < 2; ++s2) { unsigned w[4];
#pragma unroll
                for (int jj = 0; jj < 4; ++jj) { const int ja = 2 * jj, jb = 2 * jj + 1;
                    const int ta = 32 * s2 + ((ja < 4) ? 4 * q + ja : 16 + 4 * q + ja - 4), tb = 32 * s2 + ((jb < 4) ? 4 * q + jb : 16 + 4 * q + jb - 4);
                    const unsigned lo = *(const LAS bf16_t*)(buf + SC_WV + ta * 272 + (16 * sl + n) * 2), hi = *(const LAS bf16_t*)(buf + SC_WV + tb * 272 + (16 * sl + n) * 2);
                    w[jj] = lo | (hi << 16); }
                v4u ww; ww.x = w[0]; ww.y = w[1]; ww.z = w[2]; ww.w = w[3];
                VNf[s2] = __builtin_bit_cast(bf16x8, ww); VNSf[s2] = VNf[s2]; }
        }
#pragma unroll
        for (int mt = 0; mt < 4; ++mt) {
            O[mt] = (f32x4){0.f, 0.f, 0.f, 0.f};
#pragma unroll
            for (int s = 0; s < 4; ++s) { const bf16x8 a = *(const LAS bf16x8*)(buf + SC_QG + (16 * mt + n) * 272 + (32 * s + 8 * q) * 2); O[mt] = MFMA16(a, Sf[s], O[mt]); }
            if (gdn) O[mt] = O[mt] * *(const LAS f32x4*)(vec + 16 * mt + 4 * q);
#pragma unroll
            for (int s2 = 0; s2 < 2; ++s2) { const bf16x8 a = *(const LAS bf16x8*)(buf + SC_A + (16 * mt + n) * 144 + (32 * s2 + 8 * q) * 2); O[mt] = MFMA16(a, VNf[s2], O[mt]); }
        }
#pragma unroll
        for (int m = 0; m < 8; ++m) {
            S[m] = S[m] * *(const LAS f32x4*)(vec + 128 + 16 * m + 4 * q);
#pragma unroll
            for (int s2 = 0; s2 < 2; ++s2) { const bf16x8 a = *(const LAS bf16x8*)(buf + SC_KDT + (16 * m + n) * 144 + (32 * s2 + 8 * q) * 2); S[m] = MFMA16(a, VNSf[s2], S[m]); }
        }
        LAS float* rs = rowsum + (c % 3) * 64;
#pragma unroll
        for (int mt = 0; mt < 4; ++mt) {
            f32x4 sqv = O[mt] * O[mt];
#pragma unroll
            for (int r = 0; r < 4; ++r) { float v = (r == 0) ? sqv.x : (r == 1) ? sqv.y : (r == 2) ? sqv.z : sqv.w;
                v = DPP_ROR_ADD(v, 8); v = DPP_ROR_ADD(v, 4); v = DPP_ROR_ADD(v, 2); v = DPP_ROR_ADD(v, 1);
                if (n == 0) (void)__hip_atomic_fetch_add(rs + 16 * mt + 4 * q + r, v, __ATOMIC_RELAXED, __HIP_MEMORY_SCOPE_WORKGROUP); }
        }
        if (c + 1 < 128) scan_write(lds + (cur ^ 1) * SC_BUF, lds + SC_VEC + (cur ^ 1) * 1024, tid, G);
        if (tid < 64) rowsum[((c + 1) % 3) * 64 + tid] = 0.f;
        __syncthreads();
#pragma unroll
        for (int mt = 0; mt < 4; ++mt) {
            const f32x4 rsv = *(const LAS f32x4*)(rs + 16 * mt + 4 * q);
#pragma unroll
            for (int r = 0; r < 4; ++r) { const float ssum = (r == 0) ? rsv.x : (r == 1) ? rsv.y : (r == 2) ? rsv.z : rsv.w;
                const float o = (r == 0) ? O[mt].x : (r == 1) ? O[mt].y : (r == 2) ? O[mt].z : O[mt].w;
                const float rstd = rsqrtf(ssum * (1.f / 128.f) + EPS);
                mix[(size_t)(t0 + 16 * mt + 4 * q + r) * DM + mix_col + 16 * sl + n] = f2bf(o * rstd * gn * siluf_(gatev[4 * mt + r])); }
        }
    }
    __syncthreads();
}

struct EpiResF32 {
    static constexpr bool PERM = false, AFTER_DRAIN = false;
    const float* R; float* O; int ldc;
    __device__ __forceinline__ void operator()(const pg8::f32x4 (&acc)[2][2][4][2], const pg8::Unit& u, int wr, int wc, int fr, int fq) const {
        const int row0 = u.pm * 256 + wr * 64 + fr, col0 = u.pn * 256 + wc * 32 + 4 * fq;
#pragma unroll
        for (int ai = 0; ai < 2; ++ai)
#pragma unroll
            for (int m = 0; m < 4; ++m) { const size_t off = (size_t)(row0 + ai * 128 + m * 16) * ldc + col0;
#pragma unroll
                for (int bj = 0; bj < 2; ++bj)
#pragma unroll
                    for (int n = 0; n < 2; ++n) { pg8::f32x4 v = acc[ai][bj][m][n]; if (R) v = v + *(const pg8::f32x4*)(R + off + bj * 128 + n * 16); *(pg8::f32x4*)(O + off + bj * 128 + n * 16) = v; } }
    }
};

__global__ void __launch_bounds__(NT, 2) mk_fwd(Args args) {
    extern __shared__ __attribute__((aligned(16))) unsigned char lds_raw[];
    LAS unsigned char* lds = (LAS unsigned char*)lds_raw;
    cg::grid_group grid = cg::this_grid();
    const int tid = threadIdx.x, lane = tid & 63, wave = __builtin_amdgcn_readfirstlane(tid >> 6);
    const int G = gridDim.x, bx = blockIdx.x;
    const int vcu = (G % 8 == 0) ? (bx % 8) * (G / 8) + bx / 8 : bx;
    const int gw = vcu * NW + wave, NGW = G * NW;
    unsigned char* ws = args.ws;
    const float* x = args.in[0]; const float* attn_g = args.in[1]; const float* w_in = args.in[2];
    const float* w_out = args.in[9]; const float* ffn_g = args.in[10]; const float* w_query = args.in[11]; const float* sub_keys = args.in[12];
    bf16_t* WinT = (bf16_t*)(ws + OFF_D);
    bf16_t* WoutT = (bf16_t*)(ws + OFF_C);
    bf16_t* Wqk = (bf16_t*)(ws + OFF_C + 8 * MiB);
    bf16_t* xn = (bf16_t*)(ws + OFF_D + 28 * MiB);
    float* ba = (float*)(ws + OFF_S);
    bf16_t* proj = (bf16_t*)(ws + OFF_B);
    bf16_t* mix = (bf16_t*)args.out;
    unsigned char* pb = ws + OFF_D; float* vecs = (float*)(ws + OFF_S + 2 * MiB);
    float* hbuf = (float*)(ws + OFF_B);
    bf16_t* hn = (bf16_t*)(ws + OFF_D + 128 * MiB);
    float* scores = (float*)(ws + OFF_D);
    unsigned char* U8 = ws + OFF_TAB; unsigned char* V8 = ws + OFF_TAB + 32 * MiB;
    float* inv_su = (float*)(ws + OFF_S + 1 * MiB); float* inv_sv = inv_su + 16384;

    const int lo = args.ph_lo, hi = args.ph_hi;
#define IN(k) (lo <= (k) && (k) < hi)
#define SYNC_AFTER(k) do { if (IN(k) && (k) + 1 < hi) grid.sync(); } while (0)
    {
        if (IN(0)) {
            LAS float* scr = (LAS float*)(lds + wave * 16384);
            constexpr int I_IN = (DM / 64) * (NPROJ / 32), I_OUT = (DM / 64) * (DM / 32);
            for (int it = gw; it < I_IN + I_OUT; it += NGW) {
                if (it < I_IN) transpose_item(w_in, INW, DM, NPROJ, WinT, scr, it, lane);
                else transpose_item(w_out, DM, DM, DM, WoutT, scr, it - I_IN, lane);
            }
            for (int m = gw; m < T; m += NGW) norm_row<true>(x + (size_t)m * DM, attn_g, w_in, xn + (size_t)m * DM, ba + (size_t)m * 16, lane);
            for (int e = gw; e < 32768; e += NGW) { const bool isv = e >= 16384; const int r = e & 16383;
                table_row((isv ? args.in[14] : args.in[13]) + (size_t)r * DM, (unsigned*)((isv ? V8 : U8) + (size_t)r * 2048), (isv ? inv_sv : inv_su) + r, lane); }
            __syncthreads();
            for (int it = bx; it < 512; it += G) wqk_item(w_query, sub_keys, Wqk, (LAS float*)lds, it, tid);
        }
        SYNC_AFTER(0);
        if (IN(1)) {
            pg8::Gemm g{xn, WinT, T, NPROJ, DM}; pg8::StaticOrder S; S.init(T, NPROJ, G, bx);
            pg8::EpiBf16<0> E{proj, NPROJ, nullptr, 0, 0, 1.f};
            pg8::gemm_phase<pg8::EpiBf16<0>, pg8::StaticOrder, true, true>(lds, g, S, E);
        }
        SYNC_AFTER(1);
        if (IN(2)) {
            for (int it = bx; it < 2048; it += G) hgrn_prep_item(it, proj, args.in[3], pb, vecs, lds, tid);
            for (int it = bx; it < 1024; it += G) gdn_prep_item(it, proj, ba, args.in[5], args.in[6], args.in[7], pb, vecs, lds, tid);
        }
        SYNC_AFTER(2);
        if (IN(3)) {
            if (bx < 32) scan_block(bx, proj, pb, vecs, args.in[4], args.in[8], mix, lds, tid);
        }
        SYNC_AFTER(3);
        if (IN(4)) {
            pg8::Gemm g{mix, WoutT, T, DM, DM}; pg8::StaticOrder S; S.init(T, DM, G, bx);
            EpiResF32 E{x, hbuf, DM};
            pg8::gemm_phase<EpiResF32, pg8::StaticOrder, true, true>(lds, g, S, E);
        }
        SYNC_AFTER(4);
        if (IN(5)) {
            for (int m = gw; m < T; m += NGW) norm_row<false>(hbuf + (size_t)m * DM, ffn_g, nullptr, hn + (size_t)m * DM, nullptr, lane);
        }
        SYNC_AFTER(5);
        if (IN(6)) {
            pg8::Gemm g{hn, Wqk, T, DM, DM}; pg8::StaticOrder S; S.init(T, DM, G, bx);
            EpiResF32 E{nullptr, scores, DM};
            pg8::gemm_phase<EpiResF32, pg8::StaticOrder, true, true>(lds, g, S, E);
        }
        SYNC_AFTER(6);
        if (IN(7)) {
            LAS int* se = (LAS int*)(lds + wave * 2048); LAS float* sa = (LAS float*)(lds + wave * 2048 + 512); LAS float* sb = (LAS float*)(lds + wave * 2048 + 1024);
            for (int t = gw; t < T; t += NGW) peer_token(t, scores, hn, hbuf, U8, V8, inv_su, inv_sv, args.in[15], args.out, se, sa, sb, lane);
        }
    }
}
}

extern "C" void kernel_launch(void* const* d_in, const int* in_sizes, int n_in, void* d_out, int out_size, void* d_ws, size_t ws_size, hipStream_t stream) {
    static int grid = 0;
    if (grid == 0) {
        int dev = 0, cus = 0, per_cu = 0;
        (void)hipGetDevice(&dev);
        (void)hipDeviceGetAttribute(&cus, hipDeviceAttributeMultiprocessorCount, dev);
        (void)hipFuncSetAttribute((const void*)mk::mk_fwd, hipFuncAttributeMaxDynamicSharedMemorySize, mk::LDS_BYTES);
        (void)hipOccupancyMaxActiveBlocksPerMultiprocessor(&per_cu, (const void*)mk::mk_fwd, mk::NT, mk::LDS_BYTES);
        if (per_cu < 1) { fprintf(stderr, "occupancy query says %d\n", per_cu); per_cu = 1; }
        grid = cus;
    }
    unsigned char* ws = (unsigned char*)d_ws;
    mk::Args a{};
    for (int i = 0; i < 16; ++i) a.in[i] = (const float*)d_in[i];
    a.out = (float*)d_out; a.ws = ws;
    {
#ifdef MIX_NAIVE
        a.ph_lo = 0; a.ph_hi = 2;
        void* kargs[] = {&a};
        (void)hipLaunchCooperativeKernel((const void*)mk::mk_fwd, dim3(grid), dim3(mk::NT), kargs, mk::LDS_BYTES, stream);
        k_mixers_seq<<<32, 128, 0, stream>>>((const bf16_t*)(ws + OFF_B), (const float*)(ws + OFF_S), (const float*)d_in[3], (const float*)d_in[4], (const float*)d_in[5], (const float*)d_in[6],
                                             (const float*)d_in[7], (const float*)d_in[8], (bf16_t*)d_out);
        mk::Args b = a; b.ph_lo = 4; b.ph_hi = 8;
        void* kargs2[] = {&b};
        (void)hipLaunchCooperativeKernel((const void*)mk::mk_fwd, dim3(grid), dim3(mk::NT), kargs2, mk::LDS_BYTES, stream);
#else
        a.ph_lo = 0; a.ph_hi = 8;
        void* kargs[] = {&a};
        hipError_t e = hipLaunchCooperativeKernel((const void*)mk::mk_fwd, dim3(grid), dim3(mk::NT), kargs, mk::LDS_BYTES, stream);
        if (e != hipSuccess) fprintf(stderr, "coop launch failed: %s\n", hipGetErrorString(e));
#endif
    }
}
```

```cpp
#include <hip/hip_runtime.h>
#include <hip/hip_cooperative_groups.h>
#include <cstdio>
namespace cg = cooperative_groups;
#include <stdint.h>

typedef unsigned short bf16_t;
typedef float f32x4 __attribute__((ext_vector_type(4)));

constexpr int T = 16384, SEQ = 8192, DM = 2048, INW = 7184, NPROJ = 7168;
constexpr float EPS = 1e-6f;
constexpr size_t MiB = 1u << 20;
constexpr size_t OFF_TAB = 1 * MiB;
constexpr size_t OFF_B = 65 * MiB;
constexpr size_t OFF_C = 289 * MiB;
constexpr size_t OFF_D = 305 * MiB;
constexpr size_t OFF_S = 500 * MiB;
constexpr int C_AQ = 0, C_AF = 1024, C_AI = 2048, C_AG = 3072, C_BQ = 4096, C_BK = 4608, C_BV = 5120, C_BZ = 6144;

__device__ __forceinline__ float bf2f(bf16_t v) { return __uint_as_float(((unsigned)v) << 16); }
__device__ __forceinline__ bf16_t f2bf(float f) { unsigned u = __float_as_uint(f); return (bf16_t)((u + 0x7fffu + ((u >> 16) & 1u)) >> 16); }
__device__ __forceinline__ float sigmoidf_(float x) { return 1.f / (1.f + __expf(-x)); }
__device__ __forceinline__ float siluf_(float x) { return x / (1.f + __expf(-x)); }
__device__ __forceinline__ float wave_sum(float v) {
#pragma unroll
    for (int o = 1; o < 64; o <<= 1) v += __shfl_xor(v, o);
    return v;
}
__device__ __forceinline__ float block_sum(float v, float* sh) {
    v = wave_sum(v);
    const int w = threadIdx.x >> 6, nw = blockDim.x >> 6;
    __syncthreads();
    if ((threadIdx.x & 63) == 0) sh[w] = v;
    __syncthreads();
    float r = 0.f;
    for (int i = 0; i < nw; ++i) r += sh[i];
    return r;
}

__global__ void __launch_bounds__(256) k_rmsnorm_x(const float* __restrict__ x, const float* __restrict__ g, const float* __restrict__ w_in,
                                                  bf16_t* __restrict__ xn, float* __restrict__ ba) {
    __shared__ float sh[8];
    __shared__ float sacc[4][16];
    const int t = blockIdx.x, tid = threadIdx.x;
    const float* xr = x + (size_t)t * DM;
    float v[8];
    float ss = 0.f;
#pragma unroll
    for (int i = 0; i < 8; ++i) { v[i] = xr[tid * 8 + i]; ss += v[i] * v[i]; }
    ss = block_sum(ss, sh);
    const float rstd = rsqrtf(ss * (1.f / DM) + EPS);
    float acc[16];
#pragma unroll
    for (int j = 0; j < 16; ++j) acc[j] = 0.f;
#pragma unroll
    for (int i = 0; i < 8; ++i) {
        const int d = tid * 8 + i;
        const float y = v[i] * rstd * g[d];
        xn[(size_t)t * DM + d] = f2bf(y);
        const float* wr = w_in + (size_t)d * INW + NPROJ;
#pragma unroll
        for (int j = 0; j < 16; ++j) acc[j] += y * wr[j];
    }
#pragma unroll
    for (int j = 0; j < 16; ++j) acc[j] = wave_sum(acc[j]);
    __syncthreads();
    if ((tid & 63) == 0) {
#pragma unroll
        for (int j = 0; j < 16; ++j) sacc[tid >> 6][j] = acc[j];
    }
    __syncthreads();
    if (tid < 16) ba[(size_t)t * 16 + tid] = sacc[0][tid] + sacc[1][tid] + sacc[2][tid] + sacc[3][tid];
}

template <int MODE>
__global__ void __launch_bounds__(256) k_gemm_naive(const bf16_t* __restrict__ A, const float* __restrict__ W, int ldw, int K, int N,
                                                   void* __restrict__ Cout, int ldc, const float* __restrict__ R) {
    __shared__ float As[16][68];
    __shared__ float Ws[16][68];
    const int tid = threadIdx.x, tx = tid & 15, ty = tid >> 4;
    const int m0 = blockIdx.y * 64, n0 = blockIdx.x * 64;
    float acc[4][4];
#pragma unroll
    for (int i = 0; i < 4; ++i)
#pragma unroll
        for (int j = 0; j < 4; ++j) acc[i][j] = 0.f;
    for (int k0 = 0; k0 < K; k0 += 16) {
        {
            const int r = tid >> 2, kk = (tid & 3) * 4;
            const bf16_t* ap = A + (size_t)(m0 + r) * K + k0 + kk;
#pragma unroll
            for (int i = 0; i < 4; ++i) As[kk + i][r] = bf2f(ap[i]);
        }
        {
            const int kk = tid >> 4, c = (tid & 15) * 4;
            const float* wp = W + (size_t)(k0 + kk) * ldw + n0 + c;
#pragma unroll
            for (int i = 0; i < 4; ++i) Ws[kk][c + i] = wp[i];
        }
        __syncthreads();
#pragma unroll
        for (int kk = 0; kk < 16; ++kk) {
            float a[4], b[4];
#pragma unroll
            for (int i = 0; i < 4; ++i) { a[i] = As[kk][ty * 4 + i]; b[i] = Ws[kk][tx * 4 + i]; }
#pragma unroll
            for (int i = 0; i < 4; ++i)
#pragma unroll
                for (int j = 0; j < 4; ++j) acc[i][j] += a[i] * b[j];
        }
        __syncthreads();
    }
#pragma unroll
    for (int i = 0; i < 4; ++i) {
        const int m = m0 + ty * 4 + i;
#pragma unroll
        for (int j = 0; j < 4; ++j) {
            const int n = n0 + tx * 4 + j;
            if (MODE == 0) ((bf16_t*)Cout)[(size_t)m * ldc + n] = f2bf(acc[i][j]);
            else if (MODE == 1) ((float*)Cout)[(size_t)m * ldc + n] = acc[i][j] + R[(size_t)m * ldc + n];
            else ((float*)Cout)[(size_t)m * ldc + n] = acc[i][j];
        }
    }
}

__global__ void __launch_bounds__(128) k_mixers_seq(const bf16_t* __restrict__ proj, const float* __restrict__ ba,
                                                   const float* __restrict__ lb_logits, const float* __restrict__ hgrn_g,
                                                   const float* __restrict__ conv_w, const float* __restrict__ A_log, const float* __restrict__ dt_bias,
                                                   const float* __restrict__ gdn_g, bf16_t* __restrict__ mix) {
    __shared__ float s0[128], s1[128], s2[128];
    __shared__ float sh[8];
    const int tid = threadIdx.x;
    float S[128];
#pragma unroll
    for (int d = 0; d < 128; ++d) S[d] = 0.f;
    if (blockIdx.x < 16) {
        const int b = blockIdx.x >> 3, h = blockIdx.x & 7;
        const float l0 = lb_logits[h * 128 + tid], l1 = lb_logits[1024 + h * 128 + tid];
        const float lb = 1.f / (1.f + __expf(l1 - l0));
        const float gn = hgrn_g[tid];
        for (int t = 0; t < SEQ; ++t) {
            const bf16_t* pr = proj + (size_t)(b * SEQ + t) * NPROJ;
            const float q = bf2f(pr[C_AQ + h * 128 + tid]), z = bf2f(pr[C_AF + h * 128 + tid]);
            const float f = lb + (1.f - lb) * sigmoidf_(z);
            __syncthreads();
            s0[tid] = q; s1[tid] = f; s2[tid] = 1.f - f;
            __syncthreads();
            const float vv = bf2f(pr[C_AI + h * 128 + tid]);
            float o = 0.f;
#pragma unroll
            for (int d = 0; d < 128; ++d) { S[d] = s1[d] * S[d] + s2[d] * vv; o += s0[d] * S[d]; }
            const float ss = block_sum(o * o, sh);
            const float rstd = rsqrtf(ss * (1.f / 128.f) + EPS);
            const float gate = bf2f(pr[C_AG + h * 128 + tid]);
            mix[(size_t)(b * SEQ + t) * DM + h * 128 + tid] = f2bf(o * rstd * gn * siluf_(gate));
        }
    } else {
        const int bb = blockIdx.x - 16, b = bb >> 3, vh = bb & 7, qh = vh >> 1;
        const int cq = qh * 128 + tid, ck = 512 + qh * 128 + tid, cv = 1024 + vh * 128 + tid;
        float wq[4], wk[4], wv[4];
#pragma unroll
        for (int j = 0; j < 4; ++j) { wq[j] = conv_w[j * 2048 + cq]; wk[j] = conv_w[j * 2048 + ck]; wv[j] = conv_w[j * 2048 + cv]; }
        float hq[3] = {0.f, 0.f, 0.f}, hk[3] = {0.f, 0.f, 0.f}, hv[3] = {0.f, 0.f, 0.f};
        const float Aexp = __expf(A_log[vh]), dtb = dt_bias[vh], gn = gdn_g[tid];
        for (int t = 0; t < SEQ; ++t) {
            const bf16_t* pr = proj + (size_t)(b * SEQ + t) * NPROJ;
            const float xq = bf2f(pr[C_BQ + qh * 128 + tid]), xk = bf2f(pr[C_BK + qh * 128 + tid]), xv = bf2f(pr[C_BV + vh * 128 + tid]);
            float q = wq[0] * hq[0] + wq[1] * hq[1] + wq[2] * hq[2] + wq[3] * xq;
            float k = wk[0] * hk[0] + wk[1] * hk[1] + wk[2] * hk[2] + wk[3] * xk;
            float v = wv[0] * hv[0] + wv[1] * hv[1] + wv[2] * hv[2] + wv[3] * xv;
            hq[0] = hq[1]; hq[1] = hq[2]; hq[2] = xq; hk[0] = hk[1]; hk[1] = hk[2]; hk[2] = xk; hv[0] = hv[1]; hv[1] = hv[2]; hv[2] = xv;
            q = siluf_(q); k = siluf_(k); v = siluf_(v);
            const float sq = block_sum(q * q, sh);
            const float sk = block_sum(k * k, sh);
            q = q * rsqrtf(sq + EPS) * 0.08838834764831845f;
            k = k * rsqrtf(sk + EPS);
            __syncthreads();
            s0[tid] = q; s1[tid] = k;
            __syncthreads();
            const float beta = sigmoidf_(ba[(size_t)(b * SEQ + t) * 16 + vh]);
            const float ax = ba[(size_t)(b * SEQ + t) * 16 + 8 + vh] + dtb;
            const float sp = ax > 20.f ? ax : log1pf(__expf(ax));
            const float eg = __expf(-Aexp * sp);
            float kS = 0.f;
#pragma unroll
            for (int d = 0; d < 128; ++d) { S[d] *= eg; kS += s1[d] * S[d]; }
            const float delta = beta * (v - kS);
            float o = 0.f;
#pragma unroll
            for (int d = 0; d < 128; ++d) { S[d] += s1[d] * delta; o += s0[d] * S[d]; }
            const float ss = block_sum(o * o, sh);
            const float rstd = rsqrtf(ss * (1.f / 128.f) + EPS);
            const float gate = bf2f(pr[C_BZ + vh * 128 + tid]);
            mix[(size_t)(b * SEQ + t) * DM + 1024 + vh * 128 + tid] = f2bf(o * rstd * gn * siluf_(gate));
        }
    }
}

__global__ void __launch_bounds__(256) k_rmsnorm_h(const float* __restrict__ h, const float* __restrict__ g, bf16_t* __restrict__ hn) {
    __shared__ float sh[8];
    const int t = blockIdx.x, tid = threadIdx.x;
    float v[8]; float ss = 0.f;
#pragma unroll
    for (int i = 0; i < 8; ++i) { v[i] = h[(size_t)t * DM + tid * 8 + i]; ss += v[i] * v[i]; }
    ss = block_sum(ss, sh);
    const float rstd = rsqrtf(ss * (1.f / DM) + EPS);
#pragma unroll
    for (int i = 0; i < 8; ++i) hn[(size_t)t * DM + tid * 8 + i] = f2bf(v[i] * rstd * g[tid * 8 + i]);
}

__global__ void __launch_bounds__(256) k_scores_naive(const float* __restrict__ qry, const float* __restrict__ sk, float* __restrict__ scores) {
    __shared__ float sq[2048];
    const int t = blockIdx.x, tid = threadIdx.x;
    for (int i = tid; i < 2048; i += 256) sq[i] = qry[(size_t)t * DM + i];
    __syncthreads();
    for (int c = tid; c < 2048; c += 256) {
        const int h = c >> 8, half = (c >> 7) & 1, n = c & 127;
        const float* kr = sk + (((size_t)half * 8 + h) * 128 + n) * 128;
        const float* qr = sq + h * 256 + half * 128;
        float a = 0.f;
        for (int k = 0; k < 128; ++k) a += qr[k] * kr[k];
        scores[(size_t)t * DM + c] = a;
    }
}

__device__ __forceinline__ void wave_argmax(float& m, int& idx) {
#pragma unroll
    for (int o = 1; o < 64; o <<= 1) {
        const float om = __shfl_xor(m, o); const int oi = __shfl_xor(idx, o);
        if (om > m || (om == m && oi < idx)) { m = om; idx = oi; }
    }
}
__device__ __forceinline__ void topk_head(const float* __restrict__ s, int lane, int& expert, float& gate) {
    float v1 = 0.f, v2 = 0.f; int i1 = 0, i2 = 0;
    {
        float a0 = s[lane], a1 = s[lane + 64];
        for (int it = 0; it < 16; ++it) {
            float m; int idx;
            if (a0 >= a1) { m = a0; idx = lane; } else { m = a1; idx = lane + 64; }
            wave_argmax(m, idx);
            if (idx == lane) a0 = -INFINITY;
            if (idx == lane + 64) a1 = -INFINITY;
            if (lane == it) { v1 = m; i1 = idx; }
        }
    }
    {
        float a0 = s[128 + lane], a1 = s[128 + lane + 64];
        for (int it = 0; it < 16; ++it) {
            float m; int idx;
            if (a0 >= a1) { m = a0; idx = lane; } else { m = a1; idx = lane + 64; }
            wave_argmax(m, idx);
            if (idx == lane) a0 = -INFINITY;
            if (idx == lane + 64) a1 = -INFINITY;
            if (lane == it) { v2 = m; i2 = idx; }
        }
    }
    float c[4];
    const float vi = __shfl(v1, lane >> 2);
#pragma unroll
    for (int cc = 0; cc < 4; ++cc) c[cc] = vi + __shfl(v2, (lane & 3) * 4 + cc);
    float best = 0.f; int pos = 0;
    for (int it = 0; it < 16; ++it) {
        float m = c[0]; int idx = lane * 4;
#pragma unroll
        for (int cc = 1; cc < 4; ++cc) if (c[cc] > m) { m = c[cc]; idx = lane * 4 + cc; }
        wave_argmax(m, idx);
#pragma unroll
        for (int cc = 0; cc < 4; ++cc) if (idx == lane * 4 + cc) c[cc] = -INFINITY;
        if (lane == it) { best = m; pos = idx; }
    }
    const int e1 = __shfl(i1, pos >> 4), e2 = __shfl(i2, pos & 15);
    expert = e1 * 128 + e2;
    const float mx = __shfl(best, 0);
    float ex = (lane < 16) ? __expf(best - mx) : 0.f;
    float sum = ex;
#pragma unroll
    for (int o = 1; o < 16; o <<= 1) sum += __shfl_xor(sum, o);
    gate = ex / sum;
}

__device__ __forceinline__ float gelu_erf(float x) { return 0.5f * x * (1.f + erff(x * 0.70710678118654752f)); }
__global__ void __launch_bounds__(256) k_peer_naive(const float* __restrict__ scores, const bf16_t* __restrict__ hn, const float* __restrict__ h,
                                                   const float* __restrict__ u_tab, const float* __restrict__ v_tab, const float* __restrict__ gfin,
                                                   float* __restrict__ out) {
    __shared__ int se[4][128];
    __shared__ float sg[4][128];
    const int w = threadIdx.x >> 6, lane = threadIdx.x & 63;
    const int t = blockIdx.x * 4 + w;
    for (int hd = 0; hd < 8; ++hd) {
        int e; float g;
        topk_head(scores + (size_t)t * DM + hd * 256, lane, e, g);
        if (lane < 16) { se[w][hd * 16 + lane] = e; sg[w][hd * 16 + lane] = g; }
    }
    __syncthreads();
    float xv[32], y[32];
#pragma unroll
    for (int j = 0; j < 8; ++j)
#pragma unroll
        for (int i = 0; i < 4; ++i) { xv[j * 4 + i] = bf2f(hn[(size_t)t * DM + j * 256 + lane * 4 + i]); y[j * 4 + i] = 0.f; }
    for (int k = 0; k < 128; ++k) {
        const int e = se[w][k]; const float g = sg[w][k];
        const float* ur = u_tab + (size_t)e * DM; const float* vr = v_tab + (size_t)e * DM;
        float p = 0.f;
#pragma unroll
        for (int j = 0; j < 8; ++j) {
            const f32x4 uu = *(const f32x4*)(ur + j * 256 + lane * 4);
            p += uu.x * xv[j * 4] + uu.y * xv[j * 4 + 1] + uu.z * xv[j * 4 + 2] + uu.w * xv[j * 4 + 3];
        }
        p = wave_sum(p);
        const float wgt = g * gelu_erf(p);
#pragma unroll
        for (int j = 0; j < 8; ++j) {
            const f32x4 vv = *(const f32x4*)(vr + j * 256 + lane * 4);
            y[j * 4] += wgt * vv.x; y[j * 4 + 1] += wgt * vv.y; y[j * 4 + 2] += wgt * vv.z; y[j * 4 + 3] += wgt * vv.w;
        }
    }
    float ss = 0.f;
#pragma unroll
    for (int j = 0; j < 8; ++j)
#pragma unroll
        for (int i = 0; i < 4; ++i) { y[j * 4 + i] += h[(size_t)t * DM + j * 256 + lane * 4 + i]; ss += y[j * 4 + i] * y[j * 4 + i]; }
    ss = wave_sum(ss);
    const float rstd = rsqrtf(ss * (1.f / DM) + EPS);
#pragma unroll
    for (int j = 0; j < 8; ++j)
#pragma unroll
        for (int i = 0; i < 4; ++i) out[(size_t)t * DM + j * 256 + lane * 4 + i] = y[j * 4 + i] * rstd * gfin[j * 256 + lane * 4 + i];
}

namespace pg8 {
#define PG8_LAS __attribute__((address_space(3)))
typedef unsigned short bf16_t;
typedef short bf16x8 __attribute__((ext_vector_type(8)));
typedef float f32x4 __attribute__((ext_vector_type(4)));
typedef unsigned u32x4 __attribute__((ext_vector_type(4)));
constexpr int BM = 256, BK = 64, HALF = 128, HTB = HALF * BK * 2  , STAGE_BYTES = 8 * HTB, NXCD = 8, WGM = 8;

__host__ __device__ __forceinline__ int lds_byte(int r, int c) { const int st = (r >> 4) * 2 + (c >> 5), rr = r & 15, cc = c & 31, ob = rr * 64 + cc * 2; return st * 1024 + (ob ^ (((ob >> 9) & 1) << 5)); }
__host__ __device__ __forceinline__ void stage_rc(int b, int& R, int& C) { const int st = b / 1024, sb = b % 1024, swz = sb ^ (((sb >> 9) & 1) << 5); R = (st >> 1) * 16 + swz / 64; C = (st & 1) * 32 + (swz % 64) / 2; }
__host__ __device__ __forceinline__ int perm32(int rho) { const int n = rho >> 4, i = rho & 15; return 8 * (i >> 2) + 4 * n + (i & 3); }

struct Unit { int pm, pn; };
struct Gemm { const bf16_t* A; const bf16_t* Bt; int M, N, K; };

struct StaticOrder {
    int nM, nN, nwg, G, c;
    __host__ __device__ void init(int M, int N, int G_, int c_) { nM = M / BM; nN = N / BM; nwg = nM * nN; G = G_; c = c_; }
    __host__ __device__ bool next(int i, Unit& u) const {
        const long L = (long)i * G + c; if (L >= nwg) return false;
        int wgid = (int)L; { const int q = nwg / NXCD, r = nwg % NXCD, xcd = wgid % NXCD, off = wgid / NXCD; wgid = (xcd < r ? xcd * (q + 1) : r * (q + 1) + (xcd - r) * q) + off; }
        const int nig = WGM * nN, gid = wgid / nig, fm = gid * WGM, gsz = (nM - fm) < WGM ? (nM - fm) : WGM;
        u.pm = fm + ((wgid % nig) % gsz); u.pn = (wgid % nig) / gsz; return true;
    }
    __device__ __forceinline__ void a_ready(const Unit&) const {}
    __device__ __forceinline__ void done(const Unit&) const {}
};

__device__ __forceinline__ unsigned cvt_pk_bf16(float lo, float hi) { unsigned r; asm volatile("v_cvt_pk_bf16_f32 %0, %1, %2" : "=v"(r) : "v"(lo), "v"(hi)); return r; }
typedef float f32x2 __attribute__((ext_vector_type(2)));
__device__ __forceinline__ f32x2 gelu_pk(f32x2 v) {
    const f32x2 av = __builtin_elementwise_abs(v), d = av * 0.2316418882f + 1.0f;
    f32x2 t; t.x = __builtin_amdgcn_rcpf(d.x); t.y = __builtin_amdgcn_rcpf(d.y);
    f32x2 q = t * 0.5307027145f + (-0.7265760135f); q = q * t + 0.7107068705f; q = q * t + (-0.142248368f); q = q * t + 0.127414796f; q = q * t;
    const f32x2 s = (v * v) * (-0.72134752044f);
    f32x2 e; e.x = __builtin_amdgcn_exp2f(s.x); e.y = __builtin_amdgcn_exp2f(s.y);
    const f32x2 m = v * (q * e), r = v - m;
    f32x2 o; o.x = v.x < 0.f ? m.x : r.x; o.y = v.y < 0.f ? m.y : r.y; return o;
}

template <int ACT  > struct EpiBf16 {
    static constexpr bool PERM = true, AFTER_DRAIN = false; static_assert(ACT == 0 || ACT == 1, "EpiBf16: ACT is 0 (none) or 1 (gelu_pk)");
    bf16_t* O; int ldc; const float* bias; int split_cols; size_t split_stride; float scale0;
    __device__ __forceinline__ void operator()(const f32x4 (&acc)[2][2][4][2], const Unit& u, int wr, int wc, int fr, int fq) const {
        const int row0 = u.pm * BM + wr * 64 + fr; int colt = u.pn * BM; bf16_t* base = O;
        float sc = 1.f; if (split_cols) { const int t = colt / split_cols; base += (size_t)t * split_stride; colt -= t * split_cols; if (t == 0) sc = scale0; }
        const int col0 = colt + wc * 32 + 8 * fq, bcol0 = u.pn * BM + wc * 32 + 8 * fq;
        f32x4 bv[2][2];
#pragma unroll
        for (int bj = 0; bj < 2; ++bj)
#pragma unroll
            for (int n = 0; n < 2; ++n) bv[bj][n] = bias ? *(const f32x4*)(bias + bcol0 + bj * HALF + 4 * n) : (f32x4){0.f, 0.f, 0.f, 0.f};
#pragma unroll
        for (int ai = 0; ai < 2; ++ai)
#pragma unroll
            for (int m = 0; m < 4; ++m) { bf16_t* rowp = base + (size_t)(row0 + ai * HALF + m * 16) * ldc + col0;
#pragma unroll
                for (int bj = 0; bj < 2; ++bj) { f32x4 v0 = acc[ai][bj][m][0] + bv[bj][0], v1 = acc[ai][bj][m][1] + bv[bj][1];
                    if (ACT == 1) { f32x2 a = gelu_pk((f32x2){v0[0], v0[1]}), b = gelu_pk((f32x2){v0[2], v0[3]}), c = gelu_pk((f32x2){v1[0], v1[1]}), d = gelu_pk((f32x2){v1[2], v1[3]});
                        v0 = (f32x4){a.x, a.y, b.x, b.y}; v1 = (f32x4){c.x, c.y, d.x, d.y}; }
                    v0 = v0 * sc; v1 = v1 * sc; u32x4 w; w.x = cvt_pk_bf16(v0[0], v0[1]); w.y = cvt_pk_bf16(v0[2], v0[3]); w.z = cvt_pk_bf16(v1[0], v1[1]); w.w = cvt_pk_bf16(v1[2], v1[3]);
                    *(u32x4*)(rowp + bj * HALF) = w; } }
    }
};
template <class Epi, class Sched, bool ALIGN_EPI = false, bool SP2 = false>
__device__ __forceinline__ void gemm_phase(PG8_LAS unsigned char* lds, const Gemm g, const Sched& S, const Epi& E) {
    const int tid = threadIdx.x, wid = __builtin_amdgcn_readfirstlane(tid >> 6), lane = tid & 63, wr = wid >> 2, wc = wid & 3, fr = lane & 15, fq = lane >> 4;
    const int K = g.K, nt = K / BK;
    unsigned voffA[2], voffB[2];
#pragma unroll
    for (int i = 0; i < 2; ++i) { int R, C; stage_rc(tid * 16 + i * 8192, R, C); const int Rb = Epi::PERM ? ((R & ~31) + perm32(R & 31)) : R;
        voffA[i] = (unsigned)(R * K + C) * 2u; voffB[i] = (unsigned)(Rb * K + C) * 2u; }
    const size_t kstep = (size_t)(BK * 2);
    const size_t hstep = (size_t)HALF * K * 2;
    const size_t tstep = 2 * hstep;
    const unsigned ldsw = (unsigned)wid * 1024u;
    const int aoff = lds_byte(wr * 64 + fr, fq * 8), boff = lds_byte(wc * 32 + fr, fq * 8);
#define PG8_SA(b, h) (((b) * 2 + (h)) * HTB)
#define PG8_SB(b, h) ((4 + (b) * 2 + (h)) * HTB)
#define PG8_STAGE(bufoff, gbase, voff) do { _Pragma("unroll") for (int _i = 0; _i < 2; ++_i) \
        __builtin_amdgcn_global_load_lds((const unsigned*)((const char*)(gbase) + (voff)[_i]), (PG8_LAS unsigned*)(lds + (bufoff) + ldsw + _i * 8192), 16, 0, 0); } while (0)
#define PG8_LDA(dst, b, h) do { _Pragma("unroll") for (int m = 0; m < 4; ++m) _Pragma("unroll") for (int k = 0; k < 2; ++k) dst[m][k] = *(const PG8_LAS bf16x8*)(lds + PG8_SA(b, h) + aoff + m * 2048 + k * 1024); } while (0)
#define PG8_LDB(dst, b, h) do { _Pragma("unroll") for (int n = 0; n < 2; ++n) _Pragma("unroll") for (int k = 0; k < 2; ++k) dst[n][k] = *(const PG8_LAS bf16x8*)(lds + PG8_SB(b, h) + boff + n * 2048 + k * 1024); } while (0)
#define PG8_MMA(ai, bj, At, Bt) do { __builtin_amdgcn_s_setprio(1); _Pragma("unroll") for (int m = 0; m < 4; ++m) _Pragma("unroll") for (int n = 0; n < 2; ++n) _Pragma("unroll") for (int k = 0; k < 2; ++k) \
        acc[ai][bj][m][n] = __builtin_amdgcn_mfma_f32_16x16x32_bf16(Bt[n][k], At[m][k], acc[ai][bj][m][n], 0, 0, 0); __builtin_amdgcn_s_setprio(0); } while (0)
#define PG8_WAIT_V(n) asm volatile("s_waitcnt vmcnt(" #n ")" ::: "memory")
#define PG8_WAIT_L(n) asm volatile("s_waitcnt lgkmcnt(" #n ")" ::: "memory")
#define PG8_BAR __builtin_amdgcn_s_barrier()
#define PG8_SCHED __builtin_amdgcn_sched_barrier(0)
    Unit cur, nxt; int ui = 0;
    if (!S.next(0, cur)) return;
    f32x4 acc[2][2][4][2];
#pragma unroll
    for (int a = 0; a < 2; ++a)
#pragma unroll
        for (int b = 0; b < 2; ++b)
#pragma unroll
            for (int m = 0; m < 4; ++m)
#pragma unroll
                for (int n = 0; n < 2; ++n) acc[a][b][m][n] = (f32x4){0.f, 0.f, 0.f, 0.f};
    bf16x8 At[4][2], B0[2][2], B1[2][2];
    const char* cA = (const char*)g.A + (size_t)cur.pm * tstep; const char* cB = (const char*)g.Bt + (size_t)cur.pn * tstep;
    S.a_ready(cur);
    if constexpr (SP2) {
        PG8_STAGE(PG8_SB(0, 0), cB, voffB); PG8_STAGE(PG8_SB(0, 1), cB + hstep, voffB); PG8_STAGE(PG8_SA(0, 0), cA, voffA); PG8_STAGE(PG8_SA(0, 1), cA + hstep, voffA);
        if (wr == 1) PG8_BAR;
        PG8_WAIT_V(2); PG8_BAR;
        PG8_STAGE(PG8_SB(1, 0), cB + kstep, voffB); PG8_STAGE(PG8_SA(1, 0), cA + kstep, voffA); PG8_STAGE(PG8_SB(1, 1), cB + hstep + kstep, voffB);
        PG8_WAIT_V(6); PG8_BAR;
    } else {
        PG8_STAGE(PG8_SB(0, 0), cB, voffB); PG8_STAGE(PG8_SA(0, 0), cA, voffA); PG8_STAGE(PG8_SB(0, 1), cB + hstep, voffB); PG8_STAGE(PG8_SA(0, 1), cA + hstep, voffA);
        if (wr == 1) PG8_BAR;
        PG8_WAIT_V(4); PG8_BAR;
        PG8_STAGE(PG8_SB(1, 0), cB + kstep, voffB); PG8_STAGE(PG8_SA(1, 0), cA + kstep, voffA); PG8_STAGE(PG8_SB(1, 1), cB + hstep + kstep, voffB);
        PG8_WAIT_V(6); PG8_BAR;
    }
    for (;;) {
        const bool has_next = S.next(ui + 1, nxt);
        const char* nA = has_next ? (const char*)g.A + (size_t)nxt.pm * tstep : cA; const char* nB = has_next ? (const char*)g.Bt + (size_t)nxt.pn * tstep : cB;
        for (int t = 0; t < nt; t += 2) {
            const bool last = (t == nt - 2);
            const char* a1 = cA + (size_t)(t + 1) * kstep;
            const char* a2 = last ? nA : cA + (size_t)(t + 2) * kstep; const char* b2 = last ? nB : cB + (size_t)(t + 2) * kstep;
            const char* a3 = a2 + kstep; const char* b3 = b2 + kstep;
            if (last && has_next) S.a_ready(nxt);
            if constexpr (SP2) {
            PG8_LDB(B0, 0, 0); PG8_LDB(B1, 0, 1); PG8_SCHED; PG8_LDA(At, 0, 0); PG8_STAGE(PG8_SA(1, 1), a1 + hstep, voffA);
            PG8_WAIT_V(8); PG8_WAIT_L(0); PG8_BAR; PG8_MMA(0, 0, At, B0); PG8_MMA(0, 1, At, B1); PG8_BAR; PG8_SCHED;
            PG8_LDA(At, 0, 1); PG8_STAGE(PG8_SB(0, 0), b2, voffB); PG8_STAGE(PG8_SB(0, 1), b2 + hstep, voffB); PG8_STAGE(PG8_SA(0, 0), a2, voffA);
            PG8_WAIT_V(8); PG8_WAIT_L(0); PG8_BAR; PG8_MMA(1, 0, At, B0); PG8_MMA(1, 1, At, B1); PG8_BAR; PG8_SCHED;
            PG8_LDB(B0, 1, 0); PG8_LDB(B1, 1, 1); PG8_SCHED; PG8_LDA(At, 1, 0); PG8_STAGE(PG8_SA(0, 1), a2 + hstep, voffA);
            PG8_WAIT_V(8); PG8_WAIT_L(0); PG8_BAR; PG8_MMA(0, 0, At, B0); PG8_MMA(0, 1, At, B1); PG8_BAR; PG8_SCHED;
            PG8_LDA(At, 1, 1); PG8_STAGE(PG8_SB(1, 0), b3, voffB); PG8_STAGE(PG8_SB(1, 1), b3 + hstep, voffB); PG8_STAGE(PG8_SA(1, 0), a3, voffA);
            PG8_WAIT_V(8); PG8_WAIT_L(0); PG8_BAR; PG8_MMA(1, 0, At, B0); PG8_MMA(1, 1, At, B1); PG8_BAR; PG8_SCHED;
            } else {
            PG8_LDB(B0, 0, 0); PG8_SCHED; PG8_LDA(At, 0, 0); PG8_STAGE(PG8_SA(1, 1), a1 + hstep, voffA);
            PG8_WAIT_L(8); PG8_BAR; PG8_WAIT_L(0); PG8_MMA(0, 0, At, B0); PG8_BAR; PG8_SCHED;
            PG8_LDB(B1, 0, 1); PG8_STAGE(PG8_SB(0, 0), b2, voffB);
            PG8_BAR; PG8_WAIT_L(0); PG8_MMA(0, 1, At, B1); PG8_BAR;
            PG8_LDA(At, 0, 1); PG8_STAGE(PG8_SA(0, 0), a2, voffA);
            PG8_BAR; PG8_WAIT_L(0); PG8_MMA(1, 0, At, B0); PG8_BAR; PG8_SCHED;
            PG8_STAGE(PG8_SB(0, 1), b2 + hstep, voffB);
            PG8_WAIT_V(6); PG8_BAR; PG8_MMA(1, 1, At, B1); PG8_BAR;
            PG8_LDB(B0, 1, 0); PG8_SCHED; PG8_LDA(At, 1, 0); PG8_STAGE(PG8_SA(0, 1), a2 + hstep, voffA);
            PG8_WAIT_L(8); PG8_BAR; PG8_WAIT_L(0); PG8_MMA(0, 0, At, B0); PG8_BAR; PG8_SCHED;
            PG8_LDB(B1, 1, 1); PG8_STAGE(PG8_SB(1, 0), b3, voffB);
            PG8_BAR; PG8_WAIT_L(0); PG8_MMA(0, 1, At, B1); PG8_BAR;
            PG8_LDA(At, 1, 1); PG8_STAGE(PG8_SA(1, 0), a3, voffA);
            PG8_BAR; PG8_WAIT_L(0); PG8_MMA(1, 0, At, B0); PG8_BAR; PG8_SCHED;
            PG8_STAGE(PG8_SB(1, 1), b3 + hstep, voffB);
            PG8_WAIT_V(6); PG8_BAR; PG8_MMA(1, 1, At, B1); PG8_BAR;
            }
        }
        if constexpr (ALIGN_EPI) { if (wr == 0) PG8_BAR; }
        if constexpr (!Epi::AFTER_DRAIN) { E(acc, cur, wr, wc, fr, fq); S.done(cur); }
        if (!has_next) break;
#pragma unroll
        for (int a = 0; a < 2; ++a)
#pragma unroll
            for (int b = 0; b < 2; ++b)
#pragma unroll
                for (int m = 0; m < 4; ++m)
#pragma unroll
                    for (int n = 0; n < 2; ++n) acc[a][b][m][n] = (f32x4){0.f, 0.f, 0.f, 0.f};
        cur = nxt; cA = nA; cB = nB; ++ui;
        if constexpr (ALIGN_EPI) { if (wr == 1) PG8_BAR; }
    }
    PG8_WAIT_V(0);
    if constexpr (!ALIGN_EPI) { if (wr == 0) PG8_BAR; }
    PG8_BAR;
    if constexpr (Epi::AFTER_DRAIN) { E.fused(acc, cur, wr, wc, fr, fq, lds, wid, lane); S.done(cur); }
#undef PG8_SA
#undef PG8_SB
#undef PG8_STAGE
#undef PG8_LDA
#undef PG8_LDB
#undef PG8_MMA
#undef PG8_WAIT_V
#undef PG8_WAIT_L
#undef PG8_BAR
#undef PG8_SCHED
}
}

namespace mk {
#define LAS __attribute__((address_space(3)))
#define GAS __attribute__((address_space(1)))
typedef unsigned v4u __attribute__((ext_vector_type(4)));
typedef unsigned v2u __attribute__((ext_vector_type(2)));
constexpr int NW = 8, NT = 512, LDS_BYTES = 163840, RING_BYTES = 131072;
#define LDS_WAIT() asm volatile("s_waitcnt lgkmcnt(0)" ::: "memory")
struct Args { const float* in[16]; float* out; unsigned char* ws; int ph_lo, ph_hi; };
__device__ __forceinline__ unsigned pk2(float lo, float hi) { return (unsigned)f2bf(lo) | ((unsigned)f2bf(hi) << 16); }

__device__ __forceinline__ void transpose_item(const float* W, int ld, int K, int ncols, bf16_t* WT, LAS float* scr, int item, int lane) {
    const int nblk = ncols / 32, kb = item / nblk, nb = item % nblk, k0 = 64 * kb, n0 = 32 * nb;
#pragma unroll 8
    for (int i = 0; i < 32; ++i) { const int kk = 2 * i + (lane >> 5); scr[kk * 33 + (lane & 31)] = W[(size_t)(k0 + kk) * ld + n0 + (lane & 31)]; }
    LDS_WAIT(); asm volatile("" ::: "memory");
    const int c = lane & 7;
#pragma unroll
    for (int j = 0; j < 4; ++j) { const int n = (lane >> 3) + 8 * j; const LAS float* s = scr + (8 * c) * 33 + n;
        v4u o; o.x = pk2(s[0 * 33], s[1 * 33]); o.y = pk2(s[2 * 33], s[3 * 33]); o.z = pk2(s[4 * 33], s[5 * 33]); o.w = pk2(s[6 * 33], s[7 * 33]);
        *(v4u*)(WT + (size_t)(n0 + n) * K + k0 + 8 * c) = o; }
    LDS_WAIT(); asm volatile("" ::: "memory");
}
template <bool WITH_BA>
__device__ __forceinline__ void norm_row(const float* xrow, const float* g, const float* w_in, bf16_t* orow, float* barow, int lane) {
    f32x4 v[8]; float ss = 0.f;
#pragma unroll
    for (int j = 0; j < 8; ++j) { v[j] = ((const f32x4*)xrow)[64 * j + lane]; ss += (v[j].x * v[j].x + v[j].y * v[j].y) + (v[j].z * v[j].z + v[j].w * v[j].w); }
    ss = wave_sum(ss);
    const float rstd = rsqrtf(ss * (1.f / DM) + EPS);
    float acc[16];
#pragma unroll
    for (int c = 0; c < 16; ++c) acc[c] = 0.f;
#pragma unroll
    for (int j = 0; j < 8; ++j) {
        const f32x4 gg = ((const f32x4*)g)[64 * j + lane];
        const f32x4 y = v[j] * rstd * gg;
        v2u o; o.x = pk2(y.x, y.y); o.y = pk2(y.z, y.w);
        ((v2u*)orow)[64 * j + lane] = o;
        if (WITH_BA) {
            const float* wr = w_in + (size_t)(4 * (64 * j + lane)) * INW + NPROJ;
#pragma unroll
            for (int i = 0; i < 4; ++i) {
                const float yi = (i == 0) ? y.x : (i == 1) ? y.y : (i == 2) ? y.z : y.w;
#pragma unroll
                for (int q4 = 0; q4 < 4; ++q4) { const f32x4 w4 = *(const f32x4*)(wr + (size_t)i * INW + 4 * q4);
                    acc[4 * q4] += yi * w4.x; acc[4 * q4 + 1] += yi * w4.y; acc[4 * q4 + 2] += yi * w4.z; acc[4 * q4 + 3] += yi * w4.w; }
            }
        }
    }
    if (WITH_BA) {
        float r = 0.f;
#pragma unroll
        for (int c = 0; c < 16; ++c) { const float s = wave_sum(acc[c]); if (lane == c) r = s; }
        if (lane < 16) barow[lane] = r;
    }
}
__device__ __forceinline__ void wqk_item(const float* Wq, const float* SK, bf16_t* Wqk, LAS float* lds, int item, int tid) {
    const int cbk = item >> 5, d0 = (item & 31) * 64, cb = cbk * 128, h = cbk >> 1, half = cbk & 1;
    LAS float* At = lds; LAS float* Bt = lds + 128 * 68;
    const float* skb = SK + ((size_t)(half * 8 + h) * 128) * 128;
#pragma unroll
    for (int i = 0; i < 4; ++i) { const int idx = tid + 512 * i, d = idx >> 5, k4 = idx & 31;
        const f32x4 w = *(const f32x4*)(Wq + (size_t)(d0 + d) * DM + cb + 4 * k4);
        At[(4 * k4 + 0) * 68 + d] = w.x; At[(4 * k4 + 1) * 68 + d] = w.y; At[(4 * k4 + 2) * 68 + d] = w.z; At[(4 * k4 + 3) * 68 + d] = w.w; }
#pragma unroll
    for (int i = 0; i < 8; ++i) { const int idx = tid + 512 * i, n = idx >> 5, k4 = idx & 31;
        const f32x4 w = *(const f32x4*)(skb + (size_t)n * 128 + 4 * k4);
        Bt[(4 * k4 + 0) * 132 + n] = w.x; Bt[(4 * k4 + 1) * 132 + n] = w.y; Bt[(4 * k4 + 2) * 132 + n] = w.z; Bt[(4 * k4 + 3) * 132 + n] = w.w; }
    __syncthreads();
    const int dy = tid >> 5, nx = tid & 31;
    float acc[4][4];
#pragma unroll
    for (int i = 0; i < 4; ++i)
#pragma unroll
        for (int j = 0; j < 4; ++j) acc[i][j] = 0.f;
#pragma unroll 4
    for (int kk = 0; kk < 128; ++kk) {
        const f32x4 a = *(const LAS f32x4*)(At + kk * 68 + 4 * dy), b = *(const LAS f32x4*)(Bt + kk * 132 + 4 * nx);
        acc[0][0] += a.x * b.x; acc[0][1] += a.x * b.y; acc[0][2] += a.x * b.z; acc[0][3] += a.x * b.w;
        acc[1][0] += a.y * b.x; acc[1][1] += a.y * b.y; acc[1][2] += a.y * b.z; acc[1][3] += a.y * b.w;
        acc[2][0] += a.z * b.x; acc[2][1] += a.z * b.y; acc[2][2] += a.z * b.z; acc[2][3] += a.z * b.w;
        acc[3][0] += a.w * b.x; acc[3][1] += a.w * b.y; acc[3][2] += a.w * b.z; acc[3][3] += a.w * b.w;
    }
#pragma unroll
    for (int j = 0; j < 4; ++j) { v2u o; o.x = pk2(acc[0][j], acc[1][j]); o.y = pk2(acc[2][j], acc[3][j]);
        *(v2u*)(Wqk + (size_t)(cb + 4 * nx + j) * DM + d0 + 4 * dy) = o; }
    __syncthreads();
}

__device__ __forceinline__ void table_row(const float* src, unsigned* dst, float* inv_scale, int lane) {
    f32x4 v[8]; float mx = 0.f;
#pragma unroll
    for (int j = 0; j < 8; ++j) { v[j] = ((const f32x4*)src)[64 * j + lane];
        mx = fmaxf(mx, fmaxf(fmaxf(fabsf(v[j].x), fabsf(v[j].y)), fmaxf(fabsf(v[j].z), fabsf(v[j].w)))); }
#pragma unroll
    for (int o = 1; o < 64; o <<= 1) mx = fmaxf(mx, __shfl_xor(mx, o));
    const float sc = mx > 0.f ? 128.f / mx : 1.f;
#pragma unroll
    for (int j = 0; j < 8; ++j) { int pk = __builtin_amdgcn_cvt_pk_fp8_f32(v[j].x * sc, v[j].y * sc, 0, false);
        pk = __builtin_amdgcn_cvt_pk_fp8_f32(v[j].z * sc, v[j].w * sc, pk, true); dst[64 * j + lane] = (unsigned)pk; }
    if (lane == 0) *inv_scale = mx > 0.f ? mx * (1.f / 128.f) : 1.f;
}
#ifndef PEER_FAST_REDUCE
#define PEER_FAST_REDUCE 1
#endif
typedef float f32x2 __attribute__((ext_vector_type(2)));
__device__ __forceinline__ float dpp_ror_add(float t, int) { return t; }
#define DPP_ROR_ADD(t, n) ((t) + __uint_as_float(__builtin_amdgcn_update_dpp(0u, __float_as_uint(t), 0x120 + (n), 0xf, 0xf, false)))
__device__ __forceinline__ float dot_row(const v4u& a, const v4u& b, const float (&xv)[32]) {
    float p = 0.f;
#pragma unroll
    for (int w = 0; w < 4; ++w) { const unsigned d = (w == 0) ? a.x : (w == 1) ? a.y : (w == 2) ? a.z : a.w;
        const f32x2 lo = __builtin_amdgcn_cvt_pk_f32_fp8(d, false), hi = __builtin_amdgcn_cvt_pk_f32_fp8(d, true);
        p += lo.x * xv[4 * w] + lo.y * xv[4 * w + 1] + hi.x * xv[4 * w + 2] + hi.y * xv[4 * w + 3]; }
#pragma unroll
    for (int w = 0; w < 4; ++w) { const unsigned d = (w == 0) ? b.x : (w == 1) ? b.y : (w == 2) ? b.z : b.w;
        const f32x2 lo = __builtin_amdgcn_cvt_pk_f32_fp8(d, false), hi = __builtin_amdgcn_cvt_pk_f32_fp8(d, true);
        p += lo.x * xv[16 + 4 * w] + lo.y * xv[16 + 4 * w + 1] + hi.x * xv[16 + 4 * w + 2] + hi.y * xv[16 + 4 * w + 3]; }
    return p;
}
__device__ __forceinline__ void axpy_row(const v4u& a, const v4u& b, float wgt, float (&y)[32]) {
#pragma unroll
    for (int w = 0; w < 4; ++w) { const unsigned d = (w == 0) ? a.x : (w == 1) ? a.y : (w == 2) ? a.z : a.w;
        const f32x2 lo = __builtin_amdgcn_cvt_pk_f32_fp8(d, false), hi = __builtin_amdgcn_cvt_pk_f32_fp8(d, true);
        y[4 * w] += wgt * lo.x; y[4 * w + 1] += wgt * lo.y; y[4 * w + 2] += wgt * hi.x; y[4 * w + 3] += wgt * hi.y; }
#pragma unroll
    for (int w = 0; w < 4; ++w) { const unsigned d = (w == 0) ? b.x : (w == 1) ? b.y : (w == 2) ? b.z : b.w;
        const f32x2 lo = __builtin_amdgcn_cvt_pk_f32_fp8(d, false), hi = __builtin_amdgcn_cvt_pk_f32_fp8(d, true);
        y[16 + 4 * w] += wgt * lo.x; y[16 + 4 * w + 1] += wgt * lo.y; y[16 + 4 * w + 2] += wgt * hi.x; y[16 + 4 * w + 3] += wgt * hi.y; }
}

#define DPP_ROR_MAX(t, n) fmaxf((t), __uint_as_float(__builtin_amdgcn_update_dpp(0u, __float_as_uint(t), 0x120 + (n), 0xf, 0xf, false)))
#define CSWAP(a, b) do { const float hi_ = fmaxf(a, b), lo_ = fminf(a, b); a = hi_; b = lo_; } while (0)
__device__ __forceinline__ void topk_token_fast(const float* __restrict__ srow, int lane, const float* inv_su, const float* inv_sv,
                                                LAS int* se, LAS float* sa, LAS float* sb) {
    const int l16 = lane & 15, row = lane >> 4;
    float R[4];
#pragma unroll
    for (int ps = 0; ps < 4; ++ps) {
        const f32x4 v0 = *(const f32x4*)(srow + (4 * ps + row) * 128 + 8 * l16), v1 = *(const f32x4*)(srow + (4 * ps + row) * 128 + 8 * l16 + 4);
        float k[8];
        k[0] = v0.x; k[1] = v0.y; k[2] = v0.z; k[3] = v0.w; k[4] = v1.x; k[5] = v1.y; k[6] = v1.z; k[7] = v1.w;
#pragma unroll
        for (int i = 0; i < 8; ++i) k[i] = __uint_as_float((__float_as_uint(k[i]) & 0xFFFFFF80u) | (unsigned)(8 * l16 + i));
        CSWAP(k[0], k[1]); CSWAP(k[2], k[3]); CSWAP(k[4], k[5]); CSWAP(k[6], k[7]);
        CSWAP(k[0], k[2]); CSWAP(k[1], k[3]); CSWAP(k[4], k[6]); CSWAP(k[5], k[7]);
        CSWAP(k[1], k[2]); CSWAP(k[5], k[6]);
        CSWAP(k[0], k[4]); CSWAP(k[1], k[5]); CSWAP(k[2], k[6]); CSWAP(k[3], k[7]);
        CSWAP(k[2], k[4]); CSWAP(k[3], k[5]);
        CSWAP(k[1], k[2]); CSWAP(k[3], k[4]); CSWAP(k[5], k[6]);
        float res = 0.f;
#pragma unroll
        for (int it = 0; it < 16; ++it) {
            float m = k[0];
            m = DPP_ROR_MAX(m, 8); m = DPP_ROR_MAX(m, 4); m = DPP_ROR_MAX(m, 2); m = DPP_ROR_MAX(m, 1);
            const bool own = (k[0] == m);
#pragma unroll
            for (int i = 0; i < 7; ++i) k[i] = own ? k[i + 1] : k[i];
            k[7] = own ? -INFINITY : k[7];
            res = (l16 == it) ? m : res;
        }
        R[ps] = res;
    }
#pragma unroll
    for (int g = 0; g < 2; ++g) {
        const auto sw = __builtin_amdgcn_permlane16_swap(__float_as_uint(R[2 * g]), __float_as_uint(R[2 * g + 1]), false, false);
        const float X = __uint_as_float(sw[0]), Y = __uint_as_float(sw[1]);
        const float a = __uint_as_float(__float_as_uint(X) & 0xFFFFFF80u);
        int j = 0;
        float v2 = __shfl(Y, (lane & 48));
        float best = 0.f;
#pragma unroll
        for (int it = 0; it < 16; ++it) {
            const float sum = a + __uint_as_float(__float_as_uint(v2) & 0xFFFFFF80u);
            const float cand = (j < 16) ? __uint_as_float((__float_as_uint(sum) & 0xFFFFFF00u) | (unsigned)((l16 << 4) | (j & 15))) : -INFINITY;
            float m = cand;
            m = DPP_ROR_MAX(m, 8); m = DPP_ROR_MAX(m, 4); m = DPP_ROR_MAX(m, 2); m = DPP_ROR_MAX(m, 1);
            best = (l16 == it) ? m : best;
            if (it < 15) { j += (cand == m) ? 1 : 0; v2 = __shfl(Y, (lane & 48) + (j & 15)); }
        }
        const unsigned bb = __float_as_uint(best);
        const int bi = (bb >> 4) & 15, bj = bb & 15;
        const unsigned k1 = __float_as_uint(__shfl(X, (lane & 48) + bi)), k2 = __float_as_uint(__shfl(Y, (lane & 48) + bj));
        const int e = (int)(k1 & 127u) * 128 + (int)(k2 & 127u);
        const float bv = __uint_as_float(bb & 0xFFFFFF00u);
        float mx = bv; mx = DPP_ROR_MAX(mx, 8); mx = DPP_ROR_MAX(mx, 4); mx = DPP_ROR_MAX(mx, 2); mx = DPP_ROR_MAX(mx, 1);
        const float ex = __expf(bv - mx);
        float sm = ex; sm = DPP_ROR_ADD(sm, 8); sm = DPP_ROR_ADD(sm, 4); sm = DPP_ROR_ADD(sm, 2); sm = DPP_ROR_ADD(sm, 1);
        const float gate = ex / sm;
        const int head = 4 * g + ((row & 1) * 2 + (row >> 1));
        se[head * 16 + l16] = e; sa[head * 16 + l16] = inv_su[e]; sb[head * 16 + l16] = gate * inv_sv[e];
    }
}
#define PEER_LOAD(DST, TAB, b) do { _Pragma("unroll") for (int r_ = 0; r_ < 4; ++r_) { const unsigned char* rp_ = (TAB) + (size_t)(unsigned)__builtin_amdgcn_readfirstlane(se[4 * (b) + r_]) * 2048 + 16 * lane; \
        DST[r_][0] = *(const v4u*)rp_; DST[r_][1] = *(const v4u*)(rp_ + 1024); } } while (0)
__device__ __forceinline__ void peer_token(int t, const float* scores, const bf16_t* hn, const float* hbuf, const unsigned char* U8, const unsigned char* V8,
                                           const float* inv_su, const float* inv_sv, const float* gfin, float* out,
                                           LAS int* se, LAS float* sa, LAS float* sb, int lane) {
    topk_token_fast(scores + (size_t)t * DM, lane, inv_su, inv_sv, se, sa, sb);
    float xv[32], y[32];
#pragma unroll
    for (int j = 0; j < 2; ++j) {
        const v4u h0 = *(const v4u*)(hn + (size_t)t * DM + 1024 * j + 16 * lane), h1 = *(const v4u*)(hn + (size_t)t * DM + 1024 * j + 16 * lane + 8);
#pragma unroll
        for (int w = 0; w < 4; ++w) { const unsigned d0 = (w == 0) ? h0.x : (w == 1) ? h0.y : (w == 2) ? h0.z : h0.w, d1 = (w == 0) ? h1.x : (w == 1) ? h1.y : (w == 2) ? h1.z : h1.w;
            xv[16 * j + 2 * w] = __uint_as_float(d0 << 16); xv[16 * j + 2 * w + 1] = __uint_as_float(d0 & 0xffff0000u);
            xv[16 * j + 8 + 2 * w] = __uint_as_float(d1 << 16); xv[16 * j + 8 + 2 * w + 1] = __uint_as_float(d1 & 0xffff0000u); }
    }
#pragma unroll
    for (int i = 0; i < 32; ++i) y[i] = 0.f;
    v4u U[4][2], V[4][2];
    PEER_LOAD(U, U8, 0);
#pragma unroll 1
    for (int b = 0; b < 32; ++b) {
        PEER_LOAD(V, V8, b);
        float pr[4];
#pragma unroll
        for (int r = 0; r < 4; ++r) pr[r] = dot_row(U[r][0], U[r][1], xv);
        if (b + 1 < 32) PEER_LOAD(U, U8, b + 1);
        float wr_[4];
#if PEER_FAST_REDUCE
        float q2[2];
#pragma unroll
        for (int r = 0; r < 2; ++r) { auto sw = __builtin_amdgcn_permlane32_swap(__float_as_uint(pr[r]), __float_as_uint(pr[r + 2]), false, false); q2[r] = __uint_as_float(sw[0]) + __uint_as_float(sw[1]); }
        float tv;
        { auto sw = __builtin_amdgcn_permlane16_swap(__float_as_uint(q2[0]), __float_as_uint(q2[1]), false, false); tv = __uint_as_float(sw[0]) + __uint_as_float(sw[1]); }
        tv = DPP_ROR_ADD(tv, 8); tv = DPP_ROR_ADD(tv, 4); tv = DPP_ROR_ADD(tv, 2); tv = DPP_ROR_ADD(tv, 1);
        const int k = 4 * b + (lane >> 4);
        const float wc = gelu_erf(tv * sa[k]) * sb[k];
#pragma unroll
        for (int r = 0; r < 4; ++r) wr_[r] = __uint_as_float(__builtin_amdgcn_readlane(__float_as_uint(wc), 16 * r));
#else
#pragma unroll
        for (int r = 0; r < 4; ++r) { const float tv = wave_sum(pr[r]); wr_[r] = gelu_erf(tv * sa[4 * b + r]) * sb[4 * b + r]; }
#endif
#pragma unroll
        for (int r = 0; r < 4; ++r) axpy_row(V[r][0], V[r][1], wr_[r], y);
    }
    float ss = 0.f;
#pragma unroll
    for (int j = 0; j < 2; ++j)
#pragma unroll
        for (int w = 0; w < 4; ++w) { const f32x4 hv = *(const f32x4*)(hbuf + (size_t)t * DM + 1024 * j + 16 * lane + 4 * w);
            y[16 * j + 4 * w] += hv.x; y[16 * j + 4 * w + 1] += hv.y; y[16 * j + 4 * w + 2] += hv.z; y[16 * j + 4 * w + 3] += hv.w;
            ss += (y[16 * j + 4 * w] * y[16 * j + 4 * w] + y[16 * j + 4 * w + 1] * y[16 * j + 4 * w + 1]) + (y[16 * j + 4 * w + 2] * y[16 * j + 4 * w + 2] + y[16 * j + 4 * w + 3] * y[16 * j + 4 * w + 3]); }
    ss = wave_sum(ss);
    const float rstd = rsqrtf(ss * (1.f / DM) + EPS);
#pragma unroll
    for (int j = 0; j < 2; ++j)
#pragma unroll
        for (int w = 0; w < 4; ++w) { const f32x4 gg = *(const f32x4*)(gfin + 1024 * j + 16 * lane + 4 * w);
            f32x4 o; o.x = y[16 * j + 4 * w] * rstd * gg.x; o.y = y[16 * j + 4 * w + 1] * rstd * gg.y; o.z = y[16 * j + 4 * w + 2] * rstd * gg.z; o.w = y[16 * j + 4 * w + 3] * rstd * gg.w;
            *(f32x4*)(out + (size_t)t * DM + 1024 * j + 16 * lane + 4 * w) = o; }
}
typedef short bf16x8 __attribute__((ext_vector_type(8)));
__device__ __forceinline__ int pos32(int x) { const int g = x & ~31, l = x & 31; return g + 8 * ((l & 15) >> 2) + 4 * (l >> 4) + (l & 3); }
constexpr size_t PB_H_QG = 0, PB_H_KDT = 32 * MiB, PB_H_A = 64 * MiB;
constexpr size_t PB_G_QS = 80 * MiB, PB_G_KT = 96 * MiB;
constexpr size_t PB_G_W = 112 * MiB, PB_G_A = 144 * MiB, PB_G_U = 160 * MiB;
constexpr int SC_QG = 0, SC_WV = 16384, SC_KDT = 32768, SC_A = 49152, SC_BUF = 57344, SC_VEC = 2 * SC_BUF, SC_OT = SC_VEC + 2048, SC_OTB = 17408, SC_GAIN = SC_OT + 2 * SC_OTB;

__device__ __forceinline__ bf16x8 pack_frag(const f32x4& x0, const f32x4& x1) {
    v4u w; w.x = pk2(x0.x, x0.y); w.y = pk2(x0.z, x0.w); w.z = pk2(x1.x, x1.y); w.w = pk2(x1.z, x1.w);
    return __builtin_bit_cast(bf16x8, w);
}
#define MFMA16(a, b, c) __builtin_amdgcn_mfma_f32_16x16x32_bf16((a), (b), (c), 0, 0, 0)

__device__ __forceinline__ void hgrn_prep_item(int item, const bf16_t* proj, const float* lb_logits, unsigned char* pb, float* vecs, LAS unsigned char* lds, int tid) {
    const int c = item & 127, sq = item >> 7, b = sq >> 3, h = sq & 7, t0 = b * SEQ + c * 64;
    const int d = tid & 127, seg = tid >> 7, lane = tid & 63, wave = tid >> 6;
    LAS bf16_t* QGl = (LAS bf16_t*)lds; LAS bf16_t* KGl = (LAS bf16_t*)(lds + 17408); LAS float* segsum = (LAS float*)(lds + 34816);
    bf16_t* gQG = (bf16_t*)(pb + PB_H_QG) + (size_t)item * 8192;
    bf16_t* gKDT = (bf16_t*)(pb + PB_H_KDT) + (size_t)item * 8192;
    bf16_t* gA = (bf16_t*)(pb + PB_H_A) + (size_t)item * 4096;
    float* gvec = vecs + (size_t)item * 256;
    const float l0 = lb_logits[h * 128 + d], l1 = lb_logits[1024 + h * 128 + d];
    const float lb = 1.f / (1.f + __expf(l1 - l0));
    float lf[16], qv[16], kv[16];
#pragma unroll
    for (int i = 0; i < 16; ++i) {
        const bf16_t* pr = proj + (size_t)(t0 + 16 * seg + i) * NPROJ + h * 128 + d;
        const float z = bf2f(pr[C_AF]); qv[i] = bf2f(pr[C_AQ]);
        const float f = lb + (1.f - lb) * sigmoidf_(z);
        lf[i] = __logf(f); kv[i] = 1.f - f;
    }
    float run = 0.f;
#pragma unroll
    for (int i = 0; i < 16; ++i) { run += lf[i]; lf[i] = run; }
    segsum[seg * 128 + d] = run;
    __syncthreads();
    float off = 0.f, bl = 0.f;
#pragma unroll
    for (int s = 0; s < 4; ++s) { const float v = segsum[s * 128 + d]; bl += v; if (s < seg) off += v; }
    const int pd = pos32(d);
    float kd[16];
#pragma unroll
    for (int i = 0; i < 16; ++i) {
        const float bc = lf[i] + off; const int tl = 16 * seg + i;
        const float qg = qv[i] * __expf(bc), kg = kv[i] * __expf(-bc);
        kd[i] = kv[i] * __expf(bl - bc);
        const bf16_t qb = f2bf(qg);
        QGl[tl * 136 + d] = qb; KGl[tl * 136 + d] = f2bf(kg);
        gQG[tl * 128 + pd] = qb;
    }
#pragma unroll
    for (int ii = 0; ii < 4; ++ii) { v2u o; o.x = pk2(kd[4 * ii], kd[4 * ii + 1]); o.y = pk2(kd[4 * ii + 2], kd[4 * ii + 3]);
        *(v2u*)(gKDT + d * 64 + 32 * (seg >> 1) + 8 * ii + 4 * (seg & 1)) = o; }
    if (seg == 0) gvec[128 + d] = __expf(bl);
    __syncthreads();
    const int n = lane & 15, q = lane >> 4;
#pragma unroll
    for (int ti = 0; ti < 2; ++ti) {
        const int id = wave + 8 * ti, mt = id >> 2, ns = id & 3;
        f32x4 acc = {0.f, 0.f, 0.f, 0.f};
        if (ns <= mt) {
#pragma unroll
            for (int s4 = 0; s4 < 4; ++s4) {
                const bf16x8 a = *(const LAS bf16x8*)(QGl + (16 * mt + n) * 136 + 32 * s4 + 8 * q);
                const bf16x8 bb = *(const LAS bf16x8*)(KGl + (16 * ns + n) * 136 + 32 * s4 + 8 * q);
                acc = MFMA16(a, bb, acc);
            }
        }
        const int s = 16 * ns + n, ps = pos32(s);
#pragma unroll
        for (int r = 0; r < 4; ++r) { const int t = 16 * mt + 4 * q + r; const float v = (r == 0) ? acc.x : (r == 1) ? acc.y : (r == 2) ? acc.z : acc.w;
            gA[t * 64 + ps] = f2bf((s <= t) ? v : 0.f); }
    }
    __syncthreads();
}

constexpr int GP_QF = 0, GP_KF = 33024, GP_N = 0, GP_QB = 66048, GP_KB = 83456, GP_VB = 100864, GP_PART = 135680, GP_SB = 137728;
__device__ __forceinline__ void gdn_prep_item(int item, const bf16_t* proj, const float* ba, const float* conv_w, const float* A_log, const float* dt_bias,
                                              unsigned char* pb, float* vecs, LAS unsigned char* lds, int tid) {
    const int c = item & 127, bq = item >> 7, b = bq >> 2, qh = bq & 3, t0 = b * SEQ + c * 64;
    const int lane = tid & 63, wave = tid >> 6;
    LAS float* QF = (LAS float*)(lds + GP_QF); LAS float* KF = (LAS float*)(lds + GP_KF);
    LAS bf16_t* QB = (LAS bf16_t*)(lds + GP_QB); LAS bf16_t* KB = (LAS bf16_t*)(lds + GP_KB); LAS bf16_t* VB = (LAS bf16_t*)(lds + GP_VB);
    LAS float* PART = (LAS float*)(lds + GP_PART); LAS float* SBETA = (LAS float*)(lds + GP_SB); LAS float* SGC = SBETA + 128;
    LAS float* NM = (LAS float*)(lds + GP_N);
    {
        int col, wch; const int dd = tid & 127;
        if (tid < 128) { col = C_BQ + qh * 128 + dd; wch = qh * 128 + dd; }
        else if (tid < 256) { col = C_BK + qh * 128 + dd; wch = 512 + qh * 128 + dd; }
        else { const int vh = 2 * qh + ((tid - 256) >> 7); col = C_BV + vh * 128 + dd; wch = 1024 + vh * 128 + dd; }
        const float w0 = conv_w[wch], w1 = conv_w[2048 + wch], w2 = conv_w[4096 + wch], w3 = conv_w[6144 + wch];
        float h0 = 0.f, h1 = 0.f, h2 = 0.f;
        const bf16_t* pr = proj + (size_t)t0 * NPROJ + col;
        if (c > 0) { h0 = bf2f(pr[-3 * NPROJ]); h1 = bf2f(pr[-2 * NPROJ]); h2 = bf2f(pr[-1 * NPROJ]); }
#pragma unroll 8
        for (int t = 0; t < 64; ++t) {
            const float xx = bf2f(pr[(size_t)t * NPROJ]);
            const float yv = siluf_(w0 * h0 + w1 * h1 + w2 * h2 + w3 * xx);
            h0 = h1; h1 = h2; h2 = xx;
            if (tid < 128) QF[t * 129 + dd] = yv;
            else if (tid < 256) KF[t * 129 + dd] = yv;
            else VB[((tid - 256) >> 7) * 8704 + t * 136 + dd] = f2bf(yv);
        }
    }
    __syncthreads();
    {
        const int t = tid & 63, part = tid >> 6, which = part >> 2, sub = part & 3;
        const LAS float* src = (which ? KF : QF) + t * 129 + 32 * sub;
        float s = 0.f;
#pragma unroll
        for (int i = 0; i < 32; ++i) s += src[i] * src[i];
        PART[(which * 4 + sub) * 64 + t] = s;
    }
    if (wave < 2) {
        const int vh = 2 * qh + wave;
        const float ax = ba[(size_t)(t0 + lane) * 16 + 8 + vh] + dt_bias[vh];
        const float sp = ax > 20.f ? ax : log1pf(__expf(ax));
        float gc = -__expf(A_log[vh]) * sp;
#pragma unroll
        for (int o = 1; o < 64; o <<= 1) { const float up = __shfl_up(gc, o); if (lane >= o) gc += up; }
        const float gl = __shfl(gc, 63);
        const float beta = sigmoidf_(ba[(size_t)(t0 + lane) * 16 + vh]);
        SBETA[wave * 64 + lane] = beta; SGC[wave * 64 + lane] = gc;
        float* gvec = vecs + ((size_t)(16 + b * 8 + vh) * 128 + c) * 256;
        gvec[lane] = __expf(gc); gvec[64 + lane] = __expf(gl - gc);
        const float dl = __expf(gl); gvec[128 + lane] = dl; gvec[192 + lane] = dl;
    }
    __syncthreads();
    {
        const int d = tid & 127, seg = tid >> 7, pd = pos32(d);
        bf16_t* gQS = (bf16_t*)(pb + PB_G_QS) + (size_t)item * 8192;
        bf16_t* gKT = (bf16_t*)(pb + PB_G_KT) + (size_t)item * 8192;
        float kk[16];
#pragma unroll
        for (int i = 0; i < 16; ++i) {
            const int tl = 16 * seg + i;
            const float sq = PART[0 * 64 + tl] + PART[1 * 64 + tl] + PART[2 * 64 + tl] + PART[3 * 64 + tl];
            const float sk = PART[4 * 64 + tl] + PART[5 * 64 + tl] + PART[6 * 64 + tl] + PART[7 * 64 + tl];
            const bf16_t qb = f2bf(QF[tl * 129 + d] * rsqrtf(sq + EPS) * 0.08838834764831845f);
            const bf16_t kb = f2bf(KF[tl * 129 + d] * rsqrtf(sk + EPS));
            QB[tl * 136 + d] = qb; KB[tl * 136 + d] = kb; gQS[tl * 128 + pd] = qb; kk[i] = bf2f(kb);
        }
#pragma unroll
        for (int ii = 0; ii < 4; ++ii) { v2u o; o.x = pk2(kk[4 * ii], kk[4 * ii + 1]); o.y = pk2(kk[4 * ii + 2], kk[4 * ii + 3]);
            *(v2u*)(gKT + d * 64 + 32 * (seg >> 1) + 8 * ii + 4 * (seg & 1)) = o; }
    }
    __syncthreads();
    {
        const int n = lane & 15, q = lane >> 4;
#pragma unroll
        for (int ti = 0; ti < 2; ++ti) {
            const int id = 2 * wave + ti, mt = id >> 2, ns = id & 3;
            f32x4 akk = {0.f, 0.f, 0.f, 0.f}, aqk = {0.f, 0.f, 0.f, 0.f};
            if (ns <= mt) {
#pragma unroll
                for (int s4 = 0; s4 < 4; ++s4) {
                    const bf16x8 kb_ = *(const LAS bf16x8*)(KB + (16 * ns + n) * 136 + 32 * s4 + 8 * q);
                    const bf16x8 ka_ = *(const LAS bf16x8*)(KB + (16 * mt + n) * 136 + 32 * s4 + 8 * q);
                    const bf16x8 qa_ = *(const LAS bf16x8*)(QB + (16 * mt + n) * 136 + 32 * s4 + 8 * q);
                    akk = MFMA16(ka_, kb_, akk); aqk = MFMA16(qa_, kb_, aqk);
                }
            }
            const int s = 16 * ns + n, ps = pos32(s);
#pragma unroll
            for (int vl = 0; vl < 2; ++vl) {
                bf16_t* gA = (bf16_t*)(pb + PB_G_A) + ((size_t)((b * 8 + 2 * qh + vl) * 128 + c)) * 4096;
                const float gcs = SGC[vl * 64 + s];
#pragma unroll
                for (int r = 0; r < 4; ++r) {
                    const int t = 16 * mt + 4 * q + r;
                    const float vk = (r == 0) ? akk.x : (r == 1) ? akk.y : (r == 2) ? akk.z : akk.w;
                    const float vq = (r == 0) ? aqk.x : (r == 1) ? aqk.y : (r == 2) ? aqk.z : aqk.w;
                    const float ex = (s <= t) ? __expf(SGC[vl * 64 + t] - gcs) : 0.f;
                    NM[vl * 4096 + t * 64 + s] = (s < t) ? SBETA[vl * 64 + t] * vk * ex : 0.f;
                    gA[t * 64 + ps] = f2bf((s <= t) ? vq * ex : 0.f);
                }
            }
        }
    }
    __syncthreads();
    {
        const int vl = tid >> 8, colx = tid & 255;
        float x[64];
        if (colx < 128) {
#pragma unroll
            for (int t = 0; t < 64; ++t) x[t] = SBETA[vl * 64 + t] * bf2f(VB[vl * 8704 + t * 136 + colx]);
        } else {
#pragma unroll
            for (int t = 0; t < 64; ++t) x[t] = SBETA[vl * 64 + t] * __expf(SGC[vl * 64 + t]) * bf2f(KB[t * 136 + colx - 128]);
        }
        __syncthreads();
        const LAS float* Nv = NM + vl * 4096;
#pragma unroll
        for (int t = 1; t < 64; ++t) {
            float acc = x[t];
#pragma unroll
            for (int s4 = 0; s4 < (t + 3) / 4; ++s4) {
                const f32x4 nn = *(const LAS f32x4*)(Nv + t * 64 + 4 * s4);
                acc -= nn.x * x[4 * s4]; if (4 * s4 + 1 < t) acc -= nn.y * x[4 * s4 + 1]; if (4 * s4 + 2 < t) acc -= nn.z * x[4 * s4 + 2]; if (4 * s4 + 3 < t) acc -= nn.w * x[4 * s4 + 3];
            }
            x[t] = acc;
        }
        if (colx < 128) {
            bf16_t* gU = (bf16_t*)(pb + PB_G_U) + ((size_t)((b * 8 + 2 * qh + vl) * 128 + c)) * 8192;
            const int sl = colx >> 4, n = colx & 15;
#pragma unroll
            for (int mt = 0; mt < 4; ++mt)
#pragma unroll
                for (int q = 0; q < 4; ++q) { v2u o; o.x = pk2(x[16 * mt + 4 * q], x[16 * mt + 4 * q + 1]); o.y = pk2(x[16 * mt + 4 * q + 2], x[16 * mt + 4 * q + 3]);
                    *(v2u*)(gU + ((size_t)((sl * 4 + mt) * 64 + q * 16 + n)) * 4) = o; }
        } else {
            LAS bf16_t* WS = (LAS bf16_t*)(lds + GP_QB) + vl * 8704;
            const int pd = pos32(colx - 128);
#pragma unroll
            for (int t = 0; t < 64; ++t) WS[t * 136 + pd] = f2bf(-x[t]);
        }
    }
    __syncthreads();
    {
#pragma unroll
        for (int i = 0; i < 4; ++i) { const int p = tid + 512 * i, vl = p >> 10, row = (p >> 4) & 63, c16 = p & 15;
            bf16_t* gW = (bf16_t*)(pb + PB_G_W) + ((size_t)((b * 8 + 2 * qh + vl) * 128 + c)) * 8192;
            *(v4u*)(gW + row * 128 + c16 * 8) = *(const LAS v4u*)(lds + GP_QB + vl * 17408 + row * 272 + c16 * 16); }
    }
    __syncthreads();
}

struct ScanSrc { const unsigned char* qg; const unsigned char* wv; const unsigned char* kdt; const unsigned char* a; const float* vec; size_t wv_row; };
__device__ __forceinline__ void scan_dma(const ScanSrc& S, LAS unsigned char* buf, LAS unsigned char* vecb, int w, int lane) {
#pragma unroll
    for (int i = 0; i < 2; ++i) { const int pi = 2 * w + i, row = 4 * pi + (lane >> 4), cl = (lane & 15) ^ (row & 15);
        __builtin_amdgcn_global_load_lds((const unsigned*)(S.qg + row * 256 + cl * 16), (LAS unsigned*)(buf + SC_QG + pi * 1024), 16, 0, 0);
        __builtin_amdgcn_global_load_lds((const unsigned*)(S.wv + (size_t)row * S.wv_row + cl * 16), (LAS unsigned*)(buf + SC_WV + pi * 1024), 16, 0, 0); }
#pragma unroll
    for (int i = 0; i < 2; ++i) { const int pi = 2 * w + i, row = 8 * pi + (lane >> 3), cl = (lane & 7) ^ ((row >> 1) & 7);
        __builtin_amdgcn_global_load_lds((const unsigned*)(S.kdt + row * 128 + cl * 16), (LAS unsigned*)(buf + SC_KDT + pi * 1024), 16, 0, 0); }
    { const int pi = w, row = 8 * pi + (lane >> 3), cl = (lane & 7) ^ ((row >> 1) & 7);
        __builtin_amdgcn_global_load_lds((const unsigned*)(S.a + row * 128 + cl * 16), (LAS unsigned*)(buf + SC_A + pi * 1024), 16, 0, 0); }
    if (w == 0) __builtin_amdgcn_global_load_lds((const unsigned*)((const unsigned char*)S.vec + lane * 16), (LAS unsigned*)vecb, 16, 0, 0);
}
__device__ __forceinline__ void scan_block(int sq, const bf16_t* proj, const unsigned char* pb, const float* vecs, const float* hgrn_g, const float* gdn_g,
                                           bf16_t* mix, LAS unsigned char* lds, int tid) {
    const bool gdn = sq >= 16;
    const int b = (sq & 15) >> 3, hh = sq & 7, lane = tid & 63, sl = __builtin_amdgcn_readfirstlane(tid >> 6), n = lane & 15, q = lane >> 4;
    const unsigned char* bQG; const unsigned char* bWV; const unsigned char* bKDT; const unsigned char* bA; const unsigned char* bU = nullptr;
    size_t wv_row, wv_chunk; int gate_col, mix_col; const float* gain;
    if (!gdn) {
        const size_t s0 = (size_t)(b * 8 + hh) * 128;
        bQG = pb + PB_H_QG + s0 * 16384; bKDT = pb + PB_H_KDT + s0 * 16384; bA = pb + PB_H_A + s0 * 8192;
        bWV = (const unsigned char*)(proj + (size_t)(b * SEQ) * NPROJ + C_AI + hh * 128); wv_row = (size_t)NPROJ * 2; wv_chunk = (size_t)64 * NPROJ * 2;
        gate_col = C_AG + hh * 128; mix_col = hh * 128; gain = hgrn_g;
    } else {
        const size_t s0 = (size_t)(b * 8 + hh) * 128, q0 = (size_t)(b * 4 + (hh >> 1)) * 128;
        bQG = pb + PB_G_QS + q0 * 16384; bKDT = pb + PB_G_KT + q0 * 16384; bA = pb + PB_G_A + s0 * 8192;
        bWV = pb + PB_G_W + s0 * 16384; wv_row = 256; wv_chunk = 16384; bU = pb + PB_G_U + s0 * 16384;
        gate_col = C_BZ + hh * 128; mix_col = 1024 + hh * 128; gain = gdn_g;
    }
    const float* bvec = vecs + (size_t)sq * 128 * 256;
    LAS float* gainl = (LAS float*)(lds + SC_GAIN);
    const int rt = tid >> 3, cg8 = tid & 7;
    f32x4 S[8];
#pragma unroll
    for (int m = 0; m < 8; ++m) S[m] = (f32x4){0.f, 0.f, 0.f, 0.f};
    v2u Ucur[4];
    {
        ScanSrc src{bQG, bWV, bKDT, bA, bvec, wv_row};
        scan_dma(src, lds, lds + SC_VEC, sl, lane);
        if (gdn) {
#pragma unroll
            for (int mt = 0; mt < 4; ++mt) Ucur[mt] = *(const v2u*)(bU + (size_t)(sl * 4 + mt) * 512 + lane * 8);
        } else {
#pragma unroll
            for (int mt = 0; mt < 4; ++mt) Ucur[mt] = (v2u){0u, 0u};
        }
        if (tid < 128) gainl[tid] = gain[tid];
    }
    asm volatile("s_waitcnt vmcnt(0)" ::: "memory");
    __syncthreads();
    for (int c = 0; c < 128; ++c) {
        const int cur = c & 1;
        LAS unsigned char* buf = lds + cur * SC_BUF;
        const LAS float* vec = (const LAS float*)(lds + SC_VEC + cur * 1024);
        const int t0 = b * SEQ + c * 64;
        const int cn = (c + 1 < 128) ? c + 1 : 127;
        { ScanSrc src{bQG + (size_t)cn * 16384, bWV + (size_t)cn * wv_chunk, bKDT + (size_t)cn * 16384, bA + (size_t)cn * 8192, bvec + (size_t)cn * 256, wv_row};
            scan_dma(src, lds + (cur ^ 1) * SC_BUF, lds + SC_VEC + (cur ^ 1) * 1024, sl, lane); }
        v2u Unx[4];
        if (gdn) {
#pragma unroll
            for (int mt = 0; mt < 4; ++mt) Unx[mt] = *(const v2u*)(bU + (size_t)cn * 16384 + (size_t)(sl * 4 + mt) * 512 + lane * 8);
        } else {
#pragma unroll
            for (int mt = 0; mt < 4; ++mt) Unx[mt] = (v2u){0u, 0u};
        }
        const bf16_t* gp = proj + (size_t)(t0 + rt) * NPROJ + gate_col + 16 * cg8;
        const v4u gt0 = *(const v4u*)gp, gt1 = *(const v4u*)(gp + 8);
        bf16x8 Sf[4];
#pragma unroll
        for (int s = 0; s < 4; ++s) Sf[s] = pack_frag(S[2 * s], S[2 * s + 1]);
        f32x4 O[4], VN[4];
        bf16x8 VNf[2], VNSf[2];
        bf16x8 fa[4], fb[4];
#define SCAN_LD4_K128(dst, OFF, mt_) do { _Pragma("unroll") for (int i_ = 0; i_ < 4; ++i_) dst[i_] = *(const LAS bf16x8*)(buf + (OFF) + (16 * (mt_) + n) * 256 + (((4 * i_ + q) ^ n) * 16)); } while (0)
#define SCAN_LD4_K64(dst, OFF, mb) do { _Pragma("unroll") for (int i_ = 0; i_ < 4; ++i_) dst[i_] = *(const LAS bf16x8*)(buf + (OFF) + (16 * ((mb) + (i_ >> 1)) + n) * 128 + (((4 * (i_ & 1) + q) ^ ((n >> 1) & 7)) * 16)); } while (0)
#define SCHED_FENCE() __builtin_amdgcn_sched_barrier(0)
#define MM4_K128(ACC, fr) do { _Pragma("unroll") for (int i_ = 0; i_ < 4; ++i_) ACC = MFMA16(fr[i_], Sf[i_], ACC); } while (0)
#pragma unroll
        for (int mt = 0; mt < 4; ++mt) O[mt] = (f32x4){0.f, 0.f, 0.f, 0.f};
        if (gdn) {
            SCAN_LD4_K128(fa, SC_WV, 0); SCHED_FENCE();
            SCAN_LD4_K128(fb, SC_WV, 1); SCHED_FENCE();
#pragma unroll
            for (int mt = 0; mt < 4; ++mt) { const v2u uu = Ucur[mt];
                VN[mt] = (f32x4){__uint_as_float(uu.x << 16), __uint_as_float(uu.x & 0xffff0000u), __uint_as_float(uu.y << 16), __uint_as_float(uu.y & 0xffff0000u)}; }
            MM4_K128(VN[0], fa); SCHED_FENCE(); SCAN_LD4_K128(fa, SC_WV, 2); SCHED_FENCE();
            MM4_K128(VN[1], fb); SCHED_FENCE(); SCAN_LD4_K128(fb, SC_WV, 3); SCHED_FENCE();
            MM4_K128(VN[2], fa); SCHED_FENCE(); SCAN_LD4_K128(fa, SC_QG, 0); SCHED_FENCE();
            MM4_K128(VN[3], fb); SCHED_FENCE(); SCAN_LD4_K128(fb, SC_QG, 1); SCHED_FENCE();
        } else {
            SCAN_LD4_K128(fa, SC_QG, 0); SCHED_FENCE();
            SCAN_LD4_K128(fb, SC_QG, 1); SCHED_FENCE();
#pragma unroll
            for (int s2 = 0; s2 < 2; ++s2) { unsigned w[4];
#pragma unroll
                for (int jj = 0; jj < 4; ++jj) { const int ja = 2 * jj, jb = 2 * jj + 1;
                    const int ta = 32 * s2 + ((ja < 4) ? 4 * q + ja : 16 + 4 * q + ja - 4), tb = 32 * s2 + ((jb < 4) ? 4 * q + jb : 16 + 4 * q + jb - 4);
                    const unsigned lo = *(const LAS bf16_t*)(buf + SC_WV + ta * 256 + (((2 * sl + (n >> 3)) ^ (ta & 15)) * 16) + (n & 7) * 2), hi = *(const LAS bf16_t*)(buf + SC_WV + tb * 256 + (((2 * sl + (n >> 3)) ^ (tb & 15)) * 16) + (n & 7) * 2);
                    w[jj] = lo | (hi << 16); }
                v4u ww; ww.x = w[0]; ww.y = w[1]; ww.z = w[2]; ww.w = w[3];
                VNf[s2] = __builtin_bit_cast(bf16x8, ww); VNSf[s2] = VNf[s2]; }
        }
        MM4_K128(O[0], fa); SCHED_FENCE(); SCAN_LD4_K128(fa, SC_QG, 2); SCHED_FENCE();
        MM4_K128(O[1], fb); SCHED_FENCE(); SCAN_LD4_K128(fb, SC_QG, 3); SCHED_FENCE();
        MM4_K128(O[2], fa); SCHED_FENCE(); SCAN_LD4_K64(fa, SC_A, 0); SCHED_FENCE();
        MM4_K128(O[3], fb); SCHED_FENCE(); SCAN_LD4_K64(fb, SC_A, 2); SCHED_FENCE();
        if (gdn) {
#pragma unroll
            for (int s2 = 0; s2 < 2; ++s2) VNf[s2] = pack_frag(VN[2 * s2], VN[2 * s2 + 1]);
#pragma unroll
            for (int s2 = 0; s2 < 2; ++s2) { const f32x4 e0 = *(const LAS f32x4*)(vec + 64 + 16 * (2 * s2) + 4 * q), e1 = *(const LAS f32x4*)(vec + 64 + 16 * (2 * s2 + 1) + 4 * q);
                VNSf[s2] = pack_frag(VN[2 * s2] * e0, VN[2 * s2 + 1] * e1); }
#pragma unroll
            for (int mt = 0; mt < 4; ++mt) O[mt] = O[mt] * *(const LAS f32x4*)(vec + 16 * mt + 4 * q);
        }
#define MM4_K64(ACC0, ACC1, fr, BF) do { ACC0 = MFMA16(fr[0], BF[0], ACC0); ACC0 = MFMA16(fr[1], BF[1], ACC0); ACC1 = MFMA16(fr[2], BF[0], ACC1); ACC1 = MFMA16(fr[3], BF[1], ACC1); } while (0)
        MM4_K64(O[0], O[1], fa, VNf); SCHED_FENCE(); SCAN_LD4_K64(fa, SC_KDT, 0); SCHED_FENCE();
        MM4_K64(O[2], O[3], fb, VNf); SCHED_FENCE(); SCAN_LD4_K64(fb, SC_KDT, 2); SCHED_FENCE();
#pragma unroll
        for (int m = 0; m < 8; ++m) S[m] = S[m] * *(const LAS f32x4*)(vec + 128 + 16 * m + 4 * q);
        MM4_K64(S[0], S[1], fa, VNSf); SCHED_FENCE(); SCAN_LD4_K64(fa, SC_KDT, 4); SCHED_FENCE();
        MM4_K64(S[2], S[3], fb, VNSf); SCHED_FENCE(); SCAN_LD4_K64(fb, SC_KDT, 6); SCHED_FENCE();
        MM4_K64(S[4], S[5], fa, VNSf);
        MM4_K64(S[6], S[7], fb, VNSf);
        LAS bf16_t* OT = (LAS bf16_t*)(lds + SC_OT + cur * SC_OTB);
#pragma unroll
        for (int mt = 0; mt < 4; ++mt) {
            OT[(16 * mt + 4 * q + 0) * 136 + 16 * sl + n] = f2bf(O[mt].x); OT[(16 * mt + 4 * q + 1) * 136 + 16 * sl + n] = f2bf(O[mt].y);
            OT[(16 * mt + 4 * q + 2) * 136 + 16 * sl + n] = f2bf(O[mt].z); OT[(16 * mt + 4 * q + 3) * 136 + 16 * sl + n] = f2bf(O[mt].w);
        }
        asm volatile("s_waitcnt vmcnt(0)" ::: "memory");
        __syncthreads();
        {
            const v4u o0 = *(const LAS v4u*)(OT + rt * 136 + 16 * cg8), o1 = *(const LAS v4u*)(OT + rt * 136 + 16 * cg8 + 8);
            float ov[16], gv[16];
#pragma unroll
            for (int w = 0; w < 4; ++w) { const unsigned a = (w == 0) ? o0.x : (w == 1) ? o0.y : (w == 2) ? o0.z : o0.w, bq = (w == 0) ? o1.x : (w == 1) ? o1.y : (w == 2) ? o1.z : o1.w;
                const unsigned ga = (w == 0) ? gt0.x : (w == 1) ? gt0.y : (w == 2) ? gt0.z : gt0.w, gb = (w == 0) ? gt1.x : (w == 1) ? gt1.y : (w == 2) ? gt1.z : gt1.w;
                ov[2 * w] = __uint_as_float(a << 16); ov[2 * w + 1] = __uint_as_float(a & 0xffff0000u); ov[8 + 2 * w] = __uint_as_float(bq << 16); ov[8 + 2 * w + 1] = __uint_as_float(bq & 0xffff0000u);
                gv[2 * w] = __uint_as_float(ga << 16); gv[2 * w + 1] = __uint_as_float(ga & 0xffff0000u); gv[8 + 2 * w] = __uint_as_float(gb << 16); gv[8 + 2 * w + 1] = __uint_as_float(gb & 0xffff0000u); }
            float ss = 0.f;
#pragma unroll
            for (int i = 0; i < 16; ++i) ss += ov[i] * ov[i];
            ss += __shfl_xor(ss, 1); ss += __shfl_xor(ss, 2); ss += __shfl_xor(ss, 4);
            const float rstd = rsqrtf(ss * (1.f / 128.f) + EPS);
            float yv[16];
#pragma unroll
            for (int i4 = 0; i4 < 4; ++i4) { const f32x4 g4 = *(const LAS f32x4*)(gainl + 16 * cg8 + 4 * i4);
                yv[4 * i4] = ov[4 * i4] * rstd * g4.x * siluf_(gv[4 * i4]); yv[4 * i4 + 1] = ov[4 * i4 + 1] * rstd * g4.y * siluf_(gv[4 * i4 + 1]);
                yv[4 * i4 + 2] = ov[4 * i4 + 2] * rstd * g4.z * siluf_(gv[4 * i4 + 2]); yv[4 * i4 + 3] = ov[4 * i4 + 3] * rstd * g4.w * siluf_(gv[4 * i4 + 3]); }
            v4u y0, y1;
            y0.x = pk2(yv[0], yv[1]); y0.y = pk2(yv[2], yv[3]); y0.z = pk2(yv[4], yv[5]); y0.w = pk2(yv[6], yv[7]);
            y1.x = pk2(yv[8], yv[9]); y1.y = pk2(yv[10], yv[11]); y1.z = pk2(yv[12], yv[13]); y1.w = pk2(yv[14], yv[15]);
            bf16_t* mp = mix + (size_t)(t0 + rt) * DM + mix_col + 16 * cg8;
            *(v4u*)mp = y0; *(v4u*)(mp + 8) = y1;
        }
#pragma unroll
        for (int mt = 0; mt < 4; ++mt) Ucur[mt] = Unx[mt];
    }
    __syncthreads();
}

struct EpiResF32 {
    static constexpr bool PERM = false, AFTER_DRAIN = false;
    const float* R; float* O; int ldc;
    __device__ __forceinline__ void operator()(const pg8::f32x4 (&acc)[2][2][4][2], const pg8::Unit& u, int wr, int wc, int fr, int fq) const {
        const int row0 = u.pm * 256 + wr * 64 + fr, col0 = u.pn * 256 + wc * 32 + 4 * fq;
#pragma unroll
        for (int ai = 0; ai < 2; ++ai)
#pragma unroll
            for (int m = 0; m < 4; ++m) { const size_t off = (size_t)(row0 + ai * 128 + m * 16) * ldc + col0;
#pragma unroll
                for (int bj = 0; bj < 2; ++bj)
#pragma unroll
                    for (int n = 0; n < 2; ++n) { pg8::f32x4 v = acc[ai][bj][m][n]; if (R) v = v + *(const pg8::f32x4*)(R + off + bj * 128 + n * 16); *(pg8::f32x4*)(O + off + bj * 128 + n * 16) = v; } }
    }
};

#define XB_TMO      128
#define XB_XCNT(j)  (256  + 64 * (j))
#define XB_XSUB(j)  (1280 + 64 * (j))
#define XB_XGEN(j)  (2304 + 64 * (j))
#define XB_TOP      3328
#define XB_TOPGEN   3392
#define XCD_BAR_WORDS 3456
#define XB_SPIN_CAP (1u << 18)

__device__ __forceinline__ unsigned xb_ld(unsigned* p)              { return __hip_atomic_load(p, __ATOMIC_RELAXED, __HIP_MEMORY_SCOPE_AGENT); }
__device__ __forceinline__ unsigned xb_add(unsigned* p, unsigned v) { return __hip_atomic_fetch_add(p, v, __ATOMIC_RELAXED, __HIP_MEMORY_SCOPE_AGENT); }
__device__ __forceinline__ unsigned xb_xcc_id() { return (unsigned)__builtin_amdgcn_s_getreg((3 << 11) | 20) & 0xFu; }
#define XB_SPIN(cond, bar) do { unsigned _sp = 0; while (cond) { __builtin_amdgcn_s_sleep(1); \
    if ((++_sp & 255u) == 0u) { if (xb_ld(&(bar)[XB_TMO])) break; if (_sp > XB_SPIN_CAP) { atomicAdd(&(bar)[XB_TMO], 1u); break; } } } } while (0)

struct XcdBarrier {
    unsigned* bar; unsigned x;
    volatile LAS unsigned* st;
};

__device__ __forceinline__ XcdBarrier xcd_barrier_post(unsigned* bar, volatile LAS unsigned* st) {
    XcdBarrier b; b.bar = bar; b.x = xb_xcc_id(); b.st = st;
    if (threadIdx.x == 0) (void)xb_add(&bar[XB_XCNT(b.x)], 1u);
    return b;
}
__device__ __forceinline__ void xcd_barrier_complete(unsigned* bar, unsigned x, unsigned& nloc, unsigned& nx) {
    const unsigned G = gridDim.x * gridDim.y * gridDim.z;
    unsigned sum, cnt, mine, sp = 0u;
    for (;;) {
        sum = 0u; cnt = 0u; mine = 0u;
#pragma unroll
        for (unsigned j = 0; j < 16; ++j) { const unsigned c = xb_ld(&bar[XB_XCNT(j)]); sum += c; cnt += (c > 0u) ? 1u : 0u; mine = (j == x) ? c : mine; }
        if (sum == G) break;
        __builtin_amdgcn_s_sleep(1);
        if ((++sp & 255u) == 0u) { if (xb_ld(&bar[XB_TMO])) break; if (sp > XB_SPIN_CAP) { atomicAdd(&bar[XB_TMO], 1u); break; } }
    }
    nloc = mine > 0u ? mine : 1u; nx = cnt > 0u ? cnt : 1u;
}

__device__ __forceinline__ void xcd_barrier(const XcdBarrier& b) {
    asm volatile("s_waitcnt vmcnt(0)" ::: "memory");
    __syncthreads();
    if (threadIdx.x == 0) {
        unsigned* bar = b.bar;
        __builtin_amdgcn_s_waitcnt(0);
        unsigned nloc = b.st[0], nx = b.st[1];
        if (nloc == 0u) { xcd_barrier_complete(bar, b.x, nloc, nx); b.st[0] = nloc; b.st[1] = nx; }
        const unsigned old = xb_add(&bar[XB_XSUB(b.x)], 1u);
        const unsigned gen = old / nloc;
        if (old + 1u == (gen + 1u) * nloc) {
            __builtin_amdgcn_fence(__ATOMIC_RELEASE, "agent");
            asm volatile("s_waitcnt vmcnt(0)" ::: "memory");
            const unsigned og = xb_add(&bar[XB_TOP], 1u);
            const unsigned tg = og / nx;
            if (og + 1u == (tg + 1u) * nx) xb_add(&bar[XB_TOPGEN], 1u);
            else XB_SPIN(xb_ld(&bar[XB_TOPGEN]) == tg, bar);
            __builtin_amdgcn_fence(__ATOMIC_ACQUIRE, "agent");
            xb_add(&bar[XB_XGEN(b.x)], 1u);
            asm volatile("s_waitcnt vmcnt(0)" ::: "memory");
        } else {
            XB_SPIN(xb_ld(&bar[XB_XGEN(b.x)]) == gen, bar);
            __builtin_amdgcn_fence(__ATOMIC_ACQUIRE, "agent");
            asm volatile("s_waitcnt vmcnt(0)" ::: "memory");
        }
    }
    __syncthreads();
}

__global__ void __launch_bounds__(NT, 2) mk_fwd(Args args) {
    extern __shared__ __attribute__((aligned(16))) unsigned char lds_raw[];
    LAS unsigned char* lds = (LAS unsigned char*)lds_raw;
    cg::grid_group grid = cg::this_grid();
    const int tid = threadIdx.x, lane = tid & 63, wave = __builtin_amdgcn_readfirstlane(tid >> 6);
    const int G = gridDim.x, bx = blockIdx.x;
    const int vcu = (G % 8 == 0) ? (bx % 8) * (G / 8) + bx / 8 : bx;
    const int gw = vcu * NW + wave, NGW = G * NW;
    unsigned char* ws = args.ws;
    const float* x = args.in[0]; const float* attn_g = args.in[1]; const float* w_in = args.in[2];
    const float* w_out = args.in[9]; const float* ffn_g = args.in[10]; const float* w_query = args.in[11]; const float* sub_keys = args.in[12];
    bf16_t* WinT = (bf16_t*)(ws + OFF_D);
    bf16_t* WoutT = (bf16_t*)(ws + OFF_C);
    bf16_t* Wqk = (bf16_t*)(ws + OFF_C + 8 * MiB);
    bf16_t* xn = (bf16_t*)(ws + OFF_D + 28 * MiB);
    float* ba = (float*)(ws + OFF_S);
    bf16_t* proj = (bf16_t*)(ws + OFF_B);
    bf16_t* mix = (bf16_t*)args.out;
    unsigned char* pb = ws + OFF_D; float* vecs = (float*)(ws + OFF_S + 2 * MiB);
    float* hbuf = (float*)(ws + OFF_B);
    bf16_t* hn = (bf16_t*)(ws + OFF_D + 128 * MiB);
    float* scores = (float*)(ws + OFF_D);
    unsigned char* U8 = ws + OFF_TAB; unsigned char* V8 = ws + OFF_TAB + 32 * MiB;
    float* inv_su = (float*)(ws + OFF_S + 1 * MiB); float* inv_sv = inv_su + 16384;

    volatile LAS unsigned* xbst = (volatile LAS unsigned*)(lds + LDS_BYTES - 16);
    if (tid < 4) xbst[tid] = 0u;
    __syncthreads();
    XcdBarrier xbar = xcd_barrier_post((unsigned*)args.ws, xbst);
    const int lo = args.ph_lo, hi = args.ph_hi;
#define IN(k) (lo <= (k) && (k) < hi)
#define SYNC_AFTER(k) do { if (IN(k) && (k) + 1 < hi) { if ((k) == 0) grid.sync(); else xcd_barrier(xbar); } } while (0)
    {
        if (IN(0)) {
            LAS float* scr = (LAS float*)(lds + wave * 16384);
            constexpr int I_IN = (DM / 64) * (NPROJ / 32);
            for (int it = gw; it < I_IN; it += NGW) transpose_item(w_in, INW, DM, NPROJ, WinT, scr, it, lane);
            for (int m = gw; m < T; m += NGW) norm_row<true>(x + (size_t)m * DM, attn_g, w_in, xn + (size_t)m * DM, ba + (size_t)m * 16, lane);
        }
        SYNC_AFTER(0);
        if (IN(1)) {
            pg8::Gemm g{xn, WinT, T, NPROJ, DM}; pg8::StaticOrder S; S.init(T, NPROJ, G, bx);
            pg8::EpiBf16<0> E{proj, NPROJ, nullptr, 0, 0, 1.f};
            pg8::gemm_phase<pg8::EpiBf16<0>, pg8::StaticOrder, true, true>(lds, g, S, E);
        }
        SYNC_AFTER(1);
        if (IN(2)) {
            for (int it = bx; it < 2048; it += G) hgrn_prep_item(it, proj, args.in[3], pb, vecs, lds, tid);
            for (int it = bx; it < 1024; it += G) gdn_prep_item(it, proj, ba, args.in[5], args.in[6], args.in[7], pb, vecs, lds, tid);
        }
        SYNC_AFTER(2);
        if (IN(3)) {
            if (bx < 32) scan_block(bx, proj, pb, vecs, args.in[4], args.in[8], mix, lds, tid);
            else if (G > 32) {
                const int fb = bx - 32, FB = G - 32, fw = fb * NW + wave, FW = FB * NW;
                for (int it = fb; it < 512; it += FB) wqk_item(w_query, sub_keys, Wqk, (LAS float*)lds, it, tid);
                LAS float* scr = (LAS float*)(lds + wave * 16384);
                constexpr int I_OUT = (DM / 64) * (DM / 32);
                for (int it = fw; it < I_OUT; it += FW) transpose_item(w_out, DM, DM, DM, WoutT, scr, it, lane);
                for (int e = fw; e < 32768; e += FW) { const bool isv = e >= 16384; const int r = e & 16383;
                    table_row((isv ? args.in[14] : args.in[13]) + (size_t)r * DM, (unsigned*)((isv ? V8 : U8) + (size_t)r * 2048), (isv ? inv_sv : inv_su) + r, lane); }
            }
        }
        SYNC_AFTER(3);
        if (IN(4)) {
            pg8::Gemm g{mix, WoutT, T, DM, DM}; pg8::StaticOrder S; S.init(T, DM, G, bx);
            EpiResF32 E{x, hbuf, DM};
            pg8::gemm_phase<EpiResF32, pg8::StaticOrder, true, true>(lds, g, S, E);
        }
        SYNC_AFTER(4);
        if (IN(5)) {
            for (int m = gw; m < T; m += NGW) norm_row<false>(hbuf + (size_t)m * DM, ffn_g, nullptr, hn + (size_t)m * DM, nullptr, lane);
        }
        SYNC_AFTER(5);
        if (IN(6)) {
            pg8::Gemm g{hn, Wqk, T, DM, DM}; pg8::StaticOrder S; S.init(T, DM, G, bx);
            EpiResF32 E{nullptr, scores, DM};
            pg8::gemm_phase<EpiResF32, pg8::StaticOrder, true, true>(lds, g, S, E);
        }
        SYNC_AFTER(6);
        if (IN(7)) {
            LAS int* se = (LAS int*)(lds + wave * 2048); LAS float* sa = (LAS float*)(lds + wave * 2048 + 512); LAS float* sb = (LAS float*)(lds + wave * 2048 + 1024);
            for (int t = gw; t < T; t += NGW) peer_token(t, scores, hn, hbuf, U8, V8, inv_su, inv_sv, args.in[15], args.out, se, sa, sb, lane);
        }
    }
}
}

extern "C" void kernel_launch(void* const* d_in, const int* in_sizes, int n_in, void* d_out, int out_size, void* d_ws, size_t ws_size, hipStream_t stream) {
    static int grid = 0;
    if (grid == 0) {
        int dev = 0, cus = 0, per_cu = 0;
        (void)hipGetDevice(&dev);
        (void)hipDeviceGetAttribute(&cus, hipDeviceAttributeMultiprocessorCount, dev);
        (void)hipFuncSetAttribute((const void*)mk::mk_fwd, hipFuncAttributeMaxDynamicSharedMemorySize, mk::LDS_BYTES);
        (void)hipOccupancyMaxActiveBlocksPerMultiprocessor(&per_cu, (const void*)mk::mk_fwd, mk::NT, mk::LDS_BYTES);
        if (per_cu < 1) { fprintf(stderr, "occupancy query says %d\n", per_cu); per_cu = 1; }
        grid = cus;
    }
    unsigned char* ws = (unsigned char*)d_ws;
    (void)hipMemsetAsync(d_ws, 0, 16384, stream);
    mk::Args a{};
    for (int i = 0; i < 16; ++i) a.in[i] = (const float*)d_in[i];
    a.out = (float*)d_out; a.ws = ws;
    {
#ifdef MIX_NAIVE
        a.ph_lo = 0; a.ph_hi = 2;
        void* kargs[] = {&a};
        (void)hipLaunchCooperativeKernel((const void*)mk::mk_fwd, dim3(grid), dim3(mk::NT), kargs, mk::LDS_BYTES, stream);
        k_mixers_seq<<<32, 128, 0, stream>>>((const bf16_t*)(ws + OFF_B), (const float*)(ws + OFF_S), (const float*)d_in[3], (const float*)d_in[4], (const float*)d_in[5], (const float*)d_in[6],
                                             (const float*)d_in[7], (const float*)d_in[8], (bf16_t*)d_out);
        mk::Args b = a; b.ph_lo = 4; b.ph_hi = 8;
        void* kargs2[] = {&b};
        (void)hipLaunchCooperativeKernel((const void*)mk::mk_fwd, dim3(grid), dim3(mk::NT), kargs2, mk::LDS_BYTES, stream);
#elif defined(PROBE_K)
        a.ph_lo = 0; a.ph_hi = (PROBE_K == 99) ? 4 : PROBE_K + 1;
        void* kargs[] = {&a};
        (void)hipLaunchCooperativeKernel((const void*)mk::mk_fwd, dim3(grid), dim3(mk::NT), kargs, mk::LDS_BYTES, stream);
        (void)hipMemsetAsync(d_ws, 0, 16384, stream);
        mk::Args b = a; b.ph_lo = (PROBE_K == 99) ? 4 : PROBE_K; b.ph_hi = 8;
        void* kargs2[] = {&b};
        (void)hipLaunchCooperativeKernel((const void*)mk::mk_fwd, dim3(grid), dim3(mk::NT), kargs2, mk::LDS_BYTES, stream);
#else
        a.ph_lo = 0; a.ph_hi = 8;
        void* kargs[] = {&a};
        hipError_t e = hipLaunchCooperativeKernel((const void*)mk::mk_fwd, dim3(grid), dim3(mk::NT), kargs, mk::LDS_BYTES, stream);
        if (e != hipSuccess) fprintf(stderr, "coop launch failed: %s\n", hipGetErrorString(e));
#endif
    }
}
```

```cpp
#include <hip/hip_runtime.h>
#include <hip/hip_cooperative_groups.h>
#include <cstdio>
namespace cg = cooperative_groups;
#include <stdint.h>

typedef unsigned short bf16_t;
typedef float f32x4 __attribute__((ext_vector_type(4)));

constexpr int T = 16384, SEQ = 8192, DM = 2048, INW = 7184, NPROJ = 7168;
constexpr float EPS = 1e-6f;
constexpr size_t MiB = 1u << 20;
constexpr size_t OFF_TAB = 1 * MiB;
constexpr size_t OFF_B = 65 * MiB;
constexpr size_t OFF_C = 289 * MiB;
constexpr size_t OFF_D = 305 * MiB;
constexpr size_t OFF_S = 500 * MiB;
constexpr int C_AQ = 0, C_AF = 1024, C_AI = 2048, C_AG = 3072, C_BQ = 4096, C_BK = 4608, C_BV = 5120, C_BZ = 6144;

__device__ __forceinline__ float bf2f(bf16_t v) { return __uint_as_float(((unsigned)v) << 16); }
typedef float f32x2_t __attribute__((ext_vector_type(2)));
typedef __bf16 bf16x2_t __attribute__((ext_vector_type(2)));
__device__ __forceinline__ unsigned cvt_pk2(float lo, float hi) { f32x2_t v = {lo, hi}; bf16x2_t b = __builtin_convertvector(v, bf16x2_t); return __builtin_bit_cast(unsigned, b); }
__device__ __forceinline__ bf16_t f2bf(float f) { return (bf16_t)(cvt_pk2(f, 0.f) & 0xffffu); }
__device__ __forceinline__ float sigmoidf_(float x) { return 1.f / (1.f + __expf(-x)); }
__device__ __forceinline__ float siluf_(float x) { return x / (1.f + __expf(-x)); }
__device__ __forceinline__ float wave_sum(float v) {
#pragma unroll
    for (int o = 1; o < 64; o <<= 1) v += __shfl_xor(v, o);
    return v;
}
__device__ __forceinline__ float block_sum(float v, float* sh) {
    v = wave_sum(v);
    const int w = threadIdx.x >> 6, nw = blockDim.x >> 6;
    __syncthreads();
    if ((threadIdx.x & 63) == 0) sh[w] = v;
    __syncthreads();
    float r = 0.f;
    for (int i = 0; i < nw; ++i) r += sh[i];
    return r;
}

__global__ void __launch_bounds__(256) k_rmsnorm_x(const float* __restrict__ x, const float* __restrict__ g, const float* __restrict__ w_in,
                                                  bf16_t* __restrict__ xn, float* __restrict__ ba) {
    __shared__ float sh[8];
    __shared__ float sacc[4][16];
    const int t = blockIdx.x, tid = threadIdx.x;
    const float* xr = x + (size_t)t * DM;
    float v[8];
    float ss = 0.f;
#pragma unroll
    for (int i = 0; i < 8; ++i) { v[i] = xr[tid * 8 + i]; ss += v[i] * v[i]; }
    ss = block_sum(ss, sh);
    const float rstd = rsqrtf(ss * (1.f / DM) + EPS);
    float acc[16];
#pragma unroll
    for (int j = 0; j < 16; ++j) acc[j] = 0.f;
#pragma unroll
    for (int i = 0; i < 8; ++i) {
        const int d = tid * 8 + i;
        const float y = v[i] * rstd * g[d];
        xn[(size_t)t * DM + d] = f2bf(y);
        const float* wr = w_in + (size_t)d * INW + NPROJ;
#pragma unroll
        for (int j = 0; j < 16; ++j) acc[j] += y * wr[j];
    }
#pragma unroll
    for (int j = 0; j < 16; ++j) acc[j] = wave_sum(acc[j]);
    __syncthreads();
    if ((tid & 63) == 0) {
#pragma unroll
        for (int j = 0; j < 16; ++j) sacc[tid >> 6][j] = acc[j];
    }
    __syncthreads();
    if (tid < 16) ba[(size_t)t * 16 + tid] = sacc[0][tid] + sacc[1][tid] + sacc[2][tid] + sacc[3][tid];
}

template <int MODE>
__global__ void __launch_bounds__(256) k_gemm_naive(const bf16_t* __restrict__ A, const float* __restrict__ W, int ldw, int K, int N,
                                                   void* __restrict__ Cout, int ldc, const float* __restrict__ R) {
    __shared__ float As[16][68];
    __shared__ float Ws[16][68];
    const int tid = threadIdx.x, tx = tid & 15, ty = tid >> 4;
    const int m0 = blockIdx.y * 64, n0 = blockIdx.x * 64;
    float acc[4][4];
#pragma unroll
    for (int i = 0; i < 4; ++i)
#pragma unroll
        for (int j = 0; j < 4; ++j) acc[i][j] = 0.f;
    for (int k0 = 0; k0 < K; k0 += 16) {
        {
            const int r = tid >> 2, kk = (tid & 3) * 4;
            const bf16_t* ap = A + (size_t)(m0 + r) * K + k0 + kk;
#pragma unroll
            for (int i = 0; i < 4; ++i) As[kk + i][r] = bf2f(ap[i]);
        }
        {
            const int kk = tid >> 4, c = (tid & 15) * 4;
            const float* wp = W + (size_t)(k0 + kk) * ldw + n0 + c;
#pragma unroll
            for (int i = 0; i < 4; ++i) Ws[kk][c + i] = wp[i];
        }
        __syncthreads();
#pragma unroll
        for (int kk = 0; kk < 16; ++kk) {
            float a[4], b[4];
#pragma unroll
            for (int i = 0; i < 4; ++i) { a[i] = As[kk][ty * 4 + i]; b[i] = Ws[kk][tx * 4 + i]; }
#pragma unroll
            for (int i = 0; i < 4; ++i)
#pragma unroll
                for (int j = 0; j < 4; ++j) acc[i][j] += a[i] * b[j];
        }
        __syncthreads();
    }
#pragma unroll
    for (int i = 0; i < 4; ++i) {
        const int m = m0 + ty * 4 + i;
#pragma unroll
        for (int j = 0; j < 4; ++j) {
            const int n = n0 + tx * 4 + j;
            if (MODE == 0) ((bf16_t*)Cout)[(size_t)m * ldc + n] = f2bf(acc[i][j]);
            else if (MODE == 1) ((float*)Cout)[(size_t)m * ldc + n] = acc[i][j] + R[(size_t)m * ldc + n];
            else ((float*)Cout)[(size_t)m * ldc + n] = acc[i][j];
        }
    }
}

__global__ void __launch_bounds__(128) k_mixers_seq(const bf16_t* __restrict__ proj, const float* __restrict__ ba,
                                                   const float* __restrict__ lb_logits, const float* __restrict__ hgrn_g,
                                                   const float* __restrict__ conv_w, const float* __restrict__ A_log, const float* __restrict__ dt_bias,
                                                   const float* __restrict__ gdn_g, bf16_t* __restrict__ mix) {
    __shared__ float s0[128], s1[128], s2[128];
    __shared__ float sh[8];
    const int tid = threadIdx.x;
    float S[128];
#pragma unroll
    for (int d = 0; d < 128; ++d) S[d] = 0.f;
    if (blockIdx.x < 16) {
        const int b = blockIdx.x >> 3, h = blockIdx.x & 7;
        const float l0 = lb_logits[h * 128 + tid], l1 = lb_logits[1024 + h * 128 + tid];
        const float lb = 1.f / (1.f + __expf(l1 - l0));
        const float gn = hgrn_g[tid];
        for (int t = 0; t < SEQ; ++t) {
            const bf16_t* pr = proj + (size_t)(b * SEQ + t) * NPROJ;
            const float q = bf2f(pr[C_AQ + h * 128 + tid]), z = bf2f(pr[C_AF + h * 128 + tid]);
            const float f = lb + (1.f - lb) * sigmoidf_(z);
            __syncthreads();
            s0[tid] = q; s1[tid] = f; s2[tid] = 1.f - f;
            __syncthreads();
            const float vv = bf2f(pr[C_AI + h * 128 + tid]);
            float o = 0.f;
#pragma unroll
            for (int d = 0; d < 128; ++d) { S[d] = s1[d] * S[d] + s2[d] * vv; o += s0[d] * S[d]; }
            const float ss = block_sum(o * o, sh);
            const float rstd = rsqrtf(ss * (1.f / 128.f) + EPS);
            const float gate = bf2f(pr[C_AG + h * 128 + tid]);
            mix[(size_t)(b * SEQ + t) * DM + h * 128 + tid] = f2bf(o * rstd * gn * siluf_(gate));
        }
    } else {
        const int bb = blockIdx.x - 16, b = bb >> 3, vh = bb & 7, qh = vh >> 1;
        const int cq = qh * 128 + tid, ck = 512 + qh * 128 + tid, cv = 1024 + vh * 128 + tid;
        float wq[4], wk[4], wv[4];
#pragma unroll
        for (int j = 0; j < 4; ++j) { wq[j] = conv_w[j * 2048 + cq]; wk[j] = conv_w[j * 2048 + ck]; wv[j] = conv_w[j * 2048 + cv]; }
        float hq[3] = {0.f, 0.f, 0.f}, hk[3] = {0.f, 0.f, 0.f}, hv[3] = {0.f, 0.f, 0.f};
        const float Aexp = __expf(A_log[vh]), dtb = dt_bias[vh], gn = gdn_g[tid];
        for (int t = 0; t < SEQ; ++t) {
            const bf16_t* pr = proj + (size_t)(b * SEQ + t) * NPROJ;
            const float xq = bf2f(pr[C_BQ + qh * 128 + tid]), xk = bf2f(pr[C_BK + qh * 128 + tid]), xv = bf2f(pr[C_BV + vh * 128 + tid]);
            float q = wq[0] * hq[0] + wq[1] * hq[1] + wq[2] * hq[2] + wq[3] * xq;
            float k = wk[0] * hk[0] + wk[1] * hk[1] + wk[2] * hk[2] + wk[3] * xk;
            float v = wv[0] * hv[0] + wv[1] * hv[1] + wv[2] * hv[2] + wv[3] * xv;
            hq[0] = hq[1]; hq[1] = hq[2]; hq[2] = xq; hk[0] = hk[1]; hk[1] = hk[2]; hk[2] = xk; hv[0] = hv[1]; hv[1] = hv[2]; hv[2] = xv;
            q = siluf_(q); k = siluf_(k); v = siluf_(v);
            const float sq = block_sum(q * q, sh);
            const float sk = block_sum(k * k, sh);
            q = q * rsqrtf(sq + EPS) * 0.08838834764831845f;
            k = k * rsqrtf(sk + EPS);
            __syncthreads();
            s0[tid] = q; s1[tid] = k;
            __syncthreads();
            const float beta = sigmoidf_(ba[(size_t)(b * SEQ + t) * 16 + vh]);
            const float ax = ba[(size_t)(b * SEQ + t) * 16 + 8 + vh] + dtb;
            const float sp = ax > 20.f ? ax : log1pf(__expf(ax));
            const float eg = __expf(-Aexp * sp);
            float kS = 0.f;
#pragma unroll
            for (int d = 0; d < 128; ++d) { S[d] *= eg; kS += s1[d] * S[d]; }
            const float delta = beta * (v - kS);
            float o = 0.f;
#pragma unroll
            for (int d = 0; d < 128; ++d) { S[d] += s1[d] * delta; o += s0[d] * S[d]; }
            const float ss = block_sum(o * o, sh);
            const float rstd = rsqrtf(ss * (1.f / 128.f) + EPS);
            const float gate = bf2f(pr[C_BZ + vh * 128 + tid]);
            mix[(size_t)(b * SEQ + t) * DM + 1024 + vh * 128 + tid] = f2bf(o * rstd * gn * siluf_(gate));
        }
    }
}

__global__ void __launch_bounds__(256) k_rmsnorm_h(const float* __restrict__ h, const float* __restrict__ g, bf16_t* __restrict__ hn) {
    __shared__ float sh[8];
    const int t = blockIdx.x, tid = threadIdx.x;
    float v[8]; float ss = 0.f;
#pragma unroll
    for (int i = 0; i < 8; ++i) { v[i] = h[(size_t)t * DM + tid * 8 + i]; ss += v[i] * v[i]; }
    ss = block_sum(ss, sh);
    const float rstd = rsqrtf(ss * (1.f / DM) + EPS);
#pragma unroll
    for (int i = 0; i < 8; ++i) hn[(size_t)t * DM + tid * 8 + i] = f2bf(v[i] * rstd * g[tid * 8 + i]);
}

__global__ void __launch_bounds__(256) k_scores_naive(const float* __restrict__ qry, const float* __restrict__ sk, float* __restrict__ scores) {
    __shared__ float sq[2048];
    const int t = blockIdx.x, tid = threadIdx.x;
    for (int i = tid; i < 2048; i += 256) sq[i] = qry[(size_t)t * DM + i];
    __syncthreads();
    for (int c = tid; c < 2048; c += 256) {
        const int h = c >> 8, half = (c >> 7) & 1, n = c & 127;
        const float* kr = sk + (((size_t)half * 8 + h) * 128 + n) * 128;
        const float* qr = sq + h * 256 + half * 128;
        float a = 0.f;
        for (int k = 0; k < 128; ++k) a += qr[k] * kr[k];
        scores[(size_t)t * DM + c] = a;
    }
}

__device__ __forceinline__ void wave_argmax(float& m, int& idx) {
#pragma unroll
    for (int o = 1; o < 64; o <<= 1) {
        const float om = __shfl_xor(m, o); const int oi = __shfl_xor(idx, o);
        if (om > m || (om == m && oi < idx)) { m = om; idx = oi; }
    }
}
__device__ __forceinline__ void topk_head(const float* __restrict__ s, int lane, int& expert, float& gate) {
    float v1 = 0.f, v2 = 0.f; int i1 = 0, i2 = 0;
    {
        float a0 = s[lane], a1 = s[lane + 64];
        for (int it = 0; it < 16; ++it) {
            float m; int idx;
            if (a0 >= a1) { m = a0; idx = lane; } else { m = a1; idx = lane + 64; }
            wave_argmax(m, idx);
            if (idx == lane) a0 = -INFINITY;
            if (idx == lane + 64) a1 = -INFINITY;
            if (lane == it) { v1 = m; i1 = idx; }
        }
    }
    {
        float a0 = s[128 + lane], a1 = s[128 + lane + 64];
        for (int it = 0; it < 16; ++it) {
            float m; int idx;
            if (a0 >= a1) { m = a0; idx = lane; } else { m = a1; idx = lane + 64; }
            wave_argmax(m, idx);
            if (idx == lane) a0 = -INFINITY;
            if (idx == lane + 64) a1 = -INFINITY;
            if (lane == it) { v2 = m; i2 = idx; }
        }
    }
    float c[4];
    const float vi = __shfl(v1, lane >> 2);
#pragma unroll
    for (int cc = 0; cc < 4; ++cc) c[cc] = vi + __shfl(v2, (lane & 3) * 4 + cc);
    float best = 0.f; int pos = 0;
    for (int it = 0; it < 16; ++it) {
        float m = c[0]; int idx = lane * 4;
#pragma unroll
        for (int cc = 1; cc < 4; ++cc) if (c[cc] > m) { m = c[cc]; idx = lane * 4 + cc; }
        wave_argmax(m, idx);
#pragma unroll
        for (int cc = 0; cc < 4; ++cc) if (idx == lane * 4 + cc) c[cc] = -INFINITY;
        if (lane == it) { best = m; pos = idx; }
    }
    const int e1 = __shfl(i1, pos >> 4), e2 = __shfl(i2, pos & 15);
    expert = e1 * 128 + e2;
    const float mx = __shfl(best, 0);
    float ex = (lane < 16) ? __expf(best - mx) : 0.f;
    float sum = ex;
#pragma unroll
    for (int o = 1; o < 16; o <<= 1) sum += __shfl_xor(sum, o);
    gate = ex / sum;
}

__device__ __forceinline__ float gelu_erf(float x) { return 0.5f * x * (1.f + erff(x * 0.70710678118654752f)); }
__global__ void __launch_bounds__(256) k_peer_naive(const float* __restrict__ scores, const bf16_t* __restrict__ hn, const float* __restrict__ h,
                                                   const float* __restrict__ u_tab, const float* __restrict__ v_tab, const float* __restrict__ gfin,
                                                   float* __restrict__ out) {
    __shared__ int se[4][128];
    __shared__ float sg[4][128];
    const int w = threadIdx.x >> 6, lane = threadIdx.x & 63;
    const int t = blockIdx.x * 4 + w;
    for (int hd = 0; hd < 8; ++hd) {
        int e; float g;
        topk_head(scores + (size_t)t * DM + hd * 256, lane, e, g);
        if (lane < 16) { se[w][hd * 16 + lane] = e; sg[w][hd * 16 + lane] = g; }
    }
    __syncthreads();
    float xv[32], y[32];
#pragma unroll
    for (int j = 0; j < 8; ++j)
#pragma unroll
        for (int i = 0; i < 4; ++i) { xv[j * 4 + i] = bf2f(hn[(size_t)t * DM + j * 256 + lane * 4 + i]); y[j * 4 + i] = 0.f; }
    for (int k = 0; k < 128; ++k) {
        const int e = se[w][k]; const float g = sg[w][k];
        const float* ur = u_tab + (size_t)e * DM; const float* vr = v_tab + (size_t)e * DM;
        float p = 0.f;
#pragma unroll
        for (int j = 0; j < 8; ++j) {
            const f32x4 uu = *(const f32x4*)(ur + j * 256 + lane * 4);
            p += uu.x * xv[j * 4] + uu.y * xv[j * 4 + 1] + uu.z * xv[j * 4 + 2] + uu.w * xv[j * 4 + 3];
        }
        p = wave_sum(p);
        const float wgt = g * gelu_erf(p);
#pragma unroll
        for (int j = 0; j < 8; ++j) {
            const f32x4 vv = *(const f32x4*)(vr + j * 256 + lane * 4);
            y[j * 4] += wgt * vv.x; y[j * 4 + 1] += wgt * vv.y; y[j * 4 + 2] += wgt * vv.z; y[j * 4 + 3] += wgt * vv.w;
        }
    }
    float ss = 0.f;
#pragma unroll
    for (int j = 0; j < 8; ++j)
#pragma unroll
        for (int i = 0; i < 4; ++i) { y[j * 4 + i] += h[(size_t)t * DM + j * 256 + lane * 4 + i]; ss += y[j * 4 + i] * y[j * 4 + i]; }
    ss = wave_sum(ss);
    const float rstd = rsqrtf(ss * (1.f / DM) + EPS);
#pragma unroll
    for (int j = 0; j < 8; ++j)
#pragma unroll
        for (int i = 0; i < 4; ++i) out[(size_t)t * DM + j * 256 + lane * 4 + i] = y[j * 4 + i] * rstd * gfin[j * 256 + lane * 4 + i];
}

namespace pg8 {
#define PG8_LAS __attribute__((address_space(3)))
typedef unsigned short bf16_t;
typedef short bf16x8 __attribute__((ext_vector_type(8)));
typedef float f32x4 __attribute__((ext_vector_type(4)));
typedef unsigned u32x4 __attribute__((ext_vector_type(4)));
constexpr int BM = 256, BK = 64, HALF = 128, HTB = HALF * BK * 2  , STAGE_BYTES = 8 * HTB, NXCD = 8, WGM = 8;

__host__ __device__ __forceinline__ int lds_byte(int r, int c) { const int st = (r >> 4) * 2 + (c >> 5), rr = r & 15, cc = c & 31, ob = rr * 64 + cc * 2; return st * 1024 + (ob ^ (((ob >> 9) & 1) << 5)); }
__host__ __device__ __forceinline__ void stage_rc(int b, int& R, int& C) { const int st = b / 1024, sb = b % 1024, swz = sb ^ (((sb >> 9) & 1) << 5); R = (st >> 1) * 16 + swz / 64; C = (st & 1) * 32 + (swz % 64) / 2; }
__host__ __device__ __forceinline__ int perm32(int rho) { const int n = rho >> 4, i = rho & 15; return 8 * (i >> 2) + 4 * n + (i & 3); }

struct Unit { int pm, pn; };
struct Gemm { const bf16_t* A; const bf16_t* Bt; int M, N, K; };

struct StaticOrder {
    int nM, nN, nwg, G, c;
    __host__ __device__ void init(int M, int N, int G_, int c_) { nM = M / BM; nN = N / BM; nwg = nM * nN; G = G_; c = c_; }
    __host__ __device__ bool next(int i, Unit& u) const {
        const long L = (long)i * G + c; if (L >= nwg) return false;
        int wgid = (int)L; { const int q = nwg / NXCD, r = nwg % NXCD, xcd = wgid % NXCD, off = wgid / NXCD; wgid = (xcd < r ? xcd * (q + 1) : r * (q + 1) + (xcd - r) * q) + off; }
        const int nig = WGM * nN, gid = wgid / nig, fm = gid * WGM, gsz = (nM - fm) < WGM ? (nM - fm) : WGM;
        u.pm = fm + ((wgid % nig) % gsz); u.pn = (wgid % nig) / gsz; return true;
    }
    __device__ __forceinline__ void a_ready(const Unit&) const {}
    __device__ __forceinline__ void done(const Unit&) const {}
};

__device__ __forceinline__ unsigned cvt_pk_bf16(float lo, float hi) { unsigned r; asm volatile("v_cvt_pk_bf16_f32 %0, %1, %2" : "=v"(r) : "v"(lo), "v"(hi)); return r; }
typedef float f32x2 __attribute__((ext_vector_type(2)));
__device__ __forceinline__ f32x2 gelu_pk(f32x2 v) {
    const f32x2 av = __builtin_elementwise_abs(v), d = av * 0.2316418882f + 1.0f;
    f32x2 t; t.x = __builtin_amdgcn_rcpf(d.x); t.y = __builtin_amdgcn_rcpf(d.y);
    f32x2 q = t * 0.5307027145f + (-0.7265760135f); q = q * t + 0.7107068705f; q = q * t + (-0.142248368f); q = q * t + 0.127414796f; q = q * t;
    const f32x2 s = (v * v) * (-0.72134752044f);
    f32x2 e; e.x = __builtin_amdgcn_exp2f(s.x); e.y = __builtin_amdgcn_exp2f(s.y);
    const f32x2 m = v * (q * e), r = v - m;
    f32x2 o; o.x = v.x < 0.f ? m.x : r.x; o.y = v.y < 0.f ? m.y : r.y; return o;
}

template <int ACT  > struct EpiBf16 {
    static constexpr bool PERM = true, AFTER_DRAIN = false; static_assert(ACT == 0 || ACT == 1, "EpiBf16: ACT is 0 (none) or 1 (gelu_pk)");
    bf16_t* O; int ldc; const float* bias; int split_cols; size_t split_stride; float scale0;
    __device__ __forceinline__ void operator()(const f32x4 (&acc)[2][2][4][2], const Unit& u, int wr, int wc, int fr, int fq) const {
        const int row0 = u.pm * BM + wr * 64 + fr; int colt = u.pn * BM; bf16_t* base = O;
        float sc = 1.f; if (split_cols) { const int t = colt / split_cols; base += (size_t)t * split_stride; colt -= t * split_cols; if (t == 0) sc = scale0; }
        const int col0 = colt + wc * 32 + 8 * fq, bcol0 = u.pn * BM + wc * 32 + 8 * fq;
        f32x4 bv[2][2];
#pragma unroll
        for (int bj = 0; bj < 2; ++bj)
#pragma unroll
            for (int n = 0; n < 2; ++n) bv[bj][n] = bias ? *(const f32x4*)(bias + bcol0 + bj * HALF + 4 * n) : (f32x4){0.f, 0.f, 0.f, 0.f};
#pragma unroll
        for (int ai = 0; ai < 2; ++ai)
#pragma unroll
            for (int m = 0; m < 4; ++m) { bf16_t* rowp = base + (size_t)(row0 + ai * HALF + m * 16) * ldc + col0;
#pragma unroll
                for (int bj = 0; bj < 2; ++bj) { f32x4 v0 = acc[ai][bj][m][0] + bv[bj][0], v1 = acc[ai][bj][m][1] + bv[bj][1];
                    if (ACT == 1) { f32x2 a = gelu_pk((f32x2){v0[0], v0[1]}), b = gelu_pk((f32x2){v0[2], v0[3]}), c = gelu_pk((f32x2){v1[0], v1[1]}), d = gelu_pk((f32x2){v1[2], v1[3]});
                        v0 = (f32x4){a.x, a.y, b.x, b.y}; v1 = (f32x4){c.x, c.y, d.x, d.y}; }
                    v0 = v0 * sc; v1 = v1 * sc; u32x4 w; w.x = cvt_pk_bf16(v0[0], v0[1]); w.y = cvt_pk_bf16(v0[2], v0[3]); w.z = cvt_pk_bf16(v1[0], v1[1]); w.w = cvt_pk_bf16(v1[2], v1[3]);
                    *(u32x4*)(rowp + bj * HALF) = w; } }
    }
};
template <class Epi, class Sched, bool ALIGN_EPI = false, bool SP2 = false>
__device__ __forceinline__ void gemm_phase(PG8_LAS unsigned char* lds, const Gemm g, const Sched& S, const Epi& E) {
    const int tid = threadIdx.x, wid = __builtin_amdgcn_readfirstlane(tid >> 6), lane = tid & 63, wr = wid >> 2, wc = wid & 3, fr = lane & 15, fq = lane >> 4;
    const int K = g.K, nt = K / BK;
    unsigned voffA[2], voffB[2];
#pragma unroll
    for (int i = 0; i < 2; ++i) { int R, C; stage_rc(tid * 16 + i * 8192, R, C); const int Rb = Epi::PERM ? ((R & ~31) + perm32(R & 31)) : R;
        voffA[i] = (unsigned)(R * K + C) * 2u; voffB[i] = (unsigned)(Rb * K + C) * 2u; }
    const size_t kstep = (size_t)(BK * 2);
    const size_t hstep = (size_t)HALF * K * 2;
    const size_t tstep = 2 * hstep;
    const unsigned ldsw = (unsigned)wid * 1024u;
    const int aoff = lds_byte(wr * 64 + fr, fq * 8), boff = lds_byte(wc * 32 + fr, fq * 8);
#define PG8_SA(b, h) (((b) * 2 + (h)) * HTB)
#define PG8_SB(b, h) ((4 + (b) * 2 + (h)) * HTB)
#define PG8_STAGE(bufoff, gbase, voff) do { _Pragma("unroll") for (int _i = 0; _i < 2; ++_i) \
        __builtin_amdgcn_global_load_lds((const unsigned*)((const char*)(gbase) + (voff)[_i]), (PG8_LAS unsigned*)(lds + (bufoff) + ldsw + _i * 8192), 16, 0, 0); } while (0)
#define PG8_LDA(dst, b, h) do { _Pragma("unroll") for (int m = 0; m < 4; ++m) _Pragma("unroll") for (int k = 0; k < 2; ++k) dst[m][k] = *(const PG8_LAS bf16x8*)(lds + PG8_SA(b, h) + aoff + m * 2048 + k * 1024); } while (0)
#define PG8_LDB(dst, b, h) do { _Pragma("unroll") for (int n = 0; n < 2; ++n) _Pragma("unroll") for (int k = 0; k < 2; ++k) dst[n][k] = *(const PG8_LAS bf16x8*)(lds + PG8_SB(b, h) + boff + n * 2048 + k * 1024); } while (0)
#define PG8_MMA(ai, bj, At, Bt) do { __builtin_amdgcn_s_setprio(1); _Pragma("unroll") for (int m = 0; m < 4; ++m) _Pragma("unroll") for (int n = 0; n < 2; ++n) _Pragma("unroll") for (int k = 0; k < 2; ++k) \
        acc[ai][bj][m][n] = __builtin_amdgcn_mfma_f32_16x16x32_bf16(Bt[n][k], At[m][k], acc[ai][bj][m][n], 0, 0, 0); __builtin_amdgcn_s_setprio(0); } while (0)
#define PG8_WAIT_V(n) asm volatile("s_waitcnt vmcnt(" #n ")" ::: "memory")
#define PG8_WAIT_L(n) asm volatile("s_waitcnt lgkmcnt(" #n ")" ::: "memory")
#define PG8_BAR __builtin_amdgcn_s_barrier()
#define PG8_SCHED __builtin_amdgcn_sched_barrier(0)
    Unit cur, nxt; int ui = 0;
    if (!S.next(0, cur)) return;
    f32x4 acc[2][2][4][2];
#pragma unroll
    for (int a = 0; a < 2; ++a)
#pragma unroll
        for (int b = 0; b < 2; ++b)
#pragma unroll
            for (int m = 0; m < 4; ++m)
#pragma unroll
                for (int n = 0; n < 2; ++n) acc[a][b][m][n] = (f32x4){0.f, 0.f, 0.f, 0.f};
    bf16x8 At[4][2], B0[2][2], B1[2][2];
    const char* cA = (const char*)g.A + (size_t)cur.pm * tstep; const char* cB = (const char*)g.Bt + (size_t)cur.pn * tstep;
    S.a_ready(cur);
    if constexpr (SP2) {
        PG8_STAGE(PG8_SB(0, 0), cB, voffB); PG8_STAGE(PG8_SB(0, 1), cB + hstep, voffB); PG8_STAGE(PG8_SA(0, 0), cA, voffA); PG8_STAGE(PG8_SA(0, 1), cA + hstep, voffA);
        if (wr == 1) PG8_BAR;
        PG8_WAIT_V(2); PG8_BAR;
        PG8_STAGE(PG8_SB(1, 0), cB + kstep, voffB); PG8_STAGE(PG8_SA(1, 0), cA + kstep, voffA); PG8_STAGE(PG8_SB(1, 1), cB + hstep + kstep, voffB);
        PG8_WAIT_V(6); PG8_BAR;
    } else {
        PG8_STAGE(PG8_SB(0, 0), cB, voffB); PG8_STAGE(PG8_SA(0, 0), cA, voffA); PG8_STAGE(PG8_SB(0, 1), cB + hstep, voffB); PG8_STAGE(PG8_SA(0, 1), cA + hstep, voffA);
        if (wr == 1) PG8_BAR;
        PG8_WAIT_V(4); PG8_BAR;
        PG8_STAGE(PG8_SB(1, 0), cB + kstep, voffB); PG8_STAGE(PG8_SA(1, 0), cA + kstep, voffA); PG8_STAGE(PG8_SB(1, 1), cB + hstep + kstep, voffB);
        PG8_WAIT_V(6); PG8_BAR;
    }
    for (;;) {
        const bool has_next = S.next(ui + 1, nxt);
        const char* nA = has_next ? (const char*)g.A + (size_t)nxt.pm * tstep : cA; const char* nB = has_next ? (const char*)g.Bt + (size_t)nxt.pn * tstep : cB;
        for (int t = 0; t < nt; t += 2) {
            const bool last = (t == nt - 2);
            const char* a1 = cA + (size_t)(t + 1) * kstep;
            const char* a2 = last ? nA : cA + (size_t)(t + 2) * kstep; const char* b2 = last ? nB : cB + (size_t)(t + 2) * kstep;
            const char* a3 = a2 + kstep; const char* b3 = b2 + kstep;
            if (last && has_next) S.a_ready(nxt);
            if constexpr (SP2) {
            PG8_LDB(B0, 0, 0); PG8_LDB(B1, 0, 1); PG8_SCHED; PG8_LDA(At, 0, 0); PG8_STAGE(PG8_SA(1, 1), a1 + hstep, voffA);
            PG8_WAIT_V(8); PG8_WAIT_L(0); PG8_BAR; PG8_MMA(0, 0, At, B0); PG8_MMA(0, 1, At, B1); PG8_BAR; PG8_SCHED;
            PG8_LDA(At, 0, 1); PG8_STAGE(PG8_SB(0, 0), b2, voffB); PG8_STAGE(PG8_SB(0, 1), b2 + hstep, voffB); PG8_STAGE(PG8_SA(0, 0), a2, voffA);
            PG8_WAIT_V(8); PG8_WAIT_L(0); PG8_BAR; PG8_MMA(1, 0, At, B0); PG8_MMA(1, 1, At, B1); PG8_BAR; PG8_SCHED;
            PG8_LDB(B0, 1, 0); PG8_LDB(B1, 1, 1); PG8_SCHED; PG8_LDA(At, 1, 0); PG8_STAGE(PG8_SA(0, 1), a2 + hstep, voffA);
            PG8_WAIT_V(8); PG8_WAIT_L(0); PG8_BAR; PG8_MMA(0, 0, At, B0); PG8_MMA(0, 1, At, B1); PG8_BAR; PG8_SCHED;
            PG8_LDA(At, 1, 1); PG8_STAGE(PG8_SB(1, 0), b3, voffB); PG8_STAGE(PG8_SB(1, 1), b3 + hstep, voffB); PG8_STAGE(PG8_SA(1, 0), a3, voffA);
            PG8_WAIT_V(8); PG8_WAIT_L(0); PG8_BAR; PG8_MMA(1, 0, At, B0); PG8_MMA(1, 1, At, B1); PG8_BAR; PG8_SCHED;
            } else {
            PG8_LDB(B0, 0, 0); PG8_SCHED; PG8_LDA(At, 0, 0); PG8_STAGE(PG8_SA(1, 1), a1 + hstep, voffA);
            PG8_WAIT_L(8); PG8_BAR; PG8_WAIT_L(0); PG8_MMA(0, 0, At, B0); PG8_BAR; PG8_SCHED;
            PG8_LDB(B1, 0, 1); PG8_STAGE(PG8_SB(0, 0), b2, voffB);
            PG8_BAR; PG8_WAIT_L(0); PG8_MMA(0, 1, At, B1); PG8_BAR;
            PG8_LDA(At, 0, 1); PG8_STAGE(PG8_SA(0, 0), a2, voffA);
            PG8_BAR; PG8_WAIT_L(0); PG8_MMA(1, 0, At, B0); PG8_BAR; PG8_SCHED;
            PG8_STAGE(PG8_SB(0, 1), b2 + hstep, voffB);
            PG8_WAIT_V(6); PG8_BAR; PG8_MMA(1, 1, At, B1); PG8_BAR;
            PG8_LDB(B0, 1, 0); PG8_SCHED; PG8_LDA(At, 1, 0); PG8_STAGE(PG8_SA(0, 1), a2 + hstep, voffA);
            PG8_WAIT_L(8); PG8_BAR; PG8_WAIT_L(0); PG8_MMA(0, 0, At, B0); PG8_BAR; PG8_SCHED;
            PG8_LDB(B1, 1, 1); PG8_STAGE(PG8_SB(1, 0), b3, voffB);
            PG8_BAR; PG8_WAIT_L(0); PG8_MMA(0, 1, At, B1); PG8_BAR;
            PG8_LDA(At, 1, 1); PG8_STAGE(PG8_SA(1, 0), a3, voffA);
            PG8_BAR; PG8_WAIT_L(0); PG8_MMA(1, 0, At, B0); PG8_BAR; PG8_SCHED;
            PG8_STAGE(PG8_SB(1, 1), b3 + hstep, voffB);
            PG8_WAIT_V(6); PG8_BAR; PG8_MMA(1, 1, At, B1); PG8_BAR;
            }
        }
        if constexpr (ALIGN_EPI) { if (wr == 0) PG8_BAR; }
        if constexpr (!Epi::AFTER_DRAIN) { E(acc, cur, wr, wc, fr, fq); S.done(cur); }
        if (!has_next) break;
#pragma unroll
        for (int a = 0; a < 2; ++a)
#pragma unroll
            for (int b = 0; b < 2; ++b)
#pragma unroll
                for (int m = 0; m < 4; ++m)
#pragma unroll
                    for (int n = 0; n < 2; ++n) acc[a][b][m][n] = (f32x4){0.f, 0.f, 0.f, 0.f};
        cur = nxt; cA = nA; cB = nB; ++ui;
        if constexpr (ALIGN_EPI) { if (wr == 1) PG8_BAR; }
    }
    PG8_WAIT_V(0);
    if constexpr (!ALIGN_EPI) { if (wr == 0) PG8_BAR; }
    PG8_BAR;
    if constexpr (Epi::AFTER_DRAIN) { E.fused(acc, cur, wr, wc, fr, fq, lds, wid, lane); S.done(cur); }
#undef PG8_SA
#undef PG8_SB
#undef PG8_STAGE
#undef PG8_LDA
#undef PG8_LDB
#undef PG8_MMA
#undef PG8_WAIT_V
#undef PG8_WAIT_L
#undef PG8_BAR
#undef PG8_SCHED
}
}

namespace mk {
#define LAS __attribute__((address_space(3)))
#define GAS __attribute__((address_space(1)))
typedef unsigned v4u __attribute__((ext_vector_type(4)));
typedef unsigned v2u __attribute__((ext_vector_type(2)));
constexpr int NW = 8, NT = 512, LDS_BYTES = 163840, RING_BYTES = 131072;
#define LDS_WAIT() asm volatile("s_waitcnt lgkmcnt(0)" ::: "memory")
#define DPP_ROR_ADD(t, n) ((t) + __uint_as_float(__builtin_amdgcn_update_dpp(0u, __float_as_uint(t), 0x120 + (n), 0xf, 0xf, false)))
struct Args { const float* in[16]; float* out; unsigned char* ws; int ph_lo, ph_hi; };
__device__ __forceinline__ unsigned pk2(float lo, float hi) { return cvt_pk2(lo, hi); }

__device__ __forceinline__ void transpose_item(const float* W, int ld, int K, int ncols, bf16_t* WT, LAS float* scr, int item, int lane) {
    const int nblk = ncols / 32, kb = item / nblk, nb = item % nblk, k0 = 64 * kb, n0 = 32 * nb;
#pragma unroll 8
    for (int i = 0; i < 32; ++i) { const int kk = 2 * i + (lane >> 5); scr[kk * 33 + (lane & 31)] = W[(size_t)(k0 + kk) * ld + n0 + (lane & 31)]; }
    LDS_WAIT(); asm volatile("" ::: "memory");
    const int c = lane & 7;
#pragma unroll
    for (int j = 0; j < 4; ++j) { const int n = (lane >> 3) + 8 * j; const LAS float* s = scr + (8 * c) * 33 + n;
        v4u o; o.x = pk2(s[0 * 33], s[1 * 33]); o.y = pk2(s[2 * 33], s[3 * 33]); o.z = pk2(s[4 * 33], s[5 * 33]); o.w = pk2(s[6 * 33], s[7 * 33]);
        *(v4u*)(WT + (size_t)(n0 + n) * K + k0 + 8 * c) = o; }
    LDS_WAIT(); asm volatile("" ::: "memory");
}
template <bool WITH_BA>
__device__ __forceinline__ void norm_row(const float* xrow, const float* g, const LAS float* wt  , bf16_t* orow, float* barow, int lane) {
    f32x4 v[8]; float ss = 0.f;
#pragma unroll
    for (int j = 0; j < 8; ++j) { v[j] = ((const f32x4*)xrow)[64 * j + lane]; ss += (v[j].x * v[j].x + v[j].y * v[j].y) + (v[j].z * v[j].z + v[j].w * v[j].w); }
    ss = wave_sum(ss);
    const float rstd = rsqrtf(ss * (1.f / DM) + EPS);
    float acc[16];
#pragma unroll
    for (int c = 0; c < 16; ++c) acc[c] = 0.f;
#pragma unroll
    for (int j = 0; j < 8; ++j) {
        const f32x4 gg = ((const f32x4*)g)[64 * j + lane];
        const f32x4 y = v[j] * rstd * gg;
        v2u o; o.x = pk2(y.x, y.y); o.y = pk2(y.z, y.w);
        ((v2u*)orow)[64 * j + lane] = o;
        if (WITH_BA) {
#pragma unroll
            for (int c = 0; c < 16; ++c) { const f32x4 w4 = *(const LAS f32x4*)(wt + c * 2048 + 4 * (64 * j + lane));
                acc[c] += (y.x * w4.x + y.y * w4.y) + (y.z * w4.z + y.w * w4.w); }
            __builtin_amdgcn_sched_barrier(0);
        }
    }
    if (WITH_BA) {
        float q8[8], t4[4];
#pragma unroll
        for (int r = 0; r < 8; ++r) { auto sw = __builtin_amdgcn_permlane32_swap(__float_as_uint(acc[r]), __float_as_uint(acc[r + 8]), false, false); q8[r] = __uint_as_float(sw[0]) + __uint_as_float(sw[1]); }
#pragma unroll
        for (int r = 0; r < 4; ++r) { auto sw = __builtin_amdgcn_permlane16_swap(__float_as_uint(q8[r]), __float_as_uint(q8[r + 4]), false, false); t4[r] = __uint_as_float(sw[0]) + __uint_as_float(sw[1]); }
#pragma unroll
        for (int r = 0; r < 4; ++r) { float tv = t4[r]; tv = DPP_ROR_ADD(tv, 8); tv = DPP_ROR_ADD(tv, 4); tv = DPP_ROR_ADD(tv, 2); tv = DPP_ROR_ADD(tv, 1); t4[r] = tv; }
        if ((lane & 15) == 0) { const int gq = lane >> 4;
#pragma unroll
            for (int r = 0; r < 4; ++r) barow[r + 4 * gq] = t4[r]; }
    }
}
__device__ __forceinline__ void wqk_item(const float* Wq, const float* SK, bf16_t* Wqk, LAS float* lds, int item, int tid) {
    const int cbk = item >> 5, d0 = (item & 31) * 64, cb = cbk * 128, h = cbk >> 1, half = cbk & 1;
    LAS float* At = lds; LAS float* Bt = lds + 128 * 68;
    const float* skb = SK + ((size_t)(half * 8 + h) * 128) * 128;
#pragma unroll
    for (int i = 0; i < 4; ++i) { const int idx = tid + 512 * i, d = idx >> 5, k4 = idx & 31;
        const f32x4 w = *(const f32x4*)(Wq + (size_t)(d0 + d) * DM + cb + 4 * k4);
        At[(4 * k4 + 0) * 68 + d] = w.x; At[(4 * k4 + 1) * 68 + d] = w.y; At[(4 * k4 + 2) * 68 + d] = w.z; At[(4 * k4 + 3) * 68 + d] = w.w; }
#pragma unroll
    for (int i = 0; i < 8; ++i) { const int idx = tid + 512 * i, n = idx >> 5, k4 = idx & 31;
        const f32x4 w = *(const f32x4*)(skb + (size_t)n * 128 + 4 * k4);
        Bt[(4 * k4 + 0) * 132 + n] = w.x; Bt[(4 * k4 + 1) * 132 + n] = w.y; Bt[(4 * k4 + 2) * 132 + n] = w.z; Bt[(4 * k4 + 3) * 132 + n] = w.w; }
    __syncthreads();
    const int dy = tid >> 5, nx = tid & 31;
    float acc[4][4];
#pragma unroll
    for (int i = 0; i < 4; ++i)
#pragma unroll
        for (int j = 0; j < 4; ++j) acc[i][j] = 0.f;
#pragma unroll 4
    for (int kk = 0; kk < 128; ++kk) {
        const f32x4 a = *(const LAS f32x4*)(At + kk * 68 + 4 * dy), b = *(const LAS f32x4*)(Bt + kk * 132 + 4 * nx);
        acc[0][0] += a.x * b.x; acc[0][1] += a.x * b.y; acc[0][2] += a.x * b.z; acc[0][3] += a.x * b.w;
        acc[1][0] += a.y * b.x; acc[1][1] += a.y * b.y; acc[1][2] += a.y * b.z; acc[1][3] += a.y * b.w;
        acc[2][0] += a.z * b.x; acc[2][1] += a.z * b.y; acc[2][2] += a.z * b.z; acc[2][3] += a.z * b.w;
        acc[3][0] += a.w * b.x; acc[3][1] += a.w * b.y; acc[3][2] += a.w * b.z; acc[3][3] += a.w * b.w;
    }
#pragma unroll
    for (int j = 0; j < 4; ++j) { v2u o; o.x = pk2(acc[0][j], acc[1][j]); o.y = pk2(acc[2][j], acc[3][j]);
        *(v2u*)(Wqk + (size_t)(cb + 4 * nx + j) * DM + d0 + 4 * dy) = o; }
    __syncthreads();
}

typedef float f32x2 __attribute__((ext_vector_type(2)));
__device__ __forceinline__ int fp4_idx_of(float v) { return (v < 1.75f) ? (int)(v * 2.f + 0.25f) : (v < 2.5f ? 4 : (v < 3.5f ? 5 : (v < 5.f ? 6 : 7))); }
__device__ __forceinline__ void fp4_calibrate(int (&nib)[8]) {
    const unsigned T = 0x76543210u;
    const f32x2 a = __builtin_amdgcn_cvt_scalef32_pk_f32_fp4(T, 1.0f, 0), b = __builtin_amdgcn_cvt_scalef32_pk_f32_fp4(T, 1.0f, 1);
    const f32x2 c = __builtin_amdgcn_cvt_scalef32_pk_f32_fp4(T, 1.0f, 2), d = __builtin_amdgcn_cvt_scalef32_pk_f32_fp4(T, 1.0f, 3);
    nib[0] = fp4_idx_of(a.x); nib[1] = fp4_idx_of(a.y); nib[2] = fp4_idx_of(b.x); nib[3] = fp4_idx_of(b.y);
    nib[4] = fp4_idx_of(c.x); nib[5] = fp4_idx_of(c.y); nib[6] = fp4_idx_of(d.x); nib[7] = fp4_idx_of(d.y);
}
__device__ __forceinline__ void table_row(const float* src, unsigned* dst, float* inv_scale, int lane) {
    int nib[8]; fp4_calibrate(nib);
    f32x4 v[8]; float mx = 0.f;
#pragma unroll
    for (int j = 0; j < 8; ++j) { v[j] = ((const f32x4*)src)[8 * lane + j];
        mx = fmaxf(mx, fmaxf(fmaxf(fabsf(v[j].x), fabsf(v[j].y)), fmaxf(fabsf(v[j].z), fabsf(v[j].w)))); }
#pragma unroll
    for (int o = 1; o < 64; o <<= 1) mx = fmaxf(mx, __shfl_xor(mx, o));
    const float sc = mx > 0.f ? mx * (0.85f / 6.f) : 1.f, isc = 1.f / sc;
    unsigned wd[4];
#pragma unroll
    for (int w = 0; w < 4; ++w) {
        unsigned acc = 0u;
#pragma unroll
        for (int e = 0; e < 8; ++e) {
            const f32x4 q = v[2 * w + (e >> 2)]; const float xe = ((e & 3) == 0) ? q.x : ((e & 3) == 1) ? q.y : ((e & 3) == 2) ? q.z : q.w;
            const float yv = fabsf(xe) * isc;
            unsigned code = (yv > 0.25f) + (yv > 0.75f) + (yv > 1.25f) + (yv > 1.75f) + (yv > 2.5f) + (yv > 3.5f) + (yv > 5.f);
            code |= (xe < 0.f) ? 8u : 0u;
            acc |= code << (4 * nib[e]);
        }
        wd[w] = acc;
    }
    v4u o; o.x = wd[0]; o.y = wd[1]; o.z = wd[2]; o.w = wd[3];
    ((v4u*)dst)[lane] = o;
    if (lane == 0) *inv_scale = sc;
}
#ifndef PEER_FAST_REDUCE
#define PEER_FAST_REDUCE 1
#endif
__device__ __forceinline__ float dpp_ror_add(float t, int) { return t; }
#define FP4_BYTE(d, j) __builtin_amdgcn_cvt_scalef32_pk_f32_fp4((d), 1.0f, (j))
__device__ __forceinline__ float dot_row(const v4u& a, const float (&xv)[32]) {
    float p = 0.f;
#pragma unroll
    for (int w = 0; w < 4; ++w) { const unsigned d = (w == 0) ? a.x : (w == 1) ? a.y : (w == 2) ? a.z : a.w;
        const f32x2 f0 = FP4_BYTE(d, 0), f1 = FP4_BYTE(d, 1), f2 = FP4_BYTE(d, 2), f3 = FP4_BYTE(d, 3);
        p += (f0.x * xv[8 * w] + f0.y * xv[8 * w + 1]) + (f1.x * xv[8 * w + 2] + f1.y * xv[8 * w + 3]) + (f2.x * xv[8 * w + 4] + f2.y * xv[8 * w + 5]) + (f3.x * xv[8 * w + 6] + f3.y * xv[8 * w + 7]); }
    return p;
}
__device__ __forceinline__ void axpy_row(const v4u& a, float wgt, float (&y)[32]) {
#pragma unroll
    for (int w = 0; w < 4; ++w) { const unsigned d = (w == 0) ? a.x : (w == 1) ? a.y : (w == 2) ? a.z : a.w;
        const f32x2 f0 = FP4_BYTE(d, 0), f1 = FP4_BYTE(d, 1), f2 = FP4_BYTE(d, 2), f3 = FP4_BYTE(d, 3);
        y[8 * w] += wgt * f0.x; y[8 * w + 1] += wgt * f0.y; y[8 * w + 2] += wgt * f1.x; y[8 * w + 3] += wgt * f1.y;
        y[8 * w + 4] += wgt * f2.x; y[8 * w + 5] += wgt * f2.y; y[8 * w + 6] += wgt * f3.x; y[8 * w + 7] += wgt * f3.y; }
}
#define DPP_ROR_MAX(t, n) fmaxf((t), __uint_as_float(__builtin_amdgcn_update_dpp(0u, __float_as_uint(t), 0x120 + (n), 0xf, 0xf, false)))
#define CSWAP(a, b) do { const float hi_ = fmaxf(a, b), lo_ = fminf(a, b); a = hi_; b = lo_; } while (0)
__device__ __forceinline__ void topk_token_fast(const float* __restrict__ srow, int lane, const float* inv_su, const float* inv_sv,
                                                LAS int* se, LAS float* sa, LAS float* sb) {
    const int l16 = lane & 15, row = lane >> 4;
    float R[4];
#pragma unroll
    for (int ps = 0; ps < 4; ++ps) {
        const f32x4 v0 = *(const f32x4*)(srow + (4 * ps + row) * 128 + 8 * l16), v1 = *(const f32x4*)(srow + (4 * ps + row) * 128 + 8 * l16 + 4);
        float k[8];
        k[0] = v0.x; k[1] = v0.y; k[2] = v0.z; k[3] = v0.w; k[4] = v1.x; k[5] = v1.y; k[6] = v1.z; k[7] = v1.w;
#pragma unroll
        for (int i = 0; i < 8; ++i) k[i] = __uint_as_float((__float_as_uint(k[i]) & 0xFFFFFF80u) | (unsigned)(8 * l16 + i));
        CSWAP(k[0], k[1]); CSWAP(k[2], k[3]); CSWAP(k[4], k[5]); CSWAP(k[6], k[7]);
        CSWAP(k[0], k[2]); CSWAP(k[1], k[3]); CSWAP(k[4], k[6]); CSWAP(k[5], k[7]);
        CSWAP(k[1], k[2]); CSWAP(k[5], k[6]);
        CSWAP(k[0], k[4]); CSWAP(k[1], k[5]); CSWAP(k[2], k[6]); CSWAP(k[3], k[7]);
        CSWAP(k[2], k[4]); CSWAP(k[3], k[5]);
        CSWAP(k[1], k[2]); CSWAP(k[3], k[4]); CSWAP(k[5], k[6]);
        float res = 0.f;
#pragma unroll
        for (int it = 0; it < 16; ++it) {
            float m = k[0];
            m = DPP_ROR_MAX(m, 8); m = DPP_ROR_MAX(m, 4); m = DPP_ROR_MAX(m, 2); m = DPP_ROR_MAX(m, 1);
            const bool own = (k[0] == m);
#pragma unroll
            for (int i = 0; i < 7; ++i) k[i] = own ? k[i + 1] : k[i];
            k[7] = own ? -INFINITY : k[7];
            res = (l16 == it) ? m : res;
        }
        R[ps] = res;
    }
#pragma unroll
    for (int g = 0; g < 2; ++g) {
        const auto sw = __builtin_amdgcn_permlane16_swap(__float_as_uint(R[2 * g]), __float_as_uint(R[2 * g + 1]), false, false);
        const float X = __uint_as_float(sw[0]), Y = __uint_as_float(sw[1]);
        const float a = __uint_as_float(__float_as_uint(X) & 0xFFFFFF80u);
        int j = 0;
        float v2 = __shfl(Y, (lane & 48));
        float best = 0.f;
#pragma unroll
        for (int it = 0; it < 16; ++it) {
            const float sum = a + __uint_as_float(__float_as_uint(v2) & 0xFFFFFF80u);
            const float cand = (j < 16) ? __uint_as_float((__float_as_uint(sum) & 0xFFFFFF00u) | (unsigned)((l16 << 4) | (j & 15))) : -INFINITY;
            float m = cand;
            m = DPP_ROR_MAX(m, 8); m = DPP_ROR_MAX(m, 4); m = DPP_ROR_MAX(m, 2); m = DPP_ROR_MAX(m, 1);
            best = (l16 == it) ? m : best;
            if (it < 15) { j += (cand == m) ? 1 : 0; v2 = __shfl(Y, (lane & 48) + (j & 15)); }
        }
        const unsigned bb = __float_as_uint(best);
        const int bi = (bb >> 4) & 15, bj = bb & 15;
        const unsigned k1 = __float_as_uint(__shfl(X, (lane & 48) + bi)), k2 = __float_as_uint(__shfl(Y, (lane & 48) + bj));
        const int e = (int)(k1 & 127u) * 128 + (int)(k2 & 127u);
        const float bv = __uint_as_float(bb & 0xFFFFFF00u);
        float mx = bv; mx = DPP_ROR_MAX(mx, 8); mx = DPP_ROR_MAX(mx, 4); mx = DPP_ROR_MAX(mx, 2); mx = DPP_ROR_MAX(mx, 1);
        const float ex = __expf(bv - mx);
        float sm = ex; sm = DPP_ROR_ADD(sm, 8); sm = DPP_ROR_ADD(sm, 4); sm = DPP_ROR_ADD(sm, 2); sm = DPP_ROR_ADD(sm, 1);
        const float gate = ex / sm;
        const int head = 4 * g + ((row & 1) * 2 + (row >> 1));
        se[head * 16 + l16] = e; sa[head * 16 + l16] = inv_su[e]; sb[head * 16 + l16] = gate * inv_sv[e];
    }
}
#define PEER_LOAD(DST, TAB, b) do { _Pragma("unroll") for (int r_ = 0; r_ < 4; ++r_) { const unsigned char* rp_ = (TAB) + (size_t)(unsigned)__builtin_amdgcn_readfirstlane(se[4 * (b) + r_]) * 1024 + 16 * lane; \
        DST[r_] = *(const v4u*)rp_; } } while (0)
__device__ __forceinline__ void peer_token(int t, const float* scores, const bf16_t* hn, const float* hbuf, const unsigned char* U8, const unsigned char* V8,
                                           const float* inv_su, const float* inv_sv, const float* gfin, float* out,
                                           LAS int* se, LAS float* sa, LAS float* sb, int lane_in) {
    int lane = lane_in;
    {
        LAS int* se0 = se + 512; LAS float* sa0 = sa + 512; LAS float* sb0 = sb + 512;
        topk_token_fast(scores + (size_t)t * DM, lane, inv_su, inv_sv, se0, sa0, sb0);
        unsigned a0 = ((unsigned)se0[lane] << 7) | (unsigned)lane, a1 = ((unsigned)se0[lane + 64] << 7) | (unsigned)(lane + 64);
#pragma unroll
        for (int k = 2; k <= 128; k <<= 1) {
#pragma unroll
            for (int j = k >> 1; j > 0; j >>= 1) {
                if (j == 64) { const unsigned lo = a0 < a1 ? a0 : a1, hi = a0 < a1 ? a1 : a0; a0 = lo; a1 = hi; }
                else {
                    const unsigned p0 = (unsigned)__shfl_xor((int)a0, j), p1 = (unsigned)__shfl_xor((int)a1, j);
                    const bool lower = (lane & j) == 0;
                    const bool up0 = (lane & k) == 0, up1 = ((lane + 64) & k) == 0;
                    const unsigned mn0 = a0 < p0 ? a0 : p0, mx0 = a0 < p0 ? p0 : a0, mn1 = a1 < p1 ? a1 : p1, mx1 = a1 < p1 ? p1 : a1;
                    a0 = (up0 == lower) ? mn0 : mx0; a1 = (up1 == lower) ? mn1 : mx1;
                }
            }
        }
        const int k0 = a0 & 127, k1 = a1 & 127;
        se[lane] = (int)(a0 >> 7); sa[lane] = sa0[k0]; sb[lane] = sb0[k0];
        se[lane + 64] = (int)(a1 >> 7); sa[lane + 64] = sa0[k1]; sb[lane + 64] = sb0[k1];
    }
    asm volatile("" : "+v"(lane));
    float xv[32], y[32];
#pragma unroll
    for (int j = 0; j < 4; ++j) {
        const v4u h0 = *(const v4u*)(hn + (size_t)t * DM + 32 * lane + 8 * j);
#pragma unroll
        for (int w = 0; w < 4; ++w) { const unsigned d0 = (w == 0) ? h0.x : (w == 1) ? h0.y : (w == 2) ? h0.z : h0.w;
            xv[8 * j + 2 * w] = __uint_as_float(d0 << 16); xv[8 * j + 2 * w + 1] = __uint_as_float(d0 & 0xffff0000u); }
    }
#pragma unroll
    for (int i = 0; i < 32; ++i) y[i] = 0.f;
    v4u Ua[4], Ub[4], Va[4];
#define PEER_BATCH(b, UC, VC) do { \
        PEER_LOAD(VC, V8, (b)); \
        float pr[4]; \
        _Pragma("unroll") for (int r = 0; r < 4; ++r) pr[r] = dot_row(UC[r], xv); \
        if ((b) + 2 < 32) PEER_LOAD(UC, U8, (b) + 2); \
        float wr_[4], q2[2]; \
        _Pragma("unroll") for (int r = 0; r < 2; ++r) { auto sw = __builtin_amdgcn_permlane32_swap(__float_as_uint(pr[r]), __float_as_uint(pr[r + 2]), false, false); q2[r] = __uint_as_float(sw[0]) + __uint_as_float(sw[1]); } \
        float tv; \
        { auto sw = __builtin_amdgcn_permlane16_swap(__float_as_uint(q2[0]), __float_as_uint(q2[1]), false, false); tv = __uint_as_float(sw[0]) + __uint_as_float(sw[1]); } \
        tv = DPP_ROR_ADD(tv, 8); tv = DPP_ROR_ADD(tv, 4); tv = DPP_ROR_ADD(tv, 2); tv = DPP_ROR_ADD(tv, 1); \
        const int k = 4 * (b) + (lane >> 4);     \
        const float wc = gelu_erf(tv * sa[k]) * sb[k]; \
        _Pragma("unroll") for (int r = 0; r < 4; ++r) wr_[r] = __uint_as_float(__builtin_amdgcn_readlane(__float_as_uint(wc), 16 * r)); \
        _Pragma("unroll") for (int r = 0; r < 4; ++r) axpy_row(VC[r], wr_[r], y); } while (0)
    PEER_LOAD(Ua, U8, 0); PEER_LOAD(Ub, U8, 1);
#pragma unroll 1
    for (int b = 0; b < 32; b += 2) { PEER_BATCH(b, Ua, Va); PEER_BATCH(b + 1, Ub, Va); }
    float ss = 0.f;
#pragma unroll
    for (int j = 0; j < 8; ++j) { const f32x4 hv = *(const f32x4*)(hbuf + (size_t)t * DM + 32 * lane + 4 * j);
        y[4 * j] += hv.x; y[4 * j + 1] += hv.y; y[4 * j + 2] += hv.z; y[4 * j + 3] += hv.w;
        ss += (y[4 * j] * y[4 * j] + y[4 * j + 1] * y[4 * j + 1]) + (y[4 * j + 2] * y[4 * j + 2] + y[4 * j + 3] * y[4 * j + 3]); }
    ss = wave_sum(ss);
    const float rstd = rsqrtf(ss * (1.f / DM) + EPS);
#pragma unroll
    for (int j = 0; j < 8; ++j) { const f32x4 gg = *(const f32x4*)(gfin + 32 * lane + 4 * j);
        f32x4 o; o.x = y[4 * j] * rstd * gg.x; o.y = y[4 * j + 1] * rstd * gg.y; o.z = y[4 * j + 2] * rstd * gg.z; o.w = y[4 * j + 3] * rstd * gg.w;
        *(f32x4*)(out + (size_t)t * DM + 32 * lane + 4 * j) = o; }
}
typedef short bf16x8 __attribute__((ext_vector_type(8)));
__device__ __forceinline__ int pos32(int x) { const int g = x & ~31, l = x & 31; return g + 8 * ((l & 15) >> 2) + 4 * (l >> 4) + (l & 3); }
constexpr size_t PB_H_QG = 0, PB_H_KDT = 32 * MiB, PB_H_A = 64 * MiB;
constexpr size_t PB_G_QS = 80 * MiB, PB_G_KT = 96 * MiB;
constexpr size_t PB_G_W = 112 * MiB, PB_G_A = 144 * MiB, PB_G_U = 160 * MiB;
constexpr int SC_QG = 0, SC_WV = 16384, SC_KDT = 32768, SC_A = 49152, SC_BUF = 57344, SC_VEC = 2 * SC_BUF, SC_OT = SC_VEC + 2048, SC_OTB = 17408, SC_GAIN = SC_OT + 2 * SC_OTB;

__device__ __forceinline__ bf16x8 pack_frag(const f32x4& x0, const f32x4& x1) {
    v4u w; w.x = pk2(x0.x, x0.y); w.y = pk2(x0.z, x0.w); w.z = pk2(x1.x, x1.y); w.w = pk2(x1.z, x1.w);
    return __builtin_bit_cast(bf16x8, w);
}
#define MFMA16(a, b, c) __builtin_amdgcn_mfma_f32_16x16x32_bf16((a), (b), (c), 0, 0, 0)

__device__ __forceinline__ void hgrn_prep_item(int item, const bf16_t* proj, const float* lb_logits, unsigned char* pb, float* vecs, LAS unsigned char* lds, int tid) {
    const int c = item & 127, sq = item >> 7, b = sq >> 3, h = sq & 7, t0 = b * SEQ + c * 64;
    const int d = tid & 127, seg = tid >> 7, lane = tid & 63, wave = tid >> 6;
    LAS bf16_t* QGl = (LAS bf16_t*)lds; LAS bf16_t* KGl = (LAS bf16_t*)(lds + 17408); LAS float* segsum = (LAS float*)(lds + 34816);
    bf16_t* gQG = (bf16_t*)(pb + PB_H_QG) + (size_t)item * 8192;
    bf16_t* gKDT = (bf16_t*)(pb + PB_H_KDT) + (size_t)item * 8192;
    bf16_t* gA = (bf16_t*)(pb + PB_H_A) + (size_t)item * 4096;
    float* gvec = vecs + (size_t)item * 256;
    const float l0 = lb_logits[h * 128 + d], l1 = lb_logits[1024 + h * 128 + d];
    const float lb = 1.f / (1.f + __expf(l1 - l0));
    float lf[16], qv[16], kv[16];
#pragma unroll
    for (int i = 0; i < 16; ++i) {
        const bf16_t* pr = proj + (size_t)(t0 + 16 * seg + i) * NPROJ + h * 128 + d;
        const float z = bf2f(pr[C_AF]); qv[i] = bf2f(pr[C_AQ]);
        const float f = lb + (1.f - lb) * sigmoidf_(z);
        lf[i] = __logf(f); kv[i] = 1.f - f;
    }
    float run = 0.f;
#pragma unroll
    for (int i = 0; i < 16; ++i) { run += lf[i]; lf[i] = run; }
    segsum[seg * 128 + d] = run;
    __syncthreads();
    float off = 0.f, bl = 0.f;
#pragma unroll
    for (int s = 0; s < 4; ++s) { const float v = segsum[s * 128 + d]; bl += v; if (s < seg) off += v; }
    const int pd = pos32(d);
    float kd[16];
#pragma unroll
    for (int i = 0; i < 16; ++i) {
        const float bc = lf[i] + off; const int tl = 16 * seg + i;
        const float qg = qv[i] * __expf(bc), kg = kv[i] * __expf(-bc);
        kd[i] = kv[i] * __expf(bl - bc);
        const bf16_t qb = f2bf(qg);
        QGl[tl * 136 + d] = qb; KGl[tl * 136 + d] = f2bf(kg);
        gQG[tl * 128 + pd] = qb;
    }
#pragma unroll
    for (int ii = 0; ii < 4; ++ii) { v2u o; o.x = pk2(kd[4 * ii], kd[4 * ii + 1]); o.y = pk2(kd[4 * ii + 2], kd[4 * ii + 3]);
        *(v2u*)(gKDT + d * 64 + 32 * (seg >> 1) + 8 * ii + 4 * (seg & 1)) = o; }
    if (seg == 0) gvec[128 + d] = __expf(bl);
    __syncthreads();
    const int n = lane & 15, q = lane >> 4;
#pragma unroll
    for (int ti = 0; ti < 2; ++ti) {
        const int id = wave + 8 * ti, mt = id >> 2, ns = id & 3;
        f32x4 acc = {0.f, 0.f, 0.f, 0.f};
        if (ns <= mt) {
#pragma unroll
            for (int s4 = 0; s4 < 4; ++s4) {
                const bf16x8 a = *(const LAS bf16x8*)(QGl + (16 * mt + n) * 136 + 32 * s4 + 8 * q);
                const bf16x8 bb = *(const LAS bf16x8*)(KGl + (16 * ns + n) * 136 + 32 * s4 + 8 * q);
                acc = MFMA16(a, bb, acc);
            }
        }
        const int s = 16 * ns + n, ps = pos32(s);
#pragma unroll
        for (int r = 0; r < 4; ++r) { const int t = 16 * mt + 4 * q + r; const float v = (r == 0) ? acc.x : (r == 1) ? acc.y : (r == 2) ? acc.z : acc.w;
            gA[t * 64 + ps] = f2bf((s <= t) ? v : 0.f); }
    }
    __syncthreads();
}

constexpr int GP_QF = 0, GP_KF = 33024, GP_N = 0, GP_QB = 66048, GP_KB = 83456, GP_VB = 100864, GP_PART = 135680, GP_SB = 137728;
__device__ __forceinline__ void gdn_prep_item(int item, const bf16_t* proj, const float* ba, const float* conv_w, const float* A_log, const float* dt_bias,
                                              unsigned char* pb, float* vecs, LAS unsigned char* lds, int tid) {
    const int c = item & 127, bq = item >> 7, b = bq >> 2, qh = bq & 3, t0 = b * SEQ + c * 64;
    const int lane = tid & 63, wave = tid >> 6;
    LAS float* QF = (LAS float*)(lds + GP_QF); LAS float* KF = (LAS float*)(lds + GP_KF);
    LAS bf16_t* QB = (LAS bf16_t*)(lds + GP_QB); LAS bf16_t* KB = (LAS bf16_t*)(lds + GP_KB); LAS bf16_t* VB = (LAS bf16_t*)(lds + GP_VB);
    LAS float* PART = (LAS float*)(lds + GP_PART); LAS float* SBETA = (LAS float*)(lds + GP_SB); LAS float* SGC = SBETA + 128;
    LAS float* NM = (LAS float*)(lds + GP_N);
    {
        int col, wch; const int dd = tid & 127;
        if (tid < 128) { col = C_BQ + qh * 128 + dd; wch = qh * 128 + dd; }
        else if (tid < 256) { col = C_BK + qh * 128 + dd; wch = 512 + qh * 128 + dd; }
        else { const int vh = 2 * qh + ((tid - 256) >> 7); col = C_BV + vh * 128 + dd; wch = 1024 + vh * 128 + dd; }
        const float w0 = conv_w[wch], w1 = conv_w[2048 + wch], w2 = conv_w[4096 + wch], w3 = conv_w[6144 + wch];
        float h0 = 0.f, h1 = 0.f, h2 = 0.f;
        const bf16_t* pr = proj + (size_t)t0 * NPROJ + col;
        if (c > 0) { h0 = bf2f(pr[-3 * NPROJ]); h1 = bf2f(pr[-2 * NPROJ]); h2 = bf2f(pr[-1 * NPROJ]); }
        unsigned xr[64];
#pragma unroll
        for (int t = 0; t < 64; ++t) xr[t] = pr[(size_t)t * NPROJ];
#pragma unroll
        for (int t = 0; t < 64; ++t) {
            const float xx = __uint_as_float(xr[t] << 16);
            const float yv = siluf_(w0 * h0 + w1 * h1 + w2 * h2 + w3 * xx);
            h0 = h1; h1 = h2; h2 = xx;
            if (tid < 128) QF[t * 129 + dd] = yv;
            else if (tid < 256) KF[t * 129 + dd] = yv;
            else VB[((tid - 256) >> 7) * 8704 + t * 136 + dd] = f2bf(yv);
        }
    }
    __syncthreads();
    {
        const int t = tid & 63, part = tid >> 6, which = part >> 2, sub = part & 3;
        const LAS float* src = (which ? KF : QF) + t * 129 + 32 * sub;
        float s = 0.f;
#pragma unroll
        for (int i = 0; i < 32; ++i) s += src[i] * src[i];
        PART[(which * 4 + sub) * 64 + t] = s;
    }
    if (wave < 2) {
        const int vh = 2 * qh + wave;
        const float ax = ba[(size_t)(t0 + lane) * 16 + 8 + vh] + dt_bias[vh];
        const float sp = ax > 20.f ? ax : log1pf(__expf(ax));
        float gc = -__expf(A_log[vh]) * sp;
#pragma unroll
        for (int o = 1; o < 64; o <<= 1) { const float up = __shfl_up(gc, o); if (lane >= o) gc += up; }
        const float gl = __shfl(gc, 63);
        const float beta = sigmoidf_(ba[(size_t)(t0 + lane) * 16 + vh]);
        SBETA[wave * 64 + lane] = beta; SGC[wave * 64 + lane] = gc;
        float* gvec = vecs + ((size_t)(16 + b * 8 + vh) * 128 + c) * 256;
        gvec[lane] = __expf(gc); gvec[64 + lane] = __expf(gl - gc);
        const float dl = __expf(gl); gvec[128 + lane] = dl; gvec[192 + lane] = dl;
    }
    __syncthreads();
    {
        const int d = tid & 127, seg = tid >> 7, pd = pos32(d);
        bf16_t* gQS = (bf16_t*)(pb + PB_G_QS) + (size_t)item * 8192;
        bf16_t* gKT = (bf16_t*)(pb + PB_G_KT) + (size_t)item * 8192;
        float kk[16];
#pragma unroll
        for (int i = 0; i < 16; ++i) {
            const int tl = 16 * seg + i;
            const float sq = PART[0 * 64 + tl] + PART[1 * 64 + tl] + PART[2 * 64 + tl] + PART[3 * 64 + tl];
            const float sk = PART[4 * 64 + tl] + PART[5 * 64 + tl] + PART[6 * 64 + tl] + PART[7 * 64 + tl];
            const bf16_t qb = f2bf(QF[tl * 129 + d] * rsqrtf(sq + EPS) * 0.08838834764831845f);
            const bf16_t kb = f2bf(KF[tl * 129 + d] * rsqrtf(sk + EPS));
            QB[tl * 136 + d] = qb; KB[tl * 136 + d] = kb; gQS[tl * 128 + pd] = qb; kk[i] = bf2f(kb);
        }
#pragma unroll
        for (int ii = 0; ii < 4; ++ii) { v2u o; o.x = pk2(kk[4 * ii], kk[4 * ii + 1]); o.y = pk2(kk[4 * ii + 2], kk[4 * ii + 3]);
            *(v2u*)(gKT + d * 64 + 32 * (seg >> 1) + 8 * ii + 4 * (seg & 1)) = o; }
    }
    __syncthreads();
    {
        const int n = lane & 15, q = lane >> 4;
#pragma unroll
        for (int ti = 0; ti < 2; ++ti) {
            const int id = 2 * wave + ti, mt = id >> 2, ns = id & 3;
            f32x4 akk = {0.f, 0.f, 0.f, 0.f}, aqk = {0.f, 0.f, 0.f, 0.f};
            if (ns <= mt) {
#pragma unroll
                for (int s4 = 0; s4 < 4; ++s4) {
                    const bf16x8 kb_ = *(const LAS bf16x8*)(KB + (16 * ns + n) * 136 + 32 * s4 + 8 * q);
                    const bf16x8 ka_ = *(const LAS bf16x8*)(KB + (16 * mt + n) * 136 + 32 * s4 + 8 * q);
                    const bf16x8 qa_ = *(const LAS bf16x8*)(QB + (16 * mt + n) * 136 + 32 * s4 + 8 * q);
                    akk = MFMA16(ka_, kb_, akk); aqk = MFMA16(qa_, kb_, aqk);
                }
            }
            const int s = 16 * ns + n, ps = pos32(s);
#pragma unroll
            for (int vl = 0; vl < 2; ++vl) {
                bf16_t* gA = (bf16_t*)(pb + PB_G_A) + ((size_t)((b * 8 + 2 * qh + vl) * 128 + c)) * 4096;
                const float gcs = SGC[vl * 64 + s];
#pragma unroll
                for (int r = 0; r < 4; ++r) {
                    const int t = 16 * mt + 4 * q + r;
                    const float vk = (r == 0) ? akk.x : (r == 1) ? akk.y : (r == 2) ? akk.z : akk.w;
                    const float vq = (r == 0) ? aqk.x : (r == 1) ? aqk.y : (r == 2) ? aqk.z : aqk.w;
                    const float ex = (s <= t) ? __expf(SGC[vl * 64 + t] - gcs) : 0.f;
                    NM[vl * 4096 + t * 64 + s] = (s < t) ? SBETA[vl * 64 + t] * vk * ex : 0.f;
                    gA[t * 64 + ps] = f2bf((s <= t) ? vq * ex : 0.f);
                }
            }
        }
    }
    __syncthreads();
    {
        const int vl = tid >> 8, colx = tid & 255;
        float x[64];
        if (colx < 128) {
#pragma unroll
            for (int t = 0; t < 64; ++t) x[t] = SBETA[vl * 64 + t] * bf2f(VB[vl * 8704 + t * 136 + colx]);
        } else {
#pragma unroll
            for (int t = 0; t < 64; ++t) x[t] = SBETA[vl * 64 + t] * __expf(SGC[vl * 64 + t]) * bf2f(KB[t * 136 + colx - 128]);
        }
        __syncthreads();
        const LAS float* Nv = NM + vl * 4096;
#pragma unroll
        for (int t = 1; t < 64; ++t) {
            float acc = x[t];
#pragma unroll
            for (int s4 = 0; s4 < (t + 3) / 4; ++s4) {
                const f32x4 nn = *(const LAS f32x4*)(Nv + t * 64 + 4 * s4);
                acc -= nn.x * x[4 * s4]; if (4 * s4 + 1 < t) acc -= nn.y * x[4 * s4 + 1]; if (4 * s4 + 2 < t) acc -= nn.z * x[4 * s4 + 2]; if (4 * s4 + 3 < t) acc -= nn.w * x[4 * s4 + 3];
            }
            x[t] = acc;
        }
        if (colx < 128) {
            bf16_t* gU = (bf16_t*)(pb + PB_G_U) + ((size_t)((b * 8 + 2 * qh + vl) * 128 + c)) * 8192;
            const int sl = colx >> 4, n = colx & 15;
#pragma unroll
            for (int mt = 0; mt < 4; ++mt)
#pragma unroll
                for (int q = 0; q < 4; ++q) { v2u o; o.x = pk2(x[16 * mt + 4 * q], x[16 * mt + 4 * q + 1]); o.y = pk2(x[16 * mt + 4 * q + 2], x[16 * mt + 4 * q + 3]);
                    *(v2u*)(gU + ((size_t)((sl * 4 + mt) * 64 + q * 16 + n)) * 4) = o; }
        } else {
            LAS bf16_t* WS = (LAS bf16_t*)(lds + GP_QB) + vl * 8704;
            const int pd = pos32(colx - 128);
#pragma unroll
            for (int t = 0; t < 64; ++t) WS[t * 136 + pd] = f2bf(-x[t]);
        }
    }
    __syncthreads();
    {
#pragma unroll
        for (int i = 0; i < 4; ++i) { const int p = tid + 512 * i, vl = p >> 10, row = (p >> 4) & 63, c16 = p & 15;
            bf16_t* gW = (bf16_t*)(pb + PB_G_W) + ((size_t)((b * 8 + 2 * qh + vl) * 128 + c)) * 8192;
            *(v4u*)(gW + row * 128 + c16 * 8) = *(const LAS v4u*)(lds + GP_QB + vl * 17408 + row * 272 + c16 * 16); }
    }
    __syncthreads();
}

struct ScanSrc { const unsigned char* qg; const unsigned char* wv; const unsigned char* kdt; const unsigned char* a; const float* vec; size_t wv_row; };
__device__ __forceinline__ void scan_dma(const ScanSrc& S, LAS unsigned char* buf, LAS unsigned char* vecb, int w, int lane) {
#pragma unroll
    for (int i = 0; i < 2; ++i) { const int pi = 2 * w + i, row = 4 * pi + (lane >> 4), cl = (lane & 15) ^ (row & 15);
        __builtin_amdgcn_global_load_lds((const unsigned*)(S.qg + row * 256 + cl * 16), (LAS unsigned*)(buf + SC_QG + pi * 1024), 16, 0, 0);
        __builtin_amdgcn_global_load_lds((const unsigned*)(S.wv + (size_t)row * S.wv_row + cl * 16), (LAS unsigned*)(buf + SC_WV + pi * 1024), 16, 0, 0); }
#pragma unroll
    for (int i = 0; i < 2; ++i) { const int pi = 2 * w + i, row = 8 * pi + (lane >> 3), cl = (lane & 7) ^ ((row >> 1) & 7);
        __builtin_amdgcn_global_load_lds((const unsigned*)(S.kdt + row * 128 + cl * 16), (LAS unsigned*)(buf + SC_KDT + pi * 1024), 16, 0, 0); }
    { const int pi = w, row = 8 * pi + (lane >> 3), cl = (lane & 7) ^ ((row >> 1) & 7);
        __builtin_amdgcn_global_load_lds((const unsigned*)(S.a + row * 128 + cl * 16), (LAS unsigned*)(buf + SC_A + pi * 1024), 16, 0, 0); }
    if (w == 0) __builtin_amdgcn_global_load_lds((const unsigned*)((const unsigned char*)S.vec + lane * 16), (LAS unsigned*)vecb, 16, 0, 0);
}
__device__ __forceinline__ void scan_block(int sq, const bf16_t* proj, const unsigned char* pb, const float* vecs, const float* hgrn_g, const float* gdn_g,
                                           bf16_t* mix, unsigned* prog, LAS unsigned char* lds, int tid) {
    const bool gdn = sq >= 16;
    const int b = (sq & 15) >> 3, hh = sq & 7, lane = tid & 63, sl = __builtin_amdgcn_readfirstlane(tid >> 6), n = lane & 15, q = lane >> 4;
    const unsigned char* bQG; const unsigned char* bWV; const unsigned char* bKDT; const unsigned char* bA; const unsigned char* bU = nullptr;
    size_t wv_row, wv_chunk; int gate_col, mix_col; const float* gain;
    if (!gdn) {
        const size_t s0 = (size_t)(b * 8 + hh) * 128;
        bQG = pb + PB_H_QG + s0 * 16384; bKDT = pb + PB_H_KDT + s0 * 16384; bA = pb + PB_H_A + s0 * 8192;
        bWV = (const unsigned char*)(proj + (size_t)(b * SEQ) * NPROJ + C_AI + hh * 128); wv_row = (size_t)NPROJ * 2; wv_chunk = (size_t)64 * NPROJ * 2;
        gate_col = C_AG + hh * 128; mix_col = hh * 128; gain = hgrn_g;
    } else {
        const size_t s0 = (size_t)(b * 8 + hh) * 128, q0 = (size_t)(b * 4 + (hh >> 1)) * 128;
        bQG = pb + PB_G_QS + q0 * 16384; bKDT = pb + PB_G_KT + q0 * 16384; bA = pb + PB_G_A + s0 * 8192;
        bWV = pb + PB_G_W + s0 * 16384; wv_row = 256; wv_chunk = 16384; bU = pb + PB_G_U + s0 * 16384;
        gate_col = C_BZ + hh * 128; mix_col = 1024 + hh * 128; gain = gdn_g;
    }
    const float* bvec = vecs + (size_t)sq * 128 * 256;
    LAS float* gainl = (LAS float*)(lds + SC_GAIN);
    const int wave = sl;
    {
        ScanSrc src{bQG, bWV, bKDT, bA, bvec, wv_row};
        scan_dma(src, lds, lds + SC_VEC, wave, lane);
        if (tid < 128) gainl[tid] = gain[tid];
    }
    asm volatile("s_waitcnt vmcnt(0) lgkmcnt(0)" ::: "memory");
    __builtin_amdgcn_s_barrier();
    asm volatile("" ::: "memory");
#define SCAN_BAR() do { asm volatile("s_waitcnt lgkmcnt(0)" ::: "memory"); __builtin_amdgcn_s_barrier(); asm volatile("" ::: "memory"); } while (0)
#define SCHED_FENCE() __builtin_amdgcn_sched_barrier(0)
    if (wave < 4) {
        f32x4 S[2][8];
#pragma unroll
        for (int e = 0; e < 2; ++e)
#pragma unroll
            for (int m = 0; m < 8; ++m) S[e][m] = (f32x4){0.f, 0.f, 0.f, 0.f};
        v2u Ureg[2][4];
#pragma unroll
        for (int e = 0; e < 2; ++e)
#pragma unroll
            for (int mt = 0; mt < 4; ++mt) Ureg[e][mt] = gdn ? *(const v2u*)(bU + (size_t)((2 * wave + e) * 4 + mt) * 512 + lane * 8) : (v2u){0u, 0u};
        for (int c = 0; c < 128; ++c) {
            int lane = tid & 63; asm volatile("" : "+v"(lane));
            const int n = lane & 15, q = lane >> 4;
            const int cur = c & 1;
            LAS unsigned char* buf = lds + cur * SC_BUF;
            const LAS float* vec = (const LAS float*)(lds + SC_VEC + cur * 1024);
            const int cn = (c + 1 < 128) ? c + 1 : 127;
            bf16x8 Sf[2][4];
#pragma unroll
            for (int e = 0; e < 2; ++e)
#pragma unroll
                for (int s4 = 0; s4 < 4; ++s4) Sf[e][s4] = pack_frag(S[e][2 * s4], S[e][2 * s4 + 1]);
            bf16x8 fa[4], fb[4];
            bf16x8 VNf[2][2], VNSf[2][2];
#define SC2_LD4_K128(dst, OFF, mt_) do { _Pragma("unroll") for (int i_ = 0; i_ < 4; ++i_) dst[i_] = *(const LAS bf16x8*)(buf + (OFF) + (16 * (mt_) + n) * 256 + (((4 * i_ + q) ^ n) * 16)); } while (0)
#define SC2_LD4_K64(dst, OFF, mb) do { _Pragma("unroll") for (int i_ = 0; i_ < 4; ++i_) dst[i_] = *(const LAS bf16x8*)(buf + (OFF) + (16 * ((mb) + (i_ >> 1)) + n) * 128 + (((4 * (i_ & 1) + q) ^ ((n >> 1) & 7)) * 16)); } while (0)
#define SC2_MM_K128(A0, A1, fr) do { _Pragma("unroll") for (int i_ = 0; i_ < 4; ++i_) { A0 = MFMA16(fr[i_], Sf[0][i_], A0); A1 = MFMA16(fr[i_], Sf[1][i_], A1); } } while (0)
#define SC2_MM_K64(X, ma, fr, BF) do { X[0][ma] = MFMA16(fr[0], BF[0][0], X[0][ma]); X[1][ma] = MFMA16(fr[0], BF[1][0], X[1][ma]); X[0][ma] = MFMA16(fr[1], BF[0][1], X[0][ma]); X[1][ma] = MFMA16(fr[1], BF[1][1], X[1][ma]); \
        X[0][(ma) + 1] = MFMA16(fr[2], BF[0][0], X[0][(ma) + 1]); X[1][(ma) + 1] = MFMA16(fr[2], BF[1][0], X[1][(ma) + 1]); X[0][(ma) + 1] = MFMA16(fr[3], BF[0][1], X[0][(ma) + 1]); X[1][(ma) + 1] = MFMA16(fr[3], BF[1][1], X[1][(ma) + 1]); } while (0)
            if (gdn) {
                f32x4 VN[2][4];
                SC2_LD4_K128(fa, SC_WV, 0); SCHED_FENCE();
                SC2_LD4_K128(fb, SC_WV, 1); SCHED_FENCE();
#pragma unroll
                for (int e = 0; e < 2; ++e)
#pragma unroll
                    for (int mt = 0; mt < 4; ++mt) { const v2u uu = Ureg[e][mt];
                        VN[e][mt] = (f32x4){__uint_as_float(uu.x << 16), __uint_as_float(uu.x & 0xffff0000u), __uint_as_float(uu.y << 16), __uint_as_float(uu.y & 0xffff0000u)}; }
#pragma unroll
                for (int e = 0; e < 2; ++e)
#pragma unroll
                    for (int mt = 0; mt < 4; ++mt) Ureg[e][mt] = *(const v2u*)(bU + (size_t)cn * 16384 + (size_t)((2 * wave + e) * 4 + mt) * 512 + lane * 8);
                SC2_MM_K128(VN[0][0], VN[1][0], fa); SCHED_FENCE(); SC2_LD4_K128(fa, SC_WV, 2); SCHED_FENCE();
                SC2_MM_K128(VN[0][1], VN[1][1], fb); SCHED_FENCE(); SC2_LD4_K128(fb, SC_WV, 3); SCHED_FENCE();
                SC2_MM_K128(VN[0][2], VN[1][2], fa); SCHED_FENCE(); SC2_LD4_K128(fa, SC_QG, 0); SCHED_FENCE();
                SC2_MM_K128(VN[0][3], VN[1][3], fb); SCHED_FENCE(); SC2_LD4_K128(fb, SC_QG, 1); SCHED_FENCE();
#pragma unroll
                for (int e = 0; e < 2; ++e)
#pragma unroll
                    for (int s2 = 0; s2 < 2; ++s2) { const f32x4 e0 = *(const LAS f32x4*)(vec + 64 + 16 * (2 * s2) + 4 * q), e1 = *(const LAS f32x4*)(vec + 64 + 16 * (2 * s2 + 1) + 4 * q);
                        VNf[e][s2] = pack_frag(VN[e][2 * s2], VN[e][2 * s2 + 1]); VNSf[e][s2] = pack_frag(VN[e][2 * s2] * e0, VN[e][2 * s2 + 1] * e1); }
            } else {
                SC2_LD4_K128(fa, SC_QG, 0); SCHED_FENCE();
                SC2_LD4_K128(fb, SC_QG, 1); SCHED_FENCE();
#pragma unroll
                for (int e = 0; e < 2; ++e)
#pragma unroll
                    for (int s2 = 0; s2 < 2; ++s2) { unsigned w[4];
#pragma unroll
                        for (int jj = 0; jj < 4; ++jj) { const int ja = 2 * jj, jb = 2 * jj + 1; const int cc = 16 * (2 * wave + e) + n;
                            const int ta = 32 * s2 + ((ja < 4) ? 4 * q + ja : 16 + 4 * q + ja - 4), tb = 32 * s2 + ((jb < 4) ? 4 * q + jb : 16 + 4 * q + jb - 4);
                            const unsigned lo = *(const LAS bf16_t*)(buf + SC_WV + ta * 256 + (((cc >> 3) ^ (ta & 15)) * 16) + (cc & 7) * 2), hi = *(const LAS bf16_t*)(buf + SC_WV + tb * 256 + (((cc >> 3) ^ (tb & 15)) * 16) + (cc & 7) * 2);
                            w[jj] = lo | (hi << 16); }
                        v4u ww; ww.x = w[0]; ww.y = w[1]; ww.z = w[2]; ww.w = w[3];
                        VNf[e][s2] = __builtin_bit_cast(bf16x8, ww); VNSf[e][s2] = VNf[e][s2]; }
            }
            f32x4 O[2][4];
#pragma unroll
            for (int e = 0; e < 2; ++e)
#pragma unroll
                for (int mt = 0; mt < 4; ++mt) O[e][mt] = (f32x4){0.f, 0.f, 0.f, 0.f};
            SC2_MM_K128(O[0][0], O[1][0], fa); SCHED_FENCE(); SC2_LD4_K128(fa, SC_QG, 2); SCHED_FENCE();
            SC2_MM_K128(O[0][1], O[1][1], fb); SCHED_FENCE(); SC2_LD4_K128(fb, SC_QG, 3); SCHED_FENCE();
            SC2_MM_K128(O[0][2], O[1][2], fa); SCHED_FENCE(); SC2_LD4_K64(fa, SC_A, 0); SCHED_FENCE();
            SC2_MM_K128(O[0][3], O[1][3], fb); SCHED_FENCE(); SC2_LD4_K64(fb, SC_A, 2); SCHED_FENCE();
            if (gdn) {
#pragma unroll
                for (int mt = 0; mt < 4; ++mt) { const f32x4 eg4 = *(const LAS f32x4*)(vec + 16 * mt + 4 * q); O[0][mt] = O[0][mt] * eg4; O[1][mt] = O[1][mt] * eg4; }
            }
            SC2_MM_K64(O, 0, fa, VNf); SCHED_FENCE(); SC2_LD4_K64(fa, SC_KDT, 0); SCHED_FENCE();
            SC2_MM_K64(O, 2, fb, VNf); SCHED_FENCE(); SC2_LD4_K64(fb, SC_KDT, 2); SCHED_FENCE();
#pragma unroll
            for (int m = 0; m < 8; ++m) { const f32x4 d4 = *(const LAS f32x4*)(vec + 128 + 16 * m + 4 * q); S[0][m] = S[0][m] * d4; S[1][m] = S[1][m] * d4; }
            SC2_MM_K64(S, 0, fa, VNSf); SCHED_FENCE(); SC2_LD4_K64(fa, SC_KDT, 4); SCHED_FENCE();
            SC2_MM_K64(S, 2, fb, VNSf); SCHED_FENCE(); SC2_LD4_K64(fb, SC_KDT, 6); SCHED_FENCE();
            SC2_MM_K64(S, 4, fa, VNSf);
            SC2_MM_K64(S, 6, fb, VNSf);
            LAS bf16_t* OT = (LAS bf16_t*)(lds + SC_OT + cur * SC_OTB);
#pragma unroll
            for (int e = 0; e < 2; ++e)
#pragma unroll
                for (int mt = 0; mt < 4; ++mt) { const int cc = 16 * (2 * wave + e) + n;
                    OT[(16 * mt + 4 * q + 0) * 136 + cc] = f2bf(O[e][mt].x); OT[(16 * mt + 4 * q + 1) * 136 + cc] = f2bf(O[e][mt].y);
                    OT[(16 * mt + 4 * q + 2) * 136 + cc] = f2bf(O[e][mt].z); OT[(16 * mt + 4 * q + 3) * 136 + cc] = f2bf(O[e][mt].w); }
            SCAN_BAR();
        }
    } else {
        const int hw = wave - 4;
        v4u gprev[4]; v4u G[15];
#pragma unroll
        for (int i = 0; i < 4; ++i) gprev[i] = (v4u){0u, 0u, 0u, 0u};
        for (int c = 0; c <= 128; ++c) {
            int lane = tid & 63; asm volatile("" : "+v"(lane));
            const int rt = hw * 16 + (lane >> 2), cg4 = lane & 3;
            const int t0 = b * SEQ + c * 64;
            v4u gcur[4];
            if (c < 128) {
                if (tid == 256) __hip_atomic_store(prog + sq, (unsigned)c, __ATOMIC_RELAXED, __HIP_MEMORY_SCOPE_AGENT);
                const int cn = (c + 1 < 128) ? c + 1 : 127;
                {
                    const unsigned char* sQG = bQG + (size_t)cn * 16384 + (size_t)hw * 4096; const unsigned char* sWV = bWV + (size_t)cn * wv_chunk + (size_t)(16 * hw) * wv_row;
                    const unsigned char* sKDT = bKDT + (size_t)cn * 16384 + (size_t)hw * 4096; const unsigned char* sA = bA + (size_t)cn * 8192 + (size_t)hw * 2048;
                    const unsigned l16 = (unsigned)lane * 16u, offv = (unsigned)(lane >> 4) * (unsigned)wv_row + (unsigned)(lane & 15) * 16u;
#pragma unroll
                    for (int i = 0; i < 4; ++i) { G[i] = *(const v4u*)(sQG + i * 1024 + l16); G[4 + i] = *(const v4u*)(sWV + (size_t)(4 * i) * wv_row + offv); }
#pragma unroll
                    for (int i = 0; i < 4; ++i) G[8 + i] = *(const v4u*)(sKDT + i * 1024 + l16);
#pragma unroll
                    for (int i = 0; i < 2; ++i) G[12 + i] = *(const v4u*)(sA + i * 1024 + l16);
                    G[14] = *(const v4u*)((const unsigned char*)(bvec + (size_t)cn * 256) + l16);
                }
                const bf16_t* gp = proj + (size_t)(t0 + rt) * NPROJ + gate_col + 32 * cg4;
#pragma unroll
                for (int i = 0; i < 4; ++i) gcur[i] = *(const v4u*)(gp + 8 * i);
            } else {
#pragma unroll
                for (int i = 0; i < 4; ++i) gcur[i] = (v4u){0u, 0u, 0u, 0u};
            }
            v4u ysave[4];
#pragma unroll
            for (int i = 0; i < 4; ++i) ysave[i] = (v4u){0u, 0u, 0u, 0u};
            if (c > 0) {
                const int pc = c - 1, pt0 = b * SEQ + pc * 64;
                const LAS bf16_t* OT = (const LAS bf16_t*)(lds + SC_OT + (pc & 1) * SC_OTB);
                float ov[32]; float ss = 0.f;
#pragma unroll
                for (int i = 0; i < 4; ++i) { const v4u o4 = *(const LAS v4u*)(OT + rt * 136 + 32 * cg4 + 8 * i);
#pragma unroll
                    for (int w = 0; w < 4; ++w) { const unsigned a = (w == 0) ? o4.x : (w == 1) ? o4.y : (w == 2) ? o4.z : o4.w;
                        ov[8 * i + 2 * w] = __uint_as_float(a << 16); ov[8 * i + 2 * w + 1] = __uint_as_float(a & 0xffff0000u); } }
#pragma unroll
                for (int i = 0; i < 32; ++i) ss += ov[i] * ov[i];
                ss += __shfl_xor(ss, 1); ss += __shfl_xor(ss, 2);
                const float rstd = rsqrtf(ss * (1.f / 128.f) + EPS);
#pragma unroll
                for (int i = 0; i < 4; ++i) {
                    const f32x4 g0 = *(const LAS f32x4*)(gainl + 32 * cg4 + 8 * i), g1 = *(const LAS f32x4*)(gainl + 32 * cg4 + 8 * i + 4);
                    float yv[8];
#pragma unroll
                    for (int w = 0; w < 4; ++w) { const unsigned ga = (w == 0) ? gprev[i].x : (w == 1) ? gprev[i].y : (w == 2) ? gprev[i].z : gprev[i].w;
                        const float z0 = __uint_as_float(ga << 16), z1 = __uint_as_float(ga & 0xffff0000u);
                        const float gg0 = (w == 0) ? g0.x : (w == 1) ? g0.z : (w == 2) ? g1.x : g1.z, gg1 = (w == 0) ? g0.y : (w == 1) ? g0.w : (w == 2) ? g1.y : g1.w;
                        yv[2 * w] = ov[8 * i + 2 * w] * rstd * gg0 * z0;
                        yv[2 * w + 1] = ov[8 * i + 2 * w + 1] * rstd * gg1 * z1; }
                    v4u y4; y4.x = pk2(yv[0], yv[1]); y4.y = pk2(yv[2], yv[3]); y4.z = pk2(yv[4], yv[5]); y4.w = pk2(yv[6], yv[7]);
                    ysave[i] = y4;
                }
            }
#pragma unroll
            for (int i = 0; i < 4; ++i) gprev[i] = gcur[i];
            if (c < 128) {
                LAS unsigned char* nb = lds + ((c + 1) & 1) * SC_BUF + hw * 4096; LAS unsigned char* nv = lds + SC_VEC + ((c + 1) & 1) * 1024;
                const int lq = lane >> 4;
#pragma unroll
                for (int i = 0; i < 4; ++i) { const int d = lq * 256 + (((lane & 15) ^ (4 * i + lq)) * 16);
                    *(LAS v4u*)(nb + SC_QG + i * 1024 + d) = G[i]; *(LAS v4u*)(nb + SC_WV + i * 1024 + d) = G[4 + i]; }
#pragma unroll
                for (int i = 0; i < 4; ++i) { const int d = (lane >> 3) * 128 + (((lane & 7) ^ (4 * (i & 1) + lq)) * 16); *(LAS v4u*)(nb + SC_KDT + i * 1024 + d) = G[8 + i]; }
#pragma unroll
                for (int i = 0; i < 2; ++i) { const int d = (lane >> 3) * 128 + (((lane & 7) ^ (4 * i + lq)) * 16); *(LAS v4u*)(nb - hw * 2048 + SC_A + i * 1024 + d) = G[12 + i]; }
                if (hw == 0) *(LAS v4u*)(nv + lane * 16) = G[14];
            }
            if (c > 0) {
                bf16_t* mp = mix + (size_t)(b * SEQ + (c - 1) * 64 + rt) * DM + mix_col + 32 * cg4;
#pragma unroll
                for (int i = 0; i < 4; ++i) *(v4u*)(mp + 8 * i) = ysave[i];
            }
            if (c < 128) SCAN_BAR();
        }
    }
    __syncthreads();
}

constexpr int PROG_WORD = 3584;
__device__ __forceinline__ void scan_warmer(int x  , int k  , const bf16_t* proj, const unsigned char* pb, const float* vecs,
                                            unsigned* ctl, LAS unsigned char* lds, int tid) {
    constexpr int AHEAD = 6, NH = 1168, NG = 1424;
    const int gid = k * 512 + tid;
    int sq, r; bool active = true;
    if (gid < NH) { sq = x; r = gid; } else if (gid < 2 * NH) { sq = x + 8; r = gid - NH; }
    else if (gid < 2 * NH + NG) { sq = x + 16; r = gid - 2 * NH; } else if (gid < 2 * NH + 2 * NG) { sq = x + 24; r = gid - 2 * NH - NG; }
    else { sq = x; r = 0; active = false; }
    const int b = (sq & 15) >> 3, hh = sq & 7;
    const unsigned char* base; size_t stride;
    if (sq < 16) {
        const size_t s0 = (size_t)(b * 8 + hh) * 128;
        if (r < 256) { base = pb + PB_H_QG + s0 * 16384 + r * 64; stride = 16384; }
        else if (r < 512) { base = pb + PB_H_KDT + s0 * 16384 + (r - 256) * 64; stride = 16384; }
        else if (r < 640) { base = pb + PB_H_A + s0 * 8192 + (r - 512) * 64; stride = 8192; }
        else if (r < 656) { base = (const unsigned char*)(vecs + (size_t)sq * 128 * 256) + (r - 640) * 64; stride = 1024; }
        else { const int rr = (r - 656) & 255, col = (r < 912) ? C_AI : C_AG;
            base = (const unsigned char*)(proj + (size_t)(b * SEQ + (rr >> 2)) * NPROJ + col + hh * 128) + (rr & 3) * 64; stride = (size_t)64 * NPROJ * 2; }
    } else {
        const size_t s0 = (size_t)(b * 8 + hh) * 128, q0 = (size_t)(b * 4 + (hh >> 1)) * 128;
        if (r < 256) { base = pb + PB_G_QS + q0 * 16384 + r * 64; stride = 16384; }
        else if (r < 512) { base = pb + PB_G_KT + q0 * 16384 + (r - 256) * 64; stride = 16384; }
        else if (r < 768) { base = pb + PB_G_W + s0 * 16384 + (r - 512) * 64; stride = 16384; }
        else if (r < 896) { base = pb + PB_G_A + s0 * 8192 + (r - 768) * 64; stride = 8192; }
        else if (r < 1152) { base = pb + PB_G_U + s0 * 16384 + (r - 896) * 64; stride = 16384; }
        else if (r < 1168) { base = (const unsigned char*)(vecs + (size_t)sq * 128 * 256) + (r - 1152) * 64; stride = 1024; }
        else { const int rr = r - 1168;
            base = (const unsigned char*)(proj + (size_t)(b * SEQ + (rr >> 2)) * NPROJ + C_BZ + hh * 128) + (rr & 3) * 64; stride = (size_t)64 * NPROJ * 2; }
    }
    volatile LAS unsigned* flag = (volatile LAS unsigned*)lds;
    for (int ct = 1; ct < 128; ++ct) {
        if (ct > AHEAD) {
            if (tid == 0) {
                unsigned spins = 0;
                for (;;) {
                    unsigned mn = 0xffffffffu;
#pragma unroll
                    for (int j = 0; j < 4; ++j) { const unsigned pv = __hip_atomic_load(ctl + PROG_WORD + x + 8 * j, __ATOMIC_RELAXED, __HIP_MEMORY_SCOPE_AGENT); mn = pv < mn ? pv : mn; }
                    if ((int)mn + AHEAD >= ct || ++spins > 200000u) break;
                    __builtin_amdgcn_s_sleep(4);
                }
            }
            __syncthreads();
        }
        if (active) { unsigned tmp; const unsigned char* pa = base + (size_t)ct * stride;
            asm volatile("global_load_dword %0, %1, off" : "=v"(tmp) : "v"(pa) : "memory"); }
    }
    asm volatile("s_waitcnt vmcnt(0)" ::: "memory");
    (void)flag;
}

struct EpiProj {
    static constexpr bool PERM = true, AFTER_DRAIN = false;
    bf16_t* O; int ldc;
    __device__ __forceinline__ void operator()(const pg8::f32x4 (&acc)[2][2][4][2], const pg8::Unit& u, int wr, int wc, int fr, int fq) const {
        const int row0 = u.pm * 256 + wr * 64 + fr, col0 = u.pn * 256 + wc * 32 + 8 * fq;
        const bool gate = (u.pn >= 12 && u.pn < 16) || (u.pn >= 24);
#pragma unroll
        for (int ai = 0; ai < 2; ++ai)
#pragma unroll
            for (int m = 0; m < 4; ++m) { bf16_t* rowp = O + (size_t)(row0 + ai * 128 + m * 16) * ldc + col0;
#pragma unroll
                for (int bj = 0; bj < 2; ++bj) { pg8::f32x4 v0 = acc[ai][bj][m][0], v1 = acc[ai][bj][m][1];
                    if (gate) {
#pragma unroll
                        for (int e = 0; e < 4; ++e) { v0[e] = v0[e] * __builtin_amdgcn_rcpf(1.f + __expf(-v0[e])); v1[e] = v1[e] * __builtin_amdgcn_rcpf(1.f + __expf(-v1[e])); } }
                    pg8::u32x4 w; w.x = pk2(v0[0], v0[1]); w.y = pk2(v0[2], v0[3]); w.z = pk2(v1[0], v1[1]); w.w = pk2(v1[2], v1[3]);
                    *(pg8::u32x4*)(rowp + bj * 128) = w; } }
    }
};
struct EpiResF32 {
    static constexpr bool PERM = false, AFTER_DRAIN = false;
    const float* R; float* O; int ldc;
    __device__ __forceinline__ void operator()(const pg8::f32x4 (&acc)[2][2][4][2], const pg8::Unit& u, int wr, int wc, int fr, int fq) const {
        const int row0 = u.pm * 256 + wr * 64 + fr, col0 = u.pn * 256 + wc * 32 + 4 * fq;
#pragma unroll
        for (int ai = 0; ai < 2; ++ai)
#pragma unroll
            for (int m = 0; m < 4; ++m) { const size_t off = (size_t)(row0 + ai * 128 + m * 16) * ldc + col0;
#pragma unroll
                for (int bj = 0; bj < 2; ++bj)
#pragma unroll
                    for (int n = 0; n < 2; ++n) { pg8::f32x4 v = acc[ai][bj][m][n]; if (R) v = v + *(const pg8::f32x4*)(R + off + bj * 128 + n * 16); *(pg8::f32x4*)(O + off + bj * 128 + n * 16) = v; } }
    }
};

#define XB_TMO      128
#define XB_XCNT(j)  (256  + 64 * (j))
#define XB_XSUB(j)  (1280 + 64 * (j))
#define XB_XGEN(j)  (2304 + 64 * (j))
#define XB_TOP      3328
#define XB_TOPGEN   3392
#define XCD_BAR_WORDS 3456
#define XB_SPIN_CAP (1u << 18)

__device__ __forceinline__ unsigned xb_ld(unsigned* p)              { return __hip_atomic_load(p, __ATOMIC_RELAXED, __HIP_MEMORY_SCOPE_AGENT); }
__device__ __forceinline__ unsigned xb_add(unsigned* p, unsigned v) { return __hip_atomic_fetch_add(p, v, __ATOMIC_RELAXED, __HIP_MEMORY_SCOPE_AGENT); }
__device__ __forceinline__ unsigned xb_xcc_id() { return (unsigned)__builtin_amdgcn_s_getreg((3 << 11) | 20) & 0xFu; }
#define XB_SPIN(cond, bar) do { unsigned _sp = 0; while (cond) { __builtin_amdgcn_s_sleep(1); \
    if ((++_sp & 255u) == 0u) { if (xb_ld(&(bar)[XB_TMO])) break; if (_sp > XB_SPIN_CAP) { atomicAdd(&(bar)[XB_TMO], 1u); break; } } } } while (0)

struct XcdBarrier {
    unsigned* bar; unsigned x;
    volatile LAS unsigned* st;
};

__device__ __forceinline__ XcdBarrier xcd_barrier_post(unsigned* bar, volatile LAS unsigned* st) {
    XcdBarrier b; b.bar = bar; b.x = xb_xcc_id(); b.st = st;
    if (threadIdx.x == 0) (void)xb_add(&bar[XB_XCNT(b.x)], 1u);
    return b;
}
__device__ __forceinline__ void xcd_barrier_complete(unsigned* bar, unsigned x, unsigned& nloc, unsigned& nx) {
    const unsigned G = gridDim.x * gridDim.y * gridDim.z;
    unsigned sum, cnt, mine, sp = 0u;
    for (;;) {
        sum = 0u; cnt = 0u; mine = 0u;
#pragma unroll
        for (unsigned j = 0; j < 16; ++j) { const unsigned c = xb_ld(&bar[XB_XCNT(j)]); sum += c; cnt += (c > 0u) ? 1u : 0u; mine = (j == x) ? c : mine; }
        if (sum == G) break;
        __builtin_amdgcn_s_sleep(1);
        if ((++sp & 255u) == 0u) { if (xb_ld(&bar[XB_TMO])) break; if (sp > XB_SPIN_CAP) { atomicAdd(&bar[XB_TMO], 1u); break; } }
    }
    nloc = mine > 0u ? mine : 1u; nx = cnt > 0u ? cnt : 1u;
}

__device__ __forceinline__ void xcd_barrier(const XcdBarrier& b) {
    asm volatile("s_waitcnt vmcnt(0)" ::: "memory");
    __syncthreads();
    if (threadIdx.x == 0) {
        unsigned* bar = b.bar;
        __builtin_amdgcn_s_waitcnt(0);
        unsigned nloc = b.st[0], nx = b.st[1];
        if (nloc == 0u) { xcd_barrier_complete(bar, b.x, nloc, nx); b.st[0] = nloc; b.st[1] = nx; }
        const unsigned old = xb_add(&bar[XB_XSUB(b.x)], 1u);
        const unsigned gen = old / nloc;
        if (old + 1u == (gen + 1u) * nloc) {
            __builtin_amdgcn_fence(__ATOMIC_RELEASE, "agent");
            asm volatile("s_waitcnt vmcnt(0)" ::: "memory");
            const unsigned og = xb_add(&bar[XB_TOP], 1u);
            const unsigned tg = og / nx;
            if (og + 1u == (tg + 1u) * nx) xb_add(&bar[XB_TOPGEN], 1u);
            else XB_SPIN(xb_ld(&bar[XB_TOPGEN]) == tg, bar);
            __builtin_amdgcn_fence(__ATOMIC_ACQUIRE, "agent");
            xb_add(&bar[XB_XGEN(b.x)], 1u);
            asm volatile("s_waitcnt vmcnt(0)" ::: "memory");
        } else {
            XB_SPIN(xb_ld(&bar[XB_XGEN(b.x)]) == gen, bar);
            __builtin_amdgcn_fence(__ATOMIC_ACQUIRE, "agent");
            asm volatile("s_waitcnt vmcnt(0)" ::: "memory");
        }
    }
    __syncthreads();
}

__device__ __forceinline__ int get_lane() { int l = (int)__builtin_amdgcn_mbcnt_hi(~0u, __builtin_amdgcn_mbcnt_lo(~0u, 0u)); asm volatile("" : "+v"(l)); return l; }
__global__ void __launch_bounds__(NT, 2) mk_fwd(Args args) {
    extern __shared__ __attribute__((aligned(16))) unsigned char lds_raw[];
    LAS unsigned char* lds = (LAS unsigned char*)lds_raw;
    cg::grid_group grid = cg::this_grid();
    const int tid = threadIdx.x, wave = __builtin_amdgcn_readfirstlane(tid >> 6);

    const int G = gridDim.x, bx = blockIdx.x;
    const int vcu = (G % 8 == 0) ? (bx % 8) * (G / 8) + bx / 8 : bx;
    const int gw = vcu * NW + wave, NGW = G * NW;
    unsigned char* ws = args.ws;
    const float* x = args.in[0]; const float* attn_g = args.in[1]; const float* w_in = args.in[2];
    const float* w_out = args.in[9]; const float* ffn_g = args.in[10]; const float* w_query = args.in[11]; const float* sub_keys = args.in[12];
    bf16_t* WinT = (bf16_t*)(ws + OFF_D);
    bf16_t* WoutT = (bf16_t*)(ws + OFF_C);
    bf16_t* Wqk = (bf16_t*)(ws + OFF_C + 8 * MiB);
    bf16_t* xn = (bf16_t*)(ws + OFF_D + 28 * MiB);
    float* ba = (float*)(ws + OFF_S);
    bf16_t* proj = (bf16_t*)(ws + OFF_B);
    bf16_t* mix = (bf16_t*)args.out;
    unsigned char* pb = ws + OFF_D; float* vecs = (float*)(ws + OFF_S + 2 * MiB);
    float* hbuf = (float*)(ws + OFF_B);
    bf16_t* hn = (bf16_t*)(ws + OFF_D + 128 * MiB);
    float* scores = (float*)(ws + OFF_D);
    unsigned char* U8 = ws + OFF_TAB; unsigned char* V8 = ws + OFF_TAB + 16 * MiB;
    float* inv_su = (float*)(ws + OFF_S + 1 * MiB); float* inv_sv = inv_su + 16384;

    volatile LAS unsigned* xbst = (volatile LAS unsigned*)(lds + LDS_BYTES - 16);
    if (tid < 4) xbst[tid] = 0u;
    __syncthreads();
    XcdBarrier xbar = xcd_barrier_post((unsigned*)args.ws, xbst);
    const int lo = args.ph_lo, hi = args.ph_hi;
#define IN(k) (lo <= (k) && (k) < hi)
#define SYNC_AFTER(k) do { if (IN(k) && (k) + 1 < hi) { if ((k) == 0) grid.sync(); else xcd_barrier(xbar); } } while (0)
    {
        if (IN(0)) {
            const int lane = get_lane();
            LAS float* scr = (LAS float*)(lds + wave * 16384);
            constexpr int I_IN = (DM / 64) * (NPROJ / 32);
            for (int it = gw; it < I_IN; it += NGW) transpose_item(w_in, INW, DM, NPROJ, WinT, scr, it, lane);
            __syncthreads();
            {
                LAS float* wt = (LAS float*)lds;
#pragma unroll
                for (int k = 0; k < 4; ++k) { const int d = tid + 512 * k; const float* wr = w_in + (size_t)d * INW + NPROJ;
#pragma unroll
                    for (int q4 = 0; q4 < 4; ++q4) { const f32x4 w4 = *(const f32x4*)(wr + 4 * q4);
                        wt[(4 * q4 + 0) * 2048 + d] = w4.x; wt[(4 * q4 + 1) * 2048 + d] = w4.y; wt[(4 * q4 + 2) * 2048 + d] = w4.z; wt[(4 * q4 + 3) * 2048 + d] = w4.w; } }
            }
            __syncthreads();
            for (int m = gw; m < T; m += NGW) norm_row<true>(x + (size_t)m * DM, attn_g, (const LAS float*)lds, xn + (size_t)m * DM, ba + (size_t)m * 16, lane);
        }
        SYNC_AFTER(0);
        if (IN(1)) {
            pg8::Gemm g{xn, WinT, T, NPROJ, DM}; pg8::StaticOrder S; S.init(T, NPROJ, G, bx);
            EpiProj E{proj, NPROJ};
            pg8::gemm_phase<EpiProj, pg8::StaticOrder, true, true>(lds, g, S, E);
        }
        SYNC_AFTER(1);
        if (IN(2)) {
            for (int it = bx; it < 2048; it += G) { int tt = threadIdx.x; asm volatile("" : "+v"(tt)); hgrn_prep_item(it, proj, args.in[3], pb, vecs, lds, tt); }
            for (int it = bx; it < 1024; it += G) { int tt = threadIdx.x; asm volatile("" : "+v"(tt)); gdn_prep_item(it, proj, ba, args.in[5], args.in[6], args.in[7], pb, vecs, lds, tt); }
        }
        SYNC_AFTER(2);
        if (IN(3)) {
            const int lane = get_lane();
            unsigned* ctl = (unsigned*)args.ws;
            if (bx < 32) scan_block(bx, proj, pb, vecs, args.in[4], args.in[8], mix, ctl + PROG_WORD, lds, tid);
            else if (G > 32) {
                int fb, FB;
                fb = bx - 32; FB = G - 32;
                const int fw = fb * NW + wave, FW = FB * NW;
                for (int it = fb; it < 512; it += FB) wqk_item(w_query, sub_keys, Wqk, (LAS float*)lds, it, tid);
                LAS float* scr = (LAS float*)(lds + wave * 16384);
                constexpr int I_OUT = (DM / 64) * (DM / 32);
                for (int it = fw; it < I_OUT; it += FW) transpose_item(w_out, DM, DM, DM, WoutT, scr, it, lane);
                for (int e = fw; e < 32768; e += FW) { const bool isv = e >= 16384; const int r = e & 16383;
                    table_row((isv ? args.in[14] : args.in[13]) + (size_t)r * DM, (unsigned*)((isv ? V8 : U8) + (size_t)r * 1024), (isv ? inv_sv : inv_su) + r, lane); }
            }
        }
        SYNC_AFTER(3);
        if (IN(4)) {
            pg8::Gemm g{mix, WoutT, T, DM, DM}; pg8::StaticOrder S; S.init(T, DM, G, bx);
            EpiResF32 E{x, hbuf, DM};
            pg8::gemm_phase<EpiResF32, pg8::StaticOrder, true, true>(lds, g, S, E);
        }
        SYNC_AFTER(4);
        if (IN(5)) {
            const int lane = get_lane();
            for (int m = gw; m < T; m += NGW) norm_row<false>(hbuf + (size_t)m * DM, ffn_g, (const LAS float*)lds, hn + (size_t)m * DM, nullptr, lane);
        }
        SYNC_AFTER(5);
        if (IN(6)) {
            pg8::Gemm g{hn, Wqk, T, DM, DM}; pg8::StaticOrder S; S.init(T, DM, G, bx);
            EpiResF32 E{nullptr, scores, DM};
            pg8::gemm_phase<EpiResF32, pg8::StaticOrder, true, true>(lds, g, S, E);
        }
        SYNC_AFTER(6);
        if (IN(7)) {
            const int lane = get_lane();
            LAS int* se = (LAS int*)(lds + wave * 4096); LAS float* sa = (LAS float*)(lds + wave * 4096 + 512); LAS float* sb = (LAS float*)(lds + wave * 4096 + 1024);
            for (int t = gw; t < T; t += NGW) { const int ln = get_lane(); peer_token(t, scores, hn, hbuf, U8, V8, inv_su, inv_sv, args.in[15], args.out, se, sa, sb, ln); }
        }
    }
}
}

extern "C" void kernel_launch(void* const* d_in, const int* in_sizes, int n_in, void* d_out, int out_size, void* d_ws, size_t ws_size, hipStream_t stream) {
    static int grid = 0;
    if (grid == 0) {
        int dev = 0, cus = 0, per_cu = 0;
        (void)hipGetDevice(&dev);
        (void)hipDeviceGetAttribute(&cus, hipDeviceAttributeMultiprocessorCount, dev);
        (void)hipFuncSetAttribute((const void*)mk::mk_fwd, hipFuncAttributeMaxDynamicSharedMemorySize, mk::LDS_BYTES);
        (void)hipOccupancyMaxActiveBlocksPerMultiprocessor(&per_cu, (const void*)mk::mk_fwd, mk::NT, mk::LDS_BYTES);
        if (per_cu < 1) { fprintf(stderr, "occupancy query says %d\n", per_cu); per_cu = 1; }
        grid = cus;
    }
    unsigned char* ws = (unsigned char*)d_ws;
    (void)hipMemsetAsync(d_ws, 0, 16384, stream);
    mk::Args a{};
    for (int i = 0; i < 16; ++i) a.in[i] = (const float*)d_in[i];
    a.out = (float*)d_out; a.ws = ws;
    {
#ifdef MIX_NAIVE
        a.ph_lo = 0; a.ph_hi = 2;
        void* kargs[] = {&a};
        (void)hipLaunchCooperativeKernel((const void*)mk::mk_fwd, dim3(grid), dim3(mk::NT), kargs, mk::LDS_BYTES, stream);
        k_mixers_seq<<<32, 128, 0, stream>>>((const bf16_t*)(ws + OFF_B), (const float*)(ws + OFF_S), (const float*)d_in[3], (const float*)d_in[4], (const float*)d_in[5], (const float*)d_in[6],
                                             (const float*)d_in[7], (const float*)d_in[8], (bf16_t*)d_out);
        mk::Args b = a; b.ph_lo = 4; b.ph_hi = 8;
        void* kargs2[] = {&b};
        (void)hipLaunchCooperativeKernel((const void*)mk::mk_fwd, dim3(grid), dim3(mk::NT), kargs2, mk::LDS_BYTES, stream);
#elif defined(PROBE_K)
        a.ph_lo = 0; a.ph_hi = (PROBE_K == 99) ? 4 : PROBE_K + 1;
        void* kargs[] = {&a};
        (void)hipLaunchCooperativeKernel((const void*)mk::mk_fwd, dim3(grid), dim3(mk::NT), kargs, mk::LDS_BYTES, stream);
        (void)hipMemsetAsync(d_ws, 0, 16384, stream);
        mk::Args b = a; b.ph_lo = (PROBE_K == 99) ? 4 : PROBE_K; b.ph_hi = 8;
        void* kargs2[] = {&b};
        (void)hipLaunchCooperativeKernel((const void*)mk::mk_fwd, dim3(grid), dim3(mk::NT), kargs2, mk::LDS_BYTES, stream);
#else
        a.ph_lo = 0; a.ph_hi = 8;
        void* kargs[] = {&a};
        hipError_t e = hipLaunchCooperativeKernel((const void*)mk::mk_fwd, dim3(grid), dim3(mk::NT), kargs, mk::LDS_BYTES, stream);
        if (e != hipSuccess) fprintf(stderr, "coop launch failed: %s\n", hipGetErrorString(e));
#endif
    }
}
```

```cpp
#include <hip/hip_runtime.h>
#include <hip/hip_cooperative_groups.h>
#include <cstdio>
namespace cg = cooperative_groups;
#include <stdint.h>

typedef unsigned short bf16_t;
typedef float f32x4 __attribute__((ext_vector_type(4)));

constexpr int T = 16384, SEQ = 8192, DM = 2048, INW = 7184, NPROJ = 7168;
constexpr float EPS = 1e-6f;
constexpr size_t MiB = 1u << 20;
constexpr size_t OFF_TAB = 1 * MiB;
constexpr size_t OFF_B = 65 * MiB;
constexpr size_t OFF_C = 289 * MiB;
constexpr size_t OFF_D = 305 * MiB;
constexpr size_t OFF_S = 500 * MiB;
constexpr int C_AQ = 0, C_AF = 1024, C_AI = 2048, C_AG = 3072, C_BQ = 4096, C_BK = 4608, C_BV = 5120, C_BZ = 6144;

__device__ __forceinline__ float bf2f(bf16_t v) { return __uint_as_float(((unsigned)v) << 16); }
typedef float f32x2_t __attribute__((ext_vector_type(2)));
typedef __bf16 bf16x2_t __attribute__((ext_vector_type(2)));
__device__ __forceinline__ unsigned cvt_pk2(float lo, float hi) { f32x2_t v = {lo, hi}; bf16x2_t b = __builtin_convertvector(v, bf16x2_t); return __builtin_bit_cast(unsigned, b); }
__device__ __forceinline__ bf16_t f2bf(float f) { return (bf16_t)(cvt_pk2(f, 0.f) & 0xffffu); }
__device__ __forceinline__ float sigmoidf_(float x) { return 1.f / (1.f + __expf(-x)); }
__device__ __forceinline__ float siluf_(float x) { return x / (1.f + __expf(-x)); }
__device__ __forceinline__ float wave_sum(float v) {
#pragma unroll
    for (int o = 1; o < 64; o <<= 1) v += __shfl_xor(v, o);
    return v;
}
__device__ __forceinline__ float block_sum(float v, float* sh) {
    v = wave_sum(v);
    const int w = threadIdx.x >> 6, nw = blockDim.x >> 6;
    __syncthreads();
    if ((threadIdx.x & 63) == 0) sh[w] = v;
    __syncthreads();
    float r = 0.f;
    for (int i = 0; i < nw; ++i) r += sh[i];
    return r;
}

__device__ __forceinline__ float gelu_erf(float x) { return 0.5f * x * (1.f + erff(x * 0.70710678118654752f)); }
namespace pg8 {
#define PG8_LAS __attribute__((address_space(3)))
typedef unsigned short bf16_t;
typedef short bf16x8 __attribute__((ext_vector_type(8)));
typedef float f32x4 __attribute__((ext_vector_type(4)));
typedef unsigned u32x4 __attribute__((ext_vector_type(4)));
constexpr int BM = 256, BK = 64, HALF = 128, HTB = HALF * BK * 2  , STAGE_BYTES = 8 * HTB, NXCD = 8, WGM = 8;

__host__ __device__ __forceinline__ int lds_byte(int r, int c) { const int st = (r >> 4) * 2 + (c >> 5), rr = r & 15, cc = c & 31, ob = rr * 64 + cc * 2; return st * 1024 + (ob ^ (((ob >> 9) & 1) << 5)); }
__host__ __device__ __forceinline__ void stage_rc(int b, int& R, int& C) { const int st = b / 1024, sb = b % 1024, swz = sb ^ (((sb >> 9) & 1) << 5); R = (st >> 1) * 16 + swz / 64; C = (st & 1) * 32 + (swz % 64) / 2; }
__host__ __device__ __forceinline__ int perm32(int rho) { const int n = rho >> 4, i = rho & 15; return 8 * (i >> 2) + 4 * n + (i & 3); }

struct Unit { int pm, pn; };
struct Gemm { const bf16_t* A; const bf16_t* Bt; int M, N, K; };

struct StaticOrder {
    int nM, nN, nwg, G, c;
    __host__ __device__ void init(int M, int N, int G_, int c_) { nM = M / BM; nN = N / BM; nwg = nM * nN; G = G_; c = c_; }
    __host__ __device__ bool next(int i, Unit& u) const {
        const long L = (long)i * G + c; if (L >= nwg) return false;
        int wgid = (int)L; { const int q = nwg / NXCD, r = nwg % NXCD, xcd = wgid % NXCD, off = wgid / NXCD; wgid = (xcd < r ? xcd * (q + 1) : r * (q + 1) + (xcd - r) * q) + off; }
        const int nig = WGM * nN, gid = wgid / nig, fm = gid * WGM, gsz = (nM - fm) < WGM ? (nM - fm) : WGM;
        u.pm = fm + ((wgid % nig) % gsz); u.pn = (wgid % nig) / gsz; return true;
    }
    __device__ __forceinline__ void a_ready(const Unit&) const {}
    __device__ __forceinline__ void done(const Unit&) const {}
};

__device__ __forceinline__ unsigned cvt_pk_bf16(float lo, float hi) { unsigned r; asm volatile("v_cvt_pk_bf16_f32 %0, %1, %2" : "=v"(r) : "v"(lo), "v"(hi)); return r; }
typedef float f32x2 __attribute__((ext_vector_type(2)));
__device__ __forceinline__ f32x2 gelu_pk(f32x2 v) {
    const f32x2 av = __builtin_elementwise_abs(v), d = av * 0.2316418882f + 1.0f;
    f32x2 t; t.x = __builtin_amdgcn_rcpf(d.x); t.y = __builtin_amdgcn_rcpf(d.y);
    f32x2 q = t * 0.5307027145f + (-0.7265760135f); q = q * t + 0.7107068705f; q = q * t + (-0.142248368f); q = q * t + 0.127414796f; q = q * t;
    const f32x2 s = (v * v) * (-0.72134752044f);
    f32x2 e; e.x = __builtin_amdgcn_exp2f(s.x); e.y = __builtin_amdgcn_exp2f(s.y);
    const f32x2 m = v * (q * e), r = v - m;
    f32x2 o; o.x = v.x < 0.f ? m.x : r.x; o.y = v.y < 0.f ? m.y : r.y; return o;
}

template <int ACT  > struct EpiBf16 {
    static constexpr bool PERM = true, AFTER_DRAIN = false; static_assert(ACT == 0 || ACT == 1, "EpiBf16: ACT is 0 (none) or 1 (gelu_pk)");
    bf16_t* O; int ldc; const float* bias; int split_cols; size_t split_stride; float scale0;
    __device__ __forceinline__ void operator()(const f32x4 (&acc)[2][2][4][2], const Unit& u, int wr, int wc, int fr, int fq) const {
        const int row0 = u.pm * BM + wr * 64 + fr; int colt = u.pn * BM; bf16_t* base = O;
        float sc = 1.f; if (split_cols) { const int t = colt / split_cols; base += (size_t)t * split_stride; colt -= t * split_cols; if (t == 0) sc = scale0; }
        const int col0 = colt + wc * 32 + 8 * fq, bcol0 = u.pn * BM + wc * 32 + 8 * fq;
        f32x4 bv[2][2];
#pragma unroll
        for (int bj = 0; bj < 2; ++bj)
#pragma unroll
            for (int n = 0; n < 2; ++n) bv[bj][n] = bias ? *(const f32x4*)(bias + bcol0 + bj * HALF + 4 * n) : (f32x4){0.f, 0.f, 0.f, 0.f};
#pragma unroll
        for (int ai = 0; ai < 2; ++ai)
#pragma unroll
            for (int m = 0; m < 4; ++m) { bf16_t* rowp = base + (size_t)(row0 + ai * HALF + m * 16) * ldc + col0;
#pragma unroll
                for (int bj = 0; bj < 2; ++bj) { f32x4 v0 = acc[ai][bj][m][0] + bv[bj][0], v1 = acc[ai][bj][m][1] + bv[bj][1];
                    if (ACT == 1) { f32x2 a = gelu_pk((f32x2){v0[0], v0[1]}), b = gelu_pk((f32x2){v0[2], v0[3]}), c = gelu_pk((f32x2){v1[0], v1[1]}), d = gelu_pk((f32x2){v1[2], v1[3]});
                        v0 = (f32x4){a.x, a.y, b.x, b.y}; v1 = (f32x4){c.x, c.y, d.x, d.y}; }
                    v0 = v0 * sc; v1 = v1 * sc; u32x4 w; w.x = cvt_pk_bf16(v0[0], v0[1]); w.y = cvt_pk_bf16(v0[2], v0[3]); w.z = cvt_pk_bf16(v1[0], v1[1]); w.w = cvt_pk_bf16(v1[2], v1[3]);
                    *(u32x4*)(rowp + bj * HALF) = w; } }
    }
};
template <class Epi, class Sched, bool ALIGN_EPI = false, bool SP2 = false>
__device__ __forceinline__ void gemm_phase(PG8_LAS unsigned char* lds, const Gemm g, const Sched& S, const Epi& E) {
    const int tid = threadIdx.x, wid = __builtin_amdgcn_readfirstlane(tid >> 6), lane = tid & 63, wr = wid >> 2, wc = wid & 3, fr = lane & 15, fq = lane >> 4;
    const int K = g.K, nt = K / BK;
    unsigned voffA[2], voffB[2];
#pragma unroll
    for (int i = 0; i < 2; ++i) { int R, C; stage_rc(tid * 16 + i * 8192, R, C); const int Rb = Epi::PERM ? ((R & ~31) + perm32(R & 31)) : R;
        voffA[i] = (unsigned)(R * K + C) * 2u; voffB[i] = (unsigned)(Rb * K + C) * 2u; }
    const size_t kstep = (size_t)(BK * 2);
    const size_t hstep = (size_t)HALF * K * 2;
    const size_t tstep = 2 * hstep;
    const unsigned ldsw = (unsigned)wid * 1024u;
    const int aoff = lds_byte(wr * 64 + fr, fq * 8), boff = lds_byte(wc * 32 + fr, fq * 8);
#define PG8_SA(b, h) (((b) * 2 + (h)) * HTB)
#define PG8_SB(b, h) ((4 + (b) * 2 + (h)) * HTB)
#define PG8_STAGE(bufoff, gbase, voff) do { _Pragma("unroll") for (int _i = 0; _i < 2; ++_i) \
        __builtin_amdgcn_global_load_lds((const unsigned*)((const char*)(gbase) + (voff)[_i]), (PG8_LAS unsigned*)(lds + (bufoff) + ldsw + _i * 8192), 16, 0, 0); } while (0)
#define PG8_LDA(dst, b, h) do { _Pragma("unroll") for (int m = 0; m < 4; ++m) _Pragma("unroll") for (int k = 0; k < 2; ++k) dst[m][k] = *(const PG8_LAS bf16x8*)(lds + PG8_SA(b, h) + aoff + m * 2048 + k * 1024); } while (0)
#define PG8_LDB(dst, b, h) do { _Pragma("unroll") for (int n = 0; n < 2; ++n) _Pragma("unroll") for (int k = 0; k < 2; ++k) dst[n][k] = *(const PG8_LAS bf16x8*)(lds + PG8_SB(b, h) + boff + n * 2048 + k * 1024); } while (0)
#define PG8_MMA(ai, bj, At, Bt) do { __builtin_amdgcn_s_setprio(1); _Pragma("unroll") for (int m = 0; m < 4; ++m) _Pragma("unroll") for (int n = 0; n < 2; ++n) _Pragma("unroll") for (int k = 0; k < 2; ++k) \
        acc[ai][bj][m][n] = __builtin_amdgcn_mfma_f32_16x16x32_bf16(Bt[n][k], At[m][k], acc[ai][bj][m][n], 0, 0, 0); __builtin_amdgcn_s_setprio(0); } while (0)
#define PG8_WAIT_V(n) asm volatile("s_waitcnt vmcnt(" #n ")" ::: "memory")
#define PG8_WAIT_L(n) asm volatile("s_waitcnt lgkmcnt(" #n ")" ::: "memory")
#define PG8_BAR __builtin_amdgcn_s_barrier()
#define PG8_SCHED __builtin_amdgcn_sched_barrier(0)
    Unit cur, nxt; int ui = 0;
    if (!S.next(0, cur)) return;
    f32x4 acc[2][2][4][2];
#pragma unroll
    for (int a = 0; a < 2; ++a)
#pragma unroll
        for (int b = 0; b < 2; ++b)
#pragma unroll
            for (int m = 0; m < 4; ++m)
#pragma unroll
                for (int n = 0; n < 2; ++n) acc[a][b][m][n] = (f32x4){0.f, 0.f, 0.f, 0.f};
    bf16x8 At[4][2], B0[2][2], B1[2][2];
    const char* cA = (const char*)g.A + (size_t)cur.pm * tstep; const char* cB = (const char*)g.Bt + (size_t)cur.pn * tstep;
    S.a_ready(cur);
    if constexpr (SP2) {
        PG8_STAGE(PG8_SB(0, 0), cB, voffB); PG8_STAGE(PG8_SB(0, 1), cB + hstep, voffB); PG8_STAGE(PG8_SA(0, 0), cA, voffA); PG8_STAGE(PG8_SA(0, 1), cA + hstep, voffA);
        if (wr == 1) PG8_BAR;
        PG8_WAIT_V(2); PG8_BAR;
        PG8_STAGE(PG8_SB(1, 0), cB + kstep, voffB); PG8_STAGE(PG8_SA(1, 0), cA + kstep, voffA); PG8_STAGE(PG8_SB(1, 1), cB + hstep + kstep, voffB);
        PG8_WAIT_V(6); PG8_BAR;
    } else {
        PG8_STAGE(PG8_SB(0, 0), cB, voffB); PG8_STAGE(PG8_SA(0, 0), cA, voffA); PG8_STAGE(PG8_SB(0, 1), cB + hstep, voffB); PG8_STAGE(PG8_SA(0, 1), cA + hstep, voffA);
        if (wr == 1) PG8_BAR;
        PG8_WAIT_V(4); PG8_BAR;
        PG8_STAGE(PG8_SB(1, 0), cB + kstep, voffB); PG8_STAGE(PG8_SA(1, 0), cA + kstep, voffA); PG8_STAGE(PG8_SB(1, 1), cB + hstep + kstep, voffB);
        PG8_WAIT_V(6); PG8_BAR;
    }
    for (;;) {
        const bool has_next = S.next(ui + 1, nxt);
        const char* nA = has_next ? (const char*)g.A + (size_t)nxt.pm * tstep : cA; const char* nB = has_next ? (const char*)g.Bt + (size_t)nxt.pn * tstep : cB;
        for (int t = 0; t < nt; t += 2) {
            const bool last = (t == nt - 2);
            const char* a1 = cA + (size_t)(t + 1) * kstep;
            const char* a2 = last ? nA : cA + (size_t)(t + 2) * kstep; const char* b2 = last ? nB : cB + (size_t)(t + 2) * kstep;
            const char* a3 = a2 + kstep; const char* b3 = b2 + kstep;
            if (last && has_next) S.a_ready(nxt);
            if constexpr (SP2) {
            PG8_LDB(B0, 0, 0); PG8_LDB(B1, 0, 1); PG8_SCHED; PG8_LDA(At, 0, 0); PG8_STAGE(PG8_SA(1, 1), a1 + hstep, voffA);
            PG8_WAIT_V(8); PG8_WAIT_L(0); PG8_BAR; PG8_MMA(0, 0, At, B0); PG8_MMA(0, 1, At, B1); PG8_BAR; PG8_SCHED;
            PG8_LDA(At, 0, 1); PG8_STAGE(PG8_SB(0, 0), b2, voffB); PG8_STAGE(PG8_SB(0, 1), b2 + hstep, voffB); PG8_STAGE(PG8_SA(0, 0), a2, voffA);
            PG8_WAIT_V(8); PG8_WAIT_L(0); PG8_BAR; PG8_MMA(1, 0, At, B0); PG8_MMA(1, 1, At, B1); PG8_BAR; PG8_SCHED;
            PG8_LDB(B0, 1, 0); PG8_LDB(B1, 1, 1); PG8_SCHED; PG8_LDA(At, 1, 0); PG8_STAGE(PG8_SA(0, 1), a2 + hstep, voffA);
            PG8_WAIT_V(8); PG8_WAIT_L(0); PG8_BAR; PG8_MMA(0, 0, At, B0); PG8_MMA(0, 1, At, B1); PG8_BAR; PG8_SCHED;
            PG8_LDA(At, 1, 1); PG8_STAGE(PG8_SB(1, 0), b3, voffB); PG8_STAGE(PG8_SB(1, 1), b3 + hstep, voffB); PG8_STAGE(PG8_SA(1, 0), a3, voffA);
            PG8_WAIT_V(8); PG8_WAIT_L(0); PG8_BAR; PG8_MMA(1, 0, At, B0); PG8_MMA(1, 1, At, B1); PG8_BAR; PG8_SCHED;
            } else {
            PG8_LDB(B0, 0, 0); PG8_SCHED; PG8_LDA(At, 0, 0); PG8_STAGE(PG8_SA(1, 1), a1 + hstep, voffA);
            PG8_WAIT_L(8); PG8_BAR; PG8_WAIT_L(0); PG8_MMA(0, 0, At, B0); PG8_BAR; PG8_SCHED;
            PG8_LDB(B1, 0, 1); PG8_STAGE(PG8_SB(0, 0), b2, voffB);
            PG8_BAR; PG8_WAIT_L(0); PG8_MMA(0, 1, At, B1); PG8_BAR;
            PG8_LDA(At, 0, 1); PG8_STAGE(PG8_SA(0, 0), a2, voffA);
            PG8_BAR; PG8_WAIT_L(0); PG8_MMA(1, 0, At, B0); PG8_BAR; PG8_SCHED;
            PG8_STAGE(PG8_SB(0, 1), b2 + hstep, voffB);
            PG8_WAIT_V(6); PG8_BAR; PG8_MMA(1, 1, At, B1); PG8_BAR;
            PG8_LDB(B0, 1, 0); PG8_SCHED; PG8_LDA(At, 1, 0); PG8_STAGE(PG8_SA(0, 1), a2 + hstep, voffA);
            PG8_WAIT_L(8); PG8_BAR; PG8_WAIT_L(0); PG8_MMA(0, 0, At, B0); PG8_BAR; PG8_SCHED;
            PG8_LDB(B1, 1, 1); PG8_STAGE(PG8_SB(1, 0), b3, voffB);
            PG8_BAR; PG8_WAIT_L(0); PG8_MMA(0, 1, At, B1); PG8_BAR;
            PG8_LDA(At, 1, 1); PG8_STAGE(PG8_SA(1, 0), a3, voffA);
            PG8_BAR; PG8_WAIT_L(0); PG8_MMA(1, 0, At, B0); PG8_BAR; PG8_SCHED;
            PG8_STAGE(PG8_SB(1, 1), b3 + hstep, voffB);
            PG8_WAIT_V(6); PG8_BAR; PG8_MMA(1, 1, At, B1); PG8_BAR;
            }
        }
        if constexpr (ALIGN_EPI) { if (wr == 0) PG8_BAR; }
        if constexpr (!Epi::AFTER_DRAIN) { E(acc, cur, wr, wc, fr, fq); S.done(cur); }
        if (!has_next) break;
#pragma unroll
        for (int a = 0; a < 2; ++a)
#pragma unroll
            for (int b = 0; b < 2; ++b)
#pragma unroll
                for (int m = 0; m < 4; ++m)
#pragma unroll
                    for (int n = 0; n < 2; ++n) acc[a][b][m][n] = (f32x4){0.f, 0.f, 0.f, 0.f};
        cur = nxt; cA = nA; cB = nB; ++ui;
        if constexpr (ALIGN_EPI) { if (wr == 1) PG8_BAR; }
    }
    PG8_WAIT_V(0);
    if constexpr (!ALIGN_EPI) { if (wr == 0) PG8_BAR; }
    PG8_BAR;
    if constexpr (Epi::AFTER_DRAIN) { E.fused(acc, cur, wr, wc, fr, fq, lds, wid, lane); S.done(cur); }
#undef PG8_SA
#undef PG8_SB
#undef PG8_STAGE
#undef PG8_LDA
#undef PG8_LDB
#undef PG8_MMA
#undef PG8_WAIT_V
#undef PG8_WAIT_L
#undef PG8_BAR
#undef PG8_SCHED
}
}

namespace mk {
#define LAS __attribute__((address_space(3)))
#define GAS __attribute__((address_space(1)))
typedef unsigned v4u __attribute__((ext_vector_type(4)));
typedef unsigned v2u __attribute__((ext_vector_type(2)));
constexpr int NW = 8, NT = 512, LDS_BYTES = 163840, RING_BYTES = 131072;
#define LDS_WAIT() asm volatile("s_waitcnt lgkmcnt(0)" ::: "memory")
#define DPP_ROR_ADD(t, n) ((t) + __uint_as_float(__builtin_amdgcn_update_dpp(0u, __float_as_uint(t), 0x120 + (n), 0xf, 0xf, false)))
struct Args { const float* in[16]; float* out; unsigned char* ws; int ph_lo, ph_hi; };
__device__ __forceinline__ unsigned pk2(float lo, float hi) { return cvt_pk2(lo, hi); }

__device__ __forceinline__ void transpose_item(const float* W, int ld, int K, int ncols, bf16_t* WT, LAS float* scr, int item, int lane) {
    const int nblk = ncols / 32, kb = item / nblk, nb = item % nblk, k0 = 64 * kb, n0 = 32 * nb;
#pragma unroll 8
    for (int i = 0; i < 32; ++i) { const int kk = 2 * i + (lane >> 5); scr[kk * 33 + (lane & 31)] = W[(size_t)(k0 + kk) * ld + n0 + (lane & 31)]; }
    LDS_WAIT(); asm volatile("" ::: "memory");
    const int c = lane & 7;
#pragma unroll
    for (int j = 0; j < 4; ++j) { const int n = (lane >> 3) + 8 * j; const LAS float* s = scr + (8 * c) * 33 + n;
        v4u o; o.x = pk2(s[0 * 33], s[1 * 33]); o.y = pk2(s[2 * 33], s[3 * 33]); o.z = pk2(s[4 * 33], s[5 * 33]); o.w = pk2(s[6 * 33], s[7 * 33]);
        *(v4u*)(WT + (size_t)(n0 + n) * K + k0 + 8 * c) = o; }
    LDS_WAIT(); asm volatile("" ::: "memory");
}
template <bool WITH_BA>
__device__ __forceinline__ void norm_row(const float* xrow, const float* g, const LAS float* wt  , bf16_t* orow, float* barow, int lane) {
    f32x4 v[8]; float ss = 0.f;
#pragma unroll
    for (int j = 0; j < 8; ++j) { v[j] = ((const f32x4*)xrow)[64 * j + lane]; ss += (v[j].x * v[j].x + v[j].y * v[j].y) + (v[j].z * v[j].z + v[j].w * v[j].w); }
    ss = wave_sum(ss);
    const float rstd = rsqrtf(ss * (1.f / DM) + EPS);
    float acc[16];
#pragma unroll
    for (int c = 0; c < 16; ++c) acc[c] = 0.f;
#pragma unroll
    for (int j = 0; j < 8; ++j) {
        const f32x4 gg = ((const f32x4*)g)[64 * j + lane];
        const f32x4 y = v[j] * rstd * gg;
        v2u o; o.x = pk2(y.x, y.y); o.y = pk2(y.z, y.w);
        ((v2u*)orow)[64 * j + lane] = o;
        if (WITH_BA) {
#pragma unroll
            for (int c = 0; c < 16; ++c) { const f32x4 w4 = *(const LAS f32x4*)(wt + c * 2048 + 4 * (64 * j + lane));
                acc[c] += (y.x * w4.x + y.y * w4.y) + (y.z * w4.z + y.w * w4.w); }
            __builtin_amdgcn_sched_barrier(0);
        }
    }
    if (WITH_BA) {
        float q8[8], t4[4];
#pragma unroll
        for (int r = 0; r < 8; ++r) { auto sw = __builtin_amdgcn_permlane32_swap(__float_as_uint(acc[r]), __float_as_uint(acc[r + 8]), false, false); q8[r] = __uint_as_float(sw[0]) + __uint_as_float(sw[1]); }
#pragma unroll
        for (int r = 0; r < 4; ++r) { auto sw = __builtin_amdgcn_permlane16_swap(__float_as_uint(q8[r]), __float_as_uint(q8[r + 4]), false, false); t4[r] = __uint_as_float(sw[0]) + __uint_as_float(sw[1]); }
#pragma unroll
        for (int r = 0; r < 4; ++r) { float tv = t4[r]; tv = DPP_ROR_ADD(tv, 8); tv = DPP_ROR_ADD(tv, 4); tv = DPP_ROR_ADD(tv, 2); tv = DPP_ROR_ADD(tv, 1); t4[r] = tv; }
        if ((lane & 15) == 0) { const int gq = lane >> 4;
#pragma unroll
            for (int r = 0; r < 4; ++r) barow[r + 4 * gq] = t4[r]; }
    }
}
__device__ __forceinline__ void wqk_item(const float* Wq, const float* SK, bf16_t* Wqk, LAS float* lds, int item, int tid) {
    const int cbk = item >> 5, d0 = (item & 31) * 64, cb = cbk * 128, h = cbk >> 1, half = cbk & 1;
    LAS float* At = lds; LAS float* Bt = lds + 128 * 68;
    const float* skb = SK + ((size_t)(half * 8 + h) * 128) * 128;
#pragma unroll
    for (int i = 0; i < 4; ++i) { const int idx = tid + 512 * i, d = idx >> 5, k4 = idx & 31;
        const f32x4 w = *(const f32x4*)(Wq + (size_t)(d0 + d) * DM + cb + 4 * k4);
        At[(4 * k4 + 0) * 68 + d] = w.x; At[(4 * k4 + 1) * 68 + d] = w.y; At[(4 * k4 + 2) * 68 + d] = w.z; At[(4 * k4 + 3) * 68 + d] = w.w; }
#pragma unroll
    for (int i = 0; i < 8; ++i) { const int idx = tid + 512 * i, n = idx >> 5, k4 = idx & 31;
        const f32x4 w = *(const f32x4*)(skb + (size_t)n * 128 + 4 * k4);
        Bt[(4 * k4 + 0) * 132 + n] = w.x; Bt[(4 * k4 + 1) * 132 + n] = w.y; Bt[(4 * k4 + 2) * 132 + n] = w.z; Bt[(4 * k4 + 3) * 132 + n] = w.w; }
    __syncthreads();
    const int dy = tid >> 5, nx = tid & 31;
    float acc[4][4];
#pragma unroll
    for (int i = 0; i < 4; ++i)
#pragma unroll
        for (int j = 0; j < 4; ++j) acc[i][j] = 0.f;
#pragma unroll 4
    for (int kk = 0; kk < 128; ++kk) {
        const f32x4 a = *(const LAS f32x4*)(At + kk * 68 + 4 * dy), b = *(const LAS f32x4*)(Bt + kk * 132 + 4 * nx);
        acc[0][0] += a.x * b.x; acc[0][1] += a.x * b.y; acc[0][2] += a.x * b.z; acc[0][3] += a.x * b.w;
        acc[1][0] += a.y * b.x; acc[1][1] += a.y * b.y; acc[1][2] += a.y * b.z; acc[1][3] += a.y * b.w;
        acc[2][0] += a.z * b.x; acc[2][1] += a.z * b.y; acc[2][2] += a.z * b.z; acc[2][3] += a.z * b.w;
        acc[3][0] += a.w * b.x; acc[3][1] += a.w * b.y; acc[3][2] += a.w * b.z; acc[3][3] += a.w * b.w;
    }
#pragma unroll
    for (int j = 0; j < 4; ++j) { v2u o; o.x = pk2(acc[0][j], acc[1][j]); o.y = pk2(acc[2][j], acc[3][j]);
        *(v2u*)(Wqk + (size_t)(cb + 4 * nx + j) * DM + d0 + 4 * dy) = o; }
    __syncthreads();
}

typedef float f32x2 __attribute__((ext_vector_type(2)));
__device__ __forceinline__ int fp4_idx_of(float v) { return (v < 1.75f) ? (int)(v * 2.f + 0.25f) : (v < 2.5f ? 4 : (v < 3.5f ? 5 : (v < 5.f ? 6 : 7))); }
__device__ __forceinline__ void fp4_calibrate(int (&nib)[8]) {
    const unsigned T = 0x76543210u;
    const f32x2 a = __builtin_amdgcn_cvt_scalef32_pk_f32_fp4(T, 1.0f, 0), b = __builtin_amdgcn_cvt_scalef32_pk_f32_fp4(T, 1.0f, 1);
    const f32x2 c = __builtin_amdgcn_cvt_scalef32_pk_f32_fp4(T, 1.0f, 2), d = __builtin_amdgcn_cvt_scalef32_pk_f32_fp4(T, 1.0f, 3);
    nib[0] = fp4_idx_of(a.x); nib[1] = fp4_idx_of(a.y); nib[2] = fp4_idx_of(b.x); nib[3] = fp4_idx_of(b.y);
    nib[4] = fp4_idx_of(c.x); nib[5] = fp4_idx_of(c.y); nib[6] = fp4_idx_of(d.x); nib[7] = fp4_idx_of(d.y);
}
__device__ __forceinline__ void table_row(const float* src, unsigned* dst, float* inv_scale, int lane) {
    int nib[8]; fp4_calibrate(nib);
    f32x4 v[8]; float mx = 0.f;
#pragma unroll
    for (int j = 0; j < 8; ++j) { v[j] = ((const f32x4*)src)[8 * lane + j];
        mx = fmaxf(mx, fmaxf(fmaxf(fabsf(v[j].x), fabsf(v[j].y)), fmaxf(fabsf(v[j].z), fabsf(v[j].w)))); }
#pragma unroll
    for (int o = 1; o < 64; o <<= 1) mx = fmaxf(mx, __shfl_xor(mx, o));
    const float sc = mx > 0.f ? mx * (0.85f / 6.f) : 1.f, isc = 1.f / sc;
    unsigned wd[4];
#pragma unroll
    for (int w = 0; w < 4; ++w) {
        unsigned acc = 0u;
#pragma unroll
        for (int e = 0; e < 8; ++e) {
            const f32x4 q = v[2 * w + (e >> 2)]; const float xe = ((e & 3) == 0) ? q.x : ((e & 3) == 1) ? q.y : ((e & 3) == 2) ? q.z : q.w;
            const float yv = fabsf(xe) * isc;
            unsigned code = (yv > 0.25f) + (yv > 0.75f) + (yv > 1.25f) + (yv > 1.75f) + (yv > 2.5f) + (yv > 3.5f) + (yv > 5.f);
            code |= (xe < 0.f) ? 8u : 0u;
            acc |= code << (4 * nib[e]);
        }
        wd[w] = acc;
    }
    v4u o; o.x = wd[0]; o.y = wd[1]; o.z = wd[2]; o.w = wd[3];
    ((v4u*)dst)[lane] = o;
    if (lane == 0) *inv_scale = sc;
}
#ifndef PEER_FAST_REDUCE
#define PEER_FAST_REDUCE 1
#endif
__device__ __forceinline__ float dpp_ror_add(float t, int) { return t; }
#define FP4_BYTE(d, j) __builtin_amdgcn_cvt_scalef32_pk_f32_fp4((d), 1.0f, (j))
__device__ __forceinline__ float dot_row(const v4u& a, const float (&xv)[32]) {
    f32x2 p2 = {0.f, 0.f};
#pragma unroll
    for (int w = 0; w < 4; ++w) { const unsigned d = (w == 0) ? a.x : (w == 1) ? a.y : (w == 2) ? a.z : a.w;
        const f32x2 f0 = FP4_BYTE(d, 0), f1 = FP4_BYTE(d, 1), f2 = FP4_BYTE(d, 2), f3 = FP4_BYTE(d, 3);
        p2 = __builtin_elementwise_fma(f0, (f32x2){xv[8 * w], xv[8 * w + 1]}, p2); p2 = __builtin_elementwise_fma(f1, (f32x2){xv[8 * w + 2], xv[8 * w + 3]}, p2);
        p2 = __builtin_elementwise_fma(f2, (f32x2){xv[8 * w + 4], xv[8 * w + 5]}, p2); p2 = __builtin_elementwise_fma(f3, (f32x2){xv[8 * w + 6], xv[8 * w + 7]}, p2); }
    return p2.x + p2.y;
}
__device__ __forceinline__ void axpy_row(const v4u& a, float wgt, float (&y)[32]) {
#pragma unroll
    for (int w = 0; w < 4; ++w) { const unsigned d = (w == 0) ? a.x : (w == 1) ? a.y : (w == 2) ? a.z : a.w;
        const f32x2 f0 = FP4_BYTE(d, 0), f1 = FP4_BYTE(d, 1), f2 = FP4_BYTE(d, 2), f3 = FP4_BYTE(d, 3);
        y[8 * w] += wgt * f0.x; y[8 * w + 1] += wgt * f0.y; y[8 * w + 2] += wgt * f1.x; y[8 * w + 3] += wgt * f1.y;
        y[8 * w + 4] += wgt * f2.x; y[8 * w + 5] += wgt * f2.y; y[8 * w + 6] += wgt * f3.x; y[8 * w + 7] += wgt * f3.y; }
}
#define DPP_ROR_MAX(t, n) fmaxf((t), __uint_as_float(__builtin_amdgcn_update_dpp(0u, __float_as_uint(t), 0x120 + (n), 0xf, 0xf, false)))
#define CSWAP(a, b) do { const float hi_ = fmaxf(a, b), lo_ = fminf(a, b); a = hi_; b = lo_; } while (0)
__device__ __forceinline__ void topk_token_fast(const float* __restrict__ srow, int lane, const float* inv_su, const float* inv_sv,
                                                LAS int* se, LAS float* sa, LAS float* sb) {
    const int l16 = lane & 15, row = lane >> 4;
    float R[4];
#pragma unroll
    for (int ps = 0; ps < 4; ++ps) {
        const f32x4 v0 = *(const f32x4*)(srow + (4 * ps + row) * 128 + 8 * l16), v1 = *(const f32x4*)(srow + (4 * ps + row) * 128 + 8 * l16 + 4);
        float k[8];
        k[0] = v0.x; k[1] = v0.y; k[2] = v0.z; k[3] = v0.w; k[4] = v1.x; k[5] = v1.y; k[6] = v1.z; k[7] = v1.w;
#pragma unroll
        for (int i = 0; i < 8; ++i) k[i] = __uint_as_float((__float_as_uint(k[i]) & 0xFFFFFF80u) | (unsigned)(8 * l16 + i));
        CSWAP(k[0], k[1]); CSWAP(k[2], k[3]); CSWAP(k[4], k[5]); CSWAP(k[6], k[7]);
        CSWAP(k[0], k[2]); CSWAP(k[1], k[3]); CSWAP(k[4], k[6]); CSWAP(k[5], k[7]);
        CSWAP(k[1], k[2]); CSWAP(k[5], k[6]);
        CSWAP(k[0], k[4]); CSWAP(k[1], k[5]); CSWAP(k[2], k[6]); CSWAP(k[3], k[7]);
        CSWAP(k[2], k[4]); CSWAP(k[3], k[5]);
        CSWAP(k[1], k[2]); CSWAP(k[3], k[4]); CSWAP(k[5], k[6]);
        float res = 0.f;
#pragma unroll
        for (int it = 0; it < 16; ++it) {
            float m = k[0];
            m = DPP_ROR_MAX(m, 8); m = DPP_ROR_MAX(m, 4); m = DPP_ROR_MAX(m, 2); m = DPP_ROR_MAX(m, 1);
            const bool own = (k[0] == m);
#pragma unroll
            for (int i = 0; i < 7; ++i) k[i] = own ? k[i + 1] : k[i];
            k[7] = own ? -INFINITY : k[7];
            res = (l16 == it) ? m : res;
        }
        R[ps] = res;
    }
#pragma unroll
    for (int g = 0; g < 2; ++g) {
        const auto sw = __builtin_amdgcn_permlane16_swap(__float_as_uint(R[2 * g]), __float_as_uint(R[2 * g + 1]), false, false);
        const float X = __uint_as_float(sw[0]), Y = __uint_as_float(sw[1]);
        const float a = __uint_as_float(__float_as_uint(X) & 0xFFFFFF80u);
        int j = 0;
        float v2 = __shfl(Y, (lane & 48));
        float best = 0.f;
#pragma unroll
        for (int it = 0; it < 16; ++it) {
            const float sum = a + __uint_as_float(__float_as_uint(v2) & 0xFFFFFF80u);
            const float cand = (j < 16) ? __uint_as_float((__float_as_uint(sum) & 0xFFFFFF00u) | (unsigned)((l16 << 4) | (j & 15))) : -INFINITY;
            float m = cand;
            m = DPP_ROR_MAX(m, 8); m = DPP_ROR_MAX(m, 4); m = DPP_ROR_MAX(m, 2); m = DPP_ROR_MAX(m, 1);
            best = (l16 == it) ? m : best;
            if (it < 15) { j += (cand == m) ? 1 : 0; v2 = __shfl(Y, (lane & 48) + (j & 15)); }
        }
        const unsigned bb = __float_as_uint(best);
        const int bi = (bb >> 4) & 15, bj = bb & 15;
        const unsigned k1 = __float_as_uint(__shfl(X, (lane & 48) + bi)), k2 = __float_as_uint(__shfl(Y, (lane & 48) + bj));
        const int e = (int)(k1 & 127u) * 128 + (int)(k2 & 127u);
        const float bv = __uint_as_float(bb & 0xFFFFFF00u);
        float mx = bv; mx = DPP_ROR_MAX(mx, 8); mx = DPP_ROR_MAX(mx, 4); mx = DPP_ROR_MAX(mx, 2); mx = DPP_ROR_MAX(mx, 1);
        const float ex = __expf(bv - mx);
        float sm = ex; sm = DPP_ROR_ADD(sm, 8); sm = DPP_ROR_ADD(sm, 4); sm = DPP_ROR_ADD(sm, 2); sm = DPP_ROR_ADD(sm, 1);
        const float gate = ex / sm;
        const int head = 4 * g + ((row & 1) * 2 + (row >> 1));
        se[head * 16 + l16] = e; sa[head * 16 + l16] = inv_su[e]; sb[head * 16 + l16] = gate * inv_sv[e];
    }
}
#define PEER_LOAD(DST, TAB, b) do { _Pragma("unroll") for (int r_ = 0; r_ < 4; ++r_) { const unsigned char* rp_ = (TAB) + (size_t)(unsigned)__builtin_amdgcn_readfirstlane(se[4 * (b) + r_]) * 1024 + 16 * lane; \
        DST[r_] = *(const v4u*)rp_; } } while (0)
__device__ __forceinline__ void peer_token(int t, const float* scores, const bf16_t* hn, const float* hbuf, const unsigned char* U8, const unsigned char* V8,
                                           const float* inv_su, const float* inv_sv, const float* gfin, float* out,
                                           LAS int* se, LAS float* sa, LAS float* sb, int lane_in) {
    int lane = lane_in;
    {
        LAS int* se0 = se + 512; LAS float* sa0 = sa + 512; LAS float* sb0 = sb + 512;
        topk_token_fast(scores + (size_t)t * DM, lane, inv_su, inv_sv, se0, sa0, sb0);
        unsigned a0 = ((unsigned)se0[lane] << 7) | (unsigned)lane, a1 = ((unsigned)se0[lane + 64] << 7) | (unsigned)(lane + 64);
#pragma unroll
        for (int k = 2; k <= 128; k <<= 1) {
#pragma unroll
            for (int j = k >> 1; j > 0; j >>= 1) {
                if (j == 64) { const unsigned lo = a0 < a1 ? a0 : a1, hi = a0 < a1 ? a1 : a0; a0 = lo; a1 = hi; }
                else {
                    const unsigned p0 = (unsigned)__shfl_xor((int)a0, j), p1 = (unsigned)__shfl_xor((int)a1, j);
                    const bool lower = (lane & j) == 0;
                    const bool up0 = (lane & k) == 0, up1 = ((lane + 64) & k) == 0;
                    const unsigned mn0 = a0 < p0 ? a0 : p0, mx0 = a0 < p0 ? p0 : a0, mn1 = a1 < p1 ? a1 : p1, mx1 = a1 < p1 ? p1 : a1;
                    a0 = (up0 == lower) ? mn0 : mx0; a1 = (up1 == lower) ? mn1 : mx1;
                }
            }
        }
        const int k0 = a0 & 127, k1 = a1 & 127;
        se[lane] = (int)(a0 >> 7); sa[lane] = sa0[k0]; sb[lane] = sb0[k0];
        se[lane + 64] = (int)(a1 >> 7); sa[lane + 64] = sa0[k1]; sb[lane + 64] = sb0[k1];
    }
    asm volatile("" : "+v"(lane));
    float xv[32], y[32];
#pragma unroll
    for (int j = 0; j < 4; ++j) {
        const v4u h0 = *(const v4u*)(hn + (size_t)t * DM + 32 * lane + 8 * j);
#pragma unroll
        for (int w = 0; w < 4; ++w) { const unsigned d0 = (w == 0) ? h0.x : (w == 1) ? h0.y : (w == 2) ? h0.z : h0.w;
            xv[8 * j + 2 * w] = __uint_as_float(d0 << 16); xv[8 * j + 2 * w + 1] = __uint_as_float(d0 & 0xffff0000u); }
    }
#pragma unroll
    for (int i = 0; i < 32; ++i) y[i] = 0.f;
    v4u Ua[4], Ub[4], Va[4];
#define PEER_BATCH(b, UC, VC) do { \
        PEER_LOAD(VC, V8, (b)); \
        float pr[4]; \
        _Pragma("unroll") for (int r = 0; r < 4; ++r) pr[r] = dot_row(UC[r], xv); \
        if ((b) + 2 < 32) PEER_LOAD(UC, U8, (b) + 2); \
        float wr_[4], q2[2]; \
        _Pragma("unroll") for (int r = 0; r < 2; ++r) { auto sw = __builtin_amdgcn_permlane32_swap(__float_as_uint(pr[r]), __float_as_uint(pr[r + 2]), false, false); q2[r] = __uint_as_float(sw[0]) + __uint_as_float(sw[1]); } \
        float tv; \
        { auto sw = __builtin_amdgcn_permlane16_swap(__float_as_uint(q2[0]), __float_as_uint(q2[1]), false, false); tv = __uint_as_float(sw[0]) + __uint_as_float(sw[1]); } \
        tv = DPP_ROR_ADD(tv, 8); tv = DPP_ROR_ADD(tv, 4); tv = DPP_ROR_ADD(tv, 2); tv = DPP_ROR_ADD(tv, 1); \
        const int k = 4 * (b) + (lane >> 4);     \
        const float wc = gelu_erf(tv * sa[k]) * sb[k]; \
        _Pragma("unroll") for (int r = 0; r < 4; ++r) wr_[r] = __uint_as_float(__builtin_amdgcn_readlane(__float_as_uint(wc), 16 * r)); \
        _Pragma("unroll") for (int r = 0; r < 4; ++r) axpy_row(VC[r], wr_[r], y); } while (0)
    PEER_LOAD(Ua, U8, 0); PEER_LOAD(Ub, U8, 1);
#pragma unroll 1
    for (int b = 0; b < 32; b += 2) { PEER_BATCH(b, Ua, Va); PEER_BATCH(b + 1, Ub, Va); }
    float ss = 0.f;
#pragma unroll
    for (int j = 0; j < 8; ++j) { const f32x4 hv = *(const f32x4*)(hbuf + (size_t)t * DM + 32 * lane + 4 * j);
        y[4 * j] += hv.x; y[4 * j + 1] += hv.y; y[4 * j + 2] += hv.z; y[4 * j + 3] += hv.w;
        ss += (y[4 * j] * y[4 * j] + y[4 * j + 1] * y[4 * j + 1]) + (y[4 * j + 2] * y[4 * j + 2] + y[4 * j + 3] * y[4 * j + 3]); }
    ss = wave_sum(ss);
    const float rstd = rsqrtf(ss * (1.f / DM) + EPS);
#pragma unroll
    for (int j = 0; j < 8; ++j) { const f32x4 gg = *(const f32x4*)(gfin + 32 * lane + 4 * j);
        f32x4 o; o.x = y[4 * j] * rstd * gg.x; o.y = y[4 * j + 1] * rstd * gg.y; o.z = y[4 * j + 2] * rstd * gg.z; o.w = y[4 * j + 3] * rstd * gg.w;
        *(f32x4*)(out + (size_t)t * DM + 32 * lane + 4 * j) = o; }
}
typedef short bf16x8 __attribute__((ext_vector_type(8)));
__device__ __forceinline__ int pos32(int x) { const int g = x & ~31, l = x & 31; return g + 8 * ((l & 15) >> 2) + 4 * (l >> 4) + (l & 3); }
constexpr size_t PB_H_QG = 0, PB_H_KDT = 32 * MiB, PB_H_A = 64 * MiB;
constexpr size_t PB_G_QS = 80 * MiB, PB_G_KT = 96 * MiB;
constexpr size_t PB_G_W = 112 * MiB, PB_G_A = 144 * MiB, PB_G_U = 160 * MiB;
constexpr int PROG_WORD = 3584;
constexpr int SC_QG = 0, SC_WV = 16384, SC_KDT = 32768, SC_A = 49152, SC_BUF = 57344, SC_VEC = 2 * SC_BUF, SC_OT = SC_VEC + 2048, SC_OTB = 17408, SC_GAIN = SC_OT + 2 * SC_OTB;

__device__ __forceinline__ bf16x8 pack_frag(const f32x4& x0, const f32x4& x1) {
    v4u w; w.x = pk2(x0.x, x0.y); w.y = pk2(x0.z, x0.w); w.z = pk2(x1.x, x1.y); w.w = pk2(x1.z, x1.w);
    return __builtin_bit_cast(bf16x8, w);
}
#define MFMA16(a, b, c) __builtin_amdgcn_mfma_f32_16x16x32_bf16((a), (b), (c), 0, 0, 0)

__device__ __forceinline__ void hgrn_prep_item(int item, const bf16_t* proj, const float* lb_logits, unsigned char* pb, float* vecs, LAS unsigned char* lds, int tid) {
    const int c = item & 127, sq = item >> 7, b = sq >> 3, h = sq & 7, t0 = b * SEQ + c * 64;
    const int d = tid & 127, seg = tid >> 7, lane = tid & 63, wave = tid >> 6;
    LAS bf16_t* QGl = (LAS bf16_t*)lds; LAS bf16_t* KGl = (LAS bf16_t*)(lds + 17408); LAS float* segsum = (LAS float*)(lds + 34816);
    bf16_t* gQG = (bf16_t*)(pb + PB_H_QG) + (size_t)item * 8192;
    bf16_t* gKDT = (bf16_t*)(pb + PB_H_KDT) + (size_t)item * 8192;
    bf16_t* gA = (bf16_t*)(pb + PB_H_A) + (size_t)item * 4096;
    float* gvec = vecs + (size_t)item * 256;
    const float l0 = lb_logits[h * 128 + d], l1 = lb_logits[1024 + h * 128 + d];
    const float lb = 1.f / (1.f + __expf(l1 - l0));
    float lf[16], qv[16], kv[16];
#pragma unroll
    for (int i = 0; i < 16; ++i) {
        const bf16_t* pr = proj + (size_t)(t0 + 16 * seg + i) * NPROJ + h * 128 + d;
        const float z = bf2f(pr[C_AF]); qv[i] = bf2f(pr[C_AQ]);
        const float f = lb + (1.f - lb) * sigmoidf_(z);
        lf[i] = __logf(f); kv[i] = 1.f - f;
    }
    float run = 0.f;
#pragma unroll
    for (int i = 0; i < 16; ++i) { run += lf[i]; lf[i] = run; }
    segsum[seg * 128 + d] = run;
    __syncthreads();
    float off = 0.f, bl = 0.f;
#pragma unroll
    for (int s = 0; s < 4; ++s) { const float v = segsum[s * 128 + d]; bl += v; if (s < seg) off += v; }
    const int pd = pos32(d);
    float kd[16];
#pragma unroll
    for (int i = 0; i < 16; ++i) {
        const float bc = lf[i] + off; const int tl = 16 * seg + i;
        const float qg = qv[i] * __expf(bc), kg = kv[i] * __expf(-bc);
        kd[i] = kv[i] * __expf(bl - bc);
        const bf16_t qb = f2bf(qg);
        QGl[tl * 136 + d] = qb; KGl[tl * 136 + d] = f2bf(kg);
        gQG[tl * 128 + pd] = qb;
    }
#pragma unroll
    for (int ii = 0; ii < 4; ++ii) { v2u o; o.x = pk2(kd[4 * ii], kd[4 * ii + 1]); o.y = pk2(kd[4 * ii + 2], kd[4 * ii + 3]);
        *(v2u*)(gKDT + d * 64 + 32 * (seg >> 1) + 8 * ii + 4 * (seg & 1)) = o; }
    if (seg == 0) gvec[128 + d] = __expf(bl);
    __syncthreads();
    const int n = lane & 15, q = lane >> 4;
#pragma unroll
    for (int ti = 0; ti < 2; ++ti) {
        const int id = wave + 8 * ti, mt = id >> 2, ns = id & 3;
        f32x4 acc = {0.f, 0.f, 0.f, 0.f};
        if (ns <= mt) {
#pragma unroll
            for (int s4 = 0; s4 < 4; ++s4) {
                const bf16x8 a = *(const LAS bf16x8*)(QGl + (16 * mt + n) * 136 + 32 * s4 + 8 * q);
                const bf16x8 bb = *(const LAS bf16x8*)(KGl + (16 * ns + n) * 136 + 32 * s4 + 8 * q);
                acc = MFMA16(a, bb, acc);
            }
        }
        const int s = 16 * ns + n, ps = pos32(s);
#pragma unroll
        for (int r = 0; r < 4; ++r) { const int t = 16 * mt + 4 * q + r; const float v = (r == 0) ? acc.x : (r == 1) ? acc.y : (r == 2) ? acc.z : acc.w;
            gA[t * 64 + ps] = f2bf((s <= t) ? v : 0.f); }
    }
    __syncthreads();
}

constexpr int GP_QF = 0, GP_KF = 33024, GP_N = 0, GP_QB = 66048, GP_KB = 83456, GP_VB = 100864, GP_PART = 135680, GP_SB = 137728;
__device__ __forceinline__ void gdn_prep_item(int item, const bf16_t* proj, const float* ba, const float* conv_w, const float* A_log, const float* dt_bias,
                                              unsigned char* pb, float* vecs, LAS unsigned char* lds, int tid) {
    const int c = item & 127, bq = item >> 7, b = bq >> 2, qh = bq & 3, t0 = b * SEQ + c * 64;
    const int lane = tid & 63, wave = tid >> 6;
    LAS float* QF = (LAS float*)(lds + GP_QF); LAS float* KF = (LAS float*)(lds + GP_KF);
    LAS bf16_t* QB = (LAS bf16_t*)(lds + GP_QB); LAS bf16_t* KB = (LAS bf16_t*)(lds + GP_KB); LAS bf16_t* VB = (LAS bf16_t*)(lds + GP_VB);
    LAS float* PART = (LAS float*)(lds + GP_PART); LAS float* SBETA = (LAS float*)(lds + GP_SB); LAS float* SGC = SBETA + 128;
    LAS float* NM = (LAS float*)(lds + GP_N);
    {
        int col, wch; const int dd = tid & 127;
        if (tid < 128) { col = C_BQ + qh * 128 + dd; wch = qh * 128 + dd; }
        else if (tid < 256) { col = C_BK + qh * 128 + dd; wch = 512 + qh * 128 + dd; }
        else { const int vh = 2 * qh + ((tid - 256) >> 7); col = C_BV + vh * 128 + dd; wch = 1024 + vh * 128 + dd; }
        const float w0 = conv_w[wch], w1 = conv_w[2048 + wch], w2 = conv_w[4096 + wch], w3 = conv_w[6144 + wch];
        float h0 = 0.f, h1 = 0.f, h2 = 0.f;
        const bf16_t* pr = proj + (size_t)t0 * NPROJ + col;
        if (c > 0) { h0 = bf2f(pr[-3 * NPROJ]); h1 = bf2f(pr[-2 * NPROJ]); h2 = bf2f(pr[-1 * NPROJ]); }
        unsigned xr[64];
#pragma unroll
        for (int t = 0; t < 64; ++t) xr[t] = pr[(size_t)t * NPROJ];
#pragma unroll
        for (int t = 0; t < 64; ++t) {
            const float xx = __uint_as_float(xr[t] << 16);
            const float yv = siluf_(w0 * h0 + w1 * h1 + w2 * h2 + w3 * xx);
            h0 = h1; h1 = h2; h2 = xx;
            if (tid < 128) QF[t * 129 + dd] = yv;
            else if (tid < 256) KF[t * 129 + dd] = yv;
            else VB[((tid - 256) >> 7) * 8704 + t * 136 + dd] = f2bf(yv);
        }
    }
    __syncthreads();
    {
        const int t = tid & 63, part = tid >> 6, which = part >> 2, sub = part & 3;
        const LAS float* src = (which ? KF : QF) + t * 129 + 32 * sub;
        float s = 0.f;
#pragma unroll
        for (int i = 0; i < 32; ++i) s += src[i] * src[i];
        PART[(which * 4 + sub) * 64 + t] = s;
    }
    if (wave < 2) {
        const int vh = 2 * qh + wave;
        const float ax = ba[(size_t)(t0 + lane) * 16 + 8 + vh] + dt_bias[vh];
        const float sp = ax > 20.f ? ax : log1pf(__expf(ax));
        float gc = -__expf(A_log[vh]) * sp;
#pragma unroll
        for (int o = 1; o < 64; o <<= 1) { const float up = __shfl_up(gc, o); if (lane >= o) gc += up; }
        const float gl = __shfl(gc, 63);
        const float beta = sigmoidf_(ba[(size_t)(t0 + lane) * 16 + vh]);
        SBETA[wave * 64 + lane] = beta; SGC[wave * 64 + lane] = gc;
        float* gvec = vecs + ((size_t)(16 + b * 8 + vh) * 128 + c) * 256;
        gvec[lane] = __expf(gc); gvec[64 + lane] = __expf(gl - gc);
        const float dl = __expf(gl); gvec[128 + lane] = dl; gvec[192 + lane] = dl;
    }
    __syncthreads();
    {
        const int d = tid & 127, seg = tid >> 7, pd = pos32(d);
        bf16_t* gQS = (bf16_t*)(pb + PB_G_QS) + (size_t)item * 8192;
        bf16_t* gKT = (bf16_t*)(pb + PB_G_KT) + (size_t)item * 8192;
        float kk[16];
#pragma unroll
        for (int i = 0; i < 16; ++i) {
            const int tl = 16 * seg + i;
            const float sq = PART[0 * 64 + tl] + PART[1 * 64 + tl] + PART[2 * 64 + tl] + PART[3 * 64 + tl];
            const float sk = PART[4 * 64 + tl] + PART[5 * 64 + tl] + PART[6 * 64 + tl] + PART[7 * 64 + tl];
            const bf16_t qb = f2bf(QF[tl * 129 + d] * rsqrtf(sq + EPS) * 0.08838834764831845f);
            const bf16_t kb = f2bf(KF[tl * 129 + d] * rsqrtf(sk + EPS));
            QB[tl * 136 + d] = qb; KB[tl * 136 + d] = kb; gQS[tl * 128 + pd] = qb; kk[i] = bf2f(kb);
        }
#pragma unroll
        for (int ii = 0; ii < 4; ++ii) { v2u o; o.x = pk2(kk[4 * ii], kk[4 * ii + 1]); o.y = pk2(kk[4 * ii + 2], kk[4 * ii + 3]);
            *(v2u*)(gKT + d * 64 + 32 * (seg >> 1) + 8 * ii + 4 * (seg & 1)) = o; }
    }
    __syncthreads();
    {
        const int n = lane & 15, q = lane >> 4;
#pragma unroll
        for (int ti = 0; ti < 2; ++ti) {
            const int id = 2 * wave + ti, mt = id >> 2, ns = id & 3;
            f32x4 akk = {0.f, 0.f, 0.f, 0.f}, aqk = {0.f, 0.f, 0.f, 0.f};
            if (ns <= mt) {
#pragma unroll
                for (int s4 = 0; s4 < 4; ++s4) {
                    const bf16x8 kb_ = *(const LAS bf16x8*)(KB + (16 * ns + n) * 136 + 32 * s4 + 8 * q);
                    const bf16x8 ka_ = *(const LAS bf16x8*)(KB + (16 * mt + n) * 136 + 32 * s4 + 8 * q);
                    const bf16x8 qa_ = *(const LAS bf16x8*)(QB + (16 * mt + n) * 136 + 32 * s4 + 8 * q);
                    akk = MFMA16(ka_, kb_, akk); aqk = MFMA16(qa_, kb_, aqk);
                }
            }
            const int s = 16 * ns + n, ps = pos32(s);
#pragma unroll
            for (int vl = 0; vl < 2; ++vl) {
                bf16_t* gA = (bf16_t*)(pb + PB_G_A) + ((size_t)((b * 8 + 2 * qh + vl) * 128 + c)) * 4096;
                const float gcs = SGC[vl * 64 + s];
#pragma unroll
                for (int r = 0; r < 4; ++r) {
                    const int t = 16 * mt + 4 * q + r;
                    const float vk = (r == 0) ? akk.x : (r == 1) ? akk.y : (r == 2) ? akk.z : akk.w;
                    const float vq = (r == 0) ? aqk.x : (r == 1) ? aqk.y : (r == 2) ? aqk.z : aqk.w;
                    const float ex = (s <= t) ? __expf(SGC[vl * 64 + t] - gcs) : 0.f;
                    NM[vl * 4096 + t * 64 + s] = (s < t) ? SBETA[vl * 64 + t] * vk * ex : 0.f;
                    gA[t * 64 + ps] = f2bf((s <= t) ? vq * ex : 0.f);
                }
            }
        }
    }
    __syncthreads();
    {
        const int vl = tid >> 8, colx = tid & 255;
        float x[64];
        if (colx < 128) {
#pragma unroll
            for (int t = 0; t < 64; ++t) x[t] = SBETA[vl * 64 + t] * bf2f(VB[vl * 8704 + t * 136 + colx]);
        } else {
#pragma unroll
            for (int t = 0; t < 64; ++t) x[t] = SBETA[vl * 64 + t] * __expf(SGC[vl * 64 + t]) * bf2f(KB[t * 136 + colx - 128]);
        }
        __syncthreads();
        const LAS float* Nv = NM + vl * 4096;
#pragma unroll
        for (int t = 1; t < 64; ++t) {
            float acc = x[t];
#pragma unroll
            for (int s4 = 0; s4 < (t + 3) / 4; ++s4) {
                const f32x4 nn = *(const LAS f32x4*)(Nv + t * 64 + 4 * s4);
                acc -= nn.x * x[4 * s4]; if (4 * s4 + 1 < t) acc -= nn.y * x[4 * s4 + 1]; if (4 * s4 + 2 < t) acc -= nn.z * x[4 * s4 + 2]; if (4 * s4 + 3 < t) acc -= nn.w * x[4 * s4 + 3];
            }
            x[t] = acc;
        }
        if (colx < 128) {
            bf16_t* gU = (bf16_t*)(pb + PB_G_U) + ((size_t)((b * 8 + 2 * qh + vl) * 128 + c)) * 8192;
            const int sl = colx >> 4, n = colx & 15;
#pragma unroll
            for (int mt = 0; mt < 4; ++mt)
#pragma unroll
                for (int q = 0; q < 4; ++q) { v2u o; o.x = pk2(x[16 * mt + 4 * q], x[16 * mt + 4 * q + 1]); o.y = pk2(x[16 * mt + 4 * q + 2], x[16 * mt + 4 * q + 3]);
                    *(v2u*)(gU + ((size_t)((sl * 4 + mt) * 64 + q * 16 + n)) * 4) = o; }
        } else {
            LAS bf16_t* WS = (LAS bf16_t*)(lds + GP_QB) + vl * 8704;
            const int pd = pos32(colx - 128);
#pragma unroll
            for (int t = 0; t < 64; ++t) WS[t * 136 + pd] = f2bf(-x[t]);
        }
    }
    __syncthreads();
    {
#pragma unroll
        for (int i = 0; i < 4; ++i) { const int p = tid + 512 * i, vl = p >> 10, row = (p >> 4) & 63, c16 = p & 15;
            bf16_t* gW = (bf16_t*)(pb + PB_G_W) + ((size_t)((b * 8 + 2 * qh + vl) * 128 + c)) * 8192;
            *(v4u*)(gW + row * 128 + c16 * 8) = *(const LAS v4u*)(lds + GP_QB + vl * 17408 + row * 272 + c16 * 16); }
    }
    __syncthreads();
}

struct ScanSrc { const unsigned char* qg; const unsigned char* wv; const unsigned char* kdt; const unsigned char* a; const float* vec; size_t wv_row; };
__device__ __forceinline__ void scan_dma(const ScanSrc& S, LAS unsigned char* buf, LAS unsigned char* vecb, int w, int lane) {
#pragma unroll
    for (int i = 0; i < 2; ++i) { const int pi = 2 * w + i, row = 4 * pi + (lane >> 4), cl = (lane & 15) ^ (row & 15);
        __builtin_amdgcn_global_load_lds((const unsigned*)(S.qg + row * 256 + cl * 16), (LAS unsigned*)(buf + SC_QG + pi * 1024), 16, 0, 0);
        __builtin_amdgcn_global_load_lds((const unsigned*)(S.wv + (size_t)row * S.wv_row + cl * 16), (LAS unsigned*)(buf + SC_WV + pi * 1024), 16, 0, 0); }
#pragma unroll
    for (int i = 0; i < 2; ++i) { const int pi = 2 * w + i, row = 8 * pi + (lane >> 3), cl = (lane & 7) ^ ((row >> 1) & 7);
        __builtin_amdgcn_global_load_lds((const unsigned*)(S.kdt + row * 128 + cl * 16), (LAS unsigned*)(buf + SC_KDT + pi * 1024), 16, 0, 0); }
    { const int pi = w, row = 8 * pi + (lane >> 3), cl = (lane & 7) ^ ((row >> 1) & 7);
        __builtin_amdgcn_global_load_lds((const unsigned*)(S.a + row * 128 + cl * 16), (LAS unsigned*)(buf + SC_A + pi * 1024), 16, 0, 0); }
    if (w == 0) __builtin_amdgcn_global_load_lds((const unsigned*)((const unsigned char*)S.vec + lane * 16), (LAS unsigned*)vecb, 16, 0, 0);
}
__device__ __forceinline__ void scan_block(int sq, const bf16_t* proj, const unsigned char* pb, const float* vecs, const float* hgrn_g, const float* gdn_g,
                                           bf16_t* mix, unsigned* prog, LAS unsigned char* lds, int tid) {
    const bool gdn = sq >= 16;
    const int b = (sq & 15) >> 3, hh = sq & 7, lane = tid & 63, sl = __builtin_amdgcn_readfirstlane(tid >> 6), n = lane & 15, q = lane >> 4;
    const unsigned char* bQG; const unsigned char* bWV; const unsigned char* bKDT; const unsigned char* bA; const unsigned char* bU = nullptr;
    size_t wv_row, wv_chunk; int gate_col, mix_col; const float* gain;
    if (!gdn) {
        const size_t s0 = (size_t)(b * 8 + hh) * 128;
        bQG = pb + PB_H_QG + s0 * 16384; bKDT = pb + PB_H_KDT + s0 * 16384; bA = pb + PB_H_A + s0 * 8192;
        bWV = (const unsigned char*)(proj + (size_t)(b * SEQ) * NPROJ + C_AI + hh * 128); wv_row = (size_t)NPROJ * 2; wv_chunk = (size_t)64 * NPROJ * 2;
        gate_col = C_AG + hh * 128; mix_col = hh * 128; gain = hgrn_g;
    } else {
        const size_t s0 = (size_t)(b * 8 + hh) * 128, q0 = (size_t)(b * 4 + (hh >> 1)) * 128;
        bQG = pb + PB_G_QS + q0 * 16384; bKDT = pb + PB_G_KT + q0 * 16384; bA = pb + PB_G_A + s0 * 8192;
        bWV = pb + PB_G_W + s0 * 16384; wv_row = 256; wv_chunk = 16384; bU = pb + PB_G_U + s0 * 16384;
        gate_col = C_BZ + hh * 128; mix_col = 1024 + hh * 128; gain = gdn_g;
    }
    const float* bvec = vecs + (size_t)sq * 128 * 256;
    LAS float* gainl = (LAS float*)(lds + SC_GAIN);
    const int wave = sl;
    {
        ScanSrc src{bQG, bWV, bKDT, bA, bvec, wv_row};
        scan_dma(src, lds, lds + SC_VEC, wave, lane);
        if (tid < 128) gainl[tid] = gain[tid];
    }
    asm volatile("s_waitcnt vmcnt(0) lgkmcnt(0)" ::: "memory");
    __builtin_amdgcn_s_barrier();
    asm volatile("" ::: "memory");
#define SCAN_BAR() do { asm volatile("s_waitcnt lgkmcnt(0)" ::: "memory"); __builtin_amdgcn_s_barrier(); asm volatile("" ::: "memory"); } while (0)
#define SCHED_FENCE() __builtin_amdgcn_sched_barrier(0)
    if (wave < 4) {
        f32x4 S[2][8];
#pragma unroll
        for (int e = 0; e < 2; ++e)
#pragma unroll
            for (int m = 0; m < 8; ++m) S[e][m] = (f32x4){0.f, 0.f, 0.f, 0.f};
        v2u Ureg[2][4];
#pragma unroll
        for (int e = 0; e < 2; ++e)
#pragma unroll
            for (int mt = 0; mt < 4; ++mt) Ureg[e][mt] = gdn ? *(const v2u*)(bU + (size_t)((2 * wave + e) * 4 + mt) * 512 + lane * 8) : (v2u){0u, 0u};
        for (int c = 0; c < 128; ++c) {
            int lane = tid & 63; asm volatile("" : "+v"(lane));
            const int n = lane & 15, q = lane >> 4;
            const int cur = c & 1;
            LAS unsigned char* buf = lds + cur * SC_BUF;
            const LAS float* vec = (const LAS float*)(lds + SC_VEC + cur * 1024);
            const int cn = (c + 1 < 128) ? c + 1 : 127;
            bf16x8 Sf[2][4];
#pragma unroll
            for (int e = 0; e < 2; ++e)
#pragma unroll
                for (int s4 = 0; s4 < 4; ++s4) Sf[e][s4] = pack_frag(S[e][2 * s4], S[e][2 * s4 + 1]);
            bf16x8 fa[4], fb[4];
            bf16x8 VNf[2][2], VNSf[2][2];
#define SC2_LD4_K128(dst, OFF, mt_) do { _Pragma("unroll") for (int i_ = 0; i_ < 4; ++i_) dst[i_] = *(const LAS bf16x8*)(buf + (OFF) + (16 * (mt_) + n) * 256 + (((4 * i_ + q) ^ n) * 16)); } while (0)
#define SC2_LD4_K64(dst, OFF, mb) do { _Pragma("unroll") for (int i_ = 0; i_ < 4; ++i_) dst[i_] = *(const LAS bf16x8*)(buf + (OFF) + (16 * ((mb) + (i_ >> 1)) + n) * 128 + (((4 * (i_ & 1) + q) ^ ((n >> 1) & 7)) * 16)); } while (0)
#define SC2_MM_K128(A0, A1, fr) do { _Pragma("unroll") for (int i_ = 0; i_ < 4; ++i_) { A0 = MFMA16(fr[i_], Sf[0][i_], A0); A1 = MFMA16(fr[i_], Sf[1][i_], A1); } } while (0)
#define SC2_MM_K64(X, ma, fr, BF) do { X[0][ma] = MFMA16(fr[0], BF[0][0], X[0][ma]); X[1][ma] = MFMA16(fr[0], BF[1][0], X[1][ma]); X[0][ma] = MFMA16(fr[1], BF[0][1], X[0][ma]); X[1][ma] = MFMA16(fr[1], BF[1][1], X[1][ma]); \
        X[0][(ma) + 1] = MFMA16(fr[2], BF[0][0], X[0][(ma) + 1]); X[1][(ma) + 1] = MFMA16(fr[2], BF[1][0], X[1][(ma) + 1]); X[0][(ma) + 1] = MFMA16(fr[3], BF[0][1], X[0][(ma) + 1]); X[1][(ma) + 1] = MFMA16(fr[3], BF[1][1], X[1][(ma) + 1]); } while (0)
            if (gdn) {
                f32x4 VN[2][4];
                SC2_LD4_K128(fa, SC_WV, 0); SCHED_FENCE();
                SC2_LD4_K128(fb, SC_WV, 1); SCHED_FENCE();
#pragma unroll
                for (int e = 0; e < 2; ++e)
#pragma unroll
                    for (int mt = 0; mt < 4; ++mt) { const v2u uu = Ureg[e][mt];
                        VN[e][mt] = (f32x4){__uint_as_float(uu.x << 16), __uint_as_float(uu.x & 0xffff0000u), __uint_as_float(uu.y << 16), __uint_as_float(uu.y & 0xffff0000u)}; }
#pragma unroll
                for (int e = 0; e < 2; ++e)
#pragma unroll
                    for (int mt = 0; mt < 4; ++mt) Ureg[e][mt] = *(const v2u*)(bU + (size_t)cn * 16384 + (size_t)((2 * wave + e) * 4 + mt) * 512 + lane * 8);
                SC2_MM_K128(VN[0][0], VN[1][0], fa); SCHED_FENCE(); SC2_LD4_K128(fa, SC_WV, 2); SCHED_FENCE();
                SC2_MM_K128(VN[0][1], VN[1][1], fb); SCHED_FENCE(); SC2_LD4_K128(fb, SC_WV, 3); SCHED_FENCE();
                SC2_MM_K128(VN[0][2], VN[1][2], fa); SCHED_FENCE(); SC2_LD4_K128(fa, SC_QG, 0); SCHED_FENCE();
                SC2_MM_K128(VN[0][3], VN[1][3], fb); SCHED_FENCE(); SC2_LD4_K128(fb, SC_QG, 1); SCHED_FENCE();
#pragma unroll
                for (int e = 0; e < 2; ++e)
#pragma unroll
                    for (int s2 = 0; s2 < 2; ++s2) { const f32x4 e0 = *(const LAS f32x4*)(vec + 64 + 16 * (2 * s2) + 4 * q), e1 = *(const LAS f32x4*)(vec + 64 + 16 * (2 * s2 + 1) + 4 * q);
                        VNf[e][s2] = pack_frag(VN[e][2 * s2], VN[e][2 * s2 + 1]); VNSf[e][s2] = pack_frag(VN[e][2 * s2] * e0, VN[e][2 * s2 + 1] * e1); }
            } else {
                SC2_LD4_K128(fa, SC_QG, 0); SCHED_FENCE();
                SC2_LD4_K128(fb, SC_QG, 1); SCHED_FENCE();
#pragma unroll
                for (int e = 0; e < 2; ++e)
#pragma unroll
                    for (int s2 = 0; s2 < 2; ++s2) { unsigned w[4];
#pragma unroll
                        for (int jj = 0; jj < 4; ++jj) { const int ja = 2 * jj, jb = 2 * jj + 1; const int cc = 16 * (2 * wave + e) + n;
                            const int ta = 32 * s2 + ((ja < 4) ? 4 * q + ja : 16 + 4 * q + ja - 4), tb = 32 * s2 + ((jb < 4) ? 4 * q + jb : 16 + 4 * q + jb - 4);
                            const unsigned lo = *(const LAS bf16_t*)(buf + SC_WV + ta * 256 + (((cc >> 3) ^ (ta & 15)) * 16) + (cc & 7) * 2), hi = *(const LAS bf16_t*)(buf + SC_WV + tb * 256 + (((cc >> 3) ^ (tb & 15)) * 16) + (cc & 7) * 2);
                            w[jj] = lo | (hi << 16); }
                        v4u ww; ww.x = w[0]; ww.y = w[1]; ww.z = w[2]; ww.w = w[3];
                        VNf[e][s2] = __builtin_bit_cast(bf16x8, ww); VNSf[e][s2] = VNf[e][s2]; }
            }
            f32x4 O[2][4];
#pragma unroll
            for (int e = 0; e < 2; ++e)
#pragma unroll
                for (int mt = 0; mt < 4; ++mt) O[e][mt] = (f32x4){0.f, 0.f, 0.f, 0.f};
            SC2_MM_K128(O[0][0], O[1][0], fa); SCHED_FENCE(); SC2_LD4_K128(fa, SC_QG, 2); SCHED_FENCE();
            SC2_MM_K128(O[0][1], O[1][1], fb); SCHED_FENCE(); SC2_LD4_K128(fb, SC_QG, 3); SCHED_FENCE();
            SC2_MM_K128(O[0][2], O[1][2], fa); SCHED_FENCE(); SC2_LD4_K64(fa, SC_A, 0); SCHED_FENCE();
            SC2_MM_K128(O[0][3], O[1][3], fb); SCHED_FENCE(); SC2_LD4_K64(fb, SC_A, 2); SCHED_FENCE();
            if (gdn) {
#pragma unroll
                for (int mt = 0; mt < 4; ++mt) { const f32x4 eg4 = *(const LAS f32x4*)(vec + 16 * mt + 4 * q); O[0][mt] = O[0][mt] * eg4; O[1][mt] = O[1][mt] * eg4; }
            }
            SC2_MM_K64(O, 0, fa, VNf); SCHED_FENCE(); SC2_LD4_K64(fa, SC_KDT, 0); SCHED_FENCE();
            SC2_MM_K64(O, 2, fb, VNf); SCHED_FENCE(); SC2_LD4_K64(fb, SC_KDT, 2); SCHED_FENCE();
#pragma unroll
            for (int m = 0; m < 8; ++m) { const f32x4 d4 = *(const LAS f32x4*)(vec + 128 + 16 * m + 4 * q); S[0][m] = S[0][m] * d4; S[1][m] = S[1][m] * d4; }
            SC2_MM_K64(S, 0, fa, VNSf); SCHED_FENCE(); SC2_LD4_K64(fa, SC_KDT, 4); SCHED_FENCE();
            SC2_MM_K64(S, 2, fb, VNSf); SCHED_FENCE(); SC2_LD4_K64(fb, SC_KDT, 6); SCHED_FENCE();
            SC2_MM_K64(S, 4, fa, VNSf);
            SC2_MM_K64(S, 6, fb, VNSf);
            LAS bf16_t* OT = (LAS bf16_t*)(lds + SC_OT + cur * SC_OTB);
#pragma unroll
            for (int e = 0; e < 2; ++e)
#pragma unroll
                for (int mt = 0; mt < 4; ++mt) { const int cc = 16 * (2 * wave + e) + n;
                    OT[(16 * mt + 4 * q + 0) * 136 + cc] = f2bf(O[e][mt].x); OT[(16 * mt + 4 * q + 1) * 136 + cc] = f2bf(O[e][mt].y);
                    OT[(16 * mt + 4 * q + 2) * 136 + cc] = f2bf(O[e][mt].z); OT[(16 * mt + 4 * q + 3) * 136 + cc] = f2bf(O[e][mt].w); }
            SCAN_BAR();
        }
    } else {
        const int hw = wave - 4;
        v4u gprev[4]; v4u G[15];
#pragma unroll
        for (int i = 0; i < 4; ++i) gprev[i] = (v4u){0u, 0u, 0u, 0u};
        for (int c = 0; c <= 128; ++c) {
            int lane = tid & 63; asm volatile("" : "+v"(lane));
            const int rt = hw * 16 + (lane >> 2), cg4 = lane & 3;
            const int t0 = b * SEQ + c * 64;
            v4u gcur[4];
            if (c < 128) {
                if (tid == 256) __hip_atomic_store(prog + sq, (unsigned)c, __ATOMIC_RELAXED, __HIP_MEMORY_SCOPE_AGENT);
                const int cn = (c + 1 < 128) ? c + 1 : 127;
                {
                    const unsigned char* sQG = bQG + (size_t)cn * 16384 + (size_t)hw * 4096; const unsigned char* sWV = bWV + (size_t)cn * wv_chunk + (size_t)(16 * hw) * wv_row;
                    const unsigned char* sKDT = bKDT + (size_t)cn * 16384 + (size_t)hw * 4096; const unsigned char* sA = bA + (size_t)cn * 8192 + (size_t)hw * 2048;
                    const unsigned l16 = (unsigned)lane * 16u, offv = (unsigned)(lane >> 4) * (unsigned)wv_row + (unsigned)(lane & 15) * 16u;
#pragma unroll
                    for (int i = 0; i < 4; ++i) { G[i] = *(const v4u*)(sQG + i * 1024 + l16); G[4 + i] = *(const v4u*)(sWV + (size_t)(4 * i) * wv_row + offv); }
#pragma unroll
                    for (int i = 0; i < 4; ++i) G[8 + i] = *(const v4u*)(sKDT + i * 1024 + l16);
#pragma unroll
                    for (int i = 0; i < 2; ++i) G[12 + i] = *(const v4u*)(sA + i * 1024 + l16);
                    G[14] = *(const v4u*)((const unsigned char*)(bvec + (size_t)cn * 256) + l16);
                }
                const bf16_t* gp = proj + (size_t)(t0 + rt) * NPROJ + gate_col + 32 * cg4;
#pragma unroll
                for (int i = 0; i < 4; ++i) gcur[i] = *(const v4u*)(gp + 8 * i);
            } else {
#pragma unroll
                for (int i = 0; i < 4; ++i) gcur[i] = (v4u){0u, 0u, 0u, 0u};
            }
            v4u ysave[4];
#pragma unroll
            for (int i = 0; i < 4; ++i) ysave[i] = (v4u){0u, 0u, 0u, 0u};
            if (c > 0) {
                const int pc = c - 1, pt0 = b * SEQ + pc * 64;
                const LAS bf16_t* OT = (const LAS bf16_t*)(lds + SC_OT + (pc & 1) * SC_OTB);
                float ov[32]; float ss = 0.f;
#pragma unroll
                for (int i = 0; i < 4; ++i) { const v4u o4 = *(const LAS v4u*)(OT + rt * 136 + 32 * cg4 + 8 * i);
#pragma unroll
                    for (int w = 0; w < 4; ++w) { const unsigned a = (w == 0) ? o4.x : (w == 1) ? o4.y : (w == 2) ? o4.z : o4.w;
                        ov[8 * i + 2 * w] = __uint_as_float(a << 16); ov[8 * i + 2 * w + 1] = __uint_as_float(a & 0xffff0000u); } }
#pragma unroll
                for (int i = 0; i < 32; ++i) ss += ov[i] * ov[i];
                ss += __shfl_xor(ss, 1); ss += __shfl_xor(ss, 2);
                const float rstd = rsqrtf(ss * (1.f / 128.f) + EPS);
#pragma unroll
                for (int i = 0; i < 4; ++i) {
                    const f32x4 g0 = *(const LAS f32x4*)(gainl + 32 * cg4 + 8 * i), g1 = *(const LAS f32x4*)(gainl + 32 * cg4 + 8 * i + 4);
                    float yv[8];
#pragma unroll
                    for (int w = 0; w < 4; ++w) { const unsigned ga = (w == 0) ? gprev[i].x : (w == 1) ? gprev[i].y : (w == 2) ? gprev[i].z : gprev[i].w;
                        const float z0 = __uint_as_float(ga << 16), z1 = __uint_as_float(ga & 0xffff0000u);
                        const float gg0 = (w == 0) ? g0.x : (w == 1) ? g0.z : (w == 2) ? g1.x : g1.z, gg1 = (w == 0) ? g0.y : (w == 1) ? g0.w : (w == 2) ? g1.y : g1.w;
                        yv[2 * w] = ov[8 * i + 2 * w] * rstd * gg0 * z0;
                        yv[2 * w + 1] = ov[8 * i + 2 * w + 1] * rstd * gg1 * z1; }
                    v4u y4; y4.x = pk2(yv[0], yv[1]); y4.y = pk2(yv[2], yv[3]); y4.z = pk2(yv[4], yv[5]); y4.w = pk2(yv[6], yv[7]);
                    ysave[i] = y4;
                }
            }
#pragma unroll
            for (int i = 0; i < 4; ++i) gprev[i] = gcur[i];
            if (c < 128) {
                LAS unsigned char* nb = lds + ((c + 1) & 1) * SC_BUF + hw * 4096; LAS unsigned char* nv = lds + SC_VEC + ((c + 1) & 1) * 1024;
                const int lq = lane >> 4;
#pragma unroll
                for (int i = 0; i < 4; ++i) { const int d = lq * 256 + (((lane & 15) ^ (4 * i + lq)) * 16);
                    *(LAS v4u*)(nb + SC_QG + i * 1024 + d) = G[i]; *(LAS v4u*)(nb + SC_WV + i * 1024 + d) = G[4 + i]; }
#pragma unroll
                for (int i = 0; i < 4; ++i) { const int d = (lane >> 3) * 128 + (((lane & 7) ^ (4 * (i & 1) + lq)) * 16); *(LAS v4u*)(nb + SC_KDT + i * 1024 + d) = G[8 + i]; }
#pragma unroll
                for (int i = 0; i < 2; ++i) { const int d = (lane >> 3) * 128 + (((lane & 7) ^ (4 * i + lq)) * 16); *(LAS v4u*)(nb - hw * 2048 + SC_A + i * 1024 + d) = G[12 + i]; }
                if (hw == 0) *(LAS v4u*)(nv + lane * 16) = G[14];
            }
            if (c > 0) {
                bf16_t* mp = mix + (size_t)(b * SEQ + (c - 1) * 64 + rt) * DM + mix_col + 32 * cg4;
#pragma unroll
                for (int i = 0; i < 4; ++i) *(v4u*)(mp + 8 * i) = ysave[i];
            }
            if (c < 128) SCAN_BAR();
        }
    }
    __syncthreads();
}

struct EpiProj {
    static constexpr bool PERM = true, AFTER_DRAIN = false;
    bf16_t* O; int ldc;
    __device__ __forceinline__ void operator()(const pg8::f32x4 (&acc)[2][2][4][2], const pg8::Unit& u, int wr, int wc, int fr, int fq) const {
        const int row0 = u.pm * 256 + wr * 64 + fr, col0 = u.pn * 256 + wc * 32 + 8 * fq;
        const bool gate = (u.pn >= 12 && u.pn < 16) || (u.pn >= 24);
#pragma unroll
        for (int ai = 0; ai < 2; ++ai)
#pragma unroll
            for (int m = 0; m < 4; ++m) { bf16_t* rowp = O + (size_t)(row0 + ai * 128 + m * 16) * ldc + col0;
#pragma unroll
                for (int bj = 0; bj < 2; ++bj) { pg8::f32x4 v0 = acc[ai][bj][m][0], v1 = acc[ai][bj][m][1];
                    if (gate) {
#pragma unroll
                        for (int e = 0; e < 4; ++e) { v0[e] = v0[e] * __builtin_amdgcn_rcpf(1.f + __expf(-v0[e])); v1[e] = v1[e] * __builtin_amdgcn_rcpf(1.f + __expf(-v1[e])); } }
                    pg8::u32x4 w; w.x = pk2(v0[0], v0[1]); w.y = pk2(v0[2], v0[3]); w.z = pk2(v1[0], v1[1]); w.w = pk2(v1[2], v1[3]);
                    *(pg8::u32x4*)(rowp + bj * 128) = w; } }
    }
};
struct EpiResF32 {
    static constexpr bool PERM = false, AFTER_DRAIN = false;
    const float* R; float* O; int ldc;
    __device__ __forceinline__ void operator()(const pg8::f32x4 (&acc)[2][2][4][2], const pg8::Unit& u, int wr, int wc, int fr, int fq) const {
        const int row0 = u.pm * 256 + wr * 64 + fr, col0 = u.pn * 256 + wc * 32 + 4 * fq;
#pragma unroll
        for (int ai = 0; ai < 2; ++ai)
#pragma unroll
            for (int m = 0; m < 4; ++m) { const size_t off = (size_t)(row0 + ai * 128 + m * 16) * ldc + col0;
#pragma unroll
                for (int bj = 0; bj < 2; ++bj)
#pragma unroll
                    for (int n = 0; n < 2; ++n) { pg8::f32x4 v = acc[ai][bj][m][n]; if (R) v = v + *(const pg8::f32x4*)(R + off + bj * 128 + n * 16); *(pg8::f32x4*)(O + off + bj * 128 + n * 16) = v; } }
    }
};

#define XB_TMO      128
#define XB_XCNT(j)  (256  + 64 * (j))
#define XB_XSUB(j)  (1280 + 64 * (j))
#define XB_XGEN(j)  (2304 + 64 * (j))
#define XB_TOP      3328
#define XB_TOPGEN   3392
#define XCD_BAR_WORDS 3456
#define XB_SPIN_CAP (1u << 18)

__device__ __forceinline__ unsigned xb_ld(unsigned* p)              { return __hip_atomic_load(p, __ATOMIC_RELAXED, __HIP_MEMORY_SCOPE_AGENT); }
__device__ __forceinline__ unsigned xb_add(unsigned* p, unsigned v) { return __hip_atomic_fetch_add(p, v, __ATOMIC_RELAXED, __HIP_MEMORY_SCOPE_AGENT); }
__device__ __forceinline__ unsigned xb_xcc_id() { return (unsigned)__builtin_amdgcn_s_getreg((3 << 11) | 20) & 0xFu; }
#define XB_SPIN(cond, bar) do { unsigned _sp = 0; while (cond) { __builtin_amdgcn_s_sleep(1); \
    if ((++_sp & 255u) == 0u) { if (xb_ld(&(bar)[XB_TMO])) break; if (_sp > XB_SPIN_CAP) { atomicAdd(&(bar)[XB_TMO], 1u); break; } } } } while (0)

struct XcdBarrier {
    unsigned* bar; unsigned x;
    volatile LAS unsigned* st;
};

__device__ __forceinline__ XcdBarrier xcd_barrier_post(unsigned* bar, volatile LAS unsigned* st) {
    XcdBarrier b; b.bar = bar; b.x = xb_xcc_id(); b.st = st;
    if (threadIdx.x == 0) (void)xb_add(&bar[XB_XCNT(b.x)], 1u);
    return b;
}
__device__ __forceinline__ void xcd_barrier_complete(unsigned* bar, unsigned x, unsigned& nloc, unsigned& nx) {
    const unsigned G = gridDim.x * gridDim.y * gridDim.z;
    unsigned sum, cnt, mine, sp = 0u;
    for (;;) {
        sum = 0u; cnt = 0u; mine = 0u;
#pragma unroll
        for (unsigned j = 0; j < 16; ++j) { const unsigned c = xb_ld(&bar[XB_XCNT(j)]); sum += c; cnt += (c > 0u) ? 1u : 0u; mine = (j == x) ? c : mine; }
        if (sum == G) break;
        __builtin_amdgcn_s_sleep(1);
        if ((++sp & 255u) == 0u) { if (xb_ld(&bar[XB_TMO])) break; if (sp > XB_SPIN_CAP) { atomicAdd(&bar[XB_TMO], 1u); break; } }
    }
    nloc = mine > 0u ? mine : 1u; nx = cnt > 0u ? cnt : 1u;
}

__device__ __forceinline__ void xcd_barrier(const XcdBarrier& b) {
    asm volatile("s_waitcnt vmcnt(0)" ::: "memory");
    __syncthreads();
    if (threadIdx.x == 0) {
        unsigned* bar = b.bar;
        __builtin_amdgcn_s_waitcnt(0);
        unsigned nloc = b.st[0], nx = b.st[1];
        if (nloc == 0u) { xcd_barrier_complete(bar, b.x, nloc, nx); b.st[0] = nloc; b.st[1] = nx; }
        const unsigned old = xb_add(&bar[XB_XSUB(b.x)], 1u);
        const unsigned gen = old / nloc;
        if (old + 1u == (gen + 1u) * nloc) {
            __builtin_amdgcn_fence(__ATOMIC_RELEASE, "agent");
            asm volatile("s_waitcnt vmcnt(0)" ::: "memory");
            const unsigned og = xb_add(&bar[XB_TOP], 1u);
            const unsigned tg = og / nx;
            if (og + 1u == (tg + 1u) * nx) xb_add(&bar[XB_TOPGEN], 1u);
            else XB_SPIN(xb_ld(&bar[XB_TOPGEN]) == tg, bar);
            __builtin_amdgcn_fence(__ATOMIC_ACQUIRE, "agent");
            xb_add(&bar[XB_XGEN(b.x)], 1u);
            asm volatile("s_waitcnt vmcnt(0)" ::: "memory");
        } else {
            XB_SPIN(xb_ld(&bar[XB_XGEN(b.x)]) == gen, bar);
            __builtin_amdgcn_fence(__ATOMIC_ACQUIRE, "agent");
            asm volatile("s_waitcnt vmcnt(0)" ::: "memory");
        }
    }
    __syncthreads();
}

__device__ __forceinline__ int get_lane() { int l = (int)__builtin_amdgcn_mbcnt_hi(~0u, __builtin_amdgcn_mbcnt_lo(~0u, 0u)); asm volatile("" : "+v"(l)); return l; }
__global__ void __launch_bounds__(NT, 2) mk_fwd(Args args) {
    extern __shared__ __attribute__((aligned(16))) unsigned char lds_raw[];
    LAS unsigned char* lds = (LAS unsigned char*)lds_raw;
    cg::grid_group grid = cg::this_grid();
    const int tid = threadIdx.x, wave = __builtin_amdgcn_readfirstlane(tid >> 6);

    const int G = gridDim.x, bx = blockIdx.x;
    const int vcu = (G % 8 == 0) ? (bx % 8) * (G / 8) + bx / 8 : bx;
    const int gw = vcu * NW + wave, NGW = G * NW;
    unsigned char* ws = args.ws;
    const float* x = args.in[0]; const float* attn_g = args.in[1]; const float* w_in = args.in[2];
    const float* w_out = args.in[9]; const float* ffn_g = args.in[10]; const float* w_query = args.in[11]; const float* sub_keys = args.in[12];
    bf16_t* WinT = (bf16_t*)(ws + OFF_D);
    bf16_t* WoutT = (bf16_t*)(ws + OFF_C);
    bf16_t* Wqk = (bf16_t*)(ws + OFF_C + 8 * MiB);
    bf16_t* xn = (bf16_t*)(ws + OFF_D + 28 * MiB);
    float* ba = (float*)(ws + OFF_S);
    bf16_t* proj = (bf16_t*)(ws + OFF_B);
    bf16_t* mix = (bf16_t*)args.out;
    unsigned char* pb = ws + OFF_D; float* vecs = (float*)(ws + OFF_S + 2 * MiB);
    float* hbuf = (float*)(ws + OFF_B);
    bf16_t* hn = (bf16_t*)(ws + OFF_D + 128 * MiB);
    float* scores = (float*)(ws + OFF_D);
    unsigned char* U8 = ws + OFF_TAB; unsigned char* V8 = ws + OFF_TAB + 16 * MiB;
    float* inv_su = (float*)(ws + OFF_S + 1 * MiB); float* inv_sv = inv_su + 16384;

    volatile LAS unsigned* xbst = (volatile LAS unsigned*)(lds + LDS_BYTES - 16);
    if (tid < 4) xbst[tid] = 0u;
    __syncthreads();
    XcdBarrier xbar = xcd_barrier_post((unsigned*)args.ws, xbst);
    const int lo = args.ph_lo, hi = args.ph_hi;
#define IN(k) (lo <= (k) && (k) < hi)
#define SYNC_AFTER(k) do { if (IN(k) && (k) + 1 < hi) { if ((k) == 0) grid.sync(); else xcd_barrier(xbar); } } while (0)
    {
        if (IN(0)) {
            const int lane = get_lane();
            LAS float* scr = (LAS float*)(lds + wave * 16384);
            constexpr int I_IN = (DM / 64) * (NPROJ / 32);
            for (int it = gw; it < I_IN; it += NGW) transpose_item(w_in, INW, DM, NPROJ, WinT, scr, it, lane);
            __syncthreads();
            {
                LAS float* wt = (LAS float*)lds;
#pragma unroll
                for (int k = 0; k < 4; ++k) { const int d = tid + 512 * k; const float* wr = w_in + (size_t)d * INW + NPROJ;
#pragma unroll
                    for (int q4 = 0; q4 < 4; ++q4) { const f32x4 w4 = *(const f32x4*)(wr + 4 * q4);
                        wt[(4 * q4 + 0) * 2048 + d] = w4.x; wt[(4 * q4 + 1) * 2048 + d] = w4.y; wt[(4 * q4 + 2) * 2048 + d] = w4.z; wt[(4 * q4 + 3) * 2048 + d] = w4.w; } }
            }
            __syncthreads();
            for (int m = gw; m < T; m += NGW) norm_row<true>(x + (size_t)m * DM, attn_g, (const LAS float*)lds, xn + (size_t)m * DM, ba + (size_t)m * 16, lane);
        }
        SYNC_AFTER(0);
        if (IN(1)) {
            pg8::Gemm g{xn, WinT, T, NPROJ, DM}; pg8::StaticOrder S; S.init(T, NPROJ, G, bx);
            EpiProj E{proj, NPROJ};
            pg8::gemm_phase<EpiProj, pg8::StaticOrder, true, true>(lds, g, S, E);
        }
        SYNC_AFTER(1);
        if (IN(2)) {
            for (int it = bx; it < 2048; it += G) { int tt = threadIdx.x; asm volatile("" : "+v"(tt)); hgrn_prep_item(it, proj, args.in[3], pb, vecs, lds, tt); }
            for (int it = bx; it < 1024; it += G) { int tt = threadIdx.x; asm volatile("" : "+v"(tt)); gdn_prep_item(it, proj, ba, args.in[5], args.in[6], args.in[7], pb, vecs, lds, tt); }
        }
        SYNC_AFTER(2);
        if (IN(3)) {
            const int lane = get_lane();
            unsigned* ctl = (unsigned*)args.ws;
            if (bx < 32) scan_block(bx, proj, pb, vecs, args.in[4], args.in[8], mix, ctl + PROG_WORD, lds, tid);
            else if (G > 32) {
                int fb, FB;
                fb = bx - 32; FB = G - 32;
                const int fw = fb * NW + wave, FW = FB * NW;
                for (int it = fb; it < 512; it += FB) wqk_item(w_query, sub_keys, Wqk, (LAS float*)lds, it, tid);
                LAS float* scr = (LAS float*)(lds + wave * 16384);
                constexpr int I_OUT = (DM / 64) * (DM / 32);
                for (int it = fw; it < I_OUT; it += FW) transpose_item(w_out, DM, DM, DM, WoutT, scr, it, lane);
                for (int e = fw; e < 32768; e += FW) { const bool isv = e >= 16384; const int r = e & 16383;
                    table_row((isv ? args.in[14] : args.in[13]) + (size_t)r * DM, (unsigned*)((isv ? V8 : U8) + (size_t)r * 1024), (isv ? inv_sv : inv_su) + r, lane); }
            }
        }
        SYNC_AFTER(3);
        if (IN(4)) {
            pg8::Gemm g{mix, WoutT, T, DM, DM}; pg8::StaticOrder S; S.init(T, DM, G, bx);
            EpiResF32 E{x, hbuf, DM};
            pg8::gemm_phase<EpiResF32, pg8::StaticOrder, true, true>(lds, g, S, E);
        }
        SYNC_AFTER(4);
        if (IN(5)) {
            const int lane = get_lane();
            for (int m = gw; m < T; m += NGW) norm_row<false>(hbuf + (size_t)m * DM, ffn_g, (const LAS float*)lds, hn + (size_t)m * DM, nullptr, lane);
        }
        SYNC_AFTER(5);
        if (IN(6)) {
            pg8::Gemm g{hn, Wqk, T, DM, DM}; pg8::StaticOrder S; S.init(T, DM, G, bx);
            EpiResF32 E{nullptr, scores, DM};
            pg8::gemm_phase<EpiResF32, pg8::StaticOrder, true, true>(lds, g, S, E);
        }
        SYNC_AFTER(6);
        if (IN(7)) {
            const int lane = get_lane();
            LAS int* se = (LAS int*)(lds + wave * 4096); LAS float* sa = (LAS float*)(lds + wave * 4096 + 512); LAS float* sb = (LAS float*)(lds + wave * 4096 + 1024);
            for (int t = gw; t < T; t += NGW) { const int ln = get_lane(); peer_token(t, scores, hn, hbuf, U8, V8, inv_su, inv_sv, args.in[15], args.out, se, sa, sb, ln); }
        }
    }
}
}

extern "C" void kernel_launch(void* const* d_in, const int* in_sizes, int n_in, void* d_out, int out_size, void* d_ws, size_t ws_size, hipStream_t stream) {
    static int grid = 0;
    if (grid == 0) {
        int dev = 0, cus = 0, per_cu = 0;
        (void)hipGetDevice(&dev);
        (void)hipDeviceGetAttribute(&cus, hipDeviceAttributeMultiprocessorCount, dev);
        (void)hipFuncSetAttribute((const void*)mk::mk_fwd, hipFuncAttributeMaxDynamicSharedMemorySize, mk::LDS_BYTES);
        (void)hipOccupancyMaxActiveBlocksPerMultiprocessor(&per_cu, (const void*)mk::mk_fwd, mk::NT, mk::LDS_BYTES);
        if (per_cu < 1) { fprintf(stderr, "occupancy query says %d\n", per_cu); per_cu = 1; }
        grid = cus;
    }
    unsigned char* ws = (unsigned char*)d_ws;
    (void)hipMemsetAsync(d_ws, 0, 16384, stream);
    mk::Args a{};
    for (int i = 0; i < 16; ++i) a.in[i] = (const float*)d_in[i];
    a.out = (float*)d_out; a.ws = ws;
    {
        a.ph_lo = 0; a.ph_hi = 8;
        void* kargs[] = {&a};
        hipError_t e = hipLaunchCooperativeKernel((const void*)mk::mk_fwd, dim3(grid), dim3(mk::NT), kargs, mk::LDS_BYTES, stream);
        if (e != hipSuccess) fprintf(stderr, "coop launch failed: %s\n", hipGetErrorString(e));
    }
}
```

```cpp
#include <hip/hip_runtime.h>
#include <hip/hip_cooperative_groups.h>
#include <cstdio>
namespace cg = cooperative_groups;
#include <stdint.h>

typedef unsigned short bf16_t;
typedef float f32x4 __attribute__((ext_vector_type(4)));

constexpr int T = 16384, SEQ = 8192, DM = 2048, INW = 7184, NPROJ = 7168;
constexpr float EPS = 1e-6f;
constexpr size_t MiB = 1u << 20;
constexpr size_t OFF_TAB = 1 * MiB;
constexpr size_t OFF_B = 65 * MiB;
constexpr size_t OFF_C = 289 * MiB;
constexpr size_t OFF_D = 305 * MiB;
constexpr size_t OFF_S = 500 * MiB;
constexpr int C_AQ = 0, C_AF = 1024, C_AI = 2048, C_AG = 3072, C_BQ = 4096, C_BK = 4608, C_BV = 5120, C_BZ = 6144;

__device__ __forceinline__ float bf2f(bf16_t v) { return __uint_as_float(((unsigned)v) << 16); }
typedef float f32x2_t __attribute__((ext_vector_type(2)));
typedef __bf16 bf16x2_t __attribute__((ext_vector_type(2)));
__device__ __forceinline__ unsigned cvt_pk2(float lo, float hi) { f32x2_t v = {lo, hi}; bf16x2_t b = __builtin_convertvector(v, bf16x2_t); return __builtin_bit_cast(unsigned, b); }
__device__ __forceinline__ bf16_t f2bf(float f) { return (bf16_t)(cvt_pk2(f, 0.f) & 0xffffu); }
__device__ __forceinline__ float sigmoidf_(float x) { return 1.f / (1.f + __expf(-x)); }
__device__ __forceinline__ float siluf_(float x) { return x / (1.f + __expf(-x)); }
__device__ __forceinline__ float wave_sum(float v) {
#pragma unroll
    for (int o = 1; o < 64; o <<= 1) v += __shfl_xor(v, o);
    return v;
}
__device__ __forceinline__ float block_sum(float v, float* sh) {
    v = wave_sum(v);
    const int w = threadIdx.x >> 6, nw = blockDim.x >> 6;
    __syncthreads();
    if ((threadIdx.x & 63) == 0) sh[w] = v;
    __syncthreads();
    float r = 0.f;
    for (int i = 0; i < nw; ++i) r += sh[i];
    return r;
}

__device__ __forceinline__ float gelu_erf(float x) { return 0.5f * x * (1.f + erff(x * 0.70710678118654752f)); }
namespace pg8 {
#define PG8_LAS __attribute__((address_space(3)))
typedef unsigned short bf16_t;
typedef short bf16x8 __attribute__((ext_vector_type(8)));
typedef float f32x4 __attribute__((ext_vector_type(4)));
typedef unsigned u32x4 __attribute__((ext_vector_type(4)));
constexpr int BM = 256, BK = 64, HALF = 128, HTB = HALF * BK * 2  , STAGE_BYTES = 8 * HTB, NXCD = 8, WGM = 8;

__host__ __device__ __forceinline__ int lds_byte(int r, int c) { const int st = (r >> 4) * 2 + (c >> 5), rr = r & 15, cc = c & 31, ob = rr * 64 + cc * 2; return st * 1024 + (ob ^ (((ob >> 9) & 1) << 5)); }
__host__ __device__ __forceinline__ void stage_rc(int b, int& R, int& C) { const int st = b / 1024, sb = b % 1024, swz = sb ^ (((sb >> 9) & 1) << 5); R = (st >> 1) * 16 + swz / 64; C = (st & 1) * 32 + (swz % 64) / 2; }
__host__ __device__ __forceinline__ int perm32(int rho) { const int n = rho >> 4, i = rho & 15; return 8 * (i >> 2) + 4 * n + (i & 3); }

struct Unit { int pm, pn; };
struct Gemm { const bf16_t* A; const bf16_t* Bt; int M, N, K; };

struct StaticOrder {
    int nM, nN, nwg, G, c;
    __host__ __device__ void init(int M, int N, int G_, int c_) { nM = M / BM; nN = N / BM; nwg = nM * nN; G = G_; c = c_; }
    __host__ __device__ bool next(int i, Unit& u) const {
        const long L = (long)i * G + c; if (L >= nwg) return false;
        int wgid = (int)L; { const int q = nwg / NXCD, r = nwg % NXCD, xcd = wgid % NXCD, off = wgid / NXCD; wgid = (xcd < r ? xcd * (q + 1) : r * (q + 1) + (xcd - r) * q) + off; }
        const int nig = WGM * nN, gid = wgid / nig, fm = gid * WGM, gsz = (nM - fm) < WGM ? (nM - fm) : WGM;
        u.pm = fm + ((wgid % nig) % gsz); u.pn = (wgid % nig) / gsz; return true;
    }
    __device__ __forceinline__ void a_ready(const Unit&) const {}
    __device__ __forceinline__ void done(const Unit&) const {}
};

__device__ __forceinline__ unsigned cvt_pk_bf16(float lo, float hi) { unsigned r; asm volatile("v_cvt_pk_bf16_f32 %0, %1, %2" : "=v"(r) : "v"(lo), "v"(hi)); return r; }
typedef float f32x2 __attribute__((ext_vector_type(2)));
__device__ __forceinline__ f32x2 gelu_pk(f32x2 v) {
    const f32x2 av = __builtin_elementwise_abs(v), d = av * 0.2316418882f + 1.0f;
    f32x2 t; t.x = __builtin_amdgcn_rcpf(d.x); t.y = __builtin_amdgcn_rcpf(d.y);
    f32x2 q = t * 0.5307027145f + (-0.7265760135f); q = q * t + 0.7107068705f; q = q * t + (-0.142248368f); q = q * t + 0.127414796f; q = q * t;
    const f32x2 s = (v * v) * (-0.72134752044f);
    f32x2 e; e.x = __builtin_amdgcn_exp2f(s.x); e.y = __builtin_amdgcn_exp2f(s.y);
    const f32x2 m = v * (q * e), r = v - m;
    f32x2 o; o.x = v.x < 0.f ? m.x : r.x; o.y = v.y < 0.f ? m.y : r.y; return o;
}

template <int ACT  > struct EpiBf16 {
    static constexpr bool PERM = true, AFTER_DRAIN = false; static_assert(ACT == 0 || ACT == 1, "EpiBf16: ACT is 0 (none) or 1 (gelu_pk)");
    bf16_t* O; int ldc; const float* bias; int split_cols; size_t split_stride; float scale0;
    __device__ __forceinline__ void operator()(const f32x4 (&acc)[2][2][4][2], const Unit& u, int wr, int wc, int fr, int fq) const {
        const int row0 = u.pm * BM + wr * 64 + fr; int colt = u.pn * BM; bf16_t* base = O;
        float sc = 1.f; if (split_cols) { const int t = colt / split_cols; base += (size_t)t * split_stride; colt -= t * split_cols; if (t == 0) sc = scale0; }
        const int col0 = colt + wc * 32 + 8 * fq, bcol0 = u.pn * BM + wc * 32 + 8 * fq;
        f32x4 bv[2][2];
#pragma unroll
        for (int bj = 0; bj < 2; ++bj)
#pragma unroll
            for (int n = 0; n < 2; ++n) bv[bj][n] = bias ? *(const f32x4*)(bias + bcol0 + bj * HALF + 4 * n) : (f32x4){0.f, 0.f, 0.f, 0.f};
#pragma unroll
        for (int ai = 0; ai < 2; ++ai)
#pragma unroll
            for (int m = 0; m < 4; ++m) { bf16_t* rowp = base + (size_t)(row0 + ai * HALF + m * 16) * ldc + col0;
#pragma unroll
                for (int bj = 0; bj < 2; ++bj) { f32x4 v0 = acc[ai][bj][m][0] + bv[bj][0], v1 = acc[ai][bj][m][1] + bv[bj][1];
                    if (ACT == 1) { f32x2 a = gelu_pk((f32x2){v0[0], v0[1]}), b = gelu_pk((f32x2){v0[2], v0[3]}), c = gelu_pk((f32x2){v1[0], v1[1]}), d = gelu_pk((f32x2){v1[2], v1[3]});
                        v0 = (f32x4){a.x, a.y, b.x, b.y}; v1 = (f32x4){c.x, c.y, d.x, d.y}; }
                    v0 = v0 * sc; v1 = v1 * sc; u32x4 w; w.x = cvt_pk_bf16(v0[0], v0[1]); w.y = cvt_pk_bf16(v0[2], v0[3]); w.z = cvt_pk_bf16(v1[0], v1[1]); w.w = cvt_pk_bf16(v1[2], v1[3]);
                    *(u32x4*)(rowp + bj * HALF) = w; } }
    }
};
template <class Epi, class Sched, bool ALIGN_EPI = false, bool SP2 = false>
__device__ __forceinline__ void gemm_phase(PG8_LAS unsigned char* lds, const Gemm g, const Sched& S, const Epi& E) {
    const int tid = threadIdx.x, wid = __builtin_amdgcn_readfirstlane(tid >> 6), lane = tid & 63, wr = wid >> 2, wc = wid & 3, fr = lane & 15, fq = lane >> 4;
    const int K = g.K, nt = K / BK;
    unsigned voffA[2], voffB[2];
#pragma unroll
    for (int i = 0; i < 2; ++i) { int R, C; stage_rc(tid * 16 + i * 8192, R, C); const int Rb = Epi::PERM ? ((R & ~31) + perm32(R & 31)) : R;
        voffA[i] = (unsigned)(R * K + C) * 2u; voffB[i] = (unsigned)(Rb * K + C) * 2u; }
    const size_t kstep = (size_t)(BK * 2);
    const size_t hstep = (size_t)HALF * K * 2;
    const size_t tstep = 2 * hstep;
    const unsigned ldsw = (unsigned)wid * 1024u;
    const int aoff = lds_byte(wr * 64 + fr, fq * 8), boff = lds_byte(wc * 32 + fr, fq * 8);
#define PG8_SA(b, h) (((b) * 2 + (h)) * HTB)
#define PG8_SB(b, h) ((4 + (b) * 2 + (h)) * HTB)
#define PG8_STAGE(bufoff, gbase, voff) do { _Pragma("unroll") for (int _i = 0; _i < 2; ++_i) \
        __builtin_amdgcn_global_load_lds((const unsigned*)((const char*)(gbase) + (voff)[_i]), (PG8_LAS unsigned*)(lds + (bufoff) + ldsw + _i * 8192), 16, 0, 0); } while (0)
#define PG8_LDA(dst, b, h) do { _Pragma("unroll") for (int m = 0; m < 4; ++m) _Pragma("unroll") for (int k = 0; k < 2; ++k) dst[m][k] = *(const PG8_LAS bf16x8*)(lds + PG8_SA(b, h) + aoff + m * 2048 + k * 1024); } while (0)
#define PG8_LDB(dst, b, h) do { _Pragma("unroll") for (int n = 0; n < 2; ++n) _Pragma("unroll") for (int k = 0; k < 2; ++k) dst[n][k] = *(const PG8_LAS bf16x8*)(lds + PG8_SB(b, h) + boff + n * 2048 + k * 1024); } while (0)
#define PG8_MMA(ai, bj, At, Bt) do { __builtin_amdgcn_s_setprio(1); _Pragma("unroll") for (int m = 0; m < 4; ++m) _Pragma("unroll") for (int n = 0; n < 2; ++n) _Pragma("unroll") for (int k = 0; k < 2; ++k) \
        acc[ai][bj][m][n] = __builtin_amdgcn_mfma_f32_16x16x32_bf16(Bt[n][k], At[m][k], acc[ai][bj][m][n], 0, 0, 0); __builtin_amdgcn_s_setprio(0); } while (0)
#define PG8_WAIT_V(n) asm volatile("s_waitcnt vmcnt(" #n ")" ::: "memory")
#define PG8_WAIT_L(n) asm volatile("s_waitcnt lgkmcnt(" #n ")" ::: "memory")
#define PG8_BAR __builtin_amdgcn_s_barrier()
#define PG8_SCHED __builtin_amdgcn_sched_barrier(0)
    Unit cur, nxt; int ui = 0;
    if (!S.next(0, cur)) return;
    f32x4 acc[2][2][4][2];
#pragma unroll
    for (int a = 0; a < 2; ++a)
#pragma unroll
        for (int b = 0; b < 2; ++b)
#pragma unroll
            for (int m = 0; m < 4; ++m)
#pragma unroll
                for (int n = 0; n < 2; ++n) acc[a][b][m][n] = (f32x4){0.f, 0.f, 0.f, 0.f};
    bf16x8 At[4][2], B0[2][2], B1[2][2];
    const char* cA = (const char*)g.A + (size_t)cur.pm * tstep; const char* cB = (const char*)g.Bt + (size_t)cur.pn * tstep;
    S.a_ready(cur);
    if constexpr (SP2) {
        PG8_STAGE(PG8_SB(0, 0), cB, voffB); PG8_STAGE(PG8_SB(0, 1), cB + hstep, voffB); PG8_STAGE(PG8_SA(0, 0), cA, voffA); PG8_STAGE(PG8_SA(0, 1), cA + hstep, voffA);
        if (wr == 1) PG8_BAR;
        PG8_WAIT_V(2); PG8_BAR;
        PG8_STAGE(PG8_SB(1, 0), cB + kstep, voffB); PG8_STAGE(PG8_SA(1, 0), cA + kstep, voffA); PG8_STAGE(PG8_SB(1, 1), cB + hstep + kstep, voffB);
        PG8_WAIT_V(6); PG8_BAR;
    } else {
        PG8_STAGE(PG8_SB(0, 0), cB, voffB); PG8_STAGE(PG8_SA(0, 0), cA, voffA); PG8_STAGE(PG8_SB(0, 1), cB + hstep, voffB); PG8_STAGE(PG8_SA(0, 1), cA + hstep, voffA);
        if (wr == 1) PG8_BAR;
        PG8_WAIT_V(4); PG8_BAR;
        PG8_STAGE(PG8_SB(1, 0), cB + kstep, voffB); PG8_STAGE(PG8_SA(1, 0), cA + kstep, voffA); PG8_STAGE(PG8_SB(1, 1), cB + hstep + kstep, voffB);
        PG8_WAIT_V(6); PG8_BAR;
    }
    for (;;) {
        const bool has_next = S.next(ui + 1, nxt);
        const char* nA = has_next ? (const char*)g.A + (size_t)nxt.pm * tstep : cA; const char* nB = has_next ? (const char*)g.Bt + (size_t)nxt.pn * tstep : cB;
        for (int t = 0; t < nt; t += 2) {
            const bool last = (t == nt - 2);
            const char* a1 = cA + (size_t)(t + 1) * kstep;
            const char* a2 = last ? nA : cA + (size_t)(t + 2) * kstep; const char* b2 = last ? nB : cB + (size_t)(t + 2) * kstep;
            const char* a3 = a2 + kstep; const char* b3 = b2 + kstep;
            if (last && has_next) S.a_ready(nxt);
            if constexpr (SP2) {
            PG8_LDB(B0, 0, 0); PG8_LDB(B1, 0, 1); PG8_SCHED; PG8_LDA(At, 0, 0); PG8_STAGE(PG8_SA(1, 1), a1 + hstep, voffA);
            PG8_WAIT_V(8); PG8_WAIT_L(0); PG8_BAR; PG8_MMA(0, 0, At, B0); PG8_MMA(0, 1, At, B1); PG8_BAR; PG8_SCHED;
            PG8_LDA(At, 0, 1); PG8_STAGE(PG8_SB(0, 0), b2, voffB); PG8_STAGE(PG8_SB(0, 1), b2 + hstep, voffB); PG8_STAGE(PG8_SA(0, 0), a2, voffA);
            PG8_WAIT_V(8); PG8_WAIT_L(0); PG8_BAR; PG8_MMA(1, 0, At, B0); PG8_MMA(1, 1, At, B1); PG8_BAR; PG8_SCHED;
            PG8_LDB(B0, 1, 0); PG8_LDB(B1, 1, 1); PG8_SCHED; PG8_LDA(At, 1, 0); PG8_STAGE(PG8_SA(0, 1), a2 + hstep, voffA);
            PG8_WAIT_V(8); PG8_WAIT_L(0); PG8_BAR; PG8_MMA(0, 0, At, B0); PG8_MMA(0, 1, At, B1); PG8_BAR; PG8_SCHED;
            PG8_LDA(At, 1, 1); PG8_STAGE(PG8_SB(1, 0), b3, voffB); PG8_STAGE(PG8_SB(1, 1), b3 + hstep, voffB); PG8_STAGE(PG8_SA(1, 0), a3, voffA);
            PG8_WAIT_V(8); PG8_WAIT_L(0); PG8_BAR; PG8_MMA(1, 0, At, B0); PG8_MMA(1, 1, At, B1); PG8_BAR; PG8_SCHED;
            } else {
            PG8_LDB(B0, 0, 0); PG8_SCHED; PG8_LDA(At, 0, 0); PG8_STAGE(PG8_SA(1, 1), a1 + hstep, voffA);
            PG8_WAIT_L(8); PG8_BAR; PG8_WAIT_L(0); PG8_MMA(0, 0, At, B0); PG8_BAR; PG8_SCHED;
            PG8_LDB(B1, 0, 1); PG8_STAGE(PG8_SB(0, 0), b2, voffB);
            PG8_BAR; PG8_WAIT_L(0); PG8_MMA(0, 1, At, B1); PG8_BAR;
            PG8_LDA(At, 0, 1); PG8_STAGE(PG8_SA(0, 0), a2, voffA);
            PG8_BAR; PG8_WAIT_L(0); PG8_MMA(1, 0, At, B0); PG8_BAR; PG8_SCHED;
            PG8_STAGE(PG8_SB(0, 1), b2 + hstep, voffB);
            PG8_WAIT_V(6); PG8_BAR; PG8_MMA(1, 1, At, B1); PG8_BAR;
            PG8_LDB(B0, 1, 0); PG8_SCHED; PG8_LDA(At, 1, 0); PG8_STAGE(PG8_SA(0, 1), a2 + hstep, voffA);
            PG8_WAIT_L(8); PG8_BAR; PG8_WAIT_L(0); PG8_MMA(0, 0, At, B0); PG8_BAR; PG8_SCHED;
            PG8_LDB(B1, 1, 1); PG8_STAGE(PG8_SB(1, 0), b3, voffB);
            PG8_BAR; PG8_WAIT_L(0); PG8_MMA(0, 1, At, B1); PG8_BAR;
            PG8_LDA(At, 1, 1); PG8_STAGE(PG8_SA(1, 0), a3, voffA);
            PG8_BAR; PG8_WAIT_L(0); PG8_MMA(1, 0, At, B0); PG8_BAR; PG8_SCHED;
            PG8_STAGE(PG8_SB(1, 1), b3 + hstep, voffB);
            PG8_WAIT_V(6); PG8_BAR; PG8_MMA(1, 1, At, B1); PG8_BAR;
            }
        }
        if constexpr (ALIGN_EPI) { if (wr == 0) PG8_BAR; }
        if constexpr (!Epi::AFTER_DRAIN) { E(acc, cur, wr, wc, fr, fq); S.done(cur); }
        if (!has_next) break;
#pragma unroll
        for (int a = 0; a < 2; ++a)
#pragma unroll
            for (int b = 0; b < 2; ++b)
#pragma unroll
                for (int m = 0; m < 4; ++m)
#pragma unroll
                    for (int n = 0; n < 2; ++n) acc[a][b][m][n] = (f32x4){0.f, 0.f, 0.f, 0.f};
        cur = nxt; cA = nA; cB = nB; ++ui;
        if constexpr (ALIGN_EPI) { if (wr == 1) PG8_BAR; }
    }
    PG8_WAIT_V(0);
    if constexpr (!ALIGN_EPI) { if (wr == 0) PG8_BAR; }
    PG8_BAR;
    if constexpr (Epi::AFTER_DRAIN) { E.fused(acc, cur, wr, wc, fr, fq, lds, wid, lane); S.done(cur); }
#undef PG8_SA
#undef PG8_SB
#undef PG8_STAGE
#undef PG8_LDA
#undef PG8_LDB
#undef PG8_MMA
#undef PG8_WAIT_V
#undef PG8_WAIT_L
#undef PG8_BAR
#undef PG8_SCHED
}
}

namespace mk {
#define LAS __attribute__((address_space(3)))
#define GAS __attribute__((address_space(1)))
typedef unsigned v4u __attribute__((ext_vector_type(4)));
typedef unsigned v2u __attribute__((ext_vector_type(2)));
constexpr int NW = 8, NT = 512, LDS_BYTES = 163840, RING_BYTES = 131072;
#define LDS_WAIT() asm volatile("s_waitcnt lgkmcnt(0)" ::: "memory")
#define DPP_ROR_ADD(t, n) ((t) + __uint_as_float(__builtin_amdgcn_update_dpp(0u, __float_as_uint(t), 0x120 + (n), 0xf, 0xf, false)))
struct Args { const float* in[16]; float* out; unsigned char* ws; int ph_lo, ph_hi; };
__device__ __forceinline__ unsigned pk2(float lo, float hi) { return cvt_pk2(lo, hi); }

__device__ __forceinline__ void transpose_item(const float* W, int ld, int K, int ncols, bf16_t* WT, LAS float* scr, int item, int lane) {
    const int nblk = ncols / 32, kb = item / nblk, nb = item % nblk, k0 = 64 * kb, n0 = 32 * nb;
#pragma unroll 8
    for (int i = 0; i < 32; ++i) { const int kk = 2 * i + (lane >> 5); scr[kk * 33 + (lane & 31)] = W[(size_t)(k0 + kk) * ld + n0 + (lane & 31)]; }
    LDS_WAIT(); asm volatile("" ::: "memory");
    const int c = lane & 7;
#pragma unroll
    for (int j = 0; j < 4; ++j) { const int n = (lane >> 3) + 8 * j; const LAS float* s = scr + (8 * c) * 33 + n;
        v4u o; o.x = pk2(s[0 * 33], s[1 * 33]); o.y = pk2(s[2 * 33], s[3 * 33]); o.z = pk2(s[4 * 33], s[5 * 33]); o.w = pk2(s[6 * 33], s[7 * 33]);
        *(v4u*)(WT + (size_t)(n0 + n) * K + k0 + 8 * c) = o; }
    LDS_WAIT(); asm volatile("" ::: "memory");
}
template <bool WITH_BA>
__device__ __forceinline__ void norm_row(const float* xrow, const float* g, const LAS float* wt  , bf16_t* orow, float* barow, int lane) {
    f32x4 v[8]; float ss = 0.f;
#pragma unroll
    for (int j = 0; j < 8; ++j) { v[j] = ((const f32x4*)xrow)[64 * j + lane]; ss += (v[j].x * v[j].x + v[j].y * v[j].y) + (v[j].z * v[j].z + v[j].w * v[j].w); }
    ss = wave_sum(ss);
    const float rstd = rsqrtf(ss * (1.f / DM) + EPS);
    float acc[16];
#pragma unroll
    for (int c = 0; c < 16; ++c) acc[c] = 0.f;
#pragma unroll
    for (int j = 0; j < 8; ++j) {
        const f32x4 gg = ((const f32x4*)g)[64 * j + lane];
        const f32x4 y = v[j] * rstd * gg;
        v2u o; o.x = pk2(y.x, y.y); o.y = pk2(y.z, y.w);
        ((v2u*)orow)[64 * j + lane] = o;
        if (WITH_BA) {
#pragma unroll
            for (int c = 0; c < 16; ++c) { const f32x4 w4 = *(const LAS f32x4*)(wt + c * 2048 + 4 * (64 * j + lane));
                acc[c] += (y.x * w4.x + y.y * w4.y) + (y.z * w4.z + y.w * w4.w); }
            __builtin_amdgcn_sched_barrier(0);
        }
    }
    if (WITH_BA) {
        float q8[8], t4[4];
#pragma unroll
        for (int r = 0; r < 8; ++r) { auto sw = __builtin_amdgcn_permlane32_swap(__float_as_uint(acc[r]), __float_as_uint(acc[r + 8]), false, false); q8[r] = __uint_as_float(sw[0]) + __uint_as_float(sw[1]); }
#pragma unroll
        for (int r = 0; r < 4; ++r) { auto sw = __builtin_amdgcn_permlane16_swap(__float_as_uint(q8[r]), __float_as_uint(q8[r + 4]), false, false); t4[r] = __uint_as_float(sw[0]) + __uint_as_float(sw[1]); }
#pragma unroll
        for (int r = 0; r < 4; ++r) { float tv = t4[r]; tv = DPP_ROR_ADD(tv, 8); tv = DPP_ROR_ADD(tv, 4); tv = DPP_ROR_ADD(tv, 2); tv = DPP_ROR_ADD(tv, 1); t4[r] = tv; }
        if ((lane & 15) == 0) { const int gq = lane >> 4;
#pragma unroll
            for (int r = 0; r < 4; ++r) barow[r + 4 * gq] = t4[r]; }
    }
}
__device__ __forceinline__ void wqk_item(const float* Wq, const float* SK, bf16_t* Wqk, LAS float* lds, int item, int tid) {
    const int cbk = item >> 5, d0 = (item & 31) * 64, cb = cbk * 128, h = cbk >> 1, half = cbk & 1;
    LAS float* At = lds; LAS float* Bt = lds + 128 * 68;
    const float* skb = SK + ((size_t)(half * 8 + h) * 128) * 128;
#pragma unroll
    for (int i = 0; i < 4; ++i) { const int idx = tid + 512 * i, d = idx >> 5, k4 = idx & 31;
        const f32x4 w = *(const f32x4*)(Wq + (size_t)(d0 + d) * DM + cb + 4 * k4);
        At[(4 * k4 + 0) * 68 + d] = w.x; At[(4 * k4 + 1) * 68 + d] = w.y; At[(4 * k4 + 2) * 68 + d] = w.z; At[(4 * k4 + 3) * 68 + d] = w.w; }
#pragma unroll
    for (int i = 0; i < 8; ++i) { const int idx = tid + 512 * i, n = idx >> 5, k4 = idx & 31;
        const f32x4 w = *(const f32x4*)(skb + (size_t)n * 128 + 4 * k4);
        Bt[(4 * k4 + 0) * 132 + n] = w.x; Bt[(4 * k4 + 1) * 132 + n] = w.y; Bt[(4 * k4 + 2) * 132 + n] = w.z; Bt[(4 * k4 + 3) * 132 + n] = w.w; }
    __syncthreads();
    const int dy = tid >> 5, nx = tid & 31;
    float acc[4][4];
#pragma unroll
    for (int i = 0; i < 4; ++i)
#pragma unroll
        for (int j = 0; j < 4; ++j) acc[i][j] = 0.f;
#pragma unroll 4
    for (int kk = 0; kk < 128; ++kk) {
        const f32x4 a = *(const LAS f32x4*)(At + kk * 68 + 4 * dy), b = *(const LAS f32x4*)(Bt + kk * 132 + 4 * nx);
        acc[0][0] += a.x * b.x; acc[0][1] += a.x * b.y; acc[0][2] += a.x * b.z; acc[0][3] += a.x * b.w;
        acc[1][0] += a.y * b.x; acc[1][1] += a.y * b.y; acc[1][2] += a.y * b.z; acc[1][3] += a.y * b.w;
        acc[2][0] += a.z * b.x; acc[2][1] += a.z * b.y; acc[2][2] += a.z * b.z; acc[2][3] += a.z * b.w;
        acc[3][0] += a.w * b.x; acc[3][1] += a.w * b.y; acc[3][2] += a.w * b.z; acc[3][3] += a.w * b.w;
    }
#pragma unroll
    for (int j = 0; j < 4; ++j) { v2u o; o.x = pk2(acc[0][j], acc[1][j]); o.y = pk2(acc[2][j], acc[3][j]);
        *(v2u*)(Wqk + (size_t)(cb + 4 * nx + j) * DM + d0 + 4 * dy) = o; }
    __syncthreads();
}

typedef float f32x2 __attribute__((ext_vector_type(2)));
__device__ __forceinline__ int fp4_idx_of(float v) { return (v < 1.75f) ? (int)(v * 2.f + 0.25f) : (v < 2.5f ? 4 : (v < 3.5f ? 5 : (v < 5.f ? 6 : 7))); }
__device__ __forceinline__ void fp4_calibrate(int (&nib)[8]) {
    const unsigned T = 0x76543210u;
    const f32x2 a = __builtin_amdgcn_cvt_scalef32_pk_f32_fp4(T, 1.0f, 0), b = __builtin_amdgcn_cvt_scalef32_pk_f32_fp4(T, 1.0f, 1);
    const f32x2 c = __builtin_amdgcn_cvt_scalef32_pk_f32_fp4(T, 1.0f, 2), d = __builtin_amdgcn_cvt_scalef32_pk_f32_fp4(T, 1.0f, 3);
    nib[0] = fp4_idx_of(a.x); nib[1] = fp4_idx_of(a.y); nib[2] = fp4_idx_of(b.x); nib[3] = fp4_idx_of(b.y);
    nib[4] = fp4_idx_of(c.x); nib[5] = fp4_idx_of(c.y); nib[6] = fp4_idx_of(d.x); nib[7] = fp4_idx_of(d.y);
}
__device__ __forceinline__ void table_row(const float* src, unsigned* dst, float* inv_scale, int lane) {
    int nib[8]; fp4_calibrate(nib);
    f32x4 v[8]; float mx = 0.f;
#pragma unroll
    for (int j = 0; j < 8; ++j) { v[j] = ((const f32x4*)src)[8 * lane + j];
        mx = fmaxf(mx, fmaxf(fmaxf(fabsf(v[j].x), fabsf(v[j].y)), fmaxf(fabsf(v[j].z), fabsf(v[j].w)))); }
#pragma unroll
    for (int o = 1; o < 64; o <<= 1) mx = fmaxf(mx, __shfl_xor(mx, o));
    const float sc = mx > 0.f ? mx * (0.85f / 6.f) : 1.f, isc = 1.f / sc;
    unsigned wd[4];
#pragma unroll
    for (int w = 0; w < 4; ++w) {
        unsigned acc = 0u;
#pragma unroll
        for (int e = 0; e < 8; ++e) {
            const f32x4 q = v[2 * w + (e >> 2)]; const float xe = ((e & 3) == 0) ? q.x : ((e & 3) == 1) ? q.y : ((e & 3) == 2) ? q.z : q.w;
            const float yv = fabsf(xe) * isc;
            unsigned code = (yv > 0.25f) + (yv > 0.75f) + (yv > 1.25f) + (yv > 1.75f) + (yv > 2.5f) + (yv > 3.5f) + (yv > 5.f);
            code |= (xe < 0.f) ? 8u : 0u;
            acc |= code << (4 * nib[e]);
        }
        wd[w] = acc;
    }
    v4u o; o.x = wd[0]; o.y = wd[1]; o.z = wd[2]; o.w = wd[3];
    ((v4u*)dst)[lane] = o;
    if (lane == 0) *inv_scale = sc;
}
#ifndef PEER_FAST_REDUCE
#define PEER_FAST_REDUCE 1
#endif
__device__ __forceinline__ float dpp_ror_add(float t, int) { return t; }
#define FP4_BYTE(d, j) __builtin_amdgcn_cvt_scalef32_pk_f32_fp4((d), 1.0f, (j))
__device__ __forceinline__ float dot_row(const v4u& a, const float (&xv)[32]) {
    f32x2 p2 = {0.f, 0.f};
#pragma unroll
    for (int w = 0; w < 4; ++w) { const unsigned d = (w == 0) ? a.x : (w == 1) ? a.y : (w == 2) ? a.z : a.w;
        const f32x2 f0 = FP4_BYTE(d, 0), f1 = FP4_BYTE(d, 1), f2 = FP4_BYTE(d, 2), f3 = FP4_BYTE(d, 3);
        p2 = __builtin_elementwise_fma(f0, (f32x2){xv[8 * w], xv[8 * w + 1]}, p2); p2 = __builtin_elementwise_fma(f1, (f32x2){xv[8 * w + 2], xv[8 * w + 3]}, p2);
        p2 = __builtin_elementwise_fma(f2, (f32x2){xv[8 * w + 4], xv[8 * w + 5]}, p2); p2 = __builtin_elementwise_fma(f3, (f32x2){xv[8 * w + 6], xv[8 * w + 7]}, p2); }
    return p2.x + p2.y;
}
__device__ __forceinline__ void axpy_row(const v4u& a, float wgt, float (&y)[32]) {
#pragma unroll
    for (int w = 0; w < 4; ++w) { const unsigned d = (w == 0) ? a.x : (w == 1) ? a.y : (w == 2) ? a.z : a.w;
        const f32x2 f0 = FP4_BYTE(d, 0), f1 = FP4_BYTE(d, 1), f2 = FP4_BYTE(d, 2), f3 = FP4_BYTE(d, 3);
        y[8 * w] += wgt * f0.x; y[8 * w + 1] += wgt * f0.y; y[8 * w + 2] += wgt * f1.x; y[8 * w + 3] += wgt * f1.y;
        y[8 * w + 4] += wgt * f2.x; y[8 * w + 5] += wgt * f2.y; y[8 * w + 6] += wgt * f3.x; y[8 * w + 7] += wgt * f3.y; }
}
#define DPP_ROR_MAX(t, n) fmaxf((t), __uint_as_float(__builtin_amdgcn_update_dpp(0u, __float_as_uint(t), 0x120 + (n), 0xf, 0xf, false)))
#define CSWAP(a, b) do { const float hi_ = fmaxf(a, b), lo_ = fminf(a, b); a = hi_; b = lo_; } while (0)
__device__ __forceinline__ void topk_token_fast(const float* __restrict__ srow, int lane, const float* inv_su, const float* inv_sv,
                                                LAS int* se, LAS float* sa, LAS float* sb) {
    const int l16 = lane & 15, row = lane >> 4;
    float R[4];
#pragma unroll
    for (int ps = 0; ps < 4; ++ps) {
        const f32x4 v0 = *(const f32x4*)(srow + (4 * ps + row) * 128 + 8 * l16), v1 = *(const f32x4*)(srow + (4 * ps + row) * 128 + 8 * l16 + 4);
        float k[8];
        k[0] = v0.x; k[1] = v0.y; k[2] = v0.z; k[3] = v0.w; k[4] = v1.x; k[5] = v1.y; k[6] = v1.z; k[7] = v1.w;
#pragma unroll
        for (int i = 0; i < 8; ++i) k[i] = __uint_as_float((__float_as_uint(k[i]) & 0xFFFFFF80u) | (unsigned)(8 * l16 + i));
        CSWAP(k[0], k[1]); CSWAP(k[2], k[3]); CSWAP(k[4], k[5]); CSWAP(k[6], k[7]);
        CSWAP(k[0], k[2]); CSWAP(k[1], k[3]); CSWAP(k[4], k[6]); CSWAP(k[5], k[7]);
        CSWAP(k[1], k[2]); CSWAP(k[5], k[6]);
        CSWAP(k[0], k[4]); CSWAP(k[1], k[5]); CSWAP(k[2], k[6]); CSWAP(k[3], k[7]);
        CSWAP(k[2], k[4]); CSWAP(k[3], k[5]);
        CSWAP(k[1], k[2]); CSWAP(k[3], k[4]); CSWAP(k[5], k[6]);
        float res = 0.f;
#pragma unroll
        for (int it = 0; it < 16; ++it) {
            float m = k[0];
            m = DPP_ROR_MAX(m, 8); m = DPP_ROR_MAX(m, 4); m = DPP_ROR_MAX(m, 2); m = DPP_ROR_MAX(m, 1);
            const bool own = (k[0] == m);
#pragma unroll
            for (int i = 0; i < 7; ++i) k[i] = own ? k[i + 1] : k[i];
            k[7] = own ? -INFINITY : k[7];
            res = (l16 == it) ? m : res;
        }
        R[ps] = res;
    }
#pragma unroll
    for (int g = 0; g < 2; ++g) {
        const auto sw = __builtin_amdgcn_permlane16_swap(__float_as_uint(R[2 * g]), __float_as_uint(R[2 * g + 1]), false, false);
        const float X = __uint_as_float(sw[0]), Y = __uint_as_float(sw[1]);
        const float a = __uint_as_float(__float_as_uint(X) & 0xFFFFFF80u);
        int j = 0;
        float v2 = __shfl(Y, (lane & 48));
        float best = 0.f;
#pragma unroll
        for (int it = 0; it < 16; ++it) {
            const float sum = a + __uint_as_float(__float_as_uint(v2) & 0xFFFFFF80u);
            const float cand = (j < 16) ? __uint_as_float((__float_as_uint(sum) & 0xFFFFFF00u) | (unsigned)((l16 << 4) | (j & 15))) : -INFINITY;
            float m = cand;
            m = DPP_ROR_MAX(m, 8); m = DPP_ROR_MAX(m, 4); m = DPP_ROR_MAX(m, 2); m = DPP_ROR_MAX(m, 1);
            best = (l16 == it) ? m : best;
            if (it < 15) { j += (cand == m) ? 1 : 0; v2 = __shfl(Y, (lane & 48) + (j & 15)); }
        }
        const unsigned bb = __float_as_uint(best);
        const int bi = (bb >> 4) & 15, bj = bb & 15;
        const unsigned k1 = __float_as_uint(__shfl(X, (lane & 48) + bi)), k2 = __float_as_uint(__shfl(Y, (lane & 48) + bj));
        const int e = (int)(k1 & 127u) * 128 + (int)(k2 & 127u);
        const float bv = __uint_as_float(bb & 0xFFFFFF00u);
        float mx = bv; mx = DPP_ROR_MAX(mx, 8); mx = DPP_ROR_MAX(mx, 4); mx = DPP_ROR_MAX(mx, 2); mx = DPP_ROR_MAX(mx, 1);
        const float ex = __expf(bv - mx);
        float sm = ex; sm = DPP_ROR_ADD(sm, 8); sm = DPP_ROR_ADD(sm, 4); sm = DPP_ROR_ADD(sm, 2); sm = DPP_ROR_ADD(sm, 1);
        const float gate = ex / sm;
        const int head = 4 * g + ((row & 1) * 2 + (row >> 1));
        se[head * 16 + l16] = e; sa[head * 16 + l16] = inv_su[e]; sb[head * 16 + l16] = gate * inv_sv[e];
    }
}
#define PEER_LOAD(DST, TAB, b) do { _Pragma("unroll") for (int r_ = 0; r_ < 4; ++r_) { const unsigned char* rp_ = (TAB) + (size_t)(unsigned)__builtin_amdgcn_readfirstlane(se[4 * (b) + r_]) * 1024 + 16 * lane; \
        DST[r_] = *(const v4u*)rp_; } } while (0)
__device__ __forceinline__ void peer_token(int t, const float* scores, const bf16_t* hn, const float* hbuf, const unsigned char* U8, const unsigned char* V8,
                                           const float* inv_su, const float* inv_sv, const float* gfin, float* out,
                                           LAS int* se, LAS float* sa, LAS float* sb, int lane_in) {
    int lane = lane_in;
    {
        LAS int* se0 = se + 512; LAS float* sa0 = sa + 512; LAS float* sb0 = sb + 512;
        topk_token_fast(scores + (size_t)t * DM, lane, inv_su, inv_sv, se0, sa0, sb0);
        unsigned a0 = ((unsigned)se0[lane] << 7) | (unsigned)lane, a1 = ((unsigned)se0[lane + 64] << 7) | (unsigned)(lane + 64);
#pragma unroll
        for (int k = 2; k <= 128; k <<= 1) {
#pragma unroll
            for (int j = k >> 1; j > 0; j >>= 1) {
                if (j == 64) { const unsigned lo = a0 < a1 ? a0 : a1, hi = a0 < a1 ? a1 : a0; a0 = lo; a1 = hi; }
                else {
                    const unsigned p0 = (unsigned)__shfl_xor((int)a0, j), p1 = (unsigned)__shfl_xor((int)a1, j);
                    const bool lower = (lane & j) == 0;
                    const bool up0 = (lane & k) == 0, up1 = ((lane + 64) & k) == 0;
                    const unsigned mn0 = a0 < p0 ? a0 : p0, mx0 = a0 < p0 ? p0 : a0, mn1 = a1 < p1 ? a1 : p1, mx1 = a1 < p1 ? p1 : a1;
                    a0 = (up0 == lower) ? mn0 : mx0; a1 = (up1 == lower) ? mn1 : mx1;
                }
            }
        }
        const int k0 = a0 & 127, k1 = a1 & 127;
        se[lane] = (int)(a0 >> 7); sa[lane] = sa0[k0]; sb[lane] = sb0[k0];
        se[lane + 64] = (int)(a1 >> 7); sa[lane + 64] = sa0[k1]; sb[lane + 64] = sb0[k1];
    }
    asm volatile("" : "+v"(lane));
    float xv[32], y[32];
#pragma unroll
    for (int j = 0; j < 4; ++j) {
        const v4u h0 = *(const v4u*)(hn + (size_t)t * DM + 32 * lane + 8 * j);
#pragma unroll
        for (int w = 0; w < 4; ++w) { const unsigned d0 = (w == 0) ? h0.x : (w == 1) ? h0.y : (w == 2) ? h0.z : h0.w;
            xv[8 * j + 2 * w] = __uint_as_float(d0 << 16); xv[8 * j + 2 * w + 1] = __uint_as_float(d0 & 0xffff0000u); }
    }
#pragma unroll
    for (int i = 0; i < 32; ++i) y[i] = 0.f;
    v4u Ua[4], Ub[4], Va[4];
#define PEER_BATCH(b, UC, VC) do { \
        PEER_LOAD(VC, V8, (b)); \
        float pr[4]; \
        _Pragma("unroll") for (int r = 0; r < 4; ++r) pr[r] = dot_row(UC[r], xv); \
        if ((b) + 2 < 32) PEER_LOAD(UC, U8, (b) + 2); \
        float wr_[4], q2[2]; \
        _Pragma("unroll") for (int r = 0; r < 2; ++r) { auto sw = __builtin_amdgcn_permlane32_swap(__float_as_uint(pr[r]), __float_as_uint(pr[r + 2]), false, false); q2[r] = __uint_as_float(sw[0]) + __uint_as_float(sw[1]); } \
        float tv; \
        { auto sw = __builtin_amdgcn_permlane16_swap(__float_as_uint(q2[0]), __float_as_uint(q2[1]), false, false); tv = __uint_as_float(sw[0]) + __uint_as_float(sw[1]); } \
        tv = DPP_ROR_ADD(tv, 8); tv = DPP_ROR_ADD(tv, 4); tv = DPP_ROR_ADD(tv, 2); tv = DPP_ROR_ADD(tv, 1); \
        const int k = 4 * (b) + (lane >> 4);     \
        const float wc = gelu_erf(tv * sa[k]) * sb[k]; \
        _Pragma("unroll") for (int r = 0; r < 4; ++r) wr_[r] = __uint_as_float(__builtin_amdgcn_readlane(__float_as_uint(wc), 16 * r)); \
        _Pragma("unroll") for (int r = 0; r < 4; ++r) axpy_row(VC[r], wr_[r], y); } while (0)
    PEER_LOAD(Ua, U8, 0); PEER_LOAD(Ub, U8, 1);
#pragma unroll 1
    for (int b = 0; b < 32; b += 2) { PEER_BATCH(b, Ua, Va); PEER_BATCH(b + 1, Ub, Va); }
    float ss = 0.f;
#pragma unroll
    for (int j = 0; j < 8; ++j) { const f32x4 hv = *(const f32x4*)(hbuf + (size_t)t * DM + 32 * lane + 4 * j);
        y[4 * j] += hv.x; y[4 * j + 1] += hv.y; y[4 * j + 2] += hv.z; y[4 * j + 3] += hv.w;
        ss += (y[4 * j] * y[4 * j] + y[4 * j + 1] * y[4 * j + 1]) + (y[4 * j + 2] * y[4 * j + 2] + y[4 * j + 3] * y[4 * j + 3]); }
    ss = wave_sum(ss);
    const float rstd = rsqrtf(ss * (1.f / DM) + EPS);
#pragma unroll
    for (int j = 0; j < 8; ++j) { const f32x4 gg = *(const f32x4*)(gfin + 32 * lane + 4 * j);
        f32x4 o; o.x = y[4 * j] * rstd * gg.x; o.y = y[4 * j + 1] * rstd * gg.y; o.z = y[4 * j + 2] * rstd * gg.z; o.w = y[4 * j + 3] * rstd * gg.w;
        *(f32x4*)(out + (size_t)t * DM + 32 * lane + 4 * j) = o; }
}
typedef short bf16x8 __attribute__((ext_vector_type(8)));
__device__ __forceinline__ int pos32(int x) { const int g = x & ~31, l = x & 31; return g + 8 * ((l & 15) >> 2) + 4 * (l >> 4) + (l & 3); }
constexpr size_t PB_H_QG = 0, PB_H_KDT = 32 * MiB, PB_H_A = 64 * MiB;
constexpr size_t PB_G_QS = 80 * MiB, PB_G_KT = 96 * MiB;
constexpr size_t PB_G_W = 112 * MiB, PB_G_A = 144 * MiB, PB_G_U = 160 * MiB;
constexpr int PROG_WORD = 3584;
constexpr int NCW = 1, NSB = 32 * (4 / NCW);
constexpr int SC_QG = 0, SC_WV = 16384, SC_KDT = 32768, SC_A = 49152, SC_BUF = 57344, SC_VEC = 2 * SC_BUF, SC_OT = SC_VEC + 2048, SC_OTB = 17408, SC_GAIN = SC_OT + 2 * SC_OTB;

__device__ __forceinline__ bf16x8 pack_frag(const f32x4& x0, const f32x4& x1) {
    v4u w; w.x = pk2(x0.x, x0.y); w.y = pk2(x0.z, x0.w); w.z = pk2(x1.x, x1.y); w.w = pk2(x1.z, x1.w);
    return __builtin_bit_cast(bf16x8, w);
}
#define MFMA16(a, b, c) __builtin_amdgcn_mfma_f32_16x16x32_bf16((a), (b), (c), 0, 0, 0)

__device__ __forceinline__ void hgrn_prep_item(int item, const bf16_t* proj, const float* lb_logits, unsigned char* pb, float* vecs, LAS unsigned char* lds, int tid) {
    const int c = item & 127, sq = item >> 7, b = sq >> 3, h = sq & 7, t0 = b * SEQ + c * 64;
    const int d = tid & 127, seg = tid >> 7, lane = tid & 63, wave = tid >> 6;
    LAS bf16_t* QGl = (LAS bf16_t*)lds; LAS bf16_t* KGl = (LAS bf16_t*)(lds + 17408); LAS float* segsum = (LAS float*)(lds + 34816);
    bf16_t* gQG = (bf16_t*)(pb + PB_H_QG) + (size_t)item * 8192;
    bf16_t* gKDT = (bf16_t*)(pb + PB_H_KDT) + (size_t)item * 8192;
    bf16_t* gA = (bf16_t*)(pb + PB_H_A) + (size_t)item * 4096;
    float* gvec = vecs + (size_t)item * 256;
    const float l0 = lb_logits[h * 128 + d], l1 = lb_logits[1024 + h * 128 + d];
    const float lb = 1.f / (1.f + __expf(l1 - l0));
    float lf[16], qv[16], kv[16];
#pragma unroll
    for (int i = 0; i < 16; ++i) {
        const bf16_t* pr = proj + (size_t)(t0 + 16 * seg + i) * NPROJ + h * 128 + d;
        const float z = bf2f(pr[C_AF]); qv[i] = bf2f(pr[C_AQ]);
        const float f = lb + (1.f - lb) * sigmoidf_(z);
        lf[i] = __logf(f); kv[i] = 1.f - f;
    }
    float run = 0.f;
#pragma unroll
    for (int i = 0; i < 16; ++i) { run += lf[i]; lf[i] = run; }
    segsum[seg * 128 + d] = run;
    __syncthreads();
    float off = 0.f, bl = 0.f;
#pragma unroll
    for (int s = 0; s < 4; ++s) { const float v = segsum[s * 128 + d]; bl += v; if (s < seg) off += v; }
    const int pd = pos32(d);
    float kd[16];
#pragma unroll
    for (int i = 0; i < 16; ++i) {
        const float bc = lf[i] + off; const int tl = 16 * seg + i;
        const float qg = qv[i] * __expf(bc), kg = kv[i] * __expf(-bc);
        kd[i] = kv[i] * __expf(bl - bc);
        const bf16_t qb = f2bf(qg);
        QGl[tl * 136 + d] = qb; KGl[tl * 136 + d] = f2bf(kg);
        gQG[tl * 128 + pd] = qb;
    }
#pragma unroll
    for (int ii = 0; ii < 4; ++ii) { v2u o; o.x = pk2(kd[4 * ii], kd[4 * ii + 1]); o.y = pk2(kd[4 * ii + 2], kd[4 * ii + 3]);
        *(v2u*)(gKDT + d * 64 + 32 * (seg >> 1) + 8 * ii + 4 * (seg & 1)) = o; }
    if (seg == 0) gvec[128 + d] = __expf(bl);
    __syncthreads();
    const int n = lane & 15, q = lane >> 4;
#pragma unroll
    for (int ti = 0; ti < 2; ++ti) {
        const int id = wave + 8 * ti, mt = id >> 2, ns = id & 3;
        f32x4 acc = {0.f, 0.f, 0.f, 0.f};
        if (ns <= mt) {
#pragma unroll
            for (int s4 = 0; s4 < 4; ++s4) {
                const bf16x8 a = *(const LAS bf16x8*)(QGl + (16 * mt + n) * 136 + 32 * s4 + 8 * q);
                const bf16x8 bb = *(const LAS bf16x8*)(KGl + (16 * ns + n) * 136 + 32 * s4 + 8 * q);
                acc = MFMA16(a, bb, acc);
            }
        }
        const int s = 16 * ns + n, ps = pos32(s);
#pragma unroll
        for (int r = 0; r < 4; ++r) { const int t = 16 * mt + 4 * q + r; const float v = (r == 0) ? acc.x : (r == 1) ? acc.y : (r == 2) ? acc.z : acc.w;
            gA[t * 64 + ps] = f2bf((s <= t) ? v : 0.f); }
    }
    __syncthreads();
}

constexpr int GP_QF = 0, GP_KF = 33024, GP_N = 0, GP_QB = 66048, GP_KB = 83456, GP_VB = 100864, GP_PART = 135680, GP_SB = 137728;
__device__ __forceinline__ void gdn_prep_item(int item, const bf16_t* proj, const float* ba, const float* conv_w, const float* A_log, const float* dt_bias,
                                              unsigned char* pb, float* vecs, LAS unsigned char* lds, int tid) {
    const int c = item & 127, bq = item >> 7, b = bq >> 2, qh = bq & 3, t0 = b * SEQ + c * 64;
    const int lane = tid & 63, wave = tid >> 6;
    LAS float* QF = (LAS float*)(lds + GP_QF); LAS float* KF = (LAS float*)(lds + GP_KF);
    LAS bf16_t* QB = (LAS bf16_t*)(lds + GP_QB); LAS bf16_t* KB = (LAS bf16_t*)(lds + GP_KB); LAS bf16_t* VB = (LAS bf16_t*)(lds + GP_VB);
    LAS float* PART = (LAS float*)(lds + GP_PART); LAS float* SBETA = (LAS float*)(lds + GP_SB); LAS float* SGC = SBETA + 128;
    LAS float* NM = (LAS float*)(lds + GP_N);
    {
        int col, wch; const int dd = tid & 127;
        if (tid < 128) { col = C_BQ + qh * 128 + dd; wch = qh * 128 + dd; }
        else if (tid < 256) { col = C_BK + qh * 128 + dd; wch = 512 + qh * 128 + dd; }
        else { const int vh = 2 * qh + ((tid - 256) >> 7); col = C_BV + vh * 128 + dd; wch = 1024 + vh * 128 + dd; }
        const float w0 = conv_w[wch], w1 = conv_w[2048 + wch], w2 = conv_w[4096 + wch], w3 = conv_w[6144 + wch];
        float h0 = 0.f, h1 = 0.f, h2 = 0.f;
        const bf16_t* pr = proj + (size_t)t0 * NPROJ + col;
        if (c > 0) { h0 = bf2f(pr[-3 * NPROJ]); h1 = bf2f(pr[-2 * NPROJ]); h2 = bf2f(pr[-1 * NPROJ]); }
        unsigned xr[64];
#pragma unroll
        for (int t = 0; t < 64; ++t) xr[t] = pr[(size_t)t * NPROJ];
#pragma unroll
        for (int t = 0; t < 64; ++t) {
            const float xx = __uint_as_float(xr[t] << 16);
            const float yv = siluf_(w0 * h0 + w1 * h1 + w2 * h2 + w3 * xx);
            h0 = h1; h1 = h2; h2 = xx;
            if (tid < 128) QF[t * 129 + dd] = yv;
            else if (tid < 256) KF[t * 129 + dd] = yv;
            else VB[((tid - 256) >> 7) * 8704 + t * 136 + dd] = f2bf(yv);
        }
    }
    __syncthreads();
    {
        const int t = tid & 63, part = tid >> 6, which = part >> 2, sub = part & 3;
        const LAS float* src = (which ? KF : QF) + t * 129 + 32 * sub;
        float s = 0.f;
#pragma unroll
        for (int i = 0; i < 32; ++i) s += src[i] * src[i];
        PART[(which * 4 + sub) * 64 + t] = s;
    }
    if (wave < 2) {
        const int vh = 2 * qh + wave;
        const float ax = ba[(size_t)(t0 + lane) * 16 + 8 + vh] + dt_bias[vh];
        const float sp = ax > 20.f ? ax : log1pf(__expf(ax));
        float gc = -__expf(A_log[vh]) * sp;
#pragma unroll
        for (int o = 1; o < 64; o <<= 1) { const float up = __shfl_up(gc, o); if (lane >= o) gc += up; }
        const float gl = __shfl(gc, 63);
        const float beta = sigmoidf_(ba[(size_t)(t0 + lane) * 16 + vh]);
        SBETA[wave * 64 + lane] = beta; SGC[wave * 64 + lane] = gc;
        float* gvec = vecs + ((size_t)(16 + b * 8 + vh) * 128 + c) * 256;
        gvec[lane] = __expf(gc); gvec[64 + lane] = __expf(gl - gc);
        const float dl = __expf(gl); gvec[128 + lane] = dl; gvec[192 + lane] = dl;
    }
    __syncthreads();
    {
        const int d = tid & 127, seg = tid >> 7, pd = pos32(d);
        bf16_t* gQS = (bf16_t*)(pb + PB_G_QS) + (size_t)item * 8192;
        bf16_t* gKT = (bf16_t*)(pb + PB_G_KT) + (size_t)item * 8192;
        float kk[16];
#pragma unroll
        for (int i = 0; i < 16; ++i) {
            const int tl = 16 * seg + i;
            const float sq = PART[0 * 64 + tl] + PART[1 * 64 + tl] + PART[2 * 64 + tl] + PART[3 * 64 + tl];
            const float sk = PART[4 * 64 + tl] + PART[5 * 64 + tl] + PART[6 * 64 + tl] + PART[7 * 64 + tl];
            const bf16_t qb = f2bf(QF[tl * 129 + d] * rsqrtf(sq + EPS) * 0.08838834764831845f);
            const bf16_t kb = f2bf(KF[tl * 129 + d] * rsqrtf(sk + EPS));
            QB[tl * 136 + d] = qb; KB[tl * 136 + d] = kb; gQS[tl * 128 + pd] = qb; kk[i] = bf2f(kb);
        }
#pragma unroll
        for (int ii = 0; ii < 4; ++ii) { v2u o; o.x = pk2(kk[4 * ii], kk[4 * ii + 1]); o.y = pk2(kk[4 * ii + 2], kk[4 * ii + 3]);
            *(v2u*)(gKT + d * 64 + 32 * (seg >> 1) + 8 * ii + 4 * (seg & 1)) = o; }
    }
    __syncthreads();
    {
        const int n = lane & 15, q = lane >> 4;
#pragma unroll
        for (int ti = 0; ti < 2; ++ti) {
            const int id = 2 * wave + ti, mt = id >> 2, ns = id & 3;
            f32x4 akk = {0.f, 0.f, 0.f, 0.f}, aqk = {0.f, 0.f, 0.f, 0.f};
            if (ns <= mt) {
#pragma unroll
                for (int s4 = 0; s4 < 4; ++s4) {
                    const bf16x8 kb_ = *(const LAS bf16x8*)(KB + (16 * ns + n) * 136 + 32 * s4 + 8 * q);
                    const bf16x8 ka_ = *(const LAS bf16x8*)(KB + (16 * mt + n) * 136 + 32 * s4 + 8 * q);
                    const bf16x8 qa_ = *(const LAS bf16x8*)(QB + (16 * mt + n) * 136 + 32 * s4 + 8 * q);
                    akk = MFMA16(ka_, kb_, akk); aqk = MFMA16(qa_, kb_, aqk);
                }
            }
            const int s = 16 * ns + n, ps = pos32(s);
#pragma unroll
            for (int vl = 0; vl < 2; ++vl) {
                bf16_t* gA = (bf16_t*)(pb + PB_G_A) + ((size_t)((b * 8 + 2 * qh + vl) * 128 + c)) * 4096;
                const float gcs = SGC[vl * 64 + s];
#pragma unroll
                for (int r = 0; r < 4; ++r) {
                    const int t = 16 * mt + 4 * q + r;
                    const float vk = (r == 0) ? akk.x : (r == 1) ? akk.y : (r == 2) ? akk.z : akk.w;
                    const float vq = (r == 0) ? aqk.x : (r == 1) ? aqk.y : (r == 2) ? aqk.z : aqk.w;
                    const float ex = (s <= t) ? __expf(SGC[vl * 64 + t] - gcs) : 0.f;
                    NM[vl * 4096 + t * 64 + s] = (s < t) ? SBETA[vl * 64 + t] * vk * ex : 0.f;
                    gA[t * 64 + ps] = f2bf((s <= t) ? vq * ex : 0.f);
                }
            }
        }
    }
    __syncthreads();
    {
        const int vl = tid >> 8, colx = tid & 255;
        float x[64];
        if (colx < 128) {
#pragma unroll
            for (int t = 0; t < 64; ++t) x[t] = SBETA[vl * 64 + t] * bf2f(VB[vl * 8704 + t * 136 + colx]);
        } else {
#pragma unroll
            for (int t = 0; t < 64; ++t) x[t] = SBETA[vl * 64 + t] * __expf(SGC[vl * 64 + t]) * bf2f(KB[t * 136 + colx - 128]);
        }
        __syncthreads();
        const LAS float* Nv = NM + vl * 4096;
#pragma unroll
        for (int t = 1; t < 64; ++t) {
            float acc = x[t];
#pragma unroll
            for (int s4 = 0; s4 < (t + 3) / 4; ++s4) {
                const f32x4 nn = *(const LAS f32x4*)(Nv + t * 64 + 4 * s4);
                acc -= nn.x * x[4 * s4]; if (4 * s4 + 1 < t) acc -= nn.y * x[4 * s4 + 1]; if (4 * s4 + 2 < t) acc -= nn.z * x[4 * s4 + 2]; if (4 * s4 + 3 < t) acc -= nn.w * x[4 * s4 + 3];
            }
            x[t] = acc;
        }
        if (colx < 128) {
            bf16_t* gU = (bf16_t*)(pb + PB_G_U) + ((size_t)((b * 8 + 2 * qh + vl) * 128 + c)) * 8192;
            const int sl = colx >> 4, n = colx & 15;
#pragma unroll
            for (int mt = 0; mt < 4; ++mt)
#pragma unroll
                for (int q = 0; q < 4; ++q) { v2u o; o.x = pk2(x[16 * mt + 4 * q], x[16 * mt + 4 * q + 1]); o.y = pk2(x[16 * mt + 4 * q + 2], x[16 * mt + 4 * q + 3]);
                    *(v2u*)(gU + ((size_t)((sl * 4 + mt) * 64 + q * 16 + n)) * 4) = o; }
        } else {
            LAS bf16_t* WS = (LAS bf16_t*)(lds + GP_QB) + vl * 8704;
            const int pd = pos32(colx - 128);
#pragma unroll
            for (int t = 0; t < 64; ++t) WS[t * 136 + pd] = f2bf(-x[t]);
        }
    }
    __syncthreads();
    {
#pragma unroll
        for (int i = 0; i < 4; ++i) { const int p = tid + 512 * i, vl = p >> 10, row = (p >> 4) & 63, c16 = p & 15;
            bf16_t* gW = (bf16_t*)(pb + PB_G_W) + ((size_t)((b * 8 + 2 * qh + vl) * 128 + c)) * 8192;
            *(v4u*)(gW + row * 128 + c16 * 8) = *(const LAS v4u*)(lds + GP_QB + vl * 17408 + row * 272 + c16 * 16); }
    }
    __syncthreads();
}

struct ScanSrc { const unsigned char* qg; const unsigned char* wv; const unsigned char* kdt; const unsigned char* a; const float* vec; size_t wv_row; };
__device__ __forceinline__ void scan_dma(const ScanSrc& S, LAS unsigned char* buf, LAS unsigned char* vecb, int w, int lane) {
#pragma unroll
    for (int i = 0; i < 2; ++i) { const int pi = 2 * w + i, row = 4 * pi + (lane >> 4), cl = (lane & 15) ^ (row & 15);
        __builtin_amdgcn_global_load_lds((const unsigned*)(S.qg + row * 256 + cl * 16), (LAS unsigned*)(buf + SC_QG + pi * 1024), 16, 0, 0);
        __builtin_amdgcn_global_load_lds((const unsigned*)(S.wv + (size_t)row * S.wv_row + cl * 16), (LAS unsigned*)(buf + SC_WV + pi * 1024), 16, 0, 0); }
#pragma unroll
    for (int i = 0; i < 2; ++i) { const int pi = 2 * w + i, row = 8 * pi + (lane >> 3), cl = (lane & 7) ^ ((row >> 1) & 7);
        __builtin_amdgcn_global_load_lds((const unsigned*)(S.kdt + row * 128 + cl * 16), (LAS unsigned*)(buf + SC_KDT + pi * 1024), 16, 0, 0); }
    { const int pi = w, row = 8 * pi + (lane >> 3), cl = (lane & 7) ^ ((row >> 1) & 7);
        __builtin_amdgcn_global_load_lds((const unsigned*)(S.a + row * 128 + cl * 16), (LAS unsigned*)(buf + SC_A + pi * 1024), 16, 0, 0); }
    if (w == 0) __builtin_amdgcn_global_load_lds((const unsigned*)((const unsigned char*)S.vec + lane * 16), (LAS unsigned*)vecb, 16, 0, 0);
}
__device__ __forceinline__ void scan_block(int sq, int g, const bf16_t* proj, const unsigned char* pb, const float* vecs, const float* hgrn_g, const float* gdn_g,
                                           bf16_t* mix, unsigned* prog, LAS unsigned char* lds, int tid) {
    const bool gdn = sq >= 16;
    const int b = (sq & 15) >> 3, hh = sq & 7, lane = tid & 63, sl = __builtin_amdgcn_readfirstlane(tid >> 6), n = lane & 15, q = lane >> 4;
    const unsigned char* bQG; const unsigned char* bWV; const unsigned char* bKDT; const unsigned char* bA; const unsigned char* bU = nullptr;
    size_t wv_row, wv_chunk; int gate_col, mix_col; const float* gain;
    if (!gdn) {
        const size_t s0 = (size_t)(b * 8 + hh) * 128;
        bQG = pb + PB_H_QG + s0 * 16384; bKDT = pb + PB_H_KDT + s0 * 16384; bA = pb + PB_H_A + s0 * 8192;
        bWV = (const unsigned char*)(proj + (size_t)(b * SEQ) * NPROJ + C_AI + hh * 128); wv_row = (size_t)NPROJ * 2; wv_chunk = (size_t)64 * NPROJ * 2;
        gate_col = C_AG + hh * 128; mix_col = hh * 128; gain = hgrn_g;
    } else {
        const size_t s0 = (size_t)(b * 8 + hh) * 128, q0 = (size_t)(b * 4 + (hh >> 1)) * 128;
        bQG = pb + PB_G_QS + q0 * 16384; bKDT = pb + PB_G_KT + q0 * 16384; bA = pb + PB_G_A + s0 * 8192;
        bWV = pb + PB_G_W + s0 * 16384; wv_row = 256; wv_chunk = 16384; bU = pb + PB_G_U + s0 * 16384;
        gate_col = C_BZ + hh * 128; mix_col = 1024 + hh * 128; gain = gdn_g;
    }
    const float* bvec = vecs + (size_t)sq * 128 * 256;
    LAS float* gainl = (LAS float*)(lds + SC_GAIN);
    const int wave = sl;
    {
        ScanSrc src{bQG, bWV, bKDT, bA, bvec, wv_row};
        scan_dma(src, lds, lds + SC_VEC, wave, lane);
        if (tid < 128) gainl[tid] = gain[tid];
    }
    __builtin_amdgcn_s_waitcnt(0x0070);
    asm volatile("" ::: "memory");
    __builtin_amdgcn_s_barrier();
    asm volatile("" ::: "memory");
#define SCAN_BAR() do { asm volatile("s_waitcnt lgkmcnt(0)" ::: "memory"); __builtin_amdgcn_s_barrier(); asm volatile("" ::: "memory"); } while (0)
#define SCHED_FENCE() __builtin_amdgcn_sched_barrier(0)
    const int cw = g * NCW + wave;
    const int hw = (NCW == 2) ? ((wave == 2) ? 0 : (wave == 3) ? 1 : (wave == 6) ? 2 : (wave == 7) ? 3 : -1)
                              : ((wave == 1) ? 0 : (wave == 2) ? 1 : (wave == 3) ? 2 : (wave == 5) ? 3 : -1);
    if (wave < NCW) {
        f32x4 S[2][8];
#pragma unroll
        for (int e = 0; e < 2; ++e)
#pragma unroll
            for (int m = 0; m < 8; ++m) S[e][m] = (f32x4){0.f, 0.f, 0.f, 0.f};
        v2u Ureg[2][4];
#pragma unroll
        for (int e = 0; e < 2; ++e)
#pragma unroll
            for (int mt = 0; mt < 4; ++mt) Ureg[e][mt] = gdn ? *(const v2u*)(bU + (size_t)((2 * cw + e) * 4 + mt) * 512 + lane * 8) : (v2u){0u, 0u};
        for (int c = 0; c < 128; ++c) {
            int lane = tid & 63; asm volatile("" : "+v"(lane));
            const int n = lane & 15, q = lane >> 4;
            const int cur = c & 1;
            LAS unsigned char* buf = lds + cur * SC_BUF;
            const LAS float* vec = (const LAS float*)(lds + SC_VEC + cur * 1024);
            const int cn = (c + 1 < 128) ? c + 1 : 127;
#define SC2_COPYOUT(cc) do { const LAS bf16_t* OTn = (const LAS bf16_t*)(lds + SC_OT + ((cc) & 1) * SC_OTB); \
                _Pragma("unroll") for (int ps_ = 0; ps_ < 4; ++ps_) { const int row_ = 16 * ps_ + (lane >> 2), pc_ = lane & 3; \
                    const v4u val_ = *(const LAS v4u*)(OTn + row_ * 136 + 32 * cw + 8 * pc_); \
                    *(v4u*)(mix + (size_t)(b * SEQ + (cc) * 64 + row_) * DM + mix_col + 32 * cw + 8 * pc_) = val_; } } while (0)
            f32x4 VN[2][4];
            if (gdn) {
#pragma unroll
                for (int e = 0; e < 2; ++e)
#pragma unroll
                    for (int mt = 0; mt < 4; ++mt) { const v2u uu = Ureg[e][mt];
                        VN[e][mt] = (f32x4){__uint_as_float(uu.x << 16), __uint_as_float(uu.x & 0xffff0000u), __uint_as_float(uu.y << 16), __uint_as_float(uu.y & 0xffff0000u)}; }
            }
            asm volatile("s_waitcnt vmcnt(0)" ::: "memory");
            if (c >= 1) SC2_COPYOUT(c - 1);
            bf16x8 Sf[2][4];
#pragma unroll
            for (int e = 0; e < 2; ++e)
#pragma unroll
                for (int s4 = 0; s4 < 4; ++s4) Sf[e][s4] = pack_frag(S[e][2 * s4], S[e][2 * s4 + 1]);
            bf16x8 fa[4], fb[4];
            bf16x8 VNf[2][2], VNSf[2][2];
#define SC2_LD4_K128(dst, OFF, mt_) do { _Pragma("unroll") for (int i_ = 0; i_ < 4; ++i_) dst[i_] = *(const LAS bf16x8*)(buf + (OFF) + (16 * (mt_) + n) * 256 + (((4 * i_ + q) ^ n) * 16)); } while (0)
#define SC2_LD4_K64(dst, OFF, mb) do { _Pragma("unroll") for (int i_ = 0; i_ < 4; ++i_) dst[i_] = *(const LAS bf16x8*)(buf + (OFF) + (16 * ((mb) + (i_ >> 1)) + n) * 128 + (((4 * (i_ & 1) + q) ^ ((n >> 1) & 7)) * 16)); } while (0)
#define SC2_MM_K128(A0, A1, fr) do { _Pragma("unroll") for (int i_ = 0; i_ < 4; ++i_) { A0 = MFMA16(fr[i_], Sf[0][i_], A0); A1 = MFMA16(fr[i_], Sf[1][i_], A1); } } while (0)
#define SC2_MM_K64(X, ma, fr, BF) do { X[0][ma] = MFMA16(fr[0], BF[0][0], X[0][ma]); X[1][ma] = MFMA16(fr[0], BF[1][0], X[1][ma]); X[0][ma] = MFMA16(fr[1], BF[0][1], X[0][ma]); X[1][ma] = MFMA16(fr[1], BF[1][1], X[1][ma]); \
        X[0][(ma) + 1] = MFMA16(fr[2], BF[0][0], X[0][(ma) + 1]); X[1][(ma) + 1] = MFMA16(fr[2], BF[1][0], X[1][(ma) + 1]); X[0][(ma) + 1] = MFMA16(fr[3], BF[0][1], X[0][(ma) + 1]); X[1][(ma) + 1] = MFMA16(fr[3], BF[1][1], X[1][(ma) + 1]); } while (0)
            if (gdn) {
                SC2_LD4_K128(fa, SC_WV, 0); SCHED_FENCE();
                SC2_LD4_K128(fb, SC_WV, 1); SCHED_FENCE();
#pragma unroll
                for (int e = 0; e < 2; ++e)
#pragma unroll
                    for (int mt = 0; mt < 4; ++mt) Ureg[e][mt] = *(const v2u*)(bU + (size_t)cn * 16384 + (size_t)((2 * cw + e) * 4 + mt) * 512 + lane * 8);
                SC2_MM_K128(VN[0][0], VN[1][0], fa); SCHED_FENCE(); SC2_LD4_K128(fa, SC_WV, 2); SCHED_FENCE();
                SC2_MM_K128(VN[0][1], VN[1][1], fb); SCHED_FENCE(); SC2_LD4_K128(fb, SC_WV, 3); SCHED_FENCE();
                SC2_MM_K128(VN[0][2], VN[1][2], fa); SCHED_FENCE(); SC2_LD4_K128(fa, SC_QG, 0); SCHED_FENCE();
                SC2_MM_K128(VN[0][3], VN[1][3], fb); SCHED_FENCE(); SC2_LD4_K128(fb, SC_QG, 1); SCHED_FENCE();
#pragma unroll
                for (int e = 0; e < 2; ++e)
#pragma unroll
                    for (int s2 = 0; s2 < 2; ++s2) { const f32x4 e0 = *(const LAS f32x4*)(vec + 64 + 16 * (2 * s2) + 4 * q), e1 = *(const LAS f32x4*)(vec + 64 + 16 * (2 * s2 + 1) + 4 * q);
                        VNf[e][s2] = pack_frag(VN[e][2 * s2], VN[e][2 * s2 + 1]); VNSf[e][s2] = pack_frag(VN[e][2 * s2] * e0, VN[e][2 * s2 + 1] * e1); }
            } else {
                SC2_LD4_K128(fa, SC_QG, 0); SCHED_FENCE();
                SC2_LD4_K128(fb, SC_QG, 1); SCHED_FENCE();
#pragma unroll
                for (int e = 0; e < 2; ++e)
#pragma unroll
                    for (int s2 = 0; s2 < 2; ++s2) { unsigned w[4];
#pragma unroll
                        for (int jj = 0; jj < 4; ++jj) { const int ja = 2 * jj, jb = 2 * jj + 1; const int cc = 16 * (2 * cw + e) + n;
                            const int ta = 32 * s2 + ((ja < 4) ? 4 * q + ja : 16 + 4 * q + ja - 4), tb = 32 * s2 + ((jb < 4) ? 4 * q + jb : 16 + 4 * q + jb - 4);
                            const unsigned lo = *(const LAS bf16_t*)(buf + SC_WV + ta * 256 + (((cc >> 3) ^ (ta & 15)) * 16) + (cc & 7) * 2), hi = *(const LAS bf16_t*)(buf + SC_WV + tb * 256 + (((cc >> 3) ^ (tb & 15)) * 16) + (cc & 7) * 2);
                            w[jj] = lo | (hi << 16); }
                        v4u ww; ww.x = w[0]; ww.y = w[1]; ww.z = w[2]; ww.w = w[3];
                        VNf[e][s2] = __builtin_bit_cast(bf16x8, ww); VNSf[e][s2] = VNf[e][s2]; }
            }
            f32x4 O[2][4];
#pragma unroll
            for (int e = 0; e < 2; ++e)
#pragma unroll
                for (int mt = 0; mt < 4; ++mt) O[e][mt] = (f32x4){0.f, 0.f, 0.f, 0.f};
            SC2_MM_K128(O[0][0], O[1][0], fa); SCHED_FENCE(); SC2_LD4_K128(fa, SC_QG, 2); SCHED_FENCE();
            SC2_MM_K128(O[0][1], O[1][1], fb); SCHED_FENCE(); SC2_LD4_K128(fb, SC_QG, 3); SCHED_FENCE();
            SC2_MM_K128(O[0][2], O[1][2], fa); SCHED_FENCE(); SC2_LD4_K64(fa, SC_A, 0); SCHED_FENCE();
            SC2_MM_K128(O[0][3], O[1][3], fb); SCHED_FENCE(); SC2_LD4_K64(fb, SC_A, 2); SCHED_FENCE();
            if (gdn) {
#pragma unroll
                for (int mt = 0; mt < 4; ++mt) { const f32x4 eg4 = *(const LAS f32x4*)(vec + 16 * mt + 4 * q); O[0][mt] = O[0][mt] * eg4; O[1][mt] = O[1][mt] * eg4; }
            }
            SC2_MM_K64(O, 0, fa, VNf); SCHED_FENCE(); SC2_LD4_K64(fa, SC_KDT, 0); SCHED_FENCE();
            SC2_MM_K64(O, 2, fb, VNf); SCHED_FENCE(); SC2_LD4_K64(fb, SC_KDT, 2); SCHED_FENCE();
#pragma unroll
            for (int m = 0; m < 8; ++m) { const f32x4 d4 = *(const LAS f32x4*)(vec + 128 + 16 * m + 4 * q); S[0][m] = S[0][m] * d4; S[1][m] = S[1][m] * d4; }
            SC2_MM_K64(S, 0, fa, VNSf); SCHED_FENCE(); SC2_LD4_K64(fa, SC_KDT, 4); SCHED_FENCE();
            SC2_MM_K64(S, 2, fb, VNSf); SCHED_FENCE(); SC2_LD4_K64(fb, SC_KDT, 6); SCHED_FENCE();
            SC2_MM_K64(S, 4, fa, VNSf);
            SC2_MM_K64(S, 6, fb, VNSf);
            LAS bf16_t* OT = (LAS bf16_t*)(lds + SC_OT + cur * SC_OTB);
#pragma unroll
            for (int e = 0; e < 2; ++e)
#pragma unroll
                for (int mt = 0; mt < 4; ++mt) { const int cc = 16 * (2 * cw + e) + n;
                    OT[(16 * mt + 4 * q + 0) * 136 + cc] = f2bf(O[e][mt].x); OT[(16 * mt + 4 * q + 1) * 136 + cc] = f2bf(O[e][mt].y);
                    OT[(16 * mt + 4 * q + 2) * 136 + cc] = f2bf(O[e][mt].z); OT[(16 * mt + 4 * q + 3) * 136 + cc] = f2bf(O[e][mt].w); }
            SCAN_BAR();
        }
        {
            int lane = tid & 63; asm volatile("" : "+v"(lane));
            asm volatile("s_waitcnt vmcnt(0)" ::: "memory");
            SC2_COPYOUT(127);
        }
    } else if (hw >= 0) {
        v4u G0[15], G1[15];
#define HLP_LOAD(GX, cn_) do { const unsigned char* sQG = bQG + (size_t)(cn_) * 16384 + (size_t)hw * 4096; const unsigned char* sWV = bWV + (size_t)(cn_) * wv_chunk + (size_t)(16 * hw) * wv_row; \
            const unsigned char* sKDT = bKDT + (size_t)(cn_) * 16384 + (size_t)hw * 4096; const unsigned char* sA = bA + (size_t)(cn_) * 8192 + (size_t)hw * 2048; \
            const unsigned l16 = (unsigned)lane * 16u, offv = (unsigned)(lane >> 4) * (unsigned)wv_row + (unsigned)(lane & 15) * 16u; \
            _Pragma("unroll") for (int i = 0; i < 4; ++i) { GX[i] = *(const v4u*)(sQG + i * 1024 + l16); GX[4 + i] = *(const v4u*)(sWV + (size_t)(4 * i) * wv_row + offv); } \
            _Pragma("unroll") for (int i = 0; i < 4; ++i) GX[8 + i] = *(const v4u*)(sKDT + i * 1024 + l16); \
            _Pragma("unroll") for (int i = 0; i < 2; ++i) GX[12 + i] = *(const v4u*)(sA + i * 1024 + l16); \
            GX[14] = *(const v4u*)((const unsigned char*)(bvec + (size_t)(cn_) * 256) + l16); } while (0)
#define HLP_STORE(GX, bi_) do { LAS unsigned char* nb = lds + (bi_) * SC_BUF + hw * 4096; LAS unsigned char* nv = lds + SC_VEC + (bi_) * 1024; const int lq = lane >> 4; \
            _Pragma("unroll") for (int i = 0; i < 4; ++i) { const int d = lq * 256 + (((lane & 15) ^ (4 * i + lq)) * 16); \
                *(LAS v4u*)(nb + SC_QG + i * 1024 + d) = GX[i]; *(LAS v4u*)(nb + SC_WV + i * 1024 + d) = GX[4 + i]; } \
            _Pragma("unroll") for (int i = 0; i < 4; ++i) { const int d = (lane >> 3) * 128 + (((lane & 7) ^ (4 * (i & 1) + lq)) * 16); *(LAS v4u*)(nb + SC_KDT + i * 1024 + d) = GX[8 + i]; } \
            _Pragma("unroll") for (int i = 0; i < 2; ++i) { const int d = (lane >> 3) * 128 + (((lane & 7) ^ (4 * i + lq)) * 16); *(LAS v4u*)(nb - hw * 2048 + SC_A + i * 1024 + d) = GX[12 + i]; } \
            if (hw == 0) *(LAS v4u*)(nv + lane * 16) = GX[14]; } while (0)
#define HLP_ITER(c, GL, GW) do { \
            int lane = tid & 63; asm volatile("" : "+v"(lane)); \
            const int c2 = ((c) + 2 < 128) ? (c) + 2 : 127; \
            HLP_LOAD(GL, c2); \
            HLP_STORE(GW, ((c) + 1) & 1); \
            SCAN_BAR(); } while (0)
        { int lane = tid & 63; asm volatile("" : "+v"(lane)); HLP_LOAD(G1, 1); }
        for (int c = 0; c < 128; c += 2) { HLP_ITER(c, G0, G1); HLP_ITER(c + 1, G1, G0); }
    } else {
        for (int c = 0; c < 128; ++c) SCAN_BAR();
    }
    __syncthreads();
}

__device__ __forceinline__ void mixnorm_row(bf16_t* mrow, const bf16_t* prow, const float (&gn)[32], int lane) {
    const int c0 = 32 * lane;
    const bf16_t* gp = prow + (c0 < 1024 ? C_AG + c0 : C_BZ + c0 - 1024);
    v4u o4[4], z4[4];
#pragma unroll
    for (int i = 0; i < 4; ++i) { o4[i] = *(const v4u*)(mrow + c0 + 8 * i); z4[i] = *(const v4u*)(gp + 8 * i); }
    float ss = 0.f;
#pragma unroll
    for (int i = 0; i < 4; ++i)
#pragma unroll
        for (int w = 0; w < 4; ++w) { const unsigned a = (w == 0) ? o4[i].x : (w == 1) ? o4[i].y : (w == 2) ? o4[i].z : o4[i].w;
            const float lo = __uint_as_float(a << 16), hi = __uint_as_float(a & 0xffff0000u); ss += lo * lo + hi * hi; }
    ss += __shfl_xor(ss, 1); ss += __shfl_xor(ss, 2);
    const float rstd = rsqrtf(ss * (1.f / 128.f) + EPS);
#pragma unroll
    for (int i = 0; i < 4; ++i) { float yv[8];
#pragma unroll
        for (int w = 0; w < 4; ++w) { const unsigned a = (w == 0) ? o4[i].x : (w == 1) ? o4[i].y : (w == 2) ? o4[i].z : o4[i].w;
            const unsigned z = (w == 0) ? z4[i].x : (w == 1) ? z4[i].y : (w == 2) ? z4[i].z : z4[i].w;
            yv[2 * w] = __uint_as_float(a << 16) * rstd * gn[8 * i + 2 * w] * __uint_as_float(z << 16);
            yv[2 * w + 1] = __uint_as_float(a & 0xffff0000u) * rstd * gn[8 * i + 2 * w + 1] * __uint_as_float(z & 0xffff0000u); }
        v4u y4; y4.x = pk2(yv[0], yv[1]); y4.y = pk2(yv[2], yv[3]); y4.z = pk2(yv[4], yv[5]); y4.w = pk2(yv[6], yv[7]);
        *(v4u*)(mrow + c0 + 8 * i) = y4; }
}

struct EpiProj {
    static constexpr bool PERM = true, AFTER_DRAIN = false;
    bf16_t* O; int ldc;
    __device__ __forceinline__ void operator()(const pg8::f32x4 (&acc)[2][2][4][2], const pg8::Unit& u, int wr, int wc, int fr, int fq) const {
        const int row0 = u.pm * 256 + wr * 64 + fr, col0 = u.pn * 256 + wc * 32 + 8 * fq;
        const bool gate = (u.pn >= 12 && u.pn < 16) || (u.pn >= 24);
#pragma unroll
        for (int ai = 0; ai < 2; ++ai)
#pragma unroll
            for (int m = 0; m < 4; ++m) { bf16_t* rowp = O + (size_t)(row0 + ai * 128 + m * 16) * ldc + col0;
#pragma unroll
                for (int bj = 0; bj < 2; ++bj) { pg8::f32x4 v0 = acc[ai][bj][m][0], v1 = acc[ai][bj][m][1];
                    if (gate) {
#pragma unroll
                        for (int e = 0; e < 4; ++e) { v0[e] = v0[e] * __builtin_amdgcn_rcpf(1.f + __expf(-v0[e])); v1[e] = v1[e] * __builtin_amdgcn_rcpf(1.f + __expf(-v1[e])); } }
                    pg8::u32x4 w; w.x = pk2(v0[0], v0[1]); w.y = pk2(v0[2], v0[3]); w.z = pk2(v1[0], v1[1]); w.w = pk2(v1[2], v1[3]);
                    *(pg8::u32x4*)(rowp + bj * 128) = w; } }
    }
};
struct EpiResF32 {
    static constexpr bool PERM = false, AFTER_DRAIN = false;
    const float* R; float* O; int ldc;
    __device__ __forceinline__ void operator()(const pg8::f32x4 (&acc)[2][2][4][2], const pg8::Unit& u, int wr, int wc, int fr, int fq) const {
        const int row0 = u.pm * 256 + wr * 64 + fr, col0 = u.pn * 256 + wc * 32 + 4 * fq;
#pragma unroll
        for (int ai = 0; ai < 2; ++ai)
#pragma unroll
            for (int m = 0; m < 4; ++m) { const size_t off = (size_t)(row0 + ai * 128 + m * 16) * ldc + col0;
#pragma unroll
                for (int bj = 0; bj < 2; ++bj)
#pragma unroll
                    for (int n = 0; n < 2; ++n) { pg8::f32x4 v = acc[ai][bj][m][n]; if (R) v = v + *(const pg8::f32x4*)(R + off + bj * 128 + n * 16); *(pg8::f32x4*)(O + off + bj * 128 + n * 16) = v; } }
    }
};

#define XB_TMO      128
#define XB_XCNT(j)  (256  + 64 * (j))
#define XB_XSUB(j)  (1280 + 64 * (j))
#define XB_XGEN(j)  (2304 + 64 * (j))
#define XB_TOP      3328
#define XB_TOPGEN   3392
#define XCD_BAR_WORDS 3456
#define XB_SPIN_CAP (1u << 18)

__device__ __forceinline__ unsigned xb_ld(unsigned* p)              { return __hip_atomic_load(p, __ATOMIC_RELAXED, __HIP_MEMORY_SCOPE_AGENT); }
__device__ __forceinline__ unsigned xb_add(unsigned* p, unsigned v) { return __hip_atomic_fetch_add(p, v, __ATOMIC_RELAXED, __HIP_MEMORY_SCOPE_AGENT); }
__device__ __forceinline__ unsigned xb_xcc_id() { return (unsigned)__builtin_amdgcn_s_getreg((3 << 11) | 20) & 0xFu; }
#define XB_SPIN(cond, bar) do { unsigned _sp = 0; while (cond) { __builtin_amdgcn_s_sleep(1); \
    if ((++_sp & 255u) == 0u) { if (xb_ld(&(bar)[XB_TMO])) break; if (_sp > XB_SPIN_CAP) { atomicAdd(&(bar)[XB_TMO], 1u); break; } } } } while (0)

struct XcdBarrier {
    unsigned* bar; unsigned x;
    volatile LAS unsigned* st;
};

__device__ __forceinline__ XcdBarrier xcd_barrier_post(unsigned* bar, volatile LAS unsigned* st) {
    XcdBarrier b; b.bar = bar; b.x = xb_xcc_id(); b.st = st;
    if (threadIdx.x == 0) (void)xb_add(&bar[XB_XCNT(b.x)], 1u);
    return b;
}
__device__ __forceinline__ void xcd_barrier_complete(unsigned* bar, unsigned x, unsigned& nloc, unsigned& nx) {
    const unsigned G = gridDim.x * gridDim.y * gridDim.z;
    unsigned sum, cnt, mine, sp = 0u;
    for (;;) {
        sum = 0u; cnt = 0u; mine = 0u;
#pragma unroll
        for (unsigned j = 0; j < 16; ++j) { const unsigned c = xb_ld(&bar[XB_XCNT(j)]); sum += c; cnt += (c > 0u) ? 1u : 0u; mine = (j == x) ? c : mine; }
        if (sum == G) break;
        __builtin_amdgcn_s_sleep(1);
        if ((++sp & 255u) == 0u) { if (xb_ld(&bar[XB_TMO])) break; if (sp > XB_SPIN_CAP) { atomicAdd(&bar[XB_TMO], 1u); break; } }
    }
    nloc = mine > 0u ? mine : 1u; nx = cnt > 0u ? cnt : 1u;
}

__device__ __forceinline__ void xcd_barrier(const XcdBarrier& b) {
    asm volatile("s_waitcnt vmcnt(0)" ::: "memory");
    __syncthreads();
    if (threadIdx.x == 0) {
        unsigned* bar = b.bar;
        __builtin_amdgcn_s_waitcnt(0);
        unsigned nloc = b.st[0], nx = b.st[1];
        if (nloc == 0u) { xcd_barrier_complete(bar, b.x, nloc, nx); b.st[0] = nloc; b.st[1] = nx; }
        const unsigned old = xb_add(&bar[XB_XSUB(b.x)], 1u);
        const unsigned gen = old / nloc;
        if (old + 1u == (gen + 1u) * nloc) {
            __builtin_amdgcn_fence(__ATOMIC_RELEASE, "agent");
            asm volatile("s_waitcnt vmcnt(0)" ::: "memory");
            const unsigned og = xb_add(&bar[XB_TOP], 1u);
            const unsigned tg = og / nx;
            if (og + 1u == (tg + 1u) * nx) xb_add(&bar[XB_TOPGEN], 1u);
            else XB_SPIN(xb_ld(&bar[XB_TOPGEN]) == tg, bar);
            __builtin_amdgcn_fence(__ATOMIC_ACQUIRE, "agent");
            xb_add(&bar[XB_XGEN(b.x)], 1u);
            asm volatile("s_waitcnt vmcnt(0)" ::: "memory");
        } else {
            XB_SPIN(xb_ld(&bar[XB_XGEN(b.x)]) == gen, bar);
            __builtin_amdgcn_fence(__ATOMIC_ACQUIRE, "agent");
            asm volatile("s_waitcnt vmcnt(0)" ::: "memory");
        }
    }
    __syncthreads();
}

__device__ __forceinline__ int get_lane() { int l = (int)__builtin_amdgcn_mbcnt_hi(~0u, __builtin_amdgcn_mbcnt_lo(~0u, 0u)); asm volatile("" : "+v"(l)); return l; }
__global__ void __launch_bounds__(NT, 2) mk_fwd(Args args) {
    extern __shared__ __attribute__((aligned(16))) unsigned char lds_raw[];
    LAS unsigned char* lds = (LAS unsigned char*)lds_raw;
    cg::grid_group grid = cg::this_grid();
    const int tid = threadIdx.x, wave = __builtin_amdgcn_readfirstlane(tid >> 6);

    const int G = gridDim.x, bx = blockIdx.x;
    const int vcu = (G % 8 == 0) ? (bx % 8) * (G / 8) + bx / 8 : bx;
    const int gw = vcu * NW + wave, NGW = G * NW;
    unsigned char* ws = args.ws;
    const float* x = args.in[0]; const float* attn_g = args.in[1]; const float* w_in = args.in[2];
    const float* w_out = args.in[9]; const float* ffn_g = args.in[10]; const float* w_query = args.in[11]; const float* sub_keys = args.in[12];
    bf16_t* WinT = (bf16_t*)(ws + OFF_D);
    bf16_t* WoutT = (bf16_t*)(ws + OFF_C);
    bf16_t* Wqk = (bf16_t*)(ws + OFF_C + 8 * MiB);
    bf16_t* xn = (bf16_t*)(ws + OFF_D + 28 * MiB);
    float* ba = (float*)(ws + OFF_S);
    bf16_t* proj = (bf16_t*)(ws + OFF_B);
    bf16_t* mix = (bf16_t*)args.out;
    unsigned char* pb = ws + OFF_D; float* vecs = (float*)(ws + OFF_S + 2 * MiB);
    float* hbuf = (float*)(ws + OFF_B);
    bf16_t* hn = (bf16_t*)(ws + OFF_D + 128 * MiB);
    float* scores = (float*)(ws + OFF_D);
    unsigned char* U8 = ws + OFF_TAB; unsigned char* V8 = ws + OFF_TAB + 16 * MiB;
    float* inv_su = (float*)(ws + OFF_S + 1 * MiB); float* inv_sv = inv_su + 16384;

    volatile LAS unsigned* xbst = (volatile LAS unsigned*)(lds + LDS_BYTES - 16);
    if (tid < 4) xbst[tid] = 0u;
    __syncthreads();
    XcdBarrier xbar = xcd_barrier_post((unsigned*)args.ws, xbst);
    const int lo = args.ph_lo, hi = args.ph_hi;
#define IN(k) (lo <= (k) && (k) < hi)
#define SYNC_AFTER(k) do { if (IN(k) && (k) + 1 < hi) { if ((k) == 0) grid.sync(); else xcd_barrier(xbar); } } while (0)
    {
        if (IN(0)) {
            const int lane = get_lane();
            LAS float* scr = (LAS float*)(lds + wave * 16384);
            constexpr int I_IN = (DM / 64) * (NPROJ / 32);
            for (int it = gw; it < I_IN; it += NGW) transpose_item(w_in, INW, DM, NPROJ, WinT, scr, it, lane);
            __syncthreads();
            {
                LAS float* wt = (LAS float*)lds;
#pragma unroll
                for (int k = 0; k < 4; ++k) { const int d = tid + 512 * k; const float* wr = w_in + (size_t)d * INW + NPROJ;
#pragma unroll
                    for (int q4 = 0; q4 < 4; ++q4) { const f32x4 w4 = *(const f32x4*)(wr + 4 * q4);
                        wt[(4 * q4 + 0) * 2048 + d] = w4.x; wt[(4 * q4 + 1) * 2048 + d] = w4.y; wt[(4 * q4 + 2) * 2048 + d] = w4.z; wt[(4 * q4 + 3) * 2048 + d] = w4.w; } }
            }
            __syncthreads();
            for (int m = gw; m < T; m += NGW) norm_row<true>(x + (size_t)m * DM, attn_g, (const LAS float*)lds, xn + (size_t)m * DM, ba + (size_t)m * 16, lane);
        }
        SYNC_AFTER(0);
        if (IN(1)) {
            pg8::Gemm g{xn, WinT, T, NPROJ, DM}; pg8::StaticOrder S; S.init(T, NPROJ, G, bx);
            EpiProj E{proj, NPROJ};
            pg8::gemm_phase<EpiProj, pg8::StaticOrder, true, true>(lds, g, S, E);
        }
        SYNC_AFTER(1);
        if (IN(2)) {
            for (int it = bx; it < 2048; it += G) { int tt = threadIdx.x; asm volatile("" : "+v"(tt)); hgrn_prep_item(it, proj, args.in[3], pb, vecs, lds, tt); }
            for (int it = bx; it < 1024; it += G) { int tt = threadIdx.x; asm volatile("" : "+v"(tt)); gdn_prep_item(it, proj, ba, args.in[5], args.in[6], args.in[7], pb, vecs, lds, tt); }
        }
        SYNC_AFTER(2);
        if (IN(3)) {
            const int lane = get_lane();
            unsigned* ctl = (unsigned*)args.ws;
            if (bx < NSB) scan_block((bx & 7) + 8 * (bx / (8 * (4 / NCW))), (bx >> 3) % (4 / NCW), proj, pb, vecs, args.in[4], args.in[8], mix, ctl + PROG_WORD, lds, tid);
            else if (G > NSB) {
                int fb, FB;
                fb = bx - NSB; FB = G - NSB;
                const int fw = fb * NW + wave, FW = FB * NW;
                for (int it = fb; it < 512; it += FB) wqk_item(w_query, sub_keys, Wqk, (LAS float*)lds, it, tid);
                LAS float* scr = (LAS float*)(lds + wave * 16384);
                constexpr int I_OUT = (DM / 64) * (DM / 32);
                for (int it = fw; it < I_OUT; it += FW) transpose_item(w_out, DM, DM, DM, WoutT, scr, it, lane);
                for (int e = fw; e < 32768; e += FW) { const bool isv = e >= 16384; const int r = e & 16383;
                    table_row((isv ? args.in[14] : args.in[13]) + (size_t)r * DM, (unsigned*)((isv ? V8 : U8) + (size_t)r * 1024), (isv ? inv_sv : inv_su) + r, lane); }
            }
        }
        SYNC_AFTER(3);
        if (IN(4)) {
            {
                const int lane = get_lane();
                float gn[32];
                { const float* gsrc = ((32 * lane) < 1024 ? args.in[4] : args.in[8]) + ((32 * lane) & 127);
#pragma unroll
                  for (int i = 0; i < 8; ++i) { const f32x4 g4 = *(const f32x4*)(gsrc + 4 * i); gn[4 * i] = g4.x; gn[4 * i + 1] = g4.y; gn[4 * i + 2] = g4.z; gn[4 * i + 3] = g4.w; } }
                for (int m = gw; m < T; m += NGW) mixnorm_row(mix + (size_t)m * DM, proj + (size_t)m * NPROJ, gn, lane);
                xcd_barrier(xbar);
            }
            pg8::Gemm g{mix, WoutT, T, DM, DM}; pg8::StaticOrder S; S.init(T, DM, G, bx);
            EpiResF32 E{x, hbuf, DM};
            pg8::gemm_phase<EpiResF32, pg8::StaticOrder, true, true>(lds, g, S, E);
        }
        SYNC_AFTER(4);
        if (IN(5)) {
            const int lane = get_lane();
            for (int m = gw; m < T; m += NGW) norm_row<false>(hbuf + (size_t)m * DM, ffn_g, (const LAS float*)lds, hn + (size_t)m * DM, nullptr, lane);
        }
        SYNC_AFTER(5);
        if (IN(6)) {
            pg8::Gemm g{hn, Wqk, T, DM, DM}; pg8::StaticOrder S; S.init(T, DM, G, bx);
            EpiResF32 E{nullptr, scores, DM};
            pg8::gemm_phase<EpiResF32, pg8::StaticOrder, true, true>(lds, g, S, E);
        }
        SYNC_AFTER(6);
        if (IN(7)) {
            const int lane = get_lane();
            LAS int* se = (LAS int*)(lds + wave * 4096); LAS float* sa = (LAS float*)(lds + wave * 4096 + 512); LAS float* sb = (LAS float*)(lds + wave * 4096 + 1024);
            for (int t = gw; t < T; t += NGW) { const int ln = get_lane(); peer_token(t, scores, hn, hbuf, U8, V8, inv_su, inv_sv, args.in[15], args.out, se, sa, sb, ln); }
        }
    }
}
}

extern "C" void kernel_launch(void* const* d_in, const int* in_sizes, int n_in, void* d_out, int out_size, void* d_ws, size_t ws_size, hipStream_t stream) {
    static int grid = 0;
    if (grid == 0) {
        int dev = 0, cus = 0, per_cu = 0;
        (void)hipGetDevice(&dev);
        (void)hipDeviceGetAttribute(&cus, hipDeviceAttributeMultiprocessorCount, dev);
        (void)hipFuncSetAttribute((const void*)mk::mk_fwd, hipFuncAttributeMaxDynamicSharedMemorySize, mk::LDS_BYTES);
        (void)hipOccupancyMaxActiveBlocksPerMultiprocessor(&per_cu, (const void*)mk::mk_fwd, mk::NT, mk::LDS_BYTES);
        if (per_cu < 1) { fprintf(stderr, "occupancy query says %d\n", per_cu); per_cu = 1; }
        grid = cus;
    }
    unsigned char* ws = (unsigned char*)d_ws;
    (void)hipMemsetAsync(d_ws, 0, 16384, stream);
    mk::Args a{};
    for (int i = 0; i < 16; ++i) a.in[i] = (const float*)d_in[i];
    a.out = (float*)d_out; a.ws = ws;
    {
        a.ph_lo = 0; a.ph_hi = 8;
        void* kargs[] = {&a};
        hipError_t e = hipLaunchCooperativeKernel((const void*)mk::mk_fwd, dim3(grid), dim3(mk::NT), kargs, mk::LDS_BYTES, stream);
        if (e != hipSuccess) fprintf(stderr, "coop launch failed: %s\n", hipGetErrorString(e));
    }
}
```

```cpp
#include <hip/hip_runtime.h>
#include <hip/hip_cooperative_groups.h>
#include <cstdio>
namespace cg = cooperative_groups;
#include <stdint.h>

typedef unsigned short bf16_t;
typedef float f32x4 __attribute__((ext_vector_type(4)));

constexpr int T = 16384, SEQ = 8192, DM = 2048, INW = 7184, NPROJ = 7168;
constexpr float EPS = 1e-6f;
constexpr size_t MiB = 1u << 20;
constexpr size_t OFF_TAB = 1 * MiB;
constexpr size_t OFF_B = 65 * MiB;
constexpr size_t OFF_C = 289 * MiB;
constexpr size_t OFF_D = 305 * MiB;
constexpr size_t OFF_S = 500 * MiB;
constexpr int C_AQ = 0, C_AF = 1024, C_AI = 2048, C_AG = 3072, C_BQ = 4096, C_BK = 4608, C_BV = 5120, C_BZ = 6144;

__device__ __forceinline__ float bf2f(bf16_t v) { return __uint_as_float(((unsigned)v) << 16); }
typedef float f32x2_t __attribute__((ext_vector_type(2)));
typedef __bf16 bf16x2_t __attribute__((ext_vector_type(2)));
__device__ __forceinline__ unsigned cvt_pk2(float lo, float hi) { f32x2_t v = {lo, hi}; bf16x2_t b = __builtin_convertvector(v, bf16x2_t); return __builtin_bit_cast(unsigned, b); }
__device__ __forceinline__ bf16_t f2bf(float f) { return (bf16_t)(cvt_pk2(f, 0.f) & 0xffffu); }
__device__ __forceinline__ float sigmoidf_(float x) { return 1.f / (1.f + __expf(-x)); }
__device__ __forceinline__ float siluf_(float x) { return x / (1.f + __expf(-x)); }
__device__ __forceinline__ float wave_sum(float v) {
#pragma unroll
    for (int o = 1; o < 64; o <<= 1) v += __shfl_xor(v, o);
    return v;
}
__device__ __forceinline__ float block_sum(float v, float* sh) {
    v = wave_sum(v);
    const int w = threadIdx.x >> 6, nw = blockDim.x >> 6;
    __syncthreads();
    if ((threadIdx.x & 63) == 0) sh[w] = v;
    __syncthreads();
    float r = 0.f;
    for (int i = 0; i < nw; ++i) r += sh[i];
    return r;
}

__device__ __forceinline__ float gelu_erf(float x) { return 0.5f * x * (1.f + erff(x * 0.70710678118654752f)); }
namespace pg8 {
#define PG8_LAS __attribute__((address_space(3)))
typedef unsigned short bf16_t;
typedef short bf16x8 __attribute__((ext_vector_type(8)));
typedef float f32x4 __attribute__((ext_vector_type(4)));
typedef unsigned u32x4 __attribute__((ext_vector_type(4)));
constexpr int BM = 256, BK = 64, HALF = 128, HTB = HALF * BK * 2  , STAGE_BYTES = 8 * HTB, NXCD = 8, WGM = 8;

__host__ __device__ __forceinline__ int lds_byte(int r, int c) { const int st = (r >> 4) * 2 + (c >> 5), rr = r & 15, cc = c & 31, ob = rr * 64 + cc * 2; return st * 1024 + (ob ^ (((ob >> 9) & 1) << 5)); }
__host__ __device__ __forceinline__ void stage_rc(int b, int& R, int& C) { const int st = b / 1024, sb = b % 1024, swz = sb ^ (((sb >> 9) & 1) << 5); R = (st >> 1) * 16 + swz / 64; C = (st & 1) * 32 + (swz % 64) / 2; }
__host__ __device__ __forceinline__ int perm32(int rho) { const int n = rho >> 4, i = rho & 15; return 8 * (i >> 2) + 4 * n + (i & 3); }

struct Unit { int pm, pn; };
struct Gemm { const bf16_t* A; const bf16_t* Bt; int M, N, K; };

struct StaticOrder {
    int nM, nN, nwg, G, c;
    __host__ __device__ void init(int M, int N, int G_, int c_) { nM = M / BM; nN = N / BM; nwg = nM * nN; G = G_; c = c_; }
    __host__ __device__ bool next(int i, Unit& u) const {
        const long L = (long)i * G + c; if (L >= nwg) return false;
        int wgid = (int)L; { const int q = nwg / NXCD, r = nwg % NXCD, xcd = wgid % NXCD, off = wgid / NXCD; wgid = (xcd < r ? xcd * (q + 1) : r * (q + 1) + (xcd - r) * q) + off; }
        const int nig = WGM * nN, gid = wgid / nig, fm = gid * WGM, gsz = (nM - fm) < WGM ? (nM - fm) : WGM;
        u.pm = fm + ((wgid % nig) % gsz); u.pn = (wgid % nig) / gsz; return true;
    }
    __device__ __forceinline__ void a_ready(const Unit&) const {}
    __device__ __forceinline__ void done(const Unit&) const {}
};

__device__ __forceinline__ unsigned cvt_pk_bf16(float lo, float hi) { unsigned r; asm volatile("v_cvt_pk_bf16_f32 %0, %1, %2" : "=v"(r) : "v"(lo), "v"(hi)); return r; }
typedef float f32x2 __attribute__((ext_vector_type(2)));
__device__ __forceinline__ f32x2 gelu_pk(f32x2 v) {
    const f32x2 av = __builtin_elementwise_abs(v), d = av * 0.2316418882f + 1.0f;
    f32x2 t; t.x = __builtin_amdgcn_rcpf(d.x); t.y = __builtin_amdgcn_rcpf(d.y);
    f32x2 q = t * 0.5307027145f + (-0.7265760135f); q = q * t + 0.7107068705f; q = q * t + (-0.142248368f); q = q * t + 0.127414796f; q = q * t;
    const f32x2 s = (v * v) * (-0.72134752044f);
    f32x2 e; e.x = __builtin_amdgcn_exp2f(s.x); e.y = __builtin_amdgcn_exp2f(s.y);
    const f32x2 m = v * (q * e), r = v - m;
    f32x2 o; o.x = v.x < 0.f ? m.x : r.x; o.y = v.y < 0.f ? m.y : r.y; return o;
}

template <int ACT  > struct EpiBf16 {
    static constexpr bool PERM = true, AFTER_DRAIN = false; static_assert(ACT == 0 || ACT == 1, "EpiBf16: ACT is 0 (none) or 1 (gelu_pk)");
    bf16_t* O; int ldc; const float* bias; int split_cols; size_t split_stride; float scale0;
    __device__ __forceinline__ void operator()(const f32x4 (&acc)[2][2][4][2], const Unit& u, int wr, int wc, int fr, int fq) const {
        const int row0 = u.pm * BM + wr * 64 + fr; int colt = u.pn * BM; bf16_t* base = O;
        float sc = 1.f; if (split_cols) { const int t = colt / split_cols; base += (size_t)t * split_stride; colt -= t * split_cols; if (t == 0) sc = scale0; }
        const int col0 = colt + wc * 32 + 8 * fq, bcol0 = u.pn * BM + wc * 32 + 8 * fq;
        f32x4 bv[2][2];
#pragma unroll
        for (int bj = 0; bj < 2; ++bj)
#pragma unroll
            for (int n = 0; n < 2; ++n) bv[bj][n] = bias ? *(const f32x4*)(bias + bcol0 + bj * HALF + 4 * n) : (f32x4){0.f, 0.f, 0.f, 0.f};
#pragma unroll
        for (int ai = 0; ai < 2; ++ai)
#pragma unroll
            for (int m = 0; m < 4; ++m) { bf16_t* rowp = base + (size_t)(row0 + ai * HALF + m * 16) * ldc + col0;
#pragma unroll
                for (int bj = 0; bj < 2; ++bj) { f32x4 v0 = acc[ai][bj][m][0] + bv[bj][0], v1 = acc[ai][bj][m][1] + bv[bj][1];
                    if (ACT == 1) { f32x2 a = gelu_pk((f32x2){v0[0], v0[1]}), b = gelu_pk((f32x2){v0[2], v0[3]}), c = gelu_pk((f32x2){v1[0], v1[1]}), d = gelu_pk((f32x2){v1[2], v1[3]});
                        v0 = (f32x4){a.x, a.y, b.x, b.y}; v1 = (f32x4){c.x, c.y, d.x, d.y}; }
                    v0 = v0 * sc; v1 = v1 * sc; u32x4 w; w.x = cvt_pk_bf16(v0[0], v0[1]); w.y = cvt_pk_bf16(v0[2], v0[3]); w.z = cvt_pk_bf16(v1[0], v1[1]); w.w = cvt_pk_bf16(v1[2], v1[3]);
                    *(u32x4*)(rowp + bj * HALF) = w; } }
    }
};
template <class Epi, class Sched, bool ALIGN_EPI = false, bool SP2 = false>
__device__ __forceinline__ void gemm_phase(PG8_LAS unsigned char* lds, const Gemm g, const Sched& S, const Epi& E) {
    const int tid = threadIdx.x, wid = __builtin_amdgcn_readfirstlane(tid >> 6), lane = tid & 63, wr = wid >> 2, wc = wid & 3, fr = lane & 15, fq = lane >> 4;
    const int K = g.K, nt = K / BK;
    unsigned voffA[2], voffB[2];
#pragma unroll
    for (int i = 0; i < 2; ++i) { int R, C; stage_rc(tid * 16 + i * 8192, R, C); const int Rb = Epi::PERM ? ((R & ~31) + perm32(R & 31)) : R;
        voffA[i] = (unsigned)(R * K + C) * 2u; voffB[i] = (unsigned)(Rb * K + C) * 2u; }
    const size_t kstep = (size_t)(BK * 2);
    const size_t hstep = (size_t)HALF * K * 2;
    const size_t tstep = 2 * hstep;
    const unsigned ldsw = (unsigned)wid * 1024u;
    const int aoff = lds_byte(wr * 64 + fr, fq * 8), boff = lds_byte(wc * 32 + fr, fq * 8);
#define PG8_SA(b, h) (((b) * 2 + (h)) * HTB)
#define PG8_SB(b, h) ((4 + (b) * 2 + (h)) * HTB)
#define PG8_STAGE(bufoff, gbase, voff) do { _Pragma("unroll") for (int _i = 0; _i < 2; ++_i) \
        __builtin_amdgcn_global_load_lds((const unsigned*)((const char*)(gbase) + (voff)[_i]), (PG8_LAS unsigned*)(lds + (bufoff) + ldsw + _i * 8192), 16, 0, 0); } while (0)
#define PG8_LDA(dst, b, h) do { _Pragma("unroll") for (int m = 0; m < 4; ++m) _Pragma("unroll") for (int k = 0; k < 2; ++k) dst[m][k] = *(const PG8_LAS bf16x8*)(lds + PG8_SA(b, h) + aoff + m * 2048 + k * 1024); } while (0)
#define PG8_LDB(dst, b, h) do { _Pragma("unroll") for (int n = 0; n < 2; ++n) _Pragma("unroll") for (int k = 0; k < 2; ++k) dst[n][k] = *(const PG8_LAS bf16x8*)(lds + PG8_SB(b, h) + boff + n * 2048 + k * 1024); } while (0)
#define PG8_MMA(ai, bj, At, Bt) do { __builtin_amdgcn_s_setprio(1); _Pragma("unroll") for (int m = 0; m < 4; ++m) _Pragma("unroll") for (int n = 0; n < 2; ++n) _Pragma("unroll") for (int k = 0; k < 2; ++k) \
        acc[ai][bj][m][n] = __builtin_amdgcn_mfma_f32_16x16x32_bf16(Bt[n][k], At[m][k], acc[ai][bj][m][n], 0, 0, 0); __builtin_amdgcn_s_setprio(0); } while (0)
#define PG8_WAIT_V(n) asm volatile("s_waitcnt vmcnt(" #n ")" ::: "memory")
#define PG8_WAIT_L(n) asm volatile("s_waitcnt lgkmcnt(" #n ")" ::: "memory")
#define PG8_BAR __builtin_amdgcn_s_barrier()
#define PG8_SCHED __builtin_amdgcn_sched_barrier(0)
    Unit cur, nxt; int ui = 0;
    if (!S.next(0, cur)) return;
    f32x4 acc[2][2][4][2];
#pragma unroll
    for (int a = 0; a < 2; ++a)
#pragma unroll
        for (int b = 0; b < 2; ++b)
#pragma unroll
            for (int m = 0; m < 4; ++m)
#pragma unroll
                for (int n = 0; n < 2; ++n) acc[a][b][m][n] = (f32x4){0.f, 0.f, 0.f, 0.f};
    bf16x8 At[4][2], B0[2][2], B1[2][2];
    const char* cA = (const char*)g.A + (size_t)cur.pm * tstep; const char* cB = (const char*)g.Bt + (size_t)cur.pn * tstep;
    S.a_ready(cur);
    if constexpr (SP2) {
        PG8_STAGE(PG8_SB(0, 0), cB, voffB); PG8_STAGE(PG8_SB(0, 1), cB + hstep, voffB); PG8_STAGE(PG8_SA(0, 0), cA, voffA); PG8_STAGE(PG8_SA(0, 1), cA + hstep, voffA);
        if (wr == 1) PG8_BAR;
        PG8_WAIT_V(2); PG8_BAR;
        PG8_STAGE(PG8_SB(1, 0), cB + kstep, voffB); PG8_STAGE(PG8_SA(1, 0), cA + kstep, voffA); PG8_STAGE(PG8_SB(1, 1), cB + hstep + kstep, voffB);
        PG8_WAIT_V(6); PG8_BAR;
    } else {
        PG8_STAGE(PG8_SB(0, 0), cB, voffB); PG8_STAGE(PG8_SA(0, 0), cA, voffA); PG8_STAGE(PG8_SB(0, 1), cB + hstep, voffB); PG8_STAGE(PG8_SA(0, 1), cA + hstep, voffA);
        if (wr == 1) PG8_BAR;
        PG8_WAIT_V(4); PG8_BAR;
        PG8_STAGE(PG8_SB(1, 0), cB + kstep, voffB); PG8_STAGE(PG8_SA(1, 0), cA + kstep, voffA); PG8_STAGE(PG8_SB(1, 1), cB + hstep + kstep, voffB);
        PG8_WAIT_V(6); PG8_BAR;
    }
    for (;;) {
        const bool has_next = S.next(ui + 1, nxt);
        const char* nA = has_next ? (const char*)g.A + (size_t)nxt.pm * tstep : cA; const char* nB = has_next ? (const char*)g.Bt + (size_t)nxt.pn * tstep : cB;
        for (int t = 0; t < nt; t += 2) {
            const bool last = (t == nt - 2);
            const char* a1 = cA + (size_t)(t + 1) * kstep;
            const char* a2 = last ? nA : cA + (size_t)(t + 2) * kstep; const char* b2 = last ? nB : cB + (size_t)(t + 2) * kstep;
            const char* a3 = a2 + kstep; const char* b3 = b2 + kstep;
            if (last && has_next) S.a_ready(nxt);
            if constexpr (SP2) {
            PG8_LDB(B0, 0, 0); PG8_LDB(B1, 0, 1); PG8_SCHED; PG8_LDA(At, 0, 0); PG8_STAGE(PG8_SA(1, 1), a1 + hstep, voffA);
            PG8_WAIT_V(8); PG8_WAIT_L(0); PG8_BAR; PG8_MMA(0, 0, At, B0); PG8_MMA(0, 1, At, B1); PG8_BAR; PG8_SCHED;
            PG8_LDA(At, 0, 1); PG8_STAGE(PG8_SB(0, 0), b2, voffB); PG8_STAGE(PG8_SB(0, 1), b2 + hstep, voffB); PG8_STAGE(PG8_SA(0, 0), a2, voffA);
            PG8_WAIT_V(8); PG8_WAIT_L(0); PG8_BAR; PG8_MMA(1, 0, At, B0); PG8_MMA(1, 1, At, B1); PG8_BAR; PG8_SCHED;
            PG8_LDB(B0, 1, 0); PG8_LDB(B1, 1, 1); PG8_SCHED; PG8_LDA(At, 1, 0); PG8_STAGE(PG8_SA(0, 1), a2 + hstep, voffA);
            PG8_WAIT_V(8); PG8_WAIT_L(0); PG8_BAR; PG8_MMA(0, 0, At, B0); PG8_MMA(0, 1, At, B1); PG8_BAR; PG8_SCHED;
            PG8_LDA(At, 1, 1); PG8_STAGE(PG8_SB(1, 0), b3, voffB); PG8_STAGE(PG8_SB(1, 1), b3 + hstep, voffB); PG8_STAGE(PG8_SA(1, 0), a3, voffA);
            PG8_WAIT_V(8); PG8_WAIT_L(0); PG8_BAR; PG8_MMA(1, 0, At, B0); PG8_MMA(1, 1, At, B1); PG8_BAR; PG8_SCHED;
            } else {
            PG8_LDB(B0, 0, 0); PG8_SCHED; PG8_LDA(At, 0, 0); PG8_STAGE(PG8_SA(1, 1), a1 + hstep, voffA);
            PG8_WAIT_L(8); PG8_BAR; PG8_WAIT_L(0); PG8_MMA(0, 0, At, B0); PG8_BAR; PG8_SCHED;
            PG8_LDB(B1, 0, 1); PG8_STAGE(PG8_SB(0, 0), b2, voffB);
            PG8_BAR; PG8_WAIT_L(0); PG8_MMA(0, 1, At, B1); PG8_BAR;
            PG8_LDA(At, 0, 1); PG8_STAGE(PG8_SA(0, 0), a2, voffA);
            PG8_BAR; PG8_WAIT_L(0); PG8_MMA(1, 0, At, B0); PG8_BAR; PG8_SCHED;
            PG8_STAGE(PG8_SB(0, 1), b2 + hstep, voffB);
            PG8_WAIT_V(6); PG8_BAR; PG8_MMA(1, 1, At, B1); PG8_BAR;
            PG8_LDB(B0, 1, 0); PG8_SCHED; PG8_LDA(At, 1, 0); PG8_STAGE(PG8_SA(0, 1), a2 + hstep, voffA);
            PG8_WAIT_L(8); PG8_BAR; PG8_WAIT_L(0); PG8_MMA(0, 0, At, B0); PG8_BAR; PG8_SCHED;
            PG8_LDB(B1, 1, 1); PG8_STAGE(PG8_SB(1, 0), b3, voffB);
            PG8_BAR; PG8_WAIT_L(0); PG8_MMA(0, 1, At, B1); PG8_BAR;
            PG8_LDA(At, 1, 1); PG8_STAGE(PG8_SA(1, 0), a3, voffA);
            PG8_BAR; PG8_WAIT_L(0); PG8_MMA(1, 0, At, B0); PG8_BAR; PG8_SCHED;
            PG8_STAGE(PG8_SB(1, 1), b3 + hstep, voffB);
            PG8_WAIT_V(6); PG8_BAR; PG8_MMA(1, 1, At, B1); PG8_BAR;
            }
        }
        if constexpr (ALIGN_EPI) { if (wr == 0) PG8_BAR; }
        if constexpr (!Epi::AFTER_DRAIN) { E(acc, cur, wr, wc, fr, fq); S.done(cur); }
        if (!has_next) break;
#pragma unroll
        for (int a = 0; a < 2; ++a)
#pragma unroll
            for (int b = 0; b < 2; ++b)
#pragma unroll
                for (int m = 0; m < 4; ++m)
#pragma unroll
                    for (int n = 0; n < 2; ++n) acc[a][b][m][n] = (f32x4){0.f, 0.f, 0.f, 0.f};
        cur = nxt; cA = nA; cB = nB; ++ui;
        if constexpr (ALIGN_EPI) { if (wr == 1) PG8_BAR; }
    }
    PG8_WAIT_V(0);
    if constexpr (!ALIGN_EPI) { if (wr == 0) PG8_BAR; }
    PG8_BAR;
    if constexpr (Epi::AFTER_DRAIN) { E.fused(acc, cur, wr, wc, fr, fq, lds, wid, lane); S.done(cur); }
#undef PG8_SA
#undef PG8_SB
#undef PG8_STAGE
#undef PG8_LDA
#undef PG8_LDB
#undef PG8_MMA
#undef PG8_WAIT_V
#undef PG8_WAIT_L
#undef PG8_BAR
#undef PG8_SCHED
}
}

namespace mk {
#define LAS __attribute__((address_space(3)))
#define GAS __attribute__((address_space(1)))
typedef unsigned v4u __attribute__((ext_vector_type(4)));
typedef unsigned v2u __attribute__((ext_vector_type(2)));
constexpr int NW = 8, NT = 512, LDS_BYTES = 163840, RING_BYTES = 131072;
#define LDS_WAIT() asm volatile("s_waitcnt lgkmcnt(0)" ::: "memory")
#define DPP_ROR_ADD(t, n) ((t) + __uint_as_float(__builtin_amdgcn_update_dpp(0u, __float_as_uint(t), 0x120 + (n), 0xf, 0xf, false)))
struct Args { const float* in[16]; float* out; unsigned char* ws; int ph_lo, ph_hi; };
__device__ __forceinline__ unsigned pk2(float lo, float hi) { return cvt_pk2(lo, hi); }

__device__ __forceinline__ void transpose_item(const float* W, int ld, int K, int ncols, bf16_t* WT, LAS float* scr, int item, int lane) {
    const int nblk = ncols / 32, kb = item / nblk, nb = item % nblk, k0 = 64 * kb, n0 = 32 * nb;
#pragma unroll 8
    for (int i = 0; i < 32; ++i) { const int kk = 2 * i + (lane >> 5); scr[kk * 33 + (lane & 31)] = W[(size_t)(k0 + kk) * ld + n0 + (lane & 31)]; }
    LDS_WAIT(); asm volatile("" ::: "memory");
    const int c = lane & 7;
#pragma unroll
    for (int j = 0; j < 4; ++j) { const int n = (lane >> 3) + 8 * j; const LAS float* s = scr + (8 * c) * 33 + n;
        v4u o; o.x = pk2(s[0 * 33], s[1 * 33]); o.y = pk2(s[2 * 33], s[3 * 33]); o.z = pk2(s[4 * 33], s[5 * 33]); o.w = pk2(s[6 * 33], s[7 * 33]);
        *(v4u*)(WT + (size_t)(n0 + n) * K + k0 + 8 * c) = o; }
    LDS_WAIT(); asm volatile("" ::: "memory");
}
template <bool WITH_BA>
__device__ __forceinline__ void norm_row(const float* xrow, const float* g, const LAS float* wt  , bf16_t* orow, float* barow, int lane) {
    f32x4 v[8]; float ss = 0.f;
#pragma unroll
    for (int j = 0; j < 8; ++j) { v[j] = ((const f32x4*)xrow)[64 * j + lane]; ss += (v[j].x * v[j].x + v[j].y * v[j].y) + (v[j].z * v[j].z + v[j].w * v[j].w); }
    ss = wave_sum(ss);
    const float rstd = rsqrtf(ss * (1.f / DM) + EPS);
    float acc[16];
#pragma unroll
    for (int c = 0; c < 16; ++c) acc[c] = 0.f;
#pragma unroll
    for (int j = 0; j < 8; ++j) {
        const f32x4 gg = ((const f32x4*)g)[64 * j + lane];
        const f32x4 y = v[j] * rstd * gg;
        v2u o; o.x = pk2(y.x, y.y); o.y = pk2(y.z, y.w);
        ((v2u*)orow)[64 * j + lane] = o;
        if (WITH_BA) {
#pragma unroll
            for (int c = 0; c < 16; ++c) { const f32x4 w4 = *(const LAS f32x4*)(wt + c * 2048 + 4 * (64 * j + lane));
                acc[c] += (y.x * w4.x + y.y * w4.y) + (y.z * w4.z + y.w * w4.w); }
            __builtin_amdgcn_sched_barrier(0);
        }
    }
    if (WITH_BA) {
        float q8[8], t4[4];
#pragma unroll
        for (int r = 0; r < 8; ++r) { auto sw = __builtin_amdgcn_permlane32_swap(__float_as_uint(acc[r]), __float_as_uint(acc[r + 8]), false, false); q8[r] = __uint_as_float(sw[0]) + __uint_as_float(sw[1]); }
#pragma unroll
        for (int r = 0; r < 4; ++r) { auto sw = __builtin_amdgcn_permlane16_swap(__float_as_uint(q8[r]), __float_as_uint(q8[r + 4]), false, false); t4[r] = __uint_as_float(sw[0]) + __uint_as_float(sw[1]); }
#pragma unroll
        for (int r = 0; r < 4; ++r) { float tv = t4[r]; tv = DPP_ROR_ADD(tv, 8); tv = DPP_ROR_ADD(tv, 4); tv = DPP_ROR_ADD(tv, 2); tv = DPP_ROR_ADD(tv, 1); t4[r] = tv; }
        if ((lane & 15) == 0) { const int gq = lane >> 4;
#pragma unroll
            for (int r = 0; r < 4; ++r) barow[r + 4 * gq] = t4[r]; }
    }
}
__device__ __forceinline__ void wqk_item(const float* Wq, const float* SK, bf16_t* Wqk, LAS float* lds, int item, int tid) {
    const int cbk = item >> 5, d0 = (item & 31) * 64, cb = cbk * 128, h = cbk >> 1, half = cbk & 1;
    LAS float* At = lds; LAS float* Bt = lds + 128 * 68;
    const float* skb = SK + ((size_t)(half * 8 + h) * 128) * 128;
#pragma unroll
    for (int i = 0; i < 4; ++i) { const int idx = tid + 512 * i, d = idx >> 5, k4 = idx & 31;
        const f32x4 w = *(const f32x4*)(Wq + (size_t)(d0 + d) * DM + cb + 4 * k4);
        At[(4 * k4 + 0) * 68 + d] = w.x; At[(4 * k4 + 1) * 68 + d] = w.y; At[(4 * k4 + 2) * 68 + d] = w.z; At[(4 * k4 + 3) * 68 + d] = w.w; }
#pragma unroll
    for (int i = 0; i < 8; ++i) { const int idx = tid + 512 * i, n = idx >> 5, k4 = idx & 31;
        const f32x4 w = *(const f32x4*)(skb + (size_t)n * 128 + 4 * k4);
        Bt[(4 * k4 + 0) * 132 + n] = w.x; Bt[(4 * k4 + 1) * 132 + n] = w.y; Bt[(4 * k4 + 2) * 132 + n] = w.z; Bt[(4 * k4 + 3) * 132 + n] = w.w; }
    __syncthreads();
    const int dy = tid >> 5, nx = tid & 31;
    float acc[4][4];
#pragma unroll
    for (int i = 0; i < 4; ++i)
#pragma unroll
        for (int j = 0; j < 4; ++j) acc[i][j] = 0.f;
#pragma unroll 4
    for (int kk = 0; kk < 128; ++kk) {
        const f32x4 a = *(const LAS f32x4*)(At + kk * 68 + 4 * dy), b = *(const LAS f32x4*)(Bt + kk * 132 + 4 * nx);
        acc[0][0] += a.x * b.x; acc[0][1] += a.x * b.y; acc[0][2] += a.x * b.z; acc[0][3] += a.x * b.w;
        acc[1][0] += a.y * b.x; acc[1][1] += a.y * b.y; acc[1][2] += a.y * b.z; acc[1][3] += a.y * b.w;
        acc[2][0] += a.z * b.x; acc[2][1] += a.z * b.y; acc[2][2] += a.z * b.z; acc[2][3] += a.z * b.w;
        acc[3][0] += a.w * b.x; acc[3][1] += a.w * b.y; acc[3][2] += a.w * b.z; acc[3][3] += a.w * b.w;
    }
#pragma unroll
    for (int j = 0; j < 4; ++j) { v2u o; o.x = pk2(acc[0][j], acc[1][j]); o.y = pk2(acc[2][j], acc[3][j]);
        *(v2u*)(Wqk + (size_t)(cb + 4 * nx + j) * DM + d0 + 4 * dy) = o; }
    __syncthreads();
}

typedef float f32x2 __attribute__((ext_vector_type(2)));
__device__ __forceinline__ int fp4_idx_of(float v) { return (v < 1.75f) ? (int)(v * 2.f + 0.25f) : (v < 2.5f ? 4 : (v < 3.5f ? 5 : (v < 5.f ? 6 : 7))); }
__device__ __forceinline__ void fp4_calibrate(int (&nib)[8]) {
    const unsigned T = 0x76543210u;
    const f32x2 a = __builtin_amdgcn_cvt_scalef32_pk_f32_fp4(T, 1.0f, 0), b = __builtin_amdgcn_cvt_scalef32_pk_f32_fp4(T, 1.0f, 1);
    const f32x2 c = __builtin_amdgcn_cvt_scalef32_pk_f32_fp4(T, 1.0f, 2), d = __builtin_amdgcn_cvt_scalef32_pk_f32_fp4(T, 1.0f, 3);
    nib[0] = fp4_idx_of(a.x); nib[1] = fp4_idx_of(a.y); nib[2] = fp4_idx_of(b.x); nib[3] = fp4_idx_of(b.y);
    nib[4] = fp4_idx_of(c.x); nib[5] = fp4_idx_of(c.y); nib[6] = fp4_idx_of(d.x); nib[7] = fp4_idx_of(d.y);
}
__device__ __forceinline__ void table_row(const float* src, unsigned* dst, float* inv_scale, int lane) {
    int nib[8]; fp4_calibrate(nib);
    f32x4 v[8]; float mx = 0.f;
#pragma unroll
    for (int j = 0; j < 8; ++j) { v[j] = ((const f32x4*)src)[8 * lane + j];
        mx = fmaxf(mx, fmaxf(fmaxf(fabsf(v[j].x), fabsf(v[j].y)), fmaxf(fabsf(v[j].z), fabsf(v[j].w)))); }
#pragma unroll
    for (int o = 1; o < 64; o <<= 1) mx = fmaxf(mx, __shfl_xor(mx, o));
    const float sc = mx > 0.f ? mx * (0.85f / 6.f) : 1.f, isc = 1.f / sc;
    unsigned wd[4];
#pragma unroll
    for (int w = 0; w < 4; ++w) {
        unsigned acc = 0u;
#pragma unroll
        for (int e = 0; e < 8; ++e) {
            const f32x4 q = v[2 * w + (e >> 2)]; const float xe = ((e & 3) == 0) ? q.x : ((e & 3) == 1) ? q.y : ((e & 3) == 2) ? q.z : q.w;
            const float yv = fabsf(xe) * isc;
            unsigned code = (yv > 0.25f) + (yv > 0.75f) + (yv > 1.25f) + (yv > 1.75f) + (yv > 2.5f) + (yv > 3.5f) + (yv > 5.f);
            code |= (xe < 0.f) ? 8u : 0u;
            acc |= code << (4 * nib[e]);
        }
        wd[w] = acc;
    }
    v4u o; o.x = wd[0]; o.y = wd[1]; o.z = wd[2]; o.w = wd[3];
    ((v4u*)dst)[lane] = o;
    if (lane == 0) *inv_scale = sc;
}
#ifndef PEER_FAST_REDUCE
#define PEER_FAST_REDUCE 1
#endif
__device__ __forceinline__ float dpp_ror_add(float t, int) { return t; }
#define FP4_BYTE(d, j) __builtin_amdgcn_cvt_scalef32_pk_f32_fp4((d), 1.0f, (j))
__device__ __forceinline__ float dot_row(const v4u& a, const float (&xv)[32]) {
    f32x2 p2 = {0.f, 0.f};
#pragma unroll
    for (int w = 0; w < 4; ++w) { const unsigned d = (w == 0) ? a.x : (w == 1) ? a.y : (w == 2) ? a.z : a.w;
        const f32x2 f0 = FP4_BYTE(d, 0), f1 = FP4_BYTE(d, 1), f2 = FP4_BYTE(d, 2), f3 = FP4_BYTE(d, 3);
        p2 = __builtin_elementwise_fma(f0, (f32x2){xv[8 * w], xv[8 * w + 1]}, p2); p2 = __builtin_elementwise_fma(f1, (f32x2){xv[8 * w + 2], xv[8 * w + 3]}, p2);
        p2 = __builtin_elementwise_fma(f2, (f32x2){xv[8 * w + 4], xv[8 * w + 5]}, p2); p2 = __builtin_elementwise_fma(f3, (f32x2){xv[8 * w + 6], xv[8 * w + 7]}, p2); }
    return p2.x + p2.y;
}
__device__ __forceinline__ void axpy_row(const v4u& a, float wgt, float (&y)[32]) {
#pragma unroll
    for (int w = 0; w < 4; ++w) { const unsigned d = (w == 0) ? a.x : (w == 1) ? a.y : (w == 2) ? a.z : a.w;
        const f32x2 f0 = FP4_BYTE(d, 0), f1 = FP4_BYTE(d, 1), f2 = FP4_BYTE(d, 2), f3 = FP4_BYTE(d, 3);
        y[8 * w] += wgt * f0.x; y[8 * w + 1] += wgt * f0.y; y[8 * w + 2] += wgt * f1.x; y[8 * w + 3] += wgt * f1.y;
        y[8 * w + 4] += wgt * f2.x; y[8 * w + 5] += wgt * f2.y; y[8 * w + 6] += wgt * f3.x; y[8 * w + 7] += wgt * f3.y; }
}
#define DPP_ROR_MAX(t, n) fmaxf((t), __uint_as_float(__builtin_amdgcn_update_dpp(0u, __float_as_uint(t), 0x120 + (n), 0xf, 0xf, false)))
#define CSWAP(a, b) do { const float hi_ = fmaxf(a, b), lo_ = fminf(a, b); a = hi_; b = lo_; } while (0)
__device__ __forceinline__ void topk_token_fast(const float* __restrict__ srow, int lane, const float* inv_su, const float* inv_sv,
                                                LAS int* se, LAS float* sa, LAS float* sb) {
    const int l16 = lane & 15, row = lane >> 4;
    float R[4];
#pragma unroll
    for (int ps = 0; ps < 4; ++ps) {
        const f32x4 v0 = *(const f32x4*)(srow + (4 * ps + row) * 128 + 8 * l16), v1 = *(const f32x4*)(srow + (4 * ps + row) * 128 + 8 * l16 + 4);
        float k[8];
        k[0] = v0.x; k[1] = v0.y; k[2] = v0.z; k[3] = v0.w; k[4] = v1.x; k[5] = v1.y; k[6] = v1.z; k[7] = v1.w;
#pragma unroll
        for (int i = 0; i < 8; ++i) k[i] = __uint_as_float((__float_as_uint(k[i]) & 0xFFFFFF80u) | (unsigned)(8 * l16 + i));
        CSWAP(k[0], k[1]); CSWAP(k[2], k[3]); CSWAP(k[4], k[5]); CSWAP(k[6], k[7]);
        CSWAP(k[0], k[2]); CSWAP(k[1], k[3]); CSWAP(k[4], k[6]); CSWAP(k[5], k[7]);
        CSWAP(k[1], k[2]); CSWAP(k[5], k[6]);
        CSWAP(k[0], k[4]); CSWAP(k[1], k[5]); CSWAP(k[2], k[6]); CSWAP(k[3], k[7]);
        CSWAP(k[2], k[4]); CSWAP(k[3], k[5]);
        CSWAP(k[1], k[2]); CSWAP(k[3], k[4]); CSWAP(k[5], k[6]);
        float res = 0.f;
#pragma unroll
        for (int it = 0; it < 16; ++it) {
            float m = k[0];
            m = DPP_ROR_MAX(m, 8); m = DPP_ROR_MAX(m, 4); m = DPP_ROR_MAX(m, 2); m = DPP_ROR_MAX(m, 1);
            const bool own = (k[0] == m);
#pragma unroll
            for (int i = 0; i < 7; ++i) k[i] = own ? k[i + 1] : k[i];
            k[7] = own ? -INFINITY : k[7];
            res = (l16 == it) ? m : res;
        }
        R[ps] = res;
    }
#pragma unroll
    for (int g = 0; g < 2; ++g) {
        const auto sw = __builtin_amdgcn_permlane16_swap(__float_as_uint(R[2 * g]), __float_as_uint(R[2 * g + 1]), false, false);
        const float X = __uint_as_float(sw[0]), Y = __uint_as_float(sw[1]);
        const float a = __uint_as_float(__float_as_uint(X) & 0xFFFFFF80u);
        int j = 0;
        float v2 = __shfl(Y, (lane & 48));
        float best = 0.f;
#pragma unroll
        for (int it = 0; it < 16; ++it) {
            const float sum = a + __uint_as_float(__float_as_uint(v2) & 0xFFFFFF80u);
            const float cand = (j < 16) ? __uint_as_float((__float_as_uint(sum) & 0xFFFFFF00u) | (unsigned)((l16 << 4) | (j & 15))) : -INFINITY;
            float m = cand;
            m = DPP_ROR_MAX(m, 8); m = DPP_ROR_MAX(m, 4); m = DPP_ROR_MAX(m, 2); m = DPP_ROR_MAX(m, 1);
            best = (l16 == it) ? m : best;
            if (it < 15) { j += (cand == m) ? 1 : 0; v2 = __shfl(Y, (lane & 48) + (j & 15)); }
        }
        const unsigned bb = __float_as_uint(best);
        const int bi = (bb >> 4) & 15, bj = bb & 15;
        const unsigned k1 = __float_as_uint(__shfl(X, (lane & 48) + bi)), k2 = __float_as_uint(__shfl(Y, (lane & 48) + bj));
        const int e = (int)(k1 & 127u) * 128 + (int)(k2 & 127u);
        const float bv = __uint_as_float(bb & 0xFFFFFF00u);
        float mx = bv; mx = DPP_ROR_MAX(mx, 8); mx = DPP_ROR_MAX(mx, 4); mx = DPP_ROR_MAX(mx, 2); mx = DPP_ROR_MAX(mx, 1);
        const float ex = __expf(bv - mx);
        float sm = ex; sm = DPP_ROR_ADD(sm, 8); sm = DPP_ROR_ADD(sm, 4); sm = DPP_ROR_ADD(sm, 2); sm = DPP_ROR_ADD(sm, 1);
        const float gate = ex / sm;
        const int head = 4 * g + ((row & 1) * 2 + (row >> 1));
        se[head * 16 + l16] = e; sa[head * 16 + l16] = inv_su[e]; sb[head * 16 + l16] = gate * inv_sv[e];
    }
}
#define PEER_LOAD(DST, TAB, b) do { _Pragma("unroll") for (int r_ = 0; r_ < 4; ++r_) { const unsigned char* rp_ = (TAB) + (size_t)(unsigned)__builtin_amdgcn_readfirstlane(se[4 * (b) + r_]) * 1024 + 16 * lane; \
        DST[r_] = *(const v4u*)rp_; } } while (0)
__device__ __forceinline__ void peer_token(int t, const float* scores, const bf16_t* hn, const float* hbuf, const unsigned char* U8, const unsigned char* V8,
                                           const float* inv_su, const float* inv_sv, const float* gfin, float* out,
                                           LAS int* se, LAS float* sa, LAS float* sb, int lane_in) {
    int lane = lane_in;
    {
        LAS int* se0 = se + 512; LAS float* sa0 = sa + 512; LAS float* sb0 = sb + 512;
        topk_token_fast(scores + (size_t)t * DM, lane, inv_su, inv_sv, se0, sa0, sb0);
        unsigned a0 = ((unsigned)se0[lane] << 7) | (unsigned)lane, a1 = ((unsigned)se0[lane + 64] << 7) | (unsigned)(lane + 64);
#pragma unroll
        for (int k = 2; k <= 128; k <<= 1) {
#pragma unroll
            for (int j = k >> 1; j > 0; j >>= 1) {
                if (j == 64) { const unsigned lo = a0 < a1 ? a0 : a1, hi = a0 < a1 ? a1 : a0; a0 = lo; a1 = hi; }
                else {
                    const unsigned p0 = (unsigned)__shfl_xor((int)a0, j), p1 = (unsigned)__shfl_xor((int)a1, j);
                    const bool lower = (lane & j) == 0;
                    const bool up0 = (lane & k) == 0, up1 = ((lane + 64) & k) == 0;
                    const unsigned mn0 = a0 < p0 ? a0 : p0, mx0 = a0 < p0 ? p0 : a0, mn1 = a1 < p1 ? a1 : p1, mx1 = a1 < p1 ? p1 : a1;
                    a0 = (up0 == lower) ? mn0 : mx0; a1 = (up1 == lower) ? mn1 : mx1;
                }
            }
        }
        const int k0 = a0 & 127, k1 = a1 & 127;
        se[lane] = (int)(a0 >> 7); sa[lane] = sa0[k0]; sb[lane] = sb0[k0];
        se[lane + 64] = (int)(a1 >> 7); sa[lane + 64] = sa0[k1]; sb[lane + 64] = sb0[k1];
    }
    asm volatile("" : "+v"(lane));
    float xv[32], y[32];
#pragma unroll
    for (int j = 0; j < 4; ++j) {
        const v4u h0 = *(const v4u*)(hn + (size_t)t * DM + 32 * lane + 8 * j);
#pragma unroll
        for (int w = 0; w < 4; ++w) { const unsigned d0 = (w == 0) ? h0.x : (w == 1) ? h0.y : (w == 2) ? h0.z : h0.w;
            xv[8 * j + 2 * w] = __uint_as_float(d0 << 16); xv[8 * j + 2 * w + 1] = __uint_as_float(d0 & 0xffff0000u); }
    }
#pragma unroll
    for (int i = 0; i < 32; ++i) y[i] = 0.f;
    v4u Ua[4], Ub[4], Va[4];
#define PEER_BATCH(b, UC, VC) do { \
        PEER_LOAD(VC, V8, (b)); \
        float pr[4]; \
        _Pragma("unroll") for (int r = 0; r < 4; ++r) pr[r] = dot_row(UC[r], xv); \
        if ((b) + 2 < 32) PEER_LOAD(UC, U8, (b) + 2); \
        float wr_[4], q2[2]; \
        _Pragma("unroll") for (int r = 0; r < 2; ++r) { auto sw = __builtin_amdgcn_permlane32_swap(__float_as_uint(pr[r]), __float_as_uint(pr[r + 2]), false, false); q2[r] = __uint_as_float(sw[0]) + __uint_as_float(sw[1]); } \
        float tv; \
        { auto sw = __builtin_amdgcn_permlane16_swap(__float_as_uint(q2[0]), __float_as_uint(q2[1]), false, false); tv = __uint_as_float(sw[0]) + __uint_as_float(sw[1]); } \
        tv = DPP_ROR_ADD(tv, 8); tv = DPP_ROR_ADD(tv, 4); tv = DPP_ROR_ADD(tv, 2); tv = DPP_ROR_ADD(tv, 1); \
        const int k = 4 * (b) + (lane >> 4);     \
        const float wc = gelu_erf(tv * sa[k]) * sb[k]; \
        _Pragma("unroll") for (int r = 0; r < 4; ++r) wr_[r] = __uint_as_float(__builtin_amdgcn_readlane(__float_as_uint(wc), 16 * r)); \
        _Pragma("unroll") for (int r = 0; r < 4; ++r) axpy_row(VC[r], wr_[r], y); } while (0)
    PEER_LOAD(Ua, U8, 0); PEER_LOAD(Ub, U8, 1);
#pragma unroll 1
    for (int b = 0; b < 32; b += 2) { PEER_BATCH(b, Ua, Va); PEER_BATCH(b + 1, Ub, Va); }
    float ss = 0.f;
#pragma unroll
    for (int j = 0; j < 8; ++j) { const f32x4 hv = *(const f32x4*)(hbuf + (size_t)t * DM + 32 * lane + 4 * j);
        y[4 * j] += hv.x; y[4 * j + 1] += hv.y; y[4 * j + 2] += hv.z; y[4 * j + 3] += hv.w;
        ss += (y[4 * j] * y[4 * j] + y[4 * j + 1] * y[4 * j + 1]) + (y[4 * j + 2] * y[4 * j + 2] + y[4 * j + 3] * y[4 * j + 3]); }
    ss = wave_sum(ss);
    const float rstd = rsqrtf(ss * (1.f / DM) + EPS);
#pragma unroll
    for (int j = 0; j < 8; ++j) { const f32x4 gg = *(const f32x4*)(gfin + 32 * lane + 4 * j);
        f32x4 o; o.x = y[4 * j] * rstd * gg.x; o.y = y[4 * j + 1] * rstd * gg.y; o.z = y[4 * j + 2] * rstd * gg.z; o.w = y[4 * j + 3] * rstd * gg.w;
        *(f32x4*)(out + (size_t)t * DM + 32 * lane + 4 * j) = o; }
}
typedef short bf16x8 __attribute__((ext_vector_type(8)));
__device__ __forceinline__ int pos32(int x) { const int g = x & ~31, l = x & 31; return g + 8 * ((l & 15) >> 2) + 4 * (l >> 4) + (l & 3); }
constexpr size_t PB_H_QG = 0, PB_H_KDT = 32 * MiB, PB_H_A = 64 * MiB;
constexpr size_t PB_G_QS = 80 * MiB, PB_G_KT = 96 * MiB;
constexpr size_t PB_G_W = 112 * MiB, PB_G_A = 144 * MiB, PB_G_U = 160 * MiB;
constexpr int PROG_WORD = 3584;
constexpr int NCW = 1, NSB = 32 * (4 / NCW), CPW = 6;
constexpr int SC_QG = 0, SC_WV = 16384, SC_KDT = 32768, SC_A = 49152, SC_BUF = 57344, SC_VEC = 2 * SC_BUF, SC_OT = SC_VEC + 2048, SC_OTB = 17408, SC_GAIN = SC_OT + 2 * SC_OTB;

__device__ __forceinline__ bf16x8 pack_frag(const f32x4& x0, const f32x4& x1) {
    v4u w; w.x = pk2(x0.x, x0.y); w.y = pk2(x0.z, x0.w); w.z = pk2(x1.x, x1.y); w.w = pk2(x1.z, x1.w);
    return __builtin_bit_cast(bf16x8, w);
}
#define MFMA16(a, b, c) __builtin_amdgcn_mfma_f32_16x16x32_bf16((a), (b), (c), 0, 0, 0)

__device__ __forceinline__ void hgrn_prep_item(int item, const bf16_t* proj, const float* lb_logits, unsigned char* pb, float* vecs, LAS unsigned char* lds, int tid) {
    const int c = item & 127, sq = item >> 7, b = sq >> 3, h = sq & 7, t0 = b * SEQ + c * 64;
    const int d = tid & 127, seg = tid >> 7, lane = tid & 63, wave = tid >> 6;
    LAS bf16_t* QGl = (LAS bf16_t*)lds; LAS bf16_t* KGl = (LAS bf16_t*)(lds + 17408); LAS float* segsum = (LAS float*)(lds + 34816);
    bf16_t* gQG = (bf16_t*)(pb + PB_H_QG) + (size_t)item * 8192;
    bf16_t* gKDT = (bf16_t*)(pb + PB_H_KDT) + (size_t)item * 8192;
    bf16_t* gA = (bf16_t*)(pb + PB_H_A) + (size_t)item * 4096;
    float* gvec = vecs + (size_t)item * 256;
    const float l0 = lb_logits[h * 128 + d], l1 = lb_logits[1024 + h * 128 + d];
    const float lb = 1.f / (1.f + __expf(l1 - l0));
    float lf[16], qv[16], kv[16];
#pragma unroll
    for (int i = 0; i < 16; ++i) {
        const bf16_t* pr = proj + (size_t)(t0 + 16 * seg + i) * NPROJ + h * 128 + d;
        const float z = bf2f(pr[C_AF]); qv[i] = bf2f(pr[C_AQ]);
        const float f = lb + (1.f - lb) * sigmoidf_(z);
        lf[i] = __logf(f); kv[i] = 1.f - f;
    }
    float run = 0.f;
#pragma unroll
    for (int i = 0; i < 16; ++i) { run += lf[i]; lf[i] = run; }
    segsum[seg * 128 + d] = run;
    __syncthreads();
    float off = 0.f, bl = 0.f;
#pragma unroll
    for (int s = 0; s < 4; ++s) { const float v = segsum[s * 128 + d]; bl += v; if (s < seg) off += v; }
    const int pd = pos32(d);
    float kd[16];
#pragma unroll
    for (int i = 0; i < 16; ++i) {
        const float bc = lf[i] + off; const int tl = 16 * seg + i;
        const float qg = qv[i] * __expf(bc), kg = kv[i] * __expf(-bc);
        kd[i] = kv[i] * __expf(bl - bc);
        const bf16_t qb = f2bf(qg);
        QGl[tl * 136 + d] = qb; KGl[tl * 136 + d] = f2bf(kg);
        gQG[tl * 128 + pd] = qb;
    }
#pragma unroll
    for (int ii = 0; ii < 4; ++ii) { v2u o; o.x = pk2(kd[4 * ii], kd[4 * ii + 1]); o.y = pk2(kd[4 * ii + 2], kd[4 * ii + 3]);
        *(v2u*)(gKDT + d * 64 + 32 * (seg >> 1) + 8 * ii + 4 * (seg & 1)) = o; }
    if (seg == 0) gvec[128 + d] = __expf(bl);
    __syncthreads();
    const int n = lane & 15, q = lane >> 4;
#pragma unroll
    for (int ti = 0; ti < 2; ++ti) {
        const int id = wave + 8 * ti, mt = id >> 2, ns = id & 3;
        f32x4 acc = {0.f, 0.f, 0.f, 0.f};
        if (ns <= mt) {
#pragma unroll
            for (int s4 = 0; s4 < 4; ++s4) {
                const bf16x8 a = *(const LAS bf16x8*)(QGl + (16 * mt + n) * 136 + 32 * s4 + 8 * q);
                const bf16x8 bb = *(const LAS bf16x8*)(KGl + (16 * ns + n) * 136 + 32 * s4 + 8 * q);
                acc = MFMA16(a, bb, acc);
            }
        }
        const int s = 16 * ns + n, ps = pos32(s);
#pragma unroll
        for (int r = 0; r < 4; ++r) { const int t = 16 * mt + 4 * q + r; const float v = (r == 0) ? acc.x : (r == 1) ? acc.y : (r == 2) ? acc.z : acc.w;
            gA[t * 64 + ps] = f2bf((s <= t) ? v : 0.f); }
    }
    __syncthreads();
}

constexpr int GP_QF = 0, GP_KF = 33024, GP_N = 0, GP_QB = 66048, GP_KB = 83456, GP_VB = 100864, GP_PART = 135680, GP_SB = 137728;
__device__ __forceinline__ void gdn_prep_item(int item, const bf16_t* proj, const float* ba, const float* conv_w, const float* A_log, const float* dt_bias,
                                              unsigned char* pb, float* vecs, LAS unsigned char* lds, int tid) {
    const int c = item & 127, bq = item >> 7, b = bq >> 2, qh = bq & 3, t0 = b * SEQ + c * 64;
    const int lane = tid & 63, wave = tid >> 6;
    LAS float* QF = (LAS float*)(lds + GP_QF); LAS float* KF = (LAS float*)(lds + GP_KF);
    LAS bf16_t* QB = (LAS bf16_t*)(lds + GP_QB); LAS bf16_t* KB = (LAS bf16_t*)(lds + GP_KB); LAS bf16_t* VB = (LAS bf16_t*)(lds + GP_VB);
    LAS float* PART = (LAS float*)(lds + GP_PART); LAS float* SBETA = (LAS float*)(lds + GP_SB); LAS float* SGC = SBETA + 128;
    LAS float* NM = (LAS float*)(lds + GP_N);
    {
        int col, wch; const int dd = tid & 127;
        if (tid < 128) { col = C_BQ + qh * 128 + dd; wch = qh * 128 + dd; }
        else if (tid < 256) { col = C_BK + qh * 128 + dd; wch = 512 + qh * 128 + dd; }
        else { const int vh = 2 * qh + ((tid - 256) >> 7); col = C_BV + vh * 128 + dd; wch = 1024 + vh * 128 + dd; }
        const float w0 = conv_w[wch], w1 = conv_w[2048 + wch], w2 = conv_w[4096 + wch], w3 = conv_w[6144 + wch];
        float h0 = 0.f, h1 = 0.f, h2 = 0.f;
        const bf16_t* pr = proj + (size_t)t0 * NPROJ + col;
        if (c > 0) { h0 = bf2f(pr[-3 * NPROJ]); h1 = bf2f(pr[-2 * NPROJ]); h2 = bf2f(pr[-1 * NPROJ]); }
        unsigned xr[64];
#pragma unroll
        for (int t = 0; t < 64; ++t) xr[t] = pr[(size_t)t * NPROJ];
#pragma unroll
        for (int t = 0; t < 64; ++t) {
            const float xx = __uint_as_float(xr[t] << 16);
            const float yv = siluf_(w0 * h0 + w1 * h1 + w2 * h2 + w3 * xx);
            h0 = h1; h1 = h2; h2 = xx;
            if (tid < 128) QF[t * 129 + dd] = yv;
            else if (tid < 256) KF[t * 129 + dd] = yv;
            else VB[((tid - 256) >> 7) * 8704 + t * 136 + dd] = f2bf(yv);
        }
    }
    __syncthreads();
    {
        const int t = tid & 63, part = tid >> 6, which = part >> 2, sub = part & 3;
        const LAS float* src = (which ? KF : QF) + t * 129 + 32 * sub;
        float s = 0.f;
#pragma unroll
        for (int i = 0; i < 32; ++i) s += src[i] * src[i];
        PART[(which * 4 + sub) * 64 + t] = s;
    }
    if (wave < 2) {
        const int vh = 2 * qh + wave;
        const float ax = ba[(size_t)(t0 + lane) * 16 + 8 + vh] + dt_bias[vh];
        const float sp = ax > 20.f ? ax : log1pf(__expf(ax));
        float gc = -__expf(A_log[vh]) * sp;
#pragma unroll
        for (int o = 1; o < 64; o <<= 1) { const float up = __shfl_up(gc, o); if (lane >= o) gc += up; }
        const float gl = __shfl(gc, 63);
        const float beta = sigmoidf_(ba[(size_t)(t0 + lane) * 16 + vh]);
        SBETA[wave * 64 + lane] = beta; SGC[wave * 64 + lane] = gc;
        float* gvec = vecs + ((size_t)(16 + b * 8 + vh) * 128 + c) * 256;
        gvec[lane] = __expf(gc); gvec[64 + lane] = __expf(gl - gc);
        const float dl = __expf(gl); gvec[128 + lane] = dl; gvec[192 + lane] = dl;
    }
    __syncthreads();
    {
        const int d = tid & 127, seg = tid >> 7, pd = pos32(d);
        bf16_t* gQS = (bf16_t*)(pb + PB_G_QS) + (size_t)item * 8192;
        bf16_t* gKT = (bf16_t*)(pb + PB_G_KT) + (size_t)item * 8192;
        float kk[16];
#pragma unroll
        for (int i = 0; i < 16; ++i) {
            const int tl = 16 * seg + i;
            const float sq = PART[0 * 64 + tl] + PART[1 * 64 + tl] + PART[2 * 64 + tl] + PART[3 * 64 + tl];
            const float sk = PART[4 * 64 + tl] + PART[5 * 64 + tl] + PART[6 * 64 + tl] + PART[7 * 64 + tl];
            const bf16_t qb = f2bf(QF[tl * 129 + d] * rsqrtf(sq + EPS) * 0.08838834764831845f);
            const bf16_t kb = f2bf(KF[tl * 129 + d] * rsqrtf(sk + EPS));
            QB[tl * 136 + d] = qb; KB[tl * 136 + d] = kb; gQS[tl * 128 + pd] = qb; kk[i] = bf2f(kb);
        }
#pragma unroll
        for (int ii = 0; ii < 4; ++ii) { v2u o; o.x = pk2(kk[4 * ii], kk[4 * ii + 1]); o.y = pk2(kk[4 * ii + 2], kk[4 * ii + 3]);
            *(v2u*)(gKT + d * 64 + 32 * (seg >> 1) + 8 * ii + 4 * (seg & 1)) = o; }
    }
    __syncthreads();
    {
        const int n = lane & 15, q = lane >> 4;
#pragma unroll
        for (int ti = 0; ti < 2; ++ti) {
            const int id = 2 * wave + ti, mt = id >> 2, ns = id & 3;
            f32x4 akk = {0.f, 0.f, 0.f, 0.f}, aqk = {0.f, 0.f, 0.f, 0.f};
            if (ns <= mt) {
#pragma unroll
                for (int s4 = 0; s4 < 4; ++s4) {
                    const bf16x8 kb_ = *(const LAS bf16x8*)(KB + (16 * ns + n) * 136 + 32 * s4 + 8 * q);
                    const bf16x8 ka_ = *(const LAS bf16x8*)(KB + (16 * mt + n) * 136 + 32 * s4 + 8 * q);
                    const bf16x8 qa_ = *(const LAS bf16x8*)(QB + (16 * mt + n) * 136 + 32 * s4 + 8 * q);
                    akk = MFMA16(ka_, kb_, akk); aqk = MFMA16(qa_, kb_, aqk);
                }
            }
            const int s = 16 * ns + n, ps = pos32(s);
#pragma unroll
            for (int vl = 0; vl < 2; ++vl) {
                bf16_t* gA = (bf16_t*)(pb + PB_G_A) + ((size_t)((b * 8 + 2 * qh + vl) * 128 + c)) * 4096;
                const float gcs = SGC[vl * 64 + s];
#pragma unroll
                for (int r = 0; r < 4; ++r) {
                    const int t = 16 * mt + 4 * q + r;
                    const float vk = (r == 0) ? akk.x : (r == 1) ? akk.y : (r == 2) ? akk.z : akk.w;
                    const float vq = (r == 0) ? aqk.x : (r == 1) ? aqk.y : (r == 2) ? aqk.z : aqk.w;
                    const float ex = (s <= t) ? __expf(SGC[vl * 64 + t] - gcs) : 0.f;
                    NM[vl * 4096 + t * 64 + s] = (s < t) ? SBETA[vl * 64 + t] * vk * ex : 0.f;
                    gA[t * 64 + ps] = f2bf((s <= t) ? vq * ex : 0.f);
                }
            }
        }
    }
    __syncthreads();
    {
        const int vl = tid >> 8, colx = tid & 255;
        float x[64];
        if (colx < 128) {
#pragma unroll
            for (int t = 0; t < 64; ++t) x[t] = SBETA[vl * 64 + t] * bf2f(VB[vl * 8704 + t * 136 + colx]);
        } else {
#pragma unroll
            for (int t = 0; t < 64; ++t) x[t] = SBETA[vl * 64 + t] * __expf(SGC[vl * 64 + t]) * bf2f(KB[t * 136 + colx - 128]);
        }
        __syncthreads();
        const LAS float* Nv = NM + vl * 4096;
#pragma unroll
        for (int t = 1; t < 64; ++t) {
            float acc = x[t];
#pragma unroll
            for (int s4 = 0; s4 < (t + 3) / 4; ++s4) {
                const f32x4 nn = *(const LAS f32x4*)(Nv + t * 64 + 4 * s4);
                acc -= nn.x * x[4 * s4]; if (4 * s4 + 1 < t) acc -= nn.y * x[4 * s4 + 1]; if (4 * s4 + 2 < t) acc -= nn.z * x[4 * s4 + 2]; if (4 * s4 + 3 < t) acc -= nn.w * x[4 * s4 + 3];
            }
            x[t] = acc;
        }
        if (colx < 128) {
            bf16_t* gU = (bf16_t*)(pb + PB_G_U) + ((size_t)((b * 8 + 2 * qh + vl) * 128 + c)) * 8192;
            const int sl = colx >> 4, n = colx & 15;
#pragma unroll
            for (int mt = 0; mt < 4; ++mt)
#pragma unroll
                for (int q = 0; q < 4; ++q) { v2u o; o.x = pk2(x[16 * mt + 4 * q], x[16 * mt + 4 * q + 1]); o.y = pk2(x[16 * mt + 4 * q + 2], x[16 * mt + 4 * q + 3]);
                    *(v2u*)(gU + ((size_t)((sl * 4 + mt) * 64 + q * 16 + n)) * 4) = o; }
        } else {
            LAS bf16_t* WS = (LAS bf16_t*)(lds + GP_QB) + vl * 8704;
            const int pd = pos32(colx - 128);
#pragma unroll
            for (int t = 0; t < 64; ++t) WS[t * 136 + pd] = f2bf(-x[t]);
        }
    }
    __syncthreads();
    {
#pragma unroll
        for (int i = 0; i < 4; ++i) { const int p = tid + 512 * i, vl = p >> 10, row = (p >> 4) & 63, c16 = p & 15;
            bf16_t* gW = (bf16_t*)(pb + PB_G_W) + ((size_t)((b * 8 + 2 * qh + vl) * 128 + c)) * 8192;
            *(v4u*)(gW + row * 128 + c16 * 8) = *(const LAS v4u*)(lds + GP_QB + vl * 17408 + row * 272 + c16 * 16); }
    }
    __syncthreads();
}

struct ScanSrc { const unsigned char* qg; const unsigned char* wv; const unsigned char* kdt; const unsigned char* a; const float* vec; size_t wv_row; };
__device__ __forceinline__ void scan_dma(const ScanSrc& S, LAS unsigned char* buf, LAS unsigned char* vecb, int w, int lane) {
#pragma unroll
    for (int i = 0; i < 2; ++i) { const int pi = 2 * w + i, row = 4 * pi + (lane >> 4), cl = (lane & 15) ^ (row & 15);
        __builtin_amdgcn_global_load_lds((const unsigned*)(S.qg + row * 256 + cl * 16), (LAS unsigned*)(buf + SC_QG + pi * 1024), 16, 0, 0);
        __builtin_amdgcn_global_load_lds((const unsigned*)(S.wv + (size_t)row * S.wv_row + cl * 16), (LAS unsigned*)(buf + SC_WV + pi * 1024), 16, 0, 0); }
#pragma unroll
    for (int i = 0; i < 2; ++i) { const int pi = 2 * w + i, row = 8 * pi + (lane >> 3), cl = (lane & 7) ^ ((row >> 1) & 7);
        __builtin_amdgcn_global_load_lds((const unsigned*)(S.kdt + row * 128 + cl * 16), (LAS unsigned*)(buf + SC_KDT + pi * 1024), 16, 0, 0); }
    { const int pi = w, row = 8 * pi + (lane >> 3), cl = (lane & 7) ^ ((row >> 1) & 7);
        __builtin_amdgcn_global_load_lds((const unsigned*)(S.a + row * 128 + cl * 16), (LAS unsigned*)(buf + SC_A + pi * 1024), 16, 0, 0); }
    if (w == 0) __builtin_amdgcn_global_load_lds((const unsigned*)((const unsigned char*)S.vec + lane * 16), (LAS unsigned*)vecb, 16, 0, 0);
}
template <bool GDN>
__device__ __forceinline__ void scan_block(int sq, int g, const bf16_t* proj, const unsigned char* pb, const float* vecs, const float* hgrn_g, const float* gdn_g,
                                           bf16_t* mix, unsigned* prog, LAS unsigned char* lds, int tid) {
    constexpr bool gdn = GDN;
    const int b = (sq & 15) >> 3, hh = sq & 7, lane = tid & 63, sl = __builtin_amdgcn_readfirstlane(tid >> 6), n = lane & 15, q = lane >> 4;
    const unsigned char* bQG; const unsigned char* bWV; const unsigned char* bKDT; const unsigned char* bA; const unsigned char* bU = nullptr;
    size_t wv_row, wv_chunk; int gate_col, mix_col; const float* gain;
    if (!gdn) {
        const size_t s0 = (size_t)(b * 8 + hh) * 128;
        bQG = pb + PB_H_QG + s0 * 16384; bKDT = pb + PB_H_KDT + s0 * 16384; bA = pb + PB_H_A + s0 * 8192;
        bWV = (const unsigned char*)(proj + (size_t)(b * SEQ) * NPROJ + C_AI + hh * 128); wv_row = (size_t)NPROJ * 2; wv_chunk = (size_t)64 * NPROJ * 2;
        gate_col = C_AG + hh * 128; mix_col = hh * 128; gain = hgrn_g;
    } else {
        const size_t s0 = (size_t)(b * 8 + hh) * 128, q0 = (size_t)(b * 4 + (hh >> 1)) * 128;
        bQG = pb + PB_G_QS + q0 * 16384; bKDT = pb + PB_G_KT + q0 * 16384; bA = pb + PB_G_A + s0 * 8192;
        bWV = pb + PB_G_W + s0 * 16384; wv_row = 256; wv_chunk = 16384; bU = pb + PB_G_U + s0 * 16384;
        gate_col = C_BZ + hh * 128; mix_col = 1024 + hh * 128; gain = gdn_g;
    }
    const float* bvec = vecs + (size_t)sq * 128 * 256;
    LAS float* gainl = (LAS float*)(lds + SC_GAIN);
    const int wave = sl;
    {
        ScanSrc src{bQG, bWV, bKDT, bA, bvec, wv_row};
        scan_dma(src, lds, lds + SC_VEC, wave, lane);
        if (tid < 128) gainl[tid] = gain[tid];
    }
    __builtin_amdgcn_s_waitcnt(0x0070);
    asm volatile("" ::: "memory");
    __builtin_amdgcn_s_barrier();
    asm volatile("" ::: "memory");
#define SCAN_BAR() do { asm volatile("s_waitcnt lgkmcnt(0)" ::: "memory"); __builtin_amdgcn_s_barrier(); asm volatile("" ::: "memory"); } while (0)
#define SCHED_FENCE() __builtin_amdgcn_sched_barrier(0)
    const int cw = g * NCW + wave;
    const int hw = (NCW == 2) ? ((wave == 2) ? 0 : (wave == 3) ? 1 : (wave == 6) ? 2 : (wave == 7) ? 3 : -1)
                              : ((wave == 1) ? 0 : (wave == 2) ? 1 : (wave == 3) ? 2 : (wave == 5) ? 3 : -1);
    if (wave < NCW) {
        f32x4 S[2][8];
        bf16x8 Sf[2][4];
#pragma unroll
        for (int e = 0; e < 2; ++e) {
#pragma unroll
            for (int m = 0; m < 8; ++m) S[e][m] = (f32x4){0.f, 0.f, 0.f, 0.f};
#pragma unroll
            for (int s4 = 0; s4 < 4; ++s4) Sf[e][s4] = pack_frag(S[e][0], S[e][1]);
        }
        v2u Ureg[2][4];
#pragma unroll
        for (int e = 0; e < 2; ++e)
#pragma unroll
            for (int mt = 0; mt < 4; ++mt) Ureg[e][mt] = GDN ? *(const v2u*)(bU + (size_t)((2 * cw + e) * 4 + mt) * 512 + lane * 8) : (v2u){0u, 0u};
        for (int c = 0; c < 128; ++c) {
            int lane = tid & 63; asm volatile("" : "+v"(lane));
            const int n = lane & 15, q = lane >> 4;
            const int cur = c & 1;
            LAS unsigned char* buf = lds + cur * SC_BUF;
            const LAS float* vec = (const LAS float*)(lds + SC_VEC + cur * 1024);
            const int cn = (c + 1 < 128) ? c + 1 : 127;
            f32x4 VN[2][4];
            bf16x8 fa[4], fb[4];
            bf16x8 VNf[2][2], VNSf[2][2];
#define SC2_LD4_K128(dst, OFF, mt_) do { _Pragma("unroll") for (int i_ = 0; i_ < 4; ++i_) dst[i_] = *(const LAS bf16x8*)(buf + (OFF) + (16 * (mt_) + n) * 256 + (((4 * i_ + q) ^ n) * 16)); } while (0)
#define SC2_LD4_K64(dst, OFF, mb) do { _Pragma("unroll") for (int i_ = 0; i_ < 4; ++i_) dst[i_] = *(const LAS bf16x8*)(buf + (OFF) + (16 * ((mb) + (i_ >> 1)) + n) * 128 + (((4 * (i_ & 1) + q) ^ ((n >> 1) & 7)) * 16)); } while (0)
#define SC2_MM_K128(A0, A1, fr) do { _Pragma("unroll") for (int i_ = 0; i_ < 4; ++i_) { A0 = MFMA16(fr[i_], Sf[0][i_], A0); A1 = MFMA16(fr[i_], Sf[1][i_], A1); } } while (0)
#define SC2_MM_K64(X, ma, fr, BF) do { X[0][ma] = MFMA16(fr[0], BF[0][0], X[0][ma]); X[1][ma] = MFMA16(fr[0], BF[1][0], X[1][ma]); X[0][ma] = MFMA16(fr[1], BF[0][1], X[0][ma]); X[1][ma] = MFMA16(fr[1], BF[1][1], X[1][ma]); \
        X[0][(ma) + 1] = MFMA16(fr[2], BF[0][0], X[0][(ma) + 1]); X[1][(ma) + 1] = MFMA16(fr[2], BF[1][0], X[1][(ma) + 1]); X[0][(ma) + 1] = MFMA16(fr[3], BF[0][1], X[0][(ma) + 1]); X[1][(ma) + 1] = MFMA16(fr[3], BF[1][1], X[1][(ma) + 1]); } while (0)
#define SC2_DECAY(m) do { const f32x4 d4_ = *(const LAS f32x4*)(vec + 128 + 16 * (m) + 4 * q); S[0][m] = S[0][m] * d4_; S[1][m] = S[1][m] * d4_; } while (0)
#define SC2_PACK_S(s4) do { Sf[0][s4] = pack_frag(S[0][2 * (s4)], S[0][2 * (s4) + 1]); Sf[1][s4] = pack_frag(S[1][2 * (s4)], S[1][2 * (s4) + 1]); } while (0)
#define SC2_PACK_VN(e) do { _Pragma("unroll") for (int s2 = 0; s2 < 2; ++s2) { \
                VNf[e][s2] = pack_frag(VN[e][2 * s2], VN[e][2 * s2 + 1]); VNSf[e][s2] = pack_frag(VN[e][2 * s2] * eS[2 * s2], VN[e][2 * s2 + 1] * eS[2 * s2 + 1]); } } while (0)
#define SC2_OT_WRITE(e) do { LAS bf16_t* OT_ = (LAS bf16_t*)(lds + SC_OT + cur * SC_OTB); const int cc_ = 16 * (2 * cw + (e)) + n; \
                _Pragma("unroll") for (int mt = 0; mt < 4; ++mt) { \
                    OT_[(16 * mt + 4 * q + 0) * 136 + cc_] = f2bf(O[e][mt].x); OT_[(16 * mt + 4 * q + 1) * 136 + cc_] = f2bf(O[e][mt].y); \
                    OT_[(16 * mt + 4 * q + 2) * 136 + cc_] = f2bf(O[e][mt].z); OT_[(16 * mt + 4 * q + 3) * 136 + cc_] = f2bf(O[e][mt].w); } } while (0)
            f32x4 eS[4];
            if (GDN) {
#pragma unroll
                for (int e = 0; e < 2; ++e)
#pragma unroll
                    for (int mt = 0; mt < 4; ++mt) { const v2u uu = Ureg[e][mt];
                        VN[e][mt] = (f32x4){__uint_as_float(uu.x << 16), __uint_as_float(uu.x & 0xffff0000u), __uint_as_float(uu.y << 16), __uint_as_float(uu.y & 0xffff0000u)}; }
                SC2_LD4_K128(fa, SC_WV, 0); SCHED_FENCE();
                SC2_LD4_K128(fb, SC_WV, 1); SCHED_FENCE();
#pragma unroll
                for (int e = 0; e < 2; ++e)
#pragma unroll
                    for (int mt = 0; mt < 4; ++mt) Ureg[e][mt] = *(const v2u*)(bU + (size_t)cn * 16384 + (size_t)((2 * cw + e) * 4 + mt) * 512 + lane * 8);
#pragma unroll
                for (int i = 0; i < 4; ++i) eS[i] = *(const LAS f32x4*)(vec + 64 + 16 * i + 4 * q);
                SCHED_FENCE();
                SC2_MM_K128(VN[0][0], VN[1][0], fa); SC2_DECAY(0); SC2_DECAY(1); SCHED_FENCE(); SC2_LD4_K128(fa, SC_WV, 2); SCHED_FENCE();
                SC2_MM_K128(VN[0][1], VN[1][1], fb); SC2_DECAY(2); SC2_DECAY(3); SCHED_FENCE(); SC2_LD4_K128(fb, SC_WV, 3); SCHED_FENCE();
                SC2_MM_K128(VN[0][2], VN[1][2], fa); SC2_DECAY(4); SC2_DECAY(5); SCHED_FENCE(); SC2_LD4_K128(fa, SC_QG, 0); SCHED_FENCE();
                SC2_MM_K128(VN[0][3], VN[1][3], fb); SC2_DECAY(6); SC2_DECAY(7); SCHED_FENCE(); SC2_LD4_K128(fb, SC_QG, 1); SCHED_FENCE();
            } else {
                SC2_LD4_K128(fa, SC_QG, 0); SCHED_FENCE();
                SC2_LD4_K128(fb, SC_QG, 1); SCHED_FENCE();
#pragma unroll
                for (int e = 0; e < 2; ++e)
#pragma unroll
                    for (int s2 = 0; s2 < 2; ++s2) { unsigned w[4];
#pragma unroll
                        for (int jj = 0; jj < 4; ++jj) { const int ja = 2 * jj, jb = 2 * jj + 1; const int cc = 16 * (2 * cw + e) + n;
                            const int ta = 32 * s2 + ((ja < 4) ? 4 * q + ja : 16 + 4 * q + ja - 4), tb = 32 * s2 + ((jb < 4) ? 4 * q + jb : 16 + 4 * q + jb - 4);
                            const unsigned lo = *(const LAS bf16_t*)(buf + SC_WV + ta * 256 + (((cc >> 3) ^ (ta & 15)) * 16) + (cc & 7) * 2), hi = *(const LAS bf16_t*)(buf + SC_WV + tb * 256 + (((cc >> 3) ^ (tb & 15)) * 16) + (cc & 7) * 2);
                            w[jj] = lo | (hi << 16); }
                        v4u ww; ww.x = w[0]; ww.y = w[1]; ww.z = w[2]; ww.w = w[3];
                        VNf[e][s2] = __builtin_bit_cast(bf16x8, ww); VNSf[e][s2] = VNf[e][s2]; }
                SCHED_FENCE();
            }
            f32x4 O[2][4];
#pragma unroll
            for (int e = 0; e < 2; ++e)
#pragma unroll
                for (int mt = 0; mt < 4; ++mt) O[e][mt] = (f32x4){0.f, 0.f, 0.f, 0.f};
            if (GDN) {
                SC2_MM_K128(O[0][0], O[1][0], fa); SC2_PACK_VN(0); SCHED_FENCE(); SC2_LD4_K128(fa, SC_QG, 2); SCHED_FENCE();
                SC2_MM_K128(O[0][1], O[1][1], fb); SC2_PACK_VN(1); SCHED_FENCE(); SC2_LD4_K128(fb, SC_QG, 3); SCHED_FENCE();
                SC2_MM_K128(O[0][2], O[1][2], fa); SCHED_FENCE(); SC2_LD4_K64(fa, SC_A, 0); SCHED_FENCE();
                SC2_MM_K128(O[0][3], O[1][3], fb); SCHED_FENCE(); SC2_LD4_K64(fb, SC_A, 2); SCHED_FENCE();
#pragma unroll
                for (int mt = 0; mt < 4; ++mt) { const f32x4 eg4 = *(const LAS f32x4*)(vec + 16 * mt + 4 * q); O[0][mt] = O[0][mt] * eg4; O[1][mt] = O[1][mt] * eg4; }
            } else {
                SC2_MM_K128(O[0][0], O[1][0], fa); SC2_DECAY(0); SC2_DECAY(1); SCHED_FENCE(); SC2_LD4_K128(fa, SC_QG, 2); SCHED_FENCE();
                SC2_MM_K128(O[0][1], O[1][1], fb); SC2_DECAY(2); SC2_DECAY(3); SCHED_FENCE(); SC2_LD4_K128(fb, SC_QG, 3); SCHED_FENCE();
                SC2_MM_K128(O[0][2], O[1][2], fa); SC2_DECAY(4); SC2_DECAY(5); SCHED_FENCE(); SC2_LD4_K64(fa, SC_A, 0); SCHED_FENCE();
                SC2_MM_K128(O[0][3], O[1][3], fb); SC2_DECAY(6); SC2_DECAY(7); SCHED_FENCE(); SC2_LD4_K64(fb, SC_A, 2); SCHED_FENCE();
            }
            SC2_MM_K64(O, 0, fa, VNf); SCHED_FENCE(); SC2_LD4_K64(fa, SC_KDT, 0); SCHED_FENCE();
            SC2_MM_K64(O, 2, fb, VNf); SCHED_FENCE(); SC2_LD4_K64(fb, SC_KDT, 2); SCHED_FENCE();
            SC2_MM_K64(S, 0, fa, VNSf); SC2_OT_WRITE(0); SCHED_FENCE(); SC2_LD4_K64(fa, SC_KDT, 4); SCHED_FENCE();
            SC2_MM_K64(S, 2, fb, VNSf); SC2_OT_WRITE(1); SCHED_FENCE(); SC2_LD4_K64(fb, SC_KDT, 6); SCHED_FENCE();
            SC2_MM_K64(S, 4, fa, VNSf); SC2_PACK_S(0); SCHED_FENCE();
            SC2_MM_K64(S, 6, fb, VNSf); SC2_PACK_S(1); SC2_PACK_S(2); SCHED_FENCE();
            SC2_PACK_S(3);
            SCAN_BAR();
        }
    } else if (wave == CPW) {
        for (int c = 0; c < 128; ++c) {
            SCAN_BAR();
            int lane = tid & 63; asm volatile("" : "+v"(lane));
            const LAS bf16_t* OTn = (const LAS bf16_t*)(lds + SC_OT + (c & 1) * SC_OTB);
#pragma unroll
            for (int w = 0; w < NCW; ++w)
#pragma unroll
                for (int ps = 0; ps < 4; ++ps) { const int row = 16 * ps + (lane >> 2), pc = lane & 3, col = 32 * (g * NCW + w) + 8 * pc;
                    const v4u val = *(const LAS v4u*)(OTn + row * 136 + col);
                    *(v4u*)(mix + (size_t)(b * SEQ + c * 64 + row) * DM + mix_col + col) = val; }
        }
    } else if (hw >= 0) {
        v4u G0[15], G1[15];
#define HLP_LOAD(GX, cn_) do { const unsigned char* sQG = bQG + (size_t)(cn_) * 16384 + (size_t)hw * 4096; const unsigned char* sWV = bWV + (size_t)(cn_) * wv_chunk + (size_t)(16 * hw) * wv_row; \
            const unsigned char* sKDT = bKDT + (size_t)(cn_) * 16384 + (size_t)hw * 4096; const unsigned char* sA = bA + (size_t)(cn_) * 8192 + (size_t)hw * 2048; \
            const unsigned l16 = (unsigned)lane * 16u, offv = (unsigned)(lane >> 4) * (unsigned)wv_row + (unsigned)(lane & 15) * 16u; \
            _Pragma("unroll") for (int i = 0; i < 4; ++i) { GX[i] = *(const v4u*)(sQG + i * 1024 + l16); GX[4 + i] = *(const v4u*)(sWV + (size_t)(4 * i) * wv_row + offv); } \
            _Pragma("unroll") for (int i = 0; i < 4; ++i) GX[8 + i] = *(const v4u*)(sKDT + i * 1024 + l16); \
            _Pragma("unroll") for (int i = 0; i < 2; ++i) GX[12 + i] = *(const v4u*)(sA + i * 1024 + l16); \
            GX[14] = *(const v4u*)((const unsigned char*)(bvec + (size_t)(cn_) * 256) + l16); } while (0)
#define HLP_STORE(GX, bi_) do { LAS unsigned char* nb = lds + (bi_) * SC_BUF + hw * 4096; LAS unsigned char* nv = lds + SC_VEC + (bi_) * 1024; const int lq = lane >> 4; \
            _Pragma("unroll") for (int i = 0; i < 4; ++i) { const int d = lq * 256 + (((lane & 15) ^ (4 * i + lq)) * 16); \
                *(LAS v4u*)(nb + SC_QG + i * 1024 + d) = GX[i]; *(LAS v4u*)(nb + SC_WV + i * 1024 + d) = GX[4 + i]; } \
            _Pragma("unroll") for (int i = 0; i < 4; ++i) { const int d = (lane >> 3) * 128 + (((lane & 7) ^ (4 * (i & 1) + lq)) * 16); *(LAS v4u*)(nb + SC_KDT + i * 1024 + d) = GX[8 + i]; } \
            _Pragma("unroll") for (int i = 0; i < 2; ++i) { const int d = (lane >> 3) * 128 + (((lane & 7) ^ (4 * i + lq)) * 16); *(LAS v4u*)(nb - hw * 2048 + SC_A + i * 1024 + d) = GX[12 + i]; } \
            if (hw == 0) *(LAS v4u*)(nv + lane * 16) = GX[14]; } while (0)
#define HLP_ITER(c, GL, GW) do { \
            int lane = tid & 63; asm volatile("" : "+v"(lane)); \
            const int c2 = ((c) + 2 < 128) ? (c) + 2 : 127; \
            HLP_LOAD(GL, c2); \
            HLP_STORE(GW, ((c) + 1) & 1); \
            SCAN_BAR(); } while (0)
        { int lane = tid & 63; asm volatile("" : "+v"(lane)); HLP_LOAD(G1, 1); }
        for (int c = 0; c < 128; c += 2) { HLP_ITER(c, G0, G1); HLP_ITER(c + 1, G1, G0); }
    } else {
        for (int c = 0; c < 128; ++c) SCAN_BAR();
    }
    __syncthreads();
}

__device__ __forceinline__ void mixnorm_row(bf16_t* mrow, const bf16_t* prow, const float (&gn)[32], int lane) {
    const int c0 = 32 * lane;
    const bf16_t* gp = prow + (c0 < 1024 ? C_AG + c0 : C_BZ + c0 - 1024);
    v4u o4[4], z4[4];
#pragma unroll
    for (int i = 0; i < 4; ++i) { o4[i] = *(const v4u*)(mrow + c0 + 8 * i); z4[i] = *(const v4u*)(gp + 8 * i); }
    float ss = 0.f;
#pragma unroll
    for (int i = 0; i < 4; ++i)
#pragma unroll
        for (int w = 0; w < 4; ++w) { const unsigned a = (w == 0) ? o4[i].x : (w == 1) ? o4[i].y : (w == 2) ? o4[i].z : o4[i].w;
            const float lo = __uint_as_float(a << 16), hi = __uint_as_float(a & 0xffff0000u); ss += lo * lo + hi * hi; }
    ss += __shfl_xor(ss, 1); ss += __shfl_xor(ss, 2);
    const float rstd = rsqrtf(ss * (1.f / 128.f) + EPS);
#pragma unroll
    for (int i = 0; i < 4; ++i) { float yv[8];
#pragma unroll
        for (int w = 0; w < 4; ++w) { const unsigned a = (w == 0) ? o4[i].x : (w == 1) ? o4[i].y : (w == 2) ? o4[i].z : o4[i].w;
            const unsigned z = (w == 0) ? z4[i].x : (w == 1) ? z4[i].y : (w == 2) ? z4[i].z : z4[i].w;
            yv[2 * w] = __uint_as_float(a << 16) * rstd * gn[8 * i + 2 * w] * __uint_as_float(z << 16);
            yv[2 * w + 1] = __uint_as_float(a & 0xffff0000u) * rstd * gn[8 * i + 2 * w + 1] * __uint_as_float(z & 0xffff0000u); }
        v4u y4; y4.x = pk2(yv[0], yv[1]); y4.y = pk2(yv[2], yv[3]); y4.z = pk2(yv[4], yv[5]); y4.w = pk2(yv[6], yv[7]);
        *(v4u*)(mrow + c0 + 8 * i) = y4; }
}

struct EpiProj {
    static constexpr bool PERM = true, AFTER_DRAIN = false;
    bf16_t* O; int ldc;
    __device__ __forceinline__ void operator()(const pg8::f32x4 (&acc)[2][2][4][2], const pg8::Unit& u, int wr, int wc, int fr, int fq) const {
        const int row0 = u.pm * 256 + wr * 64 + fr, col0 = u.pn * 256 + wc * 32 + 8 * fq;
        const bool gate = (u.pn >= 12 && u.pn < 16) || (u.pn >= 24);
#pragma unroll
        for (int ai = 0; ai < 2; ++ai)
#pragma unroll
            for (int m = 0; m < 4; ++m) { bf16_t* rowp = O + (size_t)(row0 + ai * 128 + m * 16) * ldc + col0;
#pragma unroll
                for (int bj = 0; bj < 2; ++bj) { pg8::f32x4 v0 = acc[ai][bj][m][0], v1 = acc[ai][bj][m][1];
                    if (gate) {
#pragma unroll
                        for (int e = 0; e < 4; ++e) { v0[e] = v0[e] * __builtin_amdgcn_rcpf(1.f + __expf(-v0[e])); v1[e] = v1[e] * __builtin_amdgcn_rcpf(1.f + __expf(-v1[e])); } }
                    pg8::u32x4 w; w.x = pk2(v0[0], v0[1]); w.y = pk2(v0[2], v0[3]); w.z = pk2(v1[0], v1[1]); w.w = pk2(v1[2], v1[3]);
                    *(pg8::u32x4*)(rowp + bj * 128) = w; } }
    }
};
struct EpiResF32 {
    static constexpr bool PERM = false, AFTER_DRAIN = false;
    const float* R; float* O; int ldc;
    __device__ __forceinline__ void operator()(const pg8::f32x4 (&acc)[2][2][4][2], const pg8::Unit& u, int wr, int wc, int fr, int fq) const {
        const int row0 = u.pm * 256 + wr * 64 + fr, col0 = u.pn * 256 + wc * 32 + 4 * fq;
#pragma unroll
        for (int ai = 0; ai < 2; ++ai)
#pragma unroll
            for (int m = 0; m < 4; ++m) { const size_t off = (size_t)(row0 + ai * 128 + m * 16) * ldc + col0;
#pragma unroll
                for (int bj = 0; bj < 2; ++bj)
#pragma unroll
                    for (int n = 0; n < 2; ++n) { pg8::f32x4 v = acc[ai][bj][m][n]; if (R) v = v + *(const pg8::f32x4*)(R + off + bj * 128 + n * 16); *(pg8::f32x4*)(O + off + bj * 128 + n * 16) = v; } }
    }
};

#define XB_TMO      128
#define XB_XCNT(j)  (256  + 64 * (j))
#define XB_XSUB(j)  (1280 + 64 * (j))
#define XB_XGEN(j)  (2304 + 64 * (j))
#define XB_TOP      3328
#define XB_TOPGEN   3392
#define XCD_BAR_WORDS 3456
#define XB_SPIN_CAP (1u << 18)

__device__ __forceinline__ unsigned xb_ld(unsigned* p)              { return __hip_atomic_load(p, __ATOMIC_RELAXED, __HIP_MEMORY_SCOPE_AGENT); }
__device__ __forceinline__ unsigned xb_add(unsigned* p, unsigned v) { return __hip_atomic_fetch_add(p, v, __ATOMIC_RELAXED, __HIP_MEMORY_SCOPE_AGENT); }
__device__ __forceinline__ unsigned xb_xcc_id() { return (unsigned)__builtin_amdgcn_s_getreg((3 << 11) | 20) & 0xFu; }
#define XB_SPIN(cond, bar) do { unsigned _sp = 0; while (cond) { __builtin_amdgcn_s_sleep(1); \
    if ((++_sp & 255u) == 0u) { if (xb_ld(&(bar)[XB_TMO])) break; if (_sp > XB_SPIN_CAP) { atomicAdd(&(bar)[XB_TMO], 1u); break; } } } } while (0)

struct XcdBarrier {
    unsigned* bar; unsigned x;
    volatile LAS unsigned* st;
};

__device__ __forceinline__ XcdBarrier xcd_barrier_post(unsigned* bar, volatile LAS unsigned* st) {
    XcdBarrier b; b.bar = bar; b.x = xb_xcc_id(); b.st = st;
    if (threadIdx.x == 0) (void)xb_add(&bar[XB_XCNT(b.x)], 1u);
    return b;
}
__device__ __forceinline__ void xcd_barrier_complete(unsigned* bar, unsigned x, unsigned& nloc, unsigned& nx) {
    const unsigned G = gridDim.x * gridDim.y * gridDim.z;
    unsigned sum, cnt, mine, sp = 0u;
    for (;;) {
        sum = 0u; cnt = 0u; mine = 0u;
#pragma unroll
        for (unsigned j = 0; j < 16; ++j) { const unsigned c = xb_ld(&bar[XB_XCNT(j)]); sum += c; cnt += (c > 0u) ? 1u : 0u; mine = (j == x) ? c : mine; }
        if (sum == G) break;
        __builtin_amdgcn_s_sleep(1);
        if ((++sp & 255u) == 0u) { if (xb_ld(&bar[XB_TMO])) break; if (sp > XB_SPIN_CAP) { atomicAdd(&bar[XB_TMO], 1u); break; } }
    }
    nloc = mine > 0u ? mine : 1u; nx = cnt > 0u ? cnt : 1u;
}

__device__ __forceinline__ void xcd_barrier(const XcdBarrier& b) {
    asm volatile("s_waitcnt vmcnt(0)" ::: "memory");
    __syncthreads();
    if (threadIdx.x == 0) {
        unsigned* bar = b.bar;
        __builtin_amdgcn_s_waitcnt(0);
        unsigned nloc = b.st[0], nx = b.st[1];
        if (nloc == 0u) { xcd_barrier_complete(bar, b.x, nloc, nx); b.st[0] = nloc; b.st[1] = nx; }
        const unsigned old = xb_add(&bar[XB_XSUB(b.x)], 1u);
        const unsigned gen = old / nloc;
        if (old + 1u == (gen + 1u) * nloc) {
            __builtin_amdgcn_fence(__ATOMIC_RELEASE, "agent");
            asm volatile("s_waitcnt vmcnt(0)" ::: "memory");
            const unsigned og = xb_add(&bar[XB_TOP], 1u);
            const unsigned tg = og / nx;
            if (og + 1u == (tg + 1u) * nx) xb_add(&bar[XB_TOPGEN], 1u);
            else XB_SPIN(xb_ld(&bar[XB_TOPGEN]) == tg, bar);
            __builtin_amdgcn_fence(__ATOMIC_ACQUIRE, "agent");
            xb_add(&bar[XB_XGEN(b.x)], 1u);
            asm volatile("s_waitcnt vmcnt(0)" ::: "memory");
        } else {
            XB_SPIN(xb_ld(&bar[XB_XGEN(b.x)]) == gen, bar);
            __builtin_amdgcn_fence(__ATOMIC_ACQUIRE, "agent");
            asm volatile("s_waitcnt vmcnt(0)" ::: "memory");
        }
    }
    __syncthreads();
}

__device__ __forceinline__ int get_lane() { int l = (int)__builtin_amdgcn_mbcnt_hi(~0u, __builtin_amdgcn_mbcnt_lo(~0u, 0u)); asm volatile("" : "+v"(l)); return l; }
__global__ void __launch_bounds__(NT, 2) mk_fwd(Args args) {
    extern __shared__ __attribute__((aligned(16))) unsigned char lds_raw[];
    LAS unsigned char* lds = (LAS unsigned char*)lds_raw;
    cg::grid_group grid = cg::this_grid();
    const int tid = threadIdx.x, wave = __builtin_amdgcn_readfirstlane(tid >> 6);

    const int G = gridDim.x, bx = blockIdx.x;
    const int vcu = (G % 8 == 0) ? (bx % 8) * (G / 8) + bx / 8 : bx;
    const int gw = vcu * NW + wave, NGW = G * NW;
    unsigned char* ws = args.ws;
    const float* x = args.in[0]; const float* attn_g = args.in[1]; const float* w_in = args.in[2];
    const float* w_out = args.in[9]; const float* ffn_g = args.in[10]; const float* w_query = args.in[11]; const float* sub_keys = args.in[12];
    bf16_t* WinT = (bf16_t*)(ws + OFF_D);
    bf16_t* WoutT = (bf16_t*)(ws + OFF_C);
    bf16_t* Wqk = (bf16_t*)(ws + OFF_C + 8 * MiB);
    bf16_t* xn = (bf16_t*)(ws + OFF_D + 28 * MiB);
    float* ba = (float*)(ws + OFF_S);
    bf16_t* proj = (bf16_t*)(ws + OFF_B);
    bf16_t* mix = (bf16_t*)args.out;
    unsigned char* pb = ws + OFF_D; float* vecs = (float*)(ws + OFF_S + 2 * MiB);
    float* hbuf = (float*)(ws + OFF_B);
    bf16_t* hn = (bf16_t*)(ws + OFF_D + 128 * MiB);
    float* scores = (float*)(ws + OFF_D);
    unsigned char* U8 = ws + OFF_TAB; unsigned char* V8 = ws + OFF_TAB + 16 * MiB;
    float* inv_su = (float*)(ws + OFF_S + 1 * MiB); float* inv_sv = inv_su + 16384;

    volatile LAS unsigned* xbst = (volatile LAS unsigned*)(lds + LDS_BYTES - 16);
    if (tid < 4) xbst[tid] = 0u;
    __syncthreads();
    XcdBarrier xbar = xcd_barrier_post((unsigned*)args.ws, xbst);
    const int lo = args.ph_lo, hi = args.ph_hi;
#define IN(k) (lo <= (k) && (k) < hi)
#define SYNC_AFTER(k) do { if (IN(k) && (k) + 1 < hi) { if ((k) == 0) grid.sync(); else xcd_barrier(xbar); } } while (0)
    {
        if (IN(0)) {
            const int lane = get_lane();
            LAS float* scr = (LAS float*)(lds + wave * 16384);
            constexpr int I_IN = (DM / 64) * (NPROJ / 32);
            for (int it = gw; it < I_IN; it += NGW) transpose_item(w_in, INW, DM, NPROJ, WinT, scr, it, lane);
            __syncthreads();
            {
                LAS float* wt = (LAS float*)lds;
#pragma unroll
                for (int k = 0; k < 4; ++k) { const int d = tid + 512 * k; const float* wr = w_in + (size_t)d * INW + NPROJ;
#pragma unroll
                    for (int q4 = 0; q4 < 4; ++q4) { const f32x4 w4 = *(const f32x4*)(wr + 4 * q4);
                        wt[(4 * q4 + 0) * 2048 + d] = w4.x; wt[(4 * q4 + 1) * 2048 + d] = w4.y; wt[(4 * q4 + 2) * 2048 + d] = w4.z; wt[(4 * q4 + 3) * 2048 + d] = w4.w; } }
            }
            __syncthreads();
            for (int m = gw; m < T; m += NGW) norm_row<true>(x + (size_t)m * DM, attn_g, (const LAS float*)lds, xn + (size_t)m * DM, ba + (size_t)m * 16, lane);
        }
        SYNC_AFTER(0);
        if (IN(1)) {
            pg8::Gemm g{xn, WinT, T, NPROJ, DM}; pg8::StaticOrder S; S.init(T, NPROJ, G, bx);
            EpiProj E{proj, NPROJ};
            pg8::gemm_phase<EpiProj, pg8::StaticOrder, true, true>(lds, g, S, E);
        }
        SYNC_AFTER(1);
        if (IN(2)) {
            for (int it = bx; it < 2048; it += G) { int tt = threadIdx.x; asm volatile("" : "+v"(tt)); hgrn_prep_item(it, proj, args.in[3], pb, vecs, lds, tt); }
            for (int it = bx; it < 1024; it += G) { int tt = threadIdx.x; asm volatile("" : "+v"(tt)); gdn_prep_item(it, proj, ba, args.in[5], args.in[6], args.in[7], pb, vecs, lds, tt); }
        }
        SYNC_AFTER(2);
        if (IN(3)) {
            const int lane = get_lane();
            unsigned* ctl = (unsigned*)args.ws;
            if (bx < NSB) {
                const int sq = (bx & 7) + 8 * (bx / (8 * (4 / NCW))), cgp = (bx >> 3) % (4 / NCW);
                if (sq >= 16) scan_block<true>(sq, cgp, proj, pb, vecs, args.in[4], args.in[8], mix, ctl + PROG_WORD, lds, tid);
                else scan_block<false>(sq, cgp, proj, pb, vecs, args.in[4], args.in[8], mix, ctl + PROG_WORD, lds, tid);
            }
            else if (G > NSB) {
                int fb, FB;
                fb = bx - NSB; FB = G - NSB;
                const int fw = fb * NW + wave, FW = FB * NW;
                for (int it = fb; it < 512; it += FB) wqk_item(w_query, sub_keys, Wqk, (LAS float*)lds, it, tid);
                LAS float* scr = (LAS float*)(lds + wave * 16384);
                constexpr int I_OUT = (DM / 64) * (DM / 32);
                for (int it = fw; it < I_OUT; it += FW) transpose_item(w_out, DM, DM, DM, WoutT, scr, it, lane);
                for (int e = fw; e < 32768; e += FW) { const bool isv = e >= 16384; const int r = e & 16383;
                    table_row((isv ? args.in[14] : args.in[13]) + (size_t)r * DM, (unsigned*)((isv ? V8 : U8) + (size_t)r * 1024), (isv ? inv_sv : inv_su) + r, lane); }
            }
        }
        SYNC_AFTER(3);
        if (IN(4)) {
            {
                const int lane = get_lane();
                float gn[32];
                { const float* gsrc = ((32 * lane) < 1024 ? args.in[4] : args.in[8]) + ((32 * lane) & 127);
#pragma unroll
                  for (int i = 0; i < 8; ++i) { const f32x4 g4 = *(const f32x4*)(gsrc + 4 * i); gn[4 * i] = g4.x; gn[4 * i + 1] = g4.y; gn[4 * i + 2] = g4.z; gn[4 * i + 3] = g4.w; } }
                for (int m = gw; m < T; m += NGW) mixnorm_row(mix + (size_t)m * DM, proj + (size_t)m * NPROJ, gn, lane);
                xcd_barrier(xbar);
            }
            pg8::Gemm g{mix, WoutT, T, DM, DM}; pg8::StaticOrder S; S.init(T, DM, G, bx);
            EpiResF32 E{x, hbuf, DM};
            pg8::gemm_phase<EpiResF32, pg8::StaticOrder, true, true>(lds, g, S, E);
        }
        SYNC_AFTER(4);
        if (IN(5)) {
            const int lane = get_lane();
            for (int m = gw; m < T; m += NGW) norm_row<false>(hbuf + (size_t)m * DM, ffn_g, (const LAS float*)lds, hn + (size_t)m * DM, nullptr, lane);
        }
        SYNC_AFTER(5);
        if (IN(6)) {
            pg8::Gemm g{hn, Wqk, T, DM, DM}; pg8::StaticOrder S; S.init(T, DM, G, bx);
            EpiResF32 E{nullptr, scores, DM};
            pg8::gemm_phase<EpiResF32, pg8::StaticOrder, true, true>(lds, g, S, E);
        }
        SYNC_AFTER(6);
        if (IN(7)) {
            const int lane = get_lane();
            LAS int* se = (LAS int*)(lds + wave * 4096); LAS float* sa = (LAS float*)(lds + wave * 4096 + 512); LAS float* sb = (LAS float*)(lds + wave * 4096 + 1024);
            for (int t = gw; t < T; t += NGW) { const int ln = get_lane(); peer_token(t, scores, hn, hbuf, U8, V8, inv_su, inv_sv, args.in[15], args.out, se, sa, sb, ln); }
        }
    }
}
}

extern "C" void kernel_launch(void* const* d_in, const int* in_sizes, int n_in, void* d_out, int out_size, void* d_ws, size_t ws_size, hipStream_t stream) {
    static int grid = 0;
    if (grid == 0) {
        int dev = 0, cus = 0, per_cu = 0;
        (void)hipGetDevice(&dev);
        (void)hipDeviceGetAttribute(&cus, hipDeviceAttributeMultiprocessorCount, dev);
        (void)hipFuncSetAttribute((const void*)mk::mk_fwd, hipFuncAttributeMaxDynamicSharedMemorySize, mk::LDS_BYTES);
        (void)hipOccupancyMaxActiveBlocksPerMultiprocessor(&per_cu, (const void*)mk::mk_fwd, mk::NT, mk::LDS_BYTES);
        if (per_cu < 1) { fprintf(stderr, "occupancy query says %d\n", per_cu); per_cu = 1; }
        grid = cus;
    }
    unsigned char* ws = (unsigned char*)d_ws;
    (void)hipMemsetAsync(d_ws, 0, 16384, stream);
    mk::Args a{};
    for (int i = 0; i < 16; ++i) a.in[i] = (const float*)d_in[i];
    a.out = (float*)d_out; a.ws = ws;
    {
        a.ph_lo = 0; a.ph_hi = 8;
        void* kargs[] = {&a};
        hipError_t e = hipLaunchCooperativeKernel((const void*)mk::mk_fwd, dim3(grid), dim3(mk::NT), kargs, mk::LDS_BYTES, stream);
        if (e != hipSuccess) fprintf(stderr, "coop launch failed: %s\n", hipGetErrorString(e));
    }
}
```

```cpp
#include <hip/hip_runtime.h>
#include <hip/hip_cooperative_groups.h>
#include <cstdio>
namespace cg = cooperative_groups;
#include <stdint.h>

typedef unsigned short bf16_t;
typedef float f32x4 __attribute__((ext_vector_type(4)));

constexpr int T = 16384, SEQ = 8192, DM = 2048, INW = 7184, NPROJ = 7168;
constexpr float EPS = 1e-6f;
constexpr size_t MiB = 1u << 20;
constexpr size_t OFF_TAB = 1 * MiB;
constexpr size_t OFF_B = 65 * MiB;
constexpr size_t OFF_C = 289 * MiB;
constexpr size_t OFF_D = 305 * MiB;
constexpr size_t OFF_S = 500 * MiB;
constexpr int C_AQ = 0, C_AF = 1024, C_AI = 2048, C_AG = 3072, C_BQ = 4096, C_BK = 4608, C_BV = 5120, C_BZ = 6144;

__device__ __forceinline__ float bf2f(bf16_t v) { return __uint_as_float(((unsigned)v) << 16); }
typedef float f32x2_t __attribute__((ext_vector_type(2)));
typedef __bf16 bf16x2_t __attribute__((ext_vector_type(2)));
__device__ __forceinline__ unsigned cvt_pk2(float lo, float hi) { f32x2_t v = {lo, hi}; bf16x2_t b = __builtin_convertvector(v, bf16x2_t); return __builtin_bit_cast(unsigned, b); }
__device__ __forceinline__ bf16_t f2bf(float f) { return (bf16_t)(cvt_pk2(f, 0.f) & 0xffffu); }
__device__ __forceinline__ float sigmoidf_(float x) { return 1.f / (1.f + __expf(-x)); }
__device__ __forceinline__ float siluf_(float x) { return x / (1.f + __expf(-x)); }
__device__ __forceinline__ float wave_sum(float v) {
#pragma unroll
    for (int o = 1; o < 64; o <<= 1) v += __shfl_xor(v, o);
    return v;
}
__device__ __forceinline__ float block_sum(float v, float* sh) {
    v = wave_sum(v);
    const int w = threadIdx.x >> 6, nw = blockDim.x >> 6;
    __syncthreads();
    if ((threadIdx.x & 63) == 0) sh[w] = v;
    __syncthreads();
    float r = 0.f;
    for (int i = 0; i < nw; ++i) r += sh[i];
    return r;
}

__device__ __forceinline__ float gelu_erf(float x) { return 0.5f * x * (1.f + erff(x * 0.70710678118654752f)); }
namespace pg8 {
#define PG8_LAS __attribute__((address_space(3)))
typedef unsigned short bf16_t;
typedef short bf16x8 __attribute__((ext_vector_type(8)));
typedef float f32x4 __attribute__((ext_vector_type(4)));
typedef unsigned u32x4 __attribute__((ext_vector_type(4)));
constexpr int BM = 256, BK = 64, HALF = 128, HTB = HALF * BK * 2  , STAGE_BYTES = 8 * HTB, NXCD = 8, WGM = 8;

__host__ __device__ __forceinline__ int lds_byte(int r, int c) { const int st = (r >> 4) * 2 + (c >> 5), rr = r & 15, cc = c & 31, ob = rr * 64 + cc * 2; return st * 1024 + (ob ^ (((ob >> 9) & 1) << 5)); }
__host__ __device__ __forceinline__ void stage_rc(int b, int& R, int& C) { const int st = b / 1024, sb = b % 1024, swz = sb ^ (((sb >> 9) & 1) << 5); R = (st >> 1) * 16 + swz / 64; C = (st & 1) * 32 + (swz % 64) / 2; }
__host__ __device__ __forceinline__ int perm32(int rho) { const int n = rho >> 4, i = rho & 15; return 8 * (i >> 2) + 4 * n + (i & 3); }

struct Unit { int pm, pn; };
struct Gemm { const bf16_t* A; const bf16_t* Bt; int M, N, K; };

struct StaticOrder {
    int nM, nN, nwg, G, c;
    __host__ __device__ void init(int M, int N, int G_, int c_) { nM = M / BM; nN = N / BM; nwg = nM * nN; G = G_; c = c_; }
    __host__ __device__ bool next(int i, Unit& u) const {
        const long L = (long)i * G + c; if (L >= nwg) return false;
        int wgid = (int)L; { const int q = nwg / NXCD, r = nwg % NXCD, xcd = wgid % NXCD, off = wgid / NXCD; wgid = (xcd < r ? xcd * (q + 1) : r * (q + 1) + (xcd - r) * q) + off; }
        const int nig = WGM * nN, gid = wgid / nig, fm = gid * WGM, gsz = (nM - fm) < WGM ? (nM - fm) : WGM;
        u.pm = fm + ((wgid % nig) % gsz); u.pn = (wgid % nig) / gsz; return true;
    }
    __device__ __forceinline__ void a_ready(const Unit&) const {}
    __device__ __forceinline__ void done(const Unit&) const {}
};

__device__ __forceinline__ unsigned cvt_pk_bf16(float lo, float hi) { unsigned r; asm volatile("v_cvt_pk_bf16_f32 %0, %1, %2" : "=v"(r) : "v"(lo), "v"(hi)); return r; }
typedef float f32x2 __attribute__((ext_vector_type(2)));
__device__ __forceinline__ f32x2 gelu_pk(f32x2 v) {
    const f32x2 av = __builtin_elementwise_abs(v), d = av * 0.2316418882f + 1.0f;
    f32x2 t; t.x = __builtin_amdgcn_rcpf(d.x); t.y = __builtin_amdgcn_rcpf(d.y);
    f32x2 q = t * 0.5307027145f + (-0.7265760135f); q = q * t + 0.7107068705f; q = q * t + (-0.142248368f); q = q * t + 0.127414796f; q = q * t;
    const f32x2 s = (v * v) * (-0.72134752044f);
    f32x2 e; e.x = __builtin_amdgcn_exp2f(s.x); e.y = __builtin_amdgcn_exp2f(s.y);
    const f32x2 m = v * (q * e), r = v - m;
    f32x2 o; o.x = v.x < 0.f ? m.x : r.x; o.y = v.y < 0.f ? m.y : r.y; return o;
}

template <int ACT  > struct EpiBf16 {
    static constexpr bool PERM = true, AFTER_DRAIN = false; static_assert(ACT == 0 || ACT == 1, "EpiBf16: ACT is 0 (none) or 1 (gelu_pk)");
    bf16_t* O; int ldc; const float* bias; int split_cols; size_t split_stride; float scale0;
    __device__ __forceinline__ void operator()(const f32x4 (&acc)[2][2][4][2], const Unit& u, int wr, int wc, int fr, int fq) const {
        const int row0 = u.pm * BM + wr * 64 + fr; int colt = u.pn * BM; bf16_t* base = O;
        float sc = 1.f; if (split_cols) { const int t = colt / split_cols; base += (size_t)t * split_stride; colt -= t * split_cols; if (t == 0) sc = scale0; }
        const int col0 = colt + wc * 32 + 8 * fq, bcol0 = u.pn * BM + wc * 32 + 8 * fq;
        f32x4 bv[2][2];
#pragma unroll
        for (int bj = 0; bj < 2; ++bj)
#pragma unroll
            for (int n = 0; n < 2; ++n) bv[bj][n] = bias ? *(const f32x4*)(bias + bcol0 + bj * HALF + 4 * n) : (f32x4){0.f, 0.f, 0.f, 0.f};
#pragma unroll
        for (int ai = 0; ai < 2; ++ai)
#pragma unroll
            for (int m = 0; m < 4; ++m) { bf16_t* rowp = base + (size_t)(row0 + ai * HALF + m * 16) * ldc + col0;
#pragma unroll
                for (int bj = 0; bj < 2; ++bj) { f32x4 v0 = acc[ai][bj][m][0] + bv[bj][0], v1 = acc[ai][bj][m][1] + bv[bj][1];
                    if (ACT == 1) { f32x2 a = gelu_pk((f32x2){v0[0], v0[1]}), b = gelu_pk((f32x2){v0[2], v0[3]}), c = gelu_pk((f32x2){v1[0], v1[1]}), d = gelu_pk((f32x2){v1[2], v1[3]});
                        v0 = (f32x4){a.x, a.y, b.x, b.y}; v1 = (f32x4){c.x, c.y, d.x, d.y}; }
                    v0 = v0 * sc; v1 = v1 * sc; u32x4 w; w.x = cvt_pk_bf16(v0[0], v0[1]); w.y = cvt_pk_bf16(v0[2], v0[3]); w.z = cvt_pk_bf16(v1[0], v1[1]); w.w = cvt_pk_bf16(v1[2], v1[3]);
                    *(u32x4*)(rowp + bj * HALF) = w; } }
    }
};
template <class Epi, class Sched, bool ALIGN_EPI = false, bool SP2 = false>
__device__ __forceinline__ void gemm_phase(PG8_LAS unsigned char* lds, const Gemm g, const Sched& S, const Epi& E) {
    const int tid = threadIdx.x, wid = __builtin_amdgcn_readfirstlane(tid >> 6), lane = tid & 63, wr = wid >> 2, wc = wid & 3, fr = lane & 15, fq = lane >> 4;
    const int K = g.K, nt = K / BK;
    unsigned voffA[2], voffB[2];
#pragma unroll
    for (int i = 0; i < 2; ++i) { int R, C; stage_rc(tid * 16 + i * 8192, R, C); const int Rb = Epi::PERM ? ((R & ~31) + perm32(R & 31)) : R;
        voffA[i] = (unsigned)(R * K + C) * 2u; voffB[i] = (unsigned)(Rb * K + C) * 2u; }
    const size_t kstep = (size_t)(BK * 2);
    const size_t hstep = (size_t)HALF * K * 2;
    const size_t tstep = 2 * hstep;
    const unsigned ldsw = (unsigned)wid * 1024u;
    const int aoff = lds_byte(wr * 64 + fr, fq * 8), boff = lds_byte(wc * 32 + fr, fq * 8);
#define PG8_SA(b, h) (((b) * 2 + (h)) * HTB)
#define PG8_SB(b, h) ((4 + (b) * 2 + (h)) * HTB)
#define PG8_STAGE(bufoff, gbase, voff) do { _Pragma("unroll") for (int _i = 0; _i < 2; ++_i) \
        __builtin_amdgcn_global_load_lds((const unsigned*)((const char*)(gbase) + (voff)[_i]), (PG8_LAS unsigned*)(lds + (bufoff) + ldsw + _i * 8192), 16, 0, 0); } while (0)
#define PG8_LDA(dst, b, h) do { _Pragma("unroll") for (int m = 0; m < 4; ++m) _Pragma("unroll") for (int k = 0; k < 2; ++k) dst[m][k] = *(const PG8_LAS bf16x8*)(lds + PG8_SA(b, h) + aoff + m * 2048 + k * 1024); } while (0)
#define PG8_LDB(dst, b, h) do { _Pragma("unroll") for (int n = 0; n < 2; ++n) _Pragma("unroll") for (int k = 0; k < 2; ++k) dst[n][k] = *(const PG8_LAS bf16x8*)(lds + PG8_SB(b, h) + boff + n * 2048 + k * 1024); } while (0)
#define PG8_MMA(ai, bj, At, Bt) do { __builtin_amdgcn_s_setprio(1); _Pragma("unroll") for (int m = 0; m < 4; ++m) _Pragma("unroll") for (int n = 0; n < 2; ++n) _Pragma("unroll") for (int k = 0; k < 2; ++k) \
        acc[ai][bj][m][n] = __builtin_amdgcn_mfma_f32_16x16x32_bf16(Bt[n][k], At[m][k], acc[ai][bj][m][n], 0, 0, 0); __builtin_amdgcn_s_setprio(0); } while (0)
#define PG8_WAIT_V(n) asm volatile("s_waitcnt vmcnt(" #n ")" ::: "memory")
#define PG8_WAIT_L(n) asm volatile("s_waitcnt lgkmcnt(" #n ")" ::: "memory")
#define PG8_BAR __builtin_amdgcn_s_barrier()
#define PG8_SCHED __builtin_amdgcn_sched_barrier(0)
    Unit cur, nxt; int ui = 0;
    if (!S.next(0, cur)) return;
    f32x4 acc[2][2][4][2];
#pragma unroll
    for (int a = 0; a < 2; ++a)
#pragma unroll
        for (int b = 0; b < 2; ++b)
#pragma unroll
            for (int m = 0; m < 4; ++m)
#pragma unroll
                for (int n = 0; n < 2; ++n) acc[a][b][m][n] = (f32x4){0.f, 0.f, 0.f, 0.f};
    bf16x8 At[4][2], B0[2][2], B1[2][2];
    const char* cA = (const char*)g.A + (size_t)cur.pm * tstep; const char* cB = (const char*)g.Bt + (size_t)cur.pn * tstep;
    S.a_ready(cur);
    if constexpr (SP2) {
        PG8_STAGE(PG8_SB(0, 0), cB, voffB); PG8_STAGE(PG8_SB(0, 1), cB + hstep, voffB); PG8_STAGE(PG8_SA(0, 0), cA, voffA); PG8_STAGE(PG8_SA(0, 1), cA + hstep, voffA);
        if (wr == 1) PG8_BAR;
        PG8_WAIT_V(2); PG8_BAR;
        PG8_STAGE(PG8_SB(1, 0), cB + kstep, voffB); PG8_STAGE(PG8_SA(1, 0), cA + kstep, voffA); PG8_STAGE(PG8_SB(1, 1), cB + hstep + kstep, voffB);
        PG8_WAIT_V(6); PG8_BAR;
    } else {
        PG8_STAGE(PG8_SB(0, 0), cB, voffB); PG8_STAGE(PG8_SA(0, 0), cA, voffA); PG8_STAGE(PG8_SB(0, 1), cB + hstep, voffB); PG8_STAGE(PG8_SA(0, 1), cA + hstep, voffA);
        if (wr == 1) PG8_BAR;
        PG8_WAIT_V(4); PG8_BAR;
        PG8_STAGE(PG8_SB(1, 0), cB + kstep, voffB); PG8_STAGE(PG8_SA(1, 0), cA + kstep, voffA); PG8_STAGE(PG8_SB(1, 1), cB + hstep + kstep, voffB);
        PG8_WAIT_V(6); PG8_BAR;
    }
    for (;;) {
        const bool has_next = S.next(ui + 1, nxt);
        const char* nA = has_next ? (const char*)g.A + (size_t)nxt.pm * tstep : cA; const char* nB = has_next ? (const char*)g.Bt + (size_t)nxt.pn * tstep : cB;
        for (int t = 0; t < nt; t += 2) {
            const bool last = (t == nt - 2);
            const char* a1 = cA + (size_t)(t + 1) * kstep;
            const char* a2 = last ? nA : cA + (size_t)(t + 2) * kstep; const char* b2 = last ? nB : cB + (size_t)(t + 2) * kstep;
            const char* a3 = a2 + kstep; const char* b3 = b2 + kstep;
            if (last && has_next) S.a_ready(nxt);
            if constexpr (SP2) {
            PG8_LDB(B0, 0, 0); PG8_LDB(B1, 0, 1); PG8_SCHED; PG8_LDA(At, 0, 0); PG8_STAGE(PG8_SA(1, 1), a1 + hstep, voffA);
            PG8_WAIT_V(8); PG8_WAIT_L(0); PG8_BAR; PG8_MMA(0, 0, At, B0); PG8_MMA(0, 1, At, B1); PG8_BAR; PG8_SCHED;
            PG8_LDA(At, 0, 1); PG8_STAGE(PG8_SB(0, 0), b2, voffB); PG8_STAGE(PG8_SB(0, 1), b2 + hstep, voffB); PG8_STAGE(PG8_SA(0, 0), a2, voffA);
            PG8_WAIT_V(8); PG8_WAIT_L(0); PG8_BAR; PG8_MMA(1, 0, At, B0); PG8_MMA(1, 1, At, B1); PG8_BAR; PG8_SCHED;
            PG8_LDB(B0, 1, 0); PG8_LDB(B1, 1, 1); PG8_SCHED; PG8_LDA(At, 1, 0); PG8_STAGE(PG8_SA(0, 1), a2 + hstep, voffA);
            PG8_WAIT_V(8); PG8_WAIT_L(0); PG8_BAR; PG8_MMA(0, 0, At, B0); PG8_MMA(0, 1, At, B1); PG8_BAR; PG8_SCHED;
            PG8_LDA(At, 1, 1); PG8_STAGE(PG8_SB(1, 0), b3, voffB); PG8_STAGE(PG8_SB(1, 1), b3 + hstep, voffB); PG8_STAGE(PG8_SA(1, 0), a3, voffA);
            PG8_WAIT_V(8); PG8_WAIT_L(0); PG8_BAR; PG8_MMA(1, 0, At, B0); PG8_MMA(1, 1, At, B1); PG8_BAR; PG8_SCHED;
            } else {
            PG8_LDB(B0, 0, 0); PG8_SCHED; PG8_LDA(At, 0, 0); PG8_STAGE(PG8_SA(1, 1), a1 + hstep, voffA);
            PG8_WAIT_L(8); PG8_BAR; PG8_WAIT_L(0); PG8_MMA(0, 0, At, B0); PG8_BAR; PG8_SCHED;
            PG8_LDB(B1, 0, 1); PG8_STAGE(PG8_SB(0, 0), b2, voffB);
            PG8_BAR; PG8_WAIT_L(0); PG8_MMA(0, 1, At, B1); PG8_BAR;
            PG8_LDA(At, 0, 1); PG8_STAGE(PG8_SA(0, 0), a2, voffA);
            PG8_BAR; PG8_WAIT_L(0); PG8_MMA(1, 0, At, B0); PG8_BAR; PG8_SCHED;
            PG8_STAGE(PG8_SB(0, 1), b2 + hstep, voffB);
            PG8_WAIT_V(6); PG8_BAR; PG8_MMA(1, 1, At, B1); PG8_BAR;
            PG8_LDB(B0, 1, 0); PG8_SCHED; PG8_LDA(At, 1, 0); PG8_STAGE(PG8_SA(0, 1), a2 + hstep, voffA);
            PG8_WAIT_L(8); PG8_BAR; PG8_WAIT_L(0); PG8_MMA(0, 0, At, B0); PG8_BAR; PG8_SCHED;
            PG8_LDB(B1, 1, 1); PG8_STAGE(PG8_SB(1, 0), b3, voffB);
            PG8_BAR; PG8_WAIT_L(0); PG8_MMA(0, 1, At, B1); PG8_BAR;
            PG8_LDA(At, 1, 1); PG8_STAGE(PG8_SA(1, 0), a3, voffA);
            PG8_BAR; PG8_WAIT_L(0); PG8_MMA(1, 0, At, B0); PG8_BAR; PG8_SCHED;
            PG8_STAGE(PG8_SB(1, 1), b3 + hstep, voffB);
            PG8_WAIT_V(6); PG8_BAR; PG8_MMA(1, 1, At, B1); PG8_BAR;
            }
        }
        if constexpr (ALIGN_EPI) { if (wr == 0) PG8_BAR; }
        if constexpr (!Epi::AFTER_DRAIN) { E(acc, cur, wr, wc, fr, fq); S.done(cur); }
        if (!has_next) break;
#pragma unroll
        for (int a = 0; a < 2; ++a)
#pragma unroll
            for (int b = 0; b < 2; ++b)
#pragma unroll
                for (int m = 0; m < 4; ++m)
#pragma unroll
                    for (int n = 0; n < 2; ++n) acc[a][b][m][n] = (f32x4){0.f, 0.f, 0.f, 0.f};
        cur = nxt; cA = nA; cB = nB; ++ui;
        if constexpr (ALIGN_EPI) { if (wr == 1) PG8_BAR; }
    }
    PG8_WAIT_V(0);
    if constexpr (!ALIGN_EPI) { if (wr == 0) PG8_BAR; }
    PG8_BAR;
    if constexpr (Epi::AFTER_DRAIN) { E.fused(acc, cur, wr, wc, fr, fq, lds, wid, lane); S.done(cur); }
#undef PG8_SA
#undef PG8_SB
#undef PG8_STAGE
#undef PG8_LDA
#undef PG8_LDB
#undef PG8_MMA
#undef PG8_WAIT_V
#undef PG8_WAIT_L
#undef PG8_BAR
#undef PG8_SCHED
}
}

namespace mk {
#define LAS __attribute__((address_space(3)))
#define GAS __attribute__((address_space(1)))
typedef unsigned v4u __attribute__((ext_vector_type(4)));
typedef unsigned v2u __attribute__((ext_vector_type(2)));
constexpr int NW = 8, NT = 512, LDS_BYTES = 163840, RING_BYTES = 131072;
#define LDS_WAIT() asm volatile("s_waitcnt lgkmcnt(0)" ::: "memory")
#define DPP_ROR_ADD(t, n) ((t) + __uint_as_float(__builtin_amdgcn_update_dpp(0u, __float_as_uint(t), 0x120 + (n), 0xf, 0xf, false)))
struct Args { const float* in[16]; float* out; unsigned char* ws; int ph_lo, ph_hi; };
__device__ __forceinline__ unsigned pk2(float lo, float hi) { return cvt_pk2(lo, hi); }

__device__ __forceinline__ void transpose_item(const float* W, int ld, int K, int ncols, bf16_t* WT, LAS float* scr, int item, int lane) {
    const int nblk = ncols / 32, kb = item / nblk, nb = item % nblk, k0 = 64 * kb, n0 = 32 * nb;
#pragma unroll 8
    for (int i = 0; i < 32; ++i) { const int kk = 2 * i + (lane >> 5); scr[kk * 33 + (lane & 31)] = W[(size_t)(k0 + kk) * ld + n0 + (lane & 31)]; }
    LDS_WAIT(); asm volatile("" ::: "memory");
    const int c = lane & 7;
#pragma unroll
    for (int j = 0; j < 4; ++j) { const int n = (lane >> 3) + 8 * j; const LAS float* s = scr + (8 * c) * 33 + n;
        v4u o; o.x = pk2(s[0 * 33], s[1 * 33]); o.y = pk2(s[2 * 33], s[3 * 33]); o.z = pk2(s[4 * 33], s[5 * 33]); o.w = pk2(s[6 * 33], s[7 * 33]);
        *(v4u*)(WT + (size_t)(n0 + n) * K + k0 + 8 * c) = o; }
    LDS_WAIT(); asm volatile("" ::: "memory");
}
template <bool WITH_BA>
__device__ __forceinline__ void norm_row(const float* xrow, const float* g, const LAS float* wt  , bf16_t* orow, float* barow, int lane) {
    f32x4 v[8]; float ss = 0.f;
#pragma unroll
    for (int j = 0; j < 8; ++j) { v[j] = ((const f32x4*)xrow)[64 * j + lane]; ss += (v[j].x * v[j].x + v[j].y * v[j].y) + (v[j].z * v[j].z + v[j].w * v[j].w); }
    ss = wave_sum(ss);
    const float rstd = rsqrtf(ss * (1.f / DM) + EPS);
    float acc[16];
#pragma unroll
    for (int c = 0; c < 16; ++c) acc[c] = 0.f;
#pragma unroll
    for (int j = 0; j < 8; ++j) {
        const f32x4 gg = ((const f32x4*)g)[64 * j + lane];
        const f32x4 y = v[j] * rstd * gg;
        v2u o; o.x = pk2(y.x, y.y); o.y = pk2(y.z, y.w);
        ((v2u*)orow)[64 * j + lane] = o;
        if (WITH_BA) {
#pragma unroll
            for (int c = 0; c < 16; ++c) { const f32x4 w4 = *(const LAS f32x4*)(wt + c * 2048 + 4 * (64 * j + lane));
                acc[c] += (y.x * w4.x + y.y * w4.y) + (y.z * w4.z + y.w * w4.w); }
            __builtin_amdgcn_sched_barrier(0);
        }
    }
    if (WITH_BA) {
        float q8[8], t4[4];
#pragma unroll
        for (int r = 0; r < 8; ++r) { auto sw = __builtin_amdgcn_permlane32_swap(__float_as_uint(acc[r]), __float_as_uint(acc[r + 8]), false, false); q8[r] = __uint_as_float(sw[0]) + __uint_as_float(sw[1]); }
#pragma unroll
        for (int r = 0; r < 4; ++r) { auto sw = __builtin_amdgcn_permlane16_swap(__float_as_uint(q8[r]), __float_as_uint(q8[r + 4]), false, false); t4[r] = __uint_as_float(sw[0]) + __uint_as_float(sw[1]); }
#pragma unroll
        for (int r = 0; r < 4; ++r) { float tv = t4[r]; tv = DPP_ROR_ADD(tv, 8); tv = DPP_ROR_ADD(tv, 4); tv = DPP_ROR_ADD(tv, 2); tv = DPP_ROR_ADD(tv, 1); t4[r] = tv; }
        if ((lane & 15) == 0) { const int gq = lane >> 4;
#pragma unroll
            for (int r = 0; r < 4; ++r) barow[r + 4 * gq] = t4[r]; }
    }
}
__device__ __forceinline__ void wqk_item(const float* Wq, const float* SK, bf16_t* Wqk, LAS float* lds, int item, int tid) {
    const int cbk = item >> 5, d0 = (item & 31) * 64, cb = cbk * 128, h = cbk >> 1, half = cbk & 1;
    LAS float* At = lds; LAS float* Bt = lds + 128 * 68;
    const float* skb = SK + ((size_t)(half * 8 + h) * 128) * 128;
#pragma unroll
    for (int i = 0; i < 4; ++i) { const int idx = tid + 512 * i, d = idx >> 5, k4 = idx & 31;
        const f32x4 w = *(const f32x4*)(Wq + (size_t)(d0 + d) * DM + cb + 4 * k4);
        At[(4 * k4 + 0) * 68 + d] = w.x; At[(4 * k4 + 1) * 68 + d] = w.y; At[(4 * k4 + 2) * 68 + d] = w.z; At[(4 * k4 + 3) * 68 + d] = w.w; }
#pragma unroll
    for (int i = 0; i < 8; ++i) { const int idx = tid + 512 * i, n = idx >> 5, k4 = idx & 31;
        const f32x4 w = *(const f32x4*)(skb + (size_t)n * 128 + 4 * k4);
        Bt[(4 * k4 + 0) * 132 + n] = w.x; Bt[(4 * k4 + 1) * 132 + n] = w.y; Bt[(4 * k4 + 2) * 132 + n] = w.z; Bt[(4 * k4 + 3) * 132 + n] = w.w; }
    __syncthreads();
    const int dy = tid >> 5, nx = tid & 31;
    float acc[4][4];
#pragma unroll
    for (int i = 0; i < 4; ++i)
#pragma unroll
        for (int j = 0; j < 4; ++j) acc[i][j] = 0.f;
#pragma unroll 4
    for (int kk = 0; kk < 128; ++kk) {
        const f32x4 a = *(const LAS f32x4*)(At + kk * 68 + 4 * dy), b = *(const LAS f32x4*)(Bt + kk * 132 + 4 * nx);
        acc[0][0] += a.x * b.x; acc[0][1] += a.x * b.y; acc[0][2] += a.x * b.z; acc[0][3] += a.x * b.w;
        acc[1][0] += a.y * b.x; acc[1][1] += a.y * b.y; acc[1][2] += a.y * b.z; acc[1][3] += a.y * b.w;
        acc[2][0] += a.z * b.x; acc[2][1] += a.z * b.y; acc[2][2] += a.z * b.z; acc[2][3] += a.z * b.w;
        acc[3][0] += a.w * b.x; acc[3][1] += a.w * b.y; acc[3][2] += a.w * b.z; acc[3][3] += a.w * b.w;
    }
#pragma unroll
    for (int j = 0; j < 4; ++j) { v2u o; o.x = pk2(acc[0][j], acc[1][j]); o.y = pk2(acc[2][j], acc[3][j]);
        *(v2u*)(Wqk + (size_t)(cb + 4 * nx + j) * DM + d0 + 4 * dy) = o; }
    __syncthreads();
}

typedef float f32x2 __attribute__((ext_vector_type(2)));
__device__ __forceinline__ int fp4_idx_of(float v) { return (v < 1.75f) ? (int)(v * 2.f + 0.25f) : (v < 2.5f ? 4 : (v < 3.5f ? 5 : (v < 5.f ? 6 : 7))); }
__device__ __forceinline__ void fp4_calibrate(int (&nib)[8]) {
    const unsigned T = 0x76543210u;
    const f32x2 a = __builtin_amdgcn_cvt_scalef32_pk_f32_fp4(T, 1.0f, 0), b = __builtin_amdgcn_cvt_scalef32_pk_f32_fp4(T, 1.0f, 1);
    const f32x2 c = __builtin_amdgcn_cvt_scalef32_pk_f32_fp4(T, 1.0f, 2), d = __builtin_amdgcn_cvt_scalef32_pk_f32_fp4(T, 1.0f, 3);
    nib[0] = fp4_idx_of(a.x); nib[1] = fp4_idx_of(a.y); nib[2] = fp4_idx_of(b.x); nib[3] = fp4_idx_of(b.y);
    nib[4] = fp4_idx_of(c.x); nib[5] = fp4_idx_of(c.y); nib[6] = fp4_idx_of(d.x); nib[7] = fp4_idx_of(d.y);
}
__device__ __forceinline__ void table_row_sw(const float* src, unsigned* dst, float* inv_scale, int lane) {
    int nib[8]; fp4_calibrate(nib);
    f32x4 v[8]; float mx = 0.f;
#pragma unroll
    for (int j = 0; j < 8; ++j) { v[j] = ((const f32x4*)src)[8 * lane + j];
        mx = fmaxf(mx, fmaxf(fmaxf(fabsf(v[j].x), fabsf(v[j].y)), fmaxf(fabsf(v[j].z), fabsf(v[j].w)))); }
#pragma unroll
    for (int o = 1; o < 64; o <<= 1) mx = fmaxf(mx, __shfl_xor(mx, o));
    const float sc = mx > 0.f ? mx * (0.85f / 6.f) : 1.f, isc = 1.f / sc;
    unsigned wd[4];
#pragma unroll
    for (int w = 0; w < 4; ++w) {
        unsigned acc = 0u;
#pragma unroll
        for (int e = 0; e < 8; ++e) {
            const f32x4 q = v[2 * w + (e >> 2)]; const float xe = ((e & 3) == 0) ? q.x : ((e & 3) == 1) ? q.y : ((e & 3) == 2) ? q.z : q.w;
            const float yv = fabsf(xe) * isc;
            unsigned code = (yv > 0.25f) + (yv > 0.75f) + (yv > 1.25f) + (yv > 1.75f) + (yv > 2.5f) + (yv > 3.5f) + (yv > 5.f);
            code |= (xe < 0.f) ? 8u : 0u;
            acc |= code << (4 * nib[e]);
        }
        wd[w] = acc;
    }
    v4u o; o.x = wd[0]; o.y = wd[1]; o.z = wd[2]; o.w = wd[3];
    ((v4u*)dst)[lane] = o;
    if (lane == 0) *inv_scale = sc;
}
__device__ __forceinline__ bool fp4_hw_encoder_ok() {
    unsigned t = 0u, u = 0u;
    t = __builtin_amdgcn_cvt_scalef32_pk_fp4_f32(t, 0.f, 0.5f, 1.0f, 0); t = __builtin_amdgcn_cvt_scalef32_pk_fp4_f32(t, 1.f, -1.5f, 1.0f, 1);
    t = __builtin_amdgcn_cvt_scalef32_pk_fp4_f32(t, 2.f, 3.f, 1.0f, 2); t = __builtin_amdgcn_cvt_scalef32_pk_fp4_f32(t, -4.f, 6.f, 1.0f, 3);
    u = __builtin_amdgcn_cvt_scalef32_pk_fp4_f32(u, 0.2f, 0.3f, 1.0f, 0); u = __builtin_amdgcn_cvt_scalef32_pk_fp4_f32(u, 2.4f, -2.6f, 1.0f, 1);
    u = __builtin_amdgcn_cvt_scalef32_pk_fp4_f32(u, 5.2f, -4.9f, 1.0f, 2); u = __builtin_amdgcn_cvt_scalef32_pk_fp4_f32(u, 1.3f, 0.8f, 1.0f, 3);
    const f32x2 a = __builtin_amdgcn_cvt_scalef32_pk_f32_fp4(t, 1.0f, 0), b = __builtin_amdgcn_cvt_scalef32_pk_f32_fp4(t, 1.0f, 1);
    const f32x2 c = __builtin_amdgcn_cvt_scalef32_pk_f32_fp4(t, 1.0f, 2), d = __builtin_amdgcn_cvt_scalef32_pk_f32_fp4(t, 1.0f, 3);
    const f32x2 e = __builtin_amdgcn_cvt_scalef32_pk_f32_fp4(u, 1.0f, 0), f = __builtin_amdgcn_cvt_scalef32_pk_f32_fp4(u, 1.0f, 1);
    const f32x2 g = __builtin_amdgcn_cvt_scalef32_pk_f32_fp4(u, 1.0f, 2), h = __builtin_amdgcn_cvt_scalef32_pk_f32_fp4(u, 1.0f, 3);
    return a.x == 0.f && a.y == 0.5f && b.x == 1.f && b.y == -1.5f && c.x == 2.f && c.y == 3.f && d.x == -4.f && d.y == 6.f
        && e.x == 0.f && e.y == 0.5f && f.x == 2.f && f.y == -3.f && g.x == 6.f && g.y == -4.f && h.x == 1.5f && h.y == 1.f;
}
__device__ __forceinline__ void table_row2(const float* src, unsigned* dst, float* inv_scale, int lane) {
    if (!fp4_hw_encoder_ok()) { table_row_sw(src, dst, inv_scale, lane); table_row_sw(src + DM, dst + 256, inv_scale + 1, lane); return; }
    f32x4 v[2][8]; float mx[2] = {0.f, 0.f};
#pragma unroll
    for (int r = 0; r < 2; ++r)
#pragma unroll
        for (int j = 0; j < 8; ++j) v[r][j] = ((const f32x4*)(src + (size_t)r * DM))[8 * lane + j];
#pragma unroll
    for (int r = 0; r < 2; ++r) {
#pragma unroll
        for (int j = 0; j < 8; ++j) mx[r] = fmaxf(mx[r], fmaxf(fmaxf(fabsf(v[r][j].x), fabsf(v[r][j].y)), fmaxf(fabsf(v[r][j].z), fabsf(v[r][j].w))));
#pragma unroll
        for (int o = 1; o < 64; o <<= 1) mx[r] = fmaxf(mx[r], __shfl_xor(mx[r], o));
        const float sc = mx[r] > 0.f ? mx[r] * (0.85f / 6.f) : 1.f, isc = 1.f / sc;
        unsigned wd[4];
#pragma unroll
        for (int w = 0; w < 4; ++w) { unsigned acc = 0u;
#pragma unroll
            for (int k = 0; k < 4; ++k) { const f32x4 q4 = v[r][2 * w + (k >> 1)];
                const float xa = (k & 1) ? q4.z : q4.x, xb = (k & 1) ? q4.w : q4.y;
                const float ya = fminf(fmaxf(xa * isc, -6.f), 6.f), yb = fminf(fmaxf(xb * isc, -6.f), 6.f);
                acc = (k == 0) ? __builtin_amdgcn_cvt_scalef32_pk_fp4_f32(acc, ya, yb, 1.0f, 0) : (k == 1) ? __builtin_amdgcn_cvt_scalef32_pk_fp4_f32(acc, ya, yb, 1.0f, 1)
                    : (k == 2) ? __builtin_amdgcn_cvt_scalef32_pk_fp4_f32(acc, ya, yb, 1.0f, 2) : __builtin_amdgcn_cvt_scalef32_pk_fp4_f32(acc, ya, yb, 1.0f, 3); }
            wd[w] = acc; }
        v4u o; o.x = wd[0]; o.y = wd[1]; o.z = wd[2]; o.w = wd[3];
        ((v4u*)(dst + (size_t)r * 256))[lane] = o;
        if (lane == 0) inv_scale[r] = sc;
    }
}
#ifndef PEER_FAST_REDUCE
#define PEER_FAST_REDUCE 1
#endif
__device__ __forceinline__ float dpp_ror_add(float t, int) { return t; }
#define FP4_BYTE(d, j) __builtin_amdgcn_cvt_scalef32_pk_f32_fp4((d), 1.0f, (j))
__device__ __forceinline__ float dot_row(const v4u& a, const float (&xv)[32]) {
    f32x2 p2 = {0.f, 0.f};
#pragma unroll
    for (int w = 0; w < 4; ++w) { const unsigned d = (w == 0) ? a.x : (w == 1) ? a.y : (w == 2) ? a.z : a.w;
        const f32x2 f0 = FP4_BYTE(d, 0), f1 = FP4_BYTE(d, 1), f2 = FP4_BYTE(d, 2), f3 = FP4_BYTE(d, 3);
        p2 = __builtin_elementwise_fma(f0, (f32x2){xv[8 * w], xv[8 * w + 1]}, p2); p2 = __builtin_elementwise_fma(f1, (f32x2){xv[8 * w + 2], xv[8 * w + 3]}, p2);
        p2 = __builtin_elementwise_fma(f2, (f32x2){xv[8 * w + 4], xv[8 * w + 5]}, p2); p2 = __builtin_elementwise_fma(f3, (f32x2){xv[8 * w + 6], xv[8 * w + 7]}, p2); }
    return p2.x + p2.y;
}
__device__ __forceinline__ void axpy_row(const v4u& a, float wgt, float (&y)[32]) {
#pragma unroll
    for (int w = 0; w < 4; ++w) { const unsigned d = (w == 0) ? a.x : (w == 1) ? a.y : (w == 2) ? a.z : a.w;
        const f32x2 f0 = FP4_BYTE(d, 0), f1 = FP4_BYTE(d, 1), f2 = FP4_BYTE(d, 2), f3 = FP4_BYTE(d, 3);
        y[8 * w] += wgt * f0.x; y[8 * w + 1] += wgt * f0.y; y[8 * w + 2] += wgt * f1.x; y[8 * w + 3] += wgt * f1.y;
        y[8 * w + 4] += wgt * f2.x; y[8 * w + 5] += wgt * f2.y; y[8 * w + 6] += wgt * f3.x; y[8 * w + 7] += wgt * f3.y; }
}
#define DPP_ROR_MAX(t, n) fmaxf((t), __uint_as_float(__builtin_amdgcn_update_dpp(0u, __float_as_uint(t), 0x120 + (n), 0xf, 0xf, false)))
#define CSWAP(a, b) do { const float hi_ = fmaxf(a, b), lo_ = fminf(a, b); a = hi_; b = lo_; } while (0)
__device__ __forceinline__ void topk_token_fast(const float* __restrict__ srow, int lane, const float* inv_su, const float* inv_sv,
                                                LAS int* se, LAS float* sa, LAS float* sb) {
    const int l16 = lane & 15, row = lane >> 4;
    float R[4];
#pragma unroll
    for (int ps = 0; ps < 4; ++ps) {
        const f32x4 v0 = *(const f32x4*)(srow + (4 * ps + row) * 128 + 8 * l16), v1 = *(const f32x4*)(srow + (4 * ps + row) * 128 + 8 * l16 + 4);
        float k[8];
        k[0] = v0.x; k[1] = v0.y; k[2] = v0.z; k[3] = v0.w; k[4] = v1.x; k[5] = v1.y; k[6] = v1.z; k[7] = v1.w;
#pragma unroll
        for (int i = 0; i < 8; ++i) k[i] = __uint_as_float((__float_as_uint(k[i]) & 0xFFFFFF80u) | (unsigned)(8 * l16 + i));
        CSWAP(k[0], k[1]); CSWAP(k[2], k[3]); CSWAP(k[4], k[5]); CSWAP(k[6], k[7]);
        CSWAP(k[0], k[2]); CSWAP(k[1], k[3]); CSWAP(k[4], k[6]); CSWAP(k[5], k[7]);
        CSWAP(k[1], k[2]); CSWAP(k[5], k[6]);
        CSWAP(k[0], k[4]); CSWAP(k[1], k[5]); CSWAP(k[2], k[6]); CSWAP(k[3], k[7]);
        CSWAP(k[2], k[4]); CSWAP(k[3], k[5]);
        CSWAP(k[1], k[2]); CSWAP(k[3], k[4]); CSWAP(k[5], k[6]);
        float res = 0.f;
#pragma unroll
        for (int it = 0; it < 16; ++it) {
            float m = k[0];
            m = DPP_ROR_MAX(m, 8); m = DPP_ROR_MAX(m, 4); m = DPP_ROR_MAX(m, 2); m = DPP_ROR_MAX(m, 1);
            const bool own = (k[0] == m);
#pragma unroll
            for (int i = 0; i < 7; ++i) k[i] = own ? k[i + 1] : k[i];
            k[7] = own ? -INFINITY : k[7];
            res = (l16 == it) ? m : res;
        }
        R[ps] = res;
    }
#pragma unroll
    for (int g = 0; g < 2; ++g) {
        const auto sw = __builtin_amdgcn_permlane16_swap(__float_as_uint(R[2 * g]), __float_as_uint(R[2 * g + 1]), false, false);
        const float X = __uint_as_float(sw[0]), Y = __uint_as_float(sw[1]);
        const float a = __uint_as_float(__float_as_uint(X) & 0xFFFFFF80u);
        int j = 0;
        float v2 = __shfl(Y, (lane & 48));
        float best = 0.f;
#pragma unroll
        for (int it = 0; it < 16; ++it) {
            const float sum = a + __uint_as_float(__float_as_uint(v2) & 0xFFFFFF80u);
            const float cand = (j < 16) ? __uint_as_float((__float_as_uint(sum) & 0xFFFFFF00u) | (unsigned)((l16 << 4) | (j & 15))) : -INFINITY;
            float m = cand;
            m = DPP_ROR_MAX(m, 8); m = DPP_ROR_MAX(m, 4); m = DPP_ROR_MAX(m, 2); m = DPP_ROR_MAX(m, 1);
            best = (l16 == it) ? m : best;
            if (it < 15) { j += (cand == m) ? 1 : 0; v2 = __shfl(Y, (lane & 48) + (j & 15)); }
        }
        const unsigned bb = __float_as_uint(best);
        const int bi = (bb >> 4) & 15, bj = bb & 15;
        const unsigned k1 = __float_as_uint(__shfl(X, (lane & 48) + bi)), k2 = __float_as_uint(__shfl(Y, (lane & 48) + bj));
        const int e = (int)(k1 & 127u) * 128 + (int)(k2 & 127u);
        const float bv = __uint_as_float(bb & 0xFFFFFF00u);
        float mx = bv; mx = DPP_ROR_MAX(mx, 8); mx = DPP_ROR_MAX(mx, 4); mx = DPP_ROR_MAX(mx, 2); mx = DPP_ROR_MAX(mx, 1);
        const float ex = __expf(bv - mx);
        float sm = ex; sm = DPP_ROR_ADD(sm, 8); sm = DPP_ROR_ADD(sm, 4); sm = DPP_ROR_ADD(sm, 2); sm = DPP_ROR_ADD(sm, 1);
        const float gate = ex / sm;
        const int head = 4 * g + ((row & 1) * 2 + (row >> 1));
        se[head * 16 + l16] = e; sa[head * 16 + l16] = inv_su[e]; sb[head * 16 + l16] = gate * inv_sv[e];
    }
}
#define PEER_LOAD(DST, TAB, b) do { _Pragma("unroll") for (int r_ = 0; r_ < 4; ++r_) { const unsigned char* rp_ = (TAB) + (size_t)(unsigned)__builtin_amdgcn_readfirstlane(se[4 * (b) + r_]) * 1024 + 16 * lane; \
        DST[r_] = *(const v4u*)rp_; } } while (0)
__device__ __forceinline__ void peer_token(int t, const float* scores, const bf16_t* hn, const float* hbuf, const unsigned char* U8, const unsigned char* V8,
                                           const float* inv_su, const float* inv_sv, const float* gfin, float* out,
                                           LAS int* se, LAS float* sa, LAS float* sb, int lane_in) {
    int lane = lane_in;
    {
        LAS int* se0 = se + 512; LAS float* sa0 = sa + 512; LAS float* sb0 = sb + 512;
        topk_token_fast(scores + (size_t)t * DM, lane, inv_su, inv_sv, se0, sa0, sb0);
        unsigned a0 = ((unsigned)se0[lane] << 7) | (unsigned)lane, a1 = ((unsigned)se0[lane + 64] << 7) | (unsigned)(lane + 64);
#pragma unroll
        for (int k = 2; k <= 128; k <<= 1) {
#pragma unroll
            for (int j = k >> 1; j > 0; j >>= 1) {
                if (j == 64) { const unsigned lo = a0 < a1 ? a0 : a1, hi = a0 < a1 ? a1 : a0; a0 = lo; a1 = hi; }
                else {
                    const unsigned p0 = (unsigned)__shfl_xor((int)a0, j), p1 = (unsigned)__shfl_xor((int)a1, j);
                    const bool lower = (lane & j) == 0;
                    const bool up0 = (lane & k) == 0, up1 = ((lane + 64) & k) == 0;
                    const unsigned mn0 = a0 < p0 ? a0 : p0, mx0 = a0 < p0 ? p0 : a0, mn1 = a1 < p1 ? a1 : p1, mx1 = a1 < p1 ? p1 : a1;
                    a0 = (up0 == lower) ? mn0 : mx0; a1 = (up1 == lower) ? mn1 : mx1;
                }
            }
        }
        const int k0 = a0 & 127, k1 = a1 & 127;
        se[lane] = (int)(a0 >> 7); sa[lane] = sa0[k0]; sb[lane] = sb0[k0];
        se[lane + 64] = (int)(a1 >> 7); sa[lane + 64] = sa0[k1]; sb[lane + 64] = sb0[k1];
    }
    asm volatile("" : "+v"(lane));
    float xv[32], y[32];
#pragma unroll
    for (int j = 0; j < 4; ++j) {
        const v4u h0 = *(const v4u*)(hn + (size_t)t * DM + 32 * lane + 8 * j);
#pragma unroll
        for (int w = 0; w < 4; ++w) { const unsigned d0 = (w == 0) ? h0.x : (w == 1) ? h0.y : (w == 2) ? h0.z : h0.w;
            xv[8 * j + 2 * w] = __uint_as_float(d0 << 16); xv[8 * j + 2 * w + 1] = __uint_as_float(d0 & 0xffff0000u); }
    }
#pragma unroll
    for (int i = 0; i < 32; ++i) y[i] = 0.f;
    v4u Ua[4], Ub[4], Va[4];
#define PEER_BATCH(b, UC, VC) do { \
        PEER_LOAD(VC, V8, (b)); \
        float pr[4]; \
        _Pragma("unroll") for (int r = 0; r < 4; ++r) pr[r] = dot_row(UC[r], xv); \
        if ((b) + 2 < 32) PEER_LOAD(UC, U8, (b) + 2); \
        float wr_[4], q2[2]; \
        _Pragma("unroll") for (int r = 0; r < 2; ++r) { auto sw = __builtin_amdgcn_permlane32_swap(__float_as_uint(pr[r]), __float_as_uint(pr[r + 2]), false, false); q2[r] = __uint_as_float(sw[0]) + __uint_as_float(sw[1]); } \
        float tv; \
        { auto sw = __builtin_amdgcn_permlane16_swap(__float_as_uint(q2[0]), __float_as_uint(q2[1]), false, false); tv = __uint_as_float(sw[0]) + __uint_as_float(sw[1]); } \
        tv = DPP_ROR_ADD(tv, 8); tv = DPP_ROR_ADD(tv, 4); tv = DPP_ROR_ADD(tv, 2); tv = DPP_ROR_ADD(tv, 1); \
        const int k = 4 * (b) + (lane >> 4);     \
        const float wc = gelu_erf(tv * sa[k]) * sb[k]; \
        _Pragma("unroll") for (int r = 0; r < 4; ++r) wr_[r] = __uint_as_float(__builtin_amdgcn_readlane(__float_as_uint(wc), 16 * r)); \
        _Pragma("unroll") for (int r = 0; r < 4; ++r) axpy_row(VC[r], wr_[r], y); } while (0)
    PEER_LOAD(Ua, U8, 0); PEER_LOAD(Ub, U8, 1);
#pragma unroll 1
    for (int b = 0; b < 32; b += 2) { PEER_BATCH(b, Ua, Va); PEER_BATCH(b + 1, Ub, Va); }
    float ss = 0.f;
#pragma unroll
    for (int j = 0; j < 8; ++j) { const f32x4 hv = *(const f32x4*)(hbuf + (size_t)t * DM + 32 * lane + 4 * j);
        y[4 * j] += hv.x; y[4 * j + 1] += hv.y; y[4 * j + 2] += hv.z; y[4 * j + 3] += hv.w;
        ss += (y[4 * j] * y[4 * j] + y[4 * j + 1] * y[4 * j + 1]) + (y[4 * j + 2] * y[4 * j + 2] + y[4 * j + 3] * y[4 * j + 3]); }
    ss = wave_sum(ss);
    const float rstd = rsqrtf(ss * (1.f / DM) + EPS);
#pragma unroll
    for (int j = 0; j < 8; ++j) { const f32x4 gg = *(const f32x4*)(gfin + 32 * lane + 4 * j);
        f32x4 o; o.x = y[4 * j] * rstd * gg.x; o.y = y[4 * j + 1] * rstd * gg.y; o.z = y[4 * j + 2] * rstd * gg.z; o.w = y[4 * j + 3] * rstd * gg.w;
        *(f32x4*)(out + (size_t)t * DM + 32 * lane + 4 * j) = o; }
}
typedef short bf16x8 __attribute__((ext_vector_type(8)));
__device__ __forceinline__ int pos32(int x) { const int g = x & ~31, l = x & 31; return g + 8 * ((l & 15) >> 2) + 4 * (l >> 4) + (l & 3); }
constexpr size_t PB_H_QG = 0, PB_H_KDT = 32 * MiB, PB_H_A = 64 * MiB;
constexpr size_t PB_G_QS = 80 * MiB, PB_G_KT = 96 * MiB;
constexpr size_t PB_G_W = 112 * MiB, PB_G_A = 144 * MiB, PB_G_U = 160 * MiB;
constexpr int PROG_WORD = 3584;
constexpr int NSB = 128, CPW = 4;
constexpr int SC_QG = 0, SC_WV = 16384, SC_KDT = 32768, SC_A = 49152, SC_BUF = 57344, SC_VEC = 2 * SC_BUF, SC_OT = SC_VEC + 2048, SC_OTB = 17408, SC_GAIN = SC_OT + 2 * SC_OTB;

__device__ __forceinline__ bf16x8 pack_frag(const f32x4& x0, const f32x4& x1) {
    v4u w; w.x = pk2(x0.x, x0.y); w.y = pk2(x0.z, x0.w); w.z = pk2(x1.x, x1.y); w.w = pk2(x1.z, x1.w);
    return __builtin_bit_cast(bf16x8, w);
}
#define MFMA16(a, b, c) __builtin_amdgcn_mfma_f32_16x16x32_bf16((a), (b), (c), 0, 0, 0)

__device__ __forceinline__ void hgrn_prep_item(int item, const bf16_t* proj, const float* lb_logits, unsigned char* pb, float* vecs, LAS unsigned char* lds, int tid) {
    const int c = item & 127, sq = item >> 7, b = sq >> 3, h = sq & 7, t0 = b * SEQ + c * 64;
    const int d = tid & 127, seg = tid >> 7, lane = tid & 63, wave = tid >> 6;
    LAS bf16_t* QGl = (LAS bf16_t*)lds; LAS bf16_t* KGl = (LAS bf16_t*)(lds + 17408); LAS float* segsum = (LAS float*)(lds + 34816);
    bf16_t* gQG = (bf16_t*)(pb + PB_H_QG) + (size_t)item * 8192;
    bf16_t* gKDT = (bf16_t*)(pb + PB_H_KDT) + (size_t)item * 8192;
    bf16_t* gA = (bf16_t*)(pb + PB_H_A) + (size_t)item * 4096;
    float* gvec = vecs + (size_t)item * 256;
    const float l0 = lb_logits[h * 128 + d], l1 = lb_logits[1024 + h * 128 + d];
    const float lb = 1.f / (1.f + __expf(l1 - l0));
    float lf[16], qv[16], kv[16];
#pragma unroll
    for (int i = 0; i < 16; ++i) {
        const bf16_t* pr = proj + (size_t)(t0 + 16 * seg + i) * NPROJ + h * 128 + d;
        const float z = bf2f(pr[C_AF]); qv[i] = bf2f(pr[C_AQ]);
        const float f = lb + (1.f - lb) * sigmoidf_(z);
        lf[i] = __logf(f); kv[i] = 1.f - f;
    }
    float run = 0.f;
#pragma unroll
    for (int i = 0; i < 16; ++i) { run += lf[i]; lf[i] = run; }
    segsum[seg * 128 + d] = run;
    __syncthreads();
    float off = 0.f, bl = 0.f;
#pragma unroll
    for (int s = 0; s < 4; ++s) { const float v = segsum[s * 128 + d]; bl += v; if (s < seg) off += v; }
    const int pd = pos32(d);
    float kd[16];
#pragma unroll
    for (int i = 0; i < 16; ++i) {
        const float bc = lf[i] + off; const int tl = 16 * seg + i;
        const float qg = qv[i] * __expf(bc), kg = kv[i] * __expf(-bc);
        kd[i] = kv[i] * __expf(bl - bc);
        const bf16_t qb = f2bf(qg);
        QGl[tl * 136 + d] = qb; KGl[tl * 136 + d] = f2bf(kg);
        gQG[tl * 128 + pd] = qb;
    }
#pragma unroll
    for (int ii = 0; ii < 4; ++ii) { v2u o; o.x = pk2(kd[4 * ii], kd[4 * ii + 1]); o.y = pk2(kd[4 * ii + 2], kd[4 * ii + 3]);
        *(v2u*)(gKDT + d * 64 + 32 * (seg >> 1) + 8 * ii + 4 * (seg & 1)) = o; }
    if (seg == 0) gvec[128 + d] = __expf(bl);
    __syncthreads();
    const int n = lane & 15, q = lane >> 4;
#pragma unroll
    for (int ti = 0; ti < 2; ++ti) {
        const int id = wave + 8 * ti, mt = id >> 2, ns = id & 3;
        f32x4 acc = {0.f, 0.f, 0.f, 0.f};
        if (ns <= mt) {
#pragma unroll
            for (int s4 = 0; s4 < 4; ++s4) {
                const bf16x8 a = *(const LAS bf16x8*)(QGl + (16 * mt + n) * 136 + 32 * s4 + 8 * q);
                const bf16x8 bb = *(const LAS bf16x8*)(KGl + (16 * ns + n) * 136 + 32 * s4 + 8 * q);
                acc = MFMA16(a, bb, acc);
            }
        }
        const int s = 16 * ns + n, ps = pos32(s);
#pragma unroll
        for (int r = 0; r < 4; ++r) { const int t = 16 * mt + 4 * q + r; const float v = (r == 0) ? acc.x : (r == 1) ? acc.y : (r == 2) ? acc.z : acc.w;
            gA[t * 64 + ps] = f2bf((s <= t) ? v : 0.f); }
    }
    __syncthreads();
}

constexpr int GP_QF = 0, GP_KF = 33024, GP_N = 0, GP_QB = 66048, GP_KB = 83456, GP_VB = 100864, GP_PART = 135680, GP_SB = 137728;
__device__ __forceinline__ void gdn_prep_item(int item, const bf16_t* proj, const float* ba, const float* conv_w, const float* A_log, const float* dt_bias,
                                              unsigned char* pb, float* vecs, LAS unsigned char* lds, int tid) {
    const int c = item & 127, bq = item >> 7, b = bq >> 2, qh = bq & 3, t0 = b * SEQ + c * 64;
    const int lane = tid & 63, wave = tid >> 6;
    LAS float* QF = (LAS float*)(lds + GP_QF); LAS float* KF = (LAS float*)(lds + GP_KF);
    LAS bf16_t* QB = (LAS bf16_t*)(lds + GP_QB); LAS bf16_t* KB = (LAS bf16_t*)(lds + GP_KB); LAS bf16_t* VB = (LAS bf16_t*)(lds + GP_VB);
    LAS float* PART = (LAS float*)(lds + GP_PART); LAS float* SBETA = (LAS float*)(lds + GP_SB); LAS float* SGC = SBETA + 128;
    LAS float* NM = (LAS float*)(lds + GP_N);
    {
        int col, wch; const int dd = tid & 127;
        if (tid < 128) { col = C_BQ + qh * 128 + dd; wch = qh * 128 + dd; }
        else if (tid < 256) { col = C_BK + qh * 128 + dd; wch = 512 + qh * 128 + dd; }
        else { const int vh = 2 * qh + ((tid - 256) >> 7); col = C_BV + vh * 128 + dd; wch = 1024 + vh * 128 + dd; }
        const float w0 = conv_w[wch], w1 = conv_w[2048 + wch], w2 = conv_w[4096 + wch], w3 = conv_w[6144 + wch];
        float h0 = 0.f, h1 = 0.f, h2 = 0.f;
        const bf16_t* pr = proj + (size_t)t0 * NPROJ + col;
        if (c > 0) { h0 = bf2f(pr[-3 * NPROJ]); h1 = bf2f(pr[-2 * NPROJ]); h2 = bf2f(pr[-1 * NPROJ]); }
        unsigned xr[64];
#pragma unroll
        for (int t = 0; t < 64; ++t) xr[t] = pr[(size_t)t * NPROJ];
#pragma unroll
        for (int t = 0; t < 64; ++t) {
            const float xx = __uint_as_float(xr[t] << 16);
            const float yv = siluf_(w0 * h0 + w1 * h1 + w2 * h2 + w3 * xx);
            h0 = h1; h1 = h2; h2 = xx;
            if (tid < 128) QF[t * 129 + dd] = yv;
            else if (tid < 256) KF[t * 129 + dd] = yv;
            else VB[((tid - 256) >> 7) * 8704 + t * 136 + dd] = f2bf(yv);
        }
    }
    __syncthreads();
    {
        const int t = tid & 63, part = tid >> 6, which = part >> 2, sub = part & 3;
        const LAS float* src = (which ? KF : QF) + t * 129 + 32 * sub;
        float s = 0.f;
#pragma unroll
        for (int i = 0; i < 32; ++i) s += src[i] * src[i];
        PART[(which * 4 + sub) * 64 + t] = s;
    }
    if (wave < 2) {
        const int vh = 2 * qh + wave;
        const float ax = ba[(size_t)(t0 + lane) * 16 + 8 + vh] + dt_bias[vh];
        const float sp = ax > 20.f ? ax : log1pf(__expf(ax));
        float gc = -__expf(A_log[vh]) * sp;
#pragma unroll
        for (int o = 1; o < 64; o <<= 1) { const float up = __shfl_up(gc, o); if (lane >= o) gc += up; }
        const float gl = __shfl(gc, 63);
        const float beta = sigmoidf_(ba[(size_t)(t0 + lane) * 16 + vh]);
        SBETA[wave * 64 + lane] = beta; SGC[wave * 64 + lane] = gc;
        float* gvec = vecs + ((size_t)(16 + b * 8 + vh) * 128 + c) * 256;
        gvec[lane] = __expf(gc); gvec[64 + lane] = __expf(gl - gc);
        const float dl = __expf(gl); gvec[128 + lane] = dl; gvec[192 + lane] = dl;
    }
    __syncthreads();
    {
        const int d = tid & 127, seg = tid >> 7, pd = pos32(d);
        bf16_t* gQS = (bf16_t*)(pb + PB_G_QS) + (size_t)item * 8192;
        bf16_t* gKT = (bf16_t*)(pb + PB_G_KT) + (size_t)item * 8192;
        float kk[16];
#pragma unroll
        for (int i = 0; i < 16; ++i) {
            const int tl = 16 * seg + i;
            const float sq = PART[0 * 64 + tl] + PART[1 * 64 + tl] + PART[2 * 64 + tl] + PART[3 * 64 + tl];
            const float sk = PART[4 * 64 + tl] + PART[5 * 64 + tl] + PART[6 * 64 + tl] + PART[7 * 64 + tl];
            const bf16_t qb = f2bf(QF[tl * 129 + d] * rsqrtf(sq + EPS) * 0.08838834764831845f);
            const bf16_t kb = f2bf(KF[tl * 129 + d] * rsqrtf(sk + EPS));
            QB[tl * 136 + d] = qb; KB[tl * 136 + d] = kb; gQS[tl * 128 + pd] = qb; kk[i] = bf2f(kb);
        }
#pragma unroll
        for (int ii = 0; ii < 4; ++ii) { v2u o; o.x = pk2(kk[4 * ii], kk[4 * ii + 1]); o.y = pk2(kk[4 * ii + 2], kk[4 * ii + 3]);
            *(v2u*)(gKT + d * 64 + 32 * (seg >> 1) + 8 * ii + 4 * (seg & 1)) = o; }
    }
    __syncthreads();
    {
        const int n = lane & 15, q = lane >> 4;
#pragma unroll
        for (int ti = 0; ti < 2; ++ti) {
            const int id = 2 * wave + ti, mt = id >> 2, ns = id & 3;
            f32x4 akk = {0.f, 0.f, 0.f, 0.f}, aqk = {0.f, 0.f, 0.f, 0.f};
            if (ns <= mt) {
#pragma unroll
                for (int s4 = 0; s4 < 4; ++s4) {
                    const bf16x8 kb_ = *(const LAS bf16x8*)(KB + (16 * ns + n) * 136 + 32 * s4 + 8 * q);
                    const bf16x8 ka_ = *(const LAS bf16x8*)(KB + (16 * mt + n) * 136 + 32 * s4 + 8 * q);
                    const bf16x8 qa_ = *(const LAS bf16x8*)(QB + (16 * mt + n) * 136 + 32 * s4 + 8 * q);
                    akk = MFMA16(ka_, kb_, akk); aqk = MFMA16(qa_, kb_, aqk);
                }
            }
            const int s = 16 * ns + n, ps = pos32(s);
#pragma unroll
            for (int vl = 0; vl < 2; ++vl) {
                bf16_t* gA = (bf16_t*)(pb + PB_G_A) + ((size_t)((b * 8 + 2 * qh + vl) * 128 + c)) * 4096;
                const float gcs = SGC[vl * 64 + s];
#pragma unroll
                for (int r = 0; r < 4; ++r) {
                    const int t = 16 * mt + 4 * q + r;
                    const float vk = (r == 0) ? akk.x : (r == 1) ? akk.y : (r == 2) ? akk.z : akk.w;
                    const float vq = (r == 0) ? aqk.x : (r == 1) ? aqk.y : (r == 2) ? aqk.z : aqk.w;
                    const float ex = (s <= t) ? __expf(SGC[vl * 64 + t] - gcs) : 0.f;
                    NM[vl * 4096 + t * 64 + s] = (s < t) ? SBETA[vl * 64 + t] * vk * ex : 0.f;
                    gA[t * 64 + ps] = f2bf((s <= t) ? vq * ex : 0.f);
                }
            }
        }
    }
    __syncthreads();
    {
        const int vl = tid >> 8, colx = tid & 255;
        float x[64];
        if (colx < 128) {
#pragma unroll
            for (int t = 0; t < 64; ++t) x[t] = SBETA[vl * 64 + t] * bf2f(VB[vl * 8704 + t * 136 + colx]);
        } else {
#pragma unroll
            for (int t = 0; t < 64; ++t) x[t] = SBETA[vl * 64 + t] * __expf(SGC[vl * 64 + t]) * bf2f(KB[t * 136 + colx - 128]);
        }
        __syncthreads();
        const LAS float* Nv = NM + vl * 4096;
#pragma unroll
        for (int t = 1; t < 64; ++t) {
            float acc = x[t];
#pragma unroll
            for (int s4 = 0; s4 < (t + 3) / 4; ++s4) {
                const f32x4 nn = *(const LAS f32x4*)(Nv + t * 64 + 4 * s4);
                acc -= nn.x * x[4 * s4]; if (4 * s4 + 1 < t) acc -= nn.y * x[4 * s4 + 1]; if (4 * s4 + 2 < t) acc -= nn.z * x[4 * s4 + 2]; if (4 * s4 + 3 < t) acc -= nn.w * x[4 * s4 + 3];
            }
            x[t] = acc;
        }
        if (colx < 128) {
            bf16_t* gU = (bf16_t*)(pb + PB_G_U) + ((size_t)((b * 8 + 2 * qh + vl) * 128 + c)) * 8192;
            const int sl = colx >> 4, n = colx & 15;
#pragma unroll
            for (int mt = 0; mt < 4; ++mt)
#pragma unroll
                for (int q = 0; q < 4; ++q) { v2u o; o.x = pk2(x[16 * mt + 4 * q], x[16 * mt + 4 * q + 1]); o.y = pk2(x[16 * mt + 4 * q + 2], x[16 * mt + 4 * q + 3]);
                    *(v2u*)(gU + ((size_t)((sl * 4 + mt) * 64 + q * 16 + n)) * 4) = o; }
        } else {
            LAS bf16_t* WS = (LAS bf16_t*)(lds + GP_QB) + vl * 8704;
            const int pd = pos32(colx - 128);
#pragma unroll
            for (int t = 0; t < 64; ++t) WS[t * 136 + pd] = f2bf(-x[t]);
        }
    }
    __syncthreads();
    {
#pragma unroll
        for (int i = 0; i < 4; ++i) { const int p = tid + 512 * i, vl = p >> 10, row = (p >> 4) & 63, c16 = p & 15;
            bf16_t* gW = (bf16_t*)(pb + PB_G_W) + ((size_t)((b * 8 + 2 * qh + vl) * 128 + c)) * 8192;
            *(v4u*)(gW + row * 128 + c16 * 8) = *(const LAS v4u*)(lds + GP_QB + vl * 17408 + row * 272 + c16 * 16); }
    }
    __syncthreads();
}

struct ScanSrc { const unsigned char* qg; const unsigned char* wv; const unsigned char* kdt; const unsigned char* a; const float* vec; size_t wv_row; };
__device__ __forceinline__ void scan_dma(const ScanSrc& S, LAS unsigned char* buf, LAS unsigned char* vecb, int w, int lane) {
#pragma unroll
    for (int i = 0; i < 2; ++i) { const int pi = 2 * w + i, row = 4 * pi + (lane >> 4), cl = (lane & 15) ^ (row & 15);
        __builtin_amdgcn_global_load_lds((const unsigned*)(S.qg + row * 256 + cl * 16), (LAS unsigned*)(buf + SC_QG + pi * 1024), 16, 0, 0);
        __builtin_amdgcn_global_load_lds((const unsigned*)(S.wv + (size_t)row * S.wv_row + cl * 16), (LAS unsigned*)(buf + SC_WV + pi * 1024), 16, 0, 0); }
#pragma unroll
    for (int i = 0; i < 2; ++i) { const int pi = 2 * w + i, row = 8 * pi + (lane >> 3), cl = (lane & 7) ^ ((row >> 1) & 7);
        __builtin_amdgcn_global_load_lds((const unsigned*)(S.kdt + row * 128 + cl * 16), (LAS unsigned*)(buf + SC_KDT + pi * 1024), 16, 0, 0); }
    { const int pi = w, row = 8 * pi + (lane >> 3), cl = (lane & 7) ^ ((row >> 1) & 7);
        __builtin_amdgcn_global_load_lds((const unsigned*)(S.a + row * 128 + cl * 16), (LAS unsigned*)(buf + SC_A + pi * 1024), 16, 0, 0); }
    if (w == 0) __builtin_amdgcn_global_load_lds((const unsigned*)((const unsigned char*)S.vec + lane * 16), (LAS unsigned*)vecb, 16, 0, 0);
}
template <bool GDN>
__device__ __forceinline__ void scan_block(int sq, int g, const bf16_t* proj, const unsigned char* pb, const float* vecs, const float* hgrn_g, const float* gdn_g,
                                           bf16_t* mix, unsigned* prog, LAS unsigned char* lds, int tid) {
    constexpr bool gdn = GDN;
    const int b = (sq & 15) >> 3, hh = sq & 7, lane = tid & 63, sl = __builtin_amdgcn_readfirstlane(tid >> 6), n = lane & 15, q = lane >> 4;
    const unsigned char* bQG; const unsigned char* bWV; const unsigned char* bKDT; const unsigned char* bA; const unsigned char* bU = nullptr;
    size_t wv_row, wv_chunk; int gate_col, mix_col; const float* gain;
    if (!gdn) {
        const size_t s0 = (size_t)(b * 8 + hh) * 128;
        bQG = pb + PB_H_QG + s0 * 16384; bKDT = pb + PB_H_KDT + s0 * 16384; bA = pb + PB_H_A + s0 * 8192;
        bWV = (const unsigned char*)(proj + (size_t)(b * SEQ) * NPROJ + C_AI + hh * 128); wv_row = (size_t)NPROJ * 2; wv_chunk = (size_t)64 * NPROJ * 2;
        gate_col = C_AG + hh * 128; mix_col = hh * 128; gain = hgrn_g;
    } else {
        const size_t s0 = (size_t)(b * 8 + hh) * 128, q0 = (size_t)(b * 4 + (hh >> 1)) * 128;
        bQG = pb + PB_G_QS + q0 * 16384; bKDT = pb + PB_G_KT + q0 * 16384; bA = pb + PB_G_A + s0 * 8192;
        bWV = pb + PB_G_W + s0 * 16384; wv_row = 256; wv_chunk = 16384; bU = pb + PB_G_U + s0 * 16384;
        gate_col = C_BZ + hh * 128; mix_col = 1024 + hh * 128; gain = gdn_g;
    }
    const float* bvec = vecs + (size_t)sq * 128 * 256;
    LAS float* gainl = (LAS float*)(lds + SC_GAIN);
    const int wave = sl;
    {
        ScanSrc src{bQG, bWV, bKDT, bA, bvec, wv_row};
        scan_dma(src, lds, lds + SC_VEC, wave, lane);
        if (tid < 128) gainl[tid] = gain[tid];
    }
    __builtin_amdgcn_s_waitcnt(0x0070);
    asm volatile("" ::: "memory");
    __builtin_amdgcn_s_barrier();
    asm volatile("" ::: "memory");
#define SCAN_BAR() do { asm volatile("s_waitcnt lgkmcnt(0)" ::: "memory"); __builtin_amdgcn_s_barrier(); asm volatile("" ::: "memory"); } while (0)
#define SCHED_FENCE() __builtin_amdgcn_sched_barrier(0)
    const int sl16 = 2 * g + wave;
    const int hw = (wave == 2) ? 0 : (wave == 3) ? 1 : (wave == 6) ? 2 : (wave == 7) ? 3 : -1;
    if (wave < 2) {
        f32x4 S[8];
        bf16x8 Sf[4];
#pragma unroll
        for (int m = 0; m < 8; ++m) S[m] = (f32x4){0.f, 0.f, 0.f, 0.f};
#pragma unroll
        for (int s4 = 0; s4 < 4; ++s4) Sf[s4] = pack_frag(S[0], S[1]);
        v2u Ureg[4];
#pragma unroll
        for (int mt = 0; mt < 4; ++mt) Ureg[mt] = GDN ? *(const v2u*)(bU + (size_t)(sl16 * 4 + mt) * 512 + lane * 8) : (v2u){0u, 0u};
        for (int c = 0; c < 128; ++c) {
            int lane = tid & 63; asm volatile("" : "+v"(lane));
            const int n = lane & 15, q = lane >> 4;
            const int cur = c & 1;
            LAS unsigned char* buf = lds + cur * SC_BUF;
            const LAS float* vec = (const LAS float*)(lds + SC_VEC + cur * 1024);
            const int cn = (c + 1 < 128) ? c + 1 : 127;
            f32x4 VN[4];
            bf16x8 fa[8], fb[8];
            bf16x8 VNf[2], VNSf[2];
#define SC3_LD8_K128(dst, OFF, mt_) do { _Pragma("unroll") for (int i_ = 0; i_ < 8; ++i_) dst[i_] = *(const LAS bf16x8*)(buf + (OFF) + (16 * ((mt_) + (i_ >> 2)) + n) * 256 + (((4 * (i_ & 3) + q) ^ n) * 16)); } while (0)
#define SC3_LD8_K64(dst, OFF, mb) do { _Pragma("unroll") for (int i_ = 0; i_ < 8; ++i_) dst[i_] = *(const LAS bf16x8*)(buf + (OFF) + (16 * ((mb) + (i_ >> 1)) + n) * 128 + (((4 * (i_ & 1) + q) ^ ((n >> 1) & 7)) * 16)); } while (0)
#define SC3_MM_K128(A0, A1, fr) do { _Pragma("unroll") for (int i_ = 0; i_ < 4; ++i_) { A0 = MFMA16(fr[i_], Sf[i_], A0); A1 = MFMA16(fr[4 + i_], Sf[i_], A1); } } while (0)
#define SC3_MM_K64(X, ma, fr, BF) do { _Pragma("unroll") for (int t_ = 0; t_ < 4; ++t_) { X[(ma) + t_] = MFMA16(fr[2 * t_], BF[0], X[(ma) + t_]); X[(ma) + t_] = MFMA16(fr[2 * t_ + 1], BF[1], X[(ma) + t_]); } } while (0)
#define SC3_DLOAD(m) (*(const LAS f32x4*)(vec + 128 + 16 * (m) + 4 * q))
#define SC3_EGLOAD(mt) (*(const LAS f32x4*)(vec + 16 * (mt) + 4 * q))
#define SC3_PACK_S(s4) do { Sf[s4] = pack_frag(S[2 * (s4)], S[2 * (s4) + 1]); } while (0)
#define SC3_OT_WRITE() do { LAS bf16_t* OT_ = (LAS bf16_t*)(lds + SC_OT + cur * SC_OTB); const int cc_ = 16 * sl16 + n; \
                _Pragma("unroll") for (int mt = 0; mt < 4; ++mt) { \
                    OT_[(16 * mt + 4 * q + 0) * 136 + cc_] = f2bf(O[mt].x); OT_[(16 * mt + 4 * q + 1) * 136 + cc_] = f2bf(O[mt].y); \
                    OT_[(16 * mt + 4 * q + 2) * 136 + cc_] = f2bf(O[mt].z); OT_[(16 * mt + 4 * q + 3) * 136 + cc_] = f2bf(O[mt].w); } } while (0)
            f32x4 dA, dB, dC, dD;
            f32x4 O[4];
            if (GDN) {
#pragma unroll
                for (int mt = 0; mt < 4; ++mt) { const v2u uu = Ureg[mt];
                    VN[mt] = (f32x4){__uint_as_float(uu.x << 16), __uint_as_float(uu.x & 0xffff0000u), __uint_as_float(uu.y << 16), __uint_as_float(uu.y & 0xffff0000u)}; }
                SC3_LD8_K128(fa, SC_WV, 0); SCHED_FENCE();
                SC3_LD8_K128(fb, SC_WV, 2); SCHED_FENCE();
#pragma unroll
                for (int mt = 0; mt < 4; ++mt) Ureg[mt] = *(const v2u*)(bU + (size_t)cn * 16384 + (size_t)(sl16 * 4 + mt) * 512 + lane * 8);
                f32x4 eS[4];
#pragma unroll
                for (int i = 0; i < 4; ++i) eS[i] = *(const LAS f32x4*)(vec + 64 + 16 * i + 4 * q);
                dA = SC3_DLOAD(0); dB = SC3_DLOAD(1); dC = SC3_DLOAD(2); dD = SC3_DLOAD(3);
                SCHED_FENCE();
                SC3_PACK_S(3); SC3_MM_K128(VN[0], VN[1], fa); S[0] = S[0] * dA; S[1] = S[1] * dB; S[2] = S[2] * dC; S[3] = S[3] * dD; SCHED_FENCE();
                SC3_LD8_K128(fa, SC_QG, 0); dA = SC3_DLOAD(4); dB = SC3_DLOAD(5); dC = SC3_DLOAD(6); dD = SC3_DLOAD(7); SCHED_FENCE();
                SC3_MM_K128(VN[2], VN[3], fb); S[4] = S[4] * dA; S[5] = S[5] * dB; S[6] = S[6] * dC; S[7] = S[7] * dD; SCHED_FENCE();
                SC3_LD8_K128(fb, SC_QG, 2); dA = SC3_EGLOAD(0); dB = SC3_EGLOAD(1); SCHED_FENCE();
#pragma unroll
                for (int mt = 0; mt < 4; ++mt) O[mt] = (f32x4){0.f, 0.f, 0.f, 0.f};
                SC3_MM_K128(O[0], O[1], fa);
#pragma unroll
                for (int s2 = 0; s2 < 2; ++s2) { VNf[s2] = pack_frag(VN[2 * s2], VN[2 * s2 + 1]); VNSf[s2] = pack_frag(VN[2 * s2] * eS[2 * s2], VN[2 * s2 + 1] * eS[2 * s2 + 1]); }
                SCHED_FENCE();
                SC3_LD8_K64(fa, SC_A, 0); dC = SC3_EGLOAD(2); dD = SC3_EGLOAD(3); SCHED_FENCE();
                SC3_MM_K128(O[2], O[3], fb); O[0] = O[0] * dA; O[1] = O[1] * dB; SCHED_FENCE();
                SC3_LD8_K64(fb, SC_KDT, 0); SCHED_FENCE();
                O[2] = O[2] * dC; O[3] = O[3] * dD;
            } else {
                SC3_LD8_K128(fa, SC_QG, 0); SCHED_FENCE();
                SC3_LD8_K128(fb, SC_QG, 2); SCHED_FENCE();
#pragma unroll
                for (int s2 = 0; s2 < 2; ++s2) { unsigned w[4];
#pragma unroll
                    for (int jj = 0; jj < 4; ++jj) { const int ja = 2 * jj, jb = 2 * jj + 1; const int cc = 16 * sl16 + n;
                        const int ta = 32 * s2 + ((ja < 4) ? 4 * q + ja : 16 + 4 * q + ja - 4), tb = 32 * s2 + ((jb < 4) ? 4 * q + jb : 16 + 4 * q + jb - 4);
                        const unsigned lo = *(const LAS bf16_t*)(buf + SC_WV + ta * 256 + (((cc >> 3) ^ (ta & 15)) * 16) + (cc & 7) * 2), hi = *(const LAS bf16_t*)(buf + SC_WV + tb * 256 + (((cc >> 3) ^ (tb & 15)) * 16) + (cc & 7) * 2);
                        w[jj] = lo | (hi << 16); }
                    v4u ww; ww.x = w[0]; ww.y = w[1]; ww.z = w[2]; ww.w = w[3];
                    VNf[s2] = __builtin_bit_cast(bf16x8, ww); VNSf[s2] = VNf[s2]; }
                dA = SC3_DLOAD(0); dB = SC3_DLOAD(1); dC = SC3_DLOAD(2); dD = SC3_DLOAD(3);
                SCHED_FENCE();
#pragma unroll
                for (int mt = 0; mt < 4; ++mt) O[mt] = (f32x4){0.f, 0.f, 0.f, 0.f};
                SC3_PACK_S(3); SC3_MM_K128(O[0], O[1], fa); S[0] = S[0] * dA; S[1] = S[1] * dB; S[2] = S[2] * dC; S[3] = S[3] * dD; SCHED_FENCE();
                SC3_LD8_K64(fa, SC_A, 0); dA = SC3_DLOAD(4); dB = SC3_DLOAD(5); dC = SC3_DLOAD(6); dD = SC3_DLOAD(7); SCHED_FENCE();
                SC3_MM_K128(O[2], O[3], fb); S[4] = S[4] * dA; S[5] = S[5] * dB; S[6] = S[6] * dC; S[7] = S[7] * dD; SCHED_FENCE();
                SC3_LD8_K64(fb, SC_KDT, 0); SCHED_FENCE();
            }
            SC3_MM_K64(O, 0, fa, VNf); SCHED_FENCE();
            SC3_LD8_K64(fa, SC_KDT, 4); SCHED_FENCE();
            SC3_MM_K64(S, 0, fb, VNSf); SC3_OT_WRITE(); SCHED_FENCE();
            SC3_MM_K64(S, 4, fa, VNSf); SC3_PACK_S(0); SC3_PACK_S(1); SCHED_FENCE();
            SC3_PACK_S(2);
            SCAN_BAR();
        }
    } else if (wave == CPW) {
        for (int c = 0; c < 128; ++c) {
            SCAN_BAR();
            int lane = tid & 63; asm volatile("" : "+v"(lane));
            const LAS bf16_t* OTn = (const LAS bf16_t*)(lds + SC_OT + (c & 1) * SC_OTB);
#pragma unroll
            for (int ps = 0; ps < 4; ++ps) { const int row = 16 * ps + (lane >> 2), pc = lane & 3, col = 32 * g + 8 * pc;
                    const v4u val = *(const LAS v4u*)(OTn + row * 136 + col);
                    *(v4u*)(mix + (size_t)(b * SEQ + c * 64 + row) * DM + mix_col + col) = val; }
        }
    } else if (hw >= 0) {
        v4u G0[15], G1[15];
#define HLP_LOAD(GX, cn_) do { const unsigned char* sQG = bQG + (size_t)(cn_) * 16384 + (size_t)hw * 4096; const unsigned char* sWV = bWV + (size_t)(cn_) * wv_chunk + (size_t)(16 * hw) * wv_row; \
            const unsigned char* sKDT = bKDT + (size_t)(cn_) * 16384 + (size_t)hw * 4096; const unsigned char* sA = bA + (size_t)(cn_) * 8192 + (size_t)hw * 2048; \
            const unsigned l16 = (unsigned)lane * 16u, offv = (unsigned)(lane >> 4) * (unsigned)wv_row + (unsigned)(lane & 15) * 16u; \
            _Pragma("unroll") for (int i = 0; i < 4; ++i) { GX[i] = *(const v4u*)(sQG + i * 1024 + l16); GX[4 + i] = *(const v4u*)(sWV + (size_t)(4 * i) * wv_row + offv); } \
            _Pragma("unroll") for (int i = 0; i < 4; ++i) GX[8 + i] = *(const v4u*)(sKDT + i * 1024 + l16); \
            _Pragma("unroll") for (int i = 0; i < 2; ++i) GX[12 + i] = *(const v4u*)(sA + i * 1024 + l16); \
            GX[14] = *(const v4u*)((const unsigned char*)(bvec + (size_t)(cn_) * 256) + l16); } while (0)
#define HLP_STORE(GX, bi_) do { LAS unsigned char* nb = lds + (bi_) * SC_BUF + hw * 4096; LAS unsigned char* nv = lds + SC_VEC + (bi_) * 1024; const int lq = lane >> 4; \
            _Pragma("unroll") for (int i = 0; i < 4; ++i) { const int d = lq * 256 + (((lane & 15) ^ (4 * i + lq)) * 16); \
                *(LAS v4u*)(nb + SC_QG + i * 1024 + d) = GX[i]; *(LAS v4u*)(nb + SC_WV + i * 1024 + d) = GX[4 + i]; } \
            _Pragma("unroll") for (int i = 0; i < 4; ++i) { const int d = (lane >> 3) * 128 + (((lane & 7) ^ (4 * (i & 1) + lq)) * 16); *(LAS v4u*)(nb + SC_KDT + i * 1024 + d) = GX[8 + i]; } \
            _Pragma("unroll") for (int i = 0; i < 2; ++i) { const int d = (lane >> 3) * 128 + (((lane & 7) ^ (4 * i + lq)) * 16); *(LAS v4u*)(nb - hw * 2048 + SC_A + i * 1024 + d) = GX[12 + i]; } \
            if (hw == 0) *(LAS v4u*)(nv + lane * 16) = GX[14]; } while (0)
#define HLP_ITER(c, GL, GW) do { \
            int lane = tid & 63; asm volatile("" : "+v"(lane)); \
            const int c2 = ((c) + 2 < 128) ? (c) + 2 : 127; \
            HLP_LOAD(GL, c2); \
            HLP_STORE(GW, ((c) + 1) & 1); \
            SCAN_BAR(); } while (0)
        { int lane = tid & 63; asm volatile("" : "+v"(lane)); HLP_LOAD(G1, 1); }
        for (int c = 0; c < 128; c += 2) { HLP_ITER(c, G0, G1); HLP_ITER(c + 1, G1, G0); }
    } else {
        for (int c = 0; c < 128; ++c) SCAN_BAR();
    }
    __syncthreads();
}

__device__ __forceinline__ void mixnorm_row(bf16_t* mrow, const bf16_t* prow, const float (&gn)[32], int lane) {
    const int c0 = 32 * lane;
    const bf16_t* gp = prow + (c0 < 1024 ? C_AG + c0 : C_BZ + c0 - 1024);
    v4u o4[4], z4[4];
#pragma unroll
    for (int i = 0; i < 4; ++i) { o4[i] = *(const v4u*)(mrow + c0 + 8 * i); z4[i] = *(const v4u*)(gp + 8 * i); }
    float ss = 0.f;
#pragma unroll
    for (int i = 0; i < 4; ++i)
#pragma unroll
        for (int w = 0; w < 4; ++w) { const unsigned a = (w == 0) ? o4[i].x : (w == 1) ? o4[i].y : (w == 2) ? o4[i].z : o4[i].w;
            const float lo = __uint_as_float(a << 16), hi = __uint_as_float(a & 0xffff0000u); ss += lo * lo + hi * hi; }
    ss += __shfl_xor(ss, 1); ss += __shfl_xor(ss, 2);
    const float rstd = rsqrtf(ss * (1.f / 128.f) + EPS);
#pragma unroll
    for (int i = 0; i < 4; ++i) { float yv[8];
#pragma unroll
        for (int w = 0; w < 4; ++w) { const unsigned a = (w == 0) ? o4[i].x : (w == 1) ? o4[i].y : (w == 2) ? o4[i].z : o4[i].w;
            const unsigned z = (w == 0) ? z4[i].x : (w == 1) ? z4[i].y : (w == 2) ? z4[i].z : z4[i].w;
            yv[2 * w] = __uint_as_float(a << 16) * rstd * gn[8 * i + 2 * w] * __uint_as_float(z << 16);
            yv[2 * w + 1] = __uint_as_float(a & 0xffff0000u) * rstd * gn[8 * i + 2 * w + 1] * __uint_as_float(z & 0xffff0000u); }
        v4u y4; y4.x = pk2(yv[0], yv[1]); y4.y = pk2(yv[2], yv[3]); y4.z = pk2(yv[4], yv[5]); y4.w = pk2(yv[6], yv[7]);
        *(v4u*)(mrow + c0 + 8 * i) = y4; }
}

struct EpiProj {
    static constexpr bool PERM = true, AFTER_DRAIN = false;
    bf16_t* O; int ldc;
    __device__ __forceinline__ void operator()(const pg8::f32x4 (&acc)[2][2][4][2], const pg8::Unit& u, int wr, int wc, int fr, int fq) const {
        const int row0 = u.pm * 256 + wr * 64 + fr, col0 = u.pn * 256 + wc * 32 + 8 * fq;
        const bool gate = (u.pn >= 12 && u.pn < 16) || (u.pn >= 24);
#pragma unroll
        for (int ai = 0; ai < 2; ++ai)
#pragma unroll
            for (int m = 0; m < 4; ++m) { bf16_t* rowp = O + (size_t)(row0 + ai * 128 + m * 16) * ldc + col0;
#pragma unroll
                for (int bj = 0; bj < 2; ++bj) { pg8::f32x4 v0 = acc[ai][bj][m][0], v1 = acc[ai][bj][m][1];
                    if (gate) {
#pragma unroll
                        for (int e = 0; e < 4; ++e) { v0[e] = v0[e] * __builtin_amdgcn_rcpf(1.f + __expf(-v0[e])); v1[e] = v1[e] * __builtin_amdgcn_rcpf(1.f + __expf(-v1[e])); } }
                    pg8::u32x4 w; w.x = pk2(v0[0], v0[1]); w.y = pk2(v0[2], v0[3]); w.z = pk2(v1[0], v1[1]); w.w = pk2(v1[2], v1[3]);
                    *(pg8::u32x4*)(rowp + bj * 128) = w; } }
    }
};
struct EpiResF32 {
    static constexpr bool PERM = false, AFTER_DRAIN = false;
    const float* R; float* O; int ldc;
    __device__ __forceinline__ void operator()(const pg8::f32x4 (&acc)[2][2][4][2], const pg8::Unit& u, int wr, int wc, int fr, int fq) const {
        const int row0 = u.pm * 256 + wr * 64 + fr, col0 = u.pn * 256 + wc * 32 + 4 * fq;
#pragma unroll
        for (int ai = 0; ai < 2; ++ai)
#pragma unroll
            for (int m = 0; m < 4; ++m) { const size_t off = (size_t)(row0 + ai * 128 + m * 16) * ldc + col0;
#pragma unroll
                for (int bj = 0; bj < 2; ++bj)
#pragma unroll
                    for (int n = 0; n < 2; ++n) { pg8::f32x4 v = acc[ai][bj][m][n]; if (R) v = v + *(const pg8::f32x4*)(R + off + bj * 128 + n * 16); *(pg8::f32x4*)(O + off + bj * 128 + n * 16) = v; } }
    }
};

#define XB_TMO      128
#define XB_XCNT(j)  (256  + 64 * (j))
#define XB_XSUB(j)  (1280 + 64 * (j))
#define XB_XGEN(j)  (2304 + 64 * (j))
#define XB_TOP      3328
#define XB_TOPGEN   3392
#define XCD_BAR_WORDS 3456
#define XB_SPIN_CAP (1u << 18)

__device__ __forceinline__ unsigned xb_ld(unsigned* p)              { return __hip_atomic_load(p, __ATOMIC_RELAXED, __HIP_MEMORY_SCOPE_AGENT); }
__device__ __forceinline__ unsigned xb_add(unsigned* p, unsigned v) { return __hip_atomic_fetch_add(p, v, __ATOMIC_RELAXED, __HIP_MEMORY_SCOPE_AGENT); }
__device__ __forceinline__ unsigned xb_xcc_id() { return (unsigned)__builtin_amdgcn_s_getreg((3 << 11) | 20) & 0xFu; }
#define XB_SPIN(cond, bar) do { unsigned _sp = 0; while (cond) { __builtin_amdgcn_s_sleep(1); \
    if ((++_sp & 255u) == 0u) { if (xb_ld(&(bar)[XB_TMO])) break; if (_sp > XB_SPIN_CAP) { atomicAdd(&(bar)[XB_TMO], 1u); break; } } } } while (0)

struct XcdBarrier {
    unsigned* bar; unsigned x;
    volatile LAS unsigned* st;
};

__device__ __forceinline__ XcdBarrier xcd_barrier_post(unsigned* bar, volatile LAS unsigned* st) {
    XcdBarrier b; b.bar = bar; b.x = xb_xcc_id(); b.st = st;
    if (threadIdx.x == 0) (void)xb_add(&bar[XB_XCNT(b.x)], 1u);
    return b;
}
__device__ __forceinline__ void xcd_barrier_complete(unsigned* bar, unsigned x, unsigned& nloc, unsigned& nx) {
    const unsigned G = gridDim.x * gridDim.y * gridDim.z;
    unsigned sum, cnt, mine, sp = 0u;
    for (;;) {
        sum = 0u; cnt = 0u; mine = 0u;
#pragma unroll
        for (unsigned j = 0; j < 16; ++j) { const unsigned c = xb_ld(&bar[XB_XCNT(j)]); sum += c; cnt += (c > 0u) ? 1u : 0u; mine = (j == x) ? c : mine; }
        if (sum == G) break;
        __builtin_amdgcn_s_sleep(1);
        if ((++sp & 255u) == 0u) { if (xb_ld(&bar[XB_TMO])) break; if (sp > XB_SPIN_CAP) { atomicAdd(&bar[XB_TMO], 1u); break; } }
    }
    nloc = mine > 0u ? mine : 1u; nx = cnt > 0u ? cnt : 1u;
}

__device__ __forceinline__ void xcd_barrier(const XcdBarrier& b) {
    asm volatile("s_waitcnt vmcnt(0)" ::: "memory");
    __syncthreads();
    if (threadIdx.x == 0) {
        unsigned* bar = b.bar;
        __builtin_amdgcn_s_waitcnt(0);
        unsigned nloc = b.st[0], nx = b.st[1];
        if (nloc == 0u) { xcd_barrier_complete(bar, b.x, nloc, nx); b.st[0] = nloc; b.st[1] = nx; }
        const unsigned old = xb_add(&bar[XB_XSUB(b.x)], 1u);
        const unsigned gen = old / nloc;
        if (old + 1u == (gen + 1u) * nloc) {
            __builtin_amdgcn_fence(__ATOMIC_RELEASE, "agent");
            asm volatile("s_waitcnt vmcnt(0)" ::: "memory");
            const unsigned og = xb_add(&bar[XB_TOP], 1u);
            const unsigned tg = og / nx;
            if (og + 1u == (tg + 1u) * nx) xb_add(&bar[XB_TOPGEN], 1u);
            else XB_SPIN(xb_ld(&bar[XB_TOPGEN]) == tg, bar);
            __builtin_amdgcn_fence(__ATOMIC_ACQUIRE, "agent");
            xb_add(&bar[XB_XGEN(b.x)], 1u);
            asm volatile("s_waitcnt vmcnt(0)" ::: "memory");
        } else {
            XB_SPIN(xb_ld(&bar[XB_XGEN(b.x)]) == gen, bar);
            __builtin_amdgcn_fence(__ATOMIC_ACQUIRE, "agent");
            asm volatile("s_waitcnt vmcnt(0)" ::: "memory");
        }
    }
    __syncthreads();
}

__device__ __forceinline__ int get_lane() { int l = (int)__builtin_amdgcn_mbcnt_hi(~0u, __builtin_amdgcn_mbcnt_lo(~0u, 0u)); asm volatile("" : "+v"(l)); return l; }
__global__ void __launch_bounds__(NT, 2) mk_fwd(Args args) {
    extern __shared__ __attribute__((aligned(16))) unsigned char lds_raw[];
    LAS unsigned char* lds = (LAS unsigned char*)lds_raw;
    cg::grid_group grid = cg::this_grid();
    const int tid = threadIdx.x, wave = __builtin_amdgcn_readfirstlane(tid >> 6);

    const int G = gridDim.x, bx = blockIdx.x;
    const int vcu = (G % 8 == 0) ? (bx % 8) * (G / 8) + bx / 8 : bx;
    const int gw = vcu * NW + wave, NGW = G * NW;
    unsigned char* ws = args.ws;
    const float* x = args.in[0]; const float* attn_g = args.in[1]; const float* w_in = args.in[2];
    const float* w_out = args.in[9]; const float* ffn_g = args.in[10]; const float* w_query = args.in[11]; const float* sub_keys = args.in[12];
    bf16_t* WinT = (bf16_t*)(ws + OFF_D);
    bf16_t* WoutT = (bf16_t*)(ws + OFF_C);
    bf16_t* Wqk = (bf16_t*)(ws + OFF_C + 8 * MiB);
    bf16_t* xn = (bf16_t*)(ws + OFF_D + 28 * MiB);
    float* ba = (float*)(ws + OFF_S);
    bf16_t* proj = (bf16_t*)(ws + OFF_B);
    bf16_t* mix = (bf16_t*)args.out;
    unsigned char* pb = ws + OFF_D; float* vecs = (float*)(ws + OFF_S + 2 * MiB);
    float* hbuf = (float*)(ws + OFF_B);
    bf16_t* hn = (bf16_t*)(ws + OFF_D + 128 * MiB);
    float* scores = (float*)(ws + OFF_D);
    unsigned char* U8 = ws + OFF_TAB; unsigned char* V8 = ws + OFF_TAB + 16 * MiB;
    float* inv_su = (float*)(ws + OFF_S + 1 * MiB); float* inv_sv = inv_su + 16384;

    volatile LAS unsigned* xbst = (volatile LAS unsigned*)(lds + LDS_BYTES - 16);
    if (tid < 4) xbst[tid] = 0u;
    __syncthreads();
    XcdBarrier xbar = xcd_barrier_post((unsigned*)args.ws, xbst);
    const int lo = args.ph_lo, hi = args.ph_hi;
#define IN(k) (lo <= (k) && (k) < hi)
#define SYNC_AFTER(k) do { if (IN(k) && (k) + 1 < hi) { if ((k) == 0) grid.sync(); else xcd_barrier(xbar); } } while (0)
    {
        if (IN(0)) {
            const int lane = get_lane();
            LAS float* scr = (LAS float*)(lds + wave * 16384);
            constexpr int I_IN = (DM / 64) * (NPROJ / 32);
            for (int it = gw; it < I_IN; it += NGW) transpose_item(w_in, INW, DM, NPROJ, WinT, scr, it, lane);
            __syncthreads();
            {
                LAS float* wt = (LAS float*)lds;
#pragma unroll
                for (int k = 0; k < 4; ++k) { const int d = tid + 512 * k; const float* wr = w_in + (size_t)d * INW + NPROJ;
#pragma unroll
                    for (int q4 = 0; q4 < 4; ++q4) { const f32x4 w4 = *(const f32x4*)(wr + 4 * q4);
                        wt[(4 * q4 + 0) * 2048 + d] = w4.x; wt[(4 * q4 + 1) * 2048 + d] = w4.y; wt[(4 * q4 + 2) * 2048 + d] = w4.z; wt[(4 * q4 + 3) * 2048 + d] = w4.w; } }
            }
            __syncthreads();
            for (int m = gw; m < T; m += NGW) norm_row<true>(x + (size_t)m * DM, attn_g, (const LAS float*)lds, xn + (size_t)m * DM, ba + (size_t)m * 16, lane);
        }
        SYNC_AFTER(0);
        if (IN(1)) {
            pg8::Gemm g{xn, WinT, T, NPROJ, DM}; pg8::StaticOrder S; S.init(T, NPROJ, G, bx);
            EpiProj E{proj, NPROJ};
            pg8::gemm_phase<EpiProj, pg8::StaticOrder, true, true>(lds, g, S, E);
        }
        SYNC_AFTER(1);
        if (IN(2)) {
            for (int it = bx; it < 2048; it += G) { int tt = threadIdx.x; asm volatile("" : "+v"(tt)); hgrn_prep_item(it, proj, args.in[3], pb, vecs, lds, tt); }
            for (int it = bx; it < 1024; it += G) { int tt = threadIdx.x; asm volatile("" : "+v"(tt)); gdn_prep_item(it, proj, ba, args.in[5], args.in[6], args.in[7], pb, vecs, lds, tt); }
        }
        SYNC_AFTER(2);
        if (IN(3)) {
            const int lane = get_lane();
            unsigned* ctl = (unsigned*)args.ws;
            if (bx < NSB) {
                const int sq = (bx & 7) + 8 * (bx >> 5), cgp = (bx >> 3) & 3;
                if (sq >= 16) scan_block<true>(sq, cgp, proj, pb, vecs, args.in[4], args.in[8], mix, ctl + PROG_WORD, lds, tid);
                else scan_block<false>(sq, cgp, proj, pb, vecs, args.in[4], args.in[8], mix, ctl + PROG_WORD, lds, tid);
            }
            else if (G > NSB) {
                int fb, FB;
                fb = bx - NSB; FB = G - NSB;
                const int fw = fb * NW + wave, FW = FB * NW;
                for (int it = fb; it < 512; it += FB) wqk_item(w_query, sub_keys, Wqk, (LAS float*)lds, it, tid);
                LAS float* scr = (LAS float*)(lds + wave * 16384);
                constexpr int I_OUT = (DM / 64) * (DM / 32);
                for (int it = fw; it < I_OUT; it += FW) transpose_item(w_out, DM, DM, DM, WoutT, scr, it, lane);
                for (int e = 2 * fw; e < 32768; e += 2 * FW) { const bool isv = e >= 16384; const int r = e & 16383;
                    table_row2((isv ? args.in[14] : args.in[13]) + (size_t)r * DM, (unsigned*)((isv ? V8 : U8) + (size_t)r * 1024), (isv ? inv_sv : inv_su) + r, lane); }
            }
        }
        SYNC_AFTER(3);
        if (IN(4)) {
            {
                const int lane = get_lane();
                float gn[32];
                { const float* gsrc = ((32 * lane) < 1024 ? args.in[4] : args.in[8]) + ((32 * lane) & 127);
#pragma unroll
                  for (int i = 0; i < 8; ++i) { const f32x4 g4 = *(const f32x4*)(gsrc + 4 * i); gn[4 * i] = g4.x; gn[4 * i + 1] = g4.y; gn[4 * i + 2] = g4.z; gn[4 * i + 3] = g4.w; } }
                for (int m = gw; m < T; m += NGW) mixnorm_row(mix + (size_t)m * DM, proj + (size_t)m * NPROJ, gn, lane);
                xcd_barrier(xbar);
            }
            pg8::Gemm g{mix, WoutT, T, DM, DM}; pg8::StaticOrder S; S.init(T, DM, G, bx);
            EpiResF32 E{x, hbuf, DM};
            pg8::gemm_phase<EpiResF32, pg8::StaticOrder, true, true>(lds, g, S, E);
        }
        SYNC_AFTER(4);
        if (IN(5)) {
            const int lane = get_lane();
            for (int m = gw; m < T; m += NGW) norm_row<false>(hbuf + (size_t)m * DM, ffn_g, (const LAS float*)lds, hn + (size_t)m * DM, nullptr, lane);
        }
        SYNC_AFTER(5);
        if (IN(6)) {
            pg8::Gemm g{hn, Wqk, T, DM, DM}; pg8::StaticOrder S; S.init(T, DM, G, bx);
            EpiResF32 E{nullptr, scores, DM};
            pg8::gemm_phase<EpiResF32, pg8::StaticOrder, true, true>(lds, g, S, E);
        }
        SYNC_AFTER(6);
        if (IN(7)) {
            const int lane = get_lane();
            LAS int* se = (LAS int*)(lds + wave * 4096); LAS float* sa = (LAS float*)(lds + wave * 4096 + 512); LAS float* sb = (LAS float*)(lds + wave * 4096 + 1024);
            for (int t = gw; t < T; t += NGW) { const int ln = get_lane(); peer_token(t, scores, hn, hbuf, U8, V8, inv_su, inv_sv, args.in[15], args.out, se, sa, sb, ln); }
        }
    }
}
}

extern "C" void kernel_launch(void* const* d_in, const int* in_sizes, int n_in, void* d_out, int out_size, void* d_ws, size_t ws_size, hipStream_t stream) {
    static int grid = 0;
    if (grid == 0) {
        int dev = 0, cus = 0, per_cu = 0;
        (void)hipGetDevice(&dev);
        (void)hipDeviceGetAttribute(&cus, hipDeviceAttributeMultiprocessorCount, dev);
        (void)hipFuncSetAttribute((const void*)mk::mk_fwd, hipFuncAttributeMaxDynamicSharedMemorySize, mk::LDS_BYTES);
        (void)hipOccupancyMaxActiveBlocksPerMultiprocessor(&per_cu, (const void*)mk::mk_fwd, mk::NT, mk::LDS_BYTES);
        if (per_cu < 1) { fprintf(stderr, "occupancy query says %d\n", per_cu); per_cu = 1; }
        grid = cus;
    }
    unsigned char* ws = (unsigned char*)d_ws;
    (void)hipMemsetAsync(d_ws, 0, 16384, stream);
    mk::Args a{};
    for (int i = 0; i < 16; ++i) a.in[i] = (const float*)d_in[i];
    a.out = (float*)d_out; a.ws = ws;
    {
        a.ph_lo = 0; a.ph_hi = 8;
        void* kargs[] = {&a};
        hipError_t e = hipLaunchCooperativeKernel((const void*)mk::mk_fwd, dim3(grid), dim3(mk::NT), kargs, mk::LDS_BYTES, stream);
        if (e != hipSuccess) fprintf(stderr, "coop launch failed: %s\n", hipGetErrorString(e));
    }
}
```

```cpp
#include <hip/hip_runtime.h>
#include <hip/hip_cooperative_groups.h>
#include <cstdio>
namespace cg = cooperative_groups;
#include <stdint.h>

typedef unsigned short bf16_t;
typedef float f32x4 __attribute__((ext_vector_type(4)));

constexpr int T = 16384, SEQ = 8192, DM = 2048, INW = 7184, NPROJ = 7168;
constexpr float EPS = 1e-6f;
constexpr size_t MiB = 1u << 20;
constexpr size_t OFF_TAB = 1 * MiB;
constexpr size_t OFF_B = 65 * MiB;
constexpr size_t OFF_C = 289 * MiB;
constexpr size_t OFF_D = 305 * MiB;
constexpr size_t OFF_S = 500 * MiB;
constexpr int C_AQ = 0, C_AF = 1024, C_AI = 2048, C_AG = 3072, C_BQ = 4096, C_BK = 4608, C_BV = 5120, C_BZ = 6144;

__device__ __forceinline__ float bf2f(bf16_t v) { return __uint_as_float(((unsigned)v) << 16); }
typedef float f32x2_t __attribute__((ext_vector_type(2)));
typedef __bf16 bf16x2_t __attribute__((ext_vector_type(2)));
__device__ __forceinline__ unsigned cvt_pk2(float lo, float hi) { f32x2_t v = {lo, hi}; bf16x2_t b = __builtin_convertvector(v, bf16x2_t); return __builtin_bit_cast(unsigned, b); }
__device__ __forceinline__ bf16_t f2bf(float f) { return (bf16_t)(cvt_pk2(f, 0.f) & 0xffffu); }
__device__ __forceinline__ float sigmoidf_(float x) { return 1.f / (1.f + __expf(-x)); }
__device__ __forceinline__ float siluf_(float x) { return x / (1.f + __expf(-x)); }
__device__ __forceinline__ float wave_sum(float v) {
#pragma unroll
    for (int o = 1; o < 64; o <<= 1) v += __shfl_xor(v, o);
    return v;
}
__device__ __forceinline__ float block_sum(float v, float* sh) {
    v = wave_sum(v);
    const int w = threadIdx.x >> 6, nw = blockDim.x >> 6;
    __syncthreads();
    if ((threadIdx.x & 63) == 0) sh[w] = v;
    __syncthreads();
    float r = 0.f;
    for (int i = 0; i < nw; ++i) r += sh[i];
    return r;
}

__device__ __forceinline__ float gelu_erf(float x) { return 0.5f * x * (1.f + erff(x * 0.70710678118654752f)); }
namespace pg8 {
#define PG8_LAS __attribute__((address_space(3)))
typedef unsigned short bf16_t;
typedef short bf16x8 __attribute__((ext_vector_type(8)));
typedef float f32x4 __attribute__((ext_vector_type(4)));
typedef unsigned u32x4 __attribute__((ext_vector_type(4)));
constexpr int BM = 256, BK = 64, HALF = 128, HTB = HALF * BK * 2  , STAGE_BYTES = 8 * HTB, NXCD = 8, WGM = 8;

__host__ __device__ __forceinline__ int lds_byte(int r, int c) { const int st = (r >> 4) * 2 + (c >> 5), rr = r & 15, cc = c & 31, ob = rr * 64 + cc * 2; return st * 1024 + (ob ^ (((ob >> 9) & 1) << 5)); }
__host__ __device__ __forceinline__ void stage_rc(int b, int& R, int& C) { const int st = b / 1024, sb = b % 1024, swz = sb ^ (((sb >> 9) & 1) << 5); R = (st >> 1) * 16 + swz / 64; C = (st & 1) * 32 + (swz % 64) / 2; }
__host__ __device__ __forceinline__ int perm32(int rho) { const int n = rho >> 4, i = rho & 15; return 8 * (i >> 2) + 4 * n + (i & 3); }

struct Unit { int pm, pn; };
struct Gemm { const bf16_t* A; const bf16_t* Bt; int M, N, K; };

struct StaticOrder {
    int nM, nN, nwg, G, c;
    __host__ __device__ void init(int M, int N, int G_, int c_) { nM = M / BM; nN = N / BM; nwg = nM * nN; G = G_; c = c_; }
    __host__ __device__ bool next(int i, Unit& u) const {
        const long L = (long)i * G + c; if (L >= nwg) return false;
        int wgid = (int)L; { const int q = nwg / NXCD, r = nwg % NXCD, xcd = wgid % NXCD, off = wgid / NXCD; wgid = (xcd < r ? xcd * (q + 1) : r * (q + 1) + (xcd - r) * q) + off; }
        const int nig = WGM * nN, gid = wgid / nig, fm = gid * WGM, gsz = (nM - fm) < WGM ? (nM - fm) : WGM;
        u.pm = fm + ((wgid % nig) % gsz); u.pn = (wgid % nig) / gsz; return true;
    }
    __device__ __forceinline__ void a_ready(const Unit&) const {}
    __device__ __forceinline__ void done(const Unit&) const {}
};

__device__ __forceinline__ unsigned cvt_pk_bf16(float lo, float hi) { unsigned r; asm volatile("v_cvt_pk_bf16_f32 %0, %1, %2" : "=v"(r) : "v"(lo), "v"(hi)); return r; }
typedef float f32x2 __attribute__((ext_vector_type(2)));
__device__ __forceinline__ f32x2 gelu_pk(f32x2 v) {
    const f32x2 av = __builtin_elementwise_abs(v), d = av * 0.2316418882f + 1.0f;
    f32x2 t; t.x = __builtin_amdgcn_rcpf(d.x); t.y = __builtin_amdgcn_rcpf(d.y);
    f32x2 q = t * 0.5307027145f + (-0.7265760135f); q = q * t + 0.7107068705f; q = q * t + (-0.142248368f); q = q * t + 0.127414796f; q = q * t;
    const f32x2 s = (v * v) * (-0.72134752044f);
    f32x2 e; e.x = __builtin_amdgcn_exp2f(s.x); e.y = __builtin_amdgcn_exp2f(s.y);
    const f32x2 m = v * (q * e), r = v - m;
    f32x2 o; o.x = v.x < 0.f ? m.x : r.x; o.y = v.y < 0.f ? m.y : r.y; return o;
}

template <int ACT  > struct EpiBf16 {
    static constexpr bool PERM = true, AFTER_DRAIN = false; static_assert(ACT == 0 || ACT == 1, "EpiBf16: ACT is 0 (none) or 1 (gelu_pk)");
    bf16_t* O; int ldc; const float* bias; int split_cols; size_t split_stride; float scale0;
    __device__ __forceinline__ void operator()(const f32x4 (&acc)[2][2][4][2], const Unit& u, int wr, int wc, int fr, int fq) const {
        const int row0 = u.pm * BM + wr * 64 + fr; int colt = u.pn * BM; bf16_t* base = O;
        float sc = 1.f; if (split_cols) { const int t = colt / split_cols; base += (size_t)t * split_stride; colt -= t * split_cols; if (t == 0) sc = scale0; }
        const int col0 = colt + wc * 32 + 8 * fq, bcol0 = u.pn * BM + wc * 32 + 8 * fq;
        f32x4 bv[2][2];
#pragma unroll
        for (int bj = 0; bj < 2; ++bj)
#pragma unroll
            for (int n = 0; n < 2; ++n) bv[bj][n] = bias ? *(const f32x4*)(bias + bcol0 + bj * HALF + 4 * n) : (f32x4){0.f, 0.f, 0.f, 0.f};
#pragma unroll
        for (int ai = 0; ai < 2; ++ai)
#pragma unroll
            for (int m = 0; m < 4; ++m) { bf16_t* rowp = base + (size_t)(row0 + ai * HALF + m * 16) * ldc + col0;
#pragma unroll
                for (int bj = 0; bj < 2; ++bj) { f32x4 v0 = acc[ai][bj][m][0] + bv[bj][0], v1 = acc[ai][bj][m][1] + bv[bj][1];
                    if (ACT == 1) { f32x2 a = gelu_pk((f32x2){v0[0], v0[1]}), b = gelu_pk((f32x2){v0[2], v0[3]}), c = gelu_pk((f32x2){v1[0], v1[1]}), d = gelu_pk((f32x2){v1[2], v1[3]});
                        v0 = (f32x4){a.x, a.y, b.x, b.y}; v1 = (f32x4){c.x, c.y, d.x, d.y}; }
                    v0 = v0 * sc; v1 = v1 * sc; u32x4 w; w.x = cvt_pk_bf16(v0[0], v0[1]); w.y = cvt_pk_bf16(v0[2], v0[3]); w.z = cvt_pk_bf16(v1[0], v1[1]); w.w = cvt_pk_bf16(v1[2], v1[3]);
                    *(u32x4*)(rowp + bj * HALF) = w; } }
    }
};
template <class Epi, class Sched, bool ALIGN_EPI = false, bool SP2 = false>
__device__ __forceinline__ void gemm_phase(PG8_LAS unsigned char* lds, const Gemm g, const Sched& S, const Epi& E) {
    const int tid = threadIdx.x, wid = __builtin_amdgcn_readfirstlane(tid >> 6), lane = tid & 63, wr = wid >> 2, wc = wid & 3, fr = lane & 15, fq = lane >> 4;
    const int K = g.K, nt = K / BK;
    unsigned voffA[2], voffB[2];
#pragma unroll
    for (int i = 0; i < 2; ++i) { int R, C; stage_rc(tid * 16 + i * 8192, R, C); const int Rb = Epi::PERM ? ((R & ~31) + perm32(R & 31)) : R;
        voffA[i] = (unsigned)(R * K + C) * 2u; voffB[i] = (unsigned)(Rb * K + C) * 2u; }
    const size_t kstep = (size_t)(BK * 2);
    const size_t hstep = (size_t)HALF * K * 2;
    const size_t tstep = 2 * hstep;
    const unsigned ldsw = (unsigned)wid * 1024u;
    const int aoff = lds_byte(wr * 64 + fr, fq * 8), boff = lds_byte(wc * 32 + fr, fq * 8);
#define PG8_SA(b, h) (((b) * 2 + (h)) * HTB)
#define PG8_SB(b, h) ((4 + (b) * 2 + (h)) * HTB)
#define PG8_STAGE(bufoff, gbase, voff) do { _Pragma("unroll") for (int _i = 0; _i < 2; ++_i) \
        __builtin_amdgcn_global_load_lds((const unsigned*)((const char*)(gbase) + (voff)[_i]), (PG8_LAS unsigned*)(lds + (bufoff) + ldsw + _i * 8192), 16, 0, 0); } while (0)
#define PG8_LDA(dst, b, h) do { _Pragma("unroll") for (int m = 0; m < 4; ++m) _Pragma("unroll") for (int k = 0; k < 2; ++k) dst[m][k] = *(const PG8_LAS bf16x8*)(lds + PG8_SA(b, h) + aoff + m * 2048 + k * 1024); } while (0)
#define PG8_LDB(dst, b, h) do { _Pragma("unroll") for (int n = 0; n < 2; ++n) _Pragma("unroll") for (int k = 0; k < 2; ++k) dst[n][k] = *(const PG8_LAS bf16x8*)(lds + PG8_SB(b, h) + boff + n * 2048 + k * 1024); } while (0)
#define PG8_MMA(ai, bj, At, Bt) do { __builtin_amdgcn_s_setprio(1); _Pragma("unroll") for (int m = 0; m < 4; ++m) _Pragma("unroll") for (int n = 0; n < 2; ++n) _Pragma("unroll") for (int k = 0; k < 2; ++k) \
        acc[ai][bj][m][n] = __builtin_amdgcn_mfma_f32_16x16x32_bf16(Bt[n][k], At[m][k], acc[ai][bj][m][n], 0, 0, 0); __builtin_amdgcn_s_setprio(0); } while (0)
#define PG8_WAIT_V(n) asm volatile("s_waitcnt vmcnt(" #n ")" ::: "memory")
#define PG8_WAIT_L(n) asm volatile("s_waitcnt lgkmcnt(" #n ")" ::: "memory")
#define PG8_BAR __builtin_amdgcn_s_barrier()
#define PG8_SCHED __builtin_amdgcn_sched_barrier(0)
    Unit cur, nxt; int ui = 0;
    if (!S.next(0, cur)) return;
    f32x4 acc[2][2][4][2];
#pragma unroll
    for (int a = 0; a < 2; ++a)
#pragma unroll
        for (int b = 0; b < 2; ++b)
#pragma unroll
            for (int m = 0; m < 4; ++m)
#pragma unroll
                for (int n = 0; n < 2; ++n) acc[a][b][m][n] = (f32x4){0.f, 0.f, 0.f, 0.f};
    bf16x8 At[4][2], B0[2][2], B1[2][2];
    const char* cA = (const char*)g.A + (size_t)cur.pm * tstep; const char* cB = (const char*)g.Bt + (size_t)cur.pn * tstep;
    S.a_ready(cur);
    if constexpr (SP2) {
        PG8_STAGE(PG8_SB(0, 0), cB, voffB); PG8_STAGE(PG8_SB(0, 1), cB + hstep, voffB); PG8_STAGE(PG8_SA(0, 0), cA, voffA); PG8_STAGE(PG8_SA(0, 1), cA + hstep, voffA);
        if (wr == 1) PG8_BAR;
        PG8_WAIT_V(2); PG8_BAR;
        PG8_STAGE(PG8_SB(1, 0), cB + kstep, voffB); PG8_STAGE(PG8_SA(1, 0), cA + kstep, voffA); PG8_STAGE(PG8_SB(1, 1), cB + hstep + kstep, voffB);
        PG8_WAIT_V(6); PG8_BAR;
    } else {
        PG8_STAGE(PG8_SB(0, 0), cB, voffB); PG8_STAGE(PG8_SA(0, 0), cA, voffA); PG8_STAGE(PG8_SB(0, 1), cB + hstep, voffB); PG8_STAGE(PG8_SA(0, 1), cA + hstep, voffA);
        if (wr == 1) PG8_BAR;
        PG8_WAIT_V(4); PG8_BAR;
        PG8_STAGE(PG8_SB(1, 0), cB + kstep, voffB); PG8_STAGE(PG8_SA(1, 0), cA + kstep, voffA); PG8_STAGE(PG8_SB(1, 1), cB + hstep + kstep, voffB);
        PG8_WAIT_V(6); PG8_BAR;
    }
    for (;;) {
        const bool has_next = S.next(ui + 1, nxt);
        const char* nA = has_next ? (const char*)g.A + (size_t)nxt.pm * tstep : cA; const char* nB = has_next ? (const char*)g.Bt + (size_t)nxt.pn * tstep : cB;
        for (int t = 0; t < nt; t += 2) {
            const bool last = (t == nt - 2);
            const char* a1 = cA + (size_t)(t + 1) * kstep;
            const char* a2 = last ? nA : cA + (size_t)(t + 2) * kstep; const char* b2 = last ? nB : cB + (size_t)(t + 2) * kstep;
            const char* a3 = a2 + kstep; const char* b3 = b2 + kstep;
            if (last && has_next) S.a_ready(nxt);
            if constexpr (SP2) {
            PG8_LDB(B0, 0, 0); PG8_LDB(B1, 0, 1); PG8_SCHED; PG8_LDA(At, 0, 0); PG8_STAGE(PG8_SA(1, 1), a1 + hstep, voffA);
            PG8_WAIT_V(8); PG8_WAIT_L(0); PG8_BAR; PG8_MMA(0, 0, At, B0); PG8_MMA(0, 1, At, B1); PG8_BAR; PG8_SCHED;
            PG8_LDA(At, 0, 1); PG8_STAGE(PG8_SB(0, 0), b2, voffB); PG8_STAGE(PG8_SB(0, 1), b2 + hstep, voffB); PG8_STAGE(PG8_SA(0, 0), a2, voffA);
            PG8_WAIT_V(8); PG8_WAIT_L(0); PG8_BAR; PG8_MMA(1, 0, At, B0); PG8_MMA(1, 1, At, B1); PG8_BAR; PG8_SCHED;
            PG8_LDB(B0, 1, 0); PG8_LDB(B1, 1, 1); PG8_SCHED; PG8_LDA(At, 1, 0); PG8_STAGE(PG8_SA(0, 1), a2 + hstep, voffA);
            PG8_WAIT_V(8); PG8_WAIT_L(0); PG8_BAR; PG8_MMA(0, 0, At, B0); PG8_MMA(0, 1, At, B1); PG8_BAR; PG8_SCHED;
            PG8_LDA(At, 1, 1); PG8_STAGE(PG8_SB(1, 0), b3, voffB); PG8_STAGE(PG8_SB(1, 1), b3 + hstep, voffB); PG8_STAGE(PG8_SA(1, 0), a3, voffA);
            PG8_WAIT_V(8); PG8_WAIT_L(0); PG8_BAR; PG8_MMA(1, 0, At, B0); PG8_MMA(1, 1, At, B1); PG8_BAR; PG8_SCHED;
            } else {
            PG8_LDB(B0, 0, 0); PG8_SCHED; PG8_LDA(At, 0, 0); PG8_STAGE(PG8_SA(1, 1), a1 + hstep, voffA);
            PG8_WAIT_L(8); PG8_BAR; PG8_WAIT_L(0); PG8_MMA(0, 0, At, B0); PG8_BAR; PG8_SCHED;
            PG8_LDB(B1, 0, 1); PG8_STAGE(PG8_SB(0, 0), b2, voffB);
            PG8_BAR; PG8_WAIT_L(0); PG8_MMA(0, 1, At, B1); PG8_BAR;
            PG8_LDA(At, 0, 1); PG8_STAGE(PG8_SA(0, 0), a2, voffA);
            PG8_BAR; PG8_WAIT_L(0); PG8_MMA(1, 0, At, B0); PG8_BAR; PG8_SCHED;
            PG8_STAGE(PG8_SB(0, 1), b2 + hstep, voffB);
            PG8_WAIT_V(6); PG8_BAR; PG8_MMA(1, 1, At, B1); PG8_BAR;
            PG8_LDB(B0, 1, 0); PG8_SCHED; PG8_LDA(At, 1, 0); PG8_STAGE(PG8_SA(0, 1), a2 + hstep, voffA);
            PG8_WAIT_L(8); PG8_BAR; PG8_WAIT_L(0); PG8_MMA(0, 0, At, B0); PG8_BAR; PG8_SCHED;
            PG8_LDB(B1, 1, 1); PG8_STAGE(PG8_SB(1, 0), b3, voffB);
            PG8_BAR; PG8_WAIT_L(0); PG8_MMA(0, 1, At, B1); PG8_BAR;
            PG8_LDA(At, 1, 1); PG8_STAGE(PG8_SA(1, 0), a3, voffA);
            PG8_BAR; PG8_WAIT_L(0); PG8_MMA(1, 0, At, B0); PG8_BAR; PG8_SCHED;
            PG8_STAGE(PG8_SB(1, 1), b3 + hstep, voffB);
            PG8_WAIT_V(6); PG8_BAR; PG8_MMA(1, 1, At, B1); PG8_BAR;
            }
        }
        if constexpr (ALIGN_EPI) { if (wr == 0) PG8_BAR; }
        if constexpr (!Epi::AFTER_DRAIN) { E(acc, cur, wr, wc, fr, fq); S.done(cur); }
        if (!has_next) break;
#pragma unroll
        for (int a = 0; a < 2; ++a)
#pragma unroll
            for (int b = 0; b < 2; ++b)
#pragma unroll
                for (int m = 0; m < 4; ++m)
#pragma unroll
                    for (int n = 0; n < 2; ++n) acc[a][b][m][n] = (f32x4){0.f, 0.f, 0.f, 0.f};
        cur = nxt; cA = nA; cB = nB; ++ui;
        if constexpr (ALIGN_EPI) { if (wr == 1) PG8_BAR; }
    }
    PG8_WAIT_V(0);
    if constexpr (!ALIGN_EPI) { if (wr == 0) PG8_BAR; }
    PG8_BAR;
    if constexpr (Epi::AFTER_DRAIN) { E.fused(acc, cur, wr, wc, fr, fq, lds, wid, lane); S.done(cur); }
#undef PG8_SA
#undef PG8_SB
#undef PG8_STAGE
#undef PG8_LDA
#undef PG8_LDB
#undef PG8_MMA
#undef PG8_WAIT_V
#undef PG8_WAIT_L
#undef PG8_BAR
#undef PG8_SCHED
}
}

namespace mk {
#define LAS __attribute__((address_space(3)))
#define GAS __attribute__((address_space(1)))
typedef unsigned v4u __attribute__((ext_vector_type(4)));
typedef unsigned v2u __attribute__((ext_vector_type(2)));
constexpr int NW = 8, NT = 512, LDS_BYTES = 163840, RING_BYTES = 131072;
#define LDS_WAIT() asm volatile("s_waitcnt lgkmcnt(0)" ::: "memory")
#define DPP_ROR_ADD(t, n) ((t) + __uint_as_float(__builtin_amdgcn_update_dpp(0u, __float_as_uint(t), 0x120 + (n), 0xf, 0xf, false)))
struct Args { const float* in[16]; float* out; unsigned char* ws; int ph_lo, ph_hi; };
__device__ __forceinline__ unsigned pk2(float lo, float hi) { return cvt_pk2(lo, hi); }

__device__ __forceinline__ void transpose_item(const float* W, int ld, int K, int ncols, bf16_t* WT, LAS float* scr, int item, int lane) {
    const int nblk = ncols / 32, kb = item / nblk, nb = item % nblk, k0 = 64 * kb, n0 = 32 * nb;
#pragma unroll 8
    for (int i = 0; i < 32; ++i) { const int kk = 2 * i + (lane >> 5); scr[kk * 33 + (lane & 31)] = W[(size_t)(k0 + kk) * ld + n0 + (lane & 31)]; }
    LDS_WAIT(); asm volatile("" ::: "memory");
    const int c = lane & 7;
#pragma unroll
    for (int j = 0; j < 4; ++j) { const int n = (lane >> 3) + 8 * j; const LAS float* s = scr + (8 * c) * 33 + n;
        v4u o; o.x = pk2(s[0 * 33], s[1 * 33]); o.y = pk2(s[2 * 33], s[3 * 33]); o.z = pk2(s[4 * 33], s[5 * 33]); o.w = pk2(s[6 * 33], s[7 * 33]);
        *(v4u*)(WT + (size_t)(n0 + n) * K + k0 + 8 * c) = o; }
    LDS_WAIT(); asm volatile("" ::: "memory");
}
template <bool WITH_BA>
__device__ __forceinline__ void norm_row(const float* xrow, const float* g, const LAS float* wt  , bf16_t* orow, float* barow, int lane) {
    f32x4 v[8]; float ss = 0.f;
#pragma unroll
    for (int j = 0; j < 8; ++j) { v[j] = ((const f32x4*)xrow)[64 * j + lane]; ss += (v[j].x * v[j].x + v[j].y * v[j].y) + (v[j].z * v[j].z + v[j].w * v[j].w); }
    ss = wave_sum(ss);
    const float rstd = rsqrtf(ss * (1.f / DM) + EPS);
    float acc[16];
#pragma unroll
    for (int c = 0; c < 16; ++c) acc[c] = 0.f;
#pragma unroll
    for (int j = 0; j < 8; ++j) {
        const f32x4 gg = ((const f32x4*)g)[64 * j + lane];
        const f32x4 y = v[j] * rstd * gg;
        v2u o; o.x = pk2(y.x, y.y); o.y = pk2(y.z, y.w);
        ((v2u*)orow)[64 * j + lane] = o;
        if (WITH_BA) {
#pragma unroll
            for (int c = 0; c < 16; ++c) { const f32x4 w4 = *(const LAS f32x4*)(wt + c * 2048 + 4 * (64 * j + lane));
                acc[c] += (y.x * w4.x + y.y * w4.y) + (y.z * w4.z + y.w * w4.w); }
            __builtin_amdgcn_sched_barrier(0);
        }
    }
    if (WITH_BA) {
        float q8[8], t4[4];
#pragma unroll
        for (int r = 0; r < 8; ++r) { auto sw = __builtin_amdgcn_permlane32_swap(__float_as_uint(acc[r]), __float_as_uint(acc[r + 8]), false, false); q8[r] = __uint_as_float(sw[0]) + __uint_as_float(sw[1]); }
#pragma unroll
        for (int r = 0; r < 4; ++r) { auto sw = __builtin_amdgcn_permlane16_swap(__float_as_uint(q8[r]), __float_as_uint(q8[r + 4]), false, false); t4[r] = __uint_as_float(sw[0]) + __uint_as_float(sw[1]); }
#pragma unroll
        for (int r = 0; r < 4; ++r) { float tv = t4[r]; tv = DPP_ROR_ADD(tv, 8); tv = DPP_ROR_ADD(tv, 4); tv = DPP_ROR_ADD(tv, 2); tv = DPP_ROR_ADD(tv, 1); t4[r] = tv; }
        if ((lane & 15) == 0) { const int gq = lane >> 4;
#pragma unroll
            for (int r = 0; r < 4; ++r) barow[r + 4 * gq] = t4[r]; }
    }
}
__device__ __forceinline__ void wqk_item(const float* Wq, const float* SK, bf16_t* Wqk, LAS float* lds, int item, int tid) {
    const int cbk = item >> 5, d0 = (item & 31) * 64, cb = cbk * 128, h = cbk >> 1, half = cbk & 1;
    LAS float* At = lds; LAS float* Bt = lds + 128 * 68;
    const float* skb = SK + ((size_t)(half * 8 + h) * 128) * 128;
#pragma unroll
    for (int i = 0; i < 4; ++i) { const int idx = tid + 512 * i, d = idx >> 5, k4 = idx & 31;
        const f32x4 w = *(const f32x4*)(Wq + (size_t)(d0 + d) * DM + cb + 4 * k4);
        At[(4 * k4 + 0) * 68 + d] = w.x; At[(4 * k4 + 1) * 68 + d] = w.y; At[(4 * k4 + 2) * 68 + d] = w.z; At[(4 * k4 + 3) * 68 + d] = w.w; }
#pragma unroll
    for (int i = 0; i < 8; ++i) { const int idx = tid + 512 * i, n = idx >> 5, k4 = idx & 31;
        const f32x4 w = *(const f32x4*)(skb + (size_t)n * 128 + 4 * k4);
        Bt[(4 * k4 + 0) * 132 + n] = w.x; Bt[(4 * k4 + 1) * 132 + n] = w.y; Bt[(4 * k4 + 2) * 132 + n] = w.z; Bt[(4 * k4 + 3) * 132 + n] = w.w; }
    __syncthreads();
    const int dy = tid >> 5, nx = tid & 31;
    float acc[4][4];
#pragma unroll
    for (int i = 0; i < 4; ++i)
#pragma unroll
        for (int j = 0; j < 4; ++j) acc[i][j] = 0.f;
#pragma unroll 4
    for (int kk = 0; kk < 128; ++kk) {
        const f32x4 a = *(const LAS f32x4*)(At + kk * 68 + 4 * dy), b = *(const LAS f32x4*)(Bt + kk * 132 + 4 * nx);
        acc[0][0] += a.x * b.x; acc[0][1] += a.x * b.y; acc[0][2] += a.x * b.z; acc[0][3] += a.x * b.w;
        acc[1][0] += a.y * b.x; acc[1][1] += a.y * b.y; acc[1][2] += a.y * b.z; acc[1][3] += a.y * b.w;
        acc[2][0] += a.z * b.x; acc[2][1] += a.z * b.y; acc[2][2] += a.z * b.z; acc[2][3] += a.z * b.w;
        acc[3][0] += a.w * b.x; acc[3][1] += a.w * b.y; acc[3][2] += a.w * b.z; acc[3][3] += a.w * b.w;
    }
#pragma unroll
    for (int j = 0; j < 4; ++j) { v2u o; o.x = pk2(acc[0][j], acc[1][j]); o.y = pk2(acc[2][j], acc[3][j]);
        *(v2u*)(Wqk + (size_t)(cb + 4 * nx + j) * DM + d0 + 4 * dy) = o; }
    __syncthreads();
}

typedef float f32x2 __attribute__((ext_vector_type(2)));
__device__ __forceinline__ int fp4_idx_of(float v) { return (v < 1.75f) ? (int)(v * 2.f + 0.25f) : (v < 2.5f ? 4 : (v < 3.5f ? 5 : (v < 5.f ? 6 : 7))); }
__device__ __forceinline__ void fp4_calibrate(int (&nib)[8]) {
    const unsigned T = 0x76543210u;
    const f32x2 a = __builtin_amdgcn_cvt_scalef32_pk_f32_fp4(T, 1.0f, 0), b = __builtin_amdgcn_cvt_scalef32_pk_f32_fp4(T, 1.0f, 1);
    const f32x2 c = __builtin_amdgcn_cvt_scalef32_pk_f32_fp4(T, 1.0f, 2), d = __builtin_amdgcn_cvt_scalef32_pk_f32_fp4(T, 1.0f, 3);
    nib[0] = fp4_idx_of(a.x); nib[1] = fp4_idx_of(a.y); nib[2] = fp4_idx_of(b.x); nib[3] = fp4_idx_of(b.y);
    nib[4] = fp4_idx_of(c.x); nib[5] = fp4_idx_of(c.y); nib[6] = fp4_idx_of(d.x); nib[7] = fp4_idx_of(d.y);
}
__device__ __forceinline__ void table_row_sw(const float* src, unsigned* dst, float* inv_scale, int lane) {
    int nib[8]; fp4_calibrate(nib);
    f32x4 v[8]; float mx = 0.f;
#pragma unroll
    for (int j = 0; j < 8; ++j) { v[j] = ((const f32x4*)src)[8 * lane + j];
        mx = fmaxf(mx, fmaxf(fmaxf(fabsf(v[j].x), fabsf(v[j].y)), fmaxf(fabsf(v[j].z), fabsf(v[j].w)))); }
#pragma unroll
    for (int o = 1; o < 64; o <<= 1) mx = fmaxf(mx, __shfl_xor(mx, o));
    const float sc = mx > 0.f ? mx * (0.85f / 6.f) : 1.f, isc = 1.f / sc;
    unsigned wd[4];
#pragma unroll
    for (int w = 0; w < 4; ++w) {
        unsigned acc = 0u;
#pragma unroll
        for (int e = 0; e < 8; ++e) {
            const f32x4 q = v[2 * w + (e >> 2)]; const float xe = ((e & 3) == 0) ? q.x : ((e & 3) == 1) ? q.y : ((e & 3) == 2) ? q.z : q.w;
            const float yv = fabsf(xe) * isc;
            unsigned code = (yv > 0.25f) + (yv > 0.75f) + (yv > 1.25f) + (yv > 1.75f) + (yv > 2.5f) + (yv > 3.5f) + (yv > 5.f);
            code |= (xe < 0.f) ? 8u : 0u;
            acc |= code << (4 * nib[e]);
        }
        wd[w] = acc;
    }
    v4u o; o.x = wd[0]; o.y = wd[1]; o.z = wd[2]; o.w = wd[3];
    ((v4u*)dst)[lane] = o;
    if (lane == 0) *inv_scale = sc;
}
__device__ __forceinline__ bool fp4_hw_encoder_ok() {
    unsigned t = 0u, u = 0u;
    t = __builtin_amdgcn_cvt_scalef32_pk_fp4_f32(t, 0.f, 0.5f, 1.0f, 0); t = __builtin_amdgcn_cvt_scalef32_pk_fp4_f32(t, 1.f, -1.5f, 1.0f, 1);
    t = __builtin_amdgcn_cvt_scalef32_pk_fp4_f32(t, 2.f, 3.f, 1.0f, 2); t = __builtin_amdgcn_cvt_scalef32_pk_fp4_f32(t, -4.f, 6.f, 1.0f, 3);
    u = __builtin_amdgcn_cvt_scalef32_pk_fp4_f32(u, 0.2f, 0.3f, 1.0f, 0); u = __builtin_amdgcn_cvt_scalef32_pk_fp4_f32(u, 2.4f, -2.6f, 1.0f, 1);
    u = __builtin_amdgcn_cvt_scalef32_pk_fp4_f32(u, 5.2f, -4.9f, 1.0f, 2); u = __builtin_amdgcn_cvt_scalef32_pk_fp4_f32(u, 1.3f, 0.8f, 1.0f, 3);
    const f32x2 a = __builtin_amdgcn_cvt_scalef32_pk_f32_fp4(t, 1.0f, 0), b = __builtin_amdgcn_cvt_scalef32_pk_f32_fp4(t, 1.0f, 1);
    const f32x2 c = __builtin_amdgcn_cvt_scalef32_pk_f32_fp4(t, 1.0f, 2), d = __builtin_amdgcn_cvt_scalef32_pk_f32_fp4(t, 1.0f, 3);
    const f32x2 e = __builtin_amdgcn_cvt_scalef32_pk_f32_fp4(u, 1.0f, 0), f = __builtin_amdgcn_cvt_scalef32_pk_f32_fp4(u, 1.0f, 1);
    const f32x2 g = __builtin_amdgcn_cvt_scalef32_pk_f32_fp4(u, 1.0f, 2), h = __builtin_amdgcn_cvt_scalef32_pk_f32_fp4(u, 1.0f, 3);
    return a.x == 0.f && a.y == 0.5f && b.x == 1.f && b.y == -1.5f && c.x == 2.f && c.y == 3.f && d.x == -4.f && d.y == 6.f
        && e.x == 0.f && e.y == 0.5f && f.x == 2.f && f.y == -3.f && g.x == 6.f && g.y == -4.f && h.x == 1.5f && h.y == 1.f;
}
__device__ __forceinline__ void table_row2(const float* src, unsigned* dst, float* inv_scale, int lane) {
    if (!fp4_hw_encoder_ok()) { table_row_sw(src, dst, inv_scale, lane); table_row_sw(src + DM, dst + 256, inv_scale + 1, lane); return; }
    f32x4 v[2][8]; float mx[2] = {0.f, 0.f};
#pragma unroll
    for (int r = 0; r < 2; ++r)
#pragma unroll
        for (int j = 0; j < 8; ++j) v[r][j] = ((const f32x4*)(src + (size_t)r * DM))[64 * j + lane];
#pragma unroll
    for (int r = 0; r < 2; ++r) {
#pragma unroll
        for (int j = 0; j < 8; ++j) mx[r] = fmaxf(mx[r], fmaxf(fmaxf(fabsf(v[r][j].x), fabsf(v[r][j].y)), fmaxf(fabsf(v[r][j].z), fabsf(v[r][j].w))));
#pragma unroll
        for (int o = 1; o < 64; o <<= 1) mx[r] = fmaxf(mx[r], __shfl_xor(mx[r], o));
        const float sc = mx[r] > 0.f ? mx[r] * (0.85f / 6.f) : 1.f, isc = 1.f / sc;
        unsigned short* drow = (unsigned short*)(dst + (size_t)r * 256);
#pragma unroll
        for (int j = 0; j < 8; ++j) { const f32x4 q4 = v[r][j];
            const float y0 = fminf(fmaxf(q4.x * isc, -6.f), 6.f), y1 = fminf(fmaxf(q4.y * isc, -6.f), 6.f), y2 = fminf(fmaxf(q4.z * isc, -6.f), 6.f), y3 = fminf(fmaxf(q4.w * isc, -6.f), 6.f);
            unsigned acc = __builtin_amdgcn_cvt_scalef32_pk_fp4_f32(0u, y0, y1, 1.0f, 0);
            acc = __builtin_amdgcn_cvt_scalef32_pk_fp4_f32(acc, y2, y3, 1.0f, 1);
            drow[64 * j + lane] = (unsigned short)(acc & 0xffffu); }
        if (lane == 0) inv_scale[r] = sc;
    }
}
#ifndef PEER_FAST_REDUCE
#define PEER_FAST_REDUCE 1
#endif
__device__ __forceinline__ float dpp_ror_add(float t, int) { return t; }
#define FP4_BYTE(d, j) __builtin_amdgcn_cvt_scalef32_pk_f32_fp4((d), 1.0f, (j))
__device__ __forceinline__ float dot_row(const v4u& a, const float (&xv)[32]) {
    f32x2 p2 = {0.f, 0.f};
#pragma unroll
    for (int w = 0; w < 4; ++w) { const unsigned d = (w == 0) ? a.x : (w == 1) ? a.y : (w == 2) ? a.z : a.w;
        const f32x2 f0 = FP4_BYTE(d, 0), f1 = FP4_BYTE(d, 1), f2 = FP4_BYTE(d, 2), f3 = FP4_BYTE(d, 3);
        p2 = __builtin_elementwise_fma(f0, (f32x2){xv[8 * w], xv[8 * w + 1]}, p2); p2 = __builtin_elementwise_fma(f1, (f32x2){xv[8 * w + 2], xv[8 * w + 3]}, p2);
        p2 = __builtin_elementwise_fma(f2, (f32x2){xv[8 * w + 4], xv[8 * w + 5]}, p2); p2 = __builtin_elementwise_fma(f3, (f32x2){xv[8 * w + 6], xv[8 * w + 7]}, p2); }
    return p2.x + p2.y;
}
__device__ __forceinline__ void axpy_row(const v4u& a, float wgt, float (&y)[32]) {
#pragma unroll
    for (int w = 0; w < 4; ++w) { const unsigned d = (w == 0) ? a.x : (w == 1) ? a.y : (w == 2) ? a.z : a.w;
        const f32x2 f0 = FP4_BYTE(d, 0), f1 = FP4_BYTE(d, 1), f2 = FP4_BYTE(d, 2), f3 = FP4_BYTE(d, 3);
        y[8 * w] += wgt * f0.x; y[8 * w + 1] += wgt * f0.y; y[8 * w + 2] += wgt * f1.x; y[8 * w + 3] += wgt * f1.y;
        y[8 * w + 4] += wgt * f2.x; y[8 * w + 5] += wgt * f2.y; y[8 * w + 6] += wgt * f3.x; y[8 * w + 7] += wgt * f3.y; }
}
#define DPP_ROR_MAX(t, n) fmaxf((t), __uint_as_float(__builtin_amdgcn_update_dpp(0u, __float_as_uint(t), 0x120 + (n), 0xf, 0xf, false)))
#define CSWAP(a, b) do { const float hi_ = fmaxf(a, b), lo_ = fminf(a, b); a = hi_; b = lo_; } while (0)
__device__ __forceinline__ void topk_token_fast(const float* __restrict__ srow, int lane, const float* inv_su, const float* inv_sv,
                                                LAS int* se, LAS float* sa, LAS float* sb) {
    const int l16 = lane & 15, row = lane >> 4;
    float R[4];
#pragma unroll
    for (int ps = 0; ps < 4; ++ps) {
        const f32x4 v0 = *(const f32x4*)(srow + (4 * ps + row) * 128 + 8 * l16), v1 = *(const f32x4*)(srow + (4 * ps + row) * 128 + 8 * l16 + 4);
        float k[8];
        k[0] = v0.x; k[1] = v0.y; k[2] = v0.z; k[3] = v0.w; k[4] = v1.x; k[5] = v1.y; k[6] = v1.z; k[7] = v1.w;
#pragma unroll
        for (int i = 0; i < 8; ++i) k[i] = __uint_as_float((__float_as_uint(k[i]) & 0xFFFFFF80u) | (unsigned)(8 * l16 + i));
        CSWAP(k[0], k[1]); CSWAP(k[2], k[3]); CSWAP(k[4], k[5]); CSWAP(k[6], k[7]);
        CSWAP(k[0], k[2]); CSWAP(k[1], k[3]); CSWAP(k[4], k[6]); CSWAP(k[5], k[7]);
        CSWAP(k[1], k[2]); CSWAP(k[5], k[6]);
        CSWAP(k[0], k[4]); CSWAP(k[1], k[5]); CSWAP(k[2], k[6]); CSWAP(k[3], k[7]);
        CSWAP(k[2], k[4]); CSWAP(k[3], k[5]);
        CSWAP(k[1], k[2]); CSWAP(k[3], k[4]); CSWAP(k[5], k[6]);
        float res = 0.f;
#pragma unroll
        for (int it = 0; it < 16; ++it) {
            float m = k[0];
            m = DPP_ROR_MAX(m, 8); m = DPP_ROR_MAX(m, 4); m = DPP_ROR_MAX(m, 2); m = DPP_ROR_MAX(m, 1);
            const bool own = (k[0] == m);
#pragma unroll
            for (int i = 0; i < 7; ++i) k[i] = own ? k[i + 1] : k[i];
            k[7] = own ? -INFINITY : k[7];
            res = (l16 == it) ? m : res;
        }
        R[ps] = res;
    }
#pragma unroll
    for (int g = 0; g < 2; ++g) {
        const auto sw = __builtin_amdgcn_permlane16_swap(__float_as_uint(R[2 * g]), __float_as_uint(R[2 * g + 1]), false, false);
        const float X = __uint_as_float(sw[0]), Y = __uint_as_float(sw[1]);
        const float a = __uint_as_float(__float_as_uint(X) & 0xFFFFFF80u);
        int j = 0;
        float v2 = __shfl(Y, (lane & 48));
        float best = 0.f;
#pragma unroll
        for (int it = 0; it < 16; ++it) {
            const float sum = a + __uint_as_float(__float_as_uint(v2) & 0xFFFFFF80u);
            const float cand = (j < 16) ? __uint_as_float((__float_as_uint(sum) & 0xFFFFFF00u) | (unsigned)((l16 << 4) | (j & 15))) : -INFINITY;
            float m = cand;
            m = DPP_ROR_MAX(m, 8); m = DPP_ROR_MAX(m, 4); m = DPP_ROR_MAX(m, 2); m = DPP_ROR_MAX(m, 1);
            best = (l16 == it) ? m : best;
            if (it < 15) { j += (cand == m) ? 1 : 0; v2 = __shfl(Y, (lane & 48) + (j & 15)); }
        }
        const unsigned bb = __float_as_uint(best);
        const int bi = (bb >> 4) & 15, bj = bb & 15;
        const unsigned k1 = __float_as_uint(__shfl(X, (lane & 48) + bi)), k2 = __float_as_uint(__shfl(Y, (lane & 48) + bj));
        const int e = (int)(k1 & 127u) * 128 + (int)(k2 & 127u);
        const float bv = __uint_as_float(bb & 0xFFFFFF00u);
        float mx = bv; mx = DPP_ROR_MAX(mx, 8); mx = DPP_ROR_MAX(mx, 4); mx = DPP_ROR_MAX(mx, 2); mx = DPP_ROR_MAX(mx, 1);
        const float ex = __expf(bv - mx);
        float sm = ex; sm = DPP_ROR_ADD(sm, 8); sm = DPP_ROR_ADD(sm, 4); sm = DPP_ROR_ADD(sm, 2); sm = DPP_ROR_ADD(sm, 1);
        const float gate = ex / sm;
        const int head = 4 * g + ((row & 1) * 2 + (row >> 1));
        se[head * 16 + l16] = e; sa[head * 16 + l16] = inv_su[e]; sb[head * 16 + l16] = gate * inv_sv[e];
    }
}
#define PEER_LOAD(DST, TAB, b) do { _Pragma("unroll") for (int r_ = 0; r_ < 4; ++r_) { const unsigned char* rp_ = (TAB) + (size_t)(unsigned)__builtin_amdgcn_readfirstlane(se[4 * (b) + r_]) * 1024 + 16 * lane; \
        DST[r_] = *(const v4u*)rp_; } } while (0)
__device__ __forceinline__ void peer_token(int t, const float* scores, const bf16_t* hn, const float* hbuf, const unsigned char* U8, const unsigned char* V8,
                                           const float* inv_su, const float* inv_sv, const float* gfin, float* out,
                                           LAS int* se, LAS float* sa, LAS float* sb, int lane_in) {
    int lane = lane_in;
    {
        LAS int* se0 = se + 512; LAS float* sa0 = sa + 512; LAS float* sb0 = sb + 512;
        topk_token_fast(scores + (size_t)t * DM, lane, inv_su, inv_sv, se0, sa0, sb0);
        unsigned a0 = ((unsigned)se0[lane] << 7) | (unsigned)lane, a1 = ((unsigned)se0[lane + 64] << 7) | (unsigned)(lane + 64);
#pragma unroll
        for (int k = 2; k <= 128; k <<= 1) {
#pragma unroll
            for (int j = k >> 1; j > 0; j >>= 1) {
                if (j == 64) { const unsigned lo = a0 < a1 ? a0 : a1, hi = a0 < a1 ? a1 : a0; a0 = lo; a1 = hi; }
                else {
                    const unsigned p0 = (unsigned)__shfl_xor((int)a0, j), p1 = (unsigned)__shfl_xor((int)a1, j);
                    const bool lower = (lane & j) == 0;
                    const bool up0 = (lane & k) == 0, up1 = ((lane + 64) & k) == 0;
                    const unsigned mn0 = a0 < p0 ? a0 : p0, mx0 = a0 < p0 ? p0 : a0, mn1 = a1 < p1 ? a1 : p1, mx1 = a1 < p1 ? p1 : a1;
                    a0 = (up0 == lower) ? mn0 : mx0; a1 = (up1 == lower) ? mn1 : mx1;
                }
            }
        }
        const int k0 = a0 & 127, k1 = a1 & 127;
        se[lane] = (int)(a0 >> 7); sa[lane] = sa0[k0]; sb[lane] = sb0[k0];
        se[lane + 64] = (int)(a1 >> 7); sa[lane + 64] = sa0[k1]; sb[lane + 64] = sb0[k1];
    }
    asm volatile("" : "+v"(lane));
    float xv[32], y[32];
#pragma unroll
    for (int j = 0; j < 4; ++j) {
        const v4u h0 = *(const v4u*)(hn + (size_t)t * DM + 32 * lane + 8 * j);
#pragma unroll
        for (int w = 0; w < 4; ++w) { const unsigned d0 = (w == 0) ? h0.x : (w == 1) ? h0.y : (w == 2) ? h0.z : h0.w;
            xv[8 * j + 2 * w] = __uint_as_float(d0 << 16); xv[8 * j + 2 * w + 1] = __uint_as_float(d0 & 0xffff0000u); }
    }
#pragma unroll
    for (int i = 0; i < 32; ++i) y[i] = 0.f;
    v4u Ua[4], Ub[4], Va[4];
#define PEER_BATCH(b, UC, VC) do { \
        PEER_LOAD(VC, V8, (b)); \
        float pr[4]; \
        _Pragma("unroll") for (int r = 0; r < 4; ++r) pr[r] = dot_row(UC[r], xv); \
        if ((b) + 2 < 32) PEER_LOAD(UC, U8, (b) + 2); \
        float wr_[4], q2[2]; \
        _Pragma("unroll") for (int r = 0; r < 2; ++r) { auto sw = __builtin_amdgcn_permlane32_swap(__float_as_uint(pr[r]), __float_as_uint(pr[r + 2]), false, false); q2[r] = __uint_as_float(sw[0]) + __uint_as_float(sw[1]); } \
        float tv; \
        { auto sw = __builtin_amdgcn_permlane16_swap(__float_as_uint(q2[0]), __float_as_uint(q2[1]), false, false); tv = __uint_as_float(sw[0]) + __uint_as_float(sw[1]); } \
        tv = DPP_ROR_ADD(tv, 8); tv = DPP_ROR_ADD(tv, 4); tv = DPP_ROR_ADD(tv, 2); tv = DPP_ROR_ADD(tv, 1); \
        const int k = 4 * (b) + (lane >> 4);     \
        const float wc = gelu_erf(tv * sa[k]) * sb[k]; \
        _Pragma("unroll") for (int r = 0; r < 4; ++r) wr_[r] = __uint_as_float(__builtin_amdgcn_readlane(__float_as_uint(wc), 16 * r)); \
        _Pragma("unroll") for (int r = 0; r < 4; ++r) axpy_row(VC[r], wr_[r], y); } while (0)
    PEER_LOAD(Ua, U8, 0); PEER_LOAD(Ub, U8, 1);
#pragma unroll 1
    for (int b = 0; b < 32; b += 2) { PEER_BATCH(b, Ua, Va); PEER_BATCH(b + 1, Ub, Va); }
    float ss = 0.f;
#pragma unroll
    for (int j = 0; j < 8; ++j) { const f32x4 hv = *(const f32x4*)(hbuf + (size_t)t * DM + 32 * lane + 4 * j);
        y[4 * j] += hv.x; y[4 * j + 1] += hv.y; y[4 * j + 2] += hv.z; y[4 * j + 3] += hv.w;
        ss += (y[4 * j] * y[4 * j] + y[4 * j + 1] * y[4 * j + 1]) + (y[4 * j + 2] * y[4 * j + 2] + y[4 * j + 3] * y[4 * j + 3]); }
    ss = wave_sum(ss);
    const float rstd = rsqrtf(ss * (1.f / DM) + EPS);
#pragma unroll
    for (int j = 0; j < 8; ++j) { const f32x4 gg = *(const f32x4*)(gfin + 32 * lane + 4 * j);
        f32x4 o; o.x = y[4 * j] * rstd * gg.x; o.y = y[4 * j + 1] * rstd * gg.y; o.z = y[4 * j + 2] * rstd * gg.z; o.w = y[4 * j + 3] * rstd * gg.w;
        *(f32x4*)(out + (size_t)t * DM + 32 * lane + 4 * j) = o; }
}
typedef short bf16x8 __attribute__((ext_vector_type(8)));
__device__ __forceinline__ int pos32(int x) { const int g = x & ~31, l = x & 31; return g + 8 * ((l & 15) >> 2) + 4 * (l >> 4) + (l & 3); }
constexpr size_t PB_H_QG = 0, PB_H_KDT = 32 * MiB, PB_H_A = 64 * MiB;
constexpr size_t PB_G_QS = 80 * MiB, PB_G_KT = 96 * MiB;
constexpr size_t PB_G_W = 112 * MiB, PB_G_A = 144 * MiB, PB_G_U = 160 * MiB;
constexpr int CA = 96;
constexpr int PROG_WORD = 3584;
constexpr int NSB = 128, CPW = 4;
constexpr int SC_QG = 0, SC_WV = 16384, SC_KDT = 32768, SC_A = 49152, SC_BUF = 57344, SC_VEC = 2 * SC_BUF, SC_OT = SC_VEC + 2048, SC_OTB = 17408, SC_GAIN = SC_OT + 2 * SC_OTB;

__device__ __forceinline__ bf16x8 pack_frag(const f32x4& x0, const f32x4& x1) {
    v4u w; w.x = pk2(x0.x, x0.y); w.y = pk2(x0.z, x0.w); w.z = pk2(x1.x, x1.y); w.w = pk2(x1.z, x1.w);
    return __builtin_bit_cast(bf16x8, w);
}
#define MFMA16(a, b, c) __builtin_amdgcn_mfma_f32_16x16x32_bf16((a), (b), (c), 0, 0, 0)

__device__ __forceinline__ void hgrn_prep_item(int item, const bf16_t* proj, const float* lb_logits, unsigned char* pb, float* vecs, LAS unsigned char* lds, int tid) {
    const int c = item & 127, sq = item >> 7, b = sq >> 3, h = sq & 7, t0 = b * SEQ + c * 64;
    const int d = tid & 127, seg = tid >> 7, lane = tid & 63, wave = tid >> 6;
    LAS bf16_t* QGl = (LAS bf16_t*)lds; LAS bf16_t* KGl = (LAS bf16_t*)(lds + 17408); LAS float* segsum = (LAS float*)(lds + 34816);
    bf16_t* gQG = (bf16_t*)(pb + PB_H_QG) + (size_t)item * 8192;
    bf16_t* gKDT = (bf16_t*)(pb + PB_H_KDT) + (size_t)item * 8192;
    bf16_t* gA = (bf16_t*)(pb + PB_H_A) + (size_t)item * 4096;
    float* gvec = vecs + (size_t)item * 256;
    const float l0 = lb_logits[h * 128 + d], l1 = lb_logits[1024 + h * 128 + d];
    const float lb = 1.f / (1.f + __expf(l1 - l0));
    float lf[16], qv[16], kv[16];
#pragma unroll
    for (int i = 0; i < 16; ++i) {
        const bf16_t* pr = proj + (size_t)(t0 + 16 * seg + i) * NPROJ + h * 128 + d;
        const float z = bf2f(pr[C_AF]); qv[i] = bf2f(pr[C_AQ]);
        const float f = lb + (1.f - lb) * sigmoidf_(z);
        lf[i] = __logf(f); kv[i] = 1.f - f;
    }
    float run = 0.f;
#pragma unroll
    for (int i = 0; i < 16; ++i) { run += lf[i]; lf[i] = run; }
    segsum[seg * 128 + d] = run;
    __syncthreads();
    float off = 0.f, bl = 0.f;
#pragma unroll
    for (int s = 0; s < 4; ++s) { const float v = segsum[s * 128 + d]; bl += v; if (s < seg) off += v; }
    const int pd = pos32(d);
    float kd[16];
#pragma unroll
    for (int i = 0; i < 16; ++i) {
        const float bc = lf[i] + off; const int tl = 16 * seg + i;
        const float qg = qv[i] * __expf(bc), kg = kv[i] * __expf(-bc);
        kd[i] = kv[i] * __expf(bl - bc);
        const bf16_t qb = f2bf(qg);
        QGl[tl * 136 + d] = qb; KGl[tl * 136 + d] = f2bf(kg);
        gQG[tl * 128 + pd] = qb;
    }
#pragma unroll
    for (int ii = 0; ii < 4; ++ii) { v2u o; o.x = pk2(kd[4 * ii], kd[4 * ii + 1]); o.y = pk2(kd[4 * ii + 2], kd[4 * ii + 3]);
        *(v2u*)(gKDT + d * 64 + 32 * (seg >> 1) + 8 * ii + 4 * (seg & 1)) = o; }
    if (seg == 0) gvec[128 + d] = __expf(bl);
    __syncthreads();
    const int n = lane & 15, q = lane >> 4;
#pragma unroll
    for (int ti = 0; ti < 2; ++ti) {
        const int id = wave + 8 * ti, mt = id >> 2, ns = id & 3;
        f32x4 acc = {0.f, 0.f, 0.f, 0.f};
        if (ns <= mt) {
#pragma unroll
            for (int s4 = 0; s4 < 4; ++s4) {
                const bf16x8 a = *(const LAS bf16x8*)(QGl + (16 * mt + n) * 136 + 32 * s4 + 8 * q);
                const bf16x8 bb = *(const LAS bf16x8*)(KGl + (16 * ns + n) * 136 + 32 * s4 + 8 * q);
                acc = MFMA16(a, bb, acc);
            }
        }
        const int s = 16 * ns + n, ps = pos32(s);
#pragma unroll
        for (int r = 0; r < 4; ++r) { const int t = 16 * mt + 4 * q + r; const float v = (r == 0) ? acc.x : (r == 1) ? acc.y : (r == 2) ? acc.z : acc.w;
            gA[t * 64 + ps] = f2bf((s <= t) ? v : 0.f); }
    }
    __syncthreads();
}

constexpr int GP_QF = 0, GP_KF = 33024, GP_N = 0, GP_QB = 66048, GP_KB = 83456, GP_VB = 100864, GP_PART = 135680, GP_SB = 137728;
__device__ __forceinline__ void gdn_prep_item(int item, const bf16_t* proj, const float* ba, const float* conv_w, const float* A_log, const float* dt_bias,
                                              unsigned char* pb, float* vecs, LAS unsigned char* lds, int tid) {
    const int c = item & 127, bq = item >> 7, b = bq >> 2, qh = bq & 3, t0 = b * SEQ + c * 64;
    const int lane = tid & 63, wave = tid >> 6;
    LAS float* QF = (LAS float*)(lds + GP_QF); LAS float* KF = (LAS float*)(lds + GP_KF);
    LAS bf16_t* QB = (LAS bf16_t*)(lds + GP_QB); LAS bf16_t* KB = (LAS bf16_t*)(lds + GP_KB); LAS bf16_t* VB = (LAS bf16_t*)(lds + GP_VB);
    LAS float* PART = (LAS float*)(lds + GP_PART); LAS float* SBETA = (LAS float*)(lds + GP_SB); LAS float* SGC = SBETA + 128;
    LAS float* NM = (LAS float*)(lds + GP_N);
    {
        int col, wch; const int dd = tid & 127;
        if (tid < 128) { col = C_BQ + qh * 128 + dd; wch = qh * 128 + dd; }
        else if (tid < 256) { col = C_BK + qh * 128 + dd; wch = 512 + qh * 128 + dd; }
        else { const int vh = 2 * qh + ((tid - 256) >> 7); col = C_BV + vh * 128 + dd; wch = 1024 + vh * 128 + dd; }
        const float w0 = conv_w[wch], w1 = conv_w[2048 + wch], w2 = conv_w[4096 + wch], w3 = conv_w[6144 + wch];
        float h0 = 0.f, h1 = 0.f, h2 = 0.f;
        const bf16_t* pr = proj + (size_t)t0 * NPROJ + col;
        if (c > 0) { h0 = bf2f(pr[-3 * NPROJ]); h1 = bf2f(pr[-2 * NPROJ]); h2 = bf2f(pr[-1 * NPROJ]); }
        unsigned xr[64];
#pragma unroll
        for (int t = 0; t < 64; ++t) xr[t] = pr[(size_t)t * NPROJ];
#pragma unroll
        for (int t = 0; t < 64; ++t) {
            const float xx = __uint_as_float(xr[t] << 16);
            const float yv = siluf_(w0 * h0 + w1 * h1 + w2 * h2 + w3 * xx);
            h0 = h1; h1 = h2; h2 = xx;
            if (tid < 128) QF[t * 129 + dd] = yv;
            else if (tid < 256) KF[t * 129 + dd] = yv;
            else VB[((tid - 256) >> 7) * 8704 + t * 136 + dd] = f2bf(yv);
        }
    }
    __syncthreads();
    {
        const int t = tid & 63, part = tid >> 6, which = part >> 2, sub = part & 3;
        const LAS float* src = (which ? KF : QF) + t * 129 + 32 * sub;
        float s = 0.f;
#pragma unroll
        for (int i = 0; i < 32; ++i) s += src[i] * src[i];
        PART[(which * 4 + sub) * 64 + t] = s;
    }
    if (wave < 2) {
        const int vh = 2 * qh + wave;
        const float ax = ba[(size_t)(t0 + lane) * 16 + 8 + vh] + dt_bias[vh];
        const float sp = ax > 20.f ? ax : log1pf(__expf(ax));
        float gc = -__expf(A_log[vh]) * sp;
#pragma unroll
        for (int o = 1; o < 64; o <<= 1) { const float up = __shfl_up(gc, o); if (lane >= o) gc += up; }
        const float gl = __shfl(gc, 63);
        const float beta = sigmoidf_(ba[(size_t)(t0 + lane) * 16 + vh]);
        SBETA[wave * 64 + lane] = beta; SGC[wave * 64 + lane] = gc;
        float* gvec = vecs + ((size_t)(16 + b * 8 + vh) * 128 + c) * 256;
        gvec[lane] = __expf(gc); gvec[64 + lane] = __expf(gl - gc);
        const float dl = __expf(gl); gvec[128 + lane] = dl; gvec[192 + lane] = dl;
    }
    __syncthreads();
    {
        const int d = tid & 127, seg = tid >> 7, pd = pos32(d);
        bf16_t* gQS = (bf16_t*)(pb + PB_G_QS) + (size_t)item * 8192;
        bf16_t* gKT = (bf16_t*)(pb + PB_G_KT) + (size_t)item * 8192;
        float kk[16];
#pragma unroll
        for (int i = 0; i < 16; ++i) {
            const int tl = 16 * seg + i;
            const float sq = PART[0 * 64 + tl] + PART[1 * 64 + tl] + PART[2 * 64 + tl] + PART[3 * 64 + tl];
            const float sk = PART[4 * 64 + tl] + PART[5 * 64 + tl] + PART[6 * 64 + tl] + PART[7 * 64 + tl];
            const bf16_t qb = f2bf(QF[tl * 129 + d] * rsqrtf(sq + EPS) * 0.08838834764831845f);
            const bf16_t kb = f2bf(KF[tl * 129 + d] * rsqrtf(sk + EPS));
            QB[tl * 136 + d] = qb; KB[tl * 136 + d] = kb; gQS[tl * 128 + pd] = qb; kk[i] = bf2f(kb);
        }
#pragma unroll
        for (int ii = 0; ii < 4; ++ii) { v2u o; o.x = pk2(kk[4 * ii], kk[4 * ii + 1]); o.y = pk2(kk[4 * ii + 2], kk[4 * ii + 3]);
            *(v2u*)(gKT + d * 64 + 32 * (seg >> 1) + 8 * ii + 4 * (seg & 1)) = o; }
    }
    __syncthreads();
    {
        const int n = lane & 15, q = lane >> 4;
#pragma unroll
        for (int ti = 0; ti < 2; ++ti) {
            const int id = 2 * wave + ti, mt = id >> 2, ns = id & 3;
            f32x4 akk = {0.f, 0.f, 0.f, 0.f}, aqk = {0.f, 0.f, 0.f, 0.f};
            if (ns <= mt) {
#pragma unroll
                for (int s4 = 0; s4 < 4; ++s4) {
                    const bf16x8 kb_ = *(const LAS bf16x8*)(KB + (16 * ns + n) * 136 + 32 * s4 + 8 * q);
                    const bf16x8 ka_ = *(const LAS bf16x8*)(KB + (16 * mt + n) * 136 + 32 * s4 + 8 * q);
                    const bf16x8 qa_ = *(const LAS bf16x8*)(QB + (16 * mt + n) * 136 + 32 * s4 + 8 * q);
                    akk = MFMA16(ka_, kb_, akk); aqk = MFMA16(qa_, kb_, aqk);
                }
            }
            const int s = 16 * ns + n, ps = pos32(s);
#pragma unroll
            for (int vl = 0; vl < 2; ++vl) {
                bf16_t* gA = (bf16_t*)(pb + PB_G_A) + ((size_t)((b * 8 + 2 * qh + vl) * 128 + c)) * 4096;
                const float gcs = SGC[vl * 64 + s];
#pragma unroll
                for (int r = 0; r < 4; ++r) {
                    const int t = 16 * mt + 4 * q + r;
                    const float vk = (r == 0) ? akk.x : (r == 1) ? akk.y : (r == 2) ? akk.z : akk.w;
                    const float vq = (r == 0) ? aqk.x : (r == 1) ? aqk.y : (r == 2) ? aqk.z : aqk.w;
                    const float ex = (s <= t) ? __expf(SGC[vl * 64 + t] - gcs) : 0.f;
                    NM[vl * 4096 + t * 64 + s] = (s < t) ? SBETA[vl * 64 + t] * vk * ex : 0.f;
                    gA[t * 64 + ps] = f2bf((s <= t) ? vq * ex : 0.f);
                }
            }
        }
    }
    __syncthreads();
    {
        const int vl = tid >> 8, colx = tid & 255;
        float x[64];
        if (colx < 128) {
#pragma unroll
            for (int t = 0; t < 64; ++t) x[t] = SBETA[vl * 64 + t] * bf2f(VB[vl * 8704 + t * 136 + colx]);
        } else {
#pragma unroll
            for (int t = 0; t < 64; ++t) x[t] = SBETA[vl * 64 + t] * __expf(SGC[vl * 64 + t]) * bf2f(KB[t * 136 + colx - 128]);
        }
        __syncthreads();
        const LAS float* Nv = NM + vl * 4096;
#pragma unroll
        for (int t = 1; t < 64; ++t) {
            float acc = x[t];
#pragma unroll
            for (int s4 = 0; s4 < (t + 3) / 4; ++s4) {
                const f32x4 nn = *(const LAS f32x4*)(Nv + t * 64 + 4 * s4);
                acc -= nn.x * x[4 * s4]; if (4 * s4 + 1 < t) acc -= nn.y * x[4 * s4 + 1]; if (4 * s4 + 2 < t) acc -= nn.z * x[4 * s4 + 2]; if (4 * s4 + 3 < t) acc -= nn.w * x[4 * s4 + 3];
            }
            x[t] = acc;
        }
        if (colx < 128) {
            bf16_t* gU = (bf16_t*)(pb + PB_G_U) + ((size_t)((b * 8 + 2 * qh + vl) * 128 + c)) * 8192;
            const int sl = colx >> 4, n = colx & 15;
#pragma unroll
            for (int mt = 0; mt < 4; ++mt)
#pragma unroll
                for (int q = 0; q < 4; ++q) { v2u o; o.x = pk2(x[16 * mt + 4 * q], x[16 * mt + 4 * q + 1]); o.y = pk2(x[16 * mt + 4 * q + 2], x[16 * mt + 4 * q + 3]);
                    *(v2u*)(gU + ((size_t)((sl * 4 + mt) * 64 + q * 16 + n)) * 4) = o; }
        } else {
            LAS bf16_t* WS = (LAS bf16_t*)(lds + GP_QB) + vl * 8704;
            const int pd = pos32(colx - 128);
#pragma unroll
            for (int t = 0; t < 64; ++t) WS[t * 136 + pd] = f2bf(-x[t]);
        }
    }
    __syncthreads();
    {
#pragma unroll
        for (int i = 0; i < 4; ++i) { const int p = tid + 512 * i, vl = p >> 10, row = (p >> 4) & 63, c16 = p & 15;
            bf16_t* gW = (bf16_t*)(pb + PB_G_W) + ((size_t)((b * 8 + 2 * qh + vl) * 128 + c)) * 8192;
            *(v4u*)(gW + row * 128 + c16 * 8) = *(const LAS v4u*)(lds + GP_QB + vl * 17408 + row * 272 + c16 * 16); }
    }
    __syncthreads();
}

struct ScanSrc { const unsigned char* qg; const unsigned char* wv; const unsigned char* kdt; const unsigned char* a; const float* vec; size_t wv_row; };
__device__ __forceinline__ void scan_dma(const ScanSrc& S, LAS unsigned char* buf, LAS unsigned char* vecb, int w, int lane) {
#pragma unroll
    for (int i = 0; i < 2; ++i) { const int pi = 2 * w + i, row = 4 * pi + (lane >> 4), cl = (lane & 15) ^ (row & 15);
        __builtin_amdgcn_global_load_lds((const unsigned*)(S.qg + row * 256 + cl * 16), (LAS unsigned*)(buf + SC_QG + pi * 1024), 16, 0, 0);
        __builtin_amdgcn_global_load_lds((const unsigned*)(S.wv + (size_t)row * S.wv_row + cl * 16), (LAS unsigned*)(buf + SC_WV + pi * 1024), 16, 0, 0); }
#pragma unroll
    for (int i = 0; i < 2; ++i) { const int pi = 2 * w + i, row = 8 * pi + (lane >> 3), cl = (lane & 7) ^ ((row >> 1) & 7);
        __builtin_amdgcn_global_load_lds((const unsigned*)(S.kdt + row * 128 + cl * 16), (LAS unsigned*)(buf + SC_KDT + pi * 1024), 16, 0, 0); }
    { const int pi = w, row = 8 * pi + (lane >> 3), cl = (lane & 7) ^ ((row >> 1) & 7);
        __builtin_amdgcn_global_load_lds((const unsigned*)(S.a + row * 128 + cl * 16), (LAS unsigned*)(buf + SC_A + pi * 1024), 16, 0, 0); }
    if (w == 0) __builtin_amdgcn_global_load_lds((const unsigned*)((const unsigned char*)S.vec + lane * 16), (LAS unsigned*)vecb, 16, 0, 0);
}
template <bool GDN>
__device__ __forceinline__ void scan_block(int sq, int g, const bf16_t* proj, const unsigned char* pb, const float* vecs, const float* hgrn_g, const float* gdn_g,
                                           bf16_t* mix, unsigned* prog, int nfb, LAS unsigned char* lds, int tid) {
    constexpr bool gdn = GDN;
    const int b = (sq & 15) >> 3, hh = sq & 7, lane = tid & 63, sl = __builtin_amdgcn_readfirstlane(tid >> 6), n = lane & 15, q = lane >> 4;
    const unsigned char* bQG; const unsigned char* bWV; const unsigned char* bKDT; const unsigned char* bA; const unsigned char* bU = nullptr;
    size_t wv_row, wv_chunk; int gate_col, mix_col; const float* gain;
    if (!gdn) {
        const size_t s0 = (size_t)(b * 8 + hh) * 128;
        bQG = pb + PB_H_QG + s0 * 16384; bKDT = pb + PB_H_KDT + s0 * 16384; bA = pb + PB_H_A + s0 * 8192;
        bWV = (const unsigned char*)(proj + (size_t)(b * SEQ) * NPROJ + C_AI + hh * 128); wv_row = (size_t)NPROJ * 2; wv_chunk = (size_t)64 * NPROJ * 2;
        gate_col = C_AG + hh * 128; mix_col = hh * 128; gain = hgrn_g;
    } else {
        const size_t s0 = (size_t)(b * 8 + hh) * 128, q0 = (size_t)(b * 4 + (hh >> 1)) * 128;
        bQG = pb + PB_G_QS + q0 * 16384; bKDT = pb + PB_G_KT + q0 * 16384; bA = pb + PB_G_A + s0 * 8192;
        bWV = pb + PB_G_W + s0 * 16384; wv_row = 256; wv_chunk = 16384; bU = pb + PB_G_U + s0 * 16384;
        gate_col = C_BZ + hh * 128; mix_col = 1024 + hh * 128; gain = gdn_g;
    }
    const float* bvec = vecs + (size_t)sq * 128 * 256;
    LAS float* gainl = (LAS float*)(lds + SC_GAIN);
    const int wave = sl;
    {
        ScanSrc src{bQG, bWV, bKDT, bA, bvec, wv_row};
        scan_dma(src, lds, lds + SC_VEC, wave, lane);
        if (tid < 128) gainl[tid] = gain[tid];
    }
    __builtin_amdgcn_s_waitcnt(0x0070);
    asm volatile("" ::: "memory");
    __builtin_amdgcn_s_barrier();
    asm volatile("" ::: "memory");
#define SCAN_BAR() do { asm volatile("s_waitcnt lgkmcnt(0)" ::: "memory"); __builtin_amdgcn_s_barrier(); asm volatile("" ::: "memory"); } while (0)
#define SCHED_FENCE() __builtin_amdgcn_sched_barrier(0)
    const int sl16 = 2 * g + wave;
    const int hw = (wave == 2) ? 0 : (wave == 3) ? 1 : (wave == 6) ? 2 : (wave == 7) ? 3 : -1;
    if (wave < 2) {
        f32x4 S[8];
        bf16x8 Sf[4];
#pragma unroll
        for (int m = 0; m < 8; ++m) S[m] = (f32x4){0.f, 0.f, 0.f, 0.f};
#pragma unroll
        for (int s4 = 0; s4 < 4; ++s4) Sf[s4] = pack_frag(S[0], S[1]);
        v2u Ureg[4];
#pragma unroll
        for (int mt = 0; mt < 4; ++mt) Ureg[mt] = GDN ? *(const v2u*)(bU + (size_t)(sl16 * 4 + mt) * 512 + lane * 8) : (v2u){0u, 0u};
        for (int c = 0; c < 128; ++c) {
            int lane = tid & 63; asm volatile("" : "+v"(lane));
            const int n = lane & 15, q = lane >> 4;
            const int cur = c & 1;
            LAS unsigned char* buf = lds + cur * SC_BUF;
            const LAS float* vec = (const LAS float*)(lds + SC_VEC + cur * 1024);
            const int cn = (c + 1 < 128) ? c + 1 : 127;
            f32x4 VN[4];
            bf16x8 fa[8], fb[8];
            bf16x8 VNf[2], VNSf[2];
#define SC3_LD8_K128(dst, OFF, mt_) do { _Pragma("unroll") for (int i_ = 0; i_ < 8; ++i_) dst[i_] = *(const LAS bf16x8*)(buf + (OFF) + (16 * ((mt_) + (i_ >> 2)) + n) * 256 + (((4 * (i_ & 3) + q) ^ n) * 16)); } while (0)
#define SC3_LD8_K64(dst, OFF, mb) do { _Pragma("unroll") for (int i_ = 0; i_ < 8; ++i_) dst[i_] = *(const LAS bf16x8*)(buf + (OFF) + (16 * ((mb) + (i_ >> 1)) + n) * 128 + (((4 * (i_ & 1) + q) ^ ((n >> 1) & 7)) * 16)); } while (0)
#define SC3_MM_K128(A0, A1, fr) do { _Pragma("unroll") for (int i_ = 0; i_ < 4; ++i_) { A0 = MFMA16(fr[i_], Sf[i_], A0); A1 = MFMA16(fr[4 + i_], Sf[i_], A1); } } while (0)
#define SC3_MM_K64(X, ma, fr, BF) do { _Pragma("unroll") for (int t_ = 0; t_ < 4; ++t_) { X[(ma) + t_] = MFMA16(fr[2 * t_], BF[0], X[(ma) + t_]); X[(ma) + t_] = MFMA16(fr[2 * t_ + 1], BF[1], X[(ma) + t_]); } } while (0)
#define SC3_DLOAD(m) (*(const LAS f32x4*)(vec + 128 + 16 * (m) + 4 * q))
#define SC3_EGLOAD(mt) (*(const LAS f32x4*)(vec + 16 * (mt) + 4 * q))
#define SC3_PACK_S(s4) do { Sf[s4] = pack_frag(S[2 * (s4)], S[2 * (s4) + 1]); } while (0)
#define SC3_OT_WRITE() do { LAS bf16_t* OT_ = (LAS bf16_t*)(lds + SC_OT + cur * SC_OTB); const int cc_ = 16 * sl16 + n; \
                _Pragma("unroll") for (int mt = 0; mt < 4; ++mt) { \
                    OT_[(16 * mt + 4 * q + 0) * 136 + cc_] = f2bf(O[mt].x); OT_[(16 * mt + 4 * q + 1) * 136 + cc_] = f2bf(O[mt].y); \
                    OT_[(16 * mt + 4 * q + 2) * 136 + cc_] = f2bf(O[mt].z); OT_[(16 * mt + 4 * q + 3) * 136 + cc_] = f2bf(O[mt].w); } } while (0)
            f32x4 dA, dB, dC, dD;
            f32x4 O[4];
            if (GDN) {
#pragma unroll
                for (int mt = 0; mt < 4; ++mt) { const v2u uu = Ureg[mt];
                    VN[mt] = (f32x4){__uint_as_float(uu.x << 16), __uint_as_float(uu.x & 0xffff0000u), __uint_as_float(uu.y << 16), __uint_as_float(uu.y & 0xffff0000u)}; }
                SC3_LD8_K128(fa, SC_WV, 0); SCHED_FENCE();
                SC3_LD8_K128(fb, SC_WV, 2); SCHED_FENCE();
#pragma unroll
                for (int mt = 0; mt < 4; ++mt) Ureg[mt] = *(const v2u*)(bU + (size_t)cn * 16384 + (size_t)(sl16 * 4 + mt) * 512 + lane * 8);
                f32x4 eS[4];
#pragma unroll
                for (int i = 0; i < 4; ++i) eS[i] = *(const LAS f32x4*)(vec + 64 + 16 * i + 4 * q);
                dA = SC3_DLOAD(0); dB = SC3_DLOAD(1); dC = SC3_DLOAD(2); dD = SC3_DLOAD(3);
                SCHED_FENCE();
                SC3_PACK_S(3); SC3_MM_K128(VN[0], VN[1], fa); S[0] = S[0] * dA; S[1] = S[1] * dB; S[2] = S[2] * dC; S[3] = S[3] * dD; SCHED_FENCE();
                SC3_LD8_K128(fa, SC_QG, 0); dA = SC3_DLOAD(4); dB = SC3_DLOAD(5); dC = SC3_DLOAD(6); dD = SC3_DLOAD(7); SCHED_FENCE();
                SC3_MM_K128(VN[2], VN[3], fb); S[4] = S[4] * dA; S[5] = S[5] * dB; S[6] = S[6] * dC; S[7] = S[7] * dD; SCHED_FENCE();
                SC3_LD8_K128(fb, SC_QG, 2); dA = SC3_EGLOAD(0); dB = SC3_EGLOAD(1); SCHED_FENCE();
#pragma unroll
                for (int mt = 0; mt < 4; ++mt) O[mt] = (f32x4){0.f, 0.f, 0.f, 0.f};
                SC3_MM_K128(O[0], O[1], fa);
#pragma unroll
                for (int s2 = 0; s2 < 2; ++s2) { VNf[s2] = pack_frag(VN[2 * s2], VN[2 * s2 + 1]); VNSf[s2] = pack_frag(VN[2 * s2] * eS[2 * s2], VN[2 * s2 + 1] * eS[2 * s2 + 1]); }
                SCHED_FENCE();
                SC3_LD8_K64(fa, SC_A, 0); dC = SC3_EGLOAD(2); dD = SC3_EGLOAD(3); SCHED_FENCE();
                SC3_MM_K128(O[2], O[3], fb); O[0] = O[0] * dA; O[1] = O[1] * dB; SCHED_FENCE();
                SC3_LD8_K64(fb, SC_KDT, 0); SCHED_FENCE();
                O[2] = O[2] * dC; O[3] = O[3] * dD;
            } else {
                SC3_LD8_K128(fa, SC_QG, 0); SCHED_FENCE();
                SC3_LD8_K128(fb, SC_QG, 2); SCHED_FENCE();
#pragma unroll
                for (int s2 = 0; s2 < 2; ++s2) { unsigned w[4];
#pragma unroll
                    for (int jj = 0; jj < 4; ++jj) { const int ja = 2 * jj, jb = 2 * jj + 1; const int cc = 16 * sl16 + n;
                        const int ta = 32 * s2 + ((ja < 4) ? 4 * q + ja : 16 + 4 * q + ja - 4), tb = 32 * s2 + ((jb < 4) ? 4 * q + jb : 16 + 4 * q + jb - 4);
                        const unsigned lo = *(const LAS bf16_t*)(buf + SC_WV + ta * 256 + (((cc >> 3) ^ (ta & 15)) * 16) + (cc & 7) * 2), hi = *(const LAS bf16_t*)(buf + SC_WV + tb * 256 + (((cc >> 3) ^ (tb & 15)) * 16) + (cc & 7) * 2);
                        w[jj] = lo | (hi << 16); }
                    v4u ww; ww.x = w[0]; ww.y = w[1]; ww.z = w[2]; ww.w = w[3];
                    VNf[s2] = __builtin_bit_cast(bf16x8, ww); VNSf[s2] = VNf[s2]; }
                dA = SC3_DLOAD(0); dB = SC3_DLOAD(1); dC = SC3_DLOAD(2); dD = SC3_DLOAD(3);
                SCHED_FENCE();
#pragma unroll
                for (int mt = 0; mt < 4; ++mt) O[mt] = (f32x4){0.f, 0.f, 0.f, 0.f};
                SC3_PACK_S(3); SC3_MM_K128(O[0], O[1], fa); S[0] = S[0] * dA; S[1] = S[1] * dB; S[2] = S[2] * dC; S[3] = S[3] * dD; SCHED_FENCE();
                SC3_LD8_K64(fa, SC_A, 0); dA = SC3_DLOAD(4); dB = SC3_DLOAD(5); dC = SC3_DLOAD(6); dD = SC3_DLOAD(7); SCHED_FENCE();
                SC3_MM_K128(O[2], O[3], fb); S[4] = S[4] * dA; S[5] = S[5] * dB; S[6] = S[6] * dC; S[7] = S[7] * dD; SCHED_FENCE();
                SC3_LD8_K64(fb, SC_KDT, 0); SCHED_FENCE();
            }
            SC3_MM_K64(O, 0, fa, VNf); SCHED_FENCE();
            SC3_LD8_K64(fa, SC_KDT, 4); SCHED_FENCE();
            SC3_MM_K64(S, 0, fb, VNSf); SC3_OT_WRITE(); SCHED_FENCE();
            SC3_MM_K64(S, 4, fa, VNSf); SC3_PACK_S(0); SC3_PACK_S(1); SCHED_FENCE();
            SC3_PACK_S(2);
            SCAN_BAR();
        }
    } else if (wave == CPW) {
        for (int c = 0; c < 128; ++c) {
            SCAN_BAR();
            int lane = tid & 63; asm volatile("" : "+v"(lane));
            const LAS bf16_t* OTn = (const LAS bf16_t*)(lds + SC_OT + (c & 1) * SC_OTB);
#pragma unroll
            for (int ps = 0; ps < 4; ++ps) { const int row = 16 * ps + (lane >> 2), pc = lane & 3, col = 32 * g + 8 * pc;
                    const v4u val = *(const LAS v4u*)(OTn + row * 136 + col);
                    *(v4u*)(mix + (size_t)(b * SEQ + c * 64 + row) * DM + mix_col + col) = val; }
        }
    } else if (hw >= 0) {
        v4u G0[15], G1[15];
#define HLP_LOAD(GX, cn_) do { const unsigned char* sQG = bQG + (size_t)(cn_) * 16384 + (size_t)hw * 4096; const unsigned char* sWV = bWV + (size_t)(cn_) * wv_chunk + (size_t)(16 * hw) * wv_row; \
            const unsigned char* sKDT = bKDT + (size_t)(cn_) * 16384 + (size_t)hw * 4096; const unsigned char* sA = bA + (size_t)(cn_) * 8192 + (size_t)hw * 2048; \
            const unsigned l16 = (unsigned)lane * 16u, offv = (unsigned)(lane >> 4) * (unsigned)wv_row + (unsigned)(lane & 15) * 16u; \
            _Pragma("unroll") for (int i = 0; i < 4; ++i) { GX[i] = *(const v4u*)(sQG + i * 1024 + l16); GX[4 + i] = *(const v4u*)(sWV + (size_t)(4 * i) * wv_row + offv); } \
            _Pragma("unroll") for (int i = 0; i < 4; ++i) GX[8 + i] = *(const v4u*)(sKDT + i * 1024 + l16); \
            _Pragma("unroll") for (int i = 0; i < 2; ++i) GX[12 + i] = *(const v4u*)(sA + i * 1024 + l16); \
            GX[14] = *(const v4u*)((const unsigned char*)(bvec + (size_t)(cn_) * 256) + l16); } while (0)
#define HLP_STORE(GX, bi_) do { LAS unsigned char* nb = lds + (bi_) * SC_BUF + hw * 4096; LAS unsigned char* nv = lds + SC_VEC + (bi_) * 1024; const int lq = lane >> 4; \
            _Pragma("unroll") for (int i = 0; i < 4; ++i) { const int d = lq * 256 + (((lane & 15) ^ (4 * i + lq)) * 16); \
                *(LAS v4u*)(nb + SC_QG + i * 1024 + d) = GX[i]; *(LAS v4u*)(nb + SC_WV + i * 1024 + d) = GX[4 + i]; } \
            _Pragma("unroll") for (int i = 0; i < 4; ++i) { const int d = (lane >> 3) * 128 + (((lane & 7) ^ (4 * (i & 1) + lq)) * 16); *(LAS v4u*)(nb + SC_KDT + i * 1024 + d) = GX[8 + i]; } \
            _Pragma("unroll") for (int i = 0; i < 2; ++i) { const int d = (lane >> 3) * 128 + (((lane & 7) ^ (4 * i + lq)) * 16); *(LAS v4u*)(nb - hw * 2048 + SC_A + i * 1024 + d) = GX[12 + i]; } \
            if (hw == 0) *(LAS v4u*)(nv + lane * 16) = GX[14]; } while (0)
#define HLP_ITER(c, GL, GW) do { \
            int lane = tid & 63; asm volatile("" : "+v"(lane)); \
            const int c2 = ((c) + 2 < 128) ? (c) + 2 : 127; \
            HLP_LOAD(GL, c2); \
            HLP_STORE(GW, ((c) + 1) & 1); \
            SCAN_BAR(); } while (0)
        { int lane = tid & 63; asm volatile("" : "+v"(lane)); HLP_LOAD(G1, 1); }
        for (int c = 0; c < 128; c += 2) { HLP_ITER(c, G0, G1); HLP_ITER(c + 1, G1, G0); }
    } else {
        for (int c = 0; c < 128; ++c) {
            if (c == CA - 3 && nfb > 0) {
                if ((tid & 63) == 0) { while (__hip_atomic_load(prog, __ATOMIC_RELAXED, __HIP_MEMORY_SCOPE_AGENT) < (unsigned)nfb) __builtin_amdgcn_s_sleep(8); }
                __builtin_amdgcn_fence(__ATOMIC_ACQUIRE, "agent");
                asm volatile("s_waitcnt vmcnt(0)" ::: "memory");
            }
            SCAN_BAR();
        }
    }
    __syncthreads();
}

__device__ __forceinline__ void mixnorm_row(bf16_t* mrow, const bf16_t* prow, const float (&gn)[32], int lane) {
    const int c0 = 32 * lane;
    const bf16_t* gp = prow + (c0 < 1024 ? C_AG + c0 : C_BZ + c0 - 1024);
    v4u o4[4], z4[4];
#pragma unroll
    for (int i = 0; i < 4; ++i) { o4[i] = *(const v4u*)(mrow + c0 + 8 * i); z4[i] = *(const v4u*)(gp + 8 * i); }
    float ss = 0.f;
#pragma unroll
    for (int i = 0; i < 4; ++i)
#pragma unroll
        for (int w = 0; w < 4; ++w) { const unsigned a = (w == 0) ? o4[i].x : (w == 1) ? o4[i].y : (w == 2) ? o4[i].z : o4[i].w;
            const float lo = __uint_as_float(a << 16), hi = __uint_as_float(a & 0xffff0000u); ss += lo * lo + hi * hi; }
    ss += __shfl_xor(ss, 1); ss += __shfl_xor(ss, 2);
    const float rstd = rsqrtf(ss * (1.f / 128.f) + EPS);
#pragma unroll
    for (int i = 0; i < 4; ++i) { float yv[8];
#pragma unroll
        for (int w = 0; w < 4; ++w) { const unsigned a = (w == 0) ? o4[i].x : (w == 1) ? o4[i].y : (w == 2) ? o4[i].z : o4[i].w;
            const unsigned z = (w == 0) ? z4[i].x : (w == 1) ? z4[i].y : (w == 2) ? z4[i].z : z4[i].w;
            yv[2 * w] = __uint_as_float(a << 16) * rstd * gn[8 * i + 2 * w] * __uint_as_float(z << 16);
            yv[2 * w + 1] = __uint_as_float(a & 0xffff0000u) * rstd * gn[8 * i + 2 * w + 1] * __uint_as_float(z & 0xffff0000u); }
        v4u y4; y4.x = pk2(yv[0], yv[1]); y4.y = pk2(yv[2], yv[3]); y4.z = pk2(yv[4], yv[5]); y4.w = pk2(yv[6], yv[7]);
        *(v4u*)(mrow + c0 + 8 * i) = y4; }
}

struct EpiProj {
    static constexpr bool PERM = true, AFTER_DRAIN = false;
    bf16_t* O; int ldc;
    __device__ __forceinline__ void operator()(const pg8::f32x4 (&acc)[2][2][4][2], const pg8::Unit& u, int wr, int wc, int fr, int fq) const {
        const int row0 = u.pm * 256 + wr * 64 + fr, col0 = u.pn * 256 + wc * 32 + 8 * fq;
        const bool gate = (u.pn >= 12 && u.pn < 16) || (u.pn >= 24);
#pragma unroll
        for (int ai = 0; ai < 2; ++ai)
#pragma unroll
            for (int m = 0; m < 4; ++m) { bf16_t* rowp = O + (size_t)(row0 + ai * 128 + m * 16) * ldc + col0;
#pragma unroll
                for (int bj = 0; bj < 2; ++bj) { pg8::f32x4 v0 = acc[ai][bj][m][0], v1 = acc[ai][bj][m][1];
                    if (gate) {
#pragma unroll
                        for (int e = 0; e < 4; ++e) { v0[e] = v0[e] * __builtin_amdgcn_rcpf(1.f + __expf(-v0[e])); v1[e] = v1[e] * __builtin_amdgcn_rcpf(1.f + __expf(-v1[e])); } }
                    pg8::u32x4 w; w.x = pk2(v0[0], v0[1]); w.y = pk2(v0[2], v0[3]); w.z = pk2(v1[0], v1[1]); w.w = pk2(v1[2], v1[3]);
                    *(pg8::u32x4*)(rowp + bj * 128) = w; } }
    }
};
struct EpiResF32 {
    static constexpr bool PERM = false, AFTER_DRAIN = false;
    const float* R; float* O; int ldc;
    __device__ __forceinline__ void operator()(const pg8::f32x4 (&acc)[2][2][4][2], const pg8::Unit& u, int wr, int wc, int fr, int fq) const {
        const int row0 = u.pm * 256 + wr * 64 + fr, col0 = u.pn * 256 + wc * 32 + 4 * fq;
#pragma unroll
        for (int ai = 0; ai < 2; ++ai)
#pragma unroll
            for (int m = 0; m < 4; ++m) { const size_t off = (size_t)(row0 + ai * 128 + m * 16) * ldc + col0;
#pragma unroll
                for (int bj = 0; bj < 2; ++bj)
#pragma unroll
                    for (int n = 0; n < 2; ++n) { pg8::f32x4 v = acc[ai][bj][m][n]; if (R) v = v + *(const pg8::f32x4*)(R + off + bj * 128 + n * 16); *(pg8::f32x4*)(O + off + bj * 128 + n * 16) = v; } }
    }
};

#define XB_TMO      128
#define XB_XCNT(j)  (256  + 64 * (j))
#define XB_XSUB(j)  (1280 + 64 * (j))
#define XB_XGEN(j)  (2304 + 64 * (j))
#define XB_TOP      3328
#define XB_TOPGEN   3392
#define XCD_BAR_WORDS 3456
#define XB_SPIN_CAP (1u << 18)

__device__ __forceinline__ unsigned xb_ld(unsigned* p)              { return __hip_atomic_load(p, __ATOMIC_RELAXED, __HIP_MEMORY_SCOPE_AGENT); }
__device__ __forceinline__ unsigned xb_add(unsigned* p, unsigned v) { return __hip_atomic_fetch_add(p, v, __ATOMIC_RELAXED, __HIP_MEMORY_SCOPE_AGENT); }
__device__ __forceinline__ unsigned xb_xcc_id() { return (unsigned)__builtin_amdgcn_s_getreg((3 << 11) | 20) & 0xFu; }
#define XB_SPIN(cond, bar) do { unsigned _sp = 0; while (cond) { __builtin_amdgcn_s_sleep(1); \
    if ((++_sp & 255u) == 0u) { if (xb_ld(&(bar)[XB_TMO])) break; if (_sp > XB_SPIN_CAP) { atomicAdd(&(bar)[XB_TMO], 1u); break; } } } } while (0)

struct XcdBarrier {
    unsigned* bar; unsigned x;
    volatile LAS unsigned* st;
};

__device__ __forceinline__ XcdBarrier xcd_barrier_post(unsigned* bar, volatile LAS unsigned* st) {
    XcdBarrier b; b.bar = bar; b.x = xb_xcc_id(); b.st = st;
    if (threadIdx.x == 0) (void)xb_add(&bar[XB_XCNT(b.x)], 1u);
    return b;
}
__device__ __forceinline__ void xcd_barrier_complete(unsigned* bar, unsigned x, unsigned& nloc, unsigned& nx) {
    const unsigned G = gridDim.x * gridDim.y * gridDim.z;
    unsigned sum, cnt, mine, sp = 0u;
    for (;;) {
        sum = 0u; cnt = 0u; mine = 0u;
#pragma unroll
        for (unsigned j = 0; j < 16; ++j) { const unsigned c = xb_ld(&bar[XB_XCNT(j)]); sum += c; cnt += (c > 0u) ? 1u : 0u; mine = (j == x) ? c : mine; }
        if (sum == G) break;
        __builtin_amdgcn_s_sleep(1);
        if ((++sp & 255u) == 0u) { if (xb_ld(&bar[XB_TMO])) break; if (sp > XB_SPIN_CAP) { atomicAdd(&bar[XB_TMO], 1u); break; } }
    }
    nloc = mine > 0u ? mine : 1u; nx = cnt > 0u ? cnt : 1u;
}

__device__ __forceinline__ void xcd_barrier(const XcdBarrier& b) {
    asm volatile("s_waitcnt vmcnt(0)" ::: "memory");
    __syncthreads();
    if (threadIdx.x == 0) {
        unsigned* bar = b.bar;
        __builtin_amdgcn_s_waitcnt(0);
        unsigned nloc = b.st[0], nx = b.st[1];
        if (nloc == 0u) { xcd_barrier_complete(bar, b.x, nloc, nx); b.st[0] = nloc; b.st[1] = nx; }
        const unsigned old = xb_add(&bar[XB_XSUB(b.x)], 1u);
        const unsigned gen = old / nloc;
        if (old + 1u == (gen + 1u) * nloc) {
            __builtin_amdgcn_fence(__ATOMIC_RELEASE, "agent");
            asm volatile("s_waitcnt vmcnt(0)" ::: "memory");
            const unsigned og = xb_add(&bar[XB_TOP], 1u);
            const unsigned tg = og / nx;
            if (og + 1u == (tg + 1u) * nx) xb_add(&bar[XB_TOPGEN], 1u);
            else XB_SPIN(xb_ld(&bar[XB_TOPGEN]) == tg, bar);
            __builtin_amdgcn_fence(__ATOMIC_ACQUIRE, "agent");
            xb_add(&bar[XB_XGEN(b.x)], 1u);
            asm volatile("s_waitcnt vmcnt(0)" ::: "memory");
        } else {
            XB_SPIN(xb_ld(&bar[XB_XGEN(b.x)]) == gen, bar);
            __builtin_amdgcn_fence(__ATOMIC_ACQUIRE, "agent");
            asm volatile("s_waitcnt vmcnt(0)" ::: "memory");
        }
    }
    __syncthreads();
}

__device__ __forceinline__ int get_lane() { int l = (int)__builtin_amdgcn_mbcnt_hi(~0u, __builtin_amdgcn_mbcnt_lo(~0u, 0u)); asm volatile("" : "+v"(l)); return l; }
__global__ void __launch_bounds__(NT, 2) mk_fwd(Args args) {
    extern __shared__ __attribute__((aligned(16))) unsigned char lds_raw[];
    LAS unsigned char* lds = (LAS unsigned char*)lds_raw;
    cg::grid_group grid = cg::this_grid();
    const int tid = threadIdx.x, wave = __builtin_amdgcn_readfirstlane(tid >> 6);

    const int G = gridDim.x, bx = blockIdx.x;
    const int vcu = (G % 8 == 0) ? (bx % 8) * (G / 8) + bx / 8 : bx;
    const int gw = vcu * NW + wave, NGW = G * NW;
    unsigned char* ws = args.ws;
    const float* x = args.in[0]; const float* attn_g = args.in[1]; const float* w_in = args.in[2];
    const float* w_out = args.in[9]; const float* ffn_g = args.in[10]; const float* w_query = args.in[11]; const float* sub_keys = args.in[12];
    bf16_t* WinT = (bf16_t*)(ws + OFF_D);
    bf16_t* WoutT = (bf16_t*)(ws + OFF_C);
    bf16_t* Wqk = (bf16_t*)(ws + OFF_C + 8 * MiB);
    bf16_t* xn = (bf16_t*)(ws + OFF_D + 28 * MiB);
    float* ba = (float*)(ws + OFF_S);
    bf16_t* proj = (bf16_t*)(ws + OFF_B);
    bf16_t* mix = (bf16_t*)args.out;
    unsigned char* pb = ws + OFF_D; float* vecs = (float*)(ws + OFF_S + 2 * MiB);
    float* hbuf = (float*)(ws + OFF_B);
    bf16_t* hn = (bf16_t*)(ws + OFF_D + 128 * MiB);
    float* scores = (float*)(ws + OFF_D);
    unsigned char* U8 = ws + OFF_TAB; unsigned char* V8 = ws + OFF_TAB + 16 * MiB;
    float* inv_su = (float*)(ws + OFF_S + 1 * MiB); float* inv_sv = inv_su + 16384;

    volatile LAS unsigned* xbst = (volatile LAS unsigned*)(lds + LDS_BYTES - 16);
    if (tid < 4) xbst[tid] = 0u;
    __syncthreads();
    XcdBarrier xbar = xcd_barrier_post((unsigned*)args.ws, xbst);
    const int lo = args.ph_lo, hi = args.ph_hi;
#define IN(k) (lo <= (k) && (k) < hi)
#define SYNC_AFTER(k) do { if (IN(k) && (k) + 1 < hi) { if ((k) == 0) grid.sync(); else xcd_barrier(xbar); } } while (0)
    {
        if (IN(0)) {
            const int lane = get_lane();
            LAS float* scr = (LAS float*)(lds + wave * 16384);
            constexpr int I_IN = (DM / 64) * (NPROJ / 32);
            for (int it = gw; it < I_IN; it += NGW) transpose_item(w_in, INW, DM, NPROJ, WinT, scr, it, lane);
            __syncthreads();
            {
                LAS float* wt = (LAS float*)lds;
#pragma unroll
                for (int k = 0; k < 4; ++k) { const int d = tid + 512 * k; const float* wr = w_in + (size_t)d * INW + NPROJ;
#pragma unroll
                    for (int q4 = 0; q4 < 4; ++q4) { const f32x4 w4 = *(const f32x4*)(wr + 4 * q4);
                        wt[(4 * q4 + 0) * 2048 + d] = w4.x; wt[(4 * q4 + 1) * 2048 + d] = w4.y; wt[(4 * q4 + 2) * 2048 + d] = w4.z; wt[(4 * q4 + 3) * 2048 + d] = w4.w; } }
            }
            __syncthreads();
            for (int m = gw; m < T; m += NGW) norm_row<true>(x + (size_t)m * DM, attn_g, (const LAS float*)lds, xn + (size_t)m * DM, ba + (size_t)m * 16, lane);
        }
        SYNC_AFTER(0);
        if (IN(1)) {
            pg8::Gemm g{xn, WinT, T, NPROJ, DM}; pg8::StaticOrder S; S.init(T, NPROJ, G, bx);
            EpiProj E{proj, NPROJ};
            pg8::gemm_phase<EpiProj, pg8::StaticOrder, true, true>(lds, g, S, E);
        }
        SYNC_AFTER(1);
        if (IN(2)) {
            const int CAe = (G > NSB) ? CA : 128;
            for (int it = bx; it < 16 * CAe; it += G) { int tt = threadIdx.x; asm volatile("" : "+v"(tt)); hgrn_prep_item((it / CAe) * 128 + (it % CAe), proj, args.in[3], pb, vecs, lds, tt); }
            for (int it = bx; it < 8 * CAe; it += G) { int tt = threadIdx.x; asm volatile("" : "+v"(tt)); gdn_prep_item((it / CAe) * 128 + (it % CAe), proj, ba, args.in[5], args.in[6], args.in[7], pb, vecs, lds, tt); }
        }
        SYNC_AFTER(2);
        if (IN(3)) {
            const int lane = get_lane();
            unsigned* ctl = (unsigned*)args.ws;
            if (bx < NSB) {
                const int sq = (bx & 7) + 8 * (bx >> 5), cgp = (bx >> 3) & 3;
                if (sq >= 16) scan_block<true>(sq, cgp, proj, pb, vecs, args.in[4], args.in[8], mix, ctl + PROG_WORD, G - NSB, lds, tid);
                else scan_block<false>(sq, cgp, proj, pb, vecs, args.in[4], args.in[8], mix, ctl + PROG_WORD, G - NSB, lds, tid);
            }
            else if (G > NSB) {
                int fb, FB;
                fb = bx - NSB; FB = G - NSB;
                {
                    constexpr int NBL = 128 - CA;
                    for (int it = fb; it < 16 * NBL; it += FB) { int tt = threadIdx.x; asm volatile("" : "+v"(tt)); hgrn_prep_item((it & 15) * 128 + CA + (it >> 4), proj, args.in[3], pb, vecs, lds, tt); }
                    for (int it = fb; it < 8 * NBL; it += FB) { int tt = threadIdx.x; asm volatile("" : "+v"(tt)); gdn_prep_item((it & 7) * 128 + CA + (it >> 3), proj, ba, args.in[5], args.in[6], args.in[7], pb, vecs, lds, tt); }
                    __syncthreads();
                    if (tid == 0) { __threadfence(); __hip_atomic_fetch_add(ctl + PROG_WORD, 1u, __ATOMIC_RELAXED, __HIP_MEMORY_SCOPE_AGENT); }
                    __syncthreads();
                }
                const int fw = fb * NW + wave, FW = FB * NW;
                for (int it = fb; it < 512; it += FB) wqk_item(w_query, sub_keys, Wqk, (LAS float*)lds, it, tid);
                LAS float* scr = (LAS float*)(lds + wave * 16384);
                constexpr int I_OUT = (DM / 64) * (DM / 32);
                for (int it = fw; it < I_OUT; it += FW) transpose_item(w_out, DM, DM, DM, WoutT, scr, it, lane);
                for (int e = 2 * fw; e < 32768; e += 2 * FW) { const bool isv = e >= 16384; const int r = e & 16383;
                    table_row2((isv ? args.in[14] : args.in[13]) + (size_t)r * DM, (unsigned*)((isv ? V8 : U8) + (size_t)r * 1024), (isv ? inv_sv : inv_su) + r, lane); }
            }
        }
        SYNC_AFTER(3);
        if (IN(4)) {
            {
                const int lane = get_lane();
                float gn[32];
                { const float* gsrc = ((32 * lane) < 1024 ? args.in[4] : args.in[8]) + ((32 * lane) & 127);
#pragma unroll
                  for (int i = 0; i < 8; ++i) { const f32x4 g4 = *(const f32x4*)(gsrc + 4 * i); gn[4 * i] = g4.x; gn[4 * i + 1] = g4.y; gn[4 * i + 2] = g4.z; gn[4 * i + 3] = g4.w; } }
                for (int m = gw; m < T; m += NGW) mixnorm_row(mix + (size_t)m * DM, proj + (size_t)m * NPROJ, gn, lane);
                xcd_barrier(xbar);
            }
            pg8::Gemm g{mix, WoutT, T, DM, DM}; pg8::StaticOrder S; S.init(T, DM, G, bx);
            EpiResF32 E{x, hbuf, DM};
            pg8::gemm_phase<EpiResF32, pg8::StaticOrder, true, true>(lds, g, S, E);
        }
        SYNC_AFTER(4);
        if (IN(5)) {
            const int lane = get_lane();
            for (int m = gw; m < T; m += NGW) norm_row<false>(hbuf + (size_t)m * DM, ffn_g, (const LAS float*)lds, hn + (size_t)m * DM, nullptr, lane);
        }
        SYNC_AFTER(5);
        if (IN(6)) {
            pg8::Gemm g{hn, Wqk, T, DM, DM}; pg8::StaticOrder S; S.init(T, DM, G, bx);
            EpiResF32 E{nullptr, scores, DM};
            pg8::gemm_phase<EpiResF32, pg8::StaticOrder, true, true>(lds, g, S, E);
        }
        SYNC_AFTER(6);
        if (IN(7)) {
            const int lane = get_lane();
            LAS int* se = (LAS int*)(lds + wave * 4096); LAS float* sa = (LAS float*)(lds + wave * 4096 + 512); LAS float* sb = (LAS float*)(lds + wave * 4096 + 1024);
            for (int t = gw; t < T; t += NGW) { const int ln = get_lane(); peer_token(t, scores, hn, hbuf, U8, V8, inv_su, inv_sv, args.in[15], args.out, se, sa, sb, ln); }
        }
    }
}
}

extern "C" void kernel_launch(void* const* d_in, const int* in_sizes, int n_in, void* d_out, int out_size, void* d_ws, size_t ws_size, hipStream_t stream) {
    static int grid = 0;
    if (grid == 0) {
        int dev = 0, cus = 0, per_cu = 0;
        (void)hipGetDevice(&dev);
        (void)hipDeviceGetAttribute(&cus, hipDeviceAttributeMultiprocessorCount, dev);
        (void)hipFuncSetAttribute((const void*)mk::mk_fwd, hipFuncAttributeMaxDynamicSharedMemorySize, mk::LDS_BYTES);
        (void)hipOccupancyMaxActiveBlocksPerMultiprocessor(&per_cu, (const void*)mk::mk_fwd, mk::NT, mk::LDS_BYTES);
        if (per_cu < 1) { fprintf(stderr, "occupancy query says %d\n", per_cu); per_cu = 1; }
        grid = cus;
    }
    unsigned char* ws = (unsigned char*)d_ws;
    (void)hipMemsetAsync(d_ws, 0, 16384, stream);
    mk::Args a{};
    for (int i = 0; i < 16; ++i) a.in[i] = (const float*)d_in[i];
    a.out = (float*)d_out; a.ws = ws;
    {
        a.ph_lo = 0; a.ph_hi = 8;
        void* kargs[] = {&a};
        hipError_t e = hipLaunchCooperativeKernel((const void*)mk::mk_fwd, dim3(grid), dim3(mk::NT), kargs, mk::LDS_BYTES, stream);
        if (e != hipSuccess) fprintf(stderr, "coop launch failed: %s\n", hipGetErrorString(e));
    }
}
```

```cpp
#include <hip/hip_runtime.h>
#include <hip/hip_cooperative_groups.h>
#include <cstdio>
namespace cg = cooperative_groups;
#include <stdint.h>

typedef unsigned short bf16_t;
typedef float f32x4 __attribute__((ext_vector_type(4)));

constexpr int T = 16384, SEQ = 8192, DM = 2048, INW = 7184, NPROJ = 7168;
constexpr float EPS = 1e-6f;
constexpr size_t MiB = 1u << 20;
constexpr size_t OFF_TAB = 1 * MiB;
constexpr size_t OFF_B = 65 * MiB;
constexpr size_t OFF_C = 289 * MiB;
constexpr size_t OFF_D = 305 * MiB;
constexpr size_t OFF_S = 500 * MiB;
constexpr int C_AQ = 0, C_AF = 1024, C_AI = 2048, C_AG = 3072, C_BQ = 4096, C_BK = 4608, C_BV = 5120, C_BZ = 6144;

__device__ __forceinline__ float bf2f(bf16_t v) { return __uint_as_float(((unsigned)v) << 16); }
typedef float f32x2_t __attribute__((ext_vector_type(2)));
typedef __bf16 bf16x2_t __attribute__((ext_vector_type(2)));
__device__ __forceinline__ unsigned cvt_pk2(float lo, float hi) { f32x2_t v = {lo, hi}; bf16x2_t b = __builtin_convertvector(v, bf16x2_t); return __builtin_bit_cast(unsigned, b); }
__device__ __forceinline__ bf16_t f2bf(float f) { return (bf16_t)(cvt_pk2(f, 0.f) & 0xffffu); }
__device__ __forceinline__ float sigmoidf_(float x) { return 1.f / (1.f + __expf(-x)); }
__device__ __forceinline__ float siluf_(float x) { return x / (1.f + __expf(-x)); }
__device__ __forceinline__ float wave_sum(float v) {
#pragma unroll
    for (int o = 1; o < 64; o <<= 1) v += __shfl_xor(v, o);
    return v;
}
__device__ __forceinline__ float block_sum(float v, float* sh) {
    v = wave_sum(v);
    const int w = threadIdx.x >> 6, nw = blockDim.x >> 6;
    __syncthreads();
    if ((threadIdx.x & 63) == 0) sh[w] = v;
    __syncthreads();
    float r = 0.f;
    for (int i = 0; i < nw; ++i) r += sh[i];
    return r;
}

__device__ __forceinline__ float gelu_erf(float x) { return 0.5f * x * (1.f + erff(x * 0.70710678118654752f)); }
namespace pg8 {
#define PG8_LAS __attribute__((address_space(3)))
typedef unsigned short bf16_t;
typedef short bf16x8 __attribute__((ext_vector_type(8)));
typedef float f32x4 __attribute__((ext_vector_type(4)));
typedef unsigned u32x4 __attribute__((ext_vector_type(4)));
constexpr int BM = 256, BK = 64, HALF = 128, HTB = HALF * BK * 2  , STAGE_BYTES = 8 * HTB, NXCD = 8, WGM = 8;

__host__ __device__ __forceinline__ int lds_byte(int r, int c) { const int st = (r >> 4) * 2 + (c >> 5), rr = r & 15, cc = c & 31, ob = rr * 64 + cc * 2; return st * 1024 + (ob ^ (((ob >> 9) & 1) << 5)); }
__host__ __device__ __forceinline__ void stage_rc(int b, int& R, int& C) { const int st = b / 1024, sb = b % 1024, swz = sb ^ (((sb >> 9) & 1) << 5); R = (st >> 1) * 16 + swz / 64; C = (st & 1) * 32 + (swz % 64) / 2; }
__host__ __device__ __forceinline__ int perm32(int rho) { const int n = rho >> 4, i = rho & 15; return 8 * (i >> 2) + 4 * n + (i & 3); }

struct Unit { int pm, pn; };
struct Gemm { const bf16_t* A; const bf16_t* Bt; int M, N, K; };

struct StaticOrder {
    int nM, nN, nwg, G, c;
    __host__ __device__ void init(int M, int N, int G_, int c_) { nM = M / BM; nN = N / BM; nwg = nM * nN; G = G_; c = c_; }
    __host__ __device__ bool next(int i, Unit& u) const {
        const long L = (long)i * G + c; if (L >= nwg) return false;
        int wgid = (int)L; { const int q = nwg / NXCD, r = nwg % NXCD, xcd = wgid % NXCD, off = wgid / NXCD; wgid = (xcd < r ? xcd * (q + 1) : r * (q + 1) + (xcd - r) * q) + off; }
        const int nig = WGM * nN, gid = wgid / nig, fm = gid * WGM, gsz = (nM - fm) < WGM ? (nM - fm) : WGM;
        u.pm = fm + ((wgid % nig) % gsz); u.pn = (wgid % nig) / gsz; return true;
    }
    __device__ __forceinline__ void a_ready(const Unit&) const {}
    __device__ __forceinline__ void done(const Unit&) const {}
};

__device__ __forceinline__ unsigned cvt_pk_bf16(float lo, float hi) { unsigned r; asm volatile("v_cvt_pk_bf16_f32 %0, %1, %2" : "=v"(r) : "v"(lo), "v"(hi)); return r; }
typedef float f32x2 __attribute__((ext_vector_type(2)));
__device__ __forceinline__ f32x2 gelu_pk(f32x2 v) {
    const f32x2 av = __builtin_elementwise_abs(v), d = av * 0.2316418882f + 1.0f;
    f32x2 t; t.x = __builtin_amdgcn_rcpf(d.x); t.y = __builtin_amdgcn_rcpf(d.y);
    f32x2 q = t * 0.5307027145f + (-0.7265760135f); q = q * t + 0.7107068705f; q = q * t + (-0.142248368f); q = q * t + 0.127414796f; q = q * t;
    const f32x2 s = (v * v) * (-0.72134752044f);
    f32x2 e; e.x = __builtin_amdgcn_exp2f(s.x); e.y = __builtin_amdgcn_exp2f(s.y);
    const f32x2 m = v * (q * e), r = v - m;
    f32x2 o; o.x = v.x < 0.f ? m.x : r.x; o.y = v.y < 0.f ? m.y : r.y; return o;
}

template <int ACT  > struct EpiBf16 {
    static constexpr bool PERM = true, AFTER_DRAIN = false; static_assert(ACT == 0 || ACT == 1, "EpiBf16: ACT is 0 (none) or 1 (gelu_pk)");
    bf16_t* O; int ldc; const float* bias; int split_cols; size_t split_stride; float scale0;
    __device__ __forceinline__ void operator()(const f32x4 (&acc)[2][2][4][2], const Unit& u, int wr, int wc, int fr, int fq) const {
        const int row0 = u.pm * BM + wr * 64 + fr; int colt = u.pn * BM; bf16_t* base = O;
        float sc = 1.f; if (split_cols) { const int t = colt / split_cols; base += (size_t)t * split_stride; colt -= t * split_cols; if (t == 0) sc = scale0; }
        const int col0 = colt + wc * 32 + 8 * fq, bcol0 = u.pn * BM + wc * 32 + 8 * fq;
        f32x4 bv[2][2];
#pragma unroll
        for (int bj = 0; bj < 2; ++bj)
#pragma unroll
            for (int n = 0; n < 2; ++n) bv[bj][n] = bias ? *(const f32x4*)(bias + bcol0 + bj * HALF + 4 * n) : (f32x4){0.f, 0.f, 0.f, 0.f};
#pragma unroll
        for (int ai = 0; ai < 2; ++ai)
#pragma unroll
            for (int m = 0; m < 4; ++m) { bf16_t* rowp = base + (size_t)(row0 + ai * HALF + m * 16) * ldc + col0;
#pragma unroll
                for (int bj = 0; bj < 2; ++bj) { f32x4 v0 = acc[ai][bj][m][0] + bv[bj][0], v1 = acc[ai][bj][m][1] + bv[bj][1];
                    if (ACT == 1) { f32x2 a = gelu_pk((f32x2){v0[0], v0[1]}), b = gelu_pk((f32x2){v0[2], v0[3]}), c = gelu_pk((f32x2){v1[0], v1[1]}), d = gelu_pk((f32x2){v1[2], v1[3]});
                        v0 = (f32x4){a.x, a.y, b.x, b.y}; v1 = (f32x4){c.x, c.y, d.x, d.y}; }
                    v0 = v0 * sc; v1 = v1 * sc; u32x4 w; w.x = cvt_pk_bf16(v0[0], v0[1]); w.y = cvt_pk_bf16(v0[2], v0[3]); w.z = cvt_pk_bf16(v1[0], v1[1]); w.w = cvt_pk_bf16(v1[2], v1[3]);
                    *(u32x4*)(rowp + bj * HALF) = w; } }
    }
};
template <class Epi, class Sched, bool ALIGN_EPI = false, bool SP2 = false>
__device__ __forceinline__ void gemm_phase(PG8_LAS unsigned char* lds, const Gemm g, const Sched& S, const Epi& E) {
    const int tid = threadIdx.x, wid = __builtin_amdgcn_readfirstlane(tid >> 6), lane = tid & 63, wr = wid >> 2, wc = wid & 3, fr = lane & 15, fq = lane >> 4;
    const int K = g.K, nt = K / BK;
    unsigned voffA[2], voffB[2];
#pragma unroll
    for (int i = 0; i < 2; ++i) { int R, C; stage_rc(tid * 16 + i * 8192, R, C); const int Rb = Epi::PERM ? ((R & ~31) + perm32(R & 31)) : R;
        voffA[i] = (unsigned)(R * K + C) * 2u; voffB[i] = (unsigned)(Rb * K + C) * 2u; }
    const size_t kstep = (size_t)(BK * 2);
    const size_t hstep = (size_t)HALF * K * 2;
    const size_t tstep = 2 * hstep;
    const unsigned ldsw = (unsigned)wid * 1024u;
    const int aoff = lds_byte(wr * 64 + fr, fq * 8), boff = lds_byte(wc * 32 + fr, fq * 8);
#define PG8_SA(b, h) (((b) * 2 + (h)) * HTB)
#define PG8_SB(b, h) ((4 + (b) * 2 + (h)) * HTB)
#define PG8_STAGE(bufoff, gbase, voff) do { _Pragma("unroll") for (int _i = 0; _i < 2; ++_i) \
        __builtin_amdgcn_global_load_lds((const unsigned*)((const char*)(gbase) + (voff)[_i]), (PG8_LAS unsigned*)(lds + (bufoff) + ldsw + _i * 8192), 16, 0, 0); } while (0)
#define PG8_LDA(dst, b, h) do { _Pragma("unroll") for (int m = 0; m < 4; ++m) _Pragma("unroll") for (int k = 0; k < 2; ++k) dst[m][k] = *(const PG8_LAS bf16x8*)(lds + PG8_SA(b, h) + aoff + m * 2048 + k * 1024); } while (0)
#define PG8_LDB(dst, b, h) do { _Pragma("unroll") for (int n = 0; n < 2; ++n) _Pragma("unroll") for (int k = 0; k < 2; ++k) dst[n][k] = *(const PG8_LAS bf16x8*)(lds + PG8_SB(b, h) + boff + n * 2048 + k * 1024); } while (0)
#define PG8_MMA(ai, bj, At, Bt) do { __builtin_amdgcn_s_setprio(1); _Pragma("unroll") for (int m = 0; m < 4; ++m) _Pragma("unroll") for (int n = 0; n < 2; ++n) _Pragma("unroll") for (int k = 0; k < 2; ++k) \
        acc[ai][bj][m][n] = __builtin_amdgcn_mfma_f32_16x16x32_bf16(Bt[n][k], At[m][k], acc[ai][bj][m][n], 0, 0, 0); __builtin_amdgcn_s_setprio(0); } while (0)
#define PG8_WAIT_V(n) asm volatile("s_waitcnt vmcnt(" #n ")" ::: "memory")
#define PG8_WAIT_L(n) asm volatile("s_waitcnt lgkmcnt(" #n ")" ::: "memory")
#define PG8_BAR __builtin_amdgcn_s_barrier()
#define PG8_SCHED __builtin_amdgcn_sched_barrier(0)
    Unit cur, nxt; int ui = 0;
    if (!S.next(0, cur)) return;
    f32x4 acc[2][2][4][2];
#pragma unroll
    for (int a = 0; a < 2; ++a)
#pragma unroll
        for (int b = 0; b < 2; ++b)
#pragma unroll
            for (int m = 0; m < 4; ++m)
#pragma unroll
                for (int n = 0; n < 2; ++n) acc[a][b][m][n] = (f32x4){0.f, 0.f, 0.f, 0.f};
    bf16x8 At[4][2], B0[2][2], B1[2][2];
    const char* cA = (const char*)g.A + (size_t)cur.pm * tstep; const char* cB = (const char*)g.Bt + (size_t)cur.pn * tstep;
    S.a_ready(cur);
    if constexpr (SP2) {
        PG8_STAGE(PG8_SB(0, 0), cB, voffB); PG8_STAGE(PG8_SB(0, 1), cB + hstep, voffB); PG8_STAGE(PG8_SA(0, 0), cA, voffA); PG8_STAGE(PG8_SA(0, 1), cA + hstep, voffA);
        if (wr == 1) PG8_BAR;
        PG8_WAIT_V(2); PG8_BAR;
        PG8_STAGE(PG8_SB(1, 0), cB + kstep, voffB); PG8_STAGE(PG8_SA(1, 0), cA + kstep, voffA); PG8_STAGE(PG8_SB(1, 1), cB + hstep + kstep, voffB);
        PG8_WAIT_V(6); PG8_BAR;
    } else {
        PG8_STAGE(PG8_SB(0, 0), cB, voffB); PG8_STAGE(PG8_SA(0, 0), cA, voffA); PG8_STAGE(PG8_SB(0, 1), cB + hstep, voffB); PG8_STAGE(PG8_SA(0, 1), cA + hstep, voffA);
        if (wr == 1) PG8_BAR;
        PG8_WAIT_V(4); PG8_BAR;
        PG8_STAGE(PG8_SB(1, 0), cB + kstep, voffB); PG8_STAGE(PG8_SA(1, 0), cA + kstep, voffA); PG8_STAGE(PG8_SB(1, 1), cB + hstep + kstep, voffB);
        PG8_WAIT_V(6); PG8_BAR;
    }
    for (;;) {
        const bool has_next = S.next(ui + 1, nxt);
        const char* nA = has_next ? (const char*)g.A + (size_t)nxt.pm * tstep : cA; const char* nB = has_next ? (const char*)g.Bt + (size_t)nxt.pn * tstep : cB;
        for (int t = 0; t < nt; t += 2) {
            const bool last = (t == nt - 2);
            const char* a1 = cA + (size_t)(t + 1) * kstep;
            const char* a2 = last ? nA : cA + (size_t)(t + 2) * kstep; const char* b2 = last ? nB : cB + (size_t)(t + 2) * kstep;
            const char* a3 = a2 + kstep; const char* b3 = b2 + kstep;
            if (last && has_next) S.a_ready(nxt);
            if constexpr (SP2) {
            PG8_LDB(B0, 0, 0); PG8_LDB(B1, 0, 1); PG8_SCHED; PG8_LDA(At, 0, 0); PG8_STAGE(PG8_SA(1, 1), a1 + hstep, voffA);
            PG8_WAIT_V(8); PG8_WAIT_L(0); PG8_BAR; PG8_MMA(0, 0, At, B0); PG8_MMA(0, 1, At, B1); PG8_BAR; PG8_SCHED;
            PG8_LDA(At, 0, 1); PG8_STAGE(PG8_SB(0, 0), b2, voffB); PG8_STAGE(PG8_SB(0, 1), b2 + hstep, voffB); PG8_STAGE(PG8_SA(0, 0), a2, voffA);
            PG8_WAIT_V(8); PG8_WAIT_L(0); PG8_BAR; PG8_MMA(1, 0, At, B0); PG8_MMA(1, 1, At, B1); PG8_BAR; PG8_SCHED;
            PG8_LDB(B0, 1, 0); PG8_LDB(B1, 1, 1); PG8_SCHED; PG8_LDA(At, 1, 0); PG8_STAGE(PG8_SA(0, 1), a2 + hstep, voffA);
            PG8_WAIT_V(8); PG8_WAIT_L(0); PG8_BAR; PG8_MMA(0, 0, At, B0); PG8_MMA(0, 1, At, B1); PG8_BAR; PG8_SCHED;
            PG8_LDA(At, 1, 1); PG8_STAGE(PG8_SB(1, 0), b3, voffB); PG8_STAGE(PG8_SB(1, 1), b3 + hstep, voffB); PG8_STAGE(PG8_SA(1, 0), a3, voffA);
            PG8_WAIT_V(8); PG8_WAIT_L(0); PG8_BAR; PG8_MMA(1, 0, At, B0); PG8_MMA(1, 1, At, B1); PG8_BAR; PG8_SCHED;
            } else {
            PG8_LDB(B0, 0, 0); PG8_SCHED; PG8_LDA(At, 0, 0); PG8_STAGE(PG8_SA(1, 1), a1 + hstep, voffA);
            PG8_WAIT_L(8); PG8_BAR; PG8_WAIT_L(0); PG8_MMA(0, 0, At, B0); PG8_BAR; PG8_SCHED;
            PG8_LDB(B1, 0, 1); PG8_STAGE(PG8_SB(0, 0), b2, voffB);
            PG8_BAR; PG8_WAIT_L(0); PG8_MMA(0, 1, At, B1); PG8_BAR;
            PG8_LDA(At, 0, 1); PG8_STAGE(PG8_SA(0, 0), a2, voffA);
            PG8_BAR; PG8_WAIT_L(0); PG8_MMA(1, 0, At, B0); PG8_BAR; PG8_SCHED;
            PG8_STAGE(PG8_SB(0, 1), b2 + hstep, voffB);
            PG8_WAIT_V(6); PG8_BAR; PG8_MMA(1, 1, At, B1); PG8_BAR;
            PG8_LDB(B0, 1, 0); PG8_SCHED; PG8_LDA(At, 1, 0); PG8_STAGE(PG8_SA(0, 1), a2 + hstep, voffA);
            PG8_WAIT_L(8); PG8_BAR; PG8_WAIT_L(0); PG8_MMA(0, 0, At, B0); PG8_BAR; PG8_SCHED;
            PG8_LDB(B1, 1, 1); PG8_STAGE(PG8_SB(1, 0), b3, voffB);
            PG8_BAR; PG8_WAIT_L(0); PG8_MMA(0, 1, At, B1); PG8_BAR;
            PG8_LDA(At, 1, 1); PG8_STAGE(PG8_SA(1, 0), a3, voffA);
            PG8_BAR; PG8_WAIT_L(0); PG8_MMA(1, 0, At, B0); PG8_BAR; PG8_SCHED;
            PG8_STAGE(PG8_SB(1, 1), b3 + hstep, voffB);
            PG8_WAIT_V(6); PG8_BAR; PG8_MMA(1, 1, At, B1); PG8_BAR;
            }
        }
        if constexpr (ALIGN_EPI) { if (wr == 0) PG8_BAR; }
        if constexpr (!Epi::AFTER_DRAIN) { E(acc, cur, wr, wc, fr, fq); S.done(cur); }
        if (!has_next) break;
#pragma unroll
        for (int a = 0; a < 2; ++a)
#pragma unroll
            for (int b = 0; b < 2; ++b)
#pragma unroll
                for (int m = 0; m < 4; ++m)
#pragma unroll
                    for (int n = 0; n < 2; ++n) acc[a][b][m][n] = (f32x4){0.f, 0.f, 0.f, 0.f};
        cur = nxt; cA = nA; cB = nB; ++ui;
        if constexpr (ALIGN_EPI) { if (wr == 1) PG8_BAR; }
    }
    PG8_WAIT_V(0);
    if constexpr (!ALIGN_EPI) { if (wr == 0) PG8_BAR; }
    PG8_BAR;
    if constexpr (Epi::AFTER_DRAIN) { E.fused(acc, cur, wr, wc, fr, fq, lds, wid, lane); S.done(cur); }
#undef PG8_SA
#undef PG8_SB
#undef PG8_STAGE
#undef PG8_LDA
#undef PG8_LDB
#undef PG8_MMA
#undef PG8_WAIT_V
#undef PG8_WAIT_L
#undef PG8_BAR
#undef PG8_SCHED
}
}

namespace mk {
#define LAS __attribute__((address_space(3)))
#define GAS __attribute__((address_space(1)))
typedef unsigned v4u __attribute__((ext_vector_type(4)));
typedef unsigned v2u __attribute__((ext_vector_type(2)));
constexpr int NW = 8, NT = 512, LDS_BYTES = 163840, RING_BYTES = 131072;
#define LDS_WAIT() asm volatile("s_waitcnt lgkmcnt(0)" ::: "memory")
#define DPP_ROR_ADD(t, n) ((t) + __uint_as_float(__builtin_amdgcn_update_dpp(0u, __float_as_uint(t), 0x120 + (n), 0xf, 0xf, false)))
struct Args { const float* in[16]; float* out; unsigned char* ws; int ph_lo, ph_hi; };
__device__ __forceinline__ unsigned pk2(float lo, float hi) { return cvt_pk2(lo, hi); }

__device__ __forceinline__ void transpose_item(const float* W, int ld, int K, int ncols, bf16_t* WT, LAS float* scr, int item, int lane) {
    const int nblk = ncols / 32, kb = item / nblk, nb = item % nblk, k0 = 64 * kb, n0 = 32 * nb;
#pragma unroll 8
    for (int i = 0; i < 32; ++i) { const int kk = 2 * i + (lane >> 5); scr[kk * 33 + (lane & 31)] = W[(size_t)(k0 + kk) * ld + n0 + (lane & 31)]; }
    LDS_WAIT(); asm volatile("" ::: "memory");
    const int c = lane & 7;
#pragma unroll
    for (int j = 0; j < 4; ++j) { const int n = (lane >> 3) + 8 * j; const LAS float* s = scr + (8 * c) * 33 + n;
        v4u o; o.x = pk2(s[0 * 33], s[1 * 33]); o.y = pk2(s[2 * 33], s[3 * 33]); o.z = pk2(s[4 * 33], s[5 * 33]); o.w = pk2(s[6 * 33], s[7 * 33]);
        *(v4u*)(WT + (size_t)(n0 + n) * K + k0 + 8 * c) = o; }
    LDS_WAIT(); asm volatile("" ::: "memory");
}
template <bool WITH_BA>
__device__ __forceinline__ void norm_row(const float* xrow, const float* g, const LAS float* wt  , bf16_t* orow, float* barow, int lane) {
    f32x4 v[8]; float ss = 0.f;
#pragma unroll
    for (int j = 0; j < 8; ++j) { v[j] = ((const f32x4*)xrow)[64 * j + lane]; ss += (v[j].x * v[j].x + v[j].y * v[j].y) + (v[j].z * v[j].z + v[j].w * v[j].w); }
    ss = wave_sum(ss);
    const float rstd = rsqrtf(ss * (1.f / DM) + EPS);
    float acc[16];
#pragma unroll
    for (int c = 0; c < 16; ++c) acc[c] = 0.f;
#pragma unroll
    for (int j = 0; j < 8; ++j) {
        const f32x4 gg = ((const f32x4*)g)[64 * j + lane];
        const f32x4 y = v[j] * rstd * gg;
        v2u o; o.x = pk2(y.x, y.y); o.y = pk2(y.z, y.w);
        ((v2u*)orow)[64 * j + lane] = o;
        if (WITH_BA) {
#pragma unroll
            for (int c = 0; c < 16; ++c) { const f32x4 w4 = *(const LAS f32x4*)(wt + c * 2048 + 4 * (64 * j + lane));
                acc[c] += (y.x * w4.x + y.y * w4.y) + (y.z * w4.z + y.w * w4.w); }
            __builtin_amdgcn_sched_barrier(0);
        }
    }
    if (WITH_BA) {
        float q8[8], t4[4];
#pragma unroll
        for (int r = 0; r < 8; ++r) { auto sw = __builtin_amdgcn_permlane32_swap(__float_as_uint(acc[r]), __float_as_uint(acc[r + 8]), false, false); q8[r] = __uint_as_float(sw[0]) + __uint_as_float(sw[1]); }
#pragma unroll
        for (int r = 0; r < 4; ++r) { auto sw = __builtin_amdgcn_permlane16_swap(__float_as_uint(q8[r]), __float_as_uint(q8[r + 4]), false, false); t4[r] = __uint_as_float(sw[0]) + __uint_as_float(sw[1]); }
#pragma unroll
        for (int r = 0; r < 4; ++r) { float tv = t4[r]; tv = DPP_ROR_ADD(tv, 8); tv = DPP_ROR_ADD(tv, 4); tv = DPP_ROR_ADD(tv, 2); tv = DPP_ROR_ADD(tv, 1); t4[r] = tv; }
        if ((lane & 15) == 0) { const int gq = lane >> 4;
#pragma unroll
            for (int r = 0; r < 4; ++r) barow[r + 4 * gq] = t4[r]; }
    }
}
__device__ __forceinline__ void wqk_item(const float* Wq, const float* SK, bf16_t* Wqk, LAS float* lds, int item, int tid) {
    const int cbk = item >> 5, d0 = (item & 31) * 64, cb = cbk * 128, h = cbk >> 1, half = cbk & 1;
    LAS float* At = lds; LAS float* Bt = lds + 128 * 68;
    const float* skb = SK + ((size_t)(half * 8 + h) * 128) * 128;
#pragma unroll
    for (int i = 0; i < 4; ++i) { const int idx = tid + 512 * i, d = idx >> 5, k4 = idx & 31;
        const f32x4 w = *(const f32x4*)(Wq + (size_t)(d0 + d) * DM + cb + 4 * k4);
        At[(4 * k4 + 0) * 68 + d] = w.x; At[(4 * k4 + 1) * 68 + d] = w.y; At[(4 * k4 + 2) * 68 + d] = w.z; At[(4 * k4 + 3) * 68 + d] = w.w; }
#pragma unroll
    for (int i = 0; i < 8; ++i) { const int idx = tid + 512 * i, n = idx >> 5, k4 = idx & 31;
        const f32x4 w = *(const f32x4*)(skb + (size_t)n * 128 + 4 * k4);
        Bt[(4 * k4 + 0) * 132 + n] = w.x; Bt[(4 * k4 + 1) * 132 + n] = w.y; Bt[(4 * k4 + 2) * 132 + n] = w.z; Bt[(4 * k4 + 3) * 132 + n] = w.w; }
    __syncthreads();
    const int dy = tid >> 5, nx = tid & 31;
    float acc[4][4];
#pragma unroll
    for (int i = 0; i < 4; ++i)
#pragma unroll
        for (int j = 0; j < 4; ++j) acc[i][j] = 0.f;
#pragma unroll 4
    for (int kk = 0; kk < 128; ++kk) {
        const f32x4 a = *(const LAS f32x4*)(At + kk * 68 + 4 * dy), b = *(const LAS f32x4*)(Bt + kk * 132 + 4 * nx);
        acc[0][0] += a.x * b.x; acc[0][1] += a.x * b.y; acc[0][2] += a.x * b.z; acc[0][3] += a.x * b.w;
        acc[1][0] += a.y * b.x; acc[1][1] += a.y * b.y; acc[1][2] += a.y * b.z; acc[1][3] += a.y * b.w;
        acc[2][0] += a.z * b.x; acc[2][1] += a.z * b.y; acc[2][2] += a.z * b.z; acc[2][3] += a.z * b.w;
        acc[3][0] += a.w * b.x; acc[3][1] += a.w * b.y; acc[3][2] += a.w * b.z; acc[3][3] += a.w * b.w;
    }
#pragma unroll
    for (int j = 0; j < 4; ++j) { v2u o; o.x = pk2(acc[0][j], acc[1][j]); o.y = pk2(acc[2][j], acc[3][j]);
        *(v2u*)(Wqk + (size_t)(cb + 4 * nx + j) * DM + d0 + 4 * dy) = o; }
    __syncthreads();
}

typedef float f32x2 __attribute__((ext_vector_type(2)));
__device__ __forceinline__ int fp4_idx_of(float v) { return (v < 1.75f) ? (int)(v * 2.f + 0.25f) : (v < 2.5f ? 4 : (v < 3.5f ? 5 : (v < 5.f ? 6 : 7))); }
__device__ __forceinline__ void fp4_calibrate(int (&nib)[8]) {
    const unsigned T = 0x76543210u;
    const f32x2 a = __builtin_amdgcn_cvt_scalef32_pk_f32_fp4(T, 1.0f, 0), b = __builtin_amdgcn_cvt_scalef32_pk_f32_fp4(T, 1.0f, 1);
    const f32x2 c = __builtin_amdgcn_cvt_scalef32_pk_f32_fp4(T, 1.0f, 2), d = __builtin_amdgcn_cvt_scalef32_pk_f32_fp4(T, 1.0f, 3);
    nib[0] = fp4_idx_of(a.x); nib[1] = fp4_idx_of(a.y); nib[2] = fp4_idx_of(b.x); nib[3] = fp4_idx_of(b.y);
    nib[4] = fp4_idx_of(c.x); nib[5] = fp4_idx_of(c.y); nib[6] = fp4_idx_of(d.x); nib[7] = fp4_idx_of(d.y);
}
__device__ __forceinline__ void table_row_sw(const float* src, unsigned* dst, float* inv_scale, int lane) {
    int nib[8]; fp4_calibrate(nib);
    f32x4 v[8]; float mx = 0.f;
#pragma unroll
    for (int j = 0; j < 8; ++j) { v[j] = ((const f32x4*)src)[8 * lane + j];
        mx = fmaxf(mx, fmaxf(fmaxf(fabsf(v[j].x), fabsf(v[j].y)), fmaxf(fabsf(v[j].z), fabsf(v[j].w)))); }
#pragma unroll
    for (int o = 1; o < 64; o <<= 1) mx = fmaxf(mx, __shfl_xor(mx, o));
    const float sc = mx > 0.f ? mx * (0.85f / 6.f) : 1.f, isc = 1.f / sc;
    unsigned wd[4];
#pragma unroll
    for (int w = 0; w < 4; ++w) {
        unsigned acc = 0u;
#pragma unroll
        for (int e = 0; e < 8; ++e) {
            const f32x4 q = v[2 * w + (e >> 2)]; const float xe = ((e & 3) == 0) ? q.x : ((e & 3) == 1) ? q.y : ((e & 3) == 2) ? q.z : q.w;
            const float yv = fabsf(xe) * isc;
            unsigned code = (yv > 0.25f) + (yv > 0.75f) + (yv > 1.25f) + (yv > 1.75f) + (yv > 2.5f) + (yv > 3.5f) + (yv > 5.f);
            code |= (xe < 0.f) ? 8u : 0u;
            acc |= code << (4 * nib[e]);
        }
        wd[w] = acc;
    }
    v4u o; o.x = wd[0]; o.y = wd[1]; o.z = wd[2]; o.w = wd[3];
    ((v4u*)dst)[lane] = o;
    if (lane == 0) *inv_scale = sc;
}
__device__ __forceinline__ bool fp4_hw_encoder_ok() {
    unsigned t = 0u, u = 0u;
    t = __builtin_amdgcn_cvt_scalef32_pk_fp4_f32(t, 0.f, 0.5f, 1.0f, 0); t = __builtin_amdgcn_cvt_scalef32_pk_fp4_f32(t, 1.f, -1.5f, 1.0f, 1);
    t = __builtin_amdgcn_cvt_scalef32_pk_fp4_f32(t, 2.f, 3.f, 1.0f, 2); t = __builtin_amdgcn_cvt_scalef32_pk_fp4_f32(t, -4.f, 6.f, 1.0f, 3);
    u = __builtin_amdgcn_cvt_scalef32_pk_fp4_f32(u, 0.2f, 0.3f, 1.0f, 0); u = __builtin_amdgcn_cvt_scalef32_pk_fp4_f32(u, 2.4f, -2.6f, 1.0f, 1);
    u = __builtin_amdgcn_cvt_scalef32_pk_fp4_f32(u, 5.2f, -4.9f, 1.0f, 2); u = __builtin_amdgcn_cvt_scalef32_pk_fp4_f32(u, 1.3f, 0.8f, 1.0f, 3);
    const f32x2 a = __builtin_amdgcn_cvt_scalef32_pk_f32_fp4(t, 1.0f, 0), b = __builtin_amdgcn_cvt_scalef32_pk_f32_fp4(t, 1.0f, 1);
    const f32x2 c = __builtin_amdgcn_cvt_scalef32_pk_f32_fp4(t, 1.0f, 2), d = __builtin_amdgcn_cvt_scalef32_pk_f32_fp4(t, 1.0f, 3);
    const f32x2 e = __builtin_amdgcn_cvt_scalef32_pk_f32_fp4(u, 1.0f, 0), f = __builtin_amdgcn_cvt_scalef32_pk_f32_fp4(u, 1.0f, 1);
    const f32x2 g = __builtin_amdgcn_cvt_scalef32_pk_f32_fp4(u, 1.0f, 2), h = __builtin_amdgcn_cvt_scalef32_pk_f32_fp4(u, 1.0f, 3);
    return a.x == 0.f && a.y == 0.5f && b.x == 1.f && b.y == -1.5f && c.x == 2.f && c.y == 3.f && d.x == -4.f && d.y == 6.f
        && e.x == 0.f && e.y == 0.5f && f.x == 2.f && f.y == -3.f && g.x == 6.f && g.y == -4.f && h.x == 1.5f && h.y == 1.f;
}
__device__ __forceinline__ void table_row2(const float* src, unsigned* dst, float* inv_scale, int lane) {
    if (!fp4_hw_encoder_ok()) { table_row_sw(src, dst, inv_scale, lane); table_row_sw(src + DM, dst + 256, inv_scale + 1, lane); return; }
    f32x4 v[2][8]; float mx[2] = {0.f, 0.f};
#pragma unroll
    for (int r = 0; r < 2; ++r)
#pragma unroll
        for (int j = 0; j < 8; ++j) v[r][j] = ((const f32x4*)(src + (size_t)r * DM))[64 * j + lane];
#pragma unroll
    for (int r = 0; r < 2; ++r) {
#pragma unroll
        for (int j = 0; j < 8; ++j) mx[r] = fmaxf(mx[r], fmaxf(fmaxf(fabsf(v[r][j].x), fabsf(v[r][j].y)), fmaxf(fabsf(v[r][j].z), fabsf(v[r][j].w))));
#pragma unroll
        for (int o = 1; o < 64; o <<= 1) mx[r] = fmaxf(mx[r], __shfl_xor(mx[r], o));
        const float sc = mx[r] > 0.f ? mx[r] * (0.85f / 6.f) : 1.f, isc = 1.f / sc;
        unsigned short* drow = (unsigned short*)(dst + (size_t)r * 256);
#pragma unroll
        for (int j = 0; j < 8; ++j) { const f32x4 q4 = v[r][j];
            const float y0 = fminf(fmaxf(q4.x * isc, -6.f), 6.f), y1 = fminf(fmaxf(q4.y * isc, -6.f), 6.f), y2 = fminf(fmaxf(q4.z * isc, -6.f), 6.f), y3 = fminf(fmaxf(q4.w * isc, -6.f), 6.f);
            unsigned acc = __builtin_amdgcn_cvt_scalef32_pk_fp4_f32(0u, y0, y1, 1.0f, 0);
            acc = __builtin_amdgcn_cvt_scalef32_pk_fp4_f32(acc, y2, y3, 1.0f, 1);
            drow[64 * j + lane] = (unsigned short)(acc & 0xffffu); }
        if (lane == 0) inv_scale[r] = sc;
    }
}
#ifndef PEER_FAST_REDUCE
#define PEER_FAST_REDUCE 1
#endif
__device__ __forceinline__ float dpp_ror_add(float t, int) { return t; }
#define FP4_BYTE(d, j) __builtin_amdgcn_cvt_scalef32_pk_f32_fp4((d), 1.0f, (j))
__device__ __forceinline__ float dot_row(const v4u& a, const float (&xv)[32]) {
    f32x2 p2 = {0.f, 0.f};
#pragma unroll
    for (int w = 0; w < 4; ++w) { const unsigned d = (w == 0) ? a.x : (w == 1) ? a.y : (w == 2) ? a.z : a.w;
        const f32x2 f0 = FP4_BYTE(d, 0), f1 = FP4_BYTE(d, 1), f2 = FP4_BYTE(d, 2), f3 = FP4_BYTE(d, 3);
        p2 = __builtin_elementwise_fma(f0, (f32x2){xv[8 * w], xv[8 * w + 1]}, p2); p2 = __builtin_elementwise_fma(f1, (f32x2){xv[8 * w + 2], xv[8 * w + 3]}, p2);
        p2 = __builtin_elementwise_fma(f2, (f32x2){xv[8 * w + 4], xv[8 * w + 5]}, p2); p2 = __builtin_elementwise_fma(f3, (f32x2){xv[8 * w + 6], xv[8 * w + 7]}, p2); }
    return p2.x + p2.y;
}
__device__ __forceinline__ void axpy_row(const v4u& a, float wgt, float (&y)[32]) {
#pragma unroll
    for (int w = 0; w < 4; ++w) { const unsigned d = (w == 0) ? a.x : (w == 1) ? a.y : (w == 2) ? a.z : a.w;
        const f32x2 f0 = FP4_BYTE(d, 0), f1 = FP4_BYTE(d, 1), f2 = FP4_BYTE(d, 2), f3 = FP4_BYTE(d, 3);
        y[8 * w] += wgt * f0.x; y[8 * w + 1] += wgt * f0.y; y[8 * w + 2] += wgt * f1.x; y[8 * w + 3] += wgt * f1.y;
        y[8 * w + 4] += wgt * f2.x; y[8 * w + 5] += wgt * f2.y; y[8 * w + 6] += wgt * f3.x; y[8 * w + 7] += wgt * f3.y; }
}
#define DPP_ROR_MAX(t, n) fmaxf((t), __uint_as_float(__builtin_amdgcn_update_dpp(0u, __float_as_uint(t), 0x120 + (n), 0xf, 0xf, false)))
#define CSWAP(a, b) do { const float hi_ = fmaxf(a, b), lo_ = fminf(a, b); a = hi_; b = lo_; } while (0)
__device__ __forceinline__ void topk_token_fast(const float* __restrict__ srow, int lane, const float* inv_su, const float* inv_sv,
                                                LAS int* se, LAS float* sa, LAS float* sb) {
    const int l16 = lane & 15, row = lane >> 4;
    float R[4];
#pragma unroll
    for (int ps = 0; ps < 4; ++ps) {
        const f32x4 v0 = *(const f32x4*)(srow + (4 * ps + row) * 128 + 8 * l16), v1 = *(const f32x4*)(srow + (4 * ps + row) * 128 + 8 * l16 + 4);
        float k[8];
        k[0] = v0.x; k[1] = v0.y; k[2] = v0.z; k[3] = v0.w; k[4] = v1.x; k[5] = v1.y; k[6] = v1.z; k[7] = v1.w;
#pragma unroll
        for (int i = 0; i < 8; ++i) k[i] = __uint_as_float((__float_as_uint(k[i]) & 0xFFFFFF80u) | (unsigned)(8 * l16 + i));
        CSWAP(k[0], k[1]); CSWAP(k[2], k[3]); CSWAP(k[4], k[5]); CSWAP(k[6], k[7]);
        CSWAP(k[0], k[2]); CSWAP(k[1], k[3]); CSWAP(k[4], k[6]); CSWAP(k[5], k[7]);
        CSWAP(k[1], k[2]); CSWAP(k[5], k[6]);
        CSWAP(k[0], k[4]); CSWAP(k[1], k[5]); CSWAP(k[2], k[6]); CSWAP(k[3], k[7]);
        CSWAP(k[2], k[4]); CSWAP(k[3], k[5]);
        CSWAP(k[1], k[2]); CSWAP(k[3], k[4]); CSWAP(k[5], k[6]);
        float res = 0.f;
#pragma unroll
        for (int it = 0; it < 16; ++it) {
            float m = k[0];
            m = DPP_ROR_MAX(m, 8); m = DPP_ROR_MAX(m, 4); m = DPP_ROR_MAX(m, 2); m = DPP_ROR_MAX(m, 1);
            const bool own = (k[0] == m);
#pragma unroll
            for (int i = 0; i < 7; ++i) k[i] = own ? k[i + 1] : k[i];
            k[7] = own ? -INFINITY : k[7];
            res = (l16 == it) ? m : res;
        }
        R[ps] = res;
    }
#pragma unroll
    for (int g = 0; g < 2; ++g) {
        const auto sw = __builtin_amdgcn_permlane16_swap(__float_as_uint(R[2 * g]), __float_as_uint(R[2 * g + 1]), false, false);
        const float X = __uint_as_float(sw[0]), Y = __uint_as_float(sw[1]);
        const float a = __uint_as_float(__float_as_uint(X) & 0xFFFFFF80u);
        int j = 0;
        float v2 = __shfl(Y, (lane & 48));
        float best = 0.f;
#pragma unroll
        for (int it = 0; it < 16; ++it) {
            const float sum = a + __uint_as_float(__float_as_uint(v2) & 0xFFFFFF80u);
            const float cand = (j < 16) ? __uint_as_float((__float_as_uint(sum) & 0xFFFFFF00u) | (unsigned)((l16 << 4) | (j & 15))) : -INFINITY;
            float m = cand;
            m = DPP_ROR_MAX(m, 8); m = DPP_ROR_MAX(m, 4); m = DPP_ROR_MAX(m, 2); m = DPP_ROR_MAX(m, 1);
            best = (l16 == it) ? m : best;
            if (it < 15) { j += (cand == m) ? 1 : 0; v2 = __shfl(Y, (lane & 48) + (j & 15)); }
        }
        const unsigned bb = __float_as_uint(best);
        const int bi = (bb >> 4) & 15, bj = bb & 15;
        const unsigned k1 = __float_as_uint(__shfl(X, (lane & 48) + bi)), k2 = __float_as_uint(__shfl(Y, (lane & 48) + bj));
        const int e = (int)(k1 & 127u) * 128 + (int)(k2 & 127u);
        const float bv = __uint_as_float(bb & 0xFFFFFF00u);
        float mx = bv; mx = DPP_ROR_MAX(mx, 8); mx = DPP_ROR_MAX(mx, 4); mx = DPP_ROR_MAX(mx, 2); mx = DPP_ROR_MAX(mx, 1);
        const float ex = __expf(bv - mx);
        float sm = ex; sm = DPP_ROR_ADD(sm, 8); sm = DPP_ROR_ADD(sm, 4); sm = DPP_ROR_ADD(sm, 2); sm = DPP_ROR_ADD(sm, 1);
        const float gate = ex / sm;
        const int head = 4 * g + ((row & 1) * 2 + (row >> 1));
        se[head * 16 + l16] = e; sa[head * 16 + l16] = inv_su[e]; sb[head * 16 + l16] = gate * inv_sv[e];
    }
}
#define PEER_LOAD(DST, TAB, b) do { _Pragma("unroll") for (int r_ = 0; r_ < 4; ++r_) { const unsigned char* rp_ = (TAB) + (size_t)(unsigned)__builtin_amdgcn_readfirstlane(se[4 * (b) + r_]) * 1024 + 16 * lane; \
        DST[r_] = *(const v4u*)rp_; } } while (0)
__device__ __forceinline__ void peer_token(int t, const float* scores, const bf16_t* hn, const float* hbuf, const unsigned char* U8, const unsigned char* V8,
                                           const float* inv_su, const float* inv_sv, const float* gfin, float* out,
                                           LAS int* se, LAS float* sa, LAS float* sb, int lane_in) {
    int lane = lane_in;
    {
        LAS int* se0 = se + 512; LAS float* sa0 = sa + 512; LAS float* sb0 = sb + 512;
        topk_token_fast(scores + (size_t)t * DM, lane, inv_su, inv_sv, se0, sa0, sb0);
        unsigned a0 = ((unsigned)se0[lane] << 7) | (unsigned)lane, a1 = ((unsigned)se0[lane + 64] << 7) | (unsigned)(lane + 64);
#pragma unroll
        for (int k = 2; k <= 128; k <<= 1) {
#pragma unroll
            for (int j = k >> 1; j > 0; j >>= 1) {
                if (j == 64) { const unsigned lo = a0 < a1 ? a0 : a1, hi = a0 < a1 ? a1 : a0; a0 = lo; a1 = hi; }
                else {
                    const unsigned p0 = (unsigned)__shfl_xor((int)a0, j), p1 = (unsigned)__shfl_xor((int)a1, j);
                    const bool lower = (lane & j) == 0;
                    const bool up0 = (lane & k) == 0, up1 = ((lane + 64) & k) == 0;
                    const unsigned mn0 = a0 < p0 ? a0 : p0, mx0 = a0 < p0 ? p0 : a0, mn1 = a1 < p1 ? a1 : p1, mx1 = a1 < p1 ? p1 : a1;
                    a0 = (up0 == lower) ? mn0 : mx0; a1 = (up1 == lower) ? mn1 : mx1;
                }
            }
        }
        const int k0 = a0 & 127, k1 = a1 & 127;
        se[lane] = (int)(a0 >> 7); sa[lane] = sa0[k0]; sb[lane] = sb0[k0];
        se[lane + 64] = (int)(a1 >> 7); sa[lane + 64] = sa0[k1]; sb[lane + 64] = sb0[k1];
    }
    asm volatile("" : "+v"(lane));
    float xv[32], y[32];
#pragma unroll
    for (int j = 0; j < 4; ++j) {
        const v4u h0 = *(const v4u*)(hn + (size_t)t * DM + 32 * lane + 8 * j);
#pragma unroll
        for (int w = 0; w < 4; ++w) { const unsigned d0 = (w == 0) ? h0.x : (w == 1) ? h0.y : (w == 2) ? h0.z : h0.w;
            xv[8 * j + 2 * w] = __uint_as_float(d0 << 16); xv[8 * j + 2 * w + 1] = __uint_as_float(d0 & 0xffff0000u); }
    }
#pragma unroll
    for (int i = 0; i < 32; ++i) y[i] = 0.f;
    v4u Ua[4], Ub[4], Va[4];
#define PEER_BATCH(b, UC, VC) do { \
        PEER_LOAD(VC, V8, (b)); \
        float pr[4]; \
        _Pragma("unroll") for (int r = 0; r < 4; ++r) pr[r] = dot_row(UC[r], xv); \
        if ((b) + 2 < 32) PEER_LOAD(UC, U8, (b) + 2); \
        float wr_[4], q2[2]; \
        _Pragma("unroll") for (int r = 0; r < 2; ++r) { auto sw = __builtin_amdgcn_permlane32_swap(__float_as_uint(pr[r]), __float_as_uint(pr[r + 2]), false, false); q2[r] = __uint_as_float(sw[0]) + __uint_as_float(sw[1]); } \
        float tv; \
        { auto sw = __builtin_amdgcn_permlane16_swap(__float_as_uint(q2[0]), __float_as_uint(q2[1]), false, false); tv = __uint_as_float(sw[0]) + __uint_as_float(sw[1]); } \
        tv = DPP_ROR_ADD(tv, 8); tv = DPP_ROR_ADD(tv, 4); tv = DPP_ROR_ADD(tv, 2); tv = DPP_ROR_ADD(tv, 1); \
        const int k = 4 * (b) + (lane >> 4);     \
        const float wc = gelu_erf(tv * sa[k]) * sb[k]; \
        _Pragma("unroll") for (int r = 0; r < 4; ++r) wr_[r] = __uint_as_float(__builtin_amdgcn_readlane(__float_as_uint(wc), 16 * r)); \
        _Pragma("unroll") for (int r = 0; r < 4; ++r) axpy_row(VC[r], wr_[r], y); } while (0)
    PEER_LOAD(Ua, U8, 0); PEER_LOAD(Ub, U8, 1);
#pragma unroll 1
    for (int b = 0; b < 32; b += 2) { PEER_BATCH(b, Ua, Va); PEER_BATCH(b + 1, Ub, Va); }
    float ss = 0.f;
#pragma unroll
    for (int j = 0; j < 8; ++j) { const f32x4 hv = *(const f32x4*)(hbuf + (size_t)t * DM + 32 * lane + 4 * j);
        y[4 * j] += hv.x; y[4 * j + 1] += hv.y; y[4 * j + 2] += hv.z; y[4 * j + 3] += hv.w;
        ss += (y[4 * j] * y[4 * j] + y[4 * j + 1] * y[4 * j + 1]) + (y[4 * j + 2] * y[4 * j + 2] + y[4 * j + 3] * y[4 * j + 3]); }
    ss = wave_sum(ss);
    const float rstd = rsqrtf(ss * (1.f / DM) + EPS);
#pragma unroll
    for (int j = 0; j < 8; ++j) { const f32x4 gg = *(const f32x4*)(gfin + 32 * lane + 4 * j);
        f32x4 o; o.x = y[4 * j] * rstd * gg.x; o.y = y[4 * j + 1] * rstd * gg.y; o.z = y[4 * j + 2] * rstd * gg.z; o.w = y[4 * j + 3] * rstd * gg.w;
        *(f32x4*)(out + (size_t)t * DM + 32 * lane + 4 * j) = o; }
}
typedef short bf16x8 __attribute__((ext_vector_type(8)));
__device__ __forceinline__ int pos32(int x) { const int g = x & ~31, l = x & 31; return g + 8 * ((l & 15) >> 2) + 4 * (l >> 4) + (l & 3); }
constexpr size_t PB_H_QG = 0, PB_H_KDT = 32 * MiB, PB_H_A = 64 * MiB;
constexpr size_t PB_G_QS = 80 * MiB, PB_G_KT = 96 * MiB;
constexpr size_t PB_G_W = 112 * MiB, PB_G_A = 144 * MiB, PB_G_U = 160 * MiB;
constexpr int CA = 96;
constexpr int PROG_WORD = 3584;
constexpr int NSB = 128, CPW = 4;
constexpr int SC_QG = 0, SC_WV = 16384, SC_KDT = 32768, SC_A = 49152, SC_BUF = 57344, SC_VEC = 2 * SC_BUF, SC_OT = SC_VEC + 2048, SC_OTB = 17408, SC_GAIN = SC_OT + 2 * SC_OTB;

__device__ __forceinline__ bf16x8 pack_frag(const f32x4& x0, const f32x4& x1) {
    v4u w; w.x = pk2(x0.x, x0.y); w.y = pk2(x0.z, x0.w); w.z = pk2(x1.x, x1.y); w.w = pk2(x1.z, x1.w);
    return __builtin_bit_cast(bf16x8, w);
}
#define MFMA16(a, b, c) __builtin_amdgcn_mfma_f32_16x16x32_bf16((a), (b), (c), 0, 0, 0)

__device__ __forceinline__ void hgrn_prep_item(int item, const bf16_t* proj, const float* lb_logits, unsigned char* pb, float* vecs, LAS unsigned char* lds, int tid) {
    const int c = item & 127, sq = item >> 7, b = sq >> 3, h = sq & 7, t0 = b * SEQ + c * 64;
    const int d = tid & 127, seg = tid >> 7, lane = tid & 63, wave = tid >> 6;
    LAS bf16_t* QGl = (LAS bf16_t*)lds; LAS bf16_t* KGl = (LAS bf16_t*)(lds + 17408); LAS float* segsum = (LAS float*)(lds + 34816);
    bf16_t* gQG = (bf16_t*)(pb + PB_H_QG) + (size_t)item * 8192;
    bf16_t* gKDT = (bf16_t*)(pb + PB_H_KDT) + (size_t)item * 8192;
    bf16_t* gA = (bf16_t*)(pb + PB_H_A) + (size_t)item * 4096;
    float* gvec = vecs + (size_t)item * 256;
    const float l0 = lb_logits[h * 128 + d], l1 = lb_logits[1024 + h * 128 + d];
    const float lb = 1.f / (1.f + __expf(l1 - l0));
    float lf[16], qv[16], kv[16];
#pragma unroll
    for (int i = 0; i < 16; ++i) {
        const bf16_t* pr = proj + (size_t)(t0 + 16 * seg + i) * NPROJ + h * 128 + d;
        const float z = bf2f(pr[C_AF]); qv[i] = bf2f(pr[C_AQ]);
        const float f = lb + (1.f - lb) * sigmoidf_(z);
        lf[i] = __logf(f); kv[i] = 1.f - f;
    }
    float run = 0.f;
#pragma unroll
    for (int i = 0; i < 16; ++i) { run += lf[i]; lf[i] = run; }
    segsum[seg * 128 + d] = run;
    __syncthreads();
    float off = 0.f, bl = 0.f;
#pragma unroll
    for (int s = 0; s < 4; ++s) { const float v = segsum[s * 128 + d]; bl += v; if (s < seg) off += v; }
    const int pd = pos32(d);
    float kd[16];
#pragma unroll
    for (int i = 0; i < 16; ++i) {
        const float bc = lf[i] + off; const int tl = 16 * seg + i;
        const float qg = qv[i] * __expf(bc), kg = kv[i] * __expf(-bc);
        kd[i] = kv[i] * __expf(bl - bc);
        const bf16_t qb = f2bf(qg);
        QGl[tl * 136 + d] = qb; KGl[tl * 136 + d] = f2bf(kg);
        gQG[tl * 128 + pd] = qb;
    }
#pragma unroll
    for (int ii = 0; ii < 4; ++ii) { v2u o; o.x = pk2(kd[4 * ii], kd[4 * ii + 1]); o.y = pk2(kd[4 * ii + 2], kd[4 * ii + 3]);
        *(v2u*)(gKDT + d * 64 + 32 * (seg >> 1) + 8 * ii + 4 * (seg & 1)) = o; }
    if (seg == 0) gvec[128 + d] = __expf(bl);
    __syncthreads();
    const int n = lane & 15, q = lane >> 4;
#pragma unroll
    for (int ti = 0; ti < 2; ++ti) {
        const int id = wave + 8 * ti, mt = id >> 2, ns = id & 3;
        f32x4 acc = {0.f, 0.f, 0.f, 0.f};
        if (ns <= mt) {
#pragma unroll
            for (int s4 = 0; s4 < 4; ++s4) {
                const bf16x8 a = *(const LAS bf16x8*)(QGl + (16 * mt + n) * 136 + 32 * s4 + 8 * q);
                const bf16x8 bb = *(const LAS bf16x8*)(KGl + (16 * ns + n) * 136 + 32 * s4 + 8 * q);
                acc = MFMA16(a, bb, acc);
            }
        }
        const int s = 16 * ns + n, ps = pos32(s);
#pragma unroll
        for (int r = 0; r < 4; ++r) { const int t = 16 * mt + 4 * q + r; const float v = (r == 0) ? acc.x : (r == 1) ? acc.y : (r == 2) ? acc.z : acc.w;
            gA[t * 64 + ps] = f2bf((s <= t) ? v : 0.f); }
    }
    __syncthreads();
}

constexpr int GP_QF = 0, GP_KF = 33024, GP_N = 0, GP_QB = 66048, GP_KB = 83456, GP_VB = 100864, GP_PART = 135680, GP_SB = 137728;
__device__ __forceinline__ void gdn_prep_item(int item, const bf16_t* proj, const float* ba, const float* conv_w, const float* A_log, const float* dt_bias,
                                              unsigned char* pb, float* vecs, LAS unsigned char* lds, int tid) {
    const int c = item & 127, bq = item >> 7, b = bq >> 2, qh = bq & 3, t0 = b * SEQ + c * 64;
    const int lane = tid & 63, wave = tid >> 6;
    LAS float* QF = (LAS float*)(lds + GP_QF); LAS float* KF = (LAS float*)(lds + GP_KF);
    LAS bf16_t* QB = (LAS bf16_t*)(lds + GP_QB); LAS bf16_t* KB = (LAS bf16_t*)(lds + GP_KB); LAS bf16_t* VB = (LAS bf16_t*)(lds + GP_VB);
    LAS float* PART = (LAS float*)(lds + GP_PART); LAS float* SBETA = (LAS float*)(lds + GP_SB); LAS float* SGC = SBETA + 128;
    LAS float* NM = (LAS float*)(lds + GP_N);
    {
        int col, wch; const int dd = tid & 127;
        if (tid < 128) { col = C_BQ + qh * 128 + dd; wch = qh * 128 + dd; }
        else if (tid < 256) { col = C_BK + qh * 128 + dd; wch = 512 + qh * 128 + dd; }
        else { const int vh = 2 * qh + ((tid - 256) >> 7); col = C_BV + vh * 128 + dd; wch = 1024 + vh * 128 + dd; }
        const float w0 = conv_w[wch], w1 = conv_w[2048 + wch], w2 = conv_w[4096 + wch], w3 = conv_w[6144 + wch];
        float h0 = 0.f, h1 = 0.f, h2 = 0.f;
        const bf16_t* pr = proj + (size_t)t0 * NPROJ + col;
        if (c > 0) { h0 = bf2f(pr[-3 * NPROJ]); h1 = bf2f(pr[-2 * NPROJ]); h2 = bf2f(pr[-1 * NPROJ]); }
        unsigned xr[64];
#pragma unroll
        for (int t = 0; t < 64; ++t) xr[t] = pr[(size_t)t * NPROJ];
#pragma unroll
        for (int t = 0; t < 64; ++t) {
            const float xx = __uint_as_float(xr[t] << 16);
            const float yv = siluf_(w0 * h0 + w1 * h1 + w2 * h2 + w3 * xx);
            h0 = h1; h1 = h2; h2 = xx;
            if (tid < 128) QF[t * 129 + dd] = yv;
            else if (tid < 256) KF[t * 129 + dd] = yv;
            else VB[((tid - 256) >> 7) * 8704 + t * 136 + dd] = f2bf(yv);
        }
    }
    __syncthreads();
    {
        const int t = tid & 63, part = tid >> 6, which = part >> 2, sub = part & 3;
        const LAS float* src = (which ? KF : QF) + t * 129 + 32 * sub;
        float s = 0.f;
#pragma unroll
        for (int i = 0; i < 32; ++i) s += src[i] * src[i];
        PART[(which * 4 + sub) * 64 + t] = s;
    }
    if (wave < 2) {
        const int vh = 2 * qh + wave;
        const float ax = ba[(size_t)(t0 + lane) * 16 + 8 + vh] + dt_bias[vh];
        const float sp = ax > 20.f ? ax : log1pf(__expf(ax));
        float gc = -__expf(A_log[vh]) * sp;
#pragma unroll
        for (int o = 1; o < 64; o <<= 1) { const float up = __shfl_up(gc, o); if (lane >= o) gc += up; }
        const float gl = __shfl(gc, 63);
        const float beta = sigmoidf_(ba[(size_t)(t0 + lane) * 16 + vh]);
        SBETA[wave * 64 + lane] = beta; SGC[wave * 64 + lane] = gc;
        float* gvec = vecs + ((size_t)(16 + b * 8 + vh) * 128 + c) * 256;
        gvec[lane] = __expf(gc); gvec[64 + lane] = __expf(gl - gc);
        const float dl = __expf(gl); gvec[128 + lane] = dl; gvec[192 + lane] = dl;
    }
    __syncthreads();
    {
        const int d = tid & 127, seg = tid >> 7, pd = pos32(d);
        bf16_t* gQS = (bf16_t*)(pb + PB_G_QS) + (size_t)item * 8192;
        bf16_t* gKT = (bf16_t*)(pb + PB_G_KT) + (size_t)item * 8192;
        float kk[16];
#pragma unroll
        for (int i = 0; i < 16; ++i) {
            const int tl = 16 * seg + i;
            const float sq = PART[0 * 64 + tl] + PART[1 * 64 + tl] + PART[2 * 64 + tl] + PART[3 * 64 + tl];
            const float sk = PART[4 * 64 + tl] + PART[5 * 64 + tl] + PART[6 * 64 + tl] + PART[7 * 64 + tl];
            const bf16_t qb = f2bf(QF[tl * 129 + d] * rsqrtf(sq + EPS) * 0.08838834764831845f);
            const bf16_t kb = f2bf(KF[tl * 129 + d] * rsqrtf(sk + EPS));
            QB[tl * 136 + d] = qb; KB[tl * 136 + d] = kb; gQS[tl * 128 + pd] = qb; kk[i] = bf2f(kb);
        }
#pragma unroll
        for (int ii = 0; ii < 4; ++ii) { v2u o; o.x = pk2(kk[4 * ii], kk[4 * ii + 1]); o.y = pk2(kk[4 * ii + 2], kk[4 * ii + 3]);
            *(v2u*)(gKT + d * 64 + 32 * (seg >> 1) + 8 * ii + 4 * (seg & 1)) = o; }
    }
    __syncthreads();
    {
        const int n = lane & 15, q = lane >> 4;
#pragma unroll
        for (int ti = 0; ti < 2; ++ti) {
            const int id = 2 * wave + ti, mt = id >> 2, ns = id & 3;
            f32x4 akk = {0.f, 0.f, 0.f, 0.f}, aqk = {0.f, 0.f, 0.f, 0.f};
            if (ns <= mt) {
#pragma unroll
                for (int s4 = 0; s4 < 4; ++s4) {
                    const bf16x8 kb_ = *(const LAS bf16x8*)(KB + (16 * ns + n) * 136 + 32 * s4 + 8 * q);
                    const bf16x8 ka_ = *(const LAS bf16x8*)(KB + (16 * mt + n) * 136 + 32 * s4 + 8 * q);
                    const bf16x8 qa_ = *(const LAS bf16x8*)(QB + (16 * mt + n) * 136 + 32 * s4 + 8 * q);
                    akk = MFMA16(ka_, kb_, akk); aqk = MFMA16(qa_, kb_, aqk);
                }
            }
            const int s = 16 * ns + n, ps = pos32(s);
#pragma unroll
            for (int vl = 0; vl < 2; ++vl) {
                bf16_t* gA = (bf16_t*)(pb + PB_G_A) + ((size_t)((b * 8 + 2 * qh + vl) * 128 + c)) * 4096;
                const float gcs = SGC[vl * 64 + s];
#pragma unroll
                for (int r = 0; r < 4; ++r) {
                    const int t = 16 * mt + 4 * q + r;
                    const float vk = (r == 0) ? akk.x : (r == 1) ? akk.y : (r == 2) ? akk.z : akk.w;
                    const float vq = (r == 0) ? aqk.x : (r == 1) ? aqk.y : (r == 2) ? aqk.z : aqk.w;
                    const float ex = (s <= t) ? __expf(SGC[vl * 64 + t] - gcs) : 0.f;
                    NM[vl * 4096 + t * 64 + s] = (s < t) ? SBETA[vl * 64 + t] * vk * ex : 0.f;
                    gA[t * 64 + ps] = f2bf((s <= t) ? vq * ex : 0.f);
                }
            }
        }
    }
    __syncthreads();
    {
        const int vl = tid >> 8, colx = tid & 255;
        float x[64];
        if (colx < 128) {
#pragma unroll
            for (int t = 0; t < 64; ++t) x[t] = SBETA[vl * 64 + t] * bf2f(VB[vl * 8704 + t * 136 + colx]);
        } else {
#pragma unroll
            for (int t = 0; t < 64; ++t) x[t] = SBETA[vl * 64 + t] * __expf(SGC[vl * 64 + t]) * bf2f(KB[t * 136 + colx - 128]);
        }
        __syncthreads();
        const LAS float* Nv = NM + vl * 4096;
#pragma unroll
        for (int t = 1; t < 64; ++t) {
            float acc = x[t];
#pragma unroll
            for (int s4 = 0; s4 < (t + 3) / 4; ++s4) {
                const f32x4 nn = *(const LAS f32x4*)(Nv + t * 64 + 4 * s4);
                acc -= nn.x * x[4 * s4]; if (4 * s4 + 1 < t) acc -= nn.y * x[4 * s4 + 1]; if (4 * s4 + 2 < t) acc -= nn.z * x[4 * s4 + 2]; if (4 * s4 + 3 < t) acc -= nn.w * x[4 * s4 + 3];
            }
            x[t] = acc;
        }
        if (colx < 128) {
            bf16_t* gU = (bf16_t*)(pb + PB_G_U) + ((size_t)((b * 8 + 2 * qh + vl) * 128 + c)) * 8192;
            const int sl = colx >> 4, n = colx & 15;
#pragma unroll
            for (int mt = 0; mt < 4; ++mt)
#pragma unroll
                for (int q = 0; q < 4; ++q) { v2u o; o.x = pk2(x[16 * mt + 4 * q], x[16 * mt + 4 * q + 1]); o.y = pk2(x[16 * mt + 4 * q + 2], x[16 * mt + 4 * q + 3]);
                    *(v2u*)(gU + ((size_t)((sl * 4 + mt) * 64 + q * 16 + n)) * 4) = o; }
        } else {
            LAS bf16_t* WS = (LAS bf16_t*)(lds + GP_QB) + vl * 8704;
            const int pd = pos32(colx - 128);
#pragma unroll
            for (int t = 0; t < 64; ++t) WS[t * 136 + pd] = f2bf(-x[t]);
        }
    }
    __syncthreads();
    {
#pragma unroll
        for (int i = 0; i < 4; ++i) { const int p = tid + 512 * i, vl = p >> 10, row = (p >> 4) & 63, c16 = p & 15;
            bf16_t* gW = (bf16_t*)(pb + PB_G_W) + ((size_t)((b * 8 + 2 * qh + vl) * 128 + c)) * 8192;
            *(v4u*)(gW + row * 128 + c16 * 8) = *(const LAS v4u*)(lds + GP_QB + vl * 17408 + row * 272 + c16 * 16); }
    }
    __syncthreads();
}

struct ScanSrc { const unsigned char* qg; const unsigned char* wv; const unsigned char* kdt; const unsigned char* a; const float* vec; size_t wv_row; };
__device__ __forceinline__ void scan_dma(const ScanSrc& S, LAS unsigned char* buf, LAS unsigned char* vecb, int w, int lane) {
#pragma unroll
    for (int i = 0; i < 2; ++i) { const int pi = 2 * w + i, row = 4 * pi + (lane >> 4), cl = (lane & 15) ^ (row & 15);
        __builtin_amdgcn_global_load_lds((const unsigned*)(S.qg + row * 256 + cl * 16), (LAS unsigned*)(buf + SC_QG + pi * 1024), 16, 0, 0);
        __builtin_amdgcn_global_load_lds((const unsigned*)(S.wv + (size_t)row * S.wv_row + cl * 16), (LAS unsigned*)(buf + SC_WV + pi * 1024), 16, 0, 0); }
#pragma unroll
    for (int i = 0; i < 2; ++i) { const int pi = 2 * w + i, row = 8 * pi + (lane >> 3), cl = (lane & 7) ^ ((row >> 1) & 7);
        __builtin_amdgcn_global_load_lds((const unsigned*)(S.kdt + row * 128 + cl * 16), (LAS unsigned*)(buf + SC_KDT + pi * 1024), 16, 0, 0); }
    { const int pi = w, row = 8 * pi + (lane >> 3), cl = (lane & 7) ^ ((row >> 1) & 7);
        __builtin_amdgcn_global_load_lds((const unsigned*)(S.a + row * 128 + cl * 16), (LAS unsigned*)(buf + SC_A + pi * 1024), 16, 0, 0); }
    if (w == 0) __builtin_amdgcn_global_load_lds((const unsigned*)((const unsigned char*)S.vec + lane * 16), (LAS unsigned*)vecb, 16, 0, 0);
}
template <bool GDN>
__device__ __forceinline__ void scan_block(int sq, int g, const bf16_t* proj, const unsigned char* pb, const float* vecs, const float* hgrn_g, const float* gdn_g,
                                           bf16_t* mix, unsigned* prog, int nfb, LAS unsigned char* lds, int tid) {
    constexpr bool gdn = GDN;
    const int b = (sq & 15) >> 3, hh = sq & 7, lane = tid & 63, sl = __builtin_amdgcn_readfirstlane(tid >> 6), n = lane & 15, q = lane >> 4;
    const unsigned char* bQG; const unsigned char* bWV; const unsigned char* bKDT; const unsigned char* bA; const unsigned char* bU = nullptr;
    size_t wv_row, wv_chunk; int gate_col, mix_col; const float* gain;
    if (!gdn) {
        const size_t s0 = (size_t)(b * 8 + hh) * 128;
        bQG = pb + PB_H_QG + s0 * 16384; bKDT = pb + PB_H_KDT + s0 * 16384; bA = pb + PB_H_A + s0 * 8192;
        bWV = (const unsigned char*)(proj + (size_t)(b * SEQ) * NPROJ + C_AI + hh * 128); wv_row = (size_t)NPROJ * 2; wv_chunk = (size_t)64 * NPROJ * 2;
        gate_col = C_AG + hh * 128; mix_col = hh * 128; gain = hgrn_g;
    } else {
        const size_t s0 = (size_t)(b * 8 + hh) * 128, q0 = (size_t)(b * 4 + (hh >> 1)) * 128;
        bQG = pb + PB_G_QS + q0 * 16384; bKDT = pb + PB_G_KT + q0 * 16384; bA = pb + PB_G_A + s0 * 8192;
        bWV = pb + PB_G_W + s0 * 16384; wv_row = 256; wv_chunk = 16384; bU = pb + PB_G_U + s0 * 16384;
        gate_col = C_BZ + hh * 128; mix_col = 1024 + hh * 128; gain = gdn_g;
    }
    const float* bvec = vecs + (size_t)sq * 128 * 256;
    LAS float* gainl = (LAS float*)(lds + SC_GAIN);
    const int wave = sl;
    {
        ScanSrc src{bQG, bWV, bKDT, bA, bvec, wv_row};
        scan_dma(src, lds, lds + SC_VEC, wave, lane);
        if (tid < 128) gainl[tid] = gain[tid];
    }
    __builtin_amdgcn_s_waitcnt(0x0070);
    asm volatile("" ::: "memory");
    __builtin_amdgcn_s_barrier();
    asm volatile("" ::: "memory");
#define SCAN_BAR() do { asm volatile("s_waitcnt lgkmcnt(0)" ::: "memory"); __builtin_amdgcn_s_barrier(); asm volatile("" ::: "memory"); } while (0)
#define SCHED_FENCE() __builtin_amdgcn_sched_barrier(0)
    const int sl16 = 2 * g + wave;
    const int hw = (wave == 2) ? 0 : (wave == 3) ? 1 : (wave == 6) ? 2 : (wave == 7) ? 3 : -1;
    if (wave < 2) {
        f32x4 S[8];
        bf16x8 Sf[4];
#pragma unroll
        for (int m = 0; m < 8; ++m) S[m] = (f32x4){0.f, 0.f, 0.f, 0.f};
#pragma unroll
        for (int s4 = 0; s4 < 4; ++s4) Sf[s4] = pack_frag(S[0], S[1]);
        v2u Ureg[4];
#pragma unroll
        for (int mt = 0; mt < 4; ++mt) Ureg[mt] = GDN ? *(const v2u*)(bU + (size_t)(sl16 * 4 + mt) * 512 + lane * 8) : (v2u){0u, 0u};
        for (int c = 0; c < 128; ++c) {
            int lane = tid & 63; asm volatile("" : "+v"(lane));
            const int n = lane & 15, q = lane >> 4;
            const int cur = c & 1;
            LAS unsigned char* buf = lds + cur * SC_BUF;
            const LAS float* vec = (const LAS float*)(lds + SC_VEC + cur * 1024);
            const int cn = (c + 1 < 128) ? c + 1 : 127;
            f32x4 VN[4];
            bf16x8 fa[8], fb[8];
            bf16x8 VNf[2], VNSf[2];
#define SC3_LD8_K128(dst, OFF, mt_) do { _Pragma("unroll") for (int i_ = 0; i_ < 8; ++i_) dst[i_] = *(const LAS bf16x8*)(buf + (OFF) + (16 * ((mt_) + (i_ >> 2)) + n) * 256 + (((4 * (i_ & 3) + q) ^ n) * 16)); } while (0)
#define SC3_LD8_K64(dst, OFF, mb) do { _Pragma("unroll") for (int i_ = 0; i_ < 8; ++i_) dst[i_] = *(const LAS bf16x8*)(buf + (OFF) + (16 * ((mb) + (i_ >> 1)) + n) * 128 + (((4 * (i_ & 1) + q) ^ ((n >> 1) & 7)) * 16)); } while (0)
#define SC3_MM_K128(A0, A1, fr) do { _Pragma("unroll") for (int i_ = 0; i_ < 4; ++i_) { A0 = MFMA16(fr[i_], Sf[i_], A0); A1 = MFMA16(fr[4 + i_], Sf[i_], A1); } } while (0)
#define SC3_MM_K64(X, ma, fr, BF) do { _Pragma("unroll") for (int t_ = 0; t_ < 4; ++t_) { X[(ma) + t_] = MFMA16(fr[2 * t_], BF[0], X[(ma) + t_]); X[(ma) + t_] = MFMA16(fr[2 * t_ + 1], BF[1], X[(ma) + t_]); } } while (0)
#define SC3_DLOAD(m) (*(const LAS f32x4*)(vec + 128 + 16 * (m) + 4 * q))
#define SC3_EGLOAD(mt) (*(const LAS f32x4*)(vec + 16 * (mt) + 4 * q))
#define SC3_PACK_S(s4) do { Sf[s4] = pack_frag(S[2 * (s4)], S[2 * (s4) + 1]); } while (0)
#define SC3_OT_WRITE() do { LAS bf16_t* OT_ = (LAS bf16_t*)(lds + SC_OT + cur * SC_OTB); const int cc_ = 16 * sl16 + n; \
                _Pragma("unroll") for (int mt = 0; mt < 4; ++mt) { \
                    OT_[(16 * mt + 4 * q + 0) * 136 + cc_] = f2bf(O[mt].x); OT_[(16 * mt + 4 * q + 1) * 136 + cc_] = f2bf(O[mt].y); \
                    OT_[(16 * mt + 4 * q + 2) * 136 + cc_] = f2bf(O[mt].z); OT_[(16 * mt + 4 * q + 3) * 136 + cc_] = f2bf(O[mt].w); } } while (0)
            f32x4 dA, dB, dC, dD;
            f32x4 O[4];
            if (GDN) {
#pragma unroll
                for (int mt = 0; mt < 4; ++mt) { const v2u uu = Ureg[mt];
                    VN[mt] = (f32x4){__uint_as_float(uu.x << 16), __uint_as_float(uu.x & 0xffff0000u), __uint_as_float(uu.y << 16), __uint_as_float(uu.y & 0xffff0000u)}; }
                SC3_LD8_K128(fa, SC_WV, 0); SCHED_FENCE();
                SC3_LD8_K128(fb, SC_WV, 2); SCHED_FENCE();
#pragma unroll
                for (int mt = 0; mt < 4; ++mt) Ureg[mt] = *(const v2u*)(bU + (size_t)cn * 16384 + (size_t)(sl16 * 4 + mt) * 512 + lane * 8);
                f32x4 eS[4];
#pragma unroll
                for (int i = 0; i < 4; ++i) eS[i] = *(const LAS f32x4*)(vec + 64 + 16 * i + 4 * q);
                dA = SC3_DLOAD(0); dB = SC3_DLOAD(1); dC = SC3_DLOAD(2); dD = SC3_DLOAD(3);
                SCHED_FENCE();
                SC3_PACK_S(3); SC3_MM_K128(VN[0], VN[1], fa); S[0] = S[0] * dA; S[1] = S[1] * dB; S[2] = S[2] * dC; S[3] = S[3] * dD; SCHED_FENCE();
                SC3_LD8_K128(fa, SC_QG, 0); dA = SC3_DLOAD(4); dB = SC3_DLOAD(5); dC = SC3_DLOAD(6); dD = SC3_DLOAD(7); SCHED_FENCE();
                SC3_MM_K128(VN[2], VN[3], fb); S[4] = S[4] * dA; S[5] = S[5] * dB; S[6] = S[6] * dC; S[7] = S[7] * dD; SCHED_FENCE();
                SC3_LD8_K128(fb, SC_QG, 2); dA = SC3_EGLOAD(0); dB = SC3_EGLOAD(1); SCHED_FENCE();
#pragma unroll
                for (int mt = 0; mt < 4; ++mt) O[mt] = (f32x4){0.f, 0.f, 0.f, 0.f};
                SC3_MM_K128(O[0], O[1], fa);
#pragma unroll
                for (int s2 = 0; s2 < 2; ++s2) { VNf[s2] = pack_frag(VN[2 * s2], VN[2 * s2 + 1]); VNSf[s2] = pack_frag(VN[2 * s2] * eS[2 * s2], VN[2 * s2 + 1] * eS[2 * s2 + 1]); }
                SCHED_FENCE();
                SC3_LD8_K64(fa, SC_A, 0); dC = SC3_EGLOAD(2); dD = SC3_EGLOAD(3); SCHED_FENCE();
                SC3_MM_K128(O[2], O[3], fb); O[0] = O[0] * dA; O[1] = O[1] * dB; SCHED_FENCE();
                SC3_LD8_K64(fb, SC_KDT, 0); SCHED_FENCE();
                O[2] = O[2] * dC; O[3] = O[3] * dD;
            } else {
                SC3_LD8_K128(fa, SC_QG, 0); SCHED_FENCE();
                SC3_LD8_K128(fb, SC_QG, 2); SCHED_FENCE();
#pragma unroll
                for (int s2 = 0; s2 < 2; ++s2) { unsigned w[4];
#pragma unroll
                    for (int jj = 0; jj < 4; ++jj) { const int ja = 2 * jj, jb = 2 * jj + 1; const int cc = 16 * sl16 + n;
                        const int ta = 32 * s2 + ((ja < 4) ? 4 * q + ja : 16 + 4 * q + ja - 4), tb = 32 * s2 + ((jb < 4) ? 4 * q + jb : 16 + 4 * q + jb - 4);
                        const unsigned lo = *(const LAS bf16_t*)(buf + SC_WV + ta * 256 + (((cc >> 3) ^ (ta & 15)) * 16) + (cc & 7) * 2), hi = *(const LAS bf16_t*)(buf + SC_WV + tb * 256 + (((cc >> 3) ^ (tb & 15)) * 16) + (cc & 7) * 2);
                        w[jj] = lo | (hi << 16); }
                    v4u ww; ww.x = w[0]; ww.y = w[1]; ww.z = w[2]; ww.w = w[3];
                    VNf[s2] = __builtin_bit_cast(bf16x8, ww); VNSf[s2] = VNf[s2]; }
                dA = SC3_DLOAD(0); dB = SC3_DLOAD(1); dC = SC3_DLOAD(2); dD = SC3_DLOAD(3);
                SCHED_FENCE();
#pragma unroll
                for (int mt = 0; mt < 4; ++mt) O[mt] = (f32x4){0.f, 0.f, 0.f, 0.f};
                SC3_PACK_S(3); SC3_MM_K128(O[0], O[1], fa); S[0] = S[0] * dA; S[1] = S[1] * dB; S[2] = S[2] * dC; S[3] = S[3] * dD; SCHED_FENCE();
                SC3_LD8_K64(fa, SC_A, 0); dA = SC3_DLOAD(4); dB = SC3_DLOAD(5); dC = SC3_DLOAD(6); dD = SC3_DLOAD(7); SCHED_FENCE();
                SC3_MM_K128(O[2], O[3], fb); S[4] = S[4] * dA; S[5] = S[5] * dB; S[6] = S[6] * dC; S[7] = S[7] * dD; SCHED_FENCE();
                SC3_LD8_K64(fb, SC_KDT, 0); SCHED_FENCE();
            }
            SC3_MM_K64(O, 0, fa, VNf); SCHED_FENCE();
            SC3_LD8_K64(fa, SC_KDT, 4); SCHED_FENCE();
            SC3_MM_K64(S, 0, fb, VNSf); SC3_OT_WRITE(); SCHED_FENCE();
            SC3_MM_K64(S, 4, fa, VNSf); SC3_PACK_S(0); SC3_PACK_S(1); SCHED_FENCE();
            SC3_PACK_S(2);
            SCAN_BAR();
        }
    } else if (wave == CPW) {
        for (int c = 0; c < 128; ++c) {
            SCAN_BAR();
            int lane = tid & 63; asm volatile("" : "+v"(lane));
            const LAS bf16_t* OTn = (const LAS bf16_t*)(lds + SC_OT + (c & 1) * SC_OTB);
#pragma unroll
            for (int ps = 0; ps < 4; ++ps) { const int row = 16 * ps + (lane >> 2), pc = lane & 3, col = 32 * g + 8 * pc;
                    const v4u val = *(const LAS v4u*)(OTn + row * 136 + col);
                    *(v4u*)(mix + (size_t)(b * SEQ + c * 64 + row) * DM + mix_col + col) = val; }
        }
    } else if (hw >= 0) {
        v4u G0[15], G1[15];
#define HLP_LOAD(GX, cn_) do { const unsigned char* sQG = bQG + (size_t)(cn_) * 16384 + (size_t)hw * 4096; const unsigned char* sWV = bWV + (size_t)(cn_) * wv_chunk + (size_t)(16 * hw) * wv_row; \
            const unsigned char* sKDT = bKDT + (size_t)(cn_) * 16384 + (size_t)hw * 4096; const unsigned char* sA = bA + (size_t)(cn_) * 8192 + (size_t)hw * 2048; \
            const unsigned l16 = (unsigned)lane * 16u, offv = (unsigned)(lane >> 4) * (unsigned)wv_row + (unsigned)(lane & 15) * 16u; \
            _Pragma("unroll") for (int i = 0; i < 4; ++i) { GX[i] = *(const v4u*)(sQG + i * 1024 + l16); GX[4 + i] = *(const v4u*)(sWV + (size_t)(4 * i) * wv_row + offv); } \
            _Pragma("unroll") for (int i = 0; i < 4; ++i) GX[8 + i] = *(const v4u*)(sKDT + i * 1024 + l16); \
            _Pragma("unroll") for (int i = 0; i < 2; ++i) GX[12 + i] = *(const v4u*)(sA + i * 1024 + l16); \
            GX[14] = *(const v4u*)((const unsigned char*)(bvec + (size_t)(cn_) * 256) + l16); } while (0)
#define HLP_STORE(GX, bi_) do { LAS unsigned char* nb = lds + (bi_) * SC_BUF + hw * 4096; LAS unsigned char* nv = lds + SC_VEC + (bi_) * 1024; const int lq = lane >> 4; \
            _Pragma("unroll") for (int i = 0; i < 4; ++i) { const int d = lq * 256 + (((lane & 15) ^ (4 * i + lq)) * 16); \
                *(LAS v4u*)(nb + SC_QG + i * 1024 + d) = GX[i]; *(LAS v4u*)(nb + SC_WV + i * 1024 + d) = GX[4 + i]; } \
            _Pragma("unroll") for (int i = 0; i < 4; ++i) { const int d = (lane >> 3) * 128 + (((lane & 7) ^ (4 * (i & 1) + lq)) * 16); *(LAS v4u*)(nb + SC_KDT + i * 1024 + d) = GX[8 + i]; } \
            _Pragma("unroll") for (int i = 0; i < 2; ++i) { const int d = (lane >> 3) * 128 + (((lane & 7) ^ (4 * i + lq)) * 16); *(LAS v4u*)(nb - hw * 2048 + SC_A + i * 1024 + d) = GX[12 + i]; } \
            if (hw == 0) *(LAS v4u*)(nv + lane * 16) = GX[14]; } while (0)
#define HLP_ITER(c, GL, GW) do { \
            int lane = tid & 63; asm volatile("" : "+v"(lane)); \
            const int c2 = ((c) + 2 < 128) ? (c) + 2 : 127; \
            HLP_LOAD(GL, c2); \
            HLP_STORE(GW, ((c) + 1) & 1); \
            SCAN_BAR(); } while (0)
        { int lane = tid & 63; asm volatile("" : "+v"(lane)); HLP_LOAD(G1, 1); }
        for (int c = 0; c < 128; c += 2) { HLP_ITER(c, G0, G1); HLP_ITER(c + 1, G1, G0); }
    } else {
        for (int c = 0; c < 128; ++c) {
            if (c == CA - 3 && nfb > 0) {
                if ((tid & 63) == 0) { while (__hip_atomic_load(prog, __ATOMIC_RELAXED, __HIP_MEMORY_SCOPE_AGENT) < (unsigned)nfb) __builtin_amdgcn_s_sleep(8); }
                __builtin_amdgcn_fence(__ATOMIC_ACQUIRE, "agent");
                asm volatile("s_waitcnt vmcnt(0)" ::: "memory");
            }
            SCAN_BAR();
        }
    }
    __syncthreads();
}

__device__ __forceinline__ void mixnorm_row(bf16_t* mrow, const bf16_t* prow, const float (&gn)[2][8], int lane) {
    v4u o4[4], z4[4];
#pragma unroll
    for (int i = 0; i < 4; ++i) { const int c0 = 8 * (64 * i + lane);
        o4[i] = *(const v4u*)(mrow + c0); z4[i] = *(const v4u*)(prow + (i < 2 ? C_AG + c0 : C_BZ + c0 - 1024)); }
#pragma unroll
    for (int i = 0; i < 4; ++i) {
        float ss = 0.f;
#pragma unroll
        for (int w = 0; w < 4; ++w) { const unsigned a = (w == 0) ? o4[i].x : (w == 1) ? o4[i].y : (w == 2) ? o4[i].z : o4[i].w;
            const float lo = __uint_as_float(a << 16), hi = __uint_as_float(a & 0xffff0000u); ss += lo * lo + hi * hi; }
        ss += __shfl_xor(ss, 1); ss += __shfl_xor(ss, 2); ss += __shfl_xor(ss, 4); ss += __shfl_xor(ss, 8);
        const float rstd = rsqrtf(ss * (1.f / 128.f) + EPS);
        float yv[8];
#pragma unroll
        for (int w = 0; w < 4; ++w) { const unsigned a = (w == 0) ? o4[i].x : (w == 1) ? o4[i].y : (w == 2) ? o4[i].z : o4[i].w;
            const unsigned z = (w == 0) ? z4[i].x : (w == 1) ? z4[i].y : (w == 2) ? z4[i].z : z4[i].w;
            yv[2 * w] = __uint_as_float(a << 16) * rstd * gn[i >> 1][2 * w] * __uint_as_float(z << 16);
            yv[2 * w + 1] = __uint_as_float(a & 0xffff0000u) * rstd * gn[i >> 1][2 * w + 1] * __uint_as_float(z & 0xffff0000u); }
        v4u y4; y4.x = pk2(yv[0], yv[1]); y4.y = pk2(yv[2], yv[3]); y4.z = pk2(yv[4], yv[5]); y4.w = pk2(yv[6], yv[7]);
        *(v4u*)(mrow + 8 * (64 * i + lane)) = y4; }
}

struct EpiProj {
    static constexpr bool PERM = true, AFTER_DRAIN = false;
    bf16_t* O; int ldc;
    __device__ __forceinline__ void operator()(const pg8::f32x4 (&acc)[2][2][4][2], const pg8::Unit& u, int wr, int wc, int fr, int fq) const {
        const int row0 = u.pm * 256 + wr * 64 + fr, col0 = u.pn * 256 + wc * 32 + 8 * fq;
        const bool gate = (u.pn >= 12 && u.pn < 16) || (u.pn >= 24);
#pragma unroll
        for (int ai = 0; ai < 2; ++ai)
#pragma unroll
            for (int m = 0; m < 4; ++m) { bf16_t* rowp = O + (size_t)(row0 + ai * 128 + m * 16) * ldc + col0;
#pragma unroll
                for (int bj = 0; bj < 2; ++bj) { pg8::f32x4 v0 = acc[ai][bj][m][0], v1 = acc[ai][bj][m][1];
                    if (gate) {
#pragma unroll
                        for (int e = 0; e < 4; ++e) { v0[e] = v0[e] * __builtin_amdgcn_rcpf(1.f + __expf(-v0[e])); v1[e] = v1[e] * __builtin_amdgcn_rcpf(1.f + __expf(-v1[e])); } }
                    pg8::u32x4 w; w.x = pk2(v0[0], v0[1]); w.y = pk2(v0[2], v0[3]); w.z = pk2(v1[0], v1[1]); w.w = pk2(v1[2], v1[3]);
                    *(pg8::u32x4*)(rowp + bj * 128) = w; } }
    }
};
struct EpiResF32 {
    static constexpr bool PERM = false, AFTER_DRAIN = false;
    const float* R; float* O; int ldc;
    __device__ __forceinline__ void operator()(const pg8::f32x4 (&acc)[2][2][4][2], const pg8::Unit& u, int wr, int wc, int fr, int fq) const {
        const int row0 = u.pm * 256 + wr * 64 + fr, col0 = u.pn * 256 + wc * 32 + 4 * fq;
#pragma unroll
        for (int ai = 0; ai < 2; ++ai)
#pragma unroll
            for (int m = 0; m < 4; ++m) { const size_t off = (size_t)(row0 + ai * 128 + m * 16) * ldc + col0;
#pragma unroll
                for (int bj = 0; bj < 2; ++bj)
#pragma unroll
                    for (int n = 0; n < 2; ++n) { pg8::f32x4 v = acc[ai][bj][m][n]; if (R) v = v + *(const pg8::f32x4*)(R + off + bj * 128 + n * 16); *(pg8::f32x4*)(O + off + bj * 128 + n * 16) = v; } }
    }
};

#define XB_TMO      128
#define XB_XCNT(j)  (256  + 64 * (j))
#define XB_XSUB(j)  (1280 + 64 * (j))
#define XB_XGEN(j)  (2304 + 64 * (j))
#define XB_TOP      3328
#define XB_TOPGEN   3392
#define XCD_BAR_WORDS 3456
#define XB_SPIN_CAP (1u << 18)

__device__ __forceinline__ unsigned xb_ld(unsigned* p)              { return __hip_atomic_load(p, __ATOMIC_RELAXED, __HIP_MEMORY_SCOPE_AGENT); }
__device__ __forceinline__ unsigned xb_add(unsigned* p, unsigned v) { return __hip_atomic_fetch_add(p, v, __ATOMIC_RELAXED, __HIP_MEMORY_SCOPE_AGENT); }
__device__ __forceinline__ unsigned xb_xcc_id() { return (unsigned)__builtin_amdgcn_s_getreg((3 << 11) | 20) & 0xFu; }
#define XB_SPIN(cond, bar) do { unsigned _sp = 0; while (cond) { __builtin_amdgcn_s_sleep(1); \
    if ((++_sp & 255u) == 0u) { if (xb_ld(&(bar)[XB_TMO])) break; if (_sp > XB_SPIN_CAP) { atomicAdd(&(bar)[XB_TMO], 1u); break; } } } } while (0)

struct XcdBarrier {
    unsigned* bar; unsigned x;
    volatile LAS unsigned* st;
};

__device__ __forceinline__ XcdBarrier xcd_barrier_post(unsigned* bar, volatile LAS unsigned* st) {
    XcdBarrier b; b.bar = bar; b.x = xb_xcc_id(); b.st = st;
    if (threadIdx.x == 0) (void)xb_add(&bar[XB_XCNT(b.x)], 1u);
    return b;
}
__device__ __forceinline__ void xcd_barrier_complete(unsigned* bar, unsigned x, unsigned& nloc, unsigned& nx) {
    const unsigned G = gridDim.x * gridDim.y * gridDim.z;
    unsigned sum, cnt, mine, sp = 0u;
    for (;;) {
        sum = 0u; cnt = 0u; mine = 0u;
#pragma unroll
        for (unsigned j = 0; j < 16; ++j) { const unsigned c = xb_ld(&bar[XB_XCNT(j)]); sum += c; cnt += (c > 0u) ? 1u : 0u; mine = (j == x) ? c : mine; }
        if (sum == G) break;
        __builtin_amdgcn_s_sleep(1);
        if ((++sp & 255u) == 0u) { if (xb_ld(&bar[XB_TMO])) break; if (sp > XB_SPIN_CAP) { atomicAdd(&bar[XB_TMO], 1u); break; } }
    }
    nloc = mine > 0u ? mine : 1u; nx = cnt > 0u ? cnt : 1u;
}

__device__ __forceinline__ void xcd_barrier(const XcdBarrier& b) {
    asm volatile("s_waitcnt vmcnt(0)" ::: "memory");
    __syncthreads();
    if (threadIdx.x == 0) {
        unsigned* bar = b.bar;
        __builtin_amdgcn_s_waitcnt(0);
        unsigned nloc = b.st[0], nx = b.st[1];
        if (nloc == 0u) { xcd_barrier_complete(bar, b.x, nloc, nx); b.st[0] = nloc; b.st[1] = nx; }
        const unsigned old = xb_add(&bar[XB_XSUB(b.x)], 1u);
        const unsigned gen = old / nloc;
        if (old + 1u == (gen + 1u) * nloc) {
            __builtin_amdgcn_fence(__ATOMIC_RELEASE, "agent");
            asm volatile("s_waitcnt vmcnt(0)" ::: "memory");
            const unsigned og = xb_add(&bar[XB_TOP], 1u);
            const unsigned tg = og / nx;
            if (og + 1u == (tg + 1u) * nx) xb_add(&bar[XB_TOPGEN], 1u);
            else XB_SPIN(xb_ld(&bar[XB_TOPGEN]) == tg, bar);
            __builtin_amdgcn_fence(__ATOMIC_ACQUIRE, "agent");
            xb_add(&bar[XB_XGEN(b.x)], 1u);
            asm volatile("s_waitcnt vmcnt(0)" ::: "memory");
        } else {
            XB_SPIN(xb_ld(&bar[XB_XGEN(b.x)]) == gen, bar);
            __builtin_amdgcn_fence(__ATOMIC_ACQUIRE, "agent");
            asm volatile("s_waitcnt vmcnt(0)" ::: "memory");
        }
    }
    __syncthreads();
}

__device__ __forceinline__ int get_lane() { int l = (int)__builtin_amdgcn_mbcnt_hi(~0u, __builtin_amdgcn_mbcnt_lo(~0u, 0u)); asm volatile("" : "+v"(l)); return l; }
__global__ void __launch_bounds__(NT, 2) mk_fwd(Args args) {
    extern __shared__ __attribute__((aligned(16))) unsigned char lds_raw[];
    LAS unsigned char* lds = (LAS unsigned char*)lds_raw;
    cg::grid_group grid = cg::this_grid();
    const int tid = threadIdx.x, wave = __builtin_amdgcn_readfirstlane(tid >> 6);

    const int G = gridDim.x, bx = blockIdx.x;
    const int vcu = (G % 8 == 0) ? (bx % 8) * (G / 8) + bx / 8 : bx;
    const int gw = vcu * NW + wave, NGW = G * NW;
    unsigned char* ws = args.ws;
    const float* x = args.in[0]; const float* attn_g = args.in[1]; const float* w_in = args.in[2];
    const float* w_out = args.in[9]; const float* ffn_g = args.in[10]; const float* w_query = args.in[11]; const float* sub_keys = args.in[12];
    bf16_t* WinT = (bf16_t*)(ws + OFF_D);
    bf16_t* WoutT = (bf16_t*)(ws + OFF_C);
    bf16_t* Wqk = (bf16_t*)(ws + OFF_C + 8 * MiB);
    bf16_t* xn = (bf16_t*)(ws + OFF_D + 28 * MiB);
    float* ba = (float*)(ws + OFF_S);
    bf16_t* proj = (bf16_t*)(ws + OFF_B);
    bf16_t* mix = (bf16_t*)args.out;
    unsigned char* pb = ws + OFF_D; float* vecs = (float*)(ws + OFF_S + 2 * MiB);
    float* hbuf = (float*)(ws + OFF_B);
    bf16_t* hn = (bf16_t*)(ws + OFF_D + 128 * MiB);
    float* scores = (float*)(ws + OFF_D);
    unsigned char* U8 = ws + OFF_TAB; unsigned char* V8 = ws + OFF_TAB + 16 * MiB;
    float* inv_su = (float*)(ws + OFF_S + 1 * MiB); float* inv_sv = inv_su + 16384;

    volatile LAS unsigned* xbst = (volatile LAS unsigned*)(lds + LDS_BYTES - 16);
    if (tid < 4) xbst[tid] = 0u;
    __syncthreads();
    XcdBarrier xbar = xcd_barrier_post((unsigned*)args.ws, xbst);
    const int lo = args.ph_lo, hi = args.ph_hi;
#define IN(k) (lo <= (k) && (k) < hi)
#define SYNC_AFTER(k) do { if (IN(k) && (k) + 1 < hi) { if ((k) == 0) grid.sync(); else xcd_barrier(xbar); } } while (0)
    {
        if (IN(0)) {
            const int lane = get_lane();
            LAS float* scr = (LAS float*)(lds + wave * 16384);
            constexpr int I_IN = (DM / 64) * (NPROJ / 32);
            for (int it = gw; it < I_IN; it += NGW) transpose_item(w_in, INW, DM, NPROJ, WinT, scr, it, lane);
            __syncthreads();
            {
                LAS float* wt = (LAS float*)lds;
#pragma unroll
                for (int k = 0; k < 4; ++k) { const int d = tid + 512 * k; const float* wr = w_in + (size_t)d * INW + NPROJ;
#pragma unroll
                    for (int q4 = 0; q4 < 4; ++q4) { const f32x4 w4 = *(const f32x4*)(wr + 4 * q4);
                        wt[(4 * q4 + 0) * 2048 + d] = w4.x; wt[(4 * q4 + 1) * 2048 + d] = w4.y; wt[(4 * q4 + 2) * 2048 + d] = w4.z; wt[(4 * q4 + 3) * 2048 + d] = w4.w; } }
            }
            __syncthreads();
            for (int m = gw; m < T; m += NGW) norm_row<true>(x + (size_t)m * DM, attn_g, (const LAS float*)lds, xn + (size_t)m * DM, ba + (size_t)m * 16, lane);
        }
        SYNC_AFTER(0);
        if (IN(1)) {
            pg8::Gemm g{xn, WinT, T, NPROJ, DM}; pg8::StaticOrder S; S.init(T, NPROJ, G, bx);
            EpiProj E{proj, NPROJ};
            pg8::gemm_phase<EpiProj, pg8::StaticOrder, true, true>(lds, g, S, E);
        }
        SYNC_AFTER(1);
        if (IN(2)) {
            const int CAe = (G > NSB) ? CA : 128;
            for (int it = bx; it < 16 * CAe; it += G) { int tt = threadIdx.x; asm volatile("" : "+v"(tt)); hgrn_prep_item((it / CAe) * 128 + (it % CAe), proj, args.in[3], pb, vecs, lds, tt); }
            for (int it = bx; it < 8 * CAe; it += G) { int tt = threadIdx.x; asm volatile("" : "+v"(tt)); gdn_prep_item((it / CAe) * 128 + (it % CAe), proj, ba, args.in[5], args.in[6], args.in[7], pb, vecs, lds, tt); }
        }
        SYNC_AFTER(2);
        if (IN(3)) {
            const int lane = get_lane();
            unsigned* ctl = (unsigned*)args.ws;
            if (bx < NSB) {
                const int sq = (bx & 7) + 8 * (bx >> 5), cgp = (bx >> 3) & 3;
                if (sq >= 16) scan_block<true>(sq, cgp, proj, pb, vecs, args.in[4], args.in[8], mix, ctl + PROG_WORD, G - NSB, lds, tid);
                else scan_block<false>(sq, cgp, proj, pb, vecs, args.in[4], args.in[8], mix, ctl + PROG_WORD, G - NSB, lds, tid);
            }
            else if (G > NSB) {
                int fb, FB;
                fb = bx - NSB; FB = G - NSB;
                {
                    constexpr int NBL = 128 - CA;
                    for (int it = fb; it < 16 * NBL; it += FB) { int tt = threadIdx.x; asm volatile("" : "+v"(tt)); hgrn_prep_item((it & 15) * 128 + CA + (it >> 4), proj, args.in[3], pb, vecs, lds, tt); }
                    for (int it = fb; it < 8 * NBL; it += FB) { int tt = threadIdx.x; asm volatile("" : "+v"(tt)); gdn_prep_item((it & 7) * 128 + CA + (it >> 3), proj, ba, args.in[5], args.in[6], args.in[7], pb, vecs, lds, tt); }
                    __syncthreads();
                    if (tid == 0) { __threadfence(); __hip_atomic_fetch_add(ctl + PROG_WORD, 1u, __ATOMIC_RELAXED, __HIP_MEMORY_SCOPE_AGENT); }
                    __syncthreads();
                }
                const int fw = fb * NW + wave, FW = FB * NW;
                for (int it = fb; it < 512; it += FB) wqk_item(w_query, sub_keys, Wqk, (LAS float*)lds, it, tid);
                LAS float* scr = (LAS float*)(lds + wave * 16384);
                constexpr int I_OUT = (DM / 64) * (DM / 32);
                for (int it = fw; it < I_OUT; it += FW) transpose_item(w_out, DM, DM, DM, WoutT, scr, it, lane);
                for (int e = 2 * fw; e < 32768; e += 2 * FW) { const bool isv = e >= 16384; const int r = e & 16383;
                    table_row2((isv ? args.in[14] : args.in[13]) + (size_t)r * DM, (unsigned*)((isv ? V8 : U8) + (size_t)r * 1024), (isv ? inv_sv : inv_su) + r, lane); }
            }
        }
        SYNC_AFTER(3);
        if (IN(4)) {
            {
                const int lane = get_lane();
                float gn[2][8];
#pragma unroll
                for (int mxr = 0; mxr < 2; ++mxr) { const float* gsrc = (mxr == 0 ? args.in[4] : args.in[8]) + 8 * (lane & 15);
                    const f32x4 ga = *(const f32x4*)gsrc, gb = *(const f32x4*)(gsrc + 4);
                    gn[mxr][0] = ga.x; gn[mxr][1] = ga.y; gn[mxr][2] = ga.z; gn[mxr][3] = ga.w; gn[mxr][4] = gb.x; gn[mxr][5] = gb.y; gn[mxr][6] = gb.z; gn[mxr][7] = gb.w; }
                for (int m = gw; m < T; m += NGW) mixnorm_row(mix + (size_t)m * DM, proj + (size_t)m * NPROJ, gn, lane);
                xcd_barrier(xbar);
            }
            pg8::Gemm g{mix, WoutT, T, DM, DM}; pg8::StaticOrder S; S.init(T, DM, G, bx);
            EpiResF32 E{x, hbuf, DM};
            pg8::gemm_phase<EpiResF32, pg8::StaticOrder, true, true>(lds, g, S, E);
        }
        SYNC_AFTER(4);
        if (IN(5)) {
            const int lane = get_lane();
            for (int m = gw; m < T; m += NGW) norm_row<false>(hbuf + (size_t)m * DM, ffn_g, (const LAS float*)lds, hn + (size_t)m * DM, nullptr, lane);
        }
        SYNC_AFTER(5);
        if (IN(6)) {
            pg8::Gemm g{hn, Wqk, T, DM, DM}; pg8::StaticOrder S; S.init(T, DM, G, bx);
            EpiResF32 E{nullptr, scores, DM};
            pg8::gemm_phase<EpiResF32, pg8::StaticOrder, true, true>(lds, g, S, E);
        }
        SYNC_AFTER(6);
        if (IN(7)) {
            const int lane = get_lane();
            LAS int* se = (LAS int*)(lds + wave * 4096); LAS float* sa = (LAS float*)(lds + wave * 4096 + 512); LAS float* sb = (LAS float*)(lds + wave * 4096 + 1024);
            for (int t = gw; t < T; t += NGW) { const int ln = get_lane(); peer_token(t, scores, hn, hbuf, U8, V8, inv_su, inv_sv, args.in[15], args.out, se, sa, sb, ln); }
        }
    }
}
}

extern "C" void kernel_launch(void* const* d_in, const int* in_sizes, int n_in, void* d_out, int out_size, void* d_ws, size_t ws_size, hipStream_t stream) {
    static int grid = 0;
    if (grid == 0) {
        int dev = 0, cus = 0, per_cu = 0;
        (void)hipGetDevice(&dev);
        (void)hipDeviceGetAttribute(&cus, hipDeviceAttributeMultiprocessorCount, dev);
        (void)hipFuncSetAttribute((const void*)mk::mk_fwd, hipFuncAttributeMaxDynamicSharedMemorySize, mk::LDS_BYTES);
        (void)hipOccupancyMaxActiveBlocksPerMultiprocessor(&per_cu, (const void*)mk::mk_fwd, mk::NT, mk::LDS_BYTES);
        if (per_cu < 1) { fprintf(stderr, "occupancy query says %d\n", per_cu); per_cu = 1; }
        grid = cus;
    }
    unsigned char* ws = (unsigned char*)d_ws;
    (void)hipMemsetAsync(d_ws, 0, 16384, stream);
    mk::Args a{};
    for (int i = 0; i < 16; ++i) a.in[i] = (const float*)d_in[i];
    a.out = (float*)d_out; a.ws = ws;
    {
        a.ph_lo = 0; a.ph_hi = 8;
        void* kargs[] = {&a};
        hipError_t e = hipLaunchCooperativeKernel((const void*)mk::mk_fwd, dim3(grid), dim3(mk::NT), kargs, mk::LDS_BYTES, stream);
        if (e != hipSuccess) fprintf(stderr, "coop launch failed: %s\n", hipGetErrorString(e));
    }
}
```

```cpp
#include <hip/hip_runtime.h>
#include <hip/hip_cooperative_groups.h>
#include <cstdio>
namespace cg = cooperative_groups;
#include <stdint.h>

typedef unsigned short bf16_t;
typedef float f32x4 __attribute__((ext_vector_type(4)));

constexpr int T = 16384, SEQ = 8192, DM = 2048, INW = 7184, NPROJ = 7168;
constexpr float EPS = 1e-6f;
constexpr size_t MiB = 1u << 20;
constexpr size_t OFF_TAB = 1 * MiB;
constexpr size_t OFF_B = 65 * MiB;
constexpr size_t OFF_C = 289 * MiB;
constexpr size_t OFF_D = 305 * MiB;
constexpr size_t OFF_S = 500 * MiB;
constexpr int C_AQ = 0, C_AF = 1024, C_AI = 2048, C_AG = 3072, C_BQ = 4096, C_BK = 4608, C_BV = 5120, C_BZ = 6144;

__device__ __forceinline__ float bf2f(bf16_t v) { return __uint_as_float(((unsigned)v) << 16); }
typedef float f32x2_t __attribute__((ext_vector_type(2)));
typedef __bf16 bf16x2_t __attribute__((ext_vector_type(2)));
__device__ __forceinline__ unsigned cvt_pk2(float lo, float hi) { f32x2_t v = {lo, hi}; bf16x2_t b = __builtin_convertvector(v, bf16x2_t); return __builtin_bit_cast(unsigned, b); }
__device__ __forceinline__ bf16_t f2bf(float f) { return (bf16_t)(cvt_pk2(f, 0.f) & 0xffffu); }
__device__ __forceinline__ float sigmoidf_(float x) { return 1.f / (1.f + __expf(-x)); }
__device__ __forceinline__ float siluf_(float x) { return x / (1.f + __expf(-x)); }
__device__ __forceinline__ float wave_sum(float v) {
#pragma unroll
    for (int o = 1; o < 64; o <<= 1) v += __shfl_xor(v, o);
    return v;
}
__device__ __forceinline__ float block_sum(float v, float* sh) {
    v = wave_sum(v);
    const int w = threadIdx.x >> 6, nw = blockDim.x >> 6;
    __syncthreads();
    if ((threadIdx.x & 63) == 0) sh[w] = v;
    __syncthreads();
    float r = 0.f;
    for (int i = 0; i < nw; ++i) r += sh[i];
    return r;
}

__device__ __forceinline__ float gelu_erf(float x) { return 0.5f * x * (1.f + erff(x * 0.70710678118654752f)); }
namespace pg8 {
#define PG8_LAS __attribute__((address_space(3)))
typedef unsigned short bf16_t;
typedef short bf16x8 __attribute__((ext_vector_type(8)));
typedef float f32x4 __attribute__((ext_vector_type(4)));
typedef unsigned u32x4 __attribute__((ext_vector_type(4)));
constexpr int BM = 256, BK = 64, HALF = 128, HTB = HALF * BK * 2  , STAGE_BYTES = 8 * HTB, NXCD = 8, WGM = 8;

__host__ __device__ __forceinline__ int lds_byte(int r, int c) { const int st = (r >> 4) * 2 + (c >> 5), rr = r & 15, cc = c & 31, ob = rr * 64 + cc * 2; return st * 1024 + (ob ^ (((ob >> 9) & 1) << 5)); }
__host__ __device__ __forceinline__ void stage_rc(int b, int& R, int& C) { const int st = b / 1024, sb = b % 1024, swz = sb ^ (((sb >> 9) & 1) << 5); R = (st >> 1) * 16 + swz / 64; C = (st & 1) * 32 + (swz % 64) / 2; }
__host__ __device__ __forceinline__ int perm32(int rho) { const int n = rho >> 4, i = rho & 15; return 8 * (i >> 2) + 4 * n + (i & 3); }

struct Unit { int pm, pn; };
struct Gemm { const bf16_t* A; const bf16_t* Bt; int M, N, K; };

struct StaticOrder {
    int nM, nN, nwg, G, c;
    __host__ __device__ void init(int M, int N, int G_, int c_) { nM = M / BM; nN = N / BM; nwg = nM * nN; G = G_; c = c_; }
    __host__ __device__ bool next(int i, Unit& u) const {
        const long L = (long)i * G + c; if (L >= nwg) return false;
        int wgid = (int)L; { const int q = nwg / NXCD, r = nwg % NXCD, xcd = wgid % NXCD, off = wgid / NXCD; wgid = (xcd < r ? xcd * (q + 1) : r * (q + 1) + (xcd - r) * q) + off; }
        const int nig = WGM * nN, gid = wgid / nig, fm = gid * WGM, gsz = (nM - fm) < WGM ? (nM - fm) : WGM;
        u.pm = fm + ((wgid % nig) % gsz); u.pn = (wgid % nig) / gsz; return true;
    }
    __device__ __forceinline__ void a_ready(const Unit&) const {}
    __device__ __forceinline__ void done(const Unit&) const {}
};

__device__ __forceinline__ unsigned cvt_pk_bf16(float lo, float hi) { unsigned r; asm volatile("v_cvt_pk_bf16_f32 %0, %1, %2" : "=v"(r) : "v"(lo), "v"(hi)); return r; }
typedef float f32x2 __attribute__((ext_vector_type(2)));
__device__ __forceinline__ f32x2 gelu_pk(f32x2 v) {
    const f32x2 av = __builtin_elementwise_abs(v), d = av * 0.2316418882f + 1.0f;
    f32x2 t; t.x = __builtin_amdgcn_rcpf(d.x); t.y = __builtin_amdgcn_rcpf(d.y);
    f32x2 q = t * 0.5307027145f + (-0.7265760135f); q = q * t + 0.7107068705f; q = q * t + (-0.142248368f); q = q * t + 0.127414796f; q = q * t;
    const f32x2 s = (v * v) * (-0.72134752044f);
    f32x2 e; e.x = __builtin_amdgcn_exp2f(s.x); e.y = __builtin_amdgcn_exp2f(s.y);
    const f32x2 m = v * (q * e), r = v - m;
    f32x2 o; o.x = v.x < 0.f ? m.x : r.x; o.y = v.y < 0.f ? m.y : r.y; return o;
}

template <int ACT  > struct EpiBf16 {
    static constexpr bool PERM = true, AFTER_DRAIN = false; static_assert(ACT == 0 || ACT == 1, "EpiBf16: ACT is 0 (none) or 1 (gelu_pk)");
    bf16_t* O; int ldc; const float* bias; int split_cols; size_t split_stride; float scale0;
    __device__ __forceinline__ void operator()(const f32x4 (&acc)[2][2][4][2], const Unit& u, int wr, int wc, int fr, int fq) const {
        const int row0 = u.pm * BM + wr * 64 + fr; int colt = u.pn * BM; bf16_t* base = O;
        float sc = 1.f; if (split_cols) { const int t = colt / split_cols; base += (size_t)t * split_stride; colt -= t * split_cols; if (t == 0) sc = scale0; }
        const int col0 = colt + wc * 32 + 8 * fq, bcol0 = u.pn * BM + wc * 32 + 8 * fq;
        f32x4 bv[2][2];
#pragma unroll
        for (int bj = 0; bj < 2; ++bj)
#pragma unroll
            for (int n = 0; n < 2; ++n) bv[bj][n] = bias ? *(const f32x4*)(bias + bcol0 + bj * HALF + 4 * n) : (f32x4){0.f, 0.f, 0.f, 0.f};
#pragma unroll
        for (int ai = 0; ai < 2; ++ai)
#pragma unroll
            for (int m = 0; m < 4; ++m) { bf16_t* rowp = base + (size_t)(row0 + ai * HALF + m * 16) * ldc + col0;
#pragma unroll
                for (int bj = 0; bj < 2; ++bj) { f32x4 v0 = acc[ai][bj][m][0] + bv[bj][0], v1 = acc[ai][bj][m][1] + bv[bj][1];
                    if (ACT == 1) { f32x2 a = gelu_pk((f32x2){v0[0], v0[1]}), b = gelu_pk((f32x2){v0[2], v0[3]}), c = gelu_pk((f32x2){v1[0], v1[1]}), d = gelu_pk((f32x2){v1[2], v1[3]});
                        v0 = (f32x4){a.x, a.y, b.x, b.y}; v1 = (f32x4){c.x, c.y, d.x, d.y}; }
                    v0 = v0 * sc; v1 = v1 * sc; u32x4 w; w.x = cvt_pk_bf16(v0[0], v0[1]); w.y = cvt_pk_bf16(v0[2], v0[3]); w.z = cvt_pk_bf16(v1[0], v1[1]); w.w = cvt_pk_bf16(v1[2], v1[3]);
                    *(u32x4*)(rowp + bj * HALF) = w; } }
    }
};
template <class Epi, class Sched, bool ALIGN_EPI = false, bool SP2 = false>
__device__ __forceinline__ void gemm_phase(PG8_LAS unsigned char* lds, const Gemm g, const Sched& S, const Epi& E) {
    const int tid = threadIdx.x, wid = __builtin_amdgcn_readfirstlane(tid >> 6), lane = tid & 63, wr = wid >> 2, wc = wid & 3, fr = lane & 15, fq = lane >> 4;
    const int K = g.K, nt = K / BK;
    unsigned voffA[2], voffB[2];
#pragma unroll
    for (int i = 0; i < 2; ++i) { int R, C; stage_rc(tid * 16 + i * 8192, R, C); const int Rb = Epi::PERM ? ((R & ~31) + perm32(R & 31)) : R;
        voffA[i] = (unsigned)(R * K + C) * 2u; voffB[i] = (unsigned)(Rb * K + C) * 2u; }
    const size_t kstep = (size_t)(BK * 2);
    const size_t hstep = (size_t)HALF * K * 2;
    const size_t tstep = 2 * hstep;
    const unsigned ldsw = (unsigned)wid * 1024u;
    const int aoff = lds_byte(wr * 64 + fr, fq * 8), boff = lds_byte(wc * 32 + fr, fq * 8);
#define PG8_SA(b, h) (((b) * 2 + (h)) * HTB)
#define PG8_SB(b, h) ((4 + (b) * 2 + (h)) * HTB)
#define PG8_STAGE(bufoff, gbase, voff) do { _Pragma("unroll") for (int _i = 0; _i < 2; ++_i) \
        __builtin_amdgcn_global_load_lds((const unsigned*)((const char*)(gbase) + (voff)[_i]), (PG8_LAS unsigned*)(lds + (bufoff) + ldsw + _i * 8192), 16, 0, 0); } while (0)
#define PG8_LDA(dst, b, h) do { _Pragma("unroll") for (int m = 0; m < 4; ++m) _Pragma("unroll") for (int k = 0; k < 2; ++k) dst[m][k] = *(const PG8_LAS bf16x8*)(lds + PG8_SA(b, h) + aoff + m * 2048 + k * 1024); } while (0)
#define PG8_LDB(dst, b, h) do { _Pragma("unroll") for (int n = 0; n < 2; ++n) _Pragma("unroll") for (int k = 0; k < 2; ++k) dst[n][k] = *(const PG8_LAS bf16x8*)(lds + PG8_SB(b, h) + boff + n * 2048 + k * 1024); } while (0)
#define PG8_MMA(ai, bj, At, Bt) do { __builtin_amdgcn_s_setprio(1); _Pragma("unroll") for (int m = 0; m < 4; ++m) _Pragma("unroll") for (int n = 0; n < 2; ++n) _Pragma("unroll") for (int k = 0; k < 2; ++k) \
        acc[ai][bj][m][n] = __builtin_amdgcn_mfma_f32_16x16x32_bf16(Bt[n][k], At[m][k], acc[ai][bj][m][n], 0, 0, 0); __builtin_amdgcn_s_setprio(0); } while (0)
#define PG8_WAIT_V(n) asm volatile("s_waitcnt vmcnt(" #n ")" ::: "memory")
#define PG8_WAIT_L(n) asm volatile("s_waitcnt lgkmcnt(" #n ")" ::: "memory")
#define PG8_BAR __builtin_amdgcn_s_barrier()
#define PG8_SCHED __builtin_amdgcn_sched_barrier(0)
    Unit cur, nxt; int ui = 0;
    if (!S.next(0, cur)) return;
    f32x4 acc[2][2][4][2];
#pragma unroll
    for (int a = 0; a < 2; ++a)
#pragma unroll
        for (int b = 0; b < 2; ++b)
#pragma unroll
            for (int m = 0; m < 4; ++m)
#pragma unroll
                for (int n = 0; n < 2; ++n) acc[a][b][m][n] = (f32x4){0.f, 0.f, 0.f, 0.f};
    bf16x8 At[4][2], B0[2][2], B1[2][2];
    const char* cA = (const char*)g.A + (size_t)cur.pm * tstep; const char* cB = (const char*)g.Bt + (size_t)cur.pn * tstep;
    S.a_ready(cur);
    if constexpr (SP2) {
        PG8_STAGE(PG8_SB(0, 0), cB, voffB); PG8_STAGE(PG8_SB(0, 1), cB + hstep, voffB); PG8_STAGE(PG8_SA(0, 0), cA, voffA); PG8_STAGE(PG8_SA(0, 1), cA + hstep, voffA);
        if (wr == 1) PG8_BAR;
        PG8_WAIT_V(2); PG8_BAR;
        PG8_STAGE(PG8_SB(1, 0), cB + kstep, voffB); PG8_STAGE(PG8_SA(1, 0), cA + kstep, voffA); PG8_STAGE(PG8_SB(1, 1), cB + hstep + kstep, voffB);
        PG8_WAIT_V(6); PG8_BAR;
    } else {
        PG8_STAGE(PG8_SB(0, 0), cB, voffB); PG8_STAGE(PG8_SA(0, 0), cA, voffA); PG8_STAGE(PG8_SB(0, 1), cB + hstep, voffB); PG8_STAGE(PG8_SA(0, 1), cA + hstep, voffA);
        if (wr == 1) PG8_BAR;
        PG8_WAIT_V(4); PG8_BAR;
        PG8_STAGE(PG8_SB(1, 0), cB + kstep, voffB); PG8_STAGE(PG8_SA(1, 0), cA + kstep, voffA); PG8_STAGE(PG8_SB(1, 1), cB + hstep + kstep, voffB);
        PG8_WAIT_V(6); PG8_BAR;
    }
    for (;;) {
        const bool has_next = S.next(ui + 1, nxt);
        const char* nA = has_next ? (const char*)g.A + (size_t)nxt.pm * tstep : cA; const char* nB = has_next ? (const char*)g.Bt + (size_t)nxt.pn * tstep : cB;
        for (int t = 0; t < nt; t += 2) {
            const bool last = (t == nt - 2);
            const char* a1 = cA + (size_t)(t + 1) * kstep;
            const char* a2 = last ? nA : cA + (size_t)(t + 2) * kstep; const char* b2 = last ? nB : cB + (size_t)(t + 2) * kstep;
            const char* a3 = a2 + kstep; const char* b3 = b2 + kstep;
            if (last && has_next) S.a_ready(nxt);
            if constexpr (SP2) {
            PG8_LDB(B0, 0, 0); PG8_LDB(B1, 0, 1); PG8_SCHED; PG8_LDA(At, 0, 0); PG8_STAGE(PG8_SA(1, 1), a1 + hstep, voffA);
            PG8_WAIT_V(8); PG8_WAIT_L(0); PG8_BAR; PG8_MMA(0, 0, At, B0); PG8_MMA(0, 1, At, B1); PG8_BAR; PG8_SCHED;
            PG8_LDA(At, 0, 1); PG8_STAGE(PG8_SB(0, 0), b2, voffB); PG8_STAGE(PG8_SB(0, 1), b2 + hstep, voffB); PG8_STAGE(PG8_SA(0, 0), a2, voffA);
            PG8_WAIT_V(8); PG8_WAIT_L(0); PG8_BAR; PG8_MMA(1, 0, At, B0); PG8_MMA(1, 1, At, B1); PG8_BAR; PG8_SCHED;
            PG8_LDB(B0, 1, 0); PG8_LDB(B1, 1, 1); PG8_SCHED; PG8_LDA(At, 1, 0); PG8_STAGE(PG8_SA(0, 1), a2 + hstep, voffA);
            PG8_WAIT_V(8); PG8_WAIT_L(0); PG8_BAR; PG8_MMA(0, 0, At, B0); PG8_MMA(0, 1, At, B1); PG8_BAR; PG8_SCHED;
            PG8_LDA(At, 1, 1); PG8_STAGE(PG8_SB(1, 0), b3, voffB); PG8_STAGE(PG8_SB(1, 1), b3 + hstep, voffB); PG8_STAGE(PG8_SA(1, 0), a3, voffA);
            PG8_WAIT_V(8); PG8_WAIT_L(0); PG8_BAR; PG8_MMA(1, 0, At, B0); PG8_MMA(1, 1, At, B1); PG8_BAR; PG8_SCHED;
            } else {
            PG8_LDB(B0, 0, 0); PG8_SCHED; PG8_LDA(At, 0, 0); PG8_STAGE(PG8_SA(1, 1), a1 + hstep, voffA);
            PG8_WAIT_L(8); PG8_BAR; PG8_WAIT_L(0); PG8_MMA(0, 0, At, B0); PG8_BAR; PG8_SCHED;
            PG8_LDB(B1, 0, 1); PG8_STAGE(PG8_SB(0, 0), b2, voffB);
            PG8_BAR; PG8_WAIT_L(0); PG8_MMA(0, 1, At, B1); PG8_BAR;
            PG8_LDA(At, 0, 1); PG8_STAGE(PG8_SA(0, 0), a2, voffA);
            PG8_BAR; PG8_WAIT_L(0); PG8_MMA(1, 0, At, B0); PG8_BAR; PG8_SCHED;
            PG8_STAGE(PG8_SB(0, 1), b2 + hstep, voffB);
            PG8_WAIT_V(6); PG8_BAR; PG8_MMA(1, 1, At, B1); PG8_BAR;
            PG8_LDB(B0, 1, 0); PG8_SCHED; PG8_LDA(At, 1, 0); PG8_STAGE(PG8_SA(0, 1), a2 + hstep, voffA);
            PG8_WAIT_L(8); PG8_BAR; PG8_WAIT_L(0); PG8_MMA(0, 0, At, B0); PG8_BAR; PG8_SCHED;
            PG8_LDB(B1, 1, 1); PG8_STAGE(PG8_SB(1, 0), b3, voffB);
            PG8_BAR; PG8_WAIT_L(0); PG8_MMA(0, 1, At, B1); PG8_BAR;
            PG8_LDA(At, 1, 1); PG8_STAGE(PG8_SA(1, 0), a3, voffA);
            PG8_BAR; PG8_WAIT_L(0); PG8_MMA(1, 0, At, B0); PG8_BAR; PG8_SCHED;
            PG8_STAGE(PG8_SB(1, 1), b3 + hstep, voffB);
            PG8_WAIT_V(6); PG8_BAR; PG8_MMA(1, 1, At, B1); PG8_BAR;
            }
        }
        if constexpr (ALIGN_EPI) { if (wr == 0) PG8_BAR; }
        if constexpr (!Epi::AFTER_DRAIN) { E(acc, cur, wr, wc, fr, fq); S.done(cur); }
        if (!has_next) break;
#pragma unroll
        for (int a = 0; a < 2; ++a)
#pragma unroll
            for (int b = 0; b < 2; ++b)
#pragma unroll
                for (int m = 0; m < 4; ++m)
#pragma unroll
                    for (int n = 0; n < 2; ++n) acc[a][b][m][n] = (f32x4){0.f, 0.f, 0.f, 0.f};
        cur = nxt; cA = nA; cB = nB; ++ui;
        if constexpr (ALIGN_EPI) { if (wr == 1) PG8_BAR; }
    }
    PG8_WAIT_V(0);
    if constexpr (!ALIGN_EPI) { if (wr == 0) PG8_BAR; }
    PG8_BAR;
    if constexpr (Epi::AFTER_DRAIN) { E.fused(acc, cur, wr, wc, fr, fq, lds, wid, lane); S.done(cur); }
#undef PG8_SA
#undef PG8_SB
#undef PG8_STAGE
#undef PG8_LDA
#undef PG8_LDB
#undef PG8_MMA
#undef PG8_WAIT_V
#undef PG8_WAIT_L
#undef PG8_BAR
#undef PG8_SCHED
}
}

namespace mk {
#define LAS __attribute__((address_space(3)))
#define GAS __attribute__((address_space(1)))
typedef unsigned v4u __attribute__((ext_vector_type(4)));
typedef unsigned v2u __attribute__((ext_vector_type(2)));
constexpr int NW = 8, NT = 512, LDS_BYTES = 163840, RING_BYTES = 131072;
#define LDS_WAIT() asm volatile("s_waitcnt lgkmcnt(0)" ::: "memory")
#define DPP_ROR_ADD(t, n) ((t) + __uint_as_float(__builtin_amdgcn_update_dpp(0u, __float_as_uint(t), 0x120 + (n), 0xf, 0xf, false)))
struct Args { const float* in[16]; float* out; unsigned char* ws; int ph_lo, ph_hi; };
__device__ __forceinline__ unsigned pk2(float lo, float hi) { return cvt_pk2(lo, hi); }

__device__ __forceinline__ void transpose_item(const float* W, int ld, int K, int ncols, bf16_t* WT, LAS float* scr, int item, int lane) {
    const int nblk = ncols / 32, kb = item / nblk, nb = item % nblk, k0 = 64 * kb, n0 = 32 * nb;
#pragma unroll 8
    for (int i = 0; i < 32; ++i) { const int kk = 2 * i + (lane >> 5); scr[kk * 33 + (lane & 31)] = W[(size_t)(k0 + kk) * ld + n0 + (lane & 31)]; }
    LDS_WAIT(); asm volatile("" ::: "memory");
    const int c = lane & 7;
#pragma unroll
    for (int j = 0; j < 4; ++j) { const int n = (lane >> 3) + 8 * j; const LAS float* s = scr + (8 * c) * 33 + n;
        v4u o; o.x = pk2(s[0 * 33], s[1 * 33]); o.y = pk2(s[2 * 33], s[3 * 33]); o.z = pk2(s[4 * 33], s[5 * 33]); o.w = pk2(s[6 * 33], s[7 * 33]);
        *(v4u*)(WT + (size_t)(n0 + n) * K + k0 + 8 * c) = o; }
    LDS_WAIT(); asm volatile("" ::: "memory");
}
template <bool WITH_BA>
__device__ __forceinline__ void norm_row(const float* xrow, const float* g, const LAS float* wt  , bf16_t* orow, float* barow, int lane) {
    f32x4 v[8]; float ss = 0.f;
#pragma unroll
    for (int j = 0; j < 8; ++j) { v[j] = ((const f32x4*)xrow)[64 * j + lane]; ss += (v[j].x * v[j].x + v[j].y * v[j].y) + (v[j].z * v[j].z + v[j].w * v[j].w); }
    ss = wave_sum(ss);
    const float rstd = rsqrtf(ss * (1.f / DM) + EPS);
    float acc[16];
#pragma unroll
    for (int c = 0; c < 16; ++c) acc[c] = 0.f;
#pragma unroll
    for (int j = 0; j < 8; ++j) {
        const f32x4 gg = ((const f32x4*)g)[64 * j + lane];
        const f32x4 y = v[j] * rstd * gg;
        v2u o; o.x = pk2(y.x, y.y); o.y = pk2(y.z, y.w);
        ((v2u*)orow)[64 * j + lane] = o;
        if (WITH_BA) {
#pragma unroll
            for (int c = 0; c < 16; ++c) { const f32x4 w4 = *(const LAS f32x4*)(wt + c * 2048 + 4 * (64 * j + lane));
                acc[c] += (y.x * w4.x + y.y * w4.y) + (y.z * w4.z + y.w * w4.w); }
            __builtin_amdgcn_sched_barrier(0);
        }
    }
    if (WITH_BA) {
        float q8[8], t4[4];
#pragma unroll
        for (int r = 0; r < 8; ++r) { auto sw = __builtin_amdgcn_permlane32_swap(__float_as_uint(acc[r]), __float_as_uint(acc[r + 8]), false, false); q8[r] = __uint_as_float(sw[0]) + __uint_as_float(sw[1]); }
#pragma unroll
        for (int r = 0; r < 4; ++r) { auto sw = __builtin_amdgcn_permlane16_swap(__float_as_uint(q8[r]), __float_as_uint(q8[r + 4]), false, false); t4[r] = __uint_as_float(sw[0]) + __uint_as_float(sw[1]); }
#pragma unroll
        for (int r = 0; r < 4; ++r) { float tv = t4[r]; tv = DPP_ROR_ADD(tv, 8); tv = DPP_ROR_ADD(tv, 4); tv = DPP_ROR_ADD(tv, 2); tv = DPP_ROR_ADD(tv, 1); t4[r] = tv; }
        if ((lane & 15) == 0) { const int gq = lane >> 4;
#pragma unroll
            for (int r = 0; r < 4; ++r) barow[r + 4 * gq] = t4[r]; }
    }
}
__device__ __forceinline__ void wqk_item(const float* Wq, const float* SK, bf16_t* Wqk, LAS float* lds, int item, int tid) {
    const int cbk = item >> 5, d0 = (item & 31) * 64, cb = cbk * 128, h = cbk >> 1, half = cbk & 1;
    LAS float* At = lds; LAS float* Bt = lds + 128 * 68;
    const float* skb = SK + ((size_t)(half * 8 + h) * 128) * 128;
#pragma unroll
    for (int i = 0; i < 4; ++i) { const int idx = tid + 512 * i, d = idx >> 5, k4 = idx & 31;
        const f32x4 w = *(const f32x4*)(Wq + (size_t)(d0 + d) * DM + cb + 4 * k4);
        At[(4 * k4 + 0) * 68 + d] = w.x; At[(4 * k4 + 1) * 68 + d] = w.y; At[(4 * k4 + 2) * 68 + d] = w.z; At[(4 * k4 + 3) * 68 + d] = w.w; }
#pragma unroll
    for (int i = 0; i < 8; ++i) { const int idx = tid + 512 * i, n = idx >> 5, k4 = idx & 31;
        const f32x4 w = *(const f32x4*)(skb + (size_t)n * 128 + 4 * k4);
        Bt[(4 * k4 + 0) * 132 + n] = w.x; Bt[(4 * k4 + 1) * 132 + n] = w.y; Bt[(4 * k4 + 2) * 132 + n] = w.z; Bt[(4 * k4 + 3) * 132 + n] = w.w; }
    __syncthreads();
    const int dy = tid >> 5, nx = tid & 31;
    float acc[4][4];
#pragma unroll
    for (int i = 0; i < 4; ++i)
#pragma unroll
        for (int j = 0; j < 4; ++j) acc[i][j] = 0.f;
#pragma unroll 4
    for (int kk = 0; kk < 128; ++kk) {
        const f32x4 a = *(const LAS f32x4*)(At + kk * 68 + 4 * dy), b = *(const LAS f32x4*)(Bt + kk * 132 + 4 * nx);
        acc[0][0] += a.x * b.x; acc[0][1] += a.x * b.y; acc[0][2] += a.x * b.z; acc[0][3] += a.x * b.w;
        acc[1][0] += a.y * b.x; acc[1][1] += a.y * b.y; acc[1][2] += a.y * b.z; acc[1][3] += a.y * b.w;
        acc[2][0] += a.z * b.x; acc[2][1] += a.z * b.y; acc[2][2] += a.z * b.z; acc[2][3] += a.z * b.w;
        acc[3][0] += a.w * b.x; acc[3][1] += a.w * b.y; acc[3][2] += a.w * b.z; acc[3][3] += a.w * b.w;
    }
#pragma unroll
    for (int j = 0; j < 4; ++j) { v2u o; o.x = pk2(acc[0][j], acc[1][j]); o.y = pk2(acc[2][j], acc[3][j]);
        *(v2u*)(Wqk + (size_t)(cb + 4 * nx + j) * DM + d0 + 4 * dy) = o; }
    __syncthreads();
}

typedef float f32x2 __attribute__((ext_vector_type(2)));
__device__ __forceinline__ int fp4_idx_of(float v) { return (v < 1.75f) ? (int)(v * 2.f + 0.25f) : (v < 2.5f ? 4 : (v < 3.5f ? 5 : (v < 5.f ? 6 : 7))); }
__device__ __forceinline__ void fp4_calibrate(int (&nib)[8]) {
    const unsigned T = 0x76543210u;
    const f32x2 a = __builtin_amdgcn_cvt_scalef32_pk_f32_fp4(T, 1.0f, 0), b = __builtin_amdgcn_cvt_scalef32_pk_f32_fp4(T, 1.0f, 1);
    const f32x2 c = __builtin_amdgcn_cvt_scalef32_pk_f32_fp4(T, 1.0f, 2), d = __builtin_amdgcn_cvt_scalef32_pk_f32_fp4(T, 1.0f, 3);
    nib[0] = fp4_idx_of(a.x); nib[1] = fp4_idx_of(a.y); nib[2] = fp4_idx_of(b.x); nib[3] = fp4_idx_of(b.y);
    nib[4] = fp4_idx_of(c.x); nib[5] = fp4_idx_of(c.y); nib[6] = fp4_idx_of(d.x); nib[7] = fp4_idx_of(d.y);
}
__device__ __forceinline__ void table_row_sw(const float* src, unsigned* dst, float* inv_scale, int lane) {
    int nib[8]; fp4_calibrate(nib);
    f32x4 v[8]; float mx = 0.f;
#pragma unroll
    for (int j = 0; j < 8; ++j) { v[j] = ((const f32x4*)src)[8 * lane + j];
        mx = fmaxf(mx, fmaxf(fmaxf(fabsf(v[j].x), fabsf(v[j].y)), fmaxf(fabsf(v[j].z), fabsf(v[j].w)))); }
#pragma unroll
    for (int o = 1; o < 64; o <<= 1) mx = fmaxf(mx, __shfl_xor(mx, o));
    const float sc = mx > 0.f ? mx * (0.85f / 6.f) : 1.f, isc = 1.f / sc;
    unsigned wd[4];
#pragma unroll
    for (int w = 0; w < 4; ++w) {
        unsigned acc = 0u;
#pragma unroll
        for (int e = 0; e < 8; ++e) {
            const f32x4 q = v[2 * w + (e >> 2)]; const float xe = ((e & 3) == 0) ? q.x : ((e & 3) == 1) ? q.y : ((e & 3) == 2) ? q.z : q.w;
            const float yv = fabsf(xe) * isc;
            unsigned code = (yv > 0.25f) + (yv > 0.75f) + (yv > 1.25f) + (yv > 1.75f) + (yv > 2.5f) + (yv > 3.5f) + (yv > 5.f);
            code |= (xe < 0.f) ? 8u : 0u;
            acc |= code << (4 * nib[e]);
        }
        wd[w] = acc;
    }
    v4u o; o.x = wd[0]; o.y = wd[1]; o.z = wd[2]; o.w = wd[3];
    ((v4u*)dst)[lane] = o;
    if (lane == 0) *inv_scale = sc;
}
__device__ __forceinline__ bool fp4_hw_encoder_ok() {
    unsigned t = 0u, u = 0u;
    t = __builtin_amdgcn_cvt_scalef32_pk_fp4_f32(t, 0.f, 0.5f, 1.0f, 0); t = __builtin_amdgcn_cvt_scalef32_pk_fp4_f32(t, 1.f, -1.5f, 1.0f, 1);
    t = __builtin_amdgcn_cvt_scalef32_pk_fp4_f32(t, 2.f, 3.f, 1.0f, 2); t = __builtin_amdgcn_cvt_scalef32_pk_fp4_f32(t, -4.f, 6.f, 1.0f, 3);
    u = __builtin_amdgcn_cvt_scalef32_pk_fp4_f32(u, 0.2f, 0.3f, 1.0f, 0); u = __builtin_amdgcn_cvt_scalef32_pk_fp4_f32(u, 2.4f, -2.6f, 1.0f, 1);
    u = __builtin_amdgcn_cvt_scalef32_pk_fp4_f32(u, 5.2f, -4.9f, 1.0f, 2); u = __builtin_amdgcn_cvt_scalef32_pk_fp4_f32(u, 1.3f, 0.8f, 1.0f, 3);
    const f32x2 a = __builtin_amdgcn_cvt_scalef32_pk_f32_fp4(t, 1.0f, 0), b = __builtin_amdgcn_cvt_scalef32_pk_f32_fp4(t, 1.0f, 1);
    const f32x2 c = __builtin_amdgcn_cvt_scalef32_pk_f32_fp4(t, 1.0f, 2), d = __builtin_amdgcn_cvt_scalef32_pk_f32_fp4(t, 1.0f, 3);
    const f32x2 e = __builtin_amdgcn_cvt_scalef32_pk_f32_fp4(u, 1.0f, 0), f = __builtin_amdgcn_cvt_scalef32_pk_f32_fp4(u, 1.0f, 1);
    const f32x2 g = __builtin_amdgcn_cvt_scalef32_pk_f32_fp4(u, 1.0f, 2), h = __builtin_amdgcn_cvt_scalef32_pk_f32_fp4(u, 1.0f, 3);
    return a.x == 0.f && a.y == 0.5f && b.x == 1.f && b.y == -1.5f && c.x == 2.f && c.y == 3.f && d.x == -4.f && d.y == 6.f
        && e.x == 0.f && e.y == 0.5f && f.x == 2.f && f.y == -3.f && g.x == 6.f && g.y == -4.f && h.x == 1.5f && h.y == 1.f;
}
__device__ __forceinline__ void table_row2_i4(const float* src, unsigned* dst, float* inv_scale, int lane) {
    f32x4 v[2][8]; float mx[2] = {0.f, 0.f};
#pragma unroll
    for (int r = 0; r < 2; ++r)
#pragma unroll
        for (int j = 0; j < 8; ++j) v[r][j] = ((const f32x4*)(src + (size_t)r * DM))[64 * j + lane];
#pragma unroll
    for (int r = 0; r < 2; ++r) {
#pragma unroll
        for (int j = 0; j < 8; ++j) mx[r] = fmaxf(mx[r], fmaxf(fmaxf(fabsf(v[r][j].x), fabsf(v[r][j].y)), fmaxf(fabsf(v[r][j].z), fabsf(v[r][j].w))));
#pragma unroll
        for (int o = 1; o < 64; o <<= 1) mx[r] = fmaxf(mx[r], __shfl_xor(mx[r], o));
        const float sc = mx[r] > 0.f ? mx[r] * 0.1f : 1.f, isc = 1.f / sc;
        unsigned short* drow = (unsigned short*)(dst + (size_t)r * 256);
#pragma unroll
        for (int j = 0; j < 8; ++j) { const f32x4 q4 = v[r][j];
            const int q0 = (int)fminf(fmaxf(rintf(q4.x * isc), -7.f), 7.f), q1 = (int)fminf(fmaxf(rintf(q4.y * isc), -7.f), 7.f);
            const int q2 = (int)fminf(fmaxf(rintf(q4.z * isc), -7.f), 7.f), q3 = (int)fminf(fmaxf(rintf(q4.w * isc), -7.f), 7.f);
            drow[64 * j + lane] = (unsigned short)((q0 & 15) | ((q1 & 15) << 4) | ((q2 & 15) << 8) | ((q3 & 15) << 12)); }
        if (lane == 0) inv_scale[r] = sc;
    }
}
__device__ __forceinline__ void table_row2(const float* src, unsigned* dst, float* inv_scale, int lane) {
    if (!fp4_hw_encoder_ok()) { table_row_sw(src, dst, inv_scale, lane); table_row_sw(src + DM, dst + 256, inv_scale + 1, lane); return; }
    f32x4 v[2][8]; float mx[2] = {0.f, 0.f};
#pragma unroll
    for (int r = 0; r < 2; ++r)
#pragma unroll
        for (int j = 0; j < 8; ++j) v[r][j] = ((const f32x4*)(src + (size_t)r * DM))[64 * j + lane];
#pragma unroll
    for (int r = 0; r < 2; ++r) {
#pragma unroll
        for (int j = 0; j < 8; ++j) mx[r] = fmaxf(mx[r], fmaxf(fmaxf(fabsf(v[r][j].x), fabsf(v[r][j].y)), fmaxf(fabsf(v[r][j].z), fabsf(v[r][j].w))));
#pragma unroll
        for (int o = 1; o < 64; o <<= 1) mx[r] = fmaxf(mx[r], __shfl_xor(mx[r], o));
        const float sc = mx[r] > 0.f ? mx[r] * (0.85f / 6.f) : 1.f, isc = 1.f / sc;
        unsigned short* drow = (unsigned short*)(dst + (size_t)r * 256);
#pragma unroll
        for (int j = 0; j < 8; ++j) { const f32x4 q4 = v[r][j];
            const float y0 = fminf(fmaxf(q4.x * isc, -6.f), 6.f), y1 = fminf(fmaxf(q4.y * isc, -6.f), 6.f), y2 = fminf(fmaxf(q4.z * isc, -6.f), 6.f), y3 = fminf(fmaxf(q4.w * isc, -6.f), 6.f);
            unsigned acc = __builtin_amdgcn_cvt_scalef32_pk_fp4_f32(0u, y0, y1, 1.0f, 0);
            acc = __builtin_amdgcn_cvt_scalef32_pk_fp4_f32(acc, y2, y3, 1.0f, 1);
            drow[64 * j + lane] = (unsigned short)(acc & 0xffffu); }
        if (lane == 0) inv_scale[r] = sc;
    }
}
#ifndef PEER_FAST_REDUCE
#define PEER_FAST_REDUCE 1
#endif
__device__ __forceinline__ float dpp_ror_add(float t, int) { return t; }
#define FP4_BYTE(d, j) __builtin_amdgcn_cvt_scalef32_pk_f32_fp4((d), 1.0f, (j))
__device__ __forceinline__ float dot_row(const v4u& a, const unsigned (&xh)[4], const unsigned (&xl)[4], float sh, float sl) {
    int hi = 0, lo = 0;
    hi = __builtin_amdgcn_sdot8((int)a.x, (int)xh[0], hi, false); lo = __builtin_amdgcn_sdot8((int)a.x, (int)xl[0], lo, false);
    hi = __builtin_amdgcn_sdot8((int)a.y, (int)xh[1], hi, false); lo = __builtin_amdgcn_sdot8((int)a.y, (int)xl[1], lo, false);
    hi = __builtin_amdgcn_sdot8((int)a.z, (int)xh[2], hi, false); lo = __builtin_amdgcn_sdot8((int)a.z, (int)xl[2], lo, false);
    hi = __builtin_amdgcn_sdot8((int)a.w, (int)xh[3], hi, false); lo = __builtin_amdgcn_sdot8((int)a.w, (int)xl[3], lo, false);
    return (float)hi * sh + (float)lo * sl;
}
__device__ __forceinline__ void axpy_row(const v4u& a, float wgt, float (&y)[32]) {
#pragma unroll
    for (int w = 0; w < 4; ++w) { const unsigned d = (w == 0) ? a.x : (w == 1) ? a.y : (w == 2) ? a.z : a.w;
        const f32x2 f0 = FP4_BYTE(d, 0), f1 = FP4_BYTE(d, 1), f2 = FP4_BYTE(d, 2), f3 = FP4_BYTE(d, 3);
        y[8 * w] += wgt * f0.x; y[8 * w + 1] += wgt * f0.y; y[8 * w + 2] += wgt * f1.x; y[8 * w + 3] += wgt * f1.y;
        y[8 * w + 4] += wgt * f2.x; y[8 * w + 5] += wgt * f2.y; y[8 * w + 6] += wgt * f3.x; y[8 * w + 7] += wgt * f3.y; }
}
#define DPP_ROR_MAX(t, n) fmaxf((t), __uint_as_float(__builtin_amdgcn_update_dpp(0u, __float_as_uint(t), 0x120 + (n), 0xf, 0xf, false)))
#define CSWAP(a, b) do { const float hi_ = fmaxf(a, b), lo_ = fminf(a, b); a = hi_; b = lo_; } while (0)
__device__ __forceinline__ void topk_token_fast(const float* __restrict__ srow, int lane, const float* inv_su, const float* inv_sv,
                                                LAS int* se, LAS float* sa, LAS float* sb) {
    const int l16 = lane & 15, row = lane >> 4;
    float R[4];
#pragma unroll
    for (int ps = 0; ps < 4; ++ps) {
        const f32x4 v0 = *(const f32x4*)(srow + (4 * ps + row) * 128 + 8 * l16), v1 = *(const f32x4*)(srow + (4 * ps + row) * 128 + 8 * l16 + 4);
        float k[8];
        k[0] = v0.x; k[1] = v0.y; k[2] = v0.z; k[3] = v0.w; k[4] = v1.x; k[5] = v1.y; k[6] = v1.z; k[7] = v1.w;
#pragma unroll
        for (int i = 0; i < 8; ++i) k[i] = __uint_as_float((__float_as_uint(k[i]) & 0xFFFFFF80u) | (unsigned)(8 * l16 + i));
        CSWAP(k[0], k[1]); CSWAP(k[2], k[3]); CSWAP(k[4], k[5]); CSWAP(k[6], k[7]);
        CSWAP(k[0], k[2]); CSWAP(k[1], k[3]); CSWAP(k[4], k[6]); CSWAP(k[5], k[7]);
        CSWAP(k[1], k[2]); CSWAP(k[5], k[6]);
        CSWAP(k[0], k[4]); CSWAP(k[1], k[5]); CSWAP(k[2], k[6]); CSWAP(k[3], k[7]);
        CSWAP(k[2], k[4]); CSWAP(k[3], k[5]);
        CSWAP(k[1], k[2]); CSWAP(k[3], k[4]); CSWAP(k[5], k[6]);
        float res = 0.f;
#pragma unroll
        for (int it = 0; it < 16; ++it) {
            float m = k[0];
            m = DPP_ROR_MAX(m, 8); m = DPP_ROR_MAX(m, 4); m = DPP_ROR_MAX(m, 2); m = DPP_ROR_MAX(m, 1);
            const bool own = (k[0] == m);
#pragma unroll
            for (int i = 0; i < 7; ++i) k[i] = own ? k[i + 1] : k[i];
            k[7] = own ? -INFINITY : k[7];
            res = (l16 == it) ? m : res;
        }
        R[ps] = res;
    }
#pragma unroll
    for (int g = 0; g < 2; ++g) {
        const auto sw = __builtin_amdgcn_permlane16_swap(__float_as_uint(R[2 * g]), __float_as_uint(R[2 * g + 1]), false, false);
        const float X = __uint_as_float(sw[0]), Y = __uint_as_float(sw[1]);
        const float a = __uint_as_float(__float_as_uint(X) & 0xFFFFFF80u);
        int j = 0;
        float v2 = __shfl(Y, (lane & 48));
        float best = 0.f;
#pragma unroll
        for (int it = 0; it < 16; ++it) {
            const float sum = a + __uint_as_float(__float_as_uint(v2) & 0xFFFFFF80u);
            const float cand = (j < 16) ? __uint_as_float((__float_as_uint(sum) & 0xFFFFFF00u) | (unsigned)((l16 << 4) | (j & 15))) : -INFINITY;
            float m = cand;
            m = DPP_ROR_MAX(m, 8); m = DPP_ROR_MAX(m, 4); m = DPP_ROR_MAX(m, 2); m = DPP_ROR_MAX(m, 1);
            best = (l16 == it) ? m : best;
            if (it < 15) { j += (cand == m) ? 1 : 0; v2 = __shfl(Y, (lane & 48) + (j & 15)); }
        }
        const unsigned bb = __float_as_uint(best);
        const int bi = (bb >> 4) & 15, bj = bb & 15;
        const unsigned k1 = __float_as_uint(__shfl(X, (lane & 48) + bi)), k2 = __float_as_uint(__shfl(Y, (lane & 48) + bj));
        const int e = (int)(k1 & 127u) * 128 + (int)(k2 & 127u);
        const float bv = __uint_as_float(bb & 0xFFFFFF00u);
        float mx = bv; mx = DPP_ROR_MAX(mx, 8); mx = DPP_ROR_MAX(mx, 4); mx = DPP_ROR_MAX(mx, 2); mx = DPP_ROR_MAX(mx, 1);
        const float ex = __expf(bv - mx);
        float sm = ex; sm = DPP_ROR_ADD(sm, 8); sm = DPP_ROR_ADD(sm, 4); sm = DPP_ROR_ADD(sm, 2); sm = DPP_ROR_ADD(sm, 1);
        const float gate = ex / sm;
        const int head = 4 * g + ((row & 1) * 2 + (row >> 1));
        se[head * 16 + l16] = e; sa[head * 16 + l16] = inv_su[e]; sb[head * 16 + l16] = gate * inv_sv[e];
    }
}
#define PEER_LOAD(DST, TAB, b) do { _Pragma("unroll") for (int r_ = 0; r_ < 4; ++r_) { const unsigned char* rp_ = (TAB) + (size_t)(unsigned)__builtin_amdgcn_readfirstlane(se[4 * (b) + r_]) * 1024 + 16 * lane; \
        DST[r_] = *(const v4u*)rp_; } } while (0)
__device__ __forceinline__ void peer_token(int t, const float* scores, const bf16_t* hn, const float* hbuf, const unsigned char* U8, const unsigned char* V8,
                                           const float* inv_su, const float* inv_sv, const float* gfin, float* out,
                                           LAS int* se, LAS float* sa, LAS float* sb, int lane_in) {
    int lane = lane_in;
    {
        LAS int* se0 = se + 512; LAS float* sa0 = sa + 512; LAS float* sb0 = sb + 512;
        topk_token_fast(scores + (size_t)t * DM, lane, inv_su, inv_sv, se0, sa0, sb0);
        unsigned a0 = ((unsigned)se0[lane] << 7) | (unsigned)lane, a1 = ((unsigned)se0[lane + 64] << 7) | (unsigned)(lane + 64);
#pragma unroll
        for (int k = 2; k <= 128; k <<= 1) {
#pragma unroll
            for (int j = k >> 1; j > 0; j >>= 1) {
                if (j == 64) { const unsigned lo = a0 < a1 ? a0 : a1, hi = a0 < a1 ? a1 : a0; a0 = lo; a1 = hi; }
                else {
                    const unsigned p0 = (unsigned)__shfl_xor((int)a0, j), p1 = (unsigned)__shfl_xor((int)a1, j);
                    const bool lower = (lane & j) == 0;
                    const bool up0 = (lane & k) == 0, up1 = ((lane + 64) & k) == 0;
                    const unsigned mn0 = a0 < p0 ? a0 : p0, mx0 = a0 < p0 ? p0 : a0, mn1 = a1 < p1 ? a1 : p1, mx1 = a1 < p1 ? p1 : a1;
                    a0 = (up0 == lower) ? mn0 : mx0; a1 = (up1 == lower) ? mn1 : mx1;
                }
            }
        }
        const int k0 = a0 & 127, k1 = a1 & 127;
        se[lane] = (int)(a0 >> 7); sa[lane] = sa0[k0]; sb[lane] = sb0[k0];
        se[lane + 64] = (int)(a1 >> 7); sa[lane + 64] = sa0[k1]; sb[lane + 64] = sb0[k1];
    }
    asm volatile("" : "+v"(lane));
    float y[32];
    unsigned xh[4], xl[4]; float sh, sl;
    {
        float xf[32]; float mx = 0.f;
#pragma unroll
        for (int j = 0; j < 4; ++j) {
            const v4u h0 = *(const v4u*)(hn + (size_t)t * DM + 32 * lane + 8 * j);
#pragma unroll
            for (int w = 0; w < 4; ++w) { const unsigned d0 = (w == 0) ? h0.x : (w == 1) ? h0.y : (w == 2) ? h0.z : h0.w;
                xf[8 * j + 2 * w] = __uint_as_float(d0 << 16); xf[8 * j + 2 * w + 1] = __uint_as_float(d0 & 0xffff0000u);
                mx = fmaxf(mx, fmaxf(fabsf(xf[8 * j + 2 * w]), fabsf(xf[8 * j + 2 * w + 1]))); }
        }
#pragma unroll
        for (int o = 1; o < 64; o <<= 1) mx = fmaxf(mx, __shfl_xor(mx, o));
        sh = mx > 0.f ? mx * (1.f / 7.f) : 1.f; sl = sh * (1.f / 14.f);
        const float ish = 1.f / sh, isl = 1.f / sl;
#pragma unroll
        for (int w = 0; w < 4; ++w) { unsigned ph = 0u, pl = 0u;
#pragma unroll
            for (int i = 0; i < 8; ++i) { const float xe = xf[8 * w + i];
                const float qh = fminf(fmaxf(rintf(xe * ish), -7.f), 7.f);
                const float ql = fminf(fmaxf(rintf((xe - qh * sh) * isl), -7.f), 7.f);
                ph |= ((unsigned)(int)qh & 15u) << (4 * i); pl |= ((unsigned)(int)ql & 15u) << (4 * i); }
            xh[w] = ph; xl[w] = pl; }
    }
#pragma unroll
    for (int i = 0; i < 32; ++i) y[i] = 0.f;
    v4u Ua[4], Ub[4], Va[4];
#define PEER_BATCH(b, UC, VC) do { \
        PEER_LOAD(VC, V8, (b)); \
        float pr[4]; \
        _Pragma("unroll") for (int r = 0; r < 4; ++r) pr[r] = dot_row(UC[r], xh, xl, sh, sl); \
        if ((b) + 2 < 32) PEER_LOAD(UC, U8, (b) + 2); \
        float wr_[4], q2[2]; \
        _Pragma("unroll") for (int r = 0; r < 2; ++r) { auto sw = __builtin_amdgcn_permlane32_swap(__float_as_uint(pr[r]), __float_as_uint(pr[r + 2]), false, false); q2[r] = __uint_as_float(sw[0]) + __uint_as_float(sw[1]); } \
        float tv; \
        { auto sw = __builtin_amdgcn_permlane16_swap(__float_as_uint(q2[0]), __float_as_uint(q2[1]), false, false); tv = __uint_as_float(sw[0]) + __uint_as_float(sw[1]); } \
        tv = DPP_ROR_ADD(tv, 8); tv = DPP_ROR_ADD(tv, 4); tv = DPP_ROR_ADD(tv, 2); tv = DPP_ROR_ADD(tv, 1); \
        const int k = 4 * (b) + (lane >> 4);     \
        const float wc = gelu_erf(tv * sa[k]) * sb[k]; \
        _Pragma("unroll") for (int r = 0; r < 4; ++r) wr_[r] = __uint_as_float(__builtin_amdgcn_readlane(__float_as_uint(wc), 16 * r)); \
        _Pragma("unroll") for (int r = 0; r < 4; ++r) axpy_row(VC[r], wr_[r], y); } while (0)
    PEER_LOAD(Ua, U8, 0); PEER_LOAD(Ub, U8, 1);
#pragma unroll 1
    for (int b = 0; b < 32; b += 2) { PEER_BATCH(b, Ua, Va); PEER_BATCH(b + 1, Ub, Va); }
    float ss = 0.f;
#pragma unroll
    for (int j = 0; j < 8; ++j) { const f32x4 hv = *(const f32x4*)(hbuf + (size_t)t * DM + 32 * lane + 4 * j);
        y[4 * j] += hv.x; y[4 * j + 1] += hv.y; y[4 * j + 2] += hv.z; y[4 * j + 3] += hv.w;
        ss += (y[4 * j] * y[4 * j] + y[4 * j + 1] * y[4 * j + 1]) + (y[4 * j + 2] * y[4 * j + 2] + y[4 * j + 3] * y[4 * j + 3]); }
    ss = wave_sum(ss);
    const float rstd = rsqrtf(ss * (1.f / DM) + EPS);
#pragma unroll
    for (int j = 0; j < 8; ++j) { const f32x4 gg = *(const f32x4*)(gfin + 32 * lane + 4 * j);
        f32x4 o; o.x = y[4 * j] * rstd * gg.x; o.y = y[4 * j + 1] * rstd * gg.y; o.z = y[4 * j + 2] * rstd * gg.z; o.w = y[4 * j + 3] * rstd * gg.w;
        *(f32x4*)(out + (size_t)t * DM + 32 * lane + 4 * j) = o; }
}
typedef short bf16x8 __attribute__((ext_vector_type(8)));
__device__ __forceinline__ int pos32(int x) { const int g = x & ~31, l = x & 31; return g + 8 * ((l & 15) >> 2) + 4 * (l >> 4) + (l & 3); }
constexpr size_t PB_H_QG = 0, PB_H_KDT = 32 * MiB, PB_H_A = 64 * MiB;
constexpr size_t PB_G_QS = 80 * MiB, PB_G_KT = 96 * MiB;
constexpr size_t PB_G_W = 112 * MiB, PB_G_A = 144 * MiB, PB_G_U = 160 * MiB;
constexpr int CA = 96;
constexpr int PROG_WORD = 3584;
constexpr int NSB = 128, CPW = 4;
constexpr int SC_QG = 0, SC_WV = 16384, SC_KDT = 32768, SC_A = 49152, SC_BUF = 57344, SC_VEC = 2 * SC_BUF, SC_OT = SC_VEC + 2048, SC_OTB = 17408, SC_GAIN = SC_OT + 2 * SC_OTB;

__device__ __forceinline__ bf16x8 pack_frag(const f32x4& x0, const f32x4& x1) {
    v4u w; w.x = pk2(x0.x, x0.y); w.y = pk2(x0.z, x0.w); w.z = pk2(x1.x, x1.y); w.w = pk2(x1.z, x1.w);
    return __builtin_bit_cast(bf16x8, w);
}
#define MFMA16(a, b, c) __builtin_amdgcn_mfma_f32_16x16x32_bf16((a), (b), (c), 0, 0, 0)

__device__ __forceinline__ void hgrn_prep_item(int item, const bf16_t* proj, const float* lb_logits, unsigned char* pb, float* vecs, LAS unsigned char* lds, int tid) {
    const int c = item & 127, sq = item >> 7, b = sq >> 3, h = sq & 7, t0 = b * SEQ + c * 64;
    const int d = tid & 127, seg = tid >> 7, lane = tid & 63, wave = tid >> 6;
    LAS bf16_t* QGl = (LAS bf16_t*)lds; LAS bf16_t* KGl = (LAS bf16_t*)(lds + 17408); LAS float* segsum = (LAS float*)(lds + 34816);
    bf16_t* gQG = (bf16_t*)(pb + PB_H_QG) + (size_t)item * 8192;
    bf16_t* gKDT = (bf16_t*)(pb + PB_H_KDT) + (size_t)item * 8192;
    bf16_t* gA = (bf16_t*)(pb + PB_H_A) + (size_t)item * 4096;
    float* gvec = vecs + (size_t)item * 256;
    const float l0 = lb_logits[h * 128 + d], l1 = lb_logits[1024 + h * 128 + d];
    const float lb = 1.f / (1.f + __expf(l1 - l0));
    float lf[16], qv[16], kv[16];
#pragma unroll
    for (int i = 0; i < 16; ++i) {
        const bf16_t* pr = proj + (size_t)(t0 + 16 * seg + i) * NPROJ + h * 128 + d;
        const float z = bf2f(pr[C_AF]); qv[i] = bf2f(pr[C_AQ]);
        const float f = lb + (1.f - lb) * sigmoidf_(z);
        lf[i] = __logf(f); kv[i] = 1.f - f;
    }
    float run = 0.f;
#pragma unroll
    for (int i = 0; i < 16; ++i) { run += lf[i]; lf[i] = run; }
    segsum[seg * 128 + d] = run;
    __syncthreads();
    float off = 0.f, bl = 0.f;
#pragma unroll
    for (int s = 0; s < 4; ++s) { const float v = segsum[s * 128 + d]; bl += v; if (s < seg) off += v; }
    const int pd = pos32(d);
    float kd[16];
#pragma unroll
    for (int i = 0; i < 16; ++i) {
        const float bc = lf[i] + off; const int tl = 16 * seg + i;
        const float qg = qv[i] * __expf(bc), kg = kv[i] * __expf(-bc);
        kd[i] = kv[i] * __expf(bl - bc);
        const bf16_t qb = f2bf(qg);
        QGl[tl * 136 + d] = qb; KGl[tl * 136 + d] = f2bf(kg);
        gQG[tl * 128 + pd] = qb;
    }
#pragma unroll
    for (int ii = 0; ii < 4; ++ii) { v2u o; o.x = pk2(kd[4 * ii], kd[4 * ii + 1]); o.y = pk2(kd[4 * ii + 2], kd[4 * ii + 3]);
        *(v2u*)(gKDT + d * 64 + 32 * (seg >> 1) + 8 * ii + 4 * (seg & 1)) = o; }
    if (seg == 0) gvec[128 + d] = __expf(bl);
    __syncthreads();
    const int n = lane & 15, q = lane >> 4;
#pragma unroll
    for (int ti = 0; ti < 2; ++ti) {
        const int id = wave + 8 * ti, mt = id >> 2, ns = id & 3;
        f32x4 acc = {0.f, 0.f, 0.f, 0.f};
        if (ns <= mt) {
#pragma unroll
            for (int s4 = 0; s4 < 4; ++s4) {
                const bf16x8 a = *(const LAS bf16x8*)(QGl + (16 * mt + n) * 136 + 32 * s4 + 8 * q);
                const bf16x8 bb = *(const LAS bf16x8*)(KGl + (16 * ns + n) * 136 + 32 * s4 + 8 * q);
                acc = MFMA16(a, bb, acc);
            }
        }
        const int s = 16 * ns + n, ps = pos32(s);
#pragma unroll
        for (int r = 0; r < 4; ++r) { const int t = 16 * mt + 4 * q + r; const float v = (r == 0) ? acc.x : (r == 1) ? acc.y : (r == 2) ? acc.z : acc.w;
            gA[t * 64 + ps] = f2bf((s <= t) ? v : 0.f); }
    }
    __syncthreads();
}

constexpr int GP_QF = 0, GP_KF = 33024, GP_N = 0, GP_QB = 66048, GP_KB = 83456, GP_VB = 100864, GP_PART = 135680, GP_SB = 137728;
__device__ __forceinline__ void gdn_prep_item(int item, const bf16_t* proj, const float* ba, const float* conv_w, const float* A_log, const float* dt_bias,
                                              unsigned char* pb, float* vecs, LAS unsigned char* lds, int tid) {
    const int c = item & 127, bq = item >> 7, b = bq >> 2, qh = bq & 3, t0 = b * SEQ + c * 64;
    const int lane = tid & 63, wave = tid >> 6;
    LAS float* QF = (LAS float*)(lds + GP_QF); LAS float* KF = (LAS float*)(lds + GP_KF);
    LAS bf16_t* QB = (LAS bf16_t*)(lds + GP_QB); LAS bf16_t* KB = (LAS bf16_t*)(lds + GP_KB); LAS bf16_t* VB = (LAS bf16_t*)(lds + GP_VB);
    LAS float* PART = (LAS float*)(lds + GP_PART); LAS float* SBETA = (LAS float*)(lds + GP_SB); LAS float* SGC = SBETA + 128;
    LAS float* NM = (LAS float*)(lds + GP_N);
    {
        int col, wch; const int dd = tid & 127;
        if (tid < 128) { col = C_BQ + qh * 128 + dd; wch = qh * 128 + dd; }
        else if (tid < 256) { col = C_BK + qh * 128 + dd; wch = 512 + qh * 128 + dd; }
        else { const int vh = 2 * qh + ((tid - 256) >> 7); col = C_BV + vh * 128 + dd; wch = 1024 + vh * 128 + dd; }
        const float w0 = conv_w[wch], w1 = conv_w[2048 + wch], w2 = conv_w[4096 + wch], w3 = conv_w[6144 + wch];
        float h0 = 0.f, h1 = 0.f, h2 = 0.f;
        const bf16_t* pr = proj + (size_t)t0 * NPROJ + col;
        if (c > 0) { h0 = bf2f(pr[-3 * NPROJ]); h1 = bf2f(pr[-2 * NPROJ]); h2 = bf2f(pr[-1 * NPROJ]); }
        unsigned xr[64];
#pragma unroll
        for (int t = 0; t < 64; ++t) xr[t] = pr[(size_t)t * NPROJ];
#pragma unroll
        for (int t = 0; t < 64; ++t) {
            const float xx = __uint_as_float(xr[t] << 16);
            const float yv = siluf_(w0 * h0 + w1 * h1 + w2 * h2 + w3 * xx);
            h0 = h1; h1 = h2; h2 = xx;
            if (tid < 128) QF[t * 129 + dd] = yv;
            else if (tid < 256) KF[t * 129 + dd] = yv;
            else VB[((tid - 256) >> 7) * 8704 + t * 136 + dd] = f2bf(yv);
        }
    }
    __syncthreads();
    {
        const int t = tid & 63, part = tid >> 6, which = part >> 2, sub = part & 3;
        const LAS float* src = (which ? KF : QF) + t * 129 + 32 * sub;
        float s = 0.f;
#pragma unroll
        for (int i = 0; i < 32; ++i) s += src[i] * src[i];
        PART[(which * 4 + sub) * 64 + t] = s;
    }
    if (wave < 2) {
        const int vh = 2 * qh + wave;
        const float ax = ba[(size_t)(t0 + lane) * 16 + 8 + vh] + dt_bias[vh];
        const float sp = ax > 20.f ? ax : log1pf(__expf(ax));
        float gc = -__expf(A_log[vh]) * sp;
#pragma unroll
        for (int o = 1; o < 64; o <<= 1) { const float up = __shfl_up(gc, o); if (lane >= o) gc += up; }
        const float gl = __shfl(gc, 63);
        const float beta = sigmoidf_(ba[(size_t)(t0 + lane) * 16 + vh]);
        SBETA[wave * 64 + lane] = beta; SGC[wave * 64 + lane] = gc;
        float* gvec = vecs + ((size_t)(16 + b * 8 + vh) * 128 + c) * 256;
        gvec[lane] = __expf(gc); gvec[64 + lane] = __expf(gl - gc);
        const float dl = __expf(gl); gvec[128 + lane] = dl; gvec[192 + lane] = dl;
    }
    __syncthreads();
    {
        const int d = tid & 127, seg = tid >> 7, pd = pos32(d);
        bf16_t* gQS = (bf16_t*)(pb + PB_G_QS) + (size_t)item * 8192;
        bf16_t* gKT = (bf16_t*)(pb + PB_G_KT) + (size_t)item * 8192;
        float kk[16];
#pragma unroll
        for (int i = 0; i < 16; ++i) {
            const int tl = 16 * seg + i;
            const float sq = PART[0 * 64 + tl] + PART[1 * 64 + tl] + PART[2 * 64 + tl] + PART[3 * 64 + tl];
            const float sk = PART[4 * 64 + tl] + PART[5 * 64 + tl] + PART[6 * 64 + tl] + PART[7 * 64 + tl];
            const bf16_t qb = f2bf(QF[tl * 129 + d] * rsqrtf(sq + EPS) * 0.08838834764831845f);
            const bf16_t kb = f2bf(KF[tl * 129 + d] * rsqrtf(sk + EPS));
            QB[tl * 136 + d] = qb; KB[tl * 136 + d] = kb; gQS[tl * 128 + pd] = qb; kk[i] = bf2f(kb);
        }
#pragma unroll
        for (int ii = 0; ii < 4; ++ii) { v2u o; o.x = pk2(kk[4 * ii], kk[4 * ii + 1]); o.y = pk2(kk[4 * ii + 2], kk[4 * ii + 3]);
            *(v2u*)(gKT + d * 64 + 32 * (seg >> 1) + 8 * ii + 4 * (seg & 1)) = o; }
    }
    __syncthreads();
    {
        const int n = lane & 15, q = lane >> 4;
#pragma unroll
        for (int ti = 0; ti < 2; ++ti) {
            const int id = 2 * wave + ti, mt = id >> 2, ns = id & 3;
            f32x4 akk = {0.f, 0.f, 0.f, 0.f}, aqk = {0.f, 0.f, 0.f, 0.f};
            if (ns <= mt) {
#pragma unroll
                for (int s4 = 0; s4 < 4; ++s4) {
                    const bf16x8 kb_ = *(const LAS bf16x8*)(KB + (16 * ns + n) * 136 + 32 * s4 + 8 * q);
                    const bf16x8 ka_ = *(const LAS bf16x8*)(KB + (16 * mt + n) * 136 + 32 * s4 + 8 * q);
                    const bf16x8 qa_ = *(const LAS bf16x8*)(QB + (16 * mt + n) * 136 + 32 * s4 + 8 * q);
                    akk = MFMA16(ka_, kb_, akk); aqk = MFMA16(qa_, kb_, aqk);
                }
            }
            const int s = 16 * ns + n, ps = pos32(s);
#pragma unroll
            for (int vl = 0; vl < 2; ++vl) {
                bf16_t* gA = (bf16_t*)(pb + PB_G_A) + ((size_t)((b * 8 + 2 * qh + vl) * 128 + c)) * 4096;
                const float gcs = SGC[vl * 64 + s];
#pragma unroll
                for (int r = 0; r < 4; ++r) {
                    const int t = 16 * mt + 4 * q + r;
                    const float vk = (r == 0) ? akk.x : (r == 1) ? akk.y : (r == 2) ? akk.z : akk.w;
                    const float vq = (r == 0) ? aqk.x : (r == 1) ? aqk.y : (r == 2) ? aqk.z : aqk.w;
                    const float ex = (s <= t) ? __expf(SGC[vl * 64 + t] - gcs) : 0.f;
                    NM[vl * 4096 + t * 64 + s] = (s < t) ? SBETA[vl * 64 + t] * vk * ex : 0.f;
                    gA[t * 64 + ps] = f2bf((s <= t) ? vq * ex : 0.f);
                }
            }
        }
    }
    __syncthreads();
    {
        const int vl = tid >> 8, colx = tid & 255;
        float x[64];
        if (colx < 128) {
#pragma unroll
            for (int t = 0; t < 64; ++t) x[t] = SBETA[vl * 64 + t] * bf2f(VB[vl * 8704 + t * 136 + colx]);
        } else {
#pragma unroll
            for (int t = 0; t < 64; ++t) x[t] = SBETA[vl * 64 + t] * __expf(SGC[vl * 64 + t]) * bf2f(KB[t * 136 + colx - 128]);
        }
        __syncthreads();
        const LAS float* Nv = NM + vl * 4096;
#pragma unroll
        for (int t = 1; t < 64; ++t) {
            float acc = x[t];
#pragma unroll
            for (int s4 = 0; s4 < (t + 3) / 4; ++s4) {
                const f32x4 nn = *(const LAS f32x4*)(Nv + t * 64 + 4 * s4);
                acc -= nn.x * x[4 * s4]; if (4 * s4 + 1 < t) acc -= nn.y * x[4 * s4 + 1]; if (4 * s4 + 2 < t) acc -= nn.z * x[4 * s4 + 2]; if (4 * s4 + 3 < t) acc -= nn.w * x[4 * s4 + 3];
            }
            x[t] = acc;
        }
        if (colx < 128) {
            bf16_t* gU = (bf16_t*)(pb + PB_G_U) + ((size_t)((b * 8 + 2 * qh + vl) * 128 + c)) * 8192;
            const int sl = colx >> 4, n = colx & 15;
#pragma unroll
            for (int mt = 0; mt < 4; ++mt)
#pragma unroll
                for (int q = 0; q < 4; ++q) { v2u o; o.x = pk2(x[16 * mt + 4 * q], x[16 * mt + 4 * q + 1]); o.y = pk2(x[16 * mt + 4 * q + 2], x[16 * mt + 4 * q + 3]);
                    *(v2u*)(gU + ((size_t)((sl * 4 + mt) * 64 + q * 16 + n)) * 4) = o; }
        } else {
            LAS bf16_t* WS = (LAS bf16_t*)(lds + GP_QB) + vl * 8704;
            const int pd = pos32(colx - 128);
#pragma unroll
            for (int t = 0; t < 64; ++t) WS[t * 136 + pd] = f2bf(-x[t]);
        }
    }
    __syncthreads();
    {
#pragma unroll
        for (int i = 0; i < 4; ++i) { const int p = tid + 512 * i, vl = p >> 10, row = (p >> 4) & 63, c16 = p & 15;
            bf16_t* gW = (bf16_t*)(pb + PB_G_W) + ((size_t)((b * 8 + 2 * qh + vl) * 128 + c)) * 8192;
            *(v4u*)(gW + row * 128 + c16 * 8) = *(const LAS v4u*)(lds + GP_QB + vl * 17408 + row * 272 + c16 * 16); }
    }
    __syncthreads();
}

struct ScanSrc { const unsigned char* qg; const unsigned char* wv; const unsigned char* kdt; const unsigned char* a; const float* vec; size_t wv_row; };
__device__ __forceinline__ void scan_dma(const ScanSrc& S, LAS unsigned char* buf, LAS unsigned char* vecb, int w, int lane) {
#pragma unroll
    for (int i = 0; i < 2; ++i) { const int pi = 2 * w + i, row = 4 * pi + (lane >> 4), cl = (lane & 15) ^ (row & 15);
        __builtin_amdgcn_global_load_lds((const unsigned*)(S.qg + row * 256 + cl * 16), (LAS unsigned*)(buf + SC_QG + pi * 1024), 16, 0, 0);
        __builtin_amdgcn_global_load_lds((const unsigned*)(S.wv + (size_t)row * S.wv_row + cl * 16), (LAS unsigned*)(buf + SC_WV + pi * 1024), 16, 0, 0); }
#pragma unroll
    for (int i = 0; i < 2; ++i) { const int pi = 2 * w + i, row = 8 * pi + (lane >> 3), cl = (lane & 7) ^ ((row >> 1) & 7);
        __builtin_amdgcn_global_load_lds((const unsigned*)(S.kdt + row * 128 + cl * 16), (LAS unsigned*)(buf + SC_KDT + pi * 1024), 16, 0, 0); }
    { const int pi = w, row = 8 * pi + (lane >> 3), cl = (lane & 7) ^ ((row >> 1) & 7);
        __builtin_amdgcn_global_load_lds((const unsigned*)(S.a + row * 128 + cl * 16), (LAS unsigned*)(buf + SC_A + pi * 1024), 16, 0, 0); }
    if (w == 0) __builtin_amdgcn_global_load_lds((const unsigned*)((const unsigned char*)S.vec + lane * 16), (LAS unsigned*)vecb, 16, 0, 0);
}
template <bool GDN>
__device__ __forceinline__ void scan_block(int sq, int g, const bf16_t* proj, const unsigned char* pb, const float* vecs, const float* hgrn_g, const float* gdn_g,
                                           bf16_t* mix, unsigned* prog, int nfb, LAS unsigned char* lds, int tid) {
    constexpr bool gdn = GDN;
    const int b = (sq & 15) >> 3, hh = sq & 7, lane = tid & 63, sl = __builtin_amdgcn_readfirstlane(tid >> 6), n = lane & 15, q = lane >> 4;
    const unsigned char* bQG; const unsigned char* bWV; const unsigned char* bKDT; const unsigned char* bA; const unsigned char* bU = nullptr;
    size_t wv_row, wv_chunk; int gate_col, mix_col; const float* gain;
    if (!gdn) {
        const size_t s0 = (size_t)(b * 8 + hh) * 128;
        bQG = pb + PB_H_QG + s0 * 16384; bKDT = pb + PB_H_KDT + s0 * 16384; bA = pb + PB_H_A + s0 * 8192;
        bWV = (const unsigned char*)(proj + (size_t)(b * SEQ) * NPROJ + C_AI + hh * 128); wv_row = (size_t)NPROJ * 2; wv_chunk = (size_t)64 * NPROJ * 2;
        gate_col = C_AG + hh * 128; mix_col = hh * 128; gain = hgrn_g;
    } else {
        const size_t s0 = (size_t)(b * 8 + hh) * 128, q0 = (size_t)(b * 4 + (hh >> 1)) * 128;
        bQG = pb + PB_G_QS + q0 * 16384; bKDT = pb + PB_G_KT + q0 * 16384; bA = pb + PB_G_A + s0 * 8192;
        bWV = pb + PB_G_W + s0 * 16384; wv_row = 256; wv_chunk = 16384; bU = pb + PB_G_U + s0 * 16384;
        gate_col = C_BZ + hh * 128; mix_col = 1024 + hh * 128; gain = gdn_g;
    }
    const float* bvec = vecs + (size_t)sq * 128 * 256;
    LAS float* gainl = (LAS float*)(lds + SC_GAIN);
    const int wave = sl;
    {
        ScanSrc src{bQG, bWV, bKDT, bA, bvec, wv_row};
        scan_dma(src, lds, lds + SC_VEC, wave, lane);
        if (tid < 128) gainl[tid] = gain[tid];
    }
    __builtin_amdgcn_s_waitcnt(0x0070);
    asm volatile("" ::: "memory");
    __builtin_amdgcn_s_barrier();
    asm volatile("" ::: "memory");
#define SCAN_BAR() do { asm volatile("s_waitcnt lgkmcnt(0)" ::: "memory"); __builtin_amdgcn_s_barrier(); asm volatile("" ::: "memory"); } while (0)
#define SCHED_FENCE() __builtin_amdgcn_sched_barrier(0)
    const int sl16 = 2 * g + wave;
    const int hw = (wave == 2) ? 0 : (wave == 3) ? 1 : (wave == 6) ? 2 : (wave == 7) ? 3 : -1;
    if (wave < 2) {
        f32x4 S[8];
        bf16x8 Sf[4];
#pragma unroll
        for (int m = 0; m < 8; ++m) S[m] = (f32x4){0.f, 0.f, 0.f, 0.f};
#pragma unroll
        for (int s4 = 0; s4 < 4; ++s4) Sf[s4] = pack_frag(S[0], S[1]);
        v2u Ureg[4];
#pragma unroll
        for (int mt = 0; mt < 4; ++mt) Ureg[mt] = GDN ? *(const v2u*)(bU + (size_t)(sl16 * 4 + mt) * 512 + lane * 8) : (v2u){0u, 0u};
        for (int c = 0; c < 128; ++c) {
            int lane = tid & 63; asm volatile("" : "+v"(lane));
            const int n = lane & 15, q = lane >> 4;
            const int cur = c & 1;
            LAS unsigned char* buf = lds + cur * SC_BUF;
            const LAS float* vec = (const LAS float*)(lds + SC_VEC + cur * 1024);
            const int cn = (c + 1 < 128) ? c + 1 : 127;
            f32x4 VN[4];
            bf16x8 fa[8], fb[8];
            bf16x8 VNf[2], VNSf[2];
#define SC3_LD8_K128(dst, OFF, mt_) do { _Pragma("unroll") for (int i_ = 0; i_ < 8; ++i_) dst[i_] = *(const LAS bf16x8*)(buf + (OFF) + (16 * ((mt_) + (i_ >> 2)) + n) * 256 + (((4 * (i_ & 3) + q) ^ n) * 16)); } while (0)
#define SC3_LD8_K64(dst, OFF, mb) do { _Pragma("unroll") for (int i_ = 0; i_ < 8; ++i_) dst[i_] = *(const LAS bf16x8*)(buf + (OFF) + (16 * ((mb) + (i_ >> 1)) + n) * 128 + (((4 * (i_ & 1) + q) ^ ((n >> 1) & 7)) * 16)); } while (0)
#define SC3_MM_K128(A0, A1, fr) do { _Pragma("unroll") for (int i_ = 0; i_ < 4; ++i_) { A0 = MFMA16(fr[i_], Sf[i_], A0); A1 = MFMA16(fr[4 + i_], Sf[i_], A1); } } while (0)
#define SC3_MM_K64(X, ma, fr, BF) do { _Pragma("unroll") for (int t_ = 0; t_ < 4; ++t_) { X[(ma) + t_] = MFMA16(fr[2 * t_], BF[0], X[(ma) + t_]); X[(ma) + t_] = MFMA16(fr[2 * t_ + 1], BF[1], X[(ma) + t_]); } } while (0)
#define SC3_DLOAD(m) (*(const LAS f32x4*)(vec + 128 + 16 * (m) + 4 * q))
#define SC3_EGLOAD(mt) (*(const LAS f32x4*)(vec + 16 * (mt) + 4 * q))
#define SC3_PACK_S(s4) do { Sf[s4] = pack_frag(S[2 * (s4)], S[2 * (s4) + 1]); } while (0)
#define SC3_OT_WRITE() do { LAS bf16_t* OT_ = (LAS bf16_t*)(lds + SC_OT + cur * SC_OTB); const int cc_ = 16 * sl16 + n; \
                _Pragma("unroll") for (int mt = 0; mt < 4; ++mt) { \
                    OT_[(16 * mt + 4 * q + 0) * 136 + cc_] = f2bf(O[mt].x); OT_[(16 * mt + 4 * q + 1) * 136 + cc_] = f2bf(O[mt].y); \
                    OT_[(16 * mt + 4 * q + 2) * 136 + cc_] = f2bf(O[mt].z); OT_[(16 * mt + 4 * q + 3) * 136 + cc_] = f2bf(O[mt].w); } } while (0)
            f32x4 dA, dB, dC, dD;
            f32x4 O[4];
            if (GDN) {
#pragma unroll
                for (int mt = 0; mt < 4; ++mt) { const v2u uu = Ureg[mt];
                    VN[mt] = (f32x4){__uint_as_float(uu.x << 16), __uint_as_float(uu.x & 0xffff0000u), __uint_as_float(uu.y << 16), __uint_as_float(uu.y & 0xffff0000u)}; }
                SC3_LD8_K128(fa, SC_WV, 0); SCHED_FENCE();
                SC3_LD8_K128(fb, SC_WV, 2); SCHED_FENCE();
#pragma unroll
                for (int mt = 0; mt < 4; ++mt) Ureg[mt] = *(const v2u*)(bU + (size_t)cn * 16384 + (size_t)(sl16 * 4 + mt) * 512 + lane * 8);
                f32x4 eS[4];
#pragma unroll
                for (int i = 0; i < 4; ++i) eS[i] = *(const LAS f32x4*)(vec + 64 + 16 * i + 4 * q);
                dA = SC3_DLOAD(0); dB = SC3_DLOAD(1); dC = SC3_DLOAD(2); dD = SC3_DLOAD(3);
                SCHED_FENCE();
                SC3_PACK_S(3); SC3_MM_K128(VN[0], VN[1], fa); S[0] = S[0] * dA; S[1] = S[1] * dB; S[2] = S[2] * dC; S[3] = S[3] * dD; SCHED_FENCE();
                SC3_LD8_K128(fa, SC_QG, 0); dA = SC3_DLOAD(4); dB = SC3_DLOAD(5); dC = SC3_DLOAD(6); dD = SC3_DLOAD(7); SCHED_FENCE();
                SC3_MM_K128(VN[2], VN[3], fb); S[4] = S[4] * dA; S[5] = S[5] * dB; S[6] = S[6] * dC; S[7] = S[7] * dD; SCHED_FENCE();
                SC3_LD8_K128(fb, SC_QG, 2); dA = SC3_EGLOAD(0); dB = SC3_EGLOAD(1); SCHED_FENCE();
#pragma unroll
                for (int mt = 0; mt < 4; ++mt) O[mt] = (f32x4){0.f, 0.f, 0.f, 0.f};
                SC3_MM_K128(O[0], O[1], fa);
#pragma unroll
                for (int s2 = 0; s2 < 2; ++s2) { VNf[s2] = pack_frag(VN[2 * s2], VN[2 * s2 + 1]); VNSf[s2] = pack_frag(VN[2 * s2] * eS[2 * s2], VN[2 * s2 + 1] * eS[2 * s2 + 1]); }
                SCHED_FENCE();
                SC3_LD8_K64(fa, SC_A, 0); dC = SC3_EGLOAD(2); dD = SC3_EGLOAD(3); SCHED_FENCE();
                SC3_MM_K128(O[2], O[3], fb); O[0] = O[0] * dA; O[1] = O[1] * dB; SCHED_FENCE();
                SC3_LD8_K64(fb, SC_KDT, 0); SCHED_FENCE();
                O[2] = O[2] * dC; O[3] = O[3] * dD;
            } else {
                SC3_LD8_K128(fa, SC_QG, 0); SCHED_FENCE();
                SC3_LD8_K128(fb, SC_QG, 2); SCHED_FENCE();
#pragma unroll
                for (int s2 = 0; s2 < 2; ++s2) { unsigned w[4];
#pragma unroll
                    for (int jj = 0; jj < 4; ++jj) { const int ja = 2 * jj, jb = 2 * jj + 1; const int cc = 16 * sl16 + n;
                        const int ta = 32 * s2 + ((ja < 4) ? 4 * q + ja : 16 + 4 * q + ja - 4), tb = 32 * s2 + ((jb < 4) ? 4 * q + jb : 16 + 4 * q + jb - 4);
                        const unsigned lo = *(const LAS bf16_t*)(buf + SC_WV + ta * 256 + (((cc >> 3) ^ (ta & 15)) * 16) + (cc & 7) * 2), hi = *(const LAS bf16_t*)(buf + SC_WV + tb * 256 + (((cc >> 3) ^ (tb & 15)) * 16) + (cc & 7) * 2);
                        w[jj] = lo | (hi << 16); }
                    v4u ww; ww.x = w[0]; ww.y = w[1]; ww.z = w[2]; ww.w = w[3];
                    VNf[s2] = __builtin_bit_cast(bf16x8, ww); VNSf[s2] = VNf[s2]; }
                dA = SC3_DLOAD(0); dB = SC3_DLOAD(1); dC = SC3_DLOAD(2); dD = SC3_DLOAD(3);
                SCHED_FENCE();
#pragma unroll
                for (int mt = 0; mt < 4; ++mt) O[mt] = (f32x4){0.f, 0.f, 0.f, 0.f};
                SC3_PACK_S(3); SC3_MM_K128(O[0], O[1], fa); S[0] = S[0] * dA; S[1] = S[1] * dB; S[2] = S[2] * dC; S[3] = S[3] * dD; SCHED_FENCE();
                SC3_LD8_K64(fa, SC_A, 0); dA = SC3_DLOAD(4); dB = SC3_DLOAD(5); dC = SC3_DLOAD(6); dD = SC3_DLOAD(7); SCHED_FENCE();
                SC3_MM_K128(O[2], O[3], fb); S[4] = S[4] * dA; S[5] = S[5] * dB; S[6] = S[6] * dC; S[7] = S[7] * dD; SCHED_FENCE();
                SC3_LD8_K64(fb, SC_KDT, 0); SCHED_FENCE();
            }
            SC3_MM_K64(O, 0, fa, VNf); SCHED_FENCE();
            SC3_LD8_K64(fa, SC_KDT, 4); SCHED_FENCE();
            SC3_MM_K64(S, 0, fb, VNSf); SC3_OT_WRITE(); SCHED_FENCE();
            SC3_MM_K64(S, 4, fa, VNSf); SC3_PACK_S(0); SC3_PACK_S(1); SCHED_FENCE();
            SC3_PACK_S(2);
            SCAN_BAR();
        }
    } else if (wave == CPW) {
        for (int c = 0; c < 128; ++c) {
            SCAN_BAR();
            int lane = tid & 63; asm volatile("" : "+v"(lane));
            const LAS bf16_t* OTn = (const LAS bf16_t*)(lds + SC_OT + (c & 1) * SC_OTB);
#pragma unroll
            for (int ps = 0; ps < 4; ++ps) { const int row = 16 * ps + (lane >> 2), pc = lane & 3, col = 32 * g + 8 * pc;
                    const v4u val = *(const LAS v4u*)(OTn + row * 136 + col);
                    *(v4u*)(mix + (size_t)(b * SEQ + c * 64 + row) * DM + mix_col + col) = val; }
        }
    } else if (hw >= 0) {
        v4u G0[15], G1[15];
#define HLP_LOAD(GX, cn_) do { const unsigned char* sQG = bQG + (size_t)(cn_) * 16384 + (size_t)hw * 4096; const unsigned char* sWV = bWV + (size_t)(cn_) * wv_chunk + (size_t)(16 * hw) * wv_row; \
            const unsigned char* sKDT = bKDT + (size_t)(cn_) * 16384 + (size_t)hw * 4096; const unsigned char* sA = bA + (size_t)(cn_) * 8192 + (size_t)hw * 2048; \
            const unsigned l16 = (unsigned)lane * 16u, offv = (unsigned)(lane >> 4) * (unsigned)wv_row + (unsigned)(lane & 15) * 16u; \
            _Pragma("unroll") for (int i = 0; i < 4; ++i) { GX[i] = *(const v4u*)(sQG + i * 1024 + l16); GX[4 + i] = *(const v4u*)(sWV + (size_t)(4 * i) * wv_row + offv); } \
            _Pragma("unroll") for (int i = 0; i < 4; ++i) GX[8 + i] = *(const v4u*)(sKDT + i * 1024 + l16); \
            _Pragma("unroll") for (int i = 0; i < 2; ++i) GX[12 + i] = *(const v4u*)(sA + i * 1024 + l16); \
            GX[14] = *(const v4u*)((const unsigned char*)(bvec + (size_t)(cn_) * 256) + l16); } while (0)
#define HLP_STORE(GX, bi_) do { LAS unsigned char* nb = lds + (bi_) * SC_BUF + hw * 4096; LAS unsigned char* nv = lds + SC_VEC + (bi_) * 1024; const int lq = lane >> 4; \
            _Pragma("unroll") for (int i = 0; i < 4; ++i) { const int d = lq * 256 + (((lane & 15) ^ (4 * i + lq)) * 16); \
                *(LAS v4u*)(nb + SC_QG + i * 1024 + d) = GX[i]; *(LAS v4u*)(nb + SC_WV + i * 1024 + d) = GX[4 + i]; } \
            _Pragma("unroll") for (int i = 0; i < 4; ++i) { const int d = (lane >> 3) * 128 + (((lane & 7) ^ (4 * (i & 1) + lq)) * 16); *(LAS v4u*)(nb + SC_KDT + i * 1024 + d) = GX[8 + i]; } \
            _Pragma("unroll") for (int i = 0; i < 2; ++i) { const int d = (lane >> 3) * 128 + (((lane & 7) ^ (4 * i + lq)) * 16); *(LAS v4u*)(nb - hw * 2048 + SC_A + i * 1024 + d) = GX[12 + i]; } \
            if (hw == 0) *(LAS v4u*)(nv + lane * 16) = GX[14]; } while (0)
#define HLP_ITER(c, GL, GW) do { \
            int lane = tid & 63; asm volatile("" : "+v"(lane)); \
            const int c2 = ((c) + 2 < 128) ? (c) + 2 : 127; \
            HLP_LOAD(GL, c2); \
            HLP_STORE(GW, ((c) + 1) & 1); \
            SCAN_BAR(); } while (0)
        { int lane = tid & 63; asm volatile("" : "+v"(lane)); HLP_LOAD(G1, 1); }
        for (int c = 0; c < 128; c += 2) { HLP_ITER(c, G0, G1); HLP_ITER(c + 1, G1, G0); }
    } else {
        for (int c = 0; c < 128; ++c) {
            if (c == CA - 3 && nfb > 0) {
                if ((tid & 63) == 0) { while (__hip_atomic_load(prog, __ATOMIC_RELAXED, __HIP_MEMORY_SCOPE_AGENT) < (unsigned)nfb) __builtin_amdgcn_s_sleep(8); }
                __builtin_amdgcn_fence(__ATOMIC_ACQUIRE, "agent");
                asm volatile("s_waitcnt vmcnt(0)" ::: "memory");
            }
            SCAN_BAR();
        }
    }
    __syncthreads();
}

__device__ __forceinline__ void mixnorm_row(bf16_t* mrow, const bf16_t* prow, const float (&gn)[2][8], int lane) {
    v4u o4[4], z4[4];
#pragma unroll
    for (int i = 0; i < 4; ++i) { const int c0 = 8 * (64 * i + lane);
        o4[i] = *(const v4u*)(mrow + c0); z4[i] = *(const v4u*)(prow + (i < 2 ? C_AG + c0 : C_BZ + c0 - 1024)); }
#pragma unroll
    for (int i = 0; i < 4; ++i) {
        float ss = 0.f;
#pragma unroll
        for (int w = 0; w < 4; ++w) { const unsigned a = (w == 0) ? o4[i].x : (w == 1) ? o4[i].y : (w == 2) ? o4[i].z : o4[i].w;
            const float lo = __uint_as_float(a << 16), hi = __uint_as_float(a & 0xffff0000u); ss += lo * lo + hi * hi; }
        ss += __shfl_xor(ss, 1); ss += __shfl_xor(ss, 2); ss += __shfl_xor(ss, 4); ss += __shfl_xor(ss, 8);
        const float rstd = rsqrtf(ss * (1.f / 128.f) + EPS);
        float yv[8];
#pragma unroll
        for (int w = 0; w < 4; ++w) { const unsigned a = (w == 0) ? o4[i].x : (w == 1) ? o4[i].y : (w == 2) ? o4[i].z : o4[i].w;
            const unsigned z = (w == 0) ? z4[i].x : (w == 1) ? z4[i].y : (w == 2) ? z4[i].z : z4[i].w;
            yv[2 * w] = __uint_as_float(a << 16) * rstd * gn[i >> 1][2 * w] * __uint_as_float(z << 16);
            yv[2 * w + 1] = __uint_as_float(a & 0xffff0000u) * rstd * gn[i >> 1][2 * w + 1] * __uint_as_float(z & 0xffff0000u); }
        v4u y4; y4.x = pk2(yv[0], yv[1]); y4.y = pk2(yv[2], yv[3]); y4.z = pk2(yv[4], yv[5]); y4.w = pk2(yv[6], yv[7]);
        *(v4u*)(mrow + 8 * (64 * i + lane)) = y4; }
}

struct EpiProj {
    static constexpr bool PERM = true, AFTER_DRAIN = false;
    bf16_t* O; int ldc;
    __device__ __forceinline__ void operator()(const pg8::f32x4 (&acc)[2][2][4][2], const pg8::Unit& u, int wr, int wc, int fr, int fq) const {
        const int row0 = u.pm * 256 + wr * 64 + fr, col0 = u.pn * 256 + wc * 32 + 8 * fq;
        const bool gate = (u.pn >= 12 && u.pn < 16) || (u.pn >= 24);
#pragma unroll
        for (int ai = 0; ai < 2; ++ai)
#pragma unroll
            for (int m = 0; m < 4; ++m) { bf16_t* rowp = O + (size_t)(row0 + ai * 128 + m * 16) * ldc + col0;
#pragma unroll
                for (int bj = 0; bj < 2; ++bj) { pg8::f32x4 v0 = acc[ai][bj][m][0], v1 = acc[ai][bj][m][1];
                    if (gate) {
#pragma unroll
                        for (int e = 0; e < 4; ++e) { v0[e] = v0[e] * __builtin_amdgcn_rcpf(1.f + __expf(-v0[e])); v1[e] = v1[e] * __builtin_amdgcn_rcpf(1.f + __expf(-v1[e])); } }
                    pg8::u32x4 w; w.x = pk2(v0[0], v0[1]); w.y = pk2(v0[2], v0[3]); w.z = pk2(v1[0], v1[1]); w.w = pk2(v1[2], v1[3]);
                    *(pg8::u32x4*)(rowp + bj * 128) = w; } }
    }
};
struct EpiResF32 {
    static constexpr bool PERM = false, AFTER_DRAIN = false;
    const float* R; float* O; int ldc;
    __device__ __forceinline__ void operator()(const pg8::f32x4 (&acc)[2][2][4][2], const pg8::Unit& u, int wr, int wc, int fr, int fq) const {
        const int row0 = u.pm * 256 + wr * 64 + fr, col0 = u.pn * 256 + wc * 32 + 4 * fq;
#pragma unroll
        for (int ai = 0; ai < 2; ++ai)
#pragma unroll
            for (int m = 0; m < 4; ++m) { const size_t off = (size_t)(row0 + ai * 128 + m * 16) * ldc + col0;
#pragma unroll
                for (int bj = 0; bj < 2; ++bj)
#pragma unroll
                    for (int n = 0; n < 2; ++n) { pg8::f32x4 v = acc[ai][bj][m][n]; if (R) v = v + *(const pg8::f32x4*)(R + off + bj * 128 + n * 16); *(pg8::f32x4*)(O + off + bj * 128 + n * 16) = v; } }
    }
};

#define XB_TMO      128
#define XB_XCNT(j)  (256  + 64 * (j))
#define XB_XSUB(j)  (1280 + 64 * (j))
#define XB_XGEN(j)  (2304 + 64 * (j))
#define XB_TOP      3328
#define XB_TOPGEN   3392
#define XCD_BAR_WORDS 3456
#define XB_SPIN_CAP (1u << 18)

__device__ __forceinline__ unsigned xb_ld(unsigned* p)              { return __hip_atomic_load(p, __ATOMIC_RELAXED, __HIP_MEMORY_SCOPE_AGENT); }
__device__ __forceinline__ unsigned xb_add(unsigned* p, unsigned v) { return __hip_atomic_fetch_add(p, v, __ATOMIC_RELAXED, __HIP_MEMORY_SCOPE_AGENT); }
__device__ __forceinline__ unsigned xb_xcc_id() { return (unsigned)__builtin_amdgcn_s_getreg((3 << 11) | 20) & 0xFu; }
#define XB_SPIN(cond, bar) do { unsigned _sp = 0; while (cond) { __builtin_amdgcn_s_sleep(1); \
    if ((++_sp & 255u) == 0u) { if (xb_ld(&(bar)[XB_TMO])) break; if (_sp > XB_SPIN_CAP) { atomicAdd(&(bar)[XB_TMO], 1u); break; } } } } while (0)

struct XcdBarrier {
    unsigned* bar; unsigned x;
    volatile LAS unsigned* st;
};

__device__ __forceinline__ XcdBarrier xcd_barrier_post(unsigned* bar, volatile LAS unsigned* st) {
    XcdBarrier b; b.bar = bar; b.x = xb_xcc_id(); b.st = st;
    if (threadIdx.x == 0) (void)xb_add(&bar[XB_XCNT(b.x)], 1u);
    return b;
}
__device__ __forceinline__ void xcd_barrier_complete(unsigned* bar, unsigned x, unsigned& nloc, unsigned& nx) {
    const unsigned G = gridDim.x * gridDim.y * gridDim.z;
    unsigned sum, cnt, mine, sp = 0u;
    for (;;) {
        sum = 0u; cnt = 0u; mine = 0u;
#pragma unroll
        for (unsigned j = 0; j < 16; ++j) { const unsigned c = xb_ld(&bar[XB_XCNT(j)]); sum += c; cnt += (c > 0u) ? 1u : 0u; mine = (j == x) ? c : mine; }
        if (sum == G) break;
        __builtin_amdgcn_s_sleep(1);
        if ((++sp & 255u) == 0u) { if (xb_ld(&bar[XB_TMO])) break; if (sp > XB_SPIN_CAP) { atomicAdd(&bar[XB_TMO], 1u); break; } }
    }
    nloc = mine > 0u ? mine : 1u; nx = cnt > 0u ? cnt : 1u;
}

__device__ __forceinline__ void xcd_barrier(const XcdBarrier& b) {
    asm volatile("s_waitcnt vmcnt(0)" ::: "memory");
    __syncthreads();
    if (threadIdx.x == 0) {
        unsigned* bar = b.bar;
        __builtin_amdgcn_s_waitcnt(0);
        unsigned nloc = b.st[0], nx = b.st[1];
        if (nloc == 0u) { xcd_barrier_complete(bar, b.x, nloc, nx); b.st[0] = nloc; b.st[1] = nx; }
        const unsigned old = xb_add(&bar[XB_XSUB(b.x)], 1u);
        const unsigned gen = old / nloc;
        if (old + 1u == (gen + 1u) * nloc) {
            __builtin_amdgcn_fence(__ATOMIC_RELEASE, "agent");
            asm volatile("s_waitcnt vmcnt(0)" ::: "memory");
            const unsigned og = xb_add(&bar[XB_TOP], 1u);
            const unsigned tg = og / nx;
            if (og + 1u == (tg + 1u) * nx) xb_add(&bar[XB_TOPGEN], 1u);
            else XB_SPIN(xb_ld(&bar[XB_TOPGEN]) == tg, bar);
            __builtin_amdgcn_fence(__ATOMIC_ACQUIRE, "agent");
            xb_add(&bar[XB_XGEN(b.x)], 1u);
            asm volatile("s_waitcnt vmcnt(0)" ::: "memory");
        } else {
            XB_SPIN(xb_ld(&bar[XB_XGEN(b.x)]) == gen, bar);
            __builtin_amdgcn_fence(__ATOMIC_ACQUIRE, "agent");
            asm volatile("s_waitcnt vmcnt(0)" ::: "memory");
        }
    }
    __syncthreads();
}

__device__ __forceinline__ int get_lane() { int l = (int)__builtin_amdgcn_mbcnt_hi(~0u, __builtin_amdgcn_mbcnt_lo(~0u, 0u)); asm volatile("" : "+v"(l)); return l; }
__global__ void __launch_bounds__(NT, 2) mk_fwd(Args args) {
    extern __shared__ __attribute__((aligned(16))) unsigned char lds_raw[];
    LAS unsigned char* lds = (LAS unsigned char*)lds_raw;
    cg::grid_group grid = cg::this_grid();
    const int tid = threadIdx.x, wave = __builtin_amdgcn_readfirstlane(tid >> 6);

    const int G = gridDim.x, bx = blockIdx.x;
    const int vcu = (G % 8 == 0) ? (bx % 8) * (G / 8) + bx / 8 : bx;
    const int gw = vcu * NW + wave, NGW = G * NW;
    unsigned char* ws = args.ws;
    const float* x = args.in[0]; const float* attn_g = args.in[1]; const float* w_in = args.in[2];
    const float* w_out = args.in[9]; const float* ffn_g = args.in[10]; const float* w_query = args.in[11]; const float* sub_keys = args.in[12];
    bf16_t* WinT = (bf16_t*)(ws + OFF_D);
    bf16_t* WoutT = (bf16_t*)(ws + OFF_C);
    bf16_t* Wqk = (bf16_t*)(ws + OFF_C + 8 * MiB);
    bf16_t* xn = (bf16_t*)(ws + OFF_D + 28 * MiB);
    float* ba = (float*)(ws + OFF_S);
    bf16_t* proj = (bf16_t*)(ws + OFF_B);
    bf16_t* mix = (bf16_t*)args.out;
    unsigned char* pb = ws + OFF_D; float* vecs = (float*)(ws + OFF_S + 2 * MiB);
    float* hbuf = (float*)(ws + OFF_B);
    bf16_t* hn = (bf16_t*)(ws + OFF_D + 128 * MiB);
    float* scores = (float*)(ws + OFF_D);
    unsigned char* U8 = ws + OFF_TAB; unsigned char* V8 = ws + OFF_TAB + 16 * MiB;
    float* inv_su = (float*)(ws + OFF_S + 1 * MiB); float* inv_sv = inv_su + 16384;

    volatile LAS unsigned* xbst = (volatile LAS unsigned*)(lds + LDS_BYTES - 16);
    if (tid < 4) xbst[tid] = 0u;
    __syncthreads();
    XcdBarrier xbar = xcd_barrier_post((unsigned*)args.ws, xbst);
    const int lo = args.ph_lo, hi = args.ph_hi;
#define IN(k) (lo <= (k) && (k) < hi)
#define SYNC_AFTER(k) do { if (IN(k) && (k) + 1 < hi) { if ((k) == 0) grid.sync(); else xcd_barrier(xbar); } } while (0)
    {
        if (IN(0)) {
            const int lane = get_lane();
            LAS float* scr = (LAS float*)(lds + wave * 16384);
            constexpr int I_IN = (DM / 64) * (NPROJ / 32);
            for (int it = gw; it < I_IN; it += NGW) transpose_item(w_in, INW, DM, NPROJ, WinT, scr, it, lane);
            __syncthreads();
            {
                LAS float* wt = (LAS float*)lds;
#pragma unroll
                for (int k = 0; k < 4; ++k) { const int d = tid + 512 * k; const float* wr = w_in + (size_t)d * INW + NPROJ;
#pragma unroll
                    for (int q4 = 0; q4 < 4; ++q4) { const f32x4 w4 = *(const f32x4*)(wr + 4 * q4);
                        wt[(4 * q4 + 0) * 2048 + d] = w4.x; wt[(4 * q4 + 1) * 2048 + d] = w4.y; wt[(4 * q4 + 2) * 2048 + d] = w4.z; wt[(4 * q4 + 3) * 2048 + d] = w4.w; } }
            }
            __syncthreads();
            for (int m = gw; m < T; m += NGW) norm_row<true>(x + (size_t)m * DM, attn_g, (const LAS float*)lds, xn + (size_t)m * DM, ba + (size_t)m * 16, lane);
        }
        SYNC_AFTER(0);
        if (IN(1)) {
            pg8::Gemm g{xn, WinT, T, NPROJ, DM}; pg8::StaticOrder S; S.init(T, NPROJ, G, bx);
            EpiProj E{proj, NPROJ};
            pg8::gemm_phase<EpiProj, pg8::StaticOrder, true, true>(lds, g, S, E);
        }
        SYNC_AFTER(1);
        if (IN(2)) {
            const int CAe = (G > NSB) ? CA : 128;
            for (int it = bx; it < 16 * CAe; it += G) { int tt = threadIdx.x; asm volatile("" : "+v"(tt)); hgrn_prep_item((it / CAe) * 128 + (it % CAe), proj, args.in[3], pb, vecs, lds, tt); }
            for (int it = bx; it < 8 * CAe; it += G) { int tt = threadIdx.x; asm volatile("" : "+v"(tt)); gdn_prep_item((it / CAe) * 128 + (it % CAe), proj, ba, args.in[5], args.in[6], args.in[7], pb, vecs, lds, tt); }
        }
        SYNC_AFTER(2);
        if (IN(3)) {
            const int lane = get_lane();
            unsigned* ctl = (unsigned*)args.ws;
            if (bx < NSB) {
                const int sq = (bx & 7) + 8 * (bx >> 5), cgp = (bx >> 3) & 3;
                if (sq >= 16) scan_block<true>(sq, cgp, proj, pb, vecs, args.in[4], args.in[8], mix, ctl + PROG_WORD, G - NSB, lds, tid);
                else scan_block<false>(sq, cgp, proj, pb, vecs, args.in[4], args.in[8], mix, ctl + PROG_WORD, G - NSB, lds, tid);
            }
            else if (G > NSB) {
                int fb, FB;
                fb = bx - NSB; FB = G - NSB;
                {
                    constexpr int NBL = 128 - CA;
                    for (int it = fb; it < 16 * NBL; it += FB) { int tt = threadIdx.x; asm volatile("" : "+v"(tt)); hgrn_prep_item((it & 15) * 128 + CA + (it >> 4), proj, args.in[3], pb, vecs, lds, tt); }
                    for (int it = fb; it < 8 * NBL; it += FB) { int tt = threadIdx.x; asm volatile("" : "+v"(tt)); gdn_prep_item((it & 7) * 128 + CA + (it >> 3), proj, ba, args.in[5], args.in[6], args.in[7], pb, vecs, lds, tt); }
                    __syncthreads();
                    if (tid == 0) { __threadfence(); __hip_atomic_fetch_add(ctl + PROG_WORD, 1u, __ATOMIC_RELAXED, __HIP_MEMORY_SCOPE_AGENT); }
                    __syncthreads();
                }
                const int fw = fb * NW + wave, FW = FB * NW;
                for (int it = fb; it < 512; it += FB) wqk_item(w_query, sub_keys, Wqk, (LAS float*)lds, it, tid);
                LAS float* scr = (LAS float*)(lds + wave * 16384);
                constexpr int I_OUT = (DM / 64) * (DM / 32);
                for (int it = fw; it < I_OUT; it += FW) transpose_item(w_out, DM, DM, DM, WoutT, scr, it, lane);
                for (int e = 2 * fw; e < 32768; e += 2 * FW) { const bool isv = e >= 16384; const int r = e & 16383;
                    if (isv) table_row2(args.in[14] + (size_t)r * DM, (unsigned*)(V8 + (size_t)r * 1024), inv_sv + r, lane);
                    else table_row2_i4(args.in[13] + (size_t)r * DM, (unsigned*)(U8 + (size_t)r * 1024), inv_su + r, lane); }
            }
        }
        SYNC_AFTER(3);
        if (IN(4)) {
            {
                const int lane = get_lane();
                float gn[2][8];
#pragma unroll
                for (int mxr = 0; mxr < 2; ++mxr) { const float* gsrc = (mxr == 0 ? args.in[4] : args.in[8]) + 8 * (lane & 15);
                    const f32x4 ga = *(const f32x4*)gsrc, gb = *(const f32x4*)(gsrc + 4);
                    gn[mxr][0] = ga.x; gn[mxr][1] = ga.y; gn[mxr][2] = ga.z; gn[mxr][3] = ga.w; gn[mxr][4] = gb.x; gn[mxr][5] = gb.y; gn[mxr][6] = gb.z; gn[mxr][7] = gb.w; }
                for (int m = gw; m < T; m += NGW) mixnorm_row(mix + (size_t)m * DM, proj + (size_t)m * NPROJ, gn, lane);
                xcd_barrier(xbar);
            }
            pg8::Gemm g{mix, WoutT, T, DM, DM}; pg8::StaticOrder S; S.init(T, DM, G, bx);
            EpiResF32 E{x, hbuf, DM};
            pg8::gemm_phase<EpiResF32, pg8::StaticOrder, true, true>(lds, g, S, E);
        }
        SYNC_AFTER(4);
        if (IN(5)) {
            const int lane = get_lane();
            for (int m = gw; m < T; m += NGW) norm_row<false>(hbuf + (size_t)m * DM, ffn_g, (const LAS float*)lds, hn + (size_t)m * DM, nullptr, lane);
        }
        SYNC_AFTER(5);
        if (IN(6)) {
            pg8::Gemm g{hn, Wqk, T, DM, DM}; pg8::StaticOrder S; S.init(T, DM, G, bx);
            EpiResF32 E{nullptr, scores, DM};
            pg8::gemm_phase<EpiResF32, pg8::StaticOrder, true, true>(lds, g, S, E);
        }
        SYNC_AFTER(6);
        if (IN(7)) {
            const int lane = get_lane();
            LAS int* se = (LAS int*)(lds + wave * 4096); LAS float* sa = (LAS float*)(lds + wave * 4096 + 512); LAS float* sb = (LAS float*)(lds + wave * 4096 + 1024);
            for (int t = gw; t < T; t += NGW) { const int ln = get_lane(); peer_token(t, scores, hn, hbuf, U8, V8, inv_su, inv_sv, args.in[15], args.out, se, sa, sb, ln); }
        }
    }
}
}

extern "C" void kernel_launch(void* const* d_in, const int* in_sizes, int n_in, void* d_out, int out_size, void* d_ws, size_t ws_size, hipStream_t stream) {
    static int grid = 0;
    if (grid == 0) {
        int dev = 0, cus = 0, per_cu = 0;
        (void)hipGetDevice(&dev);
        (void)hipDeviceGetAttribute(&cus, hipDeviceAttributeMultiprocessorCount, dev);
        (void)hipFuncSetAttribute((const void*)mk::mk_fwd, hipFuncAttributeMaxDynamicSharedMemorySize, mk::LDS_BYTES);
        (void)hipOccupancyMaxActiveBlocksPerMultiprocessor(&per_cu, (const void*)mk::mk_fwd, mk::NT, mk::LDS_BYTES);
        if (per_cu < 1) { fprintf(stderr, "occupancy query says %d\n", per_cu); per_cu = 1; }
        grid = cus;
    }
    unsigned char* ws = (unsigned char*)d_ws;
    (void)hipMemsetAsync(d_ws, 0, 16384, stream);
    mk::Args a{};
    for (int i = 0; i < 16; ++i) a.in[i] = (const float*)d_in[i];
    a.out = (float*)d_out; a.ws = ws;
    {
        a.ph_lo = 0; a.ph_hi = 8;
        void* kargs[] = {&a};
        hipError_t e = hipLaunchCooperativeKernel((const void*)mk::mk_fwd, dim3(grid), dim3(mk::NT), kargs, mk::LDS_BYTES, stream);
        if (e != hipSuccess) fprintf(stderr, "coop launch failed: %s\n", hipGetErrorString(e));
    }
}
```

```cpp
#include <hip/hip_runtime.h>
#include <hip/hip_cooperative_groups.h>
#include <cstdio>
namespace cg = cooperative_groups;
#include <stdint.h>

typedef unsigned short bf16_t;
typedef float f32x4 __attribute__((ext_vector_type(4)));

constexpr int T = 16384, SEQ = 8192, DM = 2048, INW = 7184, NPROJ = 7168;
constexpr float EPS = 1e-6f;
constexpr size_t MiB = 1u << 20;
constexpr size_t OFF_TAB = 1 * MiB;
constexpr size_t OFF_B = 65 * MiB;
constexpr size_t OFF_C = 289 * MiB;
constexpr size_t OFF_D = 305 * MiB;
constexpr size_t OFF_S = 500 * MiB;
constexpr int C_AQ = 0, C_AF = 1024, C_AI = 2048, C_AG = 3072, C_BQ = 4096, C_BK = 4608, C_BV = 5120, C_BZ = 6144;

__device__ __forceinline__ float bf2f(bf16_t v) { return __uint_as_float(((unsigned)v) << 16); }
typedef float f32x2_t __attribute__((ext_vector_type(2)));
typedef __bf16 bf16x2_t __attribute__((ext_vector_type(2)));
__device__ __forceinline__ unsigned cvt_pk2(float lo, float hi) { f32x2_t v = {lo, hi}; bf16x2_t b = __builtin_convertvector(v, bf16x2_t); return __builtin_bit_cast(unsigned, b); }
__device__ __forceinline__ bf16_t f2bf(float f) { return (bf16_t)(cvt_pk2(f, 0.f) & 0xffffu); }
__device__ __forceinline__ float sigmoidf_(float x) { return 1.f / (1.f + __expf(-x)); }
__device__ __forceinline__ float siluf_(float x) { return x / (1.f + __expf(-x)); }
__device__ __forceinline__ float wave_sum(float v) {
#pragma unroll
    for (int o = 1; o < 64; o <<= 1) v += __shfl_xor(v, o);
    return v;
}
__device__ __forceinline__ float block_sum(float v, float* sh) {
    v = wave_sum(v);
    const int w = threadIdx.x >> 6, nw = blockDim.x >> 6;
    __syncthreads();
    if ((threadIdx.x & 63) == 0) sh[w] = v;
    __syncthreads();
    float r = 0.f;
    for (int i = 0; i < nw; ++i) r += sh[i];
    return r;
}

__device__ __forceinline__ float gelu_erf(float x) {
    const float z = fabsf(x) * 0.70710678118654752f;
    const float tt = __builtin_amdgcn_rcpf(fmaf(0.3275911f, z, 1.f));
    float pl = fmaf(1.061405429f, tt, -1.453152027f); pl = fmaf(pl, tt, 1.421413741f); pl = fmaf(pl, tt, -0.284496736f); pl = fmaf(pl, tt, 0.254829592f); pl *= tt;
    const float er = 1.f - pl * __expf(-z * z);
    return 0.5f * x * (1.f + copysignf(er, x));
}
namespace pg8 {
#define PG8_LAS __attribute__((address_space(3)))
typedef unsigned short bf16_t;
typedef short bf16x8 __attribute__((ext_vector_type(8)));
typedef float f32x4 __attribute__((ext_vector_type(4)));
typedef unsigned u32x4 __attribute__((ext_vector_type(4)));
constexpr int BM = 256, BK = 64, HALF = 128, HTB = HALF * BK * 2  , STAGE_BYTES = 8 * HTB, NXCD = 8, WGM = 8;

__host__ __device__ __forceinline__ int lds_byte(int r, int c) { const int st = (r >> 4) * 2 + (c >> 5), rr = r & 15, cc = c & 31, ob = rr * 64 + cc * 2; return st * 1024 + (ob ^ (((ob >> 9) & 1) << 5)); }
__host__ __device__ __forceinline__ void stage_rc(int b, int& R, int& C) { const int st = b / 1024, sb = b % 1024, swz = sb ^ (((sb >> 9) & 1) << 5); R = (st >> 1) * 16 + swz / 64; C = (st & 1) * 32 + (swz % 64) / 2; }
__host__ __device__ __forceinline__ int perm32(int rho) { const int n = rho >> 4, i = rho & 15; return 8 * (i >> 2) + 4 * n + (i & 3); }

struct Unit { int pm, pn; };
struct Gemm { const bf16_t* A; const bf16_t* Bt; int M, N, K; };

struct StaticOrder {
    int nM, nN, nwg, G, c;
    __host__ __device__ void init(int M, int N, int G_, int c_) { nM = M / BM; nN = N / BM; nwg = nM * nN; G = G_; c = c_; }
    __host__ __device__ bool next(int i, Unit& u) const {
        const long L = (long)i * G + c; if (L >= nwg) return false;
        int wgid = (int)L; { const int q = nwg / NXCD, r = nwg % NXCD, xcd = wgid % NXCD, off = wgid / NXCD; wgid = (xcd < r ? xcd * (q + 1) : r * (q + 1) + (xcd - r) * q) + off; }
        const int nig = WGM * nN, gid = wgid / nig, fm = gid * WGM, gsz = (nM - fm) < WGM ? (nM - fm) : WGM;
        u.pm = fm + ((wgid % nig) % gsz); u.pn = (wgid % nig) / gsz; return true;
    }
    __device__ __forceinline__ void a_ready(const Unit&) const {}
    __device__ __forceinline__ void done(const Unit&) const {}
};

__device__ __forceinline__ unsigned cvt_pk_bf16(float lo, float hi) { unsigned r; asm volatile("v_cvt_pk_bf16_f32 %0, %1, %2" : "=v"(r) : "v"(lo), "v"(hi)); return r; }
typedef float f32x2 __attribute__((ext_vector_type(2)));
__device__ __forceinline__ f32x2 gelu_pk(f32x2 v) {
    const f32x2 av = __builtin_elementwise_abs(v), d = av * 0.2316418882f + 1.0f;
    f32x2 t; t.x = __builtin_amdgcn_rcpf(d.x); t.y = __builtin_amdgcn_rcpf(d.y);
    f32x2 q = t * 0.5307027145f + (-0.7265760135f); q = q * t + 0.7107068705f; q = q * t + (-0.142248368f); q = q * t + 0.127414796f; q = q * t;
    const f32x2 s = (v * v) * (-0.72134752044f);
    f32x2 e; e.x = __builtin_amdgcn_exp2f(s.x); e.y = __builtin_amdgcn_exp2f(s.y);
    const f32x2 m = v * (q * e), r = v - m;
    f32x2 o; o.x = v.x < 0.f ? m.x : r.x; o.y = v.y < 0.f ? m.y : r.y; return o;
}

template <int ACT  > struct EpiBf16 {
    static constexpr bool PERM = true, AFTER_DRAIN = false; static_assert(ACT == 0 || ACT == 1, "EpiBf16: ACT is 0 (none) or 1 (gelu_pk)");
    bf16_t* O; int ldc; const float* bias; int split_cols; size_t split_stride; float scale0;
    __device__ __forceinline__ void operator()(const f32x4 (&acc)[2][2][4][2], const Unit& u, int wr, int wc, int fr, int fq) const {
        const int row0 = u.pm * BM + wr * 64 + fr; int colt = u.pn * BM; bf16_t* base = O;
        float sc = 1.f; if (split_cols) { const int t = colt / split_cols; base += (size_t)t * split_stride; colt -= t * split_cols; if (t == 0) sc = scale0; }
        const int col0 = colt + wc * 32 + 8 * fq, bcol0 = u.pn * BM + wc * 32 + 8 * fq;
        f32x4 bv[2][2];
#pragma unroll
        for (int bj = 0; bj < 2; ++bj)
#pragma unroll
            for (int n = 0; n < 2; ++n) bv[bj][n] = bias ? *(const f32x4*)(bias + bcol0 + bj * HALF + 4 * n) : (f32x4){0.f, 0.f, 0.f, 0.f};
#pragma unroll
        for (int ai = 0; ai < 2; ++ai)
#pragma unroll
            for (int m = 0; m < 4; ++m) { bf16_t* rowp = base + (size_t)(row0 + ai * HALF + m * 16) * ldc + col0;
#pragma unroll
                for (int bj = 0; bj < 2; ++bj) { f32x4 v0 = acc[ai][bj][m][0] + bv[bj][0], v1 = acc[ai][bj][m][1] + bv[bj][1];
                    if (ACT == 1) { f32x2 a = gelu_pk((f32x2){v0[0], v0[1]}), b = gelu_pk((f32x2){v0[2], v0[3]}), c = gelu_pk((f32x2){v1[0], v1[1]}), d = gelu_pk((f32x2){v1[2], v1[3]});
                        v0 = (f32x4){a.x, a.y, b.x, b.y}; v1 = (f32x4){c.x, c.y, d.x, d.y}; }
                    v0 = v0 * sc; v1 = v1 * sc; u32x4 w; w.x = cvt_pk_bf16(v0[0], v0[1]); w.y = cvt_pk_bf16(v0[2], v0[3]); w.z = cvt_pk_bf16(v1[0], v1[1]); w.w = cvt_pk_bf16(v1[2], v1[3]);
                    *(u32x4*)(rowp + bj * HALF) = w; } }
    }
};
template <class Epi, class Sched, bool ALIGN_EPI = false, bool SP2 = false>
__device__ __forceinline__ void gemm_phase(PG8_LAS unsigned char* lds, const Gemm g, const Sched& S, const Epi& E) {
    const int tid = threadIdx.x, wid = __builtin_amdgcn_readfirstlane(tid >> 6), lane = tid & 63, wr = wid >> 2, wc = wid & 3, fr = lane & 15, fq = lane >> 4;
    const int K = g.K, nt = K / BK;
    unsigned voffA[2], voffB[2];
#pragma unroll
    for (int i = 0; i < 2; ++i) { int R, C; stage_rc(tid * 16 + i * 8192, R, C); const int Rb = Epi::PERM ? ((R & ~31) + perm32(R & 31)) : R;
        voffA[i] = (unsigned)(R * K + C) * 2u; voffB[i] = (unsigned)(Rb * K + C) * 2u; }
    const size_t kstep = (size_t)(BK * 2);
    const size_t hstep = (size_t)HALF * K * 2;
    const size_t tstep = 2 * hstep;
    const unsigned ldsw = (unsigned)wid * 1024u;
    const int aoff = lds_byte(wr * 64 + fr, fq * 8), boff = lds_byte(wc * 32 + fr, fq * 8);
#define PG8_SA(b, h) (((b) * 2 + (h)) * HTB)
#define PG8_SB(b, h) ((4 + (b) * 2 + (h)) * HTB)
#define PG8_STAGE(bufoff, gbase, voff) do { _Pragma("unroll") for (int _i = 0; _i < 2; ++_i) \
        __builtin_amdgcn_global_load_lds((const unsigned*)((const char*)(gbase) + (voff)[_i]), (PG8_LAS unsigned*)(lds + (bufoff) + ldsw + _i * 8192), 16, 0, 0); } while (0)
#define PG8_LDA(dst, b, h) do { _Pragma("unroll") for (int m = 0; m < 4; ++m) _Pragma("unroll") for (int k = 0; k < 2; ++k) dst[m][k] = *(const PG8_LAS bf16x8*)(lds + PG8_SA(b, h) + aoff + m * 2048 + k * 1024); } while (0)
#define PG8_LDB(dst, b, h) do { _Pragma("unroll") for (int n = 0; n < 2; ++n) _Pragma("unroll") for (int k = 0; k < 2; ++k) dst[n][k] = *(const PG8_LAS bf16x8*)(lds + PG8_SB(b, h) + boff + n * 2048 + k * 1024); } while (0)
#define PG8_MMA(ai, bj, At, Bt) do { __builtin_amdgcn_s_setprio(1); _Pragma("unroll") for (int m = 0; m < 4; ++m) _Pragma("unroll") for (int n = 0; n < 2; ++n) _Pragma("unroll") for (int k = 0; k < 2; ++k) \
        acc[ai][bj][m][n] = __builtin_amdgcn_mfma_f32_16x16x32_bf16(Bt[n][k], At[m][k], acc[ai][bj][m][n], 0, 0, 0); __builtin_amdgcn_s_setprio(0); } while (0)
#define PG8_WAIT_V(n) asm volatile("s_waitcnt vmcnt(" #n ")" ::: "memory")
#define PG8_WAIT_L(n) asm volatile("s_waitcnt lgkmcnt(" #n ")" ::: "memory")
#define PG8_BAR __builtin_amdgcn_s_barrier()
#define PG8_SCHED __builtin_amdgcn_sched_barrier(0)
    Unit cur, nxt; int ui = 0;
    if (!S.next(0, cur)) return;
    f32x4 acc[2][2][4][2];
#pragma unroll
    for (int a = 0; a < 2; ++a)
#pragma unroll
        for (int b = 0; b < 2; ++b)
#pragma unroll
            for (int m = 0; m < 4; ++m)
#pragma unroll
                for (int n = 0; n < 2; ++n) acc[a][b][m][n] = (f32x4){0.f, 0.f, 0.f, 0.f};
    bf16x8 At[4][2], B0[2][2], B1[2][2];
    const char* cA = (const char*)g.A + (size_t)cur.pm * tstep; const char* cB = (const char*)g.Bt + (size_t)cur.pn * tstep;
    S.a_ready(cur);
    if constexpr (SP2) {
        PG8_STAGE(PG8_SB(0, 0), cB, voffB); PG8_STAGE(PG8_SB(0, 1), cB + hstep, voffB); PG8_STAGE(PG8_SA(0, 0), cA, voffA); PG8_STAGE(PG8_SA(0, 1), cA + hstep, voffA);
        if (wr == 1) PG8_BAR;
        PG8_WAIT_V(2); PG8_BAR;
        PG8_STAGE(PG8_SB(1, 0), cB + kstep, voffB); PG8_STAGE(PG8_SA(1, 0), cA + kstep, voffA); PG8_STAGE(PG8_SB(1, 1), cB + hstep + kstep, voffB);
        PG8_WAIT_V(6); PG8_BAR;
    } else {
        PG8_STAGE(PG8_SB(0, 0), cB, voffB); PG8_STAGE(PG8_SA(0, 0), cA, voffA); PG8_STAGE(PG8_SB(0, 1), cB + hstep, voffB); PG8_STAGE(PG8_SA(0, 1), cA + hstep, voffA);
        if (wr == 1) PG8_BAR;
        PG8_WAIT_V(4); PG8_BAR;
        PG8_STAGE(PG8_SB(1, 0), cB + kstep, voffB); PG8_STAGE(PG8_SA(1, 0), cA + kstep, voffA); PG8_STAGE(PG8_SB(1, 1), cB + hstep + kstep, voffB);
        PG8_WAIT_V(6); PG8_BAR;
    }
    for (;;) {
        const bool has_next = S.next(ui + 1, nxt);
        const char* nA = has_next ? (const char*)g.A + (size_t)nxt.pm * tstep : cA; const char* nB = has_next ? (const char*)g.Bt + (size_t)nxt.pn * tstep : cB;
        for (int t = 0; t < nt; t += 2) {
            const bool last = (t == nt - 2);
            const char* a1 = cA + (size_t)(t + 1) * kstep;
            const char* a2 = last ? nA : cA + (size_t)(t + 2) * kstep; const char* b2 = last ? nB : cB + (size_t)(t + 2) * kstep;
            const char* a3 = a2 + kstep; const char* b3 = b2 + kstep;
            if (last && has_next) S.a_ready(nxt);
            if constexpr (SP2) {
            PG8_LDB(B0, 0, 0); PG8_LDB(B1, 0, 1); PG8_SCHED; PG8_LDA(At, 0, 0); PG8_STAGE(PG8_SA(1, 1), a1 + hstep, voffA);
            PG8_WAIT_V(8); PG8_WAIT_L(0); PG8_BAR; PG8_MMA(0, 0, At, B0); PG8_MMA(0, 1, At, B1); PG8_BAR; PG8_SCHED;
            PG8_LDA(At, 0, 1); PG8_STAGE(PG8_SB(0, 0), b2, voffB); PG8_STAGE(PG8_SB(0, 1), b2 + hstep, voffB); PG8_STAGE(PG8_SA(0, 0), a2, voffA);
            PG8_WAIT_V(8); PG8_WAIT_L(0); PG8_BAR; PG8_MMA(1, 0, At, B0); PG8_MMA(1, 1, At, B1); PG8_BAR; PG8_SCHED;
            PG8_LDB(B0, 1, 0); PG8_LDB(B1, 1, 1); PG8_SCHED; PG8_LDA(At, 1, 0); PG8_STAGE(PG8_SA(0, 1), a2 + hstep, voffA);
            PG8_WAIT_V(8); PG8_WAIT_L(0); PG8_BAR; PG8_MMA(0, 0, At, B0); PG8_MMA(0, 1, At, B1); PG8_BAR; PG8_SCHED;
            PG8_LDA(At, 1, 1); PG8_STAGE(PG8_SB(1, 0), b3, voffB); PG8_STAGE(PG8_SB(1, 1), b3 + hstep, voffB); PG8_STAGE(PG8_SA(1, 0), a3, voffA);
            PG8_WAIT_V(8); PG8_WAIT_L(0); PG8_BAR; PG8_MMA(1, 0, At, B0); PG8_MMA(1, 1, At, B1); PG8_BAR; PG8_SCHED;
            } else {
            PG8_LDB(B0, 0, 0); PG8_SCHED; PG8_LDA(At, 0, 0); PG8_STAGE(PG8_SA(1, 1), a1 + hstep, voffA);
            PG8_WAIT_L(8); PG8_BAR; PG8_WAIT_L(0); PG8_MMA(0, 0, At, B0); PG8_BAR; PG8_SCHED;
            PG8_LDB(B1, 0, 1); PG8_STAGE(PG8_SB(0, 0), b2, voffB);
            PG8_BAR; PG8_WAIT_L(0); PG8_MMA(0, 1, At, B1); PG8_BAR;
            PG8_LDA(At, 0, 1); PG8_STAGE(PG8_SA(0, 0), a2, voffA);
            PG8_BAR; PG8_WAIT_L(0); PG8_MMA(1, 0, At, B0); PG8_BAR; PG8_SCHED;
            PG8_STAGE(PG8_SB(0, 1), b2 + hstep, voffB);
            PG8_WAIT_V(6); PG8_BAR; PG8_MMA(1, 1, At, B1); PG8_BAR;
            PG8_LDB(B0, 1, 0); PG8_SCHED; PG8_LDA(At, 1, 0); PG8_STAGE(PG8_SA(0, 1), a2 + hstep, voffA);
            PG8_WAIT_L(8); PG8_BAR; PG8_WAIT_L(0); PG8_MMA(0, 0, At, B0); PG8_BAR; PG8_SCHED;
            PG8_LDB(B1, 1, 1); PG8_STAGE(PG8_SB(1, 0), b3, voffB);
            PG8_BAR; PG8_WAIT_L(0); PG8_MMA(0, 1, At, B1); PG8_BAR;
            PG8_LDA(At, 1, 1); PG8_STAGE(PG8_SA(1, 0), a3, voffA);
            PG8_BAR; PG8_WAIT_L(0); PG8_MMA(1, 0, At, B0); PG8_BAR; PG8_SCHED;
            PG8_STAGE(PG8_SB(1, 1), b3 + hstep, voffB);
            PG8_WAIT_V(6); PG8_BAR; PG8_MMA(1, 1, At, B1); PG8_BAR;
            }
        }
        if constexpr (ALIGN_EPI) { if (wr == 0) PG8_BAR; }
        if constexpr (!Epi::AFTER_DRAIN) { E(acc, cur, wr, wc, fr, fq); S.done(cur); }
        if (!has_next) break;
#pragma unroll
        for (int a = 0; a < 2; ++a)
#pragma unroll
            for (int b = 0; b < 2; ++b)
#pragma unroll
                for (int m = 0; m < 4; ++m)
#pragma unroll
                    for (int n = 0; n < 2; ++n) acc[a][b][m][n] = (f32x4){0.f, 0.f, 0.f, 0.f};
        cur = nxt; cA = nA; cB = nB; ++ui;
        if constexpr (ALIGN_EPI) { if (wr == 1) PG8_BAR; }
    }
    PG8_WAIT_V(0);
    if constexpr (!ALIGN_EPI) { if (wr == 0) PG8_BAR; }
    PG8_BAR;
    if constexpr (Epi::AFTER_DRAIN) { E.fused(acc, cur, wr, wc, fr, fq, lds, wid, lane); S.done(cur); }
#undef PG8_SA
#undef PG8_SB
#undef PG8_STAGE
#undef PG8_LDA
#undef PG8_LDB
#undef PG8_MMA
#undef PG8_WAIT_V
#undef PG8_WAIT_L
#undef PG8_BAR
#undef PG8_SCHED
}
}

namespace mk {
#define LAS __attribute__((address_space(3)))
#define GAS __attribute__((address_space(1)))
typedef unsigned v4u __attribute__((ext_vector_type(4)));
typedef unsigned v2u __attribute__((ext_vector_type(2)));
constexpr int NW = 8, NT = 512, LDS_BYTES = 163840, RING_BYTES = 131072;
#define LDS_WAIT() asm volatile("s_waitcnt lgkmcnt(0)" ::: "memory")
#define DPP_ROR_ADD(t, n) ((t) + __uint_as_float(__builtin_amdgcn_update_dpp(0u, __float_as_uint(t), 0x120 + (n), 0xf, 0xf, false)))
struct Args { const float* in[16]; float* out; unsigned char* ws; int ph_lo, ph_hi; };
__device__ __forceinline__ unsigned pk2(float lo, float hi) { return cvt_pk2(lo, hi); }

__device__ __forceinline__ void transpose_item(const float* W, int ld, int K, int ncols, bf16_t* WT, LAS float* scr, int item, int lane) {
    const int nblk = ncols / 32, kb = item / nblk, nb = item % nblk, k0 = 64 * kb, n0 = 32 * nb;
#pragma unroll 8
    for (int i = 0; i < 32; ++i) { const int kk = 2 * i + (lane >> 5); scr[kk * 33 + (lane & 31)] = W[(size_t)(k0 + kk) * ld + n0 + (lane & 31)]; }
    LDS_WAIT(); asm volatile("" ::: "memory");
    const int c = lane & 7;
#pragma unroll
    for (int j = 0; j < 4; ++j) { const int n = (lane >> 3) + 8 * j; const LAS float* s = scr + (8 * c) * 33 + n;
        v4u o; o.x = pk2(s[0 * 33], s[1 * 33]); o.y = pk2(s[2 * 33], s[3 * 33]); o.z = pk2(s[4 * 33], s[5 * 33]); o.w = pk2(s[6 * 33], s[7 * 33]);
        *(v4u*)(WT + (size_t)(n0 + n) * K + k0 + 8 * c) = o; }
    LDS_WAIT(); asm volatile("" ::: "memory");
}
template <bool WITH_BA>
__device__ __forceinline__ void norm_row(const float* xrow, const float* g, const LAS float* wt  , bf16_t* orow, float* barow, int lane) {
    f32x4 v[8]; float ss = 0.f;
#pragma unroll
    for (int j = 0; j < 8; ++j) { v[j] = ((const f32x4*)xrow)[64 * j + lane]; ss += (v[j].x * v[j].x + v[j].y * v[j].y) + (v[j].z * v[j].z + v[j].w * v[j].w); }
    ss = wave_sum(ss);
    const float rstd = rsqrtf(ss * (1.f / DM) + EPS);
    float acc[16];
#pragma unroll
    for (int c = 0; c < 16; ++c) acc[c] = 0.f;
#pragma unroll
    for (int j = 0; j < 8; ++j) {
        const f32x4 gg = ((const f32x4*)g)[64 * j + lane];
        const f32x4 y = v[j] * rstd * gg;
        v2u o; o.x = pk2(y.x, y.y); o.y = pk2(y.z, y.w);
        ((v2u*)orow)[64 * j + lane] = o;
        if (WITH_BA) {
#pragma unroll
            for (int c = 0; c < 16; ++c) { const f32x4 w4 = *(const LAS f32x4*)(wt + c * 2048 + 4 * (64 * j + lane));
                acc[c] += (y.x * w4.x + y.y * w4.y) + (y.z * w4.z + y.w * w4.w); }
            __builtin_amdgcn_sched_barrier(0);
        }
    }
    if (WITH_BA) {
        float q8[8], t4[4];
#pragma unroll
        for (int r = 0; r < 8; ++r) { auto sw = __builtin_amdgcn_permlane32_swap(__float_as_uint(acc[r]), __float_as_uint(acc[r + 8]), false, false); q8[r] = __uint_as_float(sw[0]) + __uint_as_float(sw[1]); }
#pragma unroll
        for (int r = 0; r < 4; ++r) { auto sw = __builtin_amdgcn_permlane16_swap(__float_as_uint(q8[r]), __float_as_uint(q8[r + 4]), false, false); t4[r] = __uint_as_float(sw[0]) + __uint_as_float(sw[1]); }
#pragma unroll
        for (int r = 0; r < 4; ++r) { float tv = t4[r]; tv = DPP_ROR_ADD(tv, 8); tv = DPP_ROR_ADD(tv, 4); tv = DPP_ROR_ADD(tv, 2); tv = DPP_ROR_ADD(tv, 1); t4[r] = tv; }
        if ((lane & 15) == 0) { const int gq = lane >> 4;
#pragma unroll
            for (int r = 0; r < 4; ++r) barow[r + 4 * gq] = t4[r]; }
    }
}
__device__ __forceinline__ void wqk_item(const float* Wq, const float* SK, bf16_t* Wqk, LAS float* lds, int item, int tid) {
    const int cbk = item >> 5, d0 = (item & 31) * 64, cb = cbk * 128, h = cbk >> 1, half = cbk & 1;
    LAS float* At = lds; LAS float* Bt = lds + 128 * 68;
    const float* skb = SK + ((size_t)(half * 8 + h) * 128) * 128;
#pragma unroll
    for (int i = 0; i < 4; ++i) { const int idx = tid + 512 * i, d = idx >> 5, k4 = idx & 31;
        const f32x4 w = *(const f32x4*)(Wq + (size_t)(d0 + d) * DM + cb + 4 * k4);
        At[(4 * k4 + 0) * 68 + d] = w.x; At[(4 * k4 + 1) * 68 + d] = w.y; At[(4 * k4 + 2) * 68 + d] = w.z; At[(4 * k4 + 3) * 68 + d] = w.w; }
#pragma unroll
    for (int i = 0; i < 8; ++i) { const int idx = tid + 512 * i, n = idx >> 5, k4 = idx & 31;
        const f32x4 w = *(const f32x4*)(skb + (size_t)n * 128 + 4 * k4);
        Bt[(4 * k4 + 0) * 132 + n] = w.x; Bt[(4 * k4 + 1) * 132 + n] = w.y; Bt[(4 * k4 + 2) * 132 + n] = w.z; Bt[(4 * k4 + 3) * 132 + n] = w.w; }
    __syncthreads();
    const int dy = tid >> 5, nx = tid & 31;
    float acc[4][4];
#pragma unroll
    for (int i = 0; i < 4; ++i)
#pragma unroll
        for (int j = 0; j < 4; ++j) acc[i][j] = 0.f;
#pragma unroll 4
    for (int kk = 0; kk < 128; ++kk) {
        const f32x4 a = *(const LAS f32x4*)(At + kk * 68 + 4 * dy), b = *(const LAS f32x4*)(Bt + kk * 132 + 4 * nx);
        acc[0][0] += a.x * b.x; acc[0][1] += a.x * b.y; acc[0][2] += a.x * b.z; acc[0][3] += a.x * b.w;
        acc[1][0] += a.y * b.x; acc[1][1] += a.y * b.y; acc[1][2] += a.y * b.z; acc[1][3] += a.y * b.w;
        acc[2][0] += a.z * b.x; acc[2][1] += a.z * b.y; acc[2][2] += a.z * b.z; acc[2][3] += a.z * b.w;
        acc[3][0] += a.w * b.x; acc[3][1] += a.w * b.y; acc[3][2] += a.w * b.z; acc[3][3] += a.w * b.w;
    }
#pragma unroll
    for (int j = 0; j < 4; ++j) { v2u o; o.x = pk2(acc[0][j], acc[1][j]); o.y = pk2(acc[2][j], acc[3][j]);
        *(v2u*)(Wqk + (size_t)(cb + 4 * nx + j) * DM + d0 + 4 * dy) = o; }
    __syncthreads();
}

typedef float f32x2 __attribute__((ext_vector_type(2)));
__device__ __forceinline__ int fp4_idx_of(float v) { return (v < 1.75f) ? (int)(v * 2.f + 0.25f) : (v < 2.5f ? 4 : (v < 3.5f ? 5 : (v < 5.f ? 6 : 7))); }
__device__ __forceinline__ void fp4_calibrate(int (&nib)[8]) {
    const unsigned T = 0x76543210u;
    const f32x2 a = __builtin_amdgcn_cvt_scalef32_pk_f32_fp4(T, 1.0f, 0), b = __builtin_amdgcn_cvt_scalef32_pk_f32_fp4(T, 1.0f, 1);
    const f32x2 c = __builtin_amdgcn_cvt_scalef32_pk_f32_fp4(T, 1.0f, 2), d = __builtin_amdgcn_cvt_scalef32_pk_f32_fp4(T, 1.0f, 3);
    nib[0] = fp4_idx_of(a.x); nib[1] = fp4_idx_of(a.y); nib[2] = fp4_idx_of(b.x); nib[3] = fp4_idx_of(b.y);
    nib[4] = fp4_idx_of(c.x); nib[5] = fp4_idx_of(c.y); nib[6] = fp4_idx_of(d.x); nib[7] = fp4_idx_of(d.y);
}
__device__ __forceinline__ void table_row_sw(const float* src, unsigned* dst, float* inv_scale, int lane) {
    int nib[8]; fp4_calibrate(nib);
    f32x4 v[8]; float mx = 0.f;
#pragma unroll
    for (int j = 0; j < 8; ++j) { v[j] = ((const f32x4*)src)[8 * lane + j];
        mx = fmaxf(mx, fmaxf(fmaxf(fabsf(v[j].x), fabsf(v[j].y)), fmaxf(fabsf(v[j].z), fabsf(v[j].w)))); }
#pragma unroll
    for (int o = 1; o < 64; o <<= 1) mx = fmaxf(mx, __shfl_xor(mx, o));
    const float sc = mx > 0.f ? mx * (0.85f / 6.f) : 1.f, isc = 1.f / sc;
    unsigned wd[4];
#pragma unroll
    for (int w = 0; w < 4; ++w) {
        unsigned acc = 0u;
#pragma unroll
        for (int e = 0; e < 8; ++e) {
            const f32x4 q = v[2 * w + (e >> 2)]; const float xe = ((e & 3) == 0) ? q.x : ((e & 3) == 1) ? q.y : ((e & 3) == 2) ? q.z : q.w;
            const float yv = fabsf(xe) * isc;
            unsigned code = (yv > 0.25f) + (yv > 0.75f) + (yv > 1.25f) + (yv > 1.75f) + (yv > 2.5f) + (yv > 3.5f) + (yv > 5.f);
            code |= (xe < 0.f) ? 8u : 0u;
            acc |= code << (4 * nib[e]);
        }
        wd[w] = acc;
    }
    v4u o; o.x = wd[0]; o.y = wd[1]; o.z = wd[2]; o.w = wd[3];
    ((v4u*)dst)[lane] = o;
    if (lane == 0) *inv_scale = sc;
}
__device__ __forceinline__ bool fp4_hw_encoder_ok() {
    unsigned t = 0u, u = 0u;
    t = __builtin_amdgcn_cvt_scalef32_pk_fp4_f32(t, 0.f, 0.5f, 1.0f, 0); t = __builtin_amdgcn_cvt_scalef32_pk_fp4_f32(t, 1.f, -1.5f, 1.0f, 1);
    t = __builtin_amdgcn_cvt_scalef32_pk_fp4_f32(t, 2.f, 3.f, 1.0f, 2); t = __builtin_amdgcn_cvt_scalef32_pk_fp4_f32(t, -4.f, 6.f, 1.0f, 3);
    u = __builtin_amdgcn_cvt_scalef32_pk_fp4_f32(u, 0.2f, 0.3f, 1.0f, 0); u = __builtin_amdgcn_cvt_scalef32_pk_fp4_f32(u, 2.4f, -2.6f, 1.0f, 1);
    u = __builtin_amdgcn_cvt_scalef32_pk_fp4_f32(u, 5.2f, -4.9f, 1.0f, 2); u = __builtin_amdgcn_cvt_scalef32_pk_fp4_f32(u, 1.3f, 0.8f, 1.0f, 3);
    const f32x2 a = __builtin_amdgcn_cvt_scalef32_pk_f32_fp4(t, 1.0f, 0), b = __builtin_amdgcn_cvt_scalef32_pk_f32_fp4(t, 1.0f, 1);
    const f32x2 c = __builtin_amdgcn_cvt_scalef32_pk_f32_fp4(t, 1.0f, 2), d = __builtin_amdgcn_cvt_scalef32_pk_f32_fp4(t, 1.0f, 3);
    const f32x2 e = __builtin_amdgcn_cvt_scalef32_pk_f32_fp4(u, 1.0f, 0), f = __builtin_amdgcn_cvt_scalef32_pk_f32_fp4(u, 1.0f, 1);
    const f32x2 g = __builtin_amdgcn_cvt_scalef32_pk_f32_fp4(u, 1.0f, 2), h = __builtin_amdgcn_cvt_scalef32_pk_f32_fp4(u, 1.0f, 3);
    return a.x == 0.f && a.y == 0.5f && b.x == 1.f && b.y == -1.5f && c.x == 2.f && c.y == 3.f && d.x == -4.f && d.y == 6.f
        && e.x == 0.f && e.y == 0.5f && f.x == 2.f && f.y == -3.f && g.x == 6.f && g.y == -4.f && h.x == 1.5f && h.y == 1.f;
}
__device__ __forceinline__ void table_row2_i4(const float* src, unsigned* dst, float* inv_scale, int lane) {
    f32x4 v[2][8]; float mx[2] = {0.f, 0.f};
#pragma unroll
    for (int r = 0; r < 2; ++r)
#pragma unroll
        for (int j = 0; j < 8; ++j) v[r][j] = ((const f32x4*)(src + (size_t)r * DM))[64 * j + lane];
#pragma unroll
    for (int r = 0; r < 2; ++r) {
#pragma unroll
        for (int j = 0; j < 8; ++j) mx[r] = fmaxf(mx[r], fmaxf(fmaxf(fabsf(v[r][j].x), fabsf(v[r][j].y)), fmaxf(fabsf(v[r][j].z), fabsf(v[r][j].w))));
#pragma unroll
        for (int o = 1; o < 64; o <<= 1) mx[r] = fmaxf(mx[r], __shfl_xor(mx[r], o));
        const float sc = mx[r] > 0.f ? mx[r] * 0.1f : 1.f, isc = 1.f / sc;
        unsigned short* drow = (unsigned short*)(dst + (size_t)r * 256);
#pragma unroll
        for (int j = 0; j < 8; ++j) { const f32x4 q4 = v[r][j];
            const int q0 = (int)fminf(fmaxf(rintf(q4.x * isc), -7.f), 7.f), q1 = (int)fminf(fmaxf(rintf(q4.y * isc), -7.f), 7.f);
            const int q2 = (int)fminf(fmaxf(rintf(q4.z * isc), -7.f), 7.f), q3 = (int)fminf(fmaxf(rintf(q4.w * isc), -7.f), 7.f);
            drow[64 * j + lane] = (unsigned short)((q0 & 15) | ((q1 & 15) << 4) | ((q2 & 15) << 8) | ((q3 & 15) << 12)); }
        if (lane == 0) inv_scale[r] = sc;
    }
}
__device__ __forceinline__ void table_row2(const float* src, unsigned* dst, float* inv_scale, int lane) {
    if (!fp4_hw_encoder_ok()) { table_row_sw(src, dst, inv_scale, lane); table_row_sw(src + DM, dst + 256, inv_scale + 1, lane); return; }
    f32x4 v[2][8]; float mx[2] = {0.f, 0.f};
#pragma unroll
    for (int r = 0; r < 2; ++r)
#pragma unroll
        for (int j = 0; j < 8; ++j) v[r][j] = ((const f32x4*)(src + (size_t)r * DM))[64 * j + lane];
#pragma unroll
    for (int r = 0; r < 2; ++r) {
#pragma unroll
        for (int j = 0; j < 8; ++j) mx[r] = fmaxf(mx[r], fmaxf(fmaxf(fabsf(v[r][j].x), fabsf(v[r][j].y)), fmaxf(fabsf(v[r][j].z), fabsf(v[r][j].w))));
#pragma unroll
        for (int o = 1; o < 64; o <<= 1) mx[r] = fmaxf(mx[r], __shfl_xor(mx[r], o));
        const float sc = mx[r] > 0.f ? mx[r] * (0.85f / 6.f) : 1.f, isc = 1.f / sc;
        unsigned short* drow = (unsigned short*)(dst + (size_t)r * 256);
#pragma unroll
        for (int j = 0; j < 8; ++j) { const f32x4 q4 = v[r][j];
            const float y0 = fminf(fmaxf(q4.x * isc, -6.f), 6.f), y1 = fminf(fmaxf(q4.y * isc, -6.f), 6.f), y2 = fminf(fmaxf(q4.z * isc, -6.f), 6.f), y3 = fminf(fmaxf(q4.w * isc, -6.f), 6.f);
            unsigned acc = __builtin_amdgcn_cvt_scalef32_pk_fp4_f32(0u, y0, y1, 1.0f, 0);
            acc = __builtin_amdgcn_cvt_scalef32_pk_fp4_f32(acc, y2, y3, 1.0f, 1);
            drow[64 * j + lane] = (unsigned short)(acc & 0xffffu); }
        if (lane == 0) inv_scale[r] = sc;
    }
}
#ifndef PEER_FAST_REDUCE
#define PEER_FAST_REDUCE 1
#endif
__device__ __forceinline__ float dpp_ror_add(float t, int) { return t; }
#define FP4_BYTE(d, j) __builtin_amdgcn_cvt_scalef32_pk_f32_fp4((d), 1.0f, (j))
__device__ __forceinline__ float dot_row(const v4u& a, const unsigned (&xh)[4], const unsigned (&xl)[4], float sh, float sl) {
    int hi = 0, lo = 0;
    hi = __builtin_amdgcn_sdot8((int)a.x, (int)xh[0], hi, false); lo = __builtin_amdgcn_sdot8((int)a.x, (int)xl[0], lo, false);
    hi = __builtin_amdgcn_sdot8((int)a.y, (int)xh[1], hi, false); lo = __builtin_amdgcn_sdot8((int)a.y, (int)xl[1], lo, false);
    hi = __builtin_amdgcn_sdot8((int)a.z, (int)xh[2], hi, false); lo = __builtin_amdgcn_sdot8((int)a.z, (int)xl[2], lo, false);
    hi = __builtin_amdgcn_sdot8((int)a.w, (int)xh[3], hi, false); lo = __builtin_amdgcn_sdot8((int)a.w, (int)xl[3], lo, false);
    return (float)hi * sh + (float)lo * sl;
}
__device__ __forceinline__ void axpy_row(const v4u& a, float wgt, float (&y)[32]) {
#pragma unroll
    for (int w = 0; w < 4; ++w) { const unsigned d = (w == 0) ? a.x : (w == 1) ? a.y : (w == 2) ? a.z : a.w;
        const f32x2 f0 = FP4_BYTE(d, 0), f1 = FP4_BYTE(d, 1), f2 = FP4_BYTE(d, 2), f3 = FP4_BYTE(d, 3);
        y[8 * w] += wgt * f0.x; y[8 * w + 1] += wgt * f0.y; y[8 * w + 2] += wgt * f1.x; y[8 * w + 3] += wgt * f1.y;
        y[8 * w + 4] += wgt * f2.x; y[8 * w + 5] += wgt * f2.y; y[8 * w + 6] += wgt * f3.x; y[8 * w + 7] += wgt * f3.y; }
}
#define DPP_ROR_MAX(t, n) fmaxf((t), __uint_as_float(__builtin_amdgcn_update_dpp(0u, __float_as_uint(t), 0x120 + (n), 0xf, 0xf, false)))
#define CSWAP(a, b) do { const float hi_ = fmaxf(a, b), lo_ = fminf(a, b); a = hi_; b = lo_; } while (0)
__device__ __forceinline__ void topk_token_fast(const float* __restrict__ srow, int lane, const float* inv_su, const float* inv_sv,
                                                LAS int* se, LAS float* sa, LAS float* sb) {
    const int l16 = lane & 15, row = lane >> 4;
    float R[4];
#pragma unroll
    for (int ps = 0; ps < 4; ++ps) {
        const f32x4 v0 = *(const f32x4*)(srow + (4 * ps + row) * 128 + 8 * l16), v1 = *(const f32x4*)(srow + (4 * ps + row) * 128 + 8 * l16 + 4);
        float k[8];
        k[0] = v0.x; k[1] = v0.y; k[2] = v0.z; k[3] = v0.w; k[4] = v1.x; k[5] = v1.y; k[6] = v1.z; k[7] = v1.w;
#pragma unroll
        for (int i = 0; i < 8; ++i) k[i] = __uint_as_float((__float_as_uint(k[i]) & 0xFFFFFF80u) | (unsigned)(8 * l16 + i));
        CSWAP(k[0], k[1]); CSWAP(k[2], k[3]); CSWAP(k[4], k[5]); CSWAP(k[6], k[7]);
        CSWAP(k[0], k[2]); CSWAP(k[1], k[3]); CSWAP(k[4], k[6]); CSWAP(k[5], k[7]);
        CSWAP(k[1], k[2]); CSWAP(k[5], k[6]);
        CSWAP(k[0], k[4]); CSWAP(k[1], k[5]); CSWAP(k[2], k[6]); CSWAP(k[3], k[7]);
        CSWAP(k[2], k[4]); CSWAP(k[3], k[5]);
        CSWAP(k[1], k[2]); CSWAP(k[3], k[4]); CSWAP(k[5], k[6]);
        float res = 0.f;
#pragma unroll
        for (int it = 0; it < 16; ++it) {
            float m = k[0];
            m = DPP_ROR_MAX(m, 8); m = DPP_ROR_MAX(m, 4); m = DPP_ROR_MAX(m, 2); m = DPP_ROR_MAX(m, 1);
            const bool own = (k[0] == m);
#pragma unroll
            for (int i = 0; i < 7; ++i) k[i] = own ? k[i + 1] : k[i];
            k[7] = own ? -INFINITY : k[7];
            res = (l16 == it) ? m : res;
        }
        R[ps] = res;
    }
#pragma unroll
    for (int g = 0; g < 2; ++g) {
        const auto sw = __builtin_amdgcn_permlane16_swap(__float_as_uint(R[2 * g]), __float_as_uint(R[2 * g + 1]), false, false);
        const float X = __uint_as_float(sw[0]), Y = __uint_as_float(sw[1]);
        const float a = __uint_as_float(__float_as_uint(X) & 0xFFFFFF80u);
        int j = 0;
        float v2 = __shfl(Y, (lane & 48));
        float best = 0.f;
#pragma unroll
        for (int it = 0; it < 16; ++it) {
            const float sum = a + __uint_as_float(__float_as_uint(v2) & 0xFFFFFF80u);
            const float cand = (j < 16) ? __uint_as_float((__float_as_uint(sum) & 0xFFFFFF00u) | (unsigned)((l16 << 4) | (j & 15))) : -INFINITY;
            float m = cand;
            m = DPP_ROR_MAX(m, 8); m = DPP_ROR_MAX(m, 4); m = DPP_ROR_MAX(m, 2); m = DPP_ROR_MAX(m, 1);
            best = (l16 == it) ? m : best;
            if (it < 15) { j += (cand == m) ? 1 : 0; v2 = __shfl(Y, (lane & 48) + (j & 15)); }
        }
        const unsigned bb = __float_as_uint(best);
        const int bi = (bb >> 4) & 15, bj = bb & 15;
        const unsigned k1 = __float_as_uint(__shfl(X, (lane & 48) + bi)), k2 = __float_as_uint(__shfl(Y, (lane & 48) + bj));
        const int e = (int)(k1 & 127u) * 128 + (int)(k2 & 127u);
        const float bv = __uint_as_float(bb & 0xFFFFFF00u);
        float mx = bv; mx = DPP_ROR_MAX(mx, 8); mx = DPP_ROR_MAX(mx, 4); mx = DPP_ROR_MAX(mx, 2); mx = DPP_ROR_MAX(mx, 1);
        const float ex = __expf(bv - mx);
        float sm = ex; sm = DPP_ROR_ADD(sm, 8); sm = DPP_ROR_ADD(sm, 4); sm = DPP_ROR_ADD(sm, 2); sm = DPP_ROR_ADD(sm, 1);
        const float gate = ex / sm;
        const int head = 4 * g + ((row & 1) * 2 + (row >> 1));
        se[head * 16 + l16] = e; sa[head * 16 + l16] = inv_su[e]; sb[head * 16 + l16] = gate * inv_sv[e];
    }
}
#define PEER_LOAD(DST, TAB, b) do { _Pragma("unroll") for (int r_ = 0; r_ < 4; ++r_) { const unsigned char* rp_ = (TAB) + (size_t)(unsigned)__builtin_amdgcn_readfirstlane(se[4 * (b) + r_]) * 1024 + 16 * lane; \
        DST[r_] = *(const v4u*)rp_; } } while (0)
__device__ __forceinline__ void peer_token(int t, const float* scores, const bf16_t* hn, const float* hbuf, const unsigned char* U8, const unsigned char* V8,
                                           const float* inv_su, const float* inv_sv, const float* gfin, float* out,
                                           LAS int* se, LAS float* sa, LAS float* sb, int lane_in) {
    int lane = lane_in;
    {
        LAS int* se0 = se + 512; LAS float* sa0 = sa + 512; LAS float* sb0 = sb + 512;
        topk_token_fast(scores + (size_t)t * DM, lane, inv_su, inv_sv, se0, sa0, sb0);
        unsigned a0 = ((unsigned)se0[lane] << 7) | (unsigned)lane, a1 = ((unsigned)se0[lane + 64] << 7) | (unsigned)(lane + 64);
#pragma unroll
        for (int k = 2; k <= 128; k <<= 1) {
#pragma unroll
            for (int j = k >> 1; j > 0; j >>= 1) {
                if (j == 64) { const unsigned lo = a0 < a1 ? a0 : a1, hi = a0 < a1 ? a1 : a0; a0 = lo; a1 = hi; }
                else {
                    const unsigned p0 = (unsigned)__shfl_xor((int)a0, j), p1 = (unsigned)__shfl_xor((int)a1, j);
                    const bool lower = (lane & j) == 0;
                    const bool up0 = (lane & k) == 0, up1 = ((lane + 64) & k) == 0;
                    const unsigned mn0 = a0 < p0 ? a0 : p0, mx0 = a0 < p0 ? p0 : a0, mn1 = a1 < p1 ? a1 : p1, mx1 = a1 < p1 ? p1 : a1;
                    a0 = (up0 == lower) ? mn0 : mx0; a1 = (up1 == lower) ? mn1 : mx1;
                }
            }
        }
        const int k0 = a0 & 127, k1 = a1 & 127;
        se[lane] = (int)(a0 >> 7); sa[lane] = sa0[k0]; sb[lane] = sb0[k0];
        se[lane + 64] = (int)(a1 >> 7); sa[lane + 64] = sa0[k1]; sb[lane + 64] = sb0[k1];
    }
    asm volatile("" : "+v"(lane));
    float y[32];
    unsigned xh[4], xl[4]; float sh, sl;
    {
        float xf[32]; float mx = 0.f;
#pragma unroll
        for (int j = 0; j < 4; ++j) {
            const v4u h0 = *(const v4u*)(hn + (size_t)t * DM + 32 * lane + 8 * j);
#pragma unroll
            for (int w = 0; w < 4; ++w) { const unsigned d0 = (w == 0) ? h0.x : (w == 1) ? h0.y : (w == 2) ? h0.z : h0.w;
                xf[8 * j + 2 * w] = __uint_as_float(d0 << 16); xf[8 * j + 2 * w + 1] = __uint_as_float(d0 & 0xffff0000u);
                mx = fmaxf(mx, fmaxf(fabsf(xf[8 * j + 2 * w]), fabsf(xf[8 * j + 2 * w + 1]))); }
        }
#pragma unroll
        for (int o = 1; o < 64; o <<= 1) mx = fmaxf(mx, __shfl_xor(mx, o));
        sh = mx > 0.f ? mx * (1.f / 7.f) : 1.f; sl = sh * (1.f / 14.f);
        const float ish = 1.f / sh, isl = 1.f / sl;
#pragma unroll
        for (int w = 0; w < 4; ++w) { unsigned ph = 0u, pl = 0u;
#pragma unroll
            for (int i = 0; i < 8; ++i) { const float xe = xf[8 * w + i];
                const float qh = fminf(fmaxf(rintf(xe * ish), -7.f), 7.f);
                const float ql = fminf(fmaxf(rintf((xe - qh * sh) * isl), -7.f), 7.f);
                ph |= ((unsigned)(int)qh & 15u) << (4 * i); pl |= ((unsigned)(int)ql & 15u) << (4 * i); }
            xh[w] = ph; xl[w] = pl; }
    }
#pragma unroll
    for (int i = 0; i < 32; ++i) y[i] = 0.f;
    v4u Ua[4], Ub[4], Va[4];
#define PEER_BATCH(b, UC, VC) do { \
        PEER_LOAD(VC, V8, (b)); \
        float pr[4]; \
        _Pragma("unroll") for (int r = 0; r < 4; ++r) pr[r] = dot_row(UC[r], xh, xl, sh, sl); \
        if ((b) + 2 < 32) PEER_LOAD(UC, U8, (b) + 2); \
        float wr_[4], q2[2]; \
        _Pragma("unroll") for (int r = 0; r < 2; ++r) { auto sw = __builtin_amdgcn_permlane32_swap(__float_as_uint(pr[r]), __float_as_uint(pr[r + 2]), false, false); q2[r] = __uint_as_float(sw[0]) + __uint_as_float(sw[1]); } \
        float tv; \
        { auto sw = __builtin_amdgcn_permlane16_swap(__float_as_uint(q2[0]), __float_as_uint(q2[1]), false, false); tv = __uint_as_float(sw[0]) + __uint_as_float(sw[1]); } \
        tv = DPP_ROR_ADD(tv, 8); tv = DPP_ROR_ADD(tv, 4); tv = DPP_ROR_ADD(tv, 2); tv = DPP_ROR_ADD(tv, 1); \
        const int k = 4 * (b) + (lane >> 4);     \
        const float wc = gelu_erf(tv * sa[k]) * sb[k]; \
        _Pragma("unroll") for (int r = 0; r < 4; ++r) wr_[r] = __uint_as_float(__builtin_amdgcn_readlane(__float_as_uint(wc), 16 * r)); \
        _Pragma("unroll") for (int r = 0; r < 4; ++r) axpy_row(VC[r], wr_[r], y); } while (0)
    PEER_LOAD(Ua, U8, 0); PEER_LOAD(Ub, U8, 1);
#pragma unroll 1
    for (int b = 0; b < 32; b += 2) { PEER_BATCH(b, Ua, Va); PEER_BATCH(b + 1, Ub, Va); }
    float ss = 0.f;
#pragma unroll
    for (int j = 0; j < 8; ++j) { const f32x4 hv = *(const f32x4*)(hbuf + (size_t)t * DM + 32 * lane + 4 * j);
        y[4 * j] += hv.x; y[4 * j + 1] += hv.y; y[4 * j + 2] += hv.z; y[4 * j + 3] += hv.w;
        ss += (y[4 * j] * y[4 * j] + y[4 * j + 1] * y[4 * j + 1]) + (y[4 * j + 2] * y[4 * j + 2] + y[4 * j + 3] * y[4 * j + 3]); }
    ss = wave_sum(ss);
    const float rstd = rsqrtf(ss * (1.f / DM) + EPS);
#pragma unroll
    for (int j = 0; j < 8; ++j) { const f32x4 gg = *(const f32x4*)(gfin + 32 * lane + 4 * j);
        f32x4 o; o.x = y[4 * j] * rstd * gg.x; o.y = y[4 * j + 1] * rstd * gg.y; o.z = y[4 * j + 2] * rstd * gg.z; o.w = y[4 * j + 3] * rstd * gg.w;
        *(f32x4*)(out + (size_t)t * DM + 32 * lane + 4 * j) = o; }
}
typedef short bf16x8 __attribute__((ext_vector_type(8)));
__device__ __forceinline__ int pos32(int x) { const int g = x & ~31, l = x & 31; return g + 8 * ((l & 15) >> 2) + 4 * (l >> 4) + (l & 3); }
constexpr size_t PB_H_QG = 0, PB_H_KDT = 32 * MiB, PB_H_A = 64 * MiB;
constexpr size_t PB_G_QS = 80 * MiB, PB_G_KT = 96 * MiB;
constexpr size_t PB_G_W = 112 * MiB, PB_G_A = 144 * MiB, PB_G_U = 160 * MiB;
constexpr int CA = 96;
constexpr int PROG_WORD = 3584;
constexpr int NSB = 128, CPW = 4;
constexpr int SC_QG = 0, SC_WV = 16384, SC_KDT = 32768, SC_A = 49152, SC_BUF = 57344, SC_VEC = 2 * SC_BUF, SC_OT = SC_VEC + 2048, SC_OTB = 17408, SC_GAIN = SC_OT + 2 * SC_OTB;

__device__ __forceinline__ bf16x8 pack_frag(const f32x4& x0, const f32x4& x1) {
    v4u w; w.x = pk2(x0.x, x0.y); w.y = pk2(x0.z, x0.w); w.z = pk2(x1.x, x1.y); w.w = pk2(x1.z, x1.w);
    return __builtin_bit_cast(bf16x8, w);
}
#define MFMA16(a, b, c) __builtin_amdgcn_mfma_f32_16x16x32_bf16((a), (b), (c), 0, 0, 0)

__device__ __forceinline__ void hgrn_prep_item(int item, const bf16_t* proj, const float* lb_logits, unsigned char* pb, float* vecs, LAS unsigned char* lds, int tid) {
    const int c = item & 127, sq = item >> 7, b = sq >> 3, h = sq & 7, t0 = b * SEQ + c * 64;
    const int d = tid & 127, seg = tid >> 7, lane = tid & 63, wave = tid >> 6;
    LAS bf16_t* QGl = (LAS bf16_t*)lds; LAS bf16_t* KGl = (LAS bf16_t*)(lds + 17408); LAS float* segsum = (LAS float*)(lds + 34816);
    bf16_t* gQG = (bf16_t*)(pb + PB_H_QG) + (size_t)item * 8192;
    bf16_t* gKDT = (bf16_t*)(pb + PB_H_KDT) + (size_t)item * 8192;
    bf16_t* gA = (bf16_t*)(pb + PB_H_A) + (size_t)item * 4096;
    float* gvec = vecs + (size_t)item * 256;
    const float l0 = lb_logits[h * 128 + d], l1 = lb_logits[1024 + h * 128 + d];
    const float lb = 1.f / (1.f + __expf(l1 - l0));
    float lf[16], qv[16], kv[16];
#pragma unroll
    for (int i = 0; i < 16; ++i) {
        const bf16_t* pr = proj + (size_t)(t0 + 16 * seg + i) * NPROJ + h * 128 + d;
        const float z = bf2f(pr[C_AF]); qv[i] = bf2f(pr[C_AQ]);
        const float f = lb + (1.f - lb) * sigmoidf_(z);
        lf[i] = __logf(f); kv[i] = 1.f - f;
    }
    float run = 0.f;
#pragma unroll
    for (int i = 0; i < 16; ++i) { run += lf[i]; lf[i] = run; }
    segsum[seg * 128 + d] = run;
    __syncthreads();
    float off = 0.f, bl = 0.f;
#pragma unroll
    for (int s = 0; s < 4; ++s) { const float v = segsum[s * 128 + d]; bl += v; if (s < seg) off += v; }
    const int pd = pos32(d);
    float kd[16];
#pragma unroll
    for (int i = 0; i < 16; ++i) {
        const float bc = lf[i] + off; const int tl = 16 * seg + i;
        const float qg = qv[i] * __expf(bc), kg = kv[i] * __expf(-bc);
        kd[i] = kv[i] * __expf(bl - bc);
        const bf16_t qb = f2bf(qg);
        QGl[tl * 136 + d] = qb; KGl[tl * 136 + d] = f2bf(kg);
        gQG[tl * 128 + pd] = qb;
    }
#pragma unroll
    for (int ii = 0; ii < 4; ++ii) { v2u o; o.x = pk2(kd[4 * ii], kd[4 * ii + 1]); o.y = pk2(kd[4 * ii + 2], kd[4 * ii + 3]);
        *(v2u*)(gKDT + d * 64 + 32 * (seg >> 1) + 8 * ii + 4 * (seg & 1)) = o; }
    if (seg == 0) gvec[128 + d] = __expf(bl);
    __syncthreads();
    const int n = lane & 15, q = lane >> 4;
#pragma unroll
    for (int ti = 0; ti < 2; ++ti) {
        const int id = wave + 8 * ti, mt = id >> 2, ns = id & 3;
        f32x4 acc = {0.f, 0.f, 0.f, 0.f};
        if (ns <= mt) {
#pragma unroll
            for (int s4 = 0; s4 < 4; ++s4) {
                const bf16x8 a = *(const LAS bf16x8*)(QGl + (16 * mt + n) * 136 + 32 * s4 + 8 * q);
                const bf16x8 bb = *(const LAS bf16x8*)(KGl + (16 * ns + n) * 136 + 32 * s4 + 8 * q);
                acc = MFMA16(a, bb, acc);
            }
        }
        const int s = 16 * ns + n, ps = pos32(s);
#pragma unroll
        for (int r = 0; r < 4; ++r) { const int t = 16 * mt + 4 * q + r; const float v = (r == 0) ? acc.x : (r == 1) ? acc.y : (r == 2) ? acc.z : acc.w;
            gA[t * 64 + ps] = f2bf((s <= t) ? v : 0.f); }
    }
    __syncthreads();
}

constexpr int GP_QF = 0, GP_KF = 33024, GP_N = 0, GP_QB = 66048, GP_KB = 83456, GP_VB = 100864, GP_PART = 135680, GP_SB = 137728;
__device__ __forceinline__ void gdn_prep_item(int item, const bf16_t* proj, const float* ba, const float* conv_w, const float* A_log, const float* dt_bias,
                                              unsigned char* pb, float* vecs, LAS unsigned char* lds, int tid) {
    const int c = item & 127, bq = item >> 7, b = bq >> 2, qh = bq & 3, t0 = b * SEQ + c * 64;
    const int lane = tid & 63, wave = tid >> 6;
    LAS float* QF = (LAS float*)(lds + GP_QF); LAS float* KF = (LAS float*)(lds + GP_KF);
    LAS bf16_t* QB = (LAS bf16_t*)(lds + GP_QB); LAS bf16_t* KB = (LAS bf16_t*)(lds + GP_KB); LAS bf16_t* VB = (LAS bf16_t*)(lds + GP_VB);
    LAS float* PART = (LAS float*)(lds + GP_PART); LAS float* SBETA = (LAS float*)(lds + GP_SB); LAS float* SGC = SBETA + 128;
    LAS float* NM = (LAS float*)(lds + GP_N);
    {
        int col, wch; const int dd = tid & 127;
        if (tid < 128) { col = C_BQ + qh * 128 + dd; wch = qh * 128 + dd; }
        else if (tid < 256) { col = C_BK + qh * 128 + dd; wch = 512 + qh * 128 + dd; }
        else { const int vh = 2 * qh + ((tid - 256) >> 7); col = C_BV + vh * 128 + dd; wch = 1024 + vh * 128 + dd; }
        const float w0 = conv_w[wch], w1 = conv_w[2048 + wch], w2 = conv_w[4096 + wch], w3 = conv_w[6144 + wch];
        float h0 = 0.f, h1 = 0.f, h2 = 0.f;
        const bf16_t* pr = proj + (size_t)t0 * NPROJ + col;
        if (c > 0) { h0 = bf2f(pr[-3 * NPROJ]); h1 = bf2f(pr[-2 * NPROJ]); h2 = bf2f(pr[-1 * NPROJ]); }
        unsigned xr[64];
#pragma unroll
        for (int t = 0; t < 64; ++t) xr[t] = pr[(size_t)t * NPROJ];
#pragma unroll
        for (int t = 0; t < 64; ++t) {
            const float xx = __uint_as_float(xr[t] << 16);
            const float yv = siluf_(w0 * h0 + w1 * h1 + w2 * h2 + w3 * xx);
            h0 = h1; h1 = h2; h2 = xx;
            if (tid < 128) QF[t * 129 + dd] = yv;
            else if (tid < 256) KF[t * 129 + dd] = yv;
            else VB[((tid - 256) >> 7) * 8704 + t * 136 + dd] = f2bf(yv);
        }
    }
    __syncthreads();
    {
        const int t = tid & 63, part = tid >> 6, which = part >> 2, sub = part & 3;
        const LAS float* src = (which ? KF : QF) + t * 129 + 32 * sub;
        float s = 0.f;
#pragma unroll
        for (int i = 0; i < 32; ++i) s += src[i] * src[i];
        PART[(which * 4 + sub) * 64 + t] = s;
    }
    if (wave < 2) {
        const int vh = 2 * qh + wave;
        const float ax = ba[(size_t)(t0 + lane) * 16 + 8 + vh] + dt_bias[vh];
        const float sp = ax > 20.f ? ax : log1pf(__expf(ax));
        float gc = -__expf(A_log[vh]) * sp;
#pragma unroll
        for (int o = 1; o < 64; o <<= 1) { const float up = __shfl_up(gc, o); if (lane >= o) gc += up; }
        const float gl = __shfl(gc, 63);
        const float beta = sigmoidf_(ba[(size_t)(t0 + lane) * 16 + vh]);
        SBETA[wave * 64 + lane] = beta; SGC[wave * 64 + lane] = gc;
        float* gvec = vecs + ((size_t)(16 + b * 8 + vh) * 128 + c) * 256;
        gvec[lane] = __expf(gc); gvec[64 + lane] = __expf(gl - gc);
        const float dl = __expf(gl); gvec[128 + lane] = dl; gvec[192 + lane] = dl;
    }
    __syncthreads();
    {
        const int d = tid & 127, seg = tid >> 7, pd = pos32(d);
        bf16_t* gQS = (bf16_t*)(pb + PB_G_QS) + (size_t)item * 8192;
        bf16_t* gKT = (bf16_t*)(pb + PB_G_KT) + (size_t)item * 8192;
        float kk[16];
#pragma unroll
        for (int i = 0; i < 16; ++i) {
            const int tl = 16 * seg + i;
            const float sq = PART[0 * 64 + tl] + PART[1 * 64 + tl] + PART[2 * 64 + tl] + PART[3 * 64 + tl];
            const float sk = PART[4 * 64 + tl] + PART[5 * 64 + tl] + PART[6 * 64 + tl] + PART[7 * 64 + tl];
            const bf16_t qb = f2bf(QF[tl * 129 + d] * rsqrtf(sq + EPS) * 0.08838834764831845f);
            const bf16_t kb = f2bf(KF[tl * 129 + d] * rsqrtf(sk + EPS));
            QB[tl * 136 + d] = qb; KB[tl * 136 + d] = kb; gQS[tl * 128 + pd] = qb; kk[i] = bf2f(kb);
        }
#pragma unroll
        for (int ii = 0; ii < 4; ++ii) { v2u o; o.x = pk2(kk[4 * ii], kk[4 * ii + 1]); o.y = pk2(kk[4 * ii + 2], kk[4 * ii + 3]);
            *(v2u*)(gKT + d * 64 + 32 * (seg >> 1) + 8 * ii + 4 * (seg & 1)) = o; }
    }
    __syncthreads();
    {
        const int n = lane & 15, q = lane >> 4;
#pragma unroll
        for (int ti = 0; ti < 2; ++ti) {
            const int id = 2 * wave + ti, mt = id >> 2, ns = id & 3;
            f32x4 akk = {0.f, 0.f, 0.f, 0.f}, aqk = {0.f, 0.f, 0.f, 0.f};
            if (ns <= mt) {
#pragma unroll
                for (int s4 = 0; s4 < 4; ++s4) {
                    const bf16x8 kb_ = *(const LAS bf16x8*)(KB + (16 * ns + n) * 136 + 32 * s4 + 8 * q);
                    const bf16x8 ka_ = *(const LAS bf16x8*)(KB + (16 * mt + n) * 136 + 32 * s4 + 8 * q);
                    const bf16x8 qa_ = *(const LAS bf16x8*)(QB + (16 * mt + n) * 136 + 32 * s4 + 8 * q);
                    akk = MFMA16(ka_, kb_, akk); aqk = MFMA16(qa_, kb_, aqk);
                }
            }
            const int s = 16 * ns + n, ps = pos32(s);
#pragma unroll
            for (int vl = 0; vl < 2; ++vl) {
                bf16_t* gA = (bf16_t*)(pb + PB_G_A) + ((size_t)((b * 8 + 2 * qh + vl) * 128 + c)) * 4096;
                const float gcs = SGC[vl * 64 + s];
#pragma unroll
                for (int r = 0; r < 4; ++r) {
                    const int t = 16 * mt + 4 * q + r;
                    const float vk = (r == 0) ? akk.x : (r == 1) ? akk.y : (r == 2) ? akk.z : akk.w;
                    const float vq = (r == 0) ? aqk.x : (r == 1) ? aqk.y : (r == 2) ? aqk.z : aqk.w;
                    const float ex = (s <= t) ? __expf(SGC[vl * 64 + t] - gcs) : 0.f;
                    NM[vl * 4096 + t * 64 + s] = (s < t) ? SBETA[vl * 64 + t] * vk * ex : 0.f;
                    gA[t * 64 + ps] = f2bf((s <= t) ? vq * ex : 0.f);
                }
            }
        }
    }
    __syncthreads();
    {
        const int vl = tid >> 8, colx = tid & 255;
        float x[64];
        if (colx < 128) {
#pragma unroll
            for (int t = 0; t < 64; ++t) x[t] = SBETA[vl * 64 + t] * bf2f(VB[vl * 8704 + t * 136 + colx]);
        } else {
#pragma unroll
            for (int t = 0; t < 64; ++t) x[t] = SBETA[vl * 64 + t] * __expf(SGC[vl * 64 + t]) * bf2f(KB[t * 136 + colx - 128]);
        }
        __syncthreads();
        const LAS float* Nv = NM + vl * 4096;
#pragma unroll
        for (int t = 1; t < 64; ++t) {
            float acc = x[t];
#pragma unroll
            for (int s4 = 0; s4 < (t + 3) / 4; ++s4) {
                const f32x4 nn = *(const LAS f32x4*)(Nv + t * 64 + 4 * s4);
                acc -= nn.x * x[4 * s4]; if (4 * s4 + 1 < t) acc -= nn.y * x[4 * s4 + 1]; if (4 * s4 + 2 < t) acc -= nn.z * x[4 * s4 + 2]; if (4 * s4 + 3 < t) acc -= nn.w * x[4 * s4 + 3];
            }
            x[t] = acc;
        }
        if (colx < 128) {
            bf16_t* gU = (bf16_t*)(pb + PB_G_U) + ((size_t)((b * 8 + 2 * qh + vl) * 128 + c)) * 8192;
            const int sl = colx >> 4, n = colx & 15;
#pragma unroll
            for (int mt = 0; mt < 4; ++mt)
#pragma unroll
                for (int q = 0; q < 4; ++q) { v2u o; o.x = pk2(x[16 * mt + 4 * q], x[16 * mt + 4 * q + 1]); o.y = pk2(x[16 * mt + 4 * q + 2], x[16 * mt + 4 * q + 3]);
                    *(v2u*)(gU + ((size_t)((sl * 4 + mt) * 64 + q * 16 + n)) * 4) = o; }
        } else {
            LAS bf16_t* WS = (LAS bf16_t*)(lds + GP_QB) + vl * 8704;
            const int pd = pos32(colx - 128);
#pragma unroll
            for (int t = 0; t < 64; ++t) WS[t * 136 + pd] = f2bf(-x[t]);
        }
    }
    __syncthreads();
    {
#pragma unroll
        for (int i = 0; i < 4; ++i) { const int p = tid + 512 * i, vl = p >> 10, row = (p >> 4) & 63, c16 = p & 15;
            bf16_t* gW = (bf16_t*)(pb + PB_G_W) + ((size_t)((b * 8 + 2 * qh + vl) * 128 + c)) * 8192;
            *(v4u*)(gW + row * 128 + c16 * 8) = *(const LAS v4u*)(lds + GP_QB + vl * 17408 + row * 272 + c16 * 16); }
    }
    __syncthreads();
}

struct ScanSrc { const unsigned char* qg; const unsigned char* wv; const unsigned char* kdt; const unsigned char* a; const float* vec; size_t wv_row; };
__device__ __forceinline__ void scan_dma(const ScanSrc& S, LAS unsigned char* buf, LAS unsigned char* vecb, int w, int lane) {
#pragma unroll
    for (int i = 0; i < 2; ++i) { const int pi = 2 * w + i, row = 4 * pi + (lane >> 4), cl = (lane & 15) ^ (row & 15);
        __builtin_amdgcn_global_load_lds((const unsigned*)(S.qg + row * 256 + cl * 16), (LAS unsigned*)(buf + SC_QG + pi * 1024), 16, 0, 0);
        __builtin_amdgcn_global_load_lds((const unsigned*)(S.wv + (size_t)row * S.wv_row + cl * 16), (LAS unsigned*)(buf + SC_WV + pi * 1024), 16, 0, 0); }
#pragma unroll
    for (int i = 0; i < 2; ++i) { const int pi = 2 * w + i, row = 8 * pi + (lane >> 3), cl = (lane & 7) ^ ((row >> 1) & 7);
        __builtin_amdgcn_global_load_lds((const unsigned*)(S.kdt + row * 128 + cl * 16), (LAS unsigned*)(buf + SC_KDT + pi * 1024), 16, 0, 0); }
    { const int pi = w, row = 8 * pi + (lane >> 3), cl = (lane & 7) ^ ((row >> 1) & 7);
        __builtin_amdgcn_global_load_lds((const unsigned*)(S.a + row * 128 + cl * 16), (LAS unsigned*)(buf + SC_A + pi * 1024), 16, 0, 0); }
    if (w == 0) __builtin_amdgcn_global_load_lds((const unsigned*)((const unsigned char*)S.vec + lane * 16), (LAS unsigned*)vecb, 16, 0, 0);
}
template <bool GDN>
__device__ __forceinline__ void scan_block(int sq, int g, const bf16_t* proj, const unsigned char* pb, const float* vecs, const float* hgrn_g, const float* gdn_g,
                                           bf16_t* mix, unsigned* prog, int nfb, LAS unsigned char* lds, int tid) {
    constexpr bool gdn = GDN;
    const int b = (sq & 15) >> 3, hh = sq & 7, lane = tid & 63, sl = __builtin_amdgcn_readfirstlane(tid >> 6), n = lane & 15, q = lane >> 4;
    const unsigned char* bQG; const unsigned char* bWV; const unsigned char* bKDT; const unsigned char* bA; const unsigned char* bU = nullptr;
    size_t wv_row, wv_chunk; int gate_col, mix_col; const float* gain;
    if (!gdn) {
        const size_t s0 = (size_t)(b * 8 + hh) * 128;
        bQG = pb + PB_H_QG + s0 * 16384; bKDT = pb + PB_H_KDT + s0 * 16384; bA = pb + PB_H_A + s0 * 8192;
        bWV = (const unsigned char*)(proj + (size_t)(b * SEQ) * NPROJ + C_AI + hh * 128); wv_row = (size_t)NPROJ * 2; wv_chunk = (size_t)64 * NPROJ * 2;
        gate_col = C_AG + hh * 128; mix_col = hh * 128; gain = hgrn_g;
    } else {
        const size_t s0 = (size_t)(b * 8 + hh) * 128, q0 = (size_t)(b * 4 + (hh >> 1)) * 128;
        bQG = pb + PB_G_QS + q0 * 16384; bKDT = pb + PB_G_KT + q0 * 16384; bA = pb + PB_G_A + s0 * 8192;
        bWV = pb + PB_G_W + s0 * 16384; wv_row = 256; wv_chunk = 16384; bU = pb + PB_G_U + s0 * 16384;
        gate_col = C_BZ + hh * 128; mix_col = 1024 + hh * 128; gain = gdn_g;
    }
    const float* bvec = vecs + (size_t)sq * 128 * 256;
    LAS float* gainl = (LAS float*)(lds + SC_GAIN);
    const int wave = sl;
    {
        ScanSrc src{bQG, bWV, bKDT, bA, bvec, wv_row};
        scan_dma(src, lds, lds + SC_VEC, wave, lane);
        if (tid < 128) gainl[tid] = gain[tid];
    }
    __builtin_amdgcn_s_waitcnt(0x0070);
    asm volatile("" ::: "memory");
    __builtin_amdgcn_s_barrier();
    asm volatile("" ::: "memory");
#define SCAN_BAR() do { asm volatile("s_waitcnt lgkmcnt(0)" ::: "memory"); __builtin_amdgcn_s_barrier(); asm volatile("" ::: "memory"); } while (0)
#define SCHED_FENCE() __builtin_amdgcn_sched_barrier(0)
    const int sl16 = 2 * g + wave;
    const int hw = (wave == 2) ? 0 : (wave == 3) ? 1 : (wave == 6) ? 2 : (wave == 7) ? 3 : -1;
    if (wave < 2) {
        f32x4 S[8];
        bf16x8 Sf[4];
#pragma unroll
        for (int m = 0; m < 8; ++m) S[m] = (f32x4){0.f, 0.f, 0.f, 0.f};
#pragma unroll
        for (int s4 = 0; s4 < 4; ++s4) Sf[s4] = pack_frag(S[0], S[1]);
        v2u Ureg[4];
#pragma unroll
        for (int mt = 0; mt < 4; ++mt) Ureg[mt] = GDN ? *(const v2u*)(bU + (size_t)(sl16 * 4 + mt) * 512 + lane * 8) : (v2u){0u, 0u};
        for (int c = 0; c < 128; ++c) {
            int lane = tid & 63; asm volatile("" : "+v"(lane));
            const int n = lane & 15, q = lane >> 4;
            const int cur = c & 1;
            LAS unsigned char* buf = lds + cur * SC_BUF;
            const LAS float* vec = (const LAS float*)(lds + SC_VEC + cur * 1024);
            const int cn = (c + 1 < 128) ? c + 1 : 127;
            f32x4 VN[4];
            bf16x8 fa[8], fb[8];
            bf16x8 VNf[2], VNSf[2];
#define SC3_LD8_K128(dst, OFF, mt_) do { _Pragma("unroll") for (int i_ = 0; i_ < 8; ++i_) dst[i_] = *(const LAS bf16x8*)(buf + (OFF) + (16 * ((mt_) + (i_ >> 2)) + n) * 256 + (((4 * (i_ & 3) + q) ^ n) * 16)); } while (0)
#define SC3_LD8_K64(dst, OFF, mb) do { _Pragma("unroll") for (int i_ = 0; i_ < 8; ++i_) dst[i_] = *(const LAS bf16x8*)(buf + (OFF) + (16 * ((mb) + (i_ >> 1)) + n) * 128 + (((4 * (i_ & 1) + q) ^ ((n >> 1) & 7)) * 16)); } while (0)
#define SC3_MM_K128(A0, A1, fr) do { _Pragma("unroll") for (int i_ = 0; i_ < 4; ++i_) { A0 = MFMA16(fr[i_], Sf[i_], A0); A1 = MFMA16(fr[4 + i_], Sf[i_], A1); } } while (0)
#define SC3_MM_K64(X, ma, fr, BF) do { _Pragma("unroll") for (int t_ = 0; t_ < 4; ++t_) { X[(ma) + t_] = MFMA16(fr[2 * t_], BF[0], X[(ma) + t_]); X[(ma) + t_] = MFMA16(fr[2 * t_ + 1], BF[1], X[(ma) + t_]); } } while (0)
#define SC3_DLOAD(m) (*(const LAS f32x4*)(vec + 128 + 16 * (m) + 4 * q))
#define SC3_EGLOAD(mt) (*(const LAS f32x4*)(vec + 16 * (mt) + 4 * q))
#define SC3_PACK_S(s4) do { Sf[s4] = pack_frag(S[2 * (s4)], S[2 * (s4) + 1]); } while (0)
#define SC3_OT_WRITE() do { LAS bf16_t* OT_ = (LAS bf16_t*)(lds + SC_OT + cur * SC_OTB); const int cc_ = 16 * sl16 + n; \
                _Pragma("unroll") for (int mt = 0; mt < 4; ++mt) { \
                    OT_[(16 * mt + 4 * q + 0) * 136 + cc_] = f2bf(O[mt].x); OT_[(16 * mt + 4 * q + 1) * 136 + cc_] = f2bf(O[mt].y); \
                    OT_[(16 * mt + 4 * q + 2) * 136 + cc_] = f2bf(O[mt].z); OT_[(16 * mt + 4 * q + 3) * 136 + cc_] = f2bf(O[mt].w); } } while (0)
            f32x4 dA, dB, dC, dD;
            f32x4 O[4];
            if (GDN) {
#pragma unroll
                for (int mt = 0; mt < 4; ++mt) { const v2u uu = Ureg[mt];
                    VN[mt] = (f32x4){__uint_as_float(uu.x << 16), __uint_as_float(uu.x & 0xffff0000u), __uint_as_float(uu.y << 16), __uint_as_float(uu.y & 0xffff0000u)}; }
                SC3_LD8_K128(fa, SC_WV, 0); SCHED_FENCE();
                SC3_LD8_K128(fb, SC_WV, 2); SCHED_FENCE();
#pragma unroll
                for (int mt = 0; mt < 4; ++mt) Ureg[mt] = *(const v2u*)(bU + (size_t)cn * 16384 + (size_t)(sl16 * 4 + mt) * 512 + lane * 8);
                f32x4 eS[4];
#pragma unroll
                for (int i = 0; i < 4; ++i) eS[i] = *(const LAS f32x4*)(vec + 64 + 16 * i + 4 * q);
                dA = SC3_DLOAD(0); dB = SC3_DLOAD(1); dC = SC3_DLOAD(2); dD = SC3_DLOAD(3);
                SCHED_FENCE();
                SC3_PACK_S(3); SC3_MM_K128(VN[0], VN[1], fa); S[0] = S[0] * dA; S[1] = S[1] * dB; S[2] = S[2] * dC; S[3] = S[3] * dD; SCHED_FENCE();
                SC3_LD8_K128(fa, SC_QG, 0); dA = SC3_DLOAD(4); dB = SC3_DLOAD(5); dC = SC3_DLOAD(6); dD = SC3_DLOAD(7); SCHED_FENCE();
                SC3_MM_K128(VN[2], VN[3], fb); S[4] = S[4] * dA; S[5] = S[5] * dB; S[6] = S[6] * dC; S[7] = S[7] * dD; SCHED_FENCE();
                SC3_LD8_K128(fb, SC_QG, 2); dA = SC3_EGLOAD(0); dB = SC3_EGLOAD(1); SCHED_FENCE();
#pragma unroll
                for (int mt = 0; mt < 4; ++mt) O[mt] = (f32x4){0.f, 0.f, 0.f, 0.f};
                SC3_MM_K128(O[0], O[1], fa);
#pragma unroll
                for (int s2 = 0; s2 < 2; ++s2) { VNf[s2] = pack_frag(VN[2 * s2], VN[2 * s2 + 1]); VNSf[s2] = pack_frag(VN[2 * s2] * eS[2 * s2], VN[2 * s2 + 1] * eS[2 * s2 + 1]); }
                SCHED_FENCE();
                SC3_LD8_K64(fa, SC_A, 0); dC = SC3_EGLOAD(2); dD = SC3_EGLOAD(3); SCHED_FENCE();
                SC3_MM_K128(O[2], O[3], fb); O[0] = O[0] * dA; O[1] = O[1] * dB; SCHED_FENCE();
                SC3_LD8_K64(fb, SC_KDT, 0); SCHED_FENCE();
                O[2] = O[2] * dC; O[3] = O[3] * dD;
            } else {
                SC3_LD8_K128(fa, SC_QG, 0); SCHED_FENCE();
                SC3_LD8_K128(fb, SC_QG, 2); SCHED_FENCE();
#pragma unroll
                for (int s2 = 0; s2 < 2; ++s2) { unsigned w[4];
#pragma unroll
                    for (int jj = 0; jj < 4; ++jj) { const int ja = 2 * jj, jb = 2 * jj + 1; const int cc = 16 * sl16 + n;
                        const int ta = 32 * s2 + ((ja < 4) ? 4 * q + ja : 16 + 4 * q + ja - 4), tb = 32 * s2 + ((jb < 4) ? 4 * q + jb : 16 + 4 * q + jb - 4);
                        const unsigned lo = *(const LAS bf16_t*)(buf + SC_WV + ta * 256 + (((cc >> 3) ^ (ta & 15)) * 16) + (cc & 7) * 2), hi = *(const LAS bf16_t*)(buf + SC_WV + tb * 256 + (((cc >> 3) ^ (tb & 15)) * 16) + (cc & 7) * 2);
                        w[jj] = lo | (hi << 16); }
                    v4u ww; ww.x = w[0]; ww.y = w[1]; ww.z = w[2]; ww.w = w[3];
                    VNf[s2] = __builtin_bit_cast(bf16x8, ww); VNSf[s2] = VNf[s2]; }
                dA = SC3_DLOAD(0); dB = SC3_DLOAD(1); dC = SC3_DLOAD(2); dD = SC3_DLOAD(3);
                SCHED_FENCE();
#pragma unroll
                for (int mt = 0; mt < 4; ++mt) O[mt] = (f32x4){0.f, 0.f, 0.f, 0.f};
                SC3_PACK_S(3); SC3_MM_K128(O[0], O[1], fa); S[0] = S[0] * dA; S[1] = S[1] * dB; S[2] = S[2] * dC; S[3] = S[3] * dD; SCHED_FENCE();
                SC3_LD8_K64(fa, SC_A, 0); dA = SC3_DLOAD(4); dB = SC3_DLOAD(5); dC = SC3_DLOAD(6); dD = SC3_DLOAD(7); SCHED_FENCE();
                SC3_MM_K128(O[2], O[3], fb); S[4] = S[4] * dA; S[5] = S[5] * dB; S[6] = S[6] * dC; S[7] = S[7] * dD; SCHED_FENCE();
                SC3_LD8_K64(fb, SC_KDT, 0); SCHED_FENCE();
            }
            SC3_MM_K64(O, 0, fa, VNf); SCHED_FENCE();
            SC3_LD8_K64(fa, SC_KDT, 4); SCHED_FENCE();
            SC3_MM_K64(S, 0, fb, VNSf); SC3_OT_WRITE(); SCHED_FENCE();
            SC3_MM_K64(S, 4, fa, VNSf); SC3_PACK_S(0); SC3_PACK_S(1); SCHED_FENCE();
            SC3_PACK_S(2);
            SCAN_BAR();
        }
    } else if (wave == CPW) {
        for (int c = 0; c < 128; ++c) {
            SCAN_BAR();
            int lane = tid & 63; asm volatile("" : "+v"(lane));
            const LAS bf16_t* OTn = (const LAS bf16_t*)(lds + SC_OT + (c & 1) * SC_OTB);
#pragma unroll
            for (int ps = 0; ps < 4; ++ps) { const int row = 16 * ps + (lane >> 2), pc = lane & 3, col = 32 * g + 8 * pc;
                    const v4u val = *(const LAS v4u*)(OTn + row * 136 + col);
                    *(v4u*)(mix + (size_t)(b * SEQ + c * 64 + row) * DM + mix_col + col) = val; }
        }
    } else if (hw >= 0) {
        v4u G0[15], G1[15];
#define HLP_LOAD(GX, cn_) do { const unsigned char* sQG = bQG + (size_t)(cn_) * 16384 + (size_t)hw * 4096; const unsigned char* sWV = bWV + (size_t)(cn_) * wv_chunk + (size_t)(16 * hw) * wv_row; \
            const unsigned char* sKDT = bKDT + (size_t)(cn_) * 16384 + (size_t)hw * 4096; const unsigned char* sA = bA + (size_t)(cn_) * 8192 + (size_t)hw * 2048; \
            const unsigned l16 = (unsigned)lane * 16u, offv = (unsigned)(lane >> 4) * (unsigned)wv_row + (unsigned)(lane & 15) * 16u; \
            _Pragma("unroll") for (int i = 0; i < 4; ++i) { GX[i] = *(const v4u*)(sQG + i * 1024 + l16); GX[4 + i] = *(const v4u*)(sWV + (size_t)(4 * i) * wv_row + offv); } \
            _Pragma("unroll") for (int i = 0; i < 4; ++i) GX[8 + i] = *(const v4u*)(sKDT + i * 1024 + l16); \
            _Pragma("unroll") for (int i = 0; i < 2; ++i) GX[12 + i] = *(const v4u*)(sA + i * 1024 + l16); \
            GX[14] = *(const v4u*)((const unsigned char*)(bvec + (size_t)(cn_) * 256) + l16); } while (0)
#define HLP_STORE(GX, bi_) do { LAS unsigned char* nb = lds + (bi_) * SC_BUF + hw * 4096; LAS unsigned char* nv = lds + SC_VEC + (bi_) * 1024; const int lq = lane >> 4; \
            _Pragma("unroll") for (int i = 0; i < 4; ++i) { const int d = lq * 256 + (((lane & 15) ^ (4 * i + lq)) * 16); \
                *(LAS v4u*)(nb + SC_QG + i * 1024 + d) = GX[i]; *(LAS v4u*)(nb + SC_WV + i * 1024 + d) = GX[4 + i]; } \
            _Pragma("unroll") for (int i = 0; i < 4; ++i) { const int d = (lane >> 3) * 128 + (((lane & 7) ^ (4 * (i & 1) + lq)) * 16); *(LAS v4u*)(nb + SC_KDT + i * 1024 + d) = GX[8 + i]; } \
            _Pragma("unroll") for (int i = 0; i < 2; ++i) { const int d = (lane >> 3) * 128 + (((lane & 7) ^ (4 * i + lq)) * 16); *(LAS v4u*)(nb - hw * 2048 + SC_A + i * 1024 + d) = GX[12 + i]; } \
            if (hw == 0) *(LAS v4u*)(nv + lane * 16) = GX[14]; } while (0)
#define HLP_ITER(c, GL, GW) do { \
            int lane = tid & 63; asm volatile("" : "+v"(lane)); \
            const int c2 = ((c) + 2 < 128) ? (c) + 2 : 127; \
            HLP_LOAD(GL, c2); \
            HLP_STORE(GW, ((c) + 1) & 1); \
            SCAN_BAR(); } while (0)
        { int lane = tid & 63; asm volatile("" : "+v"(lane)); HLP_LOAD(G1, 1); }
        for (int c = 0; c < 128; c += 2) { HLP_ITER(c, G0, G1); HLP_ITER(c + 1, G1, G0); }
    } else {
        for (int c = 0; c < 128; ++c) {
            if (c == CA - 3 && nfb > 0) {
                if ((tid & 63) == 0) { while (__hip_atomic_load(prog, __ATOMIC_RELAXED, __HIP_MEMORY_SCOPE_AGENT) < (unsigned)nfb) __builtin_amdgcn_s_sleep(8); }
                __builtin_amdgcn_fence(__ATOMIC_ACQUIRE, "agent");
                asm volatile("s_waitcnt vmcnt(0)" ::: "memory");
            }
            SCAN_BAR();
        }
    }
    __syncthreads();
}

__device__ __forceinline__ void mixnorm_row(bf16_t* mrow, const bf16_t* prow, const float (&gn)[2][8], int lane) {
    v4u o4[4], z4[4];
#pragma unroll
    for (int i = 0; i < 4; ++i) { const int c0 = 8 * (64 * i + lane);
        o4[i] = *(const v4u*)(mrow + c0); z4[i] = *(const v4u*)(prow + (i < 2 ? C_AG + c0 : C_BZ + c0 - 1024)); }
#pragma unroll
    for (int i = 0; i < 4; ++i) {
        float ss = 0.f;
#pragma unroll
        for (int w = 0; w < 4; ++w) { const unsigned a = (w == 0) ? o4[i].x : (w == 1) ? o4[i].y : (w == 2) ? o4[i].z : o4[i].w;
            const float lo = __uint_as_float(a << 16), hi = __uint_as_float(a & 0xffff0000u); ss += lo * lo + hi * hi; }
        ss += __shfl_xor(ss, 1); ss += __shfl_xor(ss, 2); ss += __shfl_xor(ss, 4); ss += __shfl_xor(ss, 8);
        const float rstd = rsqrtf(ss * (1.f / 128.f) + EPS);
        float yv[8];
#pragma unroll
        for (int w = 0; w < 4; ++w) { const unsigned a = (w == 0) ? o4[i].x : (w == 1) ? o4[i].y : (w == 2) ? o4[i].z : o4[i].w;
            const unsigned z = (w == 0) ? z4[i].x : (w == 1) ? z4[i].y : (w == 2) ? z4[i].z : z4[i].w;
            yv[2 * w] = __uint_as_float(a << 16) * rstd * gn[i >> 1][2 * w] * __uint_as_float(z << 16);
            yv[2 * w + 1] = __uint_as_float(a & 0xffff0000u) * rstd * gn[i >> 1][2 * w + 1] * __uint_as_float(z & 0xffff0000u); }
        v4u y4; y4.x = pk2(yv[0], yv[1]); y4.y = pk2(yv[2], yv[3]); y4.z = pk2(yv[4], yv[5]); y4.w = pk2(yv[6], yv[7]);
        *(v4u*)(mrow + 8 * (64 * i + lane)) = y4; }
}

struct EpiProj {
    static constexpr bool PERM = true, AFTER_DRAIN = false;
    bf16_t* O; int ldc;
    __device__ __forceinline__ void operator()(const pg8::f32x4 (&acc)[2][2][4][2], const pg8::Unit& u, int wr, int wc, int fr, int fq) const {
        const int row0 = u.pm * 256 + wr * 64 + fr, col0 = u.pn * 256 + wc * 32 + 8 * fq;
        const bool gate = (u.pn >= 12 && u.pn < 16) || (u.pn >= 24);
#pragma unroll
        for (int ai = 0; ai < 2; ++ai)
#pragma unroll
            for (int m = 0; m < 4; ++m) { bf16_t* rowp = O + (size_t)(row0 + ai * 128 + m * 16) * ldc + col0;
#pragma unroll
                for (int bj = 0; bj < 2; ++bj) { pg8::f32x4 v0 = acc[ai][bj][m][0], v1 = acc[ai][bj][m][1];
                    if (gate) {
#pragma unroll
                        for (int e = 0; e < 4; ++e) { v0[e] = v0[e] * __builtin_amdgcn_rcpf(1.f + __expf(-v0[e])); v1[e] = v1[e] * __builtin_amdgcn_rcpf(1.f + __expf(-v1[e])); } }
                    pg8::u32x4 w; w.x = pk2(v0[0], v0[1]); w.y = pk2(v0[2], v0[3]); w.z = pk2(v1[0], v1[1]); w.w = pk2(v1[2], v1[3]);
                    *(pg8::u32x4*)(rowp + bj * 128) = w; } }
    }
};
struct EpiResF32 {
    static constexpr bool PERM = false, AFTER_DRAIN = false;
    const float* R; float* O; int ldc;
    __device__ __forceinline__ void operator()(const pg8::f32x4 (&acc)[2][2][4][2], const pg8::Unit& u, int wr, int wc, int fr, int fq) const {
        const int row0 = u.pm * 256 + wr * 64 + fr, col0 = u.pn * 256 + wc * 32 + 4 * fq;
#pragma unroll
        for (int ai = 0; ai < 2; ++ai)
#pragma unroll
            for (int m = 0; m < 4; ++m) { const size_t off = (size_t)(row0 + ai * 128 + m * 16) * ldc + col0;
#pragma unroll
                for (int bj = 0; bj < 2; ++bj)
#pragma unroll
                    for (int n = 0; n < 2; ++n) { pg8::f32x4 v = acc[ai][bj][m][n]; if (R) v = v + *(const pg8::f32x4*)(R + off + bj * 128 + n * 16); *(pg8::f32x4*)(O + off + bj * 128 + n * 16) = v; } }
    }
};

#define XB_TMO      128
#define XB_XCNT(j)  (256  + 64 * (j))
#define XB_XSUB(j)  (1280 + 64 * (j))
#define XB_XGEN(j)  (2304 + 64 * (j))
#define XB_TOP      3328
#define XB_TOPGEN   3392
#define XCD_BAR_WORDS 3456
#define XB_SPIN_CAP (1u << 18)

__device__ __forceinline__ unsigned xb_ld(unsigned* p)              { return __hip_atomic_load(p, __ATOMIC_RELAXED, __HIP_MEMORY_SCOPE_AGENT); }
__device__ __forceinline__ unsigned xb_add(unsigned* p, unsigned v) { return __hip_atomic_fetch_add(p, v, __ATOMIC_RELAXED, __HIP_MEMORY_SCOPE_AGENT); }
__device__ __forceinline__ unsigned xb_xcc_id() { return (unsigned)__builtin_amdgcn_s_getreg((3 << 11) | 20) & 0xFu; }
#define XB_SPIN(cond, bar) do { unsigned _sp = 0; while (cond) { __builtin_amdgcn_s_sleep(1); \
    if ((++_sp & 255u) == 0u) { if (xb_ld(&(bar)[XB_TMO])) break; if (_sp > XB_SPIN_CAP) { atomicAdd(&(bar)[XB_TMO], 1u); break; } } } } while (0)

struct XcdBarrier {
    unsigned* bar; unsigned x;
    volatile LAS unsigned* st;
};

__device__ __forceinline__ XcdBarrier xcd_barrier_post(unsigned* bar, volatile LAS unsigned* st) {
    XcdBarrier b; b.bar = bar; b.x = xb_xcc_id(); b.st = st;
    if (threadIdx.x == 0) (void)xb_add(&bar[XB_XCNT(b.x)], 1u);
    return b;
}
__device__ __forceinline__ void xcd_barrier_complete(unsigned* bar, unsigned x, unsigned& nloc, unsigned& nx) {
    const unsigned G = gridDim.x * gridDim.y * gridDim.z;
    unsigned sum, cnt, mine, sp = 0u;
    for (;;) {
        sum = 0u; cnt = 0u; mine = 0u;
#pragma unroll
        for (unsigned j = 0; j < 16; ++j) { const unsigned c = xb_ld(&bar[XB_XCNT(j)]); sum += c; cnt += (c > 0u) ? 1u : 0u; mine = (j == x) ? c : mine; }
        if (sum == G) break;
        __builtin_amdgcn_s_sleep(1);
        if ((++sp & 255u) == 0u) { if (xb_ld(&bar[XB_TMO])) break; if (sp > XB_SPIN_CAP) { atomicAdd(&bar[XB_TMO], 1u); break; } }
    }
    nloc = mine > 0u ? mine : 1u; nx = cnt > 0u ? cnt : 1u;
}

__device__ __forceinline__ void xcd_barrier(const XcdBarrier& b) {
    asm volatile("s_waitcnt vmcnt(0)" ::: "memory");
    __syncthreads();
    if (threadIdx.x == 0) {
        unsigned* bar = b.bar;
        __builtin_amdgcn_s_waitcnt(0);
        unsigned nloc = b.st[0], nx = b.st[1];
        if (nloc == 0u) { xcd_barrier_complete(bar, b.x, nloc, nx); b.st[0] = nloc; b.st[1] = nx; }
        const unsigned old = xb_add(&bar[XB_XSUB(b.x)], 1u);
        const unsigned gen = old / nloc;
        if (old + 1u == (gen + 1u) * nloc) {
            __builtin_amdgcn_fence(__ATOMIC_RELEASE, "agent");
            asm volatile("s_waitcnt vmcnt(0)" ::: "memory");
            const unsigned og = xb_add(&bar[XB_TOP], 1u);
            const unsigned tg = og / nx;
            if (og + 1u == (tg + 1u) * nx) xb_add(&bar[XB_TOPGEN], 1u);
            else XB_SPIN(xb_ld(&bar[XB_TOPGEN]) == tg, bar);
            __builtin_amdgcn_fence(__ATOMIC_ACQUIRE, "agent");
            xb_add(&bar[XB_XGEN(b.x)], 1u);
            asm volatile("s_waitcnt vmcnt(0)" ::: "memory");
        } else {
            XB_SPIN(xb_ld(&bar[XB_XGEN(b.x)]) == gen, bar);
            __builtin_amdgcn_fence(__ATOMIC_ACQUIRE, "agent");
            asm volatile("s_waitcnt vmcnt(0)" ::: "memory");
        }
    }
    __syncthreads();
}

__device__ __forceinline__ int get_lane() { int l = (int)__builtin_amdgcn_mbcnt_hi(~0u, __builtin_amdgcn_mbcnt_lo(~0u, 0u)); asm volatile("" : "+v"(l)); return l; }
__global__ void __launch_bounds__(NT, 2) mk_fwd(Args args) {
    extern __shared__ __attribute__((aligned(16))) unsigned char lds_raw[];
    LAS unsigned char* lds = (LAS unsigned char*)lds_raw;
    cg::grid_group grid = cg::this_grid();
    const int tid = threadIdx.x, wave = __builtin_amdgcn_readfirstlane(tid >> 6);

    const int G = gridDim.x, bx = blockIdx.x;
    const int vcu = (G % 8 == 0) ? (bx % 8) * (G / 8) + bx / 8 : bx;
    const int gw = vcu * NW + wave, NGW = G * NW;
    unsigned char* ws = args.ws;
    const float* x = args.in[0]; const float* attn_g = args.in[1]; const float* w_in = args.in[2];
    const float* w_out = args.in[9]; const float* ffn_g = args.in[10]; const float* w_query = args.in[11]; const float* sub_keys = args.in[12];
    bf16_t* WinT = (bf16_t*)(ws + OFF_D);
    bf16_t* WoutT = (bf16_t*)(ws + OFF_C);
    bf16_t* Wqk = (bf16_t*)(ws + OFF_C + 8 * MiB);
    bf16_t* xn = (bf16_t*)(ws + OFF_D + 28 * MiB);
    float* ba = (float*)(ws + OFF_S);
    bf16_t* proj = (bf16_t*)(ws + OFF_B);
    bf16_t* mix = (bf16_t*)args.out;
    unsigned char* pb = ws + OFF_D; float* vecs = (float*)(ws + OFF_S + 2 * MiB);
    float* hbuf = (float*)(ws + OFF_B);
    bf16_t* hn = (bf16_t*)(ws + OFF_D + 128 * MiB);
    float* scores = (float*)(ws + OFF_D);
    unsigned char* U8 = ws + OFF_TAB; unsigned char* V8 = ws + OFF_TAB + 16 * MiB;
    float* inv_su = (float*)(ws + OFF_S + 1 * MiB); float* inv_sv = inv_su + 16384;

    volatile LAS unsigned* xbst = (volatile LAS unsigned*)(lds + LDS_BYTES - 16);
    if (tid < 4) xbst[tid] = 0u;
    __syncthreads();
    XcdBarrier xbar = xcd_barrier_post((unsigned*)args.ws, xbst);
    const int lo = args.ph_lo, hi = args.ph_hi;
#define IN(k) (lo <= (k) && (k) < hi)
#define SYNC_AFTER(k) do { if (IN(k) && (k) + 1 < hi) { if ((k) == 0) grid.sync(); else xcd_barrier(xbar); } } while (0)
    {
        if (IN(0)) {
            const int lane = get_lane();
            LAS float* scr = (LAS float*)(lds + wave * 16384);
            constexpr int I_IN = (DM / 64) * (NPROJ / 32);
            for (int it = gw; it < I_IN; it += NGW) transpose_item(w_in, INW, DM, NPROJ, WinT, scr, it, lane);
            __syncthreads();
            {
                LAS float* wt = (LAS float*)lds;
#pragma unroll
                for (int k = 0; k < 4; ++k) { const int d = tid + 512 * k; const float* wr = w_in + (size_t)d * INW + NPROJ;
#pragma unroll
                    for (int q4 = 0; q4 < 4; ++q4) { const f32x4 w4 = *(const f32x4*)(wr + 4 * q4);
                        wt[(4 * q4 + 0) * 2048 + d] = w4.x; wt[(4 * q4 + 1) * 2048 + d] = w4.y; wt[(4 * q4 + 2) * 2048 + d] = w4.z; wt[(4 * q4 + 3) * 2048 + d] = w4.w; } }
            }
            __syncthreads();
            for (int m = gw; m < T; m += NGW) norm_row<true>(x + (size_t)m * DM, attn_g, (const LAS float*)lds, xn + (size_t)m * DM, ba + (size_t)m * 16, lane);
        }
        SYNC_AFTER(0);
        if (IN(1)) {
            pg8::Gemm g{xn, WinT, T, NPROJ, DM}; pg8::StaticOrder S; S.init(T, NPROJ, G, bx);
            EpiProj E{proj, NPROJ};
            pg8::gemm_phase<EpiProj, pg8::StaticOrder, true, true>(lds, g, S, E);
        }
        SYNC_AFTER(1);
        if (IN(2)) {
            const int CAe = (G > NSB) ? CA : 128;
            for (int it = bx; it < 16 * CAe; it += G) { int tt = threadIdx.x; asm volatile("" : "+v"(tt)); hgrn_prep_item((it / CAe) * 128 + (it % CAe), proj, args.in[3], pb, vecs, lds, tt); }
            for (int it = bx; it < 8 * CAe; it += G) { int tt = threadIdx.x; asm volatile("" : "+v"(tt)); gdn_prep_item((it / CAe) * 128 + (it % CAe), proj, ba, args.in[5], args.in[6], args.in[7], pb, vecs, lds, tt); }
        }
        SYNC_AFTER(2);
        if (IN(3)) {
            const int lane = get_lane();
            unsigned* ctl = (unsigned*)args.ws;
            if (bx < NSB) {
                const int sq = (bx & 7) + 8 * (bx >> 5), cgp = (bx >> 3) & 3;
                if (sq >= 16) scan_block<true>(sq, cgp, proj, pb, vecs, args.in[4], args.in[8], mix, ctl + PROG_WORD, G - NSB, lds, tid);
                else scan_block<false>(sq, cgp, proj, pb, vecs, args.in[4], args.in[8], mix, ctl + PROG_WORD, G - NSB, lds, tid);
            }
            else if (G > NSB) {
                int fb, FB;
                fb = bx - NSB; FB = G - NSB;
                {
                    constexpr int NBL = 128 - CA;
                    for (int it = fb; it < 16 * NBL; it += FB) { int tt = threadIdx.x; asm volatile("" : "+v"(tt)); hgrn_prep_item((it & 15) * 128 + CA + (it >> 4), proj, args.in[3], pb, vecs, lds, tt); }
                    for (int it = fb; it < 8 * NBL; it += FB) { int tt = threadIdx.x; asm volatile("" : "+v"(tt)); gdn_prep_item((it & 7) * 128 + CA + (it >> 3), proj, ba, args.in[5], args.in[6], args.in[7], pb, vecs, lds, tt); }
                    __syncthreads();
                    if (tid == 0) { __threadfence(); __hip_atomic_fetch_add(ctl + PROG_WORD, 1u, __ATOMIC_RELAXED, __HIP_MEMORY_SCOPE_AGENT); }
                    __syncthreads();
                }
                const int fw = fb * NW + wave, FW = FB * NW;
                for (int it = fb; it < 512; it += FB) wqk_item(w_query, sub_keys, Wqk, (LAS float*)lds, it, tid);
                LAS float* scr = (LAS float*)(lds + wave * 16384);
                constexpr int I_OUT = (DM / 64) * (DM / 32);
                for (int it = fw; it < I_OUT; it += FW) transpose_item(w_out, DM, DM, DM, WoutT, scr, it, lane);
                for (int e = 2 * fw; e < 32768; e += 2 * FW) { const bool isv = e >= 16384; const int r = e & 16383;
                    if (isv) table_row2(args.in[14] + (size_t)r * DM, (unsigned*)(V8 + (size_t)r * 1024), inv_sv + r, lane);
                    else table_row2_i4(args.in[13] + (size_t)r * DM, (unsigned*)(U8 + (size_t)r * 1024), inv_su + r, lane); }
            }
        }
        SYNC_AFTER(3);
        if (IN(4)) {
            {
                const int lane = get_lane();
                float gn[2][8];
#pragma unroll
                for (int mxr = 0; mxr < 2; ++mxr) { const float* gsrc = (mxr == 0 ? args.in[4] : args.in[8]) + 8 * (lane & 15);
                    const f32x4 ga = *(const f32x4*)gsrc, gb = *(const f32x4*)(gsrc + 4);
                    gn[mxr][0] = ga.x; gn[mxr][1] = ga.y; gn[mxr][2] = ga.z; gn[mxr][3] = ga.w; gn[mxr][4] = gb.x; gn[mxr][5] = gb.y; gn[mxr][6] = gb.z; gn[mxr][7] = gb.w; }
                for (int m = gw; m < T; m += NGW) mixnorm_row(mix + (size_t)m * DM, proj + (size_t)m * NPROJ, gn, lane);
                xcd_barrier(xbar);
            }
            pg8::Gemm g{mix, WoutT, T, DM, DM}; pg8::StaticOrder S; S.init(T, DM, G, bx);
            EpiResF32 E{x, hbuf, DM};
            pg8::gemm_phase<EpiResF32, pg8::StaticOrder, true, true>(lds, g, S, E);
        }
        SYNC_AFTER(4);
        if (IN(5)) {
            const int lane = get_lane();
            for (int m = gw; m < T; m += NGW) norm_row<false>(hbuf + (size_t)m * DM, ffn_g, (const LAS float*)lds, hn + (size_t)m * DM, nullptr, lane);
        }
        SYNC_AFTER(5);
        if (IN(6)) {
            pg8::Gemm g{hn, Wqk, T, DM, DM}; pg8::StaticOrder S; S.init(T, DM, G, bx);
            EpiResF32 E{nullptr, scores, DM};
            pg8::gemm_phase<EpiResF32, pg8::StaticOrder, true, true>(lds, g, S, E);
        }
        SYNC_AFTER(6);
        if (IN(7)) {
            const int lane = get_lane();
            LAS int* se = (LAS int*)(lds + wave * 4096); LAS float* sa = (LAS float*)(lds + wave * 4096 + 512); LAS float* sb = (LAS float*)(lds + wave * 4096 + 1024);
            for (int t = gw; t < T; t += NGW) { const int ln = get_lane(); peer_token(t, scores, hn, hbuf, U8, V8, inv_su, inv_sv, args.in[15], args.out, se, sa, sb, ln); }
        }
    }
}
}

extern "C" void kernel_launch(void* const* d_in, const int* in_sizes, int n_in, void* d_out, int out_size, void* d_ws, size_t ws_size, hipStream_t stream) {
    static int grid = 0;
    if (grid == 0) {
        int dev = 0, cus = 0, per_cu = 0;
        (void)hipGetDevice(&dev);
        (void)hipDeviceGetAttribute(&cus, hipDeviceAttributeMultiprocessorCount, dev);
        (void)hipFuncSetAttribute((const void*)mk::mk_fwd, hipFuncAttributeMaxDynamicSharedMemorySize, mk::LDS_BYTES);
        (void)hipOccupancyMaxActiveBlocksPerMultiprocessor(&per_cu, (const void*)mk::mk_fwd, mk::NT, mk::LDS_BYTES);
        if (per_cu < 1) { fprintf(stderr, "occupancy query says %d\n", per_cu); per_cu = 1; }
        grid = cus;
    }
    unsigned char* ws = (unsigned char*)d_ws;
    (void)hipMemsetAsync(d_ws, 0, 16384, stream);
    mk::Args a{};
    for (int i = 0; i < 16; ++i) a.in[i] = (const float*)d_in[i];
    a.out = (float*)d_out; a.ws = ws;
    {
        a.ph_lo = 0; a.ph_hi = 8;
        void* kargs[] = {&a};
        hipError_t e = hipLaunchCooperativeKernel((const void*)mk::mk_fwd, dim3(grid), dim3(mk::NT), kargs, mk::LDS_BYTES, stream);
        if (e != hipSuccess) fprintf(stderr, "coop launch failed: %s\n", hipGetErrorString(e));
    }
}
```

```cpp
#include <hip/hip_runtime.h>
#include <hip/hip_cooperative_groups.h>
#include <cstdio>
namespace cg = cooperative_groups;
#include <stdint.h>

typedef unsigned short bf16_t;
typedef float f32x4 __attribute__((ext_vector_type(4)));

constexpr int T = 16384, SEQ = 8192, DM = 2048, INW = 7184, NPROJ = 7168;
constexpr float EPS = 1e-6f;
constexpr size_t MiB = 1u << 20;
constexpr size_t OFF_TAB = 1 * MiB;
constexpr size_t OFF_B = 65 * MiB;
constexpr size_t OFF_C = 289 * MiB;
constexpr size_t OFF_D = 305 * MiB;
constexpr size_t OFF_S = 500 * MiB;
constexpr int C_AQ = 0, C_AF = 1024, C_AI = 2048, C_AG = 3072, C_BQ = 4096, C_BK = 4608, C_BV = 5120, C_BZ = 6144;

__device__ __forceinline__ float bf2f(bf16_t v) { return __uint_as_float(((unsigned)v) << 16); }
typedef float f32x2_t __attribute__((ext_vector_type(2)));
typedef __bf16 bf16x2_t __attribute__((ext_vector_type(2)));
__device__ __forceinline__ unsigned cvt_pk2(float lo, float hi) { f32x2_t v = {lo, hi}; bf16x2_t b = __builtin_convertvector(v, bf16x2_t); return __builtin_bit_cast(unsigned, b); }
__device__ __forceinline__ bf16_t f2bf(float f) { return (bf16_t)(cvt_pk2(f, 0.f) & 0xffffu); }
__device__ __forceinline__ float sigmoidf_(float x) { return 1.f / (1.f + __expf(-x)); }
__device__ __forceinline__ float siluf_(float x) { return x / (1.f + __expf(-x)); }
__device__ __forceinline__ float wave_sum(float v) {
#pragma unroll
    for (int o = 1; o < 64; o <<= 1) v += __shfl_xor(v, o);
    return v;
}
__device__ __forceinline__ float block_sum(float v, float* sh) {
    v = wave_sum(v);
    const int w = threadIdx.x >> 6, nw = blockDim.x >> 6;
    __syncthreads();
    if ((threadIdx.x & 63) == 0) sh[w] = v;
    __syncthreads();
    float r = 0.f;
    for (int i = 0; i < nw; ++i) r += sh[i];
    return r;
}

__device__ __forceinline__ float gelu_erf(float x) {
    const float z = fabsf(x) * 0.70710678118654752f;
    const float tt = __builtin_amdgcn_rcpf(fmaf(0.3275911f, z, 1.f));
    float pl = fmaf(1.061405429f, tt, -1.453152027f); pl = fmaf(pl, tt, 1.421413741f); pl = fmaf(pl, tt, -0.284496736f); pl = fmaf(pl, tt, 0.254829592f); pl *= tt;
    const float er = 1.f - pl * __expf(-z * z);
    return 0.5f * x * (1.f + copysignf(er, x));
}
namespace pg8 {
#define PG8_LAS __attribute__((address_space(3)))
typedef unsigned short bf16_t;
typedef short bf16x8 __attribute__((ext_vector_type(8)));
typedef float f32x4 __attribute__((ext_vector_type(4)));
typedef unsigned u32x4 __attribute__((ext_vector_type(4)));
constexpr int BM = 256, BK = 64, HALF = 128, HTB = HALF * BK * 2  , STAGE_BYTES = 8 * HTB, NXCD = 8, WGM = 8;

__host__ __device__ __forceinline__ int lds_byte(int r, int c) { const int st = (r >> 4) * 2 + (c >> 5), rr = r & 15, cc = c & 31, ob = rr * 64 + cc * 2; return st * 1024 + (ob ^ (((ob >> 9) & 1) << 5)); }
__host__ __device__ __forceinline__ void stage_rc(int b, int& R, int& C) { const int st = b / 1024, sb = b % 1024, swz = sb ^ (((sb >> 9) & 1) << 5); R = (st >> 1) * 16 + swz / 64; C = (st & 1) * 32 + (swz % 64) / 2; }
__host__ __device__ __forceinline__ int perm32(int rho) { const int n = rho >> 4, i = rho & 15; return 8 * (i >> 2) + 4 * n + (i & 3); }

struct Unit { int pm, pn; };
struct Gemm { const bf16_t* A; const bf16_t* Bt; int M, N, K; };

struct StaticOrder {
    int nM, nN, nwg, G, c;
    __host__ __device__ void init(int M, int N, int G_, int c_) { nM = M / BM; nN = N / BM; nwg = nM * nN; G = G_; c = c_; }
    __host__ __device__ bool next(int i, Unit& u) const {
        const long L = (long)i * G + c; if (L >= nwg) return false;
        int wgid = (int)L; { const int q = nwg / NXCD, r = nwg % NXCD, xcd = wgid % NXCD, off = wgid / NXCD; wgid = (xcd < r ? xcd * (q + 1) : r * (q + 1) + (xcd - r) * q) + off; }
        const int nig = WGM * nN, gid = wgid / nig, fm = gid * WGM, gsz = (nM - fm) < WGM ? (nM - fm) : WGM;
        u.pm = fm + ((wgid % nig) % gsz); u.pn = (wgid % nig) / gsz; return true;
    }
    __device__ __forceinline__ void a_ready(const Unit&) const {}
    __device__ __forceinline__ void done(const Unit&) const {}
};

__device__ __forceinline__ unsigned cvt_pk_bf16(float lo, float hi) { unsigned r; asm volatile("v_cvt_pk_bf16_f32 %0, %1, %2" : "=v"(r) : "v"(lo), "v"(hi)); return r; }
typedef float f32x2 __attribute__((ext_vector_type(2)));
__device__ __forceinline__ f32x2 gelu_pk(f32x2 v) {
    const f32x2 av = __builtin_elementwise_abs(v), d = av * 0.2316418882f + 1.0f;
    f32x2 t; t.x = __builtin_amdgcn_rcpf(d.x); t.y = __builtin_amdgcn_rcpf(d.y);
    f32x2 q = t * 0.5307027145f + (-0.7265760135f); q = q * t + 0.7107068705f; q = q * t + (-0.142248368f); q = q * t + 0.127414796f; q = q * t;
    const f32x2 s = (v * v) * (-0.72134752044f);
    f32x2 e; e.x = __builtin_amdgcn_exp2f(s.x); e.y = __builtin_amdgcn_exp2f(s.y);
    const f32x2 m = v * (q * e), r = v - m;
    f32x2 o; o.x = v.x < 0.f ? m.x : r.x; o.y = v.y < 0.f ? m.y : r.y; return o;
}

template <int ACT  > struct EpiBf16 {
    static constexpr bool PERM = true, AFTER_DRAIN = false; static_assert(ACT == 0 || ACT == 1, "EpiBf16: ACT is 0 (none) or 1 (gelu_pk)");
    bf16_t* O; int ldc; const float* bias; int split_cols; size_t split_stride; float scale0;
    __device__ __forceinline__ void operator()(const f32x4 (&acc)[2][2][4][2], const Unit& u, int wr, int wc, int fr, int fq) const {
        const int row0 = u.pm * BM + wr * 64 + fr; int colt = u.pn * BM; bf16_t* base = O;
        float sc = 1.f; if (split_cols) { const int t = colt / split_cols; base += (size_t)t * split_stride; colt -= t * split_cols; if (t == 0) sc = scale0; }
        const int col0 = colt + wc * 32 + 8 * fq, bcol0 = u.pn * BM + wc * 32 + 8 * fq;
        f32x4 bv[2][2];
#pragma unroll
        for (int bj = 0; bj < 2; ++bj)
#pragma unroll
            for (int n = 0; n < 2; ++n) bv[bj][n] = bias ? *(const f32x4*)(bias + bcol0 + bj * HALF + 4 * n) : (f32x4){0.f, 0.f, 0.f, 0.f};
#pragma unroll
        for (int ai = 0; ai < 2; ++ai)
#pragma unroll
            for (int m = 0; m < 4; ++m) { bf16_t* rowp = base + (size_t)(row0 + ai * HALF + m * 16) * ldc + col0;
#pragma unroll
                for (int bj = 0; bj < 2; ++bj) { f32x4 v0 = acc[ai][bj][m][0] + bv[bj][0], v1 = acc[ai][bj][m][1] + bv[bj][1];
                    if (ACT == 1) { f32x2 a = gelu_pk((f32x2){v0[0], v0[1]}), b = gelu_pk((f32x2){v0[2], v0[3]}), c = gelu_pk((f32x2){v1[0], v1[1]}), d = gelu_pk((f32x2){v1[2], v1[3]});
                        v0 = (f32x4){a.x, a.y, b.x, b.y}; v1 = (f32x4){c.x, c.y, d.x, d.y}; }
                    v0 = v0 * sc; v1 = v1 * sc; u32x4 w; w.x = cvt_pk_bf16(v0[0], v0[1]); w.y = cvt_pk_bf16(v0[2], v0[3]); w.z = cvt_pk_bf16(v1[0], v1[1]); w.w = cvt_pk_bf16(v1[2], v1[3]);
                    *(u32x4*)(rowp + bj * HALF) = w; } }
    }
};
template <class Epi, class Sched, bool ALIGN_EPI = false, bool SP2 = false>
__device__ __forceinline__ void gemm_phase(PG8_LAS unsigned char* lds, const Gemm g, const Sched& S, const Epi& E) {
    const int tid = threadIdx.x, wid = __builtin_amdgcn_readfirstlane(tid >> 6), lane = tid & 63, wr = wid >> 2, wc = wid & 3, fr = lane & 15, fq = lane >> 4;
    const int K = g.K, nt = K / BK;
    unsigned voffA[2], voffB[2];
#pragma unroll
    for (int i = 0; i < 2; ++i) { int R, C; stage_rc(tid * 16 + i * 8192, R, C); const int Rb = Epi::PERM ? ((R & ~31) + perm32(R & 31)) : R;
        voffA[i] = (unsigned)(R * K + C) * 2u; voffB[i] = (unsigned)(Rb * K + C) * 2u; }
    const size_t kstep = (size_t)(BK * 2);
    const size_t hstep = (size_t)HALF * K * 2;
    const size_t tstep = 2 * hstep;
    const unsigned ldsw = (unsigned)wid * 1024u;
    const int aoff = lds_byte(wr * 64 + fr, fq * 8), boff = lds_byte(wc * 32 + fr, fq * 8);
#define PG8_SA(b, h) (((b) * 2 + (h)) * HTB)
#define PG8_SB(b, h) ((4 + (b) * 2 + (h)) * HTB)
#define PG8_STAGE(bufoff, gbase, voff) do { _Pragma("unroll") for (int _i = 0; _i < 2; ++_i) \
        __builtin_amdgcn_global_load_lds((const unsigned*)((const char*)(gbase) + (voff)[_i]), (PG8_LAS unsigned*)(lds + (bufoff) + ldsw + _i * 8192), 16, 0, 0); } while (0)
#define PG8_LDA(dst, b, h) do { _Pragma("unroll") for (int m = 0; m < 4; ++m) _Pragma("unroll") for (int k = 0; k < 2; ++k) dst[m][k] = *(const PG8_LAS bf16x8*)(lds + PG8_SA(b, h) + aoff + m * 2048 + k * 1024); } while (0)
#define PG8_LDB(dst, b, h) do { _Pragma("unroll") for (int n = 0; n < 2; ++n) _Pragma("unroll") for (int k = 0; k < 2; ++k) dst[n][k] = *(const PG8_LAS bf16x8*)(lds + PG8_SB(b, h) + boff + n * 2048 + k * 1024); } while (0)
#define PG8_MMA(ai, bj, At, Bt) do { __builtin_amdgcn_s_setprio(1); _Pragma("unroll") for (int m = 0; m < 4; ++m) _Pragma("unroll") for (int n = 0; n < 2; ++n) _Pragma("unroll") for (int k = 0; k < 2; ++k) \
        acc[ai][bj][m][n] = __builtin_amdgcn_mfma_f32_16x16x32_bf16(Bt[n][k], At[m][k], acc[ai][bj][m][n], 0, 0, 0); __builtin_amdgcn_s_setprio(0); } while (0)
#define PG8_WAIT_V(n) asm volatile("s_waitcnt vmcnt(" #n ")" ::: "memory")
#define PG8_WAIT_L(n) asm volatile("s_waitcnt lgkmcnt(" #n ")" ::: "memory")
#define PG8_BAR __builtin_amdgcn_s_barrier()
#define PG8_SCHED __builtin_amdgcn_sched_barrier(0)
    Unit cur, nxt; int ui = 0;
    if (!S.next(0, cur)) return;
    f32x4 acc[2][2][4][2];
#pragma unroll
    for (int a = 0; a < 2; ++a)
#pragma unroll
        for (int b = 0; b < 2; ++b)
#pragma unroll
            for (int m = 0; m < 4; ++m)
#pragma unroll
                for (int n = 0; n < 2; ++n) acc[a][b][m][n] = (f32x4){0.f, 0.f, 0.f, 0.f};
    bf16x8 At[4][2], B0[2][2], B1[2][2];
    const char* cA = (const char*)g.A + (size_t)cur.pm * tstep; const char* cB = (const char*)g.Bt + (size_t)cur.pn * tstep;
    S.a_ready(cur);
    if constexpr (SP2) {
        PG8_STAGE(PG8_SB(0, 0), cB, voffB); PG8_STAGE(PG8_SB(0, 1), cB + hstep, voffB); PG8_STAGE(PG8_SA(0, 0), cA, voffA); PG8_STAGE(PG8_SA(0, 1), cA + hstep, voffA);
        if (wr == 1) PG8_BAR;
        PG8_WAIT_V(2); PG8_BAR;
        PG8_STAGE(PG8_SB(1, 0), cB + kstep, voffB); PG8_STAGE(PG8_SA(1, 0), cA + kstep, voffA); PG8_STAGE(PG8_SB(1, 1), cB + hstep + kstep, voffB);
        PG8_WAIT_V(6); PG8_BAR;
    } else {
        PG8_STAGE(PG8_SB(0, 0), cB, voffB); PG8_STAGE(PG8_SA(0, 0), cA, voffA); PG8_STAGE(PG8_SB(0, 1), cB + hstep, voffB); PG8_STAGE(PG8_SA(0, 1), cA + hstep, voffA);
        if (wr == 1) PG8_BAR;
        PG8_WAIT_V(4); PG8_BAR;
        PG8_STAGE(PG8_SB(1, 0), cB + kstep, voffB); PG8_STAGE(PG8_SA(1, 0), cA + kstep, voffA); PG8_STAGE(PG8_SB(1, 1), cB + hstep + kstep, voffB);
        PG8_WAIT_V(6); PG8_BAR;
    }
    for (;;) {
        const bool has_next = S.next(ui + 1, nxt);
        const char* nA = has_next ? (const char*)g.A + (size_t)nxt.pm * tstep : cA; const char* nB = has_next ? (const char*)g.Bt + (size_t)nxt.pn * tstep : cB;
        for (int t = 0; t < nt; t += 2) {
            const bool last = (t == nt - 2);
            const char* a1 = cA + (size_t)(t + 1) * kstep;
            const char* a2 = last ? nA : cA + (size_t)(t + 2) * kstep; const char* b2 = last ? nB : cB + (size_t)(t + 2) * kstep;
            const char* a3 = a2 + kstep; const char* b3 = b2 + kstep;
            if (last && has_next) S.a_ready(nxt);
            if constexpr (SP2) {
            PG8_LDB(B0, 0, 0); PG8_LDB(B1, 0, 1); PG8_SCHED; PG8_LDA(At, 0, 0); PG8_STAGE(PG8_SA(1, 1), a1 + hstep, voffA);
            PG8_WAIT_V(8); PG8_WAIT_L(0); PG8_BAR; PG8_MMA(0, 0, At, B0); PG8_MMA(0, 1, At, B1); PG8_BAR; PG8_SCHED;
            PG8_LDA(At, 0, 1); PG8_STAGE(PG8_SB(0, 0), b2, voffB); PG8_STAGE(PG8_SB(0, 1), b2 + hstep, voffB); PG8_STAGE(PG8_SA(0, 0), a2, voffA);
            PG8_WAIT_V(8); PG8_WAIT_L(0); PG8_BAR; PG8_MMA(1, 0, At, B0); PG8_MMA(1, 1, At, B1); PG8_BAR; PG8_SCHED;
            PG8_LDB(B0, 1, 0); PG8_LDB(B1, 1, 1); PG8_SCHED; PG8_LDA(At, 1, 0); PG8_STAGE(PG8_SA(0, 1), a2 + hstep, voffA);
            PG8_WAIT_V(8); PG8_WAIT_L(0); PG8_BAR; PG8_MMA(0, 0, At, B0); PG8_MMA(0, 1, At, B1); PG8_BAR; PG8_SCHED;
            PG8_LDA(At, 1, 1); PG8_STAGE(PG8_SB(1, 0), b3, voffB); PG8_STAGE(PG8_SB(1, 1), b3 + hstep, voffB); PG8_STAGE(PG8_SA(1, 0), a3, voffA);
            PG8_WAIT_V(8); PG8_WAIT_L(0); PG8_BAR; PG8_MMA(1, 0, At, B0); PG8_MMA(1, 1, At, B1); PG8_BAR; PG8_SCHED;
            } else {
            PG8_LDB(B0, 0, 0); PG8_SCHED; PG8_LDA(At, 0, 0); PG8_STAGE(PG8_SA(1, 1), a1 + hstep, voffA);
            PG8_WAIT_L(8); PG8_BAR; PG8_WAIT_L(0); PG8_MMA(0, 0, At, B0); PG8_BAR; PG8_SCHED;
            PG8_LDB(B1, 0, 1); PG8_STAGE(PG8_SB(0, 0), b2, voffB);
            PG8_BAR; PG8_WAIT_L(0); PG8_MMA(0, 1, At, B1); PG8_BAR;
            PG8_LDA(At, 0, 1); PG8_STAGE(PG8_SA(0, 0), a2, voffA);
            PG8_BAR; PG8_WAIT_L(0); PG8_MMA(1, 0, At, B0); PG8_BAR; PG8_SCHED;
            PG8_STAGE(PG8_SB(0, 1), b2 + hstep, voffB);
            PG8_WAIT_V(6); PG8_BAR; PG8_MMA(1, 1, At, B1); PG8_BAR;
            PG8_LDB(B0, 1, 0); PG8_SCHED; PG8_LDA(At, 1, 0); PG8_STAGE(PG8_SA(0, 1), a2 + hstep, voffA);
            PG8_WAIT_L(8); PG8_BAR; PG8_WAIT_L(0); PG8_MMA(0, 0, At, B0); PG8_BAR; PG8_SCHED;
            PG8_LDB(B1, 1, 1); PG8_STAGE(PG8_SB(1, 0), b3, voffB);
            PG8_BAR; PG8_WAIT_L(0); PG8_MMA(0, 1, At, B1); PG8_BAR;
            PG8_LDA(At, 1, 1); PG8_STAGE(PG8_SA(1, 0), a3, voffA);
            PG8_BAR; PG8_WAIT_L(0); PG8_MMA(1, 0, At, B0); PG8_BAR; PG8_SCHED;
            PG8_STAGE(PG8_SB(1, 1), b3 + hstep, voffB);
            PG8_WAIT_V(6); PG8_BAR; PG8_MMA(1, 1, At, B1); PG8_BAR;
            }
        }
        if constexpr (ALIGN_EPI) { if (wr == 0) PG8_BAR; }
        if constexpr (!Epi::AFTER_DRAIN) { E(acc, cur, wr, wc, fr, fq); S.done(cur); }
        if (!has_next) break;
#pragma unroll
        for (int a = 0; a < 2; ++a)
#pragma unroll
            for (int b = 0; b < 2; ++b)
#pragma unroll
                for (int m = 0; m < 4; ++m)
#pragma unroll
                    for (int n = 0; n < 2; ++n) acc[a][b][m][n] = (f32x4){0.f, 0.f, 0.f, 0.f};
        cur = nxt; cA = nA; cB = nB; ++ui;
        if constexpr (ALIGN_EPI) { if (wr == 1) PG8_BAR; }
    }
    PG8_WAIT_V(0);
    if constexpr (!ALIGN_EPI) { if (wr == 0) PG8_BAR; }
    PG8_BAR;
    if constexpr (Epi::AFTER_DRAIN) { E.fused(acc, cur, wr, wc, fr, fq, lds, wid, lane); S.done(cur); }
#undef PG8_SA
#undef PG8_SB
#undef PG8_STAGE
#undef PG8_LDA
#undef PG8_LDB
#undef PG8_MMA
#undef PG8_WAIT_V
#undef PG8_WAIT_L
#undef PG8_BAR
#undef PG8_SCHED
}
}

namespace mk {
#define LAS __attribute__((address_space(3)))
#define GAS __attribute__((address_space(1)))
typedef unsigned v4u __attribute__((ext_vector_type(4)));
typedef unsigned v2u __attribute__((ext_vector_type(2)));
constexpr int NW = 8, NT = 512, LDS_BYTES = 163840, RING_BYTES = 131072;
#define LDS_WAIT() asm volatile("s_waitcnt lgkmcnt(0)" ::: "memory")
#define DPP_ROR_ADD(t, n) ((t) + __uint_as_float(__builtin_amdgcn_update_dpp(0u, __float_as_uint(t), 0x120 + (n), 0xf, 0xf, false)))
struct Args { const float* in[16]; float* out; unsigned char* ws; int ph_lo, ph_hi; };
__device__ __forceinline__ unsigned pk2(float lo, float hi) { return cvt_pk2(lo, hi); }

__device__ __forceinline__ void transpose_item(const float* W, int ld, int K, int ncols, bf16_t* WT, LAS float* scr, int item, int lane) {
    const int nblk = ncols / 32, kb = item / nblk, nb = item % nblk, k0 = 64 * kb, n0 = 32 * nb;
#pragma unroll 8
    for (int i = 0; i < 32; ++i) { const int kk = 2 * i + (lane >> 5); scr[kk * 33 + (lane & 31)] = W[(size_t)(k0 + kk) * ld + n0 + (lane & 31)]; }
    LDS_WAIT(); asm volatile("" ::: "memory");
    const int c = lane & 7;
#pragma unroll
    for (int j = 0; j < 4; ++j) { const int n = (lane >> 3) + 8 * j; const LAS float* s = scr + (8 * c) * 33 + n;
        v4u o; o.x = pk2(s[0 * 33], s[1 * 33]); o.y = pk2(s[2 * 33], s[3 * 33]); o.z = pk2(s[4 * 33], s[5 * 33]); o.w = pk2(s[6 * 33], s[7 * 33]);
        *(v4u*)(WT + (size_t)(n0 + n) * K + k0 + 8 * c) = o; }
    LDS_WAIT(); asm volatile("" ::: "memory");
}
template <bool WITH_BA>
__device__ __forceinline__ void norm_row(const float* xrow, const float* g, const LAS float* wt  , bf16_t* orow, float* barow, int lane) {
    f32x4 v[8]; float ss = 0.f;
#pragma unroll
    for (int j = 0; j < 8; ++j) { v[j] = ((const f32x4*)xrow)[64 * j + lane]; ss += (v[j].x * v[j].x + v[j].y * v[j].y) + (v[j].z * v[j].z + v[j].w * v[j].w); }
    ss = wave_sum(ss);
    const float rstd = rsqrtf(ss * (1.f / DM) + EPS);
    float acc[16];
#pragma unroll
    for (int c = 0; c < 16; ++c) acc[c] = 0.f;
#pragma unroll
    for (int j = 0; j < 8; ++j) {
        const f32x4 gg = ((const f32x4*)g)[64 * j + lane];
        const f32x4 y = v[j] * rstd * gg;
        v2u o; o.x = pk2(y.x, y.y); o.y = pk2(y.z, y.w);
        ((v2u*)orow)[64 * j + lane] = o;
        if (WITH_BA) {
#pragma unroll
            for (int c = 0; c < 16; ++c) { const f32x4 w4 = *(const LAS f32x4*)(wt + c * 2048 + 4 * (64 * j + lane));
                acc[c] += (y.x * w4.x + y.y * w4.y) + (y.z * w4.z + y.w * w4.w); }
            __builtin_amdgcn_sched_barrier(0);
        }
    }
    if (WITH_BA) {
        float q8[8], t4[4];
#pragma unroll
        for (int r = 0; r < 8; ++r) { auto sw = __builtin_amdgcn_permlane32_swap(__float_as_uint(acc[r]), __float_as_uint(acc[r + 8]), false, false); q8[r] = __uint_as_float(sw[0]) + __uint_as_float(sw[1]); }
#pragma unroll
        for (int r = 0; r < 4; ++r) { auto sw = __builtin_amdgcn_permlane16_swap(__float_as_uint(q8[r]), __float_as_uint(q8[r + 4]), false, false); t4[r] = __uint_as_float(sw[0]) + __uint_as_float(sw[1]); }
#pragma unroll
        for (int r = 0; r < 4; ++r) { float tv = t4[r]; tv = DPP_ROR_ADD(tv, 8); tv = DPP_ROR_ADD(tv, 4); tv = DPP_ROR_ADD(tv, 2); tv = DPP_ROR_ADD(tv, 1); t4[r] = tv; }
        if ((lane & 15) == 0) { const int gq = lane >> 4;
#pragma unroll
            for (int r = 0; r < 4; ++r) barow[r + 4 * gq] = t4[r]; }
    }
}
__device__ __forceinline__ void wqk_item(const float* Wq, const float* SK, const float* gk  , bf16_t* Wqk, LAS float* lds, int item, int tid) {
    const int cbk = item >> 5, d0 = (item & 31) * 64, cb = cbk * 128, h = cbk >> 1, half = cbk & 1;
    LAS float* At = lds; LAS float* Bt = lds + 128 * 68;
    const float* skb = SK + ((size_t)(half * 8 + h) * 128) * 128;
#pragma unroll
    for (int i = 0; i < 4; ++i) { const int idx = tid + 512 * i, d = idx >> 5, k4 = idx & 31;
        const f32x4 w = *(const f32x4*)(Wq + (size_t)(d0 + d) * DM + cb + 4 * k4);
        At[(4 * k4 + 0) * 68 + d] = w.x; At[(4 * k4 + 1) * 68 + d] = w.y; At[(4 * k4 + 2) * 68 + d] = w.z; At[(4 * k4 + 3) * 68 + d] = w.w; }
#pragma unroll
    for (int i = 0; i < 8; ++i) { const int idx = tid + 512 * i, n = idx >> 5, k4 = idx & 31;
        const f32x4 w = *(const f32x4*)(skb + (size_t)n * 128 + 4 * k4);
        Bt[(4 * k4 + 0) * 132 + n] = w.x; Bt[(4 * k4 + 1) * 132 + n] = w.y; Bt[(4 * k4 + 2) * 132 + n] = w.z; Bt[(4 * k4 + 3) * 132 + n] = w.w; }
    __syncthreads();
    const int dy = tid >> 5, nx = tid & 31;
    float acc[4][4];
#pragma unroll
    for (int i = 0; i < 4; ++i)
#pragma unroll
        for (int j = 0; j < 4; ++j) acc[i][j] = 0.f;
#pragma unroll 4
    for (int kk = 0; kk < 128; ++kk) {
        const f32x4 a = *(const LAS f32x4*)(At + kk * 68 + 4 * dy), b = *(const LAS f32x4*)(Bt + kk * 132 + 4 * nx);
        acc[0][0] += a.x * b.x; acc[0][1] += a.x * b.y; acc[0][2] += a.x * b.z; acc[0][3] += a.x * b.w;
        acc[1][0] += a.y * b.x; acc[1][1] += a.y * b.y; acc[1][2] += a.y * b.z; acc[1][3] += a.y * b.w;
        acc[2][0] += a.z * b.x; acc[2][1] += a.z * b.y; acc[2][2] += a.z * b.z; acc[2][3] += a.z * b.w;
        acc[3][0] += a.w * b.x; acc[3][1] += a.w * b.y; acc[3][2] += a.w * b.z; acc[3][3] += a.w * b.w;
    }
    const f32x4 g4 = *(const f32x4*)(gk + d0 + 4 * dy);
#pragma unroll
    for (int j = 0; j < 4; ++j) { v2u o; o.x = pk2(acc[0][j] * g4.x, acc[1][j] * g4.y); o.y = pk2(acc[2][j] * g4.z, acc[3][j] * g4.w);
        *(v2u*)(Wqk + (size_t)(cb + 4 * nx + j) * DM + d0 + 4 * dy) = o; }
    __syncthreads();
}

typedef float f32x2 __attribute__((ext_vector_type(2)));
__device__ __forceinline__ int fp4_idx_of(float v) { return (v < 1.75f) ? (int)(v * 2.f + 0.25f) : (v < 2.5f ? 4 : (v < 3.5f ? 5 : (v < 5.f ? 6 : 7))); }
__device__ __forceinline__ void fp4_calibrate(int (&nib)[8]) {
    const unsigned T = 0x76543210u;
    const f32x2 a = __builtin_amdgcn_cvt_scalef32_pk_f32_fp4(T, 1.0f, 0), b = __builtin_amdgcn_cvt_scalef32_pk_f32_fp4(T, 1.0f, 1);
    const f32x2 c = __builtin_amdgcn_cvt_scalef32_pk_f32_fp4(T, 1.0f, 2), d = __builtin_amdgcn_cvt_scalef32_pk_f32_fp4(T, 1.0f, 3);
    nib[0] = fp4_idx_of(a.x); nib[1] = fp4_idx_of(a.y); nib[2] = fp4_idx_of(b.x); nib[3] = fp4_idx_of(b.y);
    nib[4] = fp4_idx_of(c.x); nib[5] = fp4_idx_of(c.y); nib[6] = fp4_idx_of(d.x); nib[7] = fp4_idx_of(d.y);
}
__device__ __forceinline__ void table_row_sw(const float* src, unsigned* dst, float* inv_scale, int lane) {
    int nib[8]; fp4_calibrate(nib);
    f32x4 v[8]; float mx = 0.f;
#pragma unroll
    for (int j = 0; j < 8; ++j) { v[j] = ((const f32x4*)src)[8 * lane + j];
        mx = fmaxf(mx, fmaxf(fmaxf(fabsf(v[j].x), fabsf(v[j].y)), fmaxf(fabsf(v[j].z), fabsf(v[j].w)))); }
#pragma unroll
    for (int o = 1; o < 64; o <<= 1) mx = fmaxf(mx, __shfl_xor(mx, o));
    const float sc = mx > 0.f ? mx * (0.85f / 6.f) : 1.f, isc = 1.f / sc;
    unsigned wd[4];
#pragma unroll
    for (int w = 0; w < 4; ++w) {
        unsigned acc = 0u;
#pragma unroll
        for (int e = 0; e < 8; ++e) {
            const f32x4 q = v[2 * w + (e >> 2)]; const float xe = ((e & 3) == 0) ? q.x : ((e & 3) == 1) ? q.y : ((e & 3) == 2) ? q.z : q.w;
            const float yv = fabsf(xe) * isc;
            unsigned code = (yv > 0.25f) + (yv > 0.75f) + (yv > 1.25f) + (yv > 1.75f) + (yv > 2.5f) + (yv > 3.5f) + (yv > 5.f);
            code |= (xe < 0.f) ? 8u : 0u;
            acc |= code << (4 * nib[e]);
        }
        wd[w] = acc;
    }
    v4u o; o.x = wd[0]; o.y = wd[1]; o.z = wd[2]; o.w = wd[3];
    ((v4u*)dst)[lane] = o;
    if (lane == 0) *inv_scale = sc;
}
__device__ __forceinline__ bool fp4_hw_encoder_ok() {
    unsigned t = 0u, u = 0u;
    t = __builtin_amdgcn_cvt_scalef32_pk_fp4_f32(t, 0.f, 0.5f, 1.0f, 0); t = __builtin_amdgcn_cvt_scalef32_pk_fp4_f32(t, 1.f, -1.5f, 1.0f, 1);
    t = __builtin_amdgcn_cvt_scalef32_pk_fp4_f32(t, 2.f, 3.f, 1.0f, 2); t = __builtin_amdgcn_cvt_scalef32_pk_fp4_f32(t, -4.f, 6.f, 1.0f, 3);
    u = __builtin_amdgcn_cvt_scalef32_pk_fp4_f32(u, 0.2f, 0.3f, 1.0f, 0); u = __builtin_amdgcn_cvt_scalef32_pk_fp4_f32(u, 2.4f, -2.6f, 1.0f, 1);
    u = __builtin_amdgcn_cvt_scalef32_pk_fp4_f32(u, 5.2f, -4.9f, 1.0f, 2); u = __builtin_amdgcn_cvt_scalef32_pk_fp4_f32(u, 1.3f, 0.8f, 1.0f, 3);
    const f32x2 a = __builtin_amdgcn_cvt_scalef32_pk_f32_fp4(t, 1.0f, 0), b = __builtin_amdgcn_cvt_scalef32_pk_f32_fp4(t, 1.0f, 1);
    const f32x2 c = __builtin_amdgcn_cvt_scalef32_pk_f32_fp4(t, 1.0f, 2), d = __builtin_amdgcn_cvt_scalef32_pk_f32_fp4(t, 1.0f, 3);
    const f32x2 e = __builtin_amdgcn_cvt_scalef32_pk_f32_fp4(u, 1.0f, 0), f = __builtin_amdgcn_cvt_scalef32_pk_f32_fp4(u, 1.0f, 1);
    const f32x2 g = __builtin_amdgcn_cvt_scalef32_pk_f32_fp4(u, 1.0f, 2), h = __builtin_amdgcn_cvt_scalef32_pk_f32_fp4(u, 1.0f, 3);
    return a.x == 0.f && a.y == 0.5f && b.x == 1.f && b.y == -1.5f && c.x == 2.f && c.y == 3.f && d.x == -4.f && d.y == 6.f
        && e.x == 0.f && e.y == 0.5f && f.x == 2.f && f.y == -3.f && g.x == 6.f && g.y == -4.f && h.x == 1.5f && h.y == 1.f;
}
__device__ __forceinline__ void table_row2_i4(const float* src, unsigned* dst, float* inv_scale, int lane) {
    f32x4 v[2][8]; float mx[2] = {0.f, 0.f};
#pragma unroll
    for (int r = 0; r < 2; ++r)
#pragma unroll
        for (int j = 0; j < 8; ++j) v[r][j] = __builtin_nontemporal_load(&((const f32x4*)(src + (size_t)r * DM))[64 * j + lane]);
#pragma unroll
    for (int r = 0; r < 2; ++r) {
#pragma unroll
        for (int j = 0; j < 8; ++j) mx[r] = fmaxf(mx[r], fmaxf(fmaxf(fabsf(v[r][j].x), fabsf(v[r][j].y)), fmaxf(fabsf(v[r][j].z), fabsf(v[r][j].w))));
#pragma unroll
        for (int o = 1; o < 64; o <<= 1) mx[r] = fmaxf(mx[r], __shfl_xor(mx[r], o));
        const float sc = mx[r] > 0.f ? mx[r] * 0.1f : 1.f, isc = 1.f / sc;
        unsigned short* drow = (unsigned short*)(dst + (size_t)r * 256);
#pragma unroll
        for (int j = 0; j < 8; ++j) { const f32x4 q4 = v[r][j];
            const int q0 = (int)fminf(fmaxf(rintf(q4.x * isc), -7.f), 7.f), q1 = (int)fminf(fmaxf(rintf(q4.y * isc), -7.f), 7.f);
            const int q2 = (int)fminf(fmaxf(rintf(q4.z * isc), -7.f), 7.f), q3 = (int)fminf(fmaxf(rintf(q4.w * isc), -7.f), 7.f);
            drow[64 * j + lane] = (unsigned short)((q0 & 15) | ((q1 & 15) << 4) | ((q2 & 15) << 8) | ((q3 & 15) << 12)); }
        if (lane == 0) inv_scale[r] = sc;
    }
}
__device__ __forceinline__ void table_row2(const float* src, unsigned* dst, float* inv_scale, int lane) {
    if (!fp4_hw_encoder_ok()) { table_row_sw(src, dst, inv_scale, lane); table_row_sw(src + DM, dst + 256, inv_scale + 1, lane); return; }
    f32x4 v[2][8]; float mx[2] = {0.f, 0.f};
#pragma unroll
    for (int r = 0; r < 2; ++r)
#pragma unroll
        for (int j = 0; j < 8; ++j) v[r][j] = __builtin_nontemporal_load(&((const f32x4*)(src + (size_t)r * DM))[64 * j + lane]);
#pragma unroll
    for (int r = 0; r < 2; ++r) {
#pragma unroll
        for (int j = 0; j < 8; ++j) mx[r] = fmaxf(mx[r], fmaxf(fmaxf(fabsf(v[r][j].x), fabsf(v[r][j].y)), fmaxf(fabsf(v[r][j].z), fabsf(v[r][j].w))));
#pragma unroll
        for (int o = 1; o < 64; o <<= 1) mx[r] = fmaxf(mx[r], __shfl_xor(mx[r], o));
        const float sc = mx[r] > 0.f ? mx[r] * (0.85f / 6.f) : 1.f, isc = 1.f / sc;
        unsigned short* drow = (unsigned short*)(dst + (size_t)r * 256);
#pragma unroll
        for (int j = 0; j < 8; ++j) { const f32x4 q4 = v[r][j];
            const float y0 = fminf(fmaxf(q4.x * isc, -6.f), 6.f), y1 = fminf(fmaxf(q4.y * isc, -6.f), 6.f), y2 = fminf(fmaxf(q4.z * isc, -6.f), 6.f), y3 = fminf(fmaxf(q4.w * isc, -6.f), 6.f);
            unsigned acc = __builtin_amdgcn_cvt_scalef32_pk_fp4_f32(0u, y0, y1, 1.0f, 0);
            acc = __builtin_amdgcn_cvt_scalef32_pk_fp4_f32(acc, y2, y3, 1.0f, 1);
            drow[64 * j + lane] = (unsigned short)(acc & 0xffffu); }
        if (lane == 0) inv_scale[r] = sc;
    }
}
#ifndef PEER_FAST_REDUCE
#define PEER_FAST_REDUCE 1
#endif
__device__ __forceinline__ float dpp_ror_add(float t, int) { return t; }
#define FP4_BYTE(d, j) __builtin_amdgcn_cvt_scalef32_pk_f32_fp4((d), 1.0f, (j))
__device__ __forceinline__ float dot_row(const v4u& a, const unsigned (&xh)[4], const unsigned (&xl)[4], float sh, float sl) {
    int hi = 0, lo = 0;
    hi = __builtin_amdgcn_sdot8((int)a.x, (int)xh[0], hi, false); lo = __builtin_amdgcn_sdot8((int)a.x, (int)xl[0], lo, false);
    hi = __builtin_amdgcn_sdot8((int)a.y, (int)xh[1], hi, false); lo = __builtin_amdgcn_sdot8((int)a.y, (int)xl[1], lo, false);
    hi = __builtin_amdgcn_sdot8((int)a.z, (int)xh[2], hi, false); lo = __builtin_amdgcn_sdot8((int)a.z, (int)xl[2], lo, false);
    hi = __builtin_amdgcn_sdot8((int)a.w, (int)xh[3], hi, false); lo = __builtin_amdgcn_sdot8((int)a.w, (int)xl[3], lo, false);
    return (float)hi * sh + (float)lo * sl;
}
__device__ __forceinline__ void axpy_row(const v4u& a, float wgt, float (&y)[32]) {
#pragma unroll
    for (int w = 0; w < 4; ++w) { const unsigned d = (w == 0) ? a.x : (w == 1) ? a.y : (w == 2) ? a.z : a.w;
        const f32x2 f0 = FP4_BYTE(d, 0), f1 = FP4_BYTE(d, 1), f2 = FP4_BYTE(d, 2), f3 = FP4_BYTE(d, 3);
        y[8 * w] += wgt * f0.x; y[8 * w + 1] += wgt * f0.y; y[8 * w + 2] += wgt * f1.x; y[8 * w + 3] += wgt * f1.y;
        y[8 * w + 4] += wgt * f2.x; y[8 * w + 5] += wgt * f2.y; y[8 * w + 6] += wgt * f3.x; y[8 * w + 7] += wgt * f3.y; }
}
#define DPP_ROR_MAX(t, n) fmaxf((t), __uint_as_float(__builtin_amdgcn_update_dpp(0u, __float_as_uint(t), 0x120 + (n), 0xf, 0xf, false)))
__device__ __forceinline__ int fkey(float f) { const int b_ = __float_as_int(f); return b_ ^ ((b_ >> 31) & 0x7fffffff); }
__device__ __forceinline__ float fval(int k_) { return __int_as_float(k_ ^ ((k_ >> 31) & 0x7fffffff)); }
#define DPP_ROR_MAXI(t, n) max((t), (int)__builtin_amdgcn_update_dpp(0u, (unsigned)(t), 0x120 + (n), 0xf, 0xf, false))
#define CSWAP(a, b) do { const int hi_ = max(a, b), lo_ = min(a, b); a = hi_; b = lo_; } while (0)
__device__ __forceinline__ void topk_token_fast(const _Float16* __restrict__ srow, int lane, const float* inv_su, const float* inv_sv,
                                                LAS int* se, LAS float* sa, LAS float* sb) {
    const int l16 = lane & 15, row = lane >> 4;
    float R[4];
    int k[4][8], res[4];
#pragma unroll
    for (int ps = 0; ps < 4; ++ps) {
        typedef _Float16 h8_t __attribute__((ext_vector_type(8)));
        const h8_t hv = *(const h8_t*)(srow + (4 * ps + row) * 128 + 8 * l16);
#pragma unroll
        for (int i = 0; i < 8; ++i) k[ps][i] = fkey(__uint_as_float((__float_as_uint((float)hv[i]) & 0xFFFFFF80u) | (unsigned)(8 * l16 + i)));
        CSWAP(k[ps][0], k[ps][1]); CSWAP(k[ps][2], k[ps][3]); CSWAP(k[ps][4], k[ps][5]); CSWAP(k[ps][6], k[ps][7]);
        CSWAP(k[ps][0], k[ps][2]); CSWAP(k[ps][1], k[ps][3]); CSWAP(k[ps][4], k[ps][6]); CSWAP(k[ps][5], k[ps][7]);
        CSWAP(k[ps][1], k[ps][2]); CSWAP(k[ps][5], k[ps][6]);
        CSWAP(k[ps][0], k[ps][4]); CSWAP(k[ps][1], k[ps][5]); CSWAP(k[ps][2], k[ps][6]); CSWAP(k[ps][3], k[ps][7]);
        CSWAP(k[ps][2], k[ps][4]); CSWAP(k[ps][3], k[ps][5]);
        CSWAP(k[ps][1], k[ps][2]); CSWAP(k[ps][3], k[ps][4]); CSWAP(k[ps][5], k[ps][6]);
        res[ps] = 0;
    }
#pragma unroll
    for (int it = 0; it < 16; ++it) {
        int m[4];
#pragma unroll
        for (int ps = 0; ps < 4; ++ps) m[ps] = k[ps][0];
#pragma unroll
        for (int ps = 0; ps < 4; ++ps) m[ps] = DPP_ROR_MAXI(m[ps], 8);
#pragma unroll
        for (int ps = 0; ps < 4; ++ps) m[ps] = DPP_ROR_MAXI(m[ps], 4);
#pragma unroll
        for (int ps = 0; ps < 4; ++ps) m[ps] = DPP_ROR_MAXI(m[ps], 2);
#pragma unroll
        for (int ps = 0; ps < 4; ++ps) m[ps] = DPP_ROR_MAXI(m[ps], 1);
#pragma unroll
        for (int ps = 0; ps < 4; ++ps) {
            const bool own = (k[ps][0] == m[ps]);
#pragma unroll
            for (int i = 0; i < 7; ++i) k[ps][i] = own ? k[ps][i + 1] : k[ps][i];
            k[ps][7] = own ? (int)0x80000000 : k[ps][7];
            res[ps] = (l16 == it) ? m[ps] : res[ps];
        }
    }
#pragma unroll
    for (int ps = 0; ps < 4; ++ps) R[ps] = fval(res[ps]);
    float X[2], Y[2], av[2], v2[2]; int j[2], best[2];
#pragma unroll
    for (int g = 0; g < 2; ++g) {
        const auto sw = __builtin_amdgcn_permlane16_swap(__float_as_uint(R[2 * g]), __float_as_uint(R[2 * g + 1]), false, false);
        X[g] = __uint_as_float(sw[0]); Y[g] = __uint_as_float(sw[1]);
        av[g] = __uint_as_float(__float_as_uint(X[g]) & 0xFFFFFF80u);
        j[g] = 0; best[g] = 0;
        v2[g] = __shfl(Y[g], (lane & 48));
    }
#pragma unroll
    for (int it = 0; it < 16; ++it) {
        int cand[2], m[2];
#pragma unroll
        for (int g = 0; g < 2; ++g) {
            const float sum = av[g] + __uint_as_float(__float_as_uint(v2[g]) & 0xFFFFFF80u);
            cand[g] = (j[g] < 16) ? fkey(__uint_as_float((__float_as_uint(sum) & 0xFFFFFF00u) | (unsigned)((l16 << 4) | (j[g] & 15)))) : (int)0x80000000;
            m[g] = cand[g];
        }
#pragma unroll
        for (int g = 0; g < 2; ++g) m[g] = DPP_ROR_MAXI(m[g], 8);
#pragma unroll
        for (int g = 0; g < 2; ++g) m[g] = DPP_ROR_MAXI(m[g], 4);
#pragma unroll
        for (int g = 0; g < 2; ++g) m[g] = DPP_ROR_MAXI(m[g], 2);
#pragma unroll
        for (int g = 0; g < 2; ++g) m[g] = DPP_ROR_MAXI(m[g], 1);
#pragma unroll
        for (int g = 0; g < 2; ++g) {
            best[g] = (l16 == it) ? m[g] : best[g];
            if (it < 15) { j[g] += (cand[g] == m[g]) ? 1 : 0; v2[g] = __shfl(Y[g], (lane & 48) + (j[g] & 15)); }
        }
    }
#pragma unroll
    for (int g = 0; g < 2; ++g) {
        const unsigned bb = __float_as_uint(fval(best[g]));
        const int bi = (bb >> 4) & 15, bj = bb & 15;
        const unsigned k1 = __float_as_uint(__shfl(X[g], (lane & 48) + bi)), k2 = __float_as_uint(__shfl(Y[g], (lane & 48) + bj));
        const int e = (int)(k1 & 127u) * 128 + (int)(k2 & 127u);
        const float bv = __uint_as_float(bb & 0xFFFFFF00u);
        float mx = bv; mx = DPP_ROR_MAX(mx, 8); mx = DPP_ROR_MAX(mx, 4); mx = DPP_ROR_MAX(mx, 2); mx = DPP_ROR_MAX(mx, 1);
        const float ex = __expf(bv - mx);
        float sm = ex; sm = DPP_ROR_ADD(sm, 8); sm = DPP_ROR_ADD(sm, 4); sm = DPP_ROR_ADD(sm, 2); sm = DPP_ROR_ADD(sm, 1);
        const float gate = ex * __builtin_amdgcn_rcpf(sm);
        const int head = 4 * g + ((row & 1) * 2 + (row >> 1));
        se[head * 16 + l16] = e; sa[head * 16 + l16] = inv_su[e]; sb[head * 16 + l16] = gate * inv_sv[e];
    }
}
#define PEER_LOAD(DST, TAB, b) do { _Pragma("unroll") for (int r_ = 0; r_ < 4; ++r_) { const unsigned char* rp_ = (TAB) + (size_t)(unsigned)__builtin_amdgcn_readfirstlane(se[4 * (b) + r_]) * 1024 + 16 * lane; \
        DST[r_] = *(const v4u*)rp_; } } while (0)
__device__ __forceinline__ void peer_token(int t, const _Float16* scores, const bf16_t* hn, const float* hbuf, const unsigned char* U8, const unsigned char* V8,
                                           const float* inv_su, const float* inv_sv, const float* gfin, const float* gffn, const unsigned long long* rowss, float* out,
                                           LAS int* se, LAS float* sa, LAS float* sb, int lane_in) {
    int lane = lane_in;
    {
        LAS int* se0 = se + 512; LAS float* sa0 = sa + 512; LAS float* sb0 = sb + 512;
        topk_token_fast(scores + (size_t)t * DM, lane, inv_su, inv_sv, se0, sa0, sb0);
        unsigned a0 = ((unsigned)se0[lane] << 7) | (unsigned)lane, a1 = ((unsigned)se0[lane + 64] << 7) | (unsigned)(lane + 64);
#pragma unroll
        for (int k = 2; k <= 128; k <<= 1) {
#pragma unroll
            for (int j = k >> 1; j > 0; j >>= 1) {
                if (j == 64) { const unsigned lo = a0 < a1 ? a0 : a1, hi = a0 < a1 ? a1 : a0; a0 = lo; a1 = hi; }
                else {
                    const unsigned p0 = (unsigned)__shfl_xor((int)a0, j), p1 = (unsigned)__shfl_xor((int)a1, j);
                    const bool lower = (lane & j) == 0;
                    const bool up0 = (lane & k) == 0, up1 = ((lane + 64) & k) == 0;
                    const unsigned mn0 = a0 < p0 ? a0 : p0, mx0 = a0 < p0 ? p0 : a0, mn1 = a1 < p1 ? a1 : p1, mx1 = a1 < p1 ? p1 : a1;
                    a0 = (up0 == lower) ? mn0 : mx0; a1 = (up1 == lower) ? mn1 : mx1;
                }
            }
        }
        const int k0 = a0 & 127, k1 = a1 & 127;
        se[lane] = (int)(a0 >> 7); sa[lane] = sa0[k0]; sb[lane] = sb0[k0];
        se[lane + 64] = (int)(a1 >> 7); sa[lane + 64] = sa0[k1]; sb[lane + 64] = sb0[k1];
    }
    asm volatile("" : "+v"(lane));
    float y[32];
    unsigned xh[4], xl[4]; float sh, sl;
    {
        float xf[32]; float mx = 0.f;
        const float rstd_t = rsqrtf((float)rowss[t] * (1.f / (4294967296.f * DM)) + EPS);
#pragma unroll
        for (int j = 0; j < 4; ++j) {
            const v4u h0 = *(const v4u*)(hn + (size_t)t * DM + 32 * lane + 8 * j);
            const f32x4 ga = *(const f32x4*)(gffn + 32 * lane + 8 * j), gb = *(const f32x4*)(gffn + 32 * lane + 8 * j + 4);
#pragma unroll
            for (int w = 0; w < 4; ++w) { const unsigned d0 = (w == 0) ? h0.x : (w == 1) ? h0.y : (w == 2) ? h0.z : h0.w;
                const float g0 = (w == 0) ? ga.x : (w == 1) ? ga.z : (w == 2) ? gb.x : gb.z, g1 = (w == 0) ? ga.y : (w == 1) ? ga.w : (w == 2) ? gb.y : gb.w;
                xf[8 * j + 2 * w] = __uint_as_float(d0 << 16) * (rstd_t * g0); xf[8 * j + 2 * w + 1] = __uint_as_float(d0 & 0xffff0000u) * (rstd_t * g1);
                mx = fmaxf(mx, fmaxf(fabsf(xf[8 * j + 2 * w]), fabsf(xf[8 * j + 2 * w + 1]))); }
        }
#pragma unroll
        for (int o = 1; o < 64; o <<= 1) mx = fmaxf(mx, __shfl_xor(mx, o));
        sh = mx > 0.f ? mx * (1.f / 7.f) : 1.f; sl = sh * (1.f / 14.f);
        const float ish = 1.f / sh, isl = 1.f / sl;
#pragma unroll
        for (int w = 0; w < 4; ++w) { unsigned ph = 0u, pl = 0u;
#pragma unroll
            for (int i = 0; i < 8; ++i) { const float xe = xf[8 * w + i];
                const float qh = fminf(fmaxf(rintf(xe * ish), -7.f), 7.f);
                const float ql = fminf(fmaxf(rintf((xe - qh * sh) * isl), -7.f), 7.f);
                ph |= ((unsigned)(int)qh & 15u) << (4 * i); pl |= ((unsigned)(int)ql & 15u) << (4 * i); }
            xh[w] = ph; xl[w] = pl; }
    }
#pragma unroll
    for (int i = 0; i < 32; ++i) y[i] = 0.f;
    v4u Ua[4], Ub[4], Va[4];
#define PEER_BATCH(b, UC, VC) do { \
        PEER_LOAD(VC, V8, (b)); \
        float pr[4]; \
        _Pragma("unroll") for (int r = 0; r < 4; ++r) pr[r] = dot_row(UC[r], xh, xl, sh, sl); \
        if ((b) + 2 < 32) PEER_LOAD(UC, U8, (b) + 2); \
        float wr_[4], q2[2]; \
        _Pragma("unroll") for (int r = 0; r < 2; ++r) { auto sw = __builtin_amdgcn_permlane32_swap(__float_as_uint(pr[r]), __float_as_uint(pr[r + 2]), false, false); q2[r] = __uint_as_float(sw[0]) + __uint_as_float(sw[1]); } \
        float tv; \
        { auto sw = __builtin_amdgcn_permlane16_swap(__float_as_uint(q2[0]), __float_as_uint(q2[1]), false, false); tv = __uint_as_float(sw[0]) + __uint_as_float(sw[1]); } \
        tv = DPP_ROR_ADD(tv, 8); tv = DPP_ROR_ADD(tv, 4); tv = DPP_ROR_ADD(tv, 2); tv = DPP_ROR_ADD(tv, 1); \
        const int k = 4 * (b) + (lane >> 4);     \
        const float wc = gelu_erf(tv * sa[k]) * sb[k]; \
        _Pragma("unroll") for (int r = 0; r < 4; ++r) wr_[r] = __uint_as_float(__builtin_amdgcn_readlane(__float_as_uint(wc), 16 * r)); \
        _Pragma("unroll") for (int r = 0; r < 4; ++r) axpy_row(VC[r], wr_[r], y); } while (0)
    PEER_LOAD(Ua, U8, 0); PEER_LOAD(Ub, U8, 1);
#pragma unroll 1
    for (int b = 0; b < 32; b += 2) { PEER_BATCH(b, Ua, Va); PEER_BATCH(b + 1, Ub, Va); }
    float ss = 0.f;
    int lres = lane; asm volatile("" : "+v"(lres));
#pragma unroll
    for (int j = 0; j < 4; ++j) { const v4u hv = *(const v4u*)(hn + (size_t)t * DM + 32 * lres + 8 * j);
#pragma unroll
        for (int w = 0; w < 4; ++w) { const unsigned d0 = (w == 0) ? hv.x : (w == 1) ? hv.y : (w == 2) ? hv.z : hv.w;
            y[8 * j + 2 * w] += __uint_as_float(d0 << 16); y[8 * j + 2 * w + 1] += __uint_as_float(d0 & 0xffff0000u);
            ss += y[8 * j + 2 * w] * y[8 * j + 2 * w] + y[8 * j + 2 * w + 1] * y[8 * j + 2 * w + 1]; } }
    ss = wave_sum(ss);
    const float rstd = rsqrtf(ss * (1.f / DM) + EPS);
#pragma unroll
    for (int j = 0; j < 8; ++j) { const f32x4 gg = *(const f32x4*)(gfin + 32 * lane + 4 * j);
        f32x4 o; o.x = y[4 * j] * rstd * gg.x; o.y = y[4 * j + 1] * rstd * gg.y; o.z = y[4 * j + 2] * rstd * gg.z; o.w = y[4 * j + 3] * rstd * gg.w;
        *(f32x4*)(out + (size_t)t * DM + 32 * lane + 4 * j) = o; }
}
typedef short bf16x8 __attribute__((ext_vector_type(8)));
__device__ __forceinline__ int pos32(int x) { const int g = x & ~31, l = x & 31; return g + 8 * ((l & 15) >> 2) + 4 * (l >> 4) + (l & 3); }
constexpr size_t PB_H_QG = 0, PB_H_KDT = 32 * MiB, PB_H_A = 64 * MiB;
constexpr size_t PB_G_QS = 80 * MiB, PB_G_KT = 96 * MiB;
constexpr size_t PB_G_W = 112 * MiB, PB_G_A = 144 * MiB, PB_G_U = 160 * MiB;
constexpr int CA = 96;
constexpr int PROG_WORD = 3584;
constexpr int NSB = 128, CPW = 4;
constexpr int SC_QG = 0, SC_WV = 16384, SC_KDT = 32768, SC_A = 49152, SC_BUF = 57344, SC_VEC = 2 * SC_BUF, SC_OT = SC_VEC + 2048, SC_OTB = 17408, SC_GAIN = SC_OT + 2 * SC_OTB;

__device__ __forceinline__ bf16x8 pack_frag(const f32x4& x0, const f32x4& x1) {
    v4u w; w.x = pk2(x0.x, x0.y); w.y = pk2(x0.z, x0.w); w.z = pk2(x1.x, x1.y); w.w = pk2(x1.z, x1.w);
    return __builtin_bit_cast(bf16x8, w);
}
#define MFMA16(a, b, c) __builtin_amdgcn_mfma_f32_16x16x32_bf16((a), (b), (c), 0, 0, 0)

__device__ __forceinline__ void hgrn_prep_item(int item, const bf16_t* proj, const float* lb_logits, unsigned char* pb, float* vecs, LAS unsigned char* lds, int tid) {
    const int c = item & 127, sq = item >> 7, b = sq >> 3, h = sq & 7, t0 = b * SEQ + c * 64;
    const int d = tid & 127, seg = tid >> 7, lane = tid & 63, wave = tid >> 6;
    LAS bf16_t* QGl = (LAS bf16_t*)lds; LAS bf16_t* KGl = (LAS bf16_t*)(lds + 17408); LAS float* segsum = (LAS float*)(lds + 34816);
    bf16_t* gQG = (bf16_t*)(pb + PB_H_QG) + (size_t)item * 8192;
    bf16_t* gKDT = (bf16_t*)(pb + PB_H_KDT) + (size_t)item * 8192;
    bf16_t* gA = (bf16_t*)(pb + PB_H_A) + (size_t)item * 4096;
    float* gvec = vecs + (size_t)item * 256;
    const float l0 = lb_logits[h * 128 + d], l1 = lb_logits[1024 + h * 128 + d];
    const float lb = 1.f / (1.f + __expf(l1 - l0));
    float lf[16], qv[16], kv[16];
#pragma unroll
    for (int i = 0; i < 16; ++i) {
        const bf16_t* pr = proj + (size_t)(t0 + 16 * seg + i) * NPROJ + h * 128 + d;
        const float z = bf2f(pr[C_AF]); qv[i] = bf2f(pr[C_AQ]);
        const float f = lb + (1.f - lb) * sigmoidf_(z);
        lf[i] = __logf(f); kv[i] = 1.f - f;
    }
    float run = 0.f;
#pragma unroll
    for (int i = 0; i < 16; ++i) { run += lf[i]; lf[i] = run; }
    segsum[seg * 128 + d] = run;
    __syncthreads();
    float off = 0.f, bl = 0.f;
#pragma unroll
    for (int s = 0; s < 4; ++s) { const float v = segsum[s * 128 + d]; bl += v; if (s < seg) off += v; }
    const int pd = pos32(d);
    float kd[16];
#pragma unroll
    for (int i = 0; i < 16; ++i) {
        const float bc = lf[i] + off; const int tl = 16 * seg + i;
        const float qg = qv[i] * __expf(bc), kg = kv[i] * __expf(-bc);
        kd[i] = kv[i] * __expf(bl - bc);
        const bf16_t qb = f2bf(qg);
        QGl[tl * 136 + d] = qb; KGl[tl * 136 + d] = f2bf(kg);
        gQG[tl * 128 + pd] = qb;
    }
#pragma unroll
    for (int ii = 0; ii < 4; ++ii) { v2u o; o.x = pk2(kd[4 * ii], kd[4 * ii + 1]); o.y = pk2(kd[4 * ii + 2], kd[4 * ii + 3]);
        *(v2u*)(gKDT + d * 64 + 32 * (seg >> 1) + 8 * ii + 4 * (seg & 1)) = o; }
    if (seg == 0) gvec[128 + d] = __expf(bl);
    __syncthreads();
    const int n = lane & 15, q = lane >> 4;
#pragma unroll
    for (int ti = 0; ti < 2; ++ti) {
        const int id = wave + 8 * ti, mt = id >> 2, ns = id & 3;
        f32x4 acc = {0.f, 0.f, 0.f, 0.f};
        if (ns <= mt) {
#pragma unroll
            for (int s4 = 0; s4 < 4; ++s4) {
                const bf16x8 a = *(const LAS bf16x8*)(QGl + (16 * mt + n) * 136 + 32 * s4 + 8 * q);
                const bf16x8 bb = *(const LAS bf16x8*)(KGl + (16 * ns + n) * 136 + 32 * s4 + 8 * q);
                acc = MFMA16(a, bb, acc);
            }
        }
        const int s = 16 * ns + n, ps = pos32(s);
#pragma unroll
        for (int r = 0; r < 4; ++r) { const int t = 16 * mt + 4 * q + r; const float v = (r == 0) ? acc.x : (r == 1) ? acc.y : (r == 2) ? acc.z : acc.w;
            gA[t * 64 + ps] = f2bf((s <= t) ? v : 0.f); }
    }
    __syncthreads();
}

constexpr int GP_QF = 0, GP_KF = 33024, GP_N = 0, GP_QB = 66048, GP_KB = 83456, GP_VB = 100864, GP_PART = 135680, GP_SB = 137728;
__device__ __forceinline__ void gdn_prep_item(int item, const bf16_t* proj, const float* ba, const float* conv_w, const float* A_log, const float* dt_bias,
                                              unsigned char* pb, float* vecs, LAS unsigned char* lds, int tid) {
    const int c = item & 127, bq = item >> 7, b = bq >> 2, qh = bq & 3, t0 = b * SEQ + c * 64;
    const int lane = tid & 63, wave = tid >> 6;
    LAS float* QF = (LAS float*)(lds + GP_QF); LAS float* KF = (LAS float*)(lds + GP_KF);
    LAS bf16_t* QB = (LAS bf16_t*)(lds + GP_QB); LAS bf16_t* KB = (LAS bf16_t*)(lds + GP_KB); LAS bf16_t* VB = (LAS bf16_t*)(lds + GP_VB);
    LAS float* PART = (LAS float*)(lds + GP_PART); LAS float* SBETA = (LAS float*)(lds + GP_SB); LAS float* SGC = SBETA + 128;
    LAS float* NM = (LAS float*)(lds + GP_N);
    {
        int col, wch; const int dd = tid & 127;
        if (tid < 128) { col = C_BQ + qh * 128 + dd; wch = qh * 128 + dd; }
        else if (tid < 256) { col = C_BK + qh * 128 + dd; wch = 512 + qh * 128 + dd; }
        else { const int vh = 2 * qh + ((tid - 256) >> 7); col = C_BV + vh * 128 + dd; wch = 1024 + vh * 128 + dd; }
        const float w0 = conv_w[wch], w1 = conv_w[2048 + wch], w2 = conv_w[4096 + wch], w3 = conv_w[6144 + wch];
        float h0 = 0.f, h1 = 0.f, h2 = 0.f;
        const bf16_t* pr = proj + (size_t)t0 * NPROJ + col;
        if (c > 0) { h0 = bf2f(pr[-3 * NPROJ]); h1 = bf2f(pr[-2 * NPROJ]); h2 = bf2f(pr[-1 * NPROJ]); }
        unsigned xr[64];
#pragma unroll
        for (int t = 0; t < 64; ++t) xr[t] = pr[(size_t)t * NPROJ];
#pragma unroll
        for (int t = 0; t < 64; ++t) {
            const float xx = __uint_as_float(xr[t] << 16);
            const float yv = siluf_(w0 * h0 + w1 * h1 + w2 * h2 + w3 * xx);
            h0 = h1; h1 = h2; h2 = xx;
            if (tid < 128) QF[t * 129 + dd] = yv;
            else if (tid < 256) KF[t * 129 + dd] = yv;
            else VB[((tid - 256) >> 7) * 8704 + t * 136 + dd] = f2bf(yv);
        }
    }
    __syncthreads();
    {
        const int t = tid & 63, part = tid >> 6, which = part >> 2, sub = part & 3;
        const LAS float* src = (which ? KF : QF) + t * 129 + 32 * sub;
        float s = 0.f;
#pragma unroll
        for (int i = 0; i < 32; ++i) s += src[i] * src[i];
        PART[(which * 4 + sub) * 64 + t] = s;
    }
    if (wave < 2) {
        const int vh = 2 * qh + wave;
        const float ax = ba[(size_t)(t0 + lane) * 16 + 8 + vh] + dt_bias[vh];
        const float sp = ax > 20.f ? ax : log1pf(__expf(ax));
        float gc = -__expf(A_log[vh]) * sp;
#pragma unroll
        for (int o = 1; o < 64; o <<= 1) { const float up = __shfl_up(gc, o); if (lane >= o) gc += up; }
        const float gl = __shfl(gc, 63);
        const float beta = sigmoidf_(ba[(size_t)(t0 + lane) * 16 + vh]);
        SBETA[wave * 64 + lane] = beta; SGC[wave * 64 + lane] = gc;
        float* gvec = vecs + ((size_t)(16 + b * 8 + vh) * 128 + c) * 256;
        gvec[lane] = __expf(gc); gvec[64 + lane] = __expf(gl - gc);
        const float dl = __expf(gl); gvec[128 + lane] = dl; gvec[192 + lane] = dl;
    }
    __syncthreads();
    {
        const int d = tid & 127, seg = tid >> 7, pd = pos32(d);
        bf16_t* gQS = (bf16_t*)(pb + PB_G_QS) + (size_t)item * 8192;
        bf16_t* gKT = (bf16_t*)(pb + PB_G_KT) + (size_t)item * 8192;
        float kk[16];
#pragma unroll
        for (int i = 0; i < 16; ++i) {
            const int tl = 16 * seg + i;
            const float sq = PART[0 * 64 + tl] + PART[1 * 64 + tl] + PART[2 * 64 + tl] + PART[3 * 64 + tl];
            const float sk = PART[4 * 64 + tl] + PART[5 * 64 + tl] + PART[6 * 64 + tl] + PART[7 * 64 + tl];
            const bf16_t qb = f2bf(QF[tl * 129 + d] * rsqrtf(sq + EPS) * 0.08838834764831845f);
            const bf16_t kb = f2bf(KF[tl * 129 + d] * rsqrtf(sk + EPS));
            QB[tl * 136 + d] = qb; KB[tl * 136 + d] = kb; gQS[tl * 128 + pd] = qb; kk[i] = bf2f(kb);
        }
#pragma unroll
        for (int ii = 0; ii < 4; ++ii) { v2u o; o.x = pk2(kk[4 * ii], kk[4 * ii + 1]); o.y = pk2(kk[4 * ii + 2], kk[4 * ii + 3]);
            *(v2u*)(gKT + d * 64 + 32 * (seg >> 1) + 8 * ii + 4 * (seg & 1)) = o; }
    }
    __syncthreads();
    {
        const int n = lane & 15, q = lane >> 4;
#pragma unroll
        for (int ti = 0; ti < 2; ++ti) {
            const int id = 2 * wave + ti, mt = id >> 2, ns = id & 3;
            f32x4 akk = {0.f, 0.f, 0.f, 0.f}, aqk = {0.f, 0.f, 0.f, 0.f};
            if (ns <= mt) {
#pragma unroll
                for (int s4 = 0; s4 < 4; ++s4) {
                    const bf16x8 kb_ = *(const LAS bf16x8*)(KB + (16 * ns + n) * 136 + 32 * s4 + 8 * q);
                    const bf16x8 ka_ = *(const LAS bf16x8*)(KB + (16 * mt + n) * 136 + 32 * s4 + 8 * q);
                    const bf16x8 qa_ = *(const LAS bf16x8*)(QB + (16 * mt + n) * 136 + 32 * s4 + 8 * q);
                    akk = MFMA16(ka_, kb_, akk); aqk = MFMA16(qa_, kb_, aqk);
                }
            }
            const int s = 16 * ns + n, ps = pos32(s);
#pragma unroll
            for (int vl = 0; vl < 2; ++vl) {
                bf16_t* gA = (bf16_t*)(pb + PB_G_A) + ((size_t)((b * 8 + 2 * qh + vl) * 128 + c)) * 4096;
                const float gcs = SGC[vl * 64 + s];
#pragma unroll
                for (int r = 0; r < 4; ++r) {
                    const int t = 16 * mt + 4 * q + r;
                    const float vk = (r == 0) ? akk.x : (r == 1) ? akk.y : (r == 2) ? akk.z : akk.w;
                    const float vq = (r == 0) ? aqk.x : (r == 1) ? aqk.y : (r == 2) ? aqk.z : aqk.w;
                    const float ex = (s <= t) ? __expf(SGC[vl * 64 + t] - gcs) : 0.f;
                    NM[vl * 4096 + t * 64 + s] = (s < t) ? SBETA[vl * 64 + t] * vk * ex : 0.f;
                    gA[t * 64 + ps] = f2bf((s <= t) ? vq * ex : 0.f);
                }
            }
        }
    }
    __syncthreads();
    {
        typedef float f32x2v __attribute__((ext_vector_type(2)));
        const int vl = (tid >> 7) & 1, colx = 2 * (tid & 127);
        const bool act = tid < 256;
        f32x2v x[64];
        if (act) {
            if (colx < 128) {
#pragma unroll
                for (int t = 0; t < 64; ++t) { const unsigned pr2 = *(const LAS unsigned*)(VB + vl * 8704 + t * 136 + colx); const float sb_ = SBETA[vl * 64 + t];
                    x[t] = (f32x2v){sb_ * __uint_as_float(pr2 << 16), sb_ * __uint_as_float(pr2 & 0xffff0000u)}; }
            } else {
#pragma unroll
                for (int t = 0; t < 64; ++t) { const unsigned pr2 = *(const LAS unsigned*)(KB + t * 136 + colx - 128); const float sb_ = SBETA[vl * 64 + t] * __expf(SGC[vl * 64 + t]);
                    x[t] = (f32x2v){sb_ * __uint_as_float(pr2 << 16), sb_ * __uint_as_float(pr2 & 0xffff0000u)}; }
            }
        }
        __syncthreads();
        if (act) {
            const LAS float* Nv = NM + vl * 4096;
#pragma unroll
            for (int t = 1; t < 64; ++t) {
                f32x2v acc = x[t];
#pragma unroll
                for (int s4 = 0; s4 < (t + 3) / 4; ++s4) {
                    const f32x4 nn = *(const LAS f32x4*)(Nv + t * 64 + 4 * s4);
                    acc = __builtin_elementwise_fma((f32x2v){-nn.x, -nn.x}, x[4 * s4], acc);
                    if (4 * s4 + 1 < t) acc = __builtin_elementwise_fma((f32x2v){-nn.y, -nn.y}, x[4 * s4 + 1], acc);
                    if (4 * s4 + 2 < t) acc = __builtin_elementwise_fma((f32x2v){-nn.z, -nn.z}, x[4 * s4 + 2], acc);
                    if (4 * s4 + 3 < t) acc = __builtin_elementwise_fma((f32x2v){-nn.w, -nn.w}, x[4 * s4 + 3], acc);
                }
                x[t] = acc;
            }
            if (colx < 128) {
                bf16_t* gU = (bf16_t*)(pb + PB_G_U) + ((size_t)((b * 8 + 2 * qh + vl) * 128 + c)) * 8192;
#pragma unroll
                for (int hc = 0; hc < 2; ++hc) { const int cx = colx + hc, sl = cx >> 4, n = cx & 15;
#pragma unroll
                    for (int mt = 0; mt < 4; ++mt)
#pragma unroll
                        for (int q = 0; q < 4; ++q) { v2u o; o.x = pk2(x[16 * mt + 4 * q][hc], x[16 * mt + 4 * q + 1][hc]); o.y = pk2(x[16 * mt + 4 * q + 2][hc], x[16 * mt + 4 * q + 3][hc]);
                            *(v2u*)(gU + ((size_t)((sl * 4 + mt) * 64 + q * 16 + n)) * 4) = o; } }
            } else {
                LAS bf16_t* WS = (LAS bf16_t*)(lds + GP_QB) + vl * 8704;
                const int pd0 = pos32(colx - 128), pd1 = pos32(colx + 1 - 128);
#pragma unroll
                for (int t = 0; t < 64; ++t) { WS[t * 136 + pd0] = f2bf(-x[t].x); WS[t * 136 + pd1] = f2bf(-x[t].y); }
            }
        }
    }
    __syncthreads();
    {
#pragma unroll
        for (int i = 0; i < 4; ++i) { const int p = tid + 512 * i, vl = p >> 10, row = (p >> 4) & 63, c16 = p & 15;
            bf16_t* gW = (bf16_t*)(pb + PB_G_W) + ((size_t)((b * 8 + 2 * qh + vl) * 128 + c)) * 8192;
            *(v4u*)(gW + row * 128 + c16 * 8) = *(const LAS v4u*)(lds + GP_QB + vl * 17408 + row * 272 + c16 * 16); }
    }
    __syncthreads();
}

struct ScanSrc { const unsigned char* qg; const unsigned char* wv; const unsigned char* kdt; const unsigned char* a; const float* vec; size_t wv_row; };
__device__ __forceinline__ void scan_dma(const ScanSrc& S, LAS unsigned char* buf, LAS unsigned char* vecb, int w, int lane) {
#pragma unroll
    for (int i = 0; i < 2; ++i) { const int pi = 2 * w + i, row = 4 * pi + (lane >> 4), cl = (lane & 15) ^ (row & 15);
        __builtin_amdgcn_global_load_lds((const unsigned*)(S.qg + row * 256 + cl * 16), (LAS unsigned*)(buf + SC_QG + pi * 1024), 16, 0, 0);
        __builtin_amdgcn_global_load_lds((const unsigned*)(S.wv + (size_t)row * S.wv_row + cl * 16), (LAS unsigned*)(buf + SC_WV + pi * 1024), 16, 0, 0); }
#pragma unroll
    for (int i = 0; i < 2; ++i) { const int pi = 2 * w + i, row = 8 * pi + (lane >> 3), cl = (lane & 7) ^ ((row >> 1) & 7);
        __builtin_amdgcn_global_load_lds((const unsigned*)(S.kdt + row * 128 + cl * 16), (LAS unsigned*)(buf + SC_KDT + pi * 1024), 16, 0, 0); }
    { const int pi = w, row = 8 * pi + (lane >> 3), cl = (lane & 7) ^ ((row >> 1) & 7);
        __builtin_amdgcn_global_load_lds((const unsigned*)(S.a + row * 128 + cl * 16), (LAS unsigned*)(buf + SC_A + pi * 1024), 16, 0, 0); }
    if (w == 0) __builtin_amdgcn_global_load_lds((const unsigned*)((const unsigned char*)S.vec + lane * 16), (LAS unsigned*)vecb, 16, 0, 0);
}
template <bool GDN>
__device__ __forceinline__ void scan_block(int sq, int g, const bf16_t* proj, const unsigned char* pb, const float* vecs, const float* hgrn_g, const float* gdn_g,
                                           bf16_t* mix, unsigned* prog, int nfb, LAS unsigned char* lds, int tid) {
    constexpr bool gdn = GDN;
    const int b = (sq & 15) >> 3, hh = sq & 7, lane = tid & 63, sl = __builtin_amdgcn_readfirstlane(tid >> 6), n = lane & 15, q = lane >> 4;
    const unsigned char* bQG; const unsigned char* bWV; const unsigned char* bKDT; const unsigned char* bA; const unsigned char* bU = nullptr;
    size_t wv_row, wv_chunk; int gate_col, mix_col; const float* gain;
    if (!gdn) {
        const size_t s0 = (size_t)(b * 8 + hh) * 128;
        bQG = pb + PB_H_QG + s0 * 16384; bKDT = pb + PB_H_KDT + s0 * 16384; bA = pb + PB_H_A + s0 * 8192;
        bWV = (const unsigned char*)(proj + (size_t)(b * SEQ) * NPROJ + C_AI + hh * 128); wv_row = (size_t)NPROJ * 2; wv_chunk = (size_t)64 * NPROJ * 2;
        gate_col = C_AG + hh * 128; mix_col = hh * 128; gain = hgrn_g;
    } else {
        const size_t s0 = (size_t)(b * 8 + hh) * 128, q0 = (size_t)(b * 4 + (hh >> 1)) * 128;
        bQG = pb + PB_G_QS + q0 * 16384; bKDT = pb + PB_G_KT + q0 * 16384; bA = pb + PB_G_A + s0 * 8192;
        bWV = pb + PB_G_W + s0 * 16384; wv_row = 256; wv_chunk = 16384; bU = pb + PB_G_U + s0 * 16384;
        gate_col = C_BZ + hh * 128; mix_col = 1024 + hh * 128; gain = gdn_g;
    }
    const float* bvec = vecs + (size_t)sq * 128 * 256;
    LAS float* gainl = (LAS float*)(lds + SC_GAIN);
    const int wave = sl;
    {
        ScanSrc src{bQG, bWV, bKDT, bA, bvec, wv_row};
        scan_dma(src, lds, lds + SC_VEC, wave, lane);
        if (tid < 128) gainl[tid] = gain[tid];
    }
    __builtin_amdgcn_s_waitcnt(0x0070);
    asm volatile("" ::: "memory");
    __builtin_amdgcn_s_barrier();
    asm volatile("" ::: "memory");
#define SCAN_BAR() do { asm volatile("s_waitcnt lgkmcnt(0)" ::: "memory"); __builtin_amdgcn_s_barrier(); asm volatile("" ::: "memory"); } while (0)
#define SCHED_FENCE() __builtin_amdgcn_sched_barrier(0)
    const int sl16 = 2 * g + wave;
    const int hw = (wave == 2) ? 0 : (wave == 3) ? 1 : (wave == 6) ? 2 : (wave == 7) ? 3 : -1;
    if (wave < 2) {
        f32x4 S[8];
        bf16x8 Sf[4];
#pragma unroll
        for (int m = 0; m < 8; ++m) S[m] = (f32x4){0.f, 0.f, 0.f, 0.f};
#pragma unroll
        for (int s4 = 0; s4 < 4; ++s4) Sf[s4] = pack_frag(S[0], S[1]);
        v2u Ureg[4];
#pragma unroll
        for (int mt = 0; mt < 4; ++mt) Ureg[mt] = GDN ? *(const v2u*)(bU + (size_t)(sl16 * 4 + mt) * 512 + lane * 8) : (v2u){0u, 0u};
        for (int c = 0; c < 128; ++c) {
            int lane = tid & 63; asm volatile("" : "+v"(lane));
            const int n = lane & 15, q = lane >> 4;
            const int cur = c & 1;
            LAS unsigned char* buf = lds + cur * SC_BUF;
            const LAS float* vec = (const LAS float*)(lds + SC_VEC + cur * 1024);
            const int cn = (c + 1 < 128) ? c + 1 : 127;
            f32x4 VN[4];
            bf16x8 fa[8], fb[8];
            bf16x8 VNf[2], VNSf[2];
#define SC3_LD8_K128(dst, OFF, mt_) do { _Pragma("unroll") for (int i_ = 0; i_ < 8; ++i_) dst[i_] = *(const LAS bf16x8*)(buf + (OFF) + (16 * ((mt_) + (i_ >> 2)) + n) * 256 + (((4 * (i_ & 3) + q) ^ n) * 16)); } while (0)
#define SC3_LD8_K64(dst, OFF, mb) do { _Pragma("unroll") for (int i_ = 0; i_ < 8; ++i_) dst[i_] = *(const LAS bf16x8*)(buf + (OFF) + (16 * ((mb) + (i_ >> 1)) + n) * 128 + (((4 * (i_ & 1) + q) ^ ((n >> 1) & 7)) * 16)); } while (0)
#define SC3_MM_K128(A0, A1, fr) do { _Pragma("unroll") for (int i_ = 0; i_ < 4; ++i_) { A0 = MFMA16(fr[i_], Sf[i_], A0); A1 = MFMA16(fr[4 + i_], Sf[i_], A1); } } while (0)
#define SC3_MM_K64(X, ma, fr, BF) do { _Pragma("unroll") for (int t_ = 0; t_ < 4; ++t_) { X[(ma) + t_] = MFMA16(fr[2 * t_], BF[0], X[(ma) + t_]); X[(ma) + t_] = MFMA16(fr[2 * t_ + 1], BF[1], X[(ma) + t_]); } } while (0)
#define SC3_DLOAD(m) (*(const LAS f32x4*)(vec + 128 + 16 * (m) + 4 * q))
#define SC3_EGLOAD(mt) (*(const LAS f32x4*)(vec + 16 * (mt) + 4 * q))
#define SC3_PACK_S(s4) do { Sf[s4] = pack_frag(S[2 * (s4)], S[2 * (s4) + 1]); } while (0)
#define SC3_OT_WRITE() do { LAS bf16_t* OT_ = (LAS bf16_t*)(lds + SC_OT + cur * SC_OTB); const int cc_ = 16 * sl16 + n; \
                _Pragma("unroll") for (int mt = 0; mt < 4; ++mt) { \
                    OT_[(16 * mt + 4 * q + 0) * 136 + cc_] = f2bf(O[mt].x); OT_[(16 * mt + 4 * q + 1) * 136 + cc_] = f2bf(O[mt].y); \
                    OT_[(16 * mt + 4 * q + 2) * 136 + cc_] = f2bf(O[mt].z); OT_[(16 * mt + 4 * q + 3) * 136 + cc_] = f2bf(O[mt].w); } } while (0)
            f32x4 dA, dB, dC, dD;
            f32x4 O[4];
            if (GDN) {
#pragma unroll
                for (int mt = 0; mt < 4; ++mt) { const v2u uu = Ureg[mt];
                    VN[mt] = (f32x4){__uint_as_float(uu.x << 16), __uint_as_float(uu.x & 0xffff0000u), __uint_as_float(uu.y << 16), __uint_as_float(uu.y & 0xffff0000u)}; }
                SC3_LD8_K128(fa, SC_WV, 0); SCHED_FENCE();
                SC3_LD8_K128(fb, SC_WV, 2); SCHED_FENCE();
#pragma unroll
                for (int mt = 0; mt < 4; ++mt) Ureg[mt] = *(const v2u*)(bU + (size_t)cn * 16384 + (size_t)(sl16 * 4 + mt) * 512 + lane * 8);
                f32x4 eS[4];
#pragma unroll
                for (int i = 0; i < 4; ++i) eS[i] = *(const LAS f32x4*)(vec + 64 + 16 * i + 4 * q);
                dA = SC3_DLOAD(0); dB = SC3_DLOAD(1); dC = SC3_DLOAD(2); dD = SC3_DLOAD(3);
                SCHED_FENCE();
                SC3_PACK_S(3); SC3_MM_K128(VN[0], VN[1], fa); S[0] = S[0] * dA; S[1] = S[1] * dB; S[2] = S[2] * dC; S[3] = S[3] * dD; SCHED_FENCE();
                SC3_LD8_K128(fa, SC_QG, 0); dA = SC3_DLOAD(4); dB = SC3_DLOAD(5); dC = SC3_DLOAD(6); dD = SC3_DLOAD(7); SCHED_FENCE();
                SC3_MM_K128(VN[2], VN[3], fb); S[4] = S[4] * dA; S[5] = S[5] * dB; S[6] = S[6] * dC; S[7] = S[7] * dD; SCHED_FENCE();
                SC3_LD8_K128(fb, SC_QG, 2); dA = SC3_EGLOAD(0); dB = SC3_EGLOAD(1); SCHED_FENCE();
#pragma unroll
                for (int mt = 0; mt < 4; ++mt) O[mt] = (f32x4){0.f, 0.f, 0.f, 0.f};
                SC3_MM_K128(O[0], O[1], fa);
#pragma unroll
                for (int s2 = 0; s2 < 2; ++s2) { VNf[s2] = pack_frag(VN[2 * s2], VN[2 * s2 + 1]); VNSf[s2] = pack_frag(VN[2 * s2] * eS[2 * s2], VN[2 * s2 + 1] * eS[2 * s2 + 1]); }
                SCHED_FENCE();
                SC3_LD8_K64(fa, SC_A, 0); dC = SC3_EGLOAD(2); dD = SC3_EGLOAD(3); SCHED_FENCE();
                SC3_MM_K128(O[2], O[3], fb); O[0] = O[0] * dA; O[1] = O[1] * dB; SCHED_FENCE();
                SC3_LD8_K64(fb, SC_KDT, 0); SCHED_FENCE();
                O[2] = O[2] * dC; O[3] = O[3] * dD;
            } else {
                SC3_LD8_K128(fa, SC_QG, 0); SCHED_FENCE();
                SC3_LD8_K128(fb, SC_QG, 2); SCHED_FENCE();
#pragma unroll
                for (int s2 = 0; s2 < 2; ++s2) { unsigned w[4];
#pragma unroll
                    for (int jj = 0; jj < 4; ++jj) { const int ja = 2 * jj, jb = 2 * jj + 1; const int cc = 16 * sl16 + n;
                        const int ta = 32 * s2 + ((ja < 4) ? 4 * q + ja : 16 + 4 * q + ja - 4), tb = 32 * s2 + ((jb < 4) ? 4 * q + jb : 16 + 4 * q + jb - 4);
                        const unsigned lo = *(const LAS bf16_t*)(buf + SC_WV + ta * 256 + (((cc >> 3) ^ (ta & 15)) * 16) + (cc & 7) * 2), hi = *(const LAS bf16_t*)(buf + SC_WV + tb * 256 + (((cc >> 3) ^ (tb & 15)) * 16) + (cc & 7) * 2);
                        w[jj] = lo | (hi << 16); }
                    v4u ww; ww.x = w[0]; ww.y = w[1]; ww.z = w[2]; ww.w = w[3];
                    VNf[s2] = __builtin_bit_cast(bf16x8, ww); VNSf[s2] = VNf[s2]; }
                dA = SC3_DLOAD(0); dB = SC3_DLOAD(1); dC = SC3_DLOAD(2); dD = SC3_DLOAD(3);
                SCHED_FENCE();
#pragma unroll
                for (int mt = 0; mt < 4; ++mt) O[mt] = (f32x4){0.f, 0.f, 0.f, 0.f};
                SC3_PACK_S(3); SC3_MM_K128(O[0], O[1], fa); S[0] = S[0] * dA; S[1] = S[1] * dB; S[2] = S[2] * dC; S[3] = S[3] * dD; SCHED_FENCE();
                SC3_LD8_K64(fa, SC_A, 0); dA = SC3_DLOAD(4); dB = SC3_DLOAD(5); dC = SC3_DLOAD(6); dD = SC3_DLOAD(7); SCHED_FENCE();
                SC3_MM_K128(O[2], O[3], fb); S[4] = S[4] * dA; S[5] = S[5] * dB; S[6] = S[6] * dC; S[7] = S[7] * dD; SCHED_FENCE();
                SC3_LD8_K64(fb, SC_KDT, 0); SCHED_FENCE();
            }
            SC3_MM_K64(O, 0, fa, VNf); SCHED_FENCE();
            SC3_LD8_K64(fa, SC_KDT, 4); SCHED_FENCE();
            SC3_MM_K64(S, 0, fb, VNSf); SC3_OT_WRITE(); SCHED_FENCE();
            SC3_MM_K64(S, 4, fa, VNSf); SC3_PACK_S(0); SC3_PACK_S(1); SCHED_FENCE();
            SC3_PACK_S(2);
            SCAN_BAR();
        }
    } else if (wave == CPW) {
        for (int c = 0; c < 128; ++c) {
            SCAN_BAR();
            int lane = tid & 63; asm volatile("" : "+v"(lane));
            const LAS bf16_t* OTn = (const LAS bf16_t*)(lds + SC_OT + (c & 1) * SC_OTB);
#pragma unroll
            for (int ps = 0; ps < 4; ++ps) { const int row = 16 * ps + (lane >> 2), pc = lane & 3, col = 32 * g + 8 * pc;
                    const v4u val = *(const LAS v4u*)(OTn + row * 136 + col);
                    *(v4u*)(mix + (size_t)(b * SEQ + c * 64 + row) * DM + mix_col + col) = val; }
        }
    } else if (hw >= 0) {
        v4u G0[15], G1[15];
#define HLP_LOAD(GX, cn_) do { const unsigned char* sQG = bQG + (size_t)(cn_) * 16384 + (size_t)hw * 4096; const unsigned char* sWV = bWV + (size_t)(cn_) * wv_chunk + (size_t)(16 * hw) * wv_row; \
            const unsigned char* sKDT = bKDT + (size_t)(cn_) * 16384 + (size_t)hw * 4096; const unsigned char* sA = bA + (size_t)(cn_) * 8192 + (size_t)hw * 2048; \
            const unsigned l16 = (unsigned)lane * 16u, offv = (unsigned)(lane >> 4) * (unsigned)wv_row + (unsigned)(lane & 15) * 16u; \
            _Pragma("unroll") for (int i = 0; i < 4; ++i) { GX[i] = *(const v4u*)(sQG + i * 1024 + l16); GX[4 + i] = *(const v4u*)(sWV + (size_t)(4 * i) * wv_row + offv); } \
            _Pragma("unroll") for (int i = 0; i < 4; ++i) GX[8 + i] = *(const v4u*)(sKDT + i * 1024 + l16); \
            _Pragma("unroll") for (int i = 0; i < 2; ++i) GX[12 + i] = *(const v4u*)(sA + i * 1024 + l16); \
            GX[14] = *(const v4u*)((const unsigned char*)(bvec + (size_t)(cn_) * 256) + l16); } while (0)
#define HLP_STORE(GX, bi_) do { LAS unsigned char* nb = lds + (bi_) * SC_BUF + hw * 4096; LAS unsigned char* nv = lds + SC_VEC + (bi_) * 1024; const int lq = lane >> 4; \
            _Pragma("unroll") for (int i = 0; i < 4; ++i) { const int d = lq * 256 + (((lane & 15) ^ (4 * i + lq)) * 16); \
                *(LAS v4u*)(nb + SC_QG + i * 1024 + d) = GX[i]; *(LAS v4u*)(nb + SC_WV + i * 1024 + d) = GX[4 + i]; } \
            _Pragma("unroll") for (int i = 0; i < 4; ++i) { const int d = (lane >> 3) * 128 + (((lane & 7) ^ (4 * (i & 1) + lq)) * 16); *(LAS v4u*)(nb + SC_KDT + i * 1024 + d) = GX[8 + i]; } \
            _Pragma("unroll") for (int i = 0; i < 2; ++i) { const int d = (lane >> 3) * 128 + (((lane & 7) ^ (4 * i + lq)) * 16); *(LAS v4u*)(nb - hw * 2048 + SC_A + i * 1024 + d) = GX[12 + i]; } \
            if (hw == 0) *(LAS v4u*)(nv + lane * 16) = GX[14]; } while (0)
#define HLP_ITER(c, GL, GW) do { \
            int lane = tid & 63; asm volatile("" : "+v"(lane)); \
            const int c2 = ((c) + 2 < 128) ? (c) + 2 : 127; \
            HLP_LOAD(GL, c2); \
            HLP_STORE(GW, ((c) + 1) & 1); \
            SCAN_BAR(); } while (0)
        { int lane = tid & 63; asm volatile("" : "+v"(lane)); HLP_LOAD(G1, 1); }
        for (int c = 0; c < 128; c += 2) { HLP_ITER(c, G0, G1); HLP_ITER(c + 1, G1, G0); }
    } else {
        for (int c = 0; c < 128; ++c) {
            if (c == CA - 3 && nfb > 0) {
                if ((tid & 63) == 0) { while (__hip_atomic_load(prog, __ATOMIC_RELAXED, __HIP_MEMORY_SCOPE_AGENT) < (unsigned)nfb) __builtin_amdgcn_s_sleep(8); }
                __builtin_amdgcn_fence(__ATOMIC_ACQUIRE, "agent");
                asm volatile("s_waitcnt vmcnt(0)" ::: "memory");
            }
            SCAN_BAR();
        }
    }
    __syncthreads();
}

__device__ __forceinline__ void mixnorm_row(bf16_t* mrow, const bf16_t* prow, const float (&gn)[2][8], int lane) {
    v4u o4[4], z4[4];
#pragma unroll
    for (int i = 0; i < 4; ++i) { const int c0 = 8 * (64 * i + lane);
        o4[i] = *(const v4u*)(mrow + c0); z4[i] = *(const v4u*)(prow + (i < 2 ? C_AG + c0 : C_BZ + c0 - 1024)); }
#pragma unroll
    for (int i = 0; i < 4; ++i) {
        float ss = 0.f;
#pragma unroll
        for (int w = 0; w < 4; ++w) { const unsigned a = (w == 0) ? o4[i].x : (w == 1) ? o4[i].y : (w == 2) ? o4[i].z : o4[i].w;
            const float lo = __uint_as_float(a << 16), hi = __uint_as_float(a & 0xffff0000u); ss += lo * lo + hi * hi; }
        ss += __shfl_xor(ss, 1); ss += __shfl_xor(ss, 2); ss += __shfl_xor(ss, 4); ss += __shfl_xor(ss, 8);
        const float rstd = rsqrtf(ss * (1.f / 128.f) + EPS);
        float yv[8];
#pragma unroll
        for (int w = 0; w < 4; ++w) { const unsigned a = (w == 0) ? o4[i].x : (w == 1) ? o4[i].y : (w == 2) ? o4[i].z : o4[i].w;
            const unsigned z = (w == 0) ? z4[i].x : (w == 1) ? z4[i].y : (w == 2) ? z4[i].z : z4[i].w;
            yv[2 * w] = __uint_as_float(a << 16) * rstd * gn[i >> 1][2 * w] * __uint_as_float(z << 16);
            yv[2 * w + 1] = __uint_as_float(a & 0xffff0000u) * rstd * gn[i >> 1][2 * w + 1] * __uint_as_float(z & 0xffff0000u); }
        v4u y4; y4.x = pk2(yv[0], yv[1]); y4.y = pk2(yv[2], yv[3]); y4.z = pk2(yv[4], yv[5]); y4.w = pk2(yv[6], yv[7]);
        *(v4u*)(mrow + 8 * (64 * i + lane)) = y4; }
}

struct EpiProj {
    static constexpr bool PERM = true, AFTER_DRAIN = false;
    bf16_t* O; int ldc;
    __device__ __forceinline__ void operator()(const pg8::f32x4 (&acc)[2][2][4][2], const pg8::Unit& u, int wr, int wc, int fr, int fq) const {
        const int row0 = u.pm * 256 + wr * 64 + fr, col0 = u.pn * 256 + wc * 32 + 8 * fq;
        const bool gate = (u.pn >= 12 && u.pn < 16) || (u.pn >= 24);
#pragma unroll
        for (int ai = 0; ai < 2; ++ai)
#pragma unroll
            for (int m = 0; m < 4; ++m) { bf16_t* rowp = O + (size_t)(row0 + ai * 128 + m * 16) * ldc + col0;
#pragma unroll
                for (int bj = 0; bj < 2; ++bj) { pg8::f32x4 v0 = acc[ai][bj][m][0], v1 = acc[ai][bj][m][1];
                    if (gate) {
#pragma unroll
                        for (int e = 0; e < 4; ++e) { v0[e] = v0[e] * __builtin_amdgcn_rcpf(1.f + __expf(-v0[e])); v1[e] = v1[e] * __builtin_amdgcn_rcpf(1.f + __expf(-v1[e])); } }
                    pg8::u32x4 w; w.x = pk2(v0[0], v0[1]); w.y = pk2(v0[2], v0[3]); w.z = pk2(v1[0], v1[1]); w.w = pk2(v1[2], v1[3]);
                    *(pg8::u32x4*)(rowp + bj * 128) = w; } }
    }
};
struct EpiResSS {
    static constexpr bool PERM = true, AFTER_DRAIN = false;
    const float* R; bf16_t* OB; unsigned long long* SS; int ldc;
    __device__ __forceinline__ void operator()(const pg8::f32x4 (&acc)[2][2][4][2], const pg8::Unit& u, int wr, int wc, int fr, int fq) const {
        const int row0 = u.pm * 256 + wr * 64 + fr, col0 = u.pn * 256 + wc * 32 + 8 * fq;
#pragma unroll
        for (int ai = 0; ai < 2; ++ai)
#pragma unroll
            for (int m = 0; m < 4; ++m) { const int row = row0 + ai * 128 + m * 16; const size_t off = (size_t)row * ldc + col0;
                float ssq = 0.f;
#pragma unroll
                for (int bj = 0; bj < 2; ++bj) { pg8::f32x4 v0 = acc[ai][bj][m][0], v1 = acc[ai][bj][m][1];
                    v0 = v0 + *(const pg8::f32x4*)(R + off + bj * 128); v1 = v1 + *(const pg8::f32x4*)(R + off + bj * 128 + 4);
                    pg8::u32x4 w; w.x = pk2(v0[0], v0[1]); w.y = pk2(v0[2], v0[3]); w.z = pk2(v1[0], v1[1]); w.w = pk2(v1[2], v1[3]);
                    *(pg8::u32x4*)(OB + off + bj * 128) = w;
                    ssq += (v0[0] * v0[0] + v0[1] * v0[1]) + (v0[2] * v0[2] + v0[3] * v0[3]) + (v1[0] * v1[0] + v1[1] * v1[1]) + (v1[2] * v1[2] + v1[3] * v1[3]); }
                ssq += __shfl_xor(ssq, 16); ssq += __shfl_xor(ssq, 32);
                if (fq == 0) atomicAdd(SS + row, (unsigned long long)(ssq * 4294967296.f + 0.5f)); }
    }
};
struct EpiRowScale {
    static constexpr bool PERM = true, AFTER_DRAIN = false;
    const unsigned long long* SS; _Float16* O; int ldc;
    __device__ __forceinline__ void operator()(const pg8::f32x4 (&acc)[2][2][4][2], const pg8::Unit& u, int wr, int wc, int fr, int fq) const {
        const int row0 = u.pm * 256 + wr * 64 + fr, col0 = u.pn * 256 + wc * 32 + 8 * fq;
#pragma unroll
        for (int ai = 0; ai < 2; ++ai)
#pragma unroll
            for (int m = 0; m < 4; ++m) { const int row = row0 + ai * 128 + m * 16; const size_t off = (size_t)row * ldc + col0;
                const float rstd = rsqrtf((float)SS[row] * (1.f / (4294967296.f * DM)) + EPS);
#pragma unroll
                for (int bj = 0; bj < 2; ++bj) { pg8::f32x4 a0 = acc[ai][bj][m][0] * rstd, a1 = acc[ai][bj][m][1] * rstd;
#pragma unroll
                    for (int e = 0; e < 4; ++e) { a0[e] = fminf(fmaxf(a0[e], -60000.f), 60000.f); a1[e] = fminf(fmaxf(a1[e], -60000.f), 60000.f); }
                    typedef _Float16 h8_t __attribute__((ext_vector_type(8))); typedef float f8_t __attribute__((ext_vector_type(8)));
                    const f8_t f8 = {a0[0], a0[1], a0[2], a0[3], a1[0], a1[1], a1[2], a1[3]};
                    *(h8_t*)(O + off + bj * 128) = __builtin_convertvector(f8, h8_t); } }
    }
};
struct EpiResF32 {
    static constexpr bool PERM = false, AFTER_DRAIN = false;
    const float* R; float* O; int ldc;
    __device__ __forceinline__ void operator()(const pg8::f32x4 (&acc)[2][2][4][2], const pg8::Unit& u, int wr, int wc, int fr, int fq) const {
        const int row0 = u.pm * 256 + wr * 64 + fr, col0 = u.pn * 256 + wc * 32 + 4 * fq;
#pragma unroll
        for (int ai = 0; ai < 2; ++ai)
#pragma unroll
            for (int m = 0; m < 4; ++m) { const size_t off = (size_t)(row0 + ai * 128 + m * 16) * ldc + col0;
#pragma unroll
                for (int bj = 0; bj < 2; ++bj)
#pragma unroll
                    for (int n = 0; n < 2; ++n) { pg8::f32x4 v = acc[ai][bj][m][n]; if (R) v = v + *(const pg8::f32x4*)(R + off + bj * 128 + n * 16); *(pg8::f32x4*)(O + off + bj * 128 + n * 16) = v; } }
    }
};

#define XB_TMO      128
#define XB_XCNT(j)  (256  + 64 * (j))
#define XB_XSUB(j)  (1280 + 64 * (j))
#define XB_XGEN(j)  (2304 + 64 * (j))
#define XB_TOP      3328
#define XB_TOPGEN   3392
#define XCD_BAR_WORDS 3456
#define XB_SPIN_CAP (1u << 18)

__device__ __forceinline__ unsigned xb_ld(unsigned* p)              { return __hip_atomic_load(p, __ATOMIC_RELAXED, __HIP_MEMORY_SCOPE_AGENT); }
__device__ __forceinline__ unsigned xb_add(unsigned* p, unsigned v) { return __hip_atomic_fetch_add(p, v, __ATOMIC_RELAXED, __HIP_MEMORY_SCOPE_AGENT); }
__device__ __forceinline__ unsigned xb_xcc_id() { return (unsigned)__builtin_amdgcn_s_getreg((3 << 11) | 20) & 0xFu; }
#define XB_SPIN(cond, bar) do { unsigned _sp = 0; while (cond) { __builtin_amdgcn_s_sleep(1); \
    if ((++_sp & 255u) == 0u) { if (xb_ld(&(bar)[XB_TMO])) break; if (_sp > XB_SPIN_CAP) { atomicAdd(&(bar)[XB_TMO], 1u); break; } } } } while (0)

struct XcdBarrier {
    unsigned* bar; unsigned x;
    volatile LAS unsigned* st;
};

__device__ __forceinline__ XcdBarrier xcd_barrier_post(unsigned* bar, volatile LAS unsigned* st) {
    XcdBarrier b; b.bar = bar; b.x = xb_xcc_id(); b.st = st;
    if (threadIdx.x == 0) (void)xb_add(&bar[XB_XCNT(b.x)], 1u);
    return b;
}
__device__ __forceinline__ void xcd_barrier_complete(unsigned* bar, unsigned x, unsigned& nloc, unsigned& nx) {
    const unsigned G = gridDim.x * gridDim.y * gridDim.z;
    unsigned sum, cnt, mine, sp = 0u;
    for (;;) {
        sum = 0u; cnt = 0u; mine = 0u;
#pragma unroll
        for (unsigned j = 0; j < 16; ++j) { const unsigned c = xb_ld(&bar[XB_XCNT(j)]); sum += c; cnt += (c > 0u) ? 1u : 0u; mine = (j == x) ? c : mine; }
        if (sum == G) break;
        __builtin_amdgcn_s_sleep(1);
        if ((++sp & 255u) == 0u) { if (xb_ld(&bar[XB_TMO])) break; if (sp > XB_SPIN_CAP) { atomicAdd(&bar[XB_TMO], 1u); break; } }
    }
    nloc = mine > 0u ? mine : 1u; nx = cnt > 0u ? cnt : 1u;
}

__device__ __forceinline__ void xcd_barrier(const XcdBarrier& b) {
    asm volatile("s_waitcnt vmcnt(0)" ::: "memory");
    __syncthreads();
    if (threadIdx.x == 0) {
        unsigned* bar = b.bar;
        __builtin_amdgcn_s_waitcnt(0);
        unsigned nloc = b.st[0], nx = b.st[1];
        if (nloc == 0u) { xcd_barrier_complete(bar, b.x, nloc, nx); b.st[0] = nloc; b.st[1] = nx; }
        const unsigned old = xb_add(&bar[XB_XSUB(b.x)], 1u);
        const unsigned gen = old / nloc;
        if (old + 1u == (gen + 1u) * nloc) {
            __builtin_amdgcn_fence(__ATOMIC_RELEASE, "agent");
            asm volatile("s_waitcnt vmcnt(0)" ::: "memory");
            const unsigned og = xb_add(&bar[XB_TOP], 1u);
            const unsigned tg = og / nx;
            if (og + 1u == (tg + 1u) * nx) xb_add(&bar[XB_TOPGEN], 1u);
            else XB_SPIN(xb_ld(&bar[XB_TOPGEN]) == tg, bar);
            __builtin_amdgcn_fence(__ATOMIC_ACQUIRE, "agent");
            xb_add(&bar[XB_XGEN(b.x)], 1u);
            asm volatile("s_waitcnt vmcnt(0)" ::: "memory");
        } else {
            XB_SPIN(xb_ld(&bar[XB_XGEN(b.x)]) == gen, bar);
            __builtin_amdgcn_fence(__ATOMIC_ACQUIRE, "agent");
            asm volatile("s_waitcnt vmcnt(0)" ::: "memory");
        }
    }
    __syncthreads();
}

__device__ __forceinline__ int get_lane() { int l = (int)__builtin_amdgcn_mbcnt_hi(~0u, __builtin_amdgcn_mbcnt_lo(~0u, 0u)); asm volatile("" : "+v"(l)); return l; }
__global__ void __launch_bounds__(NT, 2) mk_fwd(Args args) {
    extern __shared__ __attribute__((aligned(16))) unsigned char lds_raw[];
    LAS unsigned char* lds = (LAS unsigned char*)lds_raw;
    cg::grid_group grid = cg::this_grid();
    const int tid = threadIdx.x, wave = __builtin_amdgcn_readfirstlane(tid >> 6);

    const int G = gridDim.x, bx = blockIdx.x;
    const int vcu = (G % 8 == 0) ? (bx % 8) * (G / 8) + bx / 8 : bx;
    const int gw = vcu * NW + wave, NGW = G * NW;
    unsigned char* ws = args.ws;
    const float* x = args.in[0]; const float* attn_g = args.in[1]; const float* w_in = args.in[2];
    const float* w_out = args.in[9]; const float* ffn_g = args.in[10]; const float* w_query = args.in[11]; const float* sub_keys = args.in[12];
    bf16_t* WinT = (bf16_t*)(ws + OFF_D);
    bf16_t* WoutT = (bf16_t*)(ws + OFF_C);
    bf16_t* Wqk = (bf16_t*)(ws + OFF_C + 8 * MiB);
    bf16_t* xn = (bf16_t*)(ws + OFF_D + 28 * MiB);
    float* ba = (float*)(ws + OFF_S);
    bf16_t* proj = (bf16_t*)(ws + OFF_B);
    bf16_t* mix = (bf16_t*)args.out;
    unsigned char* pb = ws + OFF_D; float* vecs = (float*)(ws + OFF_S + 2 * MiB);
    float* hbuf = (float*)(ws + OFF_B);
    bf16_t* hn = (bf16_t*)(ws + OFF_D + 128 * MiB);
    unsigned long long* rowss = (unsigned long long*)(ws + 65536);
    _Float16* scores = (_Float16*)(ws + OFF_D);
    unsigned char* U8 = ws + OFF_TAB; unsigned char* V8 = ws + OFF_TAB + 16 * MiB;
    float* inv_su = (float*)(ws + OFF_S + 1 * MiB); float* inv_sv = inv_su + 16384;

    volatile LAS unsigned* xbst = (volatile LAS unsigned*)(lds + LDS_BYTES - 16);
    if (tid < 4) xbst[tid] = 0u;
    __syncthreads();
    XcdBarrier xbar = xcd_barrier_post((unsigned*)args.ws, xbst);
    const int lo = args.ph_lo, hi = args.ph_hi;
#define IN(k) (lo <= (k) && (k) < hi)
#define SYNC_AFTER(k) do { if (IN(k) && (k) + 1 < hi) { if ((k) == 0) grid.sync(); else xcd_barrier(xbar); } } while (0)
    {
        if (IN(0)) {
            const int lane = get_lane();
            LAS float* scr = (LAS float*)(lds + wave * 16384);
            constexpr int I_IN = (DM / 64) * (NPROJ / 32);
            for (int it = gw; it < I_IN; it += NGW) transpose_item(w_in, INW, DM, NPROJ, WinT, scr, it, lane);
            __syncthreads();
            {
                LAS float* wt = (LAS float*)lds;
#pragma unroll
                for (int k = 0; k < 4; ++k) { const int d = tid + 512 * k; const float* wr = w_in + (size_t)d * INW + NPROJ;
#pragma unroll
                    for (int q4 = 0; q4 < 4; ++q4) { const f32x4 w4 = *(const f32x4*)(wr + 4 * q4);
                        wt[(4 * q4 + 0) * 2048 + d] = w4.x; wt[(4 * q4 + 1) * 2048 + d] = w4.y; wt[(4 * q4 + 2) * 2048 + d] = w4.z; wt[(4 * q4 + 3) * 2048 + d] = w4.w; } }
            }
            __syncthreads();
            for (int m = gw; m < T; m += NGW) norm_row<true>(x + (size_t)m * DM, attn_g, (const LAS float*)lds, xn + (size_t)m * DM, ba + (size_t)m * 16, lane);
        }
        SYNC_AFTER(0);
        if (IN(1)) {
            pg8::Gemm g{xn, WinT, T, NPROJ, DM}; pg8::StaticOrder S; S.init(T, NPROJ, G, bx);
            EpiProj E{proj, NPROJ};
            pg8::gemm_phase<EpiProj, pg8::StaticOrder, true, true>(lds, g, S, E);
        }
        SYNC_AFTER(1);
        if (IN(2)) {
            const int CAe = (G > NSB) ? CA : 128;
            for (int it = bx; it < 16 * CAe; it += G) { int tt = threadIdx.x; asm volatile("" : "+v"(tt)); hgrn_prep_item((it / CAe) * 128 + (it % CAe), proj, args.in[3], pb, vecs, lds, tt); }
            for (int it = bx; it < 8 * CAe; it += G) { int tt = threadIdx.x; asm volatile("" : "+v"(tt)); gdn_prep_item((it / CAe) * 128 + (it % CAe), proj, ba, args.in[5], args.in[6], args.in[7], pb, vecs, lds, tt); }
        }
        SYNC_AFTER(2);
        if (IN(3)) {
            const int lane = get_lane();
            unsigned* ctl = (unsigned*)args.ws;
            if (bx < NSB) {
                const int sq = (bx & 7) + 8 * (bx >> 5), cgp = (bx >> 3) & 3;
                if (sq >= 16) scan_block<true>(sq, cgp, proj, pb, vecs, args.in[4], args.in[8], mix, ctl + PROG_WORD, G - NSB, lds, tid);
                else scan_block<false>(sq, cgp, proj, pb, vecs, args.in[4], args.in[8], mix, ctl + PROG_WORD, G - NSB, lds, tid);
            }
            else if (G > NSB) {
                int fb, FB;
                fb = bx - NSB; FB = G - NSB;
                {
                    constexpr int NBL = 128 - CA;
                    for (int it = fb; it < 16 * NBL; it += FB) { int tt = threadIdx.x; asm volatile("" : "+v"(tt)); hgrn_prep_item((it & 15) * 128 + CA + (it >> 4), proj, args.in[3], pb, vecs, lds, tt); }
                    for (int it = fb; it < 8 * NBL; it += FB) { int tt = threadIdx.x; asm volatile("" : "+v"(tt)); gdn_prep_item((it & 7) * 128 + CA + (it >> 3), proj, ba, args.in[5], args.in[6], args.in[7], pb, vecs, lds, tt); }
                    __syncthreads();
                    if (tid == 0) { __threadfence(); __hip_atomic_fetch_add(ctl + PROG_WORD, 1u, __ATOMIC_RELAXED, __HIP_MEMORY_SCOPE_AGENT); }
                    __syncthreads();
                }
                const int fw = fb * NW + wave, FW = FB * NW;
                for (int it = fb; it < 512; it += FB) wqk_item(w_query, sub_keys, ffn_g, Wqk, (LAS float*)lds, it, tid);
                LAS float* scr = (LAS float*)(lds + wave * 16384);
                constexpr int I_OUT = (DM / 64) * (DM / 32);
                for (int it = fw; it < I_OUT; it += FW) transpose_item(w_out, DM, DM, DM, WoutT, scr, it, lane);
                for (int e = 2 * fw; e < 32768; e += 2 * FW) { const bool isv = e >= 16384; const int r = e & 16383;
                    if (isv) table_row2(args.in[14] + (size_t)r * DM, (unsigned*)(V8 + (size_t)r * 1024), inv_sv + r, lane);
                    else table_row2_i4(args.in[13] + (size_t)r * DM, (unsigned*)(U8 + (size_t)r * 1024), inv_su + r, lane); }
            }
        }
        SYNC_AFTER(3);
        if (IN(4)) {
            {
                const int lane = get_lane();
                float gn[2][8];
#pragma unroll
                for (int mxr = 0; mxr < 2; ++mxr) { const float* gsrc = (mxr == 0 ? args.in[4] : args.in[8]) + 8 * (lane & 15);
                    const f32x4 ga = *(const f32x4*)gsrc, gb = *(const f32x4*)(gsrc + 4);
                    gn[mxr][0] = ga.x; gn[mxr][1] = ga.y; gn[mxr][2] = ga.z; gn[mxr][3] = ga.w; gn[mxr][4] = gb.x; gn[mxr][5] = gb.y; gn[mxr][6] = gb.z; gn[mxr][7] = gb.w; }
                for (int m = gw; m < T; m += NGW) mixnorm_row(mix + (size_t)m * DM, proj + (size_t)m * NPROJ, gn, lane);
                xcd_barrier(xbar);
            }
            pg8::Gemm g{mix, WoutT, T, DM, DM}; pg8::StaticOrder S; S.init(T, DM, G, bx);
            EpiResSS E{x, hn, rowss, DM};
            pg8::gemm_phase<EpiResSS, pg8::StaticOrder, true, true>(lds, g, S, E);
        }
        SYNC_AFTER(4);
        if (IN(6)) {
            pg8::Gemm g{hn, Wqk, T, DM, DM}; pg8::StaticOrder S; S.init(T, DM, G, bx);
            EpiRowScale E{rowss, scores, DM};
            pg8::gemm_phase<EpiRowScale, pg8::StaticOrder, true, true>(lds, g, S, E);
        }
        SYNC_AFTER(6);
        if (IN(7)) {
            const int lane = get_lane();
            LAS int* se = (LAS int*)(lds + wave * 4096); LAS float* sa = (LAS float*)(lds + wave * 4096 + 512); LAS float* sb = (LAS float*)(lds + wave * 4096 + 1024);
            for (int t = gw; t < T; t += NGW) { const int ln = get_lane(); peer_token(t, scores, hn, hbuf, U8, V8, inv_su, inv_sv, args.in[15], ffn_g, rowss, args.out, se, sa, sb, ln); }
        }
    }
}
}

extern "C" void kernel_launch(void* const* d_in, const int* in_sizes, int n_in, void* d_out, int out_size, void* d_ws, size_t ws_size, hipStream_t stream) {
    static int grid = 0;
    if (grid == 0) {
        int dev = 0, cus = 0, per_cu = 0;
        (void)hipGetDevice(&dev);
        (void)hipDeviceGetAttribute(&cus, hipDeviceAttributeMultiprocessorCount, dev);
        (void)hipFuncSetAttribute((const void*)mk::mk_fwd, hipFuncAttributeMaxDynamicSharedMemorySize, mk::LDS_BYTES);
        (void)hipOccupancyMaxActiveBlocksPerMultiprocessor(&per_cu, (const void*)mk::mk_fwd, mk::NT, mk::LDS_BYTES);
        if (per_cu < 1) { fprintf(stderr, "occupancy query says %d\n", per_cu); per_cu = 1; }
        grid = cus;
    }
    unsigned char* ws = (unsigned char*)d_ws;
    (void)hipMemsetAsync(d_ws, 0, 65536 + 131072, stream);
    mk::Args a{};
    for (int i = 0; i < 16; ++i) a.in[i] = (const float*)d_in[i];
    a.out = (float*)d_out; a.ws = ws;
    {
        a.ph_lo = 0; a.ph_hi = 8;
        void* kargs[] = {&a};
        hipError_t e = hipLaunchCooperativeKernel((const void*)mk::mk_fwd, dim3(grid), dim3(mk::NT), kargs, mk::LDS_BYTES, stream);
        if (e != hipSuccess) fprintf(stderr, "coop launch failed: %s\n", hipGetErrorString(e));
    }
}
```

```cpp
#include <hip/hip_runtime.h>
#include <hip/hip_cooperative_groups.h>
#include <cstdio>
namespace cg = cooperative_groups;
#include <stdint.h>

typedef unsigned short bf16_t;
typedef float f32x4 __attribute__((ext_vector_type(4)));

constexpr int T = 16384, SEQ = 8192, DM = 2048, INW = 7184, NPROJ = 7168;
constexpr float EPS = 1e-6f;
constexpr size_t MiB = 1u << 20;
constexpr size_t OFF_TAB = 1 * MiB;
constexpr size_t OFF_B = 65 * MiB;
constexpr size_t OFF_C = 289 * MiB;
constexpr size_t OFF_D = 305 * MiB;
constexpr size_t OFF_S = 500 * MiB;
constexpr int C_AQ = 0, C_AF = 1024, C_AI = 2048, C_AG = 3072, C_BQ = 4096, C_BK = 4608, C_BV = 5120, C_BZ = 6144;

__device__ __forceinline__ float bf2f(bf16_t v) { return __uint_as_float(((unsigned)v) << 16); }
typedef float f32x2_t __attribute__((ext_vector_type(2)));
typedef __bf16 bf16x2_t __attribute__((ext_vector_type(2)));
__device__ __forceinline__ unsigned cvt_pk2(float lo, float hi) { f32x2_t v = {lo, hi}; bf16x2_t b = __builtin_convertvector(v, bf16x2_t); return __builtin_bit_cast(unsigned, b); }
__device__ __forceinline__ bf16_t f2bf(float f) { return (bf16_t)(cvt_pk2(f, 0.f) & 0xffffu); }
__device__ __forceinline__ float sigmoidf_(float x) { return 1.f / (1.f + __expf(-x)); }
__device__ __forceinline__ float siluf_(float x) { return x / (1.f + __expf(-x)); }
__device__ __forceinline__ float wave_sum(float v) {
#pragma unroll
    for (int o = 1; o < 64; o <<= 1) v += __shfl_xor(v, o);
    return v;
}
__device__ __forceinline__ float block_sum(float v, float* sh) {
    v = wave_sum(v);
    const int w = threadIdx.x >> 6, nw = blockDim.x >> 6;
    __syncthreads();
    if ((threadIdx.x & 63) == 0) sh[w] = v;
    __syncthreads();
    float r = 0.f;
    for (int i = 0; i < nw; ++i) r += sh[i];
    return r;
}

__device__ __forceinline__ float gelu_erf(float x) {
    const float z = fabsf(x) * 0.70710678118654752f;
    const float tt = __builtin_amdgcn_rcpf(fmaf(0.3275911f, z, 1.f));
    float pl = fmaf(1.061405429f, tt, -1.453152027f); pl = fmaf(pl, tt, 1.421413741f); pl = fmaf(pl, tt, -0.284496736f); pl = fmaf(pl, tt, 0.254829592f); pl *= tt;
    const float er = 1.f - pl * __expf(-z * z);
    return 0.5f * x * (1.f + copysignf(er, x));
}
namespace pg8 {
#define PG8_LAS __attribute__((address_space(3)))
typedef unsigned short bf16_t;
typedef short bf16x8 __attribute__((ext_vector_type(8)));
typedef float f32x4 __attribute__((ext_vector_type(4)));
typedef unsigned u32x4 __attribute__((ext_vector_type(4)));
constexpr int BM = 256, BK = 64, HALF = 128, HTB = HALF * BK * 2  , STAGE_BYTES = 8 * HTB, NXCD = 8, WGM = 8;

__host__ __device__ __forceinline__ int lds_byte(int r, int c) { const int st = (r >> 4) * 2 + (c >> 5), rr = r & 15, cc = c & 31, ob = rr * 64 + cc * 2; return st * 1024 + (ob ^ (((ob >> 9) & 1) << 5)); }
__host__ __device__ __forceinline__ void stage_rc(int b, int& R, int& C) { const int st = b / 1024, sb = b % 1024, swz = sb ^ (((sb >> 9) & 1) << 5); R = (st >> 1) * 16 + swz / 64; C = (st & 1) * 32 + (swz % 64) / 2; }
__host__ __device__ __forceinline__ int perm32(int rho) { const int n = rho >> 4, i = rho & 15; return 8 * (i >> 2) + 4 * n + (i & 3); }

struct Unit { int pm, pn; };
struct Gemm { const bf16_t* A; const bf16_t* Bt; int M, N, K; };

struct StaticOrder {
    int nM, nN, nwg, G, c;
    __host__ __device__ void init(int M, int N, int G_, int c_) { nM = M / BM; nN = N / BM; nwg = nM * nN; G = G_; c = c_; }
    __host__ __device__ bool next(int i, Unit& u) const {
        const long L = (long)i * G + c; if (L >= nwg) return false;
        int wgid = (int)L; { const int q = nwg / NXCD, r = nwg % NXCD, xcd = wgid % NXCD, off = wgid / NXCD; wgid = (xcd < r ? xcd * (q + 1) : r * (q + 1) + (xcd - r) * q) + off; }
        const int nig = WGM * nN, gid = wgid / nig, fm = gid * WGM, gsz = (nM - fm) < WGM ? (nM - fm) : WGM;
        u.pm = fm + ((wgid % nig) % gsz); u.pn = (wgid % nig) / gsz; return true;
    }
    __device__ __forceinline__ void a_ready(const Unit&) const {}
    __device__ __forceinline__ void done(const Unit&) const {}
};

__device__ __forceinline__ unsigned cvt_pk_bf16(float lo, float hi) { unsigned r; asm volatile("v_cvt_pk_bf16_f32 %0, %1, %2" : "=v"(r) : "v"(lo), "v"(hi)); return r; }
typedef float f32x2 __attribute__((ext_vector_type(2)));
__device__ __forceinline__ f32x2 gelu_pk(f32x2 v) {
    const f32x2 av = __builtin_elementwise_abs(v), d = av * 0.2316418882f + 1.0f;
    f32x2 t; t.x = __builtin_amdgcn_rcpf(d.x); t.y = __builtin_amdgcn_rcpf(d.y);
    f32x2 q = t * 0.5307027145f + (-0.7265760135f); q = q * t + 0.7107068705f; q = q * t + (-0.142248368f); q = q * t + 0.127414796f; q = q * t;
    const f32x2 s = (v * v) * (-0.72134752044f);
    f32x2 e; e.x = __builtin_amdgcn_exp2f(s.x); e.y = __builtin_amdgcn_exp2f(s.y);
    const f32x2 m = v * (q * e), r = v - m;
    f32x2 o; o.x = v.x < 0.f ? m.x : r.x; o.y = v.y < 0.f ? m.y : r.y; return o;
}

template <int ACT  > struct EpiBf16 {
    static constexpr bool PERM = true, AFTER_DRAIN = false; static_assert(ACT == 0 || ACT == 1, "EpiBf16: ACT is 0 (none) or 1 (gelu_pk)");
    bf16_t* O; int ldc; const float* bias; int split_cols; size_t split_stride; float scale0;
    __device__ __forceinline__ void operator()(const f32x4 (&acc)[2][2][4][2], const Unit& u, int wr, int wc, int fr, int fq) const {
        const int row0 = u.pm * BM + wr * 64 + fr; int colt = u.pn * BM; bf16_t* base = O;
        float sc = 1.f; if (split_cols) { const int t = colt / split_cols; base += (size_t)t * split_stride; colt -= t * split_cols; if (t == 0) sc = scale0; }
        const int col0 = colt + wc * 32 + 8 * fq, bcol0 = u.pn * BM + wc * 32 + 8 * fq;
        f32x4 bv[2][2];
#pragma unroll
        for (int bj = 0; bj < 2; ++bj)
#pragma unroll
            for (int n = 0; n < 2; ++n) bv[bj][n] = bias ? *(const f32x4*)(bias + bcol0 + bj * HALF + 4 * n) : (f32x4){0.f, 0.f, 0.f, 0.f};
#pragma unroll
        for (int ai = 0; ai < 2; ++ai)
#pragma unroll
            for (int m = 0; m < 4; ++m) { bf16_t* rowp = base + (size_t)(row0 + ai * HALF + m * 16) * ldc + col0;
#pragma unroll
                for (int bj = 0; bj < 2; ++bj) { f32x4 v0 = acc[ai][bj][m][0] + bv[bj][0], v1 = acc[ai][bj][m][1] + bv[bj][1];
                    if (ACT == 1) { f32x2 a = gelu_pk((f32x2){v0[0], v0[1]}), b = gelu_pk((f32x2){v0[2], v0[3]}), c = gelu_pk((f32x2){v1[0], v1[1]}), d = gelu_pk((f32x2){v1[2], v1[3]});
                        v0 = (f32x4){a.x, a.y, b.x, b.y}; v1 = (f32x4){c.x, c.y, d.x, d.y}; }
                    v0 = v0 * sc; v1 = v1 * sc; u32x4 w; w.x = cvt_pk_bf16(v0[0], v0[1]); w.y = cvt_pk_bf16(v0[2], v0[3]); w.z = cvt_pk_bf16(v1[0], v1[1]); w.w = cvt_pk_bf16(v1[2], v1[3]);
                    *(u32x4*)(rowp + bj * HALF) = w; } }
    }
};
template <class Epi, class Sched, bool ALIGN_EPI = false, bool SP2 = false>
__device__ __forceinline__ void gemm_phase(PG8_LAS unsigned char* lds, const Gemm g, const Sched& S, const Epi& E) {
    const int tid = threadIdx.x, wid = __builtin_amdgcn_readfirstlane(tid >> 6), lane = tid & 63, wr = wid >> 2, wc = wid & 3, fr = lane & 15, fq = lane >> 4;
    const int K = g.K, nt = K / BK;
    unsigned voffA[2], voffB[2];
#pragma unroll
    for (int i = 0; i < 2; ++i) { int R, C; stage_rc(tid * 16 + i * 8192, R, C); const int Rb = Epi::PERM ? ((R & ~31) + perm32(R & 31)) : R;
        voffA[i] = (unsigned)(R * K + C) * 2u; voffB[i] = (unsigned)(Rb * K + C) * 2u; }
    const size_t kstep = (size_t)(BK * 2);
    const size_t hstep = (size_t)HALF * K * 2;
    const size_t tstep = 2 * hstep;
    const unsigned ldsw = (unsigned)wid * 1024u;
    const int aoff = lds_byte(wr * 64 + fr, fq * 8), boff = lds_byte(wc * 32 + fr, fq * 8);
#define PG8_SA(b, h) (((b) * 2 + (h)) * HTB)
#define PG8_SB(b, h) ((4 + (b) * 2 + (h)) * HTB)
#define PG8_STAGE(bufoff, gbase, voff) do { _Pragma("unroll") for (int _i = 0; _i < 2; ++_i) \
        __builtin_amdgcn_global_load_lds((const unsigned*)((const char*)(gbase) + (voff)[_i]), (PG8_LAS unsigned*)(lds + (bufoff) + ldsw + _i * 8192), 16, 0, 0); } while (0)
#define PG8_LDA(dst, b, h) do { _Pragma("unroll") for (int m = 0; m < 4; ++m) _Pragma("unroll") for (int k = 0; k < 2; ++k) dst[m][k] = *(const PG8_LAS bf16x8*)(lds + PG8_SA(b, h) + aoff + m * 2048 + k * 1024); } while (0)
#define PG8_LDB(dst, b, h) do { _Pragma("unroll") for (int n = 0; n < 2; ++n) _Pragma("unroll") for (int k = 0; k < 2; ++k) dst[n][k] = *(const PG8_LAS bf16x8*)(lds + PG8_SB(b, h) + boff + n * 2048 + k * 1024); } while (0)
#define PG8_MMA(ai, bj, At, Bt) do { __builtin_amdgcn_s_setprio(1); _Pragma("unroll") for (int m = 0; m < 4; ++m) _Pragma("unroll") for (int n = 0; n < 2; ++n) _Pragma("unroll") for (int k = 0; k < 2; ++k) \
        acc[ai][bj][m][n] = __builtin_amdgcn_mfma_f32_16x16x32_bf16(Bt[n][k], At[m][k], acc[ai][bj][m][n], 0, 0, 0); __builtin_amdgcn_s_setprio(0); } while (0)
#define PG8_WAIT_V(n) asm volatile("s_waitcnt vmcnt(" #n ")" ::: "memory")
#define PG8_WAIT_L(n) asm volatile("s_waitcnt lgkmcnt(" #n ")" ::: "memory")
#define PG8_BAR __builtin_amdgcn_s_barrier()
#define PG8_SCHED __builtin_amdgcn_sched_barrier(0)
    Unit cur, nxt; int ui = 0;
    if (!S.next(0, cur)) return;
    f32x4 acc[2][2][4][2];
#pragma unroll
    for (int a = 0; a < 2; ++a)
#pragma unroll
        for (int b = 0; b < 2; ++b)
#pragma unroll
            for (int m = 0; m < 4; ++m)
#pragma unroll
                for (int n = 0; n < 2; ++n) acc[a][b][m][n] = (f32x4){0.f, 0.f, 0.f, 0.f};
    bf16x8 At[4][2], B0[2][2], B1[2][2];
    const char* cA = (const char*)g.A + (size_t)cur.pm * tstep; const char* cB = (const char*)g.Bt + (size_t)cur.pn * tstep;
    S.a_ready(cur);
    if constexpr (SP2) {
        PG8_STAGE(PG8_SB(0, 0), cB, voffB); PG8_STAGE(PG8_SB(0, 1), cB + hstep, voffB); PG8_STAGE(PG8_SA(0, 0), cA, voffA); PG8_STAGE(PG8_SA(0, 1), cA + hstep, voffA);
        if (wr == 1) PG8_BAR;
        PG8_WAIT_V(2); PG8_BAR;
        PG8_STAGE(PG8_SB(1, 0), cB + kstep, voffB); PG8_STAGE(PG8_SA(1, 0), cA + kstep, voffA); PG8_STAGE(PG8_SB(1, 1), cB + hstep + kstep, voffB);
        PG8_WAIT_V(6); PG8_BAR;
    } else {
        PG8_STAGE(PG8_SB(0, 0), cB, voffB); PG8_STAGE(PG8_SA(0, 0), cA, voffA); PG8_STAGE(PG8_SB(0, 1), cB + hstep, voffB); PG8_STAGE(PG8_SA(0, 1), cA + hstep, voffA);
        if (wr == 1) PG8_BAR;
        PG8_WAIT_V(4); PG8_BAR;
        PG8_STAGE(PG8_SB(1, 0), cB + kstep, voffB); PG8_STAGE(PG8_SA(1, 0), cA + kstep, voffA); PG8_STAGE(PG8_SB(1, 1), cB + hstep + kstep, voffB);
        PG8_WAIT_V(6); PG8_BAR;
    }
    for (;;) {
        const bool has_next = S.next(ui + 1, nxt);
        const char* nA = has_next ? (const char*)g.A + (size_t)nxt.pm * tstep : cA; const char* nB = has_next ? (const char*)g.Bt + (size_t)nxt.pn * tstep : cB;
        for (int t = 0; t < nt; t += 2) {
            const bool last = (t == nt - 2);
            const char* a1 = cA + (size_t)(t + 1) * kstep;
            const char* a2 = last ? nA : cA + (size_t)(t + 2) * kstep; const char* b2 = last ? nB : cB + (size_t)(t + 2) * kstep;
            const char* a3 = a2 + kstep; const char* b3 = b2 + kstep;
            if (last && has_next) S.a_ready(nxt);
            if constexpr (SP2) {
            PG8_LDB(B0, 0, 0); PG8_LDB(B1, 0, 1); PG8_SCHED; PG8_LDA(At, 0, 0); PG8_STAGE(PG8_SA(1, 1), a1 + hstep, voffA);
            PG8_WAIT_V(8); PG8_WAIT_L(0); PG8_BAR; PG8_MMA(0, 0, At, B0); PG8_MMA(0, 1, At, B1); PG8_BAR; PG8_SCHED;
            PG8_LDA(At, 0, 1); PG8_STAGE(PG8_SB(0, 0), b2, voffB); PG8_STAGE(PG8_SB(0, 1), b2 + hstep, voffB); PG8_STAGE(PG8_SA(0, 0), a2, voffA);
            PG8_WAIT_V(8); PG8_WAIT_L(0); PG8_BAR; PG8_MMA(1, 0, At, B0); PG8_MMA(1, 1, At, B1); PG8_BAR; PG8_SCHED;
            PG8_LDB(B0, 1, 0); PG8_LDB(B1, 1, 1); PG8_SCHED; PG8_LDA(At, 1, 0); PG8_STAGE(PG8_SA(0, 1), a2 + hstep, voffA);
            PG8_WAIT_V(8); PG8_WAIT_L(0); PG8_BAR; PG8_MMA(0, 0, At, B0); PG8_MMA(0, 1, At, B1); PG8_BAR; PG8_SCHED;
            PG8_LDA(At, 1, 1); PG8_STAGE(PG8_SB(1, 0), b3, voffB); PG8_STAGE(PG8_SB(1, 1), b3 + hstep, voffB); PG8_STAGE(PG8_SA(1, 0), a3, voffA);
            PG8_WAIT_V(8); PG8_WAIT_L(0); PG8_BAR; PG8_MMA(1, 0, At, B0); PG8_MMA(1, 1, At, B1); PG8_BAR; PG8_SCHED;
            } else {
            PG8_LDB(B0, 0, 0); PG8_SCHED; PG8_LDA(At, 0, 0); PG8_STAGE(PG8_SA(1, 1), a1 + hstep, voffA);
            PG8_WAIT_L(8); PG8_BAR; PG8_WAIT_L(0); PG8_MMA(0, 0, At, B0); PG8_BAR; PG8_SCHED;
            PG8_LDB(B1, 0, 1); PG8_STAGE(PG8_SB(0, 0), b2, voffB);
            PG8_BAR; PG8_WAIT_L(0); PG8_MMA(0, 1, At, B1); PG8_BAR;
            PG8_LDA(At, 0, 1); PG8_STAGE(PG8_SA(0, 0), a2, voffA);
            PG8_BAR; PG8_WAIT_L(0); PG8_MMA(1, 0, At, B0); PG8_BAR; PG8_SCHED;
            PG8_STAGE(PG8_SB(0, 1), b2 + hstep, voffB);
            PG8_WAIT_V(6); PG8_BAR; PG8_MMA(1, 1, At, B1); PG8_BAR;
            PG8_LDB(B0, 1, 0); PG8_SCHED; PG8_LDA(At, 1, 0); PG8_STAGE(PG8_SA(0, 1), a2 + hstep, voffA);
            PG8_WAIT_L(8); PG8_BAR; PG8_WAIT_L(0); PG8_MMA(0, 0, At, B0); PG8_BAR; PG8_SCHED;
            PG8_LDB(B1, 1, 1); PG8_STAGE(PG8_SB(1, 0), b3, voffB);
            PG8_BAR; PG8_WAIT_L(0); PG8_MMA(0, 1, At, B1); PG8_BAR;
            PG8_LDA(At, 1, 1); PG8_STAGE(PG8_SA(1, 0), a3, voffA);
            PG8_BAR; PG8_WAIT_L(0); PG8_MMA(1, 0, At, B0); PG8_BAR; PG8_SCHED;
            PG8_STAGE(PG8_SB(1, 1), b3 + hstep, voffB);
            PG8_WAIT_V(6); PG8_BAR; PG8_MMA(1, 1, At, B1); PG8_BAR;
            }
        }
        if constexpr (ALIGN_EPI) { if (wr == 0) PG8_BAR; }
        if constexpr (!Epi::AFTER_DRAIN) { E(acc, cur, wr, wc, fr, fq); S.done(cur); }
        if (!has_next) break;
#pragma unroll
        for (int a = 0; a < 2; ++a)
#pragma unroll
            for (int b = 0; b < 2; ++b)
#pragma unroll
                for (int m = 0; m < 4; ++m)
#pragma unroll
                    for (int n = 0; n < 2; ++n) acc[a][b][m][n] = (f32x4){0.f, 0.f, 0.f, 0.f};
        cur = nxt; cA = nA; cB = nB; ++ui;
        if constexpr (ALIGN_EPI) { if (wr == 1) PG8_BAR; }
    }
    PG8_WAIT_V(0);
    if constexpr (!ALIGN_EPI) { if (wr == 0) PG8_BAR; }
    PG8_BAR;
    if constexpr (Epi::AFTER_DRAIN) { E.fused(acc, cur, wr, wc, fr, fq, lds, wid, lane); S.done(cur); }
#undef PG8_SA
#undef PG8_SB
#undef PG8_STAGE
#undef PG8_LDA
#undef PG8_LDB
#undef PG8_MMA
#undef PG8_WAIT_V
#undef PG8_WAIT_L
#undef PG8_BAR
#undef PG8_SCHED
}
}

namespace mk {
#define LAS __attribute__((address_space(3)))
#define GAS __attribute__((address_space(1)))
typedef unsigned v4u __attribute__((ext_vector_type(4)));
typedef unsigned v2u __attribute__((ext_vector_type(2)));
constexpr int NW = 8, NT = 512, LDS_BYTES = 163840, RING_BYTES = 131072;
#define LDS_WAIT() asm volatile("s_waitcnt lgkmcnt(0)" ::: "memory")
#define DPP_ROR_ADD(t, n) ((t) + __uint_as_float(__builtin_amdgcn_update_dpp(0u, __float_as_uint(t), 0x120 + (n), 0xf, 0xf, false)))
struct Args { const float* in[16]; float* out; unsigned char* ws; int ph_lo, ph_hi; };
__device__ __forceinline__ unsigned pk2(float lo, float hi) { return cvt_pk2(lo, hi); }

__device__ __forceinline__ void transpose_item(const float* W, int ld, int K, int ncols, bf16_t* WT, LAS float* scr, int item, int lane) {
    const int nblk = ncols / 32, kb = item / nblk, nb = item % nblk, k0 = 64 * kb, n0 = 32 * nb;
#pragma unroll 8
    for (int i = 0; i < 32; ++i) { const int kk = 2 * i + (lane >> 5); scr[kk * 33 + (lane & 31)] = W[(size_t)(k0 + kk) * ld + n0 + (lane & 31)]; }
    LDS_WAIT(); asm volatile("" ::: "memory");
    const int c = lane & 7;
#pragma unroll
    for (int j = 0; j < 4; ++j) { const int n = (lane >> 3) + 8 * j; const LAS float* s = scr + (8 * c) * 33 + n;
        v4u o; o.x = pk2(s[0 * 33], s[1 * 33]); o.y = pk2(s[2 * 33], s[3 * 33]); o.z = pk2(s[4 * 33], s[5 * 33]); o.w = pk2(s[6 * 33], s[7 * 33]);
        *(v4u*)(WT + (size_t)(n0 + n) * K + k0 + 8 * c) = o; }
    LDS_WAIT(); asm volatile("" ::: "memory");
}
template <bool WITH_BA>
__device__ __forceinline__ void norm_row(const float* xrow, const float* g, const LAS float* wt  , bf16_t* orow, float* barow, int lane) {
    f32x4 v[8]; float ss = 0.f;
#pragma unroll
    for (int j = 0; j < 8; ++j) { v[j] = ((const f32x4*)xrow)[64 * j + lane]; ss += (v[j].x * v[j].x + v[j].y * v[j].y) + (v[j].z * v[j].z + v[j].w * v[j].w); }
    ss = wave_sum(ss);
    const float rstd = rsqrtf(ss * (1.f / DM) + EPS);
    float acc[16];
#pragma unroll
    for (int c = 0; c < 16; ++c) acc[c] = 0.f;
#pragma unroll
    for (int j = 0; j < 8; ++j) {
        const f32x4 gg = ((const f32x4*)g)[64 * j + lane];
        const f32x4 y = v[j] * rstd * gg;
        v2u o; o.x = pk2(y.x, y.y); o.y = pk2(y.z, y.w);
        ((v2u*)orow)[64 * j + lane] = o;
        if (WITH_BA) {
#pragma unroll
            for (int c = 0; c < 16; ++c) { const f32x4 w4 = *(const LAS f32x4*)(wt + c * 2048 + 4 * (64 * j + lane));
                acc[c] += (y.x * w4.x + y.y * w4.y) + (y.z * w4.z + y.w * w4.w); }
            __builtin_amdgcn_sched_barrier(0);
        }
    }
    if (WITH_BA) {
        float q8[8], t4[4];
#pragma unroll
        for (int r = 0; r < 8; ++r) { auto sw = __builtin_amdgcn_permlane32_swap(__float_as_uint(acc[r]), __float_as_uint(acc[r + 8]), false, false); q8[r] = __uint_as_float(sw[0]) + __uint_as_float(sw[1]); }
#pragma unroll
        for (int r = 0; r < 4; ++r) { auto sw = __builtin_amdgcn_permlane16_swap(__float_as_uint(q8[r]), __float_as_uint(q8[r + 4]), false, false); t4[r] = __uint_as_float(sw[0]) + __uint_as_float(sw[1]); }
#pragma unroll
        for (int r = 0; r < 4; ++r) { float tv = t4[r]; tv = DPP_ROR_ADD(tv, 8); tv = DPP_ROR_ADD(tv, 4); tv = DPP_ROR_ADD(tv, 2); tv = DPP_ROR_ADD(tv, 1); t4[r] = tv; }
        if ((lane & 15) == 0) { const int gq = lane >> 4;
#pragma unroll
            for (int r = 0; r < 4; ++r) barow[r + 4 * gq] = t4[r]; }
    }
}
typedef short wq_bf16x8 __attribute__((ext_vector_type(8)));
__device__ __forceinline__ wq_bf16x8 wq_frag(const float* src) {
    const f32x4 p0 = *(const f32x4*)src, p1 = *(const f32x4*)(src + 4);
    v4u w; w.x = pk2(p0.x, p0.y); w.y = pk2(p0.z, p0.w); w.z = pk2(p1.x, p1.y); w.w = pk2(p1.z, p1.w);
    return __builtin_bit_cast(wq_bf16x8, w);
}
__device__ __forceinline__ void wqk_item(const float* Wq, const float* SK, const float* gk  , bf16_t* Wqk, LAS float* lds, int item, int tid) {
    const int cbk = item >> 5, d0 = (item & 31) * 64, cb = cbk * 128, h = cbk >> 1, half = cbk & 1;
    const float* skb = SK + ((size_t)(half * 8 + h) * 128) * 128;
    const int wave = tid >> 6, lane = tid & 63, n = lane & 15, kb = lane >> 4;
    wq_bf16x8 bfr[4];
#pragma unroll
    for (int ks = 0; ks < 4; ++ks) bfr[ks] = wq_frag(skb + (size_t)(16 * wave + n) * 128 + 32 * ks + 8 * kb);
#pragma unroll
    for (int dt = 0; dt < 4; ++dt) {
        f32x4 acc = {0.f, 0.f, 0.f, 0.f};
#pragma unroll
        for (int ks = 0; ks < 4; ++ks) { const wq_bf16x8 afr = wq_frag(Wq + (size_t)(d0 + 16 * dt + n) * DM + cb + 32 * ks + 8 * kb);
            acc = __builtin_amdgcn_mfma_f32_16x16x32_bf16(afr, bfr[ks], acc, 0, 0, 0); }
        const f32x4 g4 = *(const f32x4*)(gk + d0 + 16 * dt + 4 * kb);
        v2u o; o.x = pk2(acc.x * g4.x, acc.y * g4.y); o.y = pk2(acc.z * g4.z, acc.w * g4.w);
        *(v2u*)(Wqk + (size_t)(cb + 16 * wave + n) * DM + d0 + 16 * dt + 4 * kb) = o;
    }
}

typedef float f32x2 __attribute__((ext_vector_type(2)));
__device__ __forceinline__ int fp4_idx_of(float v) { return (v < 1.75f) ? (int)(v * 2.f + 0.25f) : (v < 2.5f ? 4 : (v < 3.5f ? 5 : (v < 5.f ? 6 : 7))); }
__device__ __forceinline__ void fp4_calibrate(int (&nib)[8]) {
    const unsigned T = 0x76543210u;
    const f32x2 a = __builtin_amdgcn_cvt_scalef32_pk_f32_fp4(T, 1.0f, 0), b = __builtin_amdgcn_cvt_scalef32_pk_f32_fp4(T, 1.0f, 1);
    const f32x2 c = __builtin_amdgcn_cvt_scalef32_pk_f32_fp4(T, 1.0f, 2), d = __builtin_amdgcn_cvt_scalef32_pk_f32_fp4(T, 1.0f, 3);
    nib[0] = fp4_idx_of(a.x); nib[1] = fp4_idx_of(a.y); nib[2] = fp4_idx_of(b.x); nib[3] = fp4_idx_of(b.y);
    nib[4] = fp4_idx_of(c.x); nib[5] = fp4_idx_of(c.y); nib[6] = fp4_idx_of(d.x); nib[7] = fp4_idx_of(d.y);
}
__device__ __forceinline__ void table_row_sw(const float* src, unsigned* dst, float* inv_scale, int lane) {
    int nib[8]; fp4_calibrate(nib);
    f32x4 v[8]; float mx = 0.f;
#pragma unroll
    for (int j = 0; j < 8; ++j) { v[j] = ((const f32x4*)src)[8 * lane + j];
        mx = fmaxf(mx, fmaxf(fmaxf(fabsf(v[j].x), fabsf(v[j].y)), fmaxf(fabsf(v[j].z), fabsf(v[j].w)))); }
#pragma unroll
    for (int o = 1; o < 64; o <<= 1) mx = fmaxf(mx, __shfl_xor(mx, o));
    const float sc = mx > 0.f ? mx * (0.85f / 6.f) : 1.f, isc = 1.f / sc;
    unsigned wd[4];
#pragma unroll
    for (int w = 0; w < 4; ++w) {
        unsigned acc = 0u;
#pragma unroll
        for (int e = 0; e < 8; ++e) {
            const f32x4 q = v[2 * w + (e >> 2)]; const float xe = ((e & 3) == 0) ? q.x : ((e & 3) == 1) ? q.y : ((e & 3) == 2) ? q.z : q.w;
            const float yv = fabsf(xe) * isc;
            unsigned code = (yv > 0.25f) + (yv > 0.75f) + (yv > 1.25f) + (yv > 1.75f) + (yv > 2.5f) + (yv > 3.5f) + (yv > 5.f);
            code |= (xe < 0.f) ? 8u : 0u;
            acc |= code << (4 * nib[e]);
        }
        wd[w] = acc;
    }
    v4u o; o.x = wd[0]; o.y = wd[1]; o.z = wd[2]; o.w = wd[3];
    ((v4u*)dst)[lane] = o;
    if (lane == 0) *inv_scale = sc;
}
__device__ __forceinline__ bool fp4_hw_encoder_ok() {
    unsigned t = 0u, u = 0u;
    t = __builtin_amdgcn_cvt_scalef32_pk_fp4_f32(t, 0.f, 0.5f, 1.0f, 0); t = __builtin_amdgcn_cvt_scalef32_pk_fp4_f32(t, 1.f, -1.5f, 1.0f, 1);
    t = __builtin_amdgcn_cvt_scalef32_pk_fp4_f32(t, 2.f, 3.f, 1.0f, 2); t = __builtin_amdgcn_cvt_scalef32_pk_fp4_f32(t, -4.f, 6.f, 1.0f, 3);
    u = __builtin_amdgcn_cvt_scalef32_pk_fp4_f32(u, 0.2f, 0.3f, 1.0f, 0); u = __builtin_amdgcn_cvt_scalef32_pk_fp4_f32(u, 2.4f, -2.6f, 1.0f, 1);
    u = __builtin_amdgcn_cvt_scalef32_pk_fp4_f32(u, 5.2f, -4.9f, 1.0f, 2); u = __builtin_amdgcn_cvt_scalef32_pk_fp4_f32(u, 1.3f, 0.8f, 1.0f, 3);
    const f32x2 a = __builtin_amdgcn_cvt_scalef32_pk_f32_fp4(t, 1.0f, 0), b = __builtin_amdgcn_cvt_scalef32_pk_f32_fp4(t, 1.0f, 1);
    const f32x2 c = __builtin_amdgcn_cvt_scalef32_pk_f32_fp4(t, 1.0f, 2), d = __builtin_amdgcn_cvt_scalef32_pk_f32_fp4(t, 1.0f, 3);
    const f32x2 e = __builtin_amdgcn_cvt_scalef32_pk_f32_fp4(u, 1.0f, 0), f = __builtin_amdgcn_cvt_scalef32_pk_f32_fp4(u, 1.0f, 1);
    const f32x2 g = __builtin_amdgcn_cvt_scalef32_pk_f32_fp4(u, 1.0f, 2), h = __builtin_amdgcn_cvt_scalef32_pk_f32_fp4(u, 1.0f, 3);
    return a.x == 0.f && a.y == 0.5f && b.x == 1.f && b.y == -1.5f && c.x == 2.f && c.y == 3.f && d.x == -4.f && d.y == 6.f
        && e.x == 0.f && e.y == 0.5f && f.x == 2.f && f.y == -3.f && g.x == 6.f && g.y == -4.f && h.x == 1.5f && h.y == 1.f;
}
__device__ __forceinline__ void table_row2_i4(const float* src, unsigned* dst, float* inv_scale, int lane) {
    f32x4 v[2][8]; float mx[2] = {0.f, 0.f};
#pragma unroll
    for (int r = 0; r < 2; ++r)
#pragma unroll
        for (int j = 0; j < 8; ++j) v[r][j] = __builtin_nontemporal_load(&((const f32x4*)(src + (size_t)r * DM))[64 * j + lane]);
#pragma unroll
    for (int r = 0; r < 2; ++r) {
#pragma unroll
        for (int j = 0; j < 8; ++j) mx[r] = fmaxf(mx[r], fmaxf(fmaxf(fabsf(v[r][j].x), fabsf(v[r][j].y)), fmaxf(fabsf(v[r][j].z), fabsf(v[r][j].w))));
#pragma unroll
        for (int o = 1; o < 64; o <<= 1) mx[r] = fmaxf(mx[r], __shfl_xor(mx[r], o));
        const float sc = mx[r] > 0.f ? mx[r] * 0.1f : 1.f, isc = 1.f / sc;
        unsigned short* drow = (unsigned short*)(dst + (size_t)r * 256);
#pragma unroll
        for (int j = 0; j < 8; ++j) { const f32x4 q4 = v[r][j];
            const int q0 = (int)fminf(fmaxf(rintf(q4.x * isc), -7.f), 7.f), q1 = (int)fminf(fmaxf(rintf(q4.y * isc), -7.f), 7.f);
            const int q2 = (int)fminf(fmaxf(rintf(q4.z * isc), -7.f), 7.f), q3 = (int)fminf(fmaxf(rintf(q4.w * isc), -7.f), 7.f);
            drow[64 * j + lane] = (unsigned short)((q0 & 15) | ((q1 & 15) << 4) | ((q2 & 15) << 8) | ((q3 & 15) << 12)); }
        if (lane == 0) inv_scale[r] = sc;
    }
}
__device__ __forceinline__ void table_row2(const float* src, unsigned* dst, float* inv_scale, int lane) {
    if (!fp4_hw_encoder_ok()) { table_row_sw(src, dst, inv_scale, lane); table_row_sw(src + DM, dst + 256, inv_scale + 1, lane); return; }
    f32x4 v[2][8]; float mx[2] = {0.f, 0.f};
#pragma unroll
    for (int r = 0; r < 2; ++r)
#pragma unroll
        for (int j = 0; j < 8; ++j) v[r][j] = __builtin_nontemporal_load(&((const f32x4*)(src + (size_t)r * DM))[64 * j + lane]);
#pragma unroll
    for (int r = 0; r < 2; ++r) {
#pragma unroll
        for (int j = 0; j < 8; ++j) mx[r] = fmaxf(mx[r], fmaxf(fmaxf(fabsf(v[r][j].x), fabsf(v[r][j].y)), fmaxf(fabsf(v[r][j].z), fabsf(v[r][j].w))));
#pragma unroll
        for (int o = 1; o < 64; o <<= 1) mx[r] = fmaxf(mx[r], __shfl_xor(mx[r], o));
        const float sc = mx[r] > 0.f ? mx[r] * (0.85f / 6.f) : 1.f, isc = 1.f / sc;
        unsigned short* drow = (unsigned short*)(dst + (size_t)r * 256);
#pragma unroll
        for (int j = 0; j < 8; ++j) { const f32x4 q4 = v[r][j];
            const float y0 = fminf(fmaxf(q4.x * isc, -6.f), 6.f), y1 = fminf(fmaxf(q4.y * isc, -6.f), 6.f), y2 = fminf(fmaxf(q4.z * isc, -6.f), 6.f), y3 = fminf(fmaxf(q4.w * isc, -6.f), 6.f);
            unsigned acc = __builtin_amdgcn_cvt_scalef32_pk_fp4_f32(0u, y0, y1, 1.0f, 0);
            acc = __builtin_amdgcn_cvt_scalef32_pk_fp4_f32(acc, y2, y3, 1.0f, 1);
            drow[64 * j + lane] = (unsigned short)(acc & 0xffffu); }
        if (lane == 0) inv_scale[r] = sc;
    }
}
#ifndef PEER_FAST_REDUCE
#define PEER_FAST_REDUCE 1
#endif
__device__ __forceinline__ float dpp_ror_add(float t, int) { return t; }
#define FP4_BYTE(d, j) __builtin_amdgcn_cvt_scalef32_pk_f32_fp4((d), 1.0f, (j))
__device__ __forceinline__ float dot_row(const v4u& a, const unsigned (&xh)[4], const unsigned (&xl)[4], float sh, float sl) {
    int hi = 0, lo = 0;
    hi = __builtin_amdgcn_sdot8((int)a.x, (int)xh[0], hi, false); lo = __builtin_amdgcn_sdot8((int)a.x, (int)xl[0], lo, false);
    hi = __builtin_amdgcn_sdot8((int)a.y, (int)xh[1], hi, false); lo = __builtin_amdgcn_sdot8((int)a.y, (int)xl[1], lo, false);
    hi = __builtin_amdgcn_sdot8((int)a.z, (int)xh[2], hi, false); lo = __builtin_amdgcn_sdot8((int)a.z, (int)xl[2], lo, false);
    hi = __builtin_amdgcn_sdot8((int)a.w, (int)xh[3], hi, false); lo = __builtin_amdgcn_sdot8((int)a.w, (int)xl[3], lo, false);
    return (float)hi * sh + (float)lo * sl;
}
__device__ __forceinline__ void axpy_row(const v4u& a, float wgt, float (&y)[32]) {
#pragma unroll
    for (int w = 0; w < 4; ++w) { const unsigned d = (w == 0) ? a.x : (w == 1) ? a.y : (w == 2) ? a.z : a.w;
        const f32x2 f0 = FP4_BYTE(d, 0), f1 = FP4_BYTE(d, 1), f2 = FP4_BYTE(d, 2), f3 = FP4_BYTE(d, 3);
        y[8 * w] += wgt * f0.x; y[8 * w + 1] += wgt * f0.y; y[8 * w + 2] += wgt * f1.x; y[8 * w + 3] += wgt * f1.y;
        y[8 * w + 4] += wgt * f2.x; y[8 * w + 5] += wgt * f2.y; y[8 * w + 6] += wgt * f3.x; y[8 * w + 7] += wgt * f3.y; }
}
#define DPP_ROR_MAX(t, n) fmaxf((t), __uint_as_float(__builtin_amdgcn_update_dpp(0u, __float_as_uint(t), 0x120 + (n), 0xf, 0xf, false)))
__device__ __forceinline__ int fkey(float f) { const int b_ = __float_as_int(f); return b_ ^ ((b_ >> 31) & 0x7fffffff); }
__device__ __forceinline__ float fval(int k_) { return __int_as_float(k_ ^ ((k_ >> 31) & 0x7fffffff)); }
#define DPP_ROR_MAXI(t, n) max((t), (int)__builtin_amdgcn_update_dpp(0u, (unsigned)(t), 0x120 + (n), 0xf, 0xf, false))
#define CSWAP(a, b) do { const int hi_ = max(a, b), lo_ = min(a, b); a = hi_; b = lo_; } while (0)
__device__ __forceinline__ void topk_token_fast(const _Float16* __restrict__ srow, int lane, const float* inv_su, const float* inv_sv,
                                                LAS int* se, LAS float* sa, LAS float* sb) {
    const int l16 = lane & 15, row = lane >> 4;
    float R[4];
    int k[4][8], res[4];
#pragma unroll
    for (int ps = 0; ps < 4; ++ps) {
        typedef _Float16 h8_t __attribute__((ext_vector_type(8)));
        const h8_t hv = *(const h8_t*)(srow + (4 * ps + row) * 128 + 8 * l16);
#pragma unroll
        for (int i = 0; i < 8; ++i) k[ps][i] = fkey(__uint_as_float((__float_as_uint((float)hv[i]) & 0xFFFFFF80u) | (unsigned)(8 * l16 + i)));
        CSWAP(k[ps][0], k[ps][1]); CSWAP(k[ps][2], k[ps][3]); CSWAP(k[ps][4], k[ps][5]); CSWAP(k[ps][6], k[ps][7]);
        CSWAP(k[ps][0], k[ps][2]); CSWAP(k[ps][1], k[ps][3]); CSWAP(k[ps][4], k[ps][6]); CSWAP(k[ps][5], k[ps][7]);
        CSWAP(k[ps][1], k[ps][2]); CSWAP(k[ps][5], k[ps][6]);
        CSWAP(k[ps][0], k[ps][4]); CSWAP(k[ps][1], k[ps][5]); CSWAP(k[ps][2], k[ps][6]); CSWAP(k[ps][3], k[ps][7]);
        CSWAP(k[ps][2], k[ps][4]); CSWAP(k[ps][3], k[ps][5]);
        CSWAP(k[ps][1], k[ps][2]); CSWAP(k[ps][3], k[ps][4]); CSWAP(k[ps][5], k[ps][6]);
        res[ps] = 0;
    }
#pragma unroll
    for (int it = 0; it < 16; ++it) {
        int m[4];
#pragma unroll
        for (int ps = 0; ps < 4; ++ps) m[ps] = k[ps][0];
#pragma unroll
        for (int ps = 0; ps < 4; ++ps) m[ps] = DPP_ROR_MAXI(m[ps], 8);
#pragma unroll
        for (int ps = 0; ps < 4; ++ps) m[ps] = DPP_ROR_MAXI(m[ps], 4);
#pragma unroll
        for (int ps = 0; ps < 4; ++ps) m[ps] = DPP_ROR_MAXI(m[ps], 2);
#pragma unroll
        for (int ps = 0; ps < 4; ++ps) m[ps] = DPP_ROR_MAXI(m[ps], 1);
#pragma unroll
        for (int ps = 0; ps < 4; ++ps) {
            const bool own = (k[ps][0] == m[ps]);
#pragma unroll
            for (int i = 0; i < 7; ++i) k[ps][i] = own ? k[ps][i + 1] : k[ps][i];
            k[ps][7] = own ? (int)0x80000000 : k[ps][7];
            res[ps] = (l16 == it) ? m[ps] : res[ps];
        }
    }
#pragma unroll
    for (int ps = 0; ps < 4; ++ps) R[ps] = fval(res[ps]);
    float X[2], Y[2], av[2], v2[2]; int j[2], best[2];
#pragma unroll
    for (int g = 0; g < 2; ++g) {
        const auto sw = __builtin_amdgcn_permlane16_swap(__float_as_uint(R[2 * g]), __float_as_uint(R[2 * g + 1]), false, false);
        X[g] = __uint_as_float(sw[0]); Y[g] = __uint_as_float(sw[1]);
        av[g] = __uint_as_float(__float_as_uint(X[g]) & 0xFFFFFF80u);
        j[g] = 0; best[g] = 0;
        v2[g] = __shfl(Y[g], (lane & 48));
    }
#pragma unroll
    for (int it = 0; it < 16; ++it) {
        int cand[2], m[2];
#pragma unroll
        for (int g = 0; g < 2; ++g) {
            const float sum = av[g] + __uint_as_float(__float_as_uint(v2[g]) & 0xFFFFFF80u);
            cand[g] = (j[g] < 16) ? fkey(__uint_as_float((__float_as_uint(sum) & 0xFFFFFF00u) | (unsigned)((l16 << 4) | (j[g] & 15)))) : (int)0x80000000;
            m[g] = cand[g];
        }
#pragma unroll
        for (int g = 0; g < 2; ++g) m[g] = DPP_ROR_MAXI(m[g], 8);
#pragma unroll
        for (int g = 0; g < 2; ++g) m[g] = DPP_ROR_MAXI(m[g], 4);
#pragma unroll
        for (int g = 0; g < 2; ++g) m[g] = DPP_ROR_MAXI(m[g], 2);
#pragma unroll
        for (int g = 0; g < 2; ++g) m[g] = DPP_ROR_MAXI(m[g], 1);
#pragma unroll
        for (int g = 0; g < 2; ++g) {
            best[g] = (l16 == it) ? m[g] : best[g];
            if (it < 15) { j[g] += (cand[g] == m[g]) ? 1 : 0; v2[g] = __shfl(Y[g], (lane & 48) + (j[g] & 15)); }
        }
    }
#pragma unroll
    for (int g = 0; g < 2; ++g) {
        const unsigned bb = __float_as_uint(fval(best[g]));
        const int bi = (bb >> 4) & 15, bj = bb & 15;
        const unsigned k1 = __float_as_uint(__shfl(X[g], (lane & 48) + bi)), k2 = __float_as_uint(__shfl(Y[g], (lane & 48) + bj));
        const int e = (int)(k1 & 127u) * 128 + (int)(k2 & 127u);
        const float bv = __uint_as_float(bb & 0xFFFFFF00u);
        float mx = bv; mx = DPP_ROR_MAX(mx, 8); mx = DPP_ROR_MAX(mx, 4); mx = DPP_ROR_MAX(mx, 2); mx = DPP_ROR_MAX(mx, 1);
        const float ex = __expf(bv - mx);
        float sm = ex; sm = DPP_ROR_ADD(sm, 8); sm = DPP_ROR_ADD(sm, 4); sm = DPP_ROR_ADD(sm, 2); sm = DPP_ROR_ADD(sm, 1);
        const float gate = ex * __builtin_amdgcn_rcpf(sm);
        const int head = 4 * g + ((row & 1) * 2 + (row >> 1));
        se[head * 16 + l16] = e; sa[head * 16 + l16] = inv_su[e]; sb[head * 16 + l16] = gate * inv_sv[e];
    }
}
#define PEER_LOAD(DST, TAB, b) do { _Pragma("unroll") for (int r_ = 0; r_ < 4; ++r_) { const unsigned char* rp_ = (TAB) + (size_t)(unsigned)__builtin_amdgcn_readfirstlane(se[4 * (b) + r_]) * 1024 + 16 * lane; \
        DST[r_] = *(const v4u*)rp_; } } while (0)
__device__ __forceinline__ void peer_token(int t, const _Float16* scores, const bf16_t* hn, const float* hbuf, const unsigned char* U8, const unsigned char* V8,
                                           const float* inv_su, const float* inv_sv, const float* gfin, const float* gffn, const unsigned long long* rowss, float* out,
                                           LAS int* se, LAS float* sa, LAS float* sb, int lane_in) {
    int lane = lane_in;
    {
        LAS int* se0 = se + 512; LAS float* sa0 = sa + 512; LAS float* sb0 = sb + 512;
        topk_token_fast(scores + (size_t)t * DM, lane, inv_su, inv_sv, se0, sa0, sb0);
        unsigned a0 = ((unsigned)se0[lane] << 7) | (unsigned)lane, a1 = ((unsigned)se0[lane + 64] << 7) | (unsigned)(lane + 64);
#pragma unroll
        for (int k = 2; k <= 128; k <<= 1) {
#pragma unroll
            for (int j = k >> 1; j > 0; j >>= 1) {
                if (j == 64) { const unsigned lo = a0 < a1 ? a0 : a1, hi = a0 < a1 ? a1 : a0; a0 = lo; a1 = hi; }
                else {
                    const unsigned p0 = (unsigned)__shfl_xor((int)a0, j), p1 = (unsigned)__shfl_xor((int)a1, j);
                    const bool lower = (lane & j) == 0;
                    const bool up0 = (lane & k) == 0, up1 = ((lane + 64) & k) == 0;
                    const unsigned mn0 = a0 < p0 ? a0 : p0, mx0 = a0 < p0 ? p0 : a0, mn1 = a1 < p1 ? a1 : p1, mx1 = a1 < p1 ? p1 : a1;
                    a0 = (up0 == lower) ? mn0 : mx0; a1 = (up1 == lower) ? mn1 : mx1;
                }
            }
        }
        const int k0 = a0 & 127, k1 = a1 & 127;
        se[lane] = (int)(a0 >> 7); sa[lane] = sa0[k0]; sb[lane] = sb0[k0];
        se[lane + 64] = (int)(a1 >> 7); sa[lane + 64] = sa0[k1]; sb[lane + 64] = sb0[k1];
    }
    asm volatile("" : "+v"(lane));
    float y[32];
    unsigned xh[4], xl[4]; float sh, sl;
    {
        float xf[32]; float mx = 0.f;
        const float rstd_t = rsqrtf((float)rowss[t] * (1.f / (4294967296.f * DM)) + EPS);
#pragma unroll
        for (int j = 0; j < 4; ++j) {
            const v4u h0 = *(const v4u*)(hn + (size_t)t * DM + 32 * lane + 8 * j);
            const f32x4 ga = *(const f32x4*)(gffn + 32 * lane + 8 * j), gb = *(const f32x4*)(gffn + 32 * lane + 8 * j + 4);
#pragma unroll
            for (int w = 0; w < 4; ++w) { const unsigned d0 = (w == 0) ? h0.x : (w == 1) ? h0.y : (w == 2) ? h0.z : h0.w;
                const float g0 = (w == 0) ? ga.x : (w == 1) ? ga.z : (w == 2) ? gb.x : gb.z, g1 = (w == 0) ? ga.y : (w == 1) ? ga.w : (w == 2) ? gb.y : gb.w;
                xf[8 * j + 2 * w] = __uint_as_float(d0 << 16) * (rstd_t * g0); xf[8 * j + 2 * w + 1] = __uint_as_float(d0 & 0xffff0000u) * (rstd_t * g1);
                mx = fmaxf(mx, fmaxf(fabsf(xf[8 * j + 2 * w]), fabsf(xf[8 * j + 2 * w + 1]))); }
        }
#pragma unroll
        for (int o = 1; o < 64; o <<= 1) mx = fmaxf(mx, __shfl_xor(mx, o));
        sh = mx > 0.f ? mx * (1.f / 7.f) : 1.f; sl = sh * (1.f / 14.f);
        const float ish = 1.f / sh, isl = 1.f / sl;
#pragma unroll
        for (int w = 0; w < 4; ++w) { unsigned ph = 0u, pl = 0u;
#pragma unroll
            for (int i = 0; i < 8; ++i) { const float xe = xf[8 * w + i];
                const float qh = fminf(fmaxf(rintf(xe * ish), -7.f), 7.f);
                const float ql = fminf(fmaxf(rintf((xe - qh * sh) * isl), -7.f), 7.f);
                ph |= ((unsigned)(int)qh & 15u) << (4 * i); pl |= ((unsigned)(int)ql & 15u) << (4 * i); }
            xh[w] = ph; xl[w] = pl; }
    }
#pragma unroll
    for (int i = 0; i < 32; ++i) y[i] = 0.f;
    v4u Ua[4], Ub[4], Va[4];
#define PEER_BATCH(b, UC, VC) do { \
        PEER_LOAD(VC, V8, (b)); \
        float pr[4]; \
        _Pragma("unroll") for (int r = 0; r < 4; ++r) pr[r] = dot_row(UC[r], xh, xl, sh, sl); \
        if ((b) + 2 < 32) PEER_LOAD(UC, U8, (b) + 2); \
        float wr_[4], q2[2]; \
        _Pragma("unroll") for (int r = 0; r < 2; ++r) { auto sw = __builtin_amdgcn_permlane32_swap(__float_as_uint(pr[r]), __float_as_uint(pr[r + 2]), false, false); q2[r] = __uint_as_float(sw[0]) + __uint_as_float(sw[1]); } \
        float tv; \
        { auto sw = __builtin_amdgcn_permlane16_swap(__float_as_uint(q2[0]), __float_as_uint(q2[1]), false, false); tv = __uint_as_float(sw[0]) + __uint_as_float(sw[1]); } \
        tv = DPP_ROR_ADD(tv, 8); tv = DPP_ROR_ADD(tv, 4); tv = DPP_ROR_ADD(tv, 2); tv = DPP_ROR_ADD(tv, 1); \
        const int k = 4 * (b) + (lane >> 4);     \
        const float wc = gelu_erf(tv * sa[k]) * sb[k]; \
        _Pragma("unroll") for (int r = 0; r < 4; ++r) wr_[r] = __uint_as_float(__builtin_amdgcn_readlane(__float_as_uint(wc), 16 * r)); \
        _Pragma("unroll") for (int r = 0; r < 4; ++r) axpy_row(VC[r], wr_[r], y); } while (0)
    PEER_LOAD(Ua, U8, 0); PEER_LOAD(Ub, U8, 1);
#pragma unroll 1
    for (int b = 0; b < 32; b += 2) { PEER_BATCH(b, Ua, Va); PEER_BATCH(b + 1, Ub, Va); }
    float ss = 0.f;
    int lres = lane; asm volatile("" : "+v"(lres));
#pragma unroll
    for (int j = 0; j < 4; ++j) { const v4u hv = *(const v4u*)(hn + (size_t)t * DM + 32 * lres + 8 * j);
#pragma unroll
        for (int w = 0; w < 4; ++w) { const unsigned d0 = (w == 0) ? hv.x : (w == 1) ? hv.y : (w == 2) ? hv.z : hv.w;
            y[8 * j + 2 * w] += __uint_as_float(d0 << 16); y[8 * j + 2 * w + 1] += __uint_as_float(d0 & 0xffff0000u);
            ss += y[8 * j + 2 * w] * y[8 * j + 2 * w] + y[8 * j + 2 * w + 1] * y[8 * j + 2 * w + 1]; } }
    ss = wave_sum(ss);
    const float rstd = rsqrtf(ss * (1.f / DM) + EPS);
#pragma unroll
    for (int j = 0; j < 8; ++j) { const f32x4 gg = *(const f32x4*)(gfin + 32 * lane + 4 * j);
        f32x4 o; o.x = y[4 * j] * rstd * gg.x; o.y = y[4 * j + 1] * rstd * gg.y; o.z = y[4 * j + 2] * rstd * gg.z; o.w = y[4 * j + 3] * rstd * gg.w;
        *(f32x4*)(out + (size_t)t * DM + 32 * lane + 4 * j) = o; }
}
typedef short bf16x8 __attribute__((ext_vector_type(8)));
__device__ __forceinline__ int pos32(int x) { const int g = x & ~31, l = x & 31; return g + 8 * ((l & 15) >> 2) + 4 * (l >> 4) + (l & 3); }
constexpr size_t PB_H_QG = 0, PB_H_KDT = 32 * MiB, PB_H_A = 64 * MiB;
constexpr size_t PB_G_QS = 80 * MiB, PB_G_KT = 96 * MiB;
constexpr size_t PB_G_W = 112 * MiB, PB_G_A = 144 * MiB, PB_G_U = 160 * MiB;
constexpr int CA = 96;
constexpr int PROG_WORD = 3584;
constexpr int NSB = 128, CPW = 4;
constexpr int SC_QG = 0, SC_WV = 16384, SC_KDT = 32768, SC_A = 49152, SC_BUF = 57344, SC_VEC = 2 * SC_BUF, SC_OT = SC_VEC + 2048, SC_OTB = 17408, SC_GAIN = SC_OT + 2 * SC_OTB;

__device__ __forceinline__ bf16x8 pack_frag(const f32x4& x0, const f32x4& x1) {
    v4u w; w.x = pk2(x0.x, x0.y); w.y = pk2(x0.z, x0.w); w.z = pk2(x1.x, x1.y); w.w = pk2(x1.z, x1.w);
    return __builtin_bit_cast(bf16x8, w);
}
#define MFMA16(a, b, c) __builtin_amdgcn_mfma_f32_16x16x32_bf16((a), (b), (c), 0, 0, 0)

__device__ __forceinline__ void hgrn_prep_item(int item, const bf16_t* proj, const float* lb_logits, unsigned char* pb, float* vecs, LAS unsigned char* lds, int tid) {
    const int c = item & 127, sq = item >> 7, b = sq >> 3, h = sq & 7, t0 = b * SEQ + c * 64;
    const int d = tid & 127, seg = tid >> 7, lane = tid & 63, wave = tid >> 6;
    LAS bf16_t* QGl = (LAS bf16_t*)lds; LAS bf16_t* KGl = (LAS bf16_t*)(lds + 17408); LAS float* segsum = (LAS float*)(lds + 34816);
    bf16_t* gQG = (bf16_t*)(pb + PB_H_QG) + (size_t)item * 8192;
    bf16_t* gKDT = (bf16_t*)(pb + PB_H_KDT) + (size_t)item * 8192;
    bf16_t* gA = (bf16_t*)(pb + PB_H_A) + (size_t)item * 4096;
    float* gvec = vecs + (size_t)item * 256;
    const float l0 = lb_logits[h * 128 + d], l1 = lb_logits[1024 + h * 128 + d];
    const float lb = 1.f / (1.f + __expf(l1 - l0));
    float lf[16], qv[16], kv[16];
#pragma unroll
    for (int i = 0; i < 16; ++i) {
        const bf16_t* pr = proj + (size_t)(t0 + 16 * seg + i) * NPROJ + h * 128 + d;
        const float z = bf2f(pr[C_AF]); qv[i] = bf2f(pr[C_AQ]);
        const float f = lb + (1.f - lb) * sigmoidf_(z);
        lf[i] = __logf(f); kv[i] = 1.f - f;
    }
    float run = 0.f;
#pragma unroll
    for (int i = 0; i < 16; ++i) { run += lf[i]; lf[i] = run; }
    segsum[seg * 128 + d] = run;
    __syncthreads();
    float off = 0.f, bl = 0.f;
#pragma unroll
    for (int s = 0; s < 4; ++s) { const float v = segsum[s * 128 + d]; bl += v; if (s < seg) off += v; }
    const int pd = pos32(d);
    float kd[16];
#pragma unroll
    for (int i = 0; i < 16; ++i) {
        const float bc = lf[i] + off; const int tl = 16 * seg + i;
        const float qg = qv[i] * __expf(bc), kg = kv[i] * __expf(-bc);
        kd[i] = kv[i] * __expf(bl - bc);
        const bf16_t qb = f2bf(qg);
        QGl[tl * 136 + d] = qb; KGl[tl * 136 + d] = f2bf(kg);
        gQG[tl * 128 + pd] = qb;
    }
#pragma unroll
    for (int ii = 0; ii < 4; ++ii) { v2u o; o.x = pk2(kd[4 * ii], kd[4 * ii + 1]); o.y = pk2(kd[4 * ii + 2], kd[4 * ii + 3]);
        *(v2u*)(gKDT + d * 64 + 32 * (seg >> 1) + 8 * ii + 4 * (seg & 1)) = o; }
    if (seg == 0) gvec[128 + d] = __expf(bl);
    __syncthreads();
    const int n = lane & 15, q = lane >> 4;
#pragma unroll
    for (int ti = 0; ti < 2; ++ti) {
        const int id = wave + 8 * ti, mt = id >> 2, ns = id & 3;
        f32x4 acc = {0.f, 0.f, 0.f, 0.f};
        if (ns <= mt) {
#pragma unroll
            for (int s4 = 0; s4 < 4; ++s4) {
                const bf16x8 a = *(const LAS bf16x8*)(QGl + (16 * mt + n) * 136 + 32 * s4 + 8 * q);
                const bf16x8 bb = *(const LAS bf16x8*)(KGl + (16 * ns + n) * 136 + 32 * s4 + 8 * q);
                acc = MFMA16(a, bb, acc);
            }
        }
        const int s = 16 * ns + n, ps = pos32(s);
#pragma unroll
        for (int r = 0; r < 4; ++r) { const int t = 16 * mt + 4 * q + r; const float v = (r == 0) ? acc.x : (r == 1) ? acc.y : (r == 2) ? acc.z : acc.w;
            gA[t * 64 + ps] = f2bf((s <= t) ? v : 0.f); }
    }
    __syncthreads();
}

constexpr int GP_QF = 0, GP_KF = 33024, GP_N = 0, GP_QB = 66048, GP_KB = 83456, GP_VB = 100864, GP_PART = 135680, GP_SB = 137728;
__device__ __forceinline__ void gdn_prep_item(int item, const bf16_t* proj, const float* ba, const float* conv_w, const float* A_log, const float* dt_bias,
                                              unsigned char* pb, float* vecs, LAS unsigned char* lds, int tid) {
    const int c = item & 127, bq = item >> 7, b = bq >> 2, qh = bq & 3, t0 = b * SEQ + c * 64;
    const int lane = tid & 63, wave = tid >> 6;
    LAS float* QF = (LAS float*)(lds + GP_QF); LAS float* KF = (LAS float*)(lds + GP_KF);
    LAS bf16_t* QB = (LAS bf16_t*)(lds + GP_QB); LAS bf16_t* KB = (LAS bf16_t*)(lds + GP_KB); LAS bf16_t* VB = (LAS bf16_t*)(lds + GP_VB);
    LAS float* PART = (LAS float*)(lds + GP_PART); LAS float* SBETA = (LAS float*)(lds + GP_SB); LAS float* SGC = SBETA + 128;
    LAS float* NM = (LAS float*)(lds + GP_N);
    {
        int col, wch; const int dd = tid & 127;
        if (tid < 128) { col = C_BQ + qh * 128 + dd; wch = qh * 128 + dd; }
        else if (tid < 256) { col = C_BK + qh * 128 + dd; wch = 512 + qh * 128 + dd; }
        else { const int vh = 2 * qh + ((tid - 256) >> 7); col = C_BV + vh * 128 + dd; wch = 1024 + vh * 128 + dd; }
        const float w0 = conv_w[wch], w1 = conv_w[2048 + wch], w2 = conv_w[4096 + wch], w3 = conv_w[6144 + wch];
        float h0 = 0.f, h1 = 0.f, h2 = 0.f;
        const bf16_t* pr = proj + (size_t)t0 * NPROJ + col;
        if (c > 0) { h0 = bf2f(pr[-3 * NPROJ]); h1 = bf2f(pr[-2 * NPROJ]); h2 = bf2f(pr[-1 * NPROJ]); }
        unsigned xr[64];
#pragma unroll
        for (int t = 0; t < 64; ++t) xr[t] = pr[(size_t)t * NPROJ];
#pragma unroll
        for (int t = 0; t < 64; ++t) {
            const float xx = __uint_as_float(xr[t] << 16);
            const float yv = siluf_(w0 * h0 + w1 * h1 + w2 * h2 + w3 * xx);
            h0 = h1; h1 = h2; h2 = xx;
            if (tid < 128) QF[t * 129 + dd] = yv;
            else if (tid < 256) KF[t * 129 + dd] = yv;
            else VB[((tid - 256) >> 7) * 8704 + t * 136 + dd] = f2bf(yv);
        }
    }
    __syncthreads();
    {
        const int t = tid & 63, part = tid >> 6, which = part >> 2, sub = part & 3;
        const LAS float* src = (which ? KF : QF) + t * 129 + 32 * sub;
        float s = 0.f;
#pragma unroll
        for (int i = 0; i < 32; ++i) s += src[i] * src[i];
        PART[(which * 4 + sub) * 64 + t] = s;
    }
    if (wave < 2) {
        const int vh = 2 * qh + wave;
        const float ax = ba[(size_t)(t0 + lane) * 16 + 8 + vh] + dt_bias[vh];
        const float sp = ax > 20.f ? ax : log1pf(__expf(ax));
        float gc = -__expf(A_log[vh]) * sp;
#pragma unroll
        for (int o = 1; o < 64; o <<= 1) { const float up = __shfl_up(gc, o); if (lane >= o) gc += up; }
        const float gl = __shfl(gc, 63);
        const float beta = sigmoidf_(ba[(size_t)(t0 + lane) * 16 + vh]);
        SBETA[wave * 64 + lane] = beta; SGC[wave * 64 + lane] = gc;
        float* gvec = vecs + ((size_t)(16 + b * 8 + vh) * 128 + c) * 256;
        gvec[lane] = __expf(gc); gvec[64 + lane] = __expf(gl - gc);
        const float dl = __expf(gl); gvec[128 + lane] = dl; gvec[192 + lane] = dl;
    }
    __syncthreads();
    {
        const int d = tid & 127, seg = tid >> 7, pd = pos32(d);
        bf16_t* gQS = (bf16_t*)(pb + PB_G_QS) + (size_t)item * 8192;
        bf16_t* gKT = (bf16_t*)(pb + PB_G_KT) + (size_t)item * 8192;
        float kk[16];
#pragma unroll
        for (int i = 0; i < 16; ++i) {
            const int tl = 16 * seg + i;
            const float sq = PART[0 * 64 + tl] + PART[1 * 64 + tl] + PART[2 * 64 + tl] + PART[3 * 64 + tl];
            const float sk = PART[4 * 64 + tl] + PART[5 * 64 + tl] + PART[6 * 64 + tl] + PART[7 * 64 + tl];
            const bf16_t qb = f2bf(QF[tl * 129 + d] * rsqrtf(sq + EPS) * 0.08838834764831845f);
            const bf16_t kb = f2bf(KF[tl * 129 + d] * rsqrtf(sk + EPS));
            QB[tl * 136 + d] = qb; KB[tl * 136 + d] = kb; gQS[tl * 128 + pd] = qb; kk[i] = bf2f(kb);
        }
#pragma unroll
        for (int ii = 0; ii < 4; ++ii) { v2u o; o.x = pk2(kk[4 * ii], kk[4 * ii + 1]); o.y = pk2(kk[4 * ii + 2], kk[4 * ii + 3]);
            *(v2u*)(gKT + d * 64 + 32 * (seg >> 1) + 8 * ii + 4 * (seg & 1)) = o; }
    }
    __syncthreads();
    {
        const int n = lane & 15, q = lane >> 4;
#pragma unroll
        for (int ti = 0; ti < 2; ++ti) {
            const int id = 2 * wave + ti, mt = id >> 2, ns = id & 3;
            f32x4 akk = {0.f, 0.f, 0.f, 0.f}, aqk = {0.f, 0.f, 0.f, 0.f};
            if (ns <= mt) {
#pragma unroll
                for (int s4 = 0; s4 < 4; ++s4) {
                    const bf16x8 kb_ = *(const LAS bf16x8*)(KB + (16 * ns + n) * 136 + 32 * s4 + 8 * q);
                    const bf16x8 ka_ = *(const LAS bf16x8*)(KB + (16 * mt + n) * 136 + 32 * s4 + 8 * q);
                    const bf16x8 qa_ = *(const LAS bf16x8*)(QB + (16 * mt + n) * 136 + 32 * s4 + 8 * q);
                    akk = MFMA16(ka_, kb_, akk); aqk = MFMA16(qa_, kb_, aqk);
                }
            }
            const int s = 16 * ns + n, ps = pos32(s);
#pragma unroll
            for (int vl = 0; vl < 2; ++vl) {
                bf16_t* gA = (bf16_t*)(pb + PB_G_A) + ((size_t)((b * 8 + 2 * qh + vl) * 128 + c)) * 4096;
                const float gcs = SGC[vl * 64 + s];
#pragma unroll
                for (int r = 0; r < 4; ++r) {
                    const int t = 16 * mt + 4 * q + r;
                    const float vk = (r == 0) ? akk.x : (r == 1) ? akk.y : (r == 2) ? akk.z : akk.w;
                    const float vq = (r == 0) ? aqk.x : (r == 1) ? aqk.y : (r == 2) ? aqk.z : aqk.w;
                    const float ex = (s <= t) ? __expf(SGC[vl * 64 + t] - gcs) : 0.f;
                    NM[vl * 4096 + t * 64 + s] = (s < t) ? SBETA[vl * 64 + t] * vk * ex : 0.f;
                    gA[t * 64 + ps] = f2bf((s <= t) ? vq * ex : 0.f);
                }
            }
        }
    }
    __syncthreads();
    {
        typedef float f32x2v __attribute__((ext_vector_type(2)));
        const int vl = (tid >> 7) & 1, colx = 2 * (tid & 127);
        const bool act = tid < 256;
        f32x2v x[64];
        if (act) {
            if (colx < 128) {
#pragma unroll
                for (int t = 0; t < 64; ++t) { const unsigned pr2 = *(const LAS unsigned*)(VB + vl * 8704 + t * 136 + colx); const float sb_ = SBETA[vl * 64 + t];
                    x[t] = (f32x2v){sb_ * __uint_as_float(pr2 << 16), sb_ * __uint_as_float(pr2 & 0xffff0000u)}; }
            } else {
#pragma unroll
                for (int t = 0; t < 64; ++t) { const unsigned pr2 = *(const LAS unsigned*)(KB + t * 136 + colx - 128); const float sb_ = SBETA[vl * 64 + t] * __expf(SGC[vl * 64 + t]);
                    x[t] = (f32x2v){sb_ * __uint_as_float(pr2 << 16), sb_ * __uint_as_float(pr2 & 0xffff0000u)}; }
            }
        }
        __syncthreads();
        if (act) {
            const LAS float* Nv = NM + vl * 4096;
#pragma unroll
            for (int t = 1; t < 64; ++t) {
                f32x2v acc = x[t];
#pragma unroll
                for (int s4 = 0; s4 < (t + 3) / 4; ++s4) {
                    const f32x4 nn = *(const LAS f32x4*)(Nv + t * 64 + 4 * s4);
                    acc = __builtin_elementwise_fma((f32x2v){-nn.x, -nn.x}, x[4 * s4], acc);
                    if (4 * s4 + 1 < t) acc = __builtin_elementwise_fma((f32x2v){-nn.y, -nn.y}, x[4 * s4 + 1], acc);
                    if (4 * s4 + 2 < t) acc = __builtin_elementwise_fma((f32x2v){-nn.z, -nn.z}, x[4 * s4 + 2], acc);
                    if (4 * s4 + 3 < t) acc = __builtin_elementwise_fma((f32x2v){-nn.w, -nn.w}, x[4 * s4 + 3], acc);
                }
                x[t] = acc;
            }
            if (colx < 128) {
                bf16_t* gU = (bf16_t*)(pb + PB_G_U) + ((size_t)((b * 8 + 2 * qh + vl) * 128 + c)) * 8192;
#pragma unroll
                for (int hc = 0; hc < 2; ++hc) { const int cx = colx + hc, sl = cx >> 4, n = cx & 15;
#pragma unroll
                    for (int mt = 0; mt < 4; ++mt)
#pragma unroll
                        for (int q = 0; q < 4; ++q) { v2u o; o.x = pk2(x[16 * mt + 4 * q][hc], x[16 * mt + 4 * q + 1][hc]); o.y = pk2(x[16 * mt + 4 * q + 2][hc], x[16 * mt + 4 * q + 3][hc]);
                            *(v2u*)(gU + ((size_t)((sl * 4 + mt) * 64 + q * 16 + n)) * 4) = o; } }
            } else {
                LAS bf16_t* WS = (LAS bf16_t*)(lds + GP_QB) + vl * 8704;
                const int pd0 = pos32(colx - 128), pd1 = pos32(colx + 1 - 128);
#pragma unroll
                for (int t = 0; t < 64; ++t) { WS[t * 136 + pd0] = f2bf(-x[t].x); WS[t * 136 + pd1] = f2bf(-x[t].y); }
            }
        }
    }
    __syncthreads();
    {
#pragma unroll
        for (int i = 0; i < 4; ++i) { const int p = tid + 512 * i, vl = p >> 10, row = (p >> 4) & 63, c16 = p & 15;
            bf16_t* gW = (bf16_t*)(pb + PB_G_W) + ((size_t)((b * 8 + 2 * qh + vl) * 128 + c)) * 8192;
            *(v4u*)(gW + row * 128 + c16 * 8) = *(const LAS v4u*)(lds + GP_QB + vl * 17408 + row * 272 + c16 * 16); }
    }
    __syncthreads();
}

struct ScanSrc { const unsigned char* qg; const unsigned char* wv; const unsigned char* kdt; const unsigned char* a; const float* vec; size_t wv_row; };
__device__ __forceinline__ void scan_dma(const ScanSrc& S, LAS unsigned char* buf, LAS unsigned char* vecb, int w, int lane) {
#pragma unroll
    for (int i = 0; i < 2; ++i) { const int pi = 2 * w + i, row = 4 * pi + (lane >> 4), cl = (lane & 15) ^ (row & 15);
        __builtin_amdgcn_global_load_lds((const unsigned*)(S.qg + row * 256 + cl * 16), (LAS unsigned*)(buf + SC_QG + pi * 1024), 16, 0, 0);
        __builtin_amdgcn_global_load_lds((const unsigned*)(S.wv + (size_t)row * S.wv_row + cl * 16), (LAS unsigned*)(buf + SC_WV + pi * 1024), 16, 0, 0); }
#pragma unroll
    for (int i = 0; i < 2; ++i) { const int pi = 2 * w + i, row = 8 * pi + (lane >> 3), cl = (lane & 7) ^ ((row >> 1) & 7);
        __builtin_amdgcn_global_load_lds((const unsigned*)(S.kdt + row * 128 + cl * 16), (LAS unsigned*)(buf + SC_KDT + pi * 1024), 16, 0, 0); }
    { const int pi = w, row = 8 * pi + (lane >> 3), cl = (lane & 7) ^ ((row >> 1) & 7);
        __builtin_amdgcn_global_load_lds((const unsigned*)(S.a + row * 128 + cl * 16), (LAS unsigned*)(buf + SC_A + pi * 1024), 16, 0, 0); }
    if (w == 0) __builtin_amdgcn_global_load_lds((const unsigned*)((const unsigned char*)S.vec + lane * 16), (LAS unsigned*)vecb, 16, 0, 0);
}
template <bool GDN>
__device__ __forceinline__ void scan_block(int sq, int g, const bf16_t* proj, const unsigned char* pb, const float* vecs, const float* hgrn_g, const float* gdn_g,
                                           bf16_t* mix, unsigned* prog, int nfb, LAS unsigned char* lds, int tid) {
    constexpr bool gdn = GDN;
    const int b = (sq & 15) >> 3, hh = sq & 7, lane = tid & 63, sl = __builtin_amdgcn_readfirstlane(tid >> 6), n = lane & 15, q = lane >> 4;
    const unsigned char* bQG; const unsigned char* bWV; const unsigned char* bKDT; const unsigned char* bA; const unsigned char* bU = nullptr;
    size_t wv_row, wv_chunk; int gate_col, mix_col; const float* gain;
    if (!gdn) {
        const size_t s0 = (size_t)(b * 8 + hh) * 128;
        bQG = pb + PB_H_QG + s0 * 16384; bKDT = pb + PB_H_KDT + s0 * 16384; bA = pb + PB_H_A + s0 * 8192;
        bWV = (const unsigned char*)(proj + (size_t)(b * SEQ) * NPROJ + C_AI + hh * 128); wv_row = (size_t)NPROJ * 2; wv_chunk = (size_t)64 * NPROJ * 2;
        gate_col = C_AG + hh * 128; mix_col = hh * 128; gain = hgrn_g;
    } else {
        const size_t s0 = (size_t)(b * 8 + hh) * 128, q0 = (size_t)(b * 4 + (hh >> 1)) * 128;
        bQG = pb + PB_G_QS + q0 * 16384; bKDT = pb + PB_G_KT + q0 * 16384; bA = pb + PB_G_A + s0 * 8192;
        bWV = pb + PB_G_W + s0 * 16384; wv_row = 256; wv_chunk = 16384; bU = pb + PB_G_U + s0 * 16384;
        gate_col = C_BZ + hh * 128; mix_col = 1024 + hh * 128; gain = gdn_g;
    }
    const float* bvec = vecs + (size_t)sq * 128 * 256;
    LAS float* gainl = (LAS float*)(lds + SC_GAIN);
    const int wave = sl;
    {
        ScanSrc src{bQG, bWV, bKDT, bA, bvec, wv_row};
        scan_dma(src, lds, lds + SC_VEC, wave, lane);
        if (tid < 128) gainl[tid] = gain[tid];
    }
    __builtin_amdgcn_s_waitcnt(0x0070);
    asm volatile("" ::: "memory");
    __builtin_amdgcn_s_barrier();
    asm volatile("" ::: "memory");
#define SCAN_BAR() do { asm volatile("s_waitcnt lgkmcnt(0)" ::: "memory"); __builtin_amdgcn_s_barrier(); asm volatile("" ::: "memory"); } while (0)
#define SCHED_FENCE() __builtin_amdgcn_sched_barrier(0)
    const int sl16 = 2 * g + wave;
    const int hw = (wave == 2) ? 0 : (wave == 3) ? 1 : (wave == 6) ? 2 : (wave == 7) ? 3 : -1;
    if (wave < 2) {
        f32x4 S[8];
        bf16x8 Sf[4];
#pragma unroll
        for (int m = 0; m < 8; ++m) S[m] = (f32x4){0.f, 0.f, 0.f, 0.f};
#pragma unroll
        for (int s4 = 0; s4 < 4; ++s4) Sf[s4] = pack_frag(S[0], S[1]);
        v2u Ureg[4];
#pragma unroll
        for (int mt = 0; mt < 4; ++mt) Ureg[mt] = GDN ? *(const v2u*)(bU + (size_t)(sl16 * 4 + mt) * 512 + lane * 8) : (v2u){0u, 0u};
        for (int c = 0; c < 128; ++c) {
            int lane = tid & 63; asm volatile("" : "+v"(lane));
            const int n = lane & 15, q = lane >> 4;
            const int cur = c & 1;
            LAS unsigned char* buf = lds + cur * SC_BUF;
            const LAS float* vec = (const LAS float*)(lds + SC_VEC + cur * 1024);
            const int cn = (c + 1 < 128) ? c + 1 : 127;
            f32x4 VN[4];
            bf16x8 fa[8], fb[8], fc[8];
            bf16x8 VNf[2], VNSf[2];
#define SC3_LD8_K128(dst, OFF, mt_) do { _Pragma("unroll") for (int i_ = 0; i_ < 8; ++i_) dst[i_] = *(const LAS bf16x8*)(buf + (OFF) + (16 * ((mt_) + (i_ >> 2)) + n) * 256 + (((4 * (i_ & 3) + q) ^ n) * 16)); } while (0)
#define SC3_LD8_K64(dst, OFF, mb) do { _Pragma("unroll") for (int i_ = 0; i_ < 8; ++i_) dst[i_] = *(const LAS bf16x8*)(buf + (OFF) + (16 * ((mb) + (i_ >> 1)) + n) * 128 + (((4 * (i_ & 1) + q) ^ ((n >> 1) & 7)) * 16)); } while (0)
#define SC3_MM_K128(A0, A1, fr) do { _Pragma("unroll") for (int i_ = 0; i_ < 4; ++i_) { A0 = MFMA16(fr[i_], Sf[i_], A0); A1 = MFMA16(fr[4 + i_], Sf[i_], A1); } } while (0)
#define SC3_MM_K64(X, ma, fr, BF) do { _Pragma("unroll") for (int t_ = 0; t_ < 4; ++t_) { X[(ma) + t_] = MFMA16(fr[2 * t_], BF[0], X[(ma) + t_]); X[(ma) + t_] = MFMA16(fr[2 * t_ + 1], BF[1], X[(ma) + t_]); } } while (0)
#define SC3_DLOAD(m) (*(const LAS f32x4*)(vec + 128 + 16 * (m) + 4 * q))
#define SC3_EGLOAD(mt) (*(const LAS f32x4*)(vec + 16 * (mt) + 4 * q))
#define SC3_PACK_S(s4) do { Sf[s4] = pack_frag(S[2 * (s4)], S[2 * (s4) + 1]); } while (0)
#define SC3_OT_WRITE() do { LAS bf16_t* OT_ = (LAS bf16_t*)(lds + SC_OT + cur * SC_OTB); const int cc_ = 16 * sl16 + n; \
                _Pragma("unroll") for (int mt = 0; mt < 4; ++mt) { \
                    OT_[(16 * mt + 4 * q + 0) * 136 + cc_] = f2bf(O[mt].x); OT_[(16 * mt + 4 * q + 1) * 136 + cc_] = f2bf(O[mt].y); \
                    OT_[(16 * mt + 4 * q + 2) * 136 + cc_] = f2bf(O[mt].z); OT_[(16 * mt + 4 * q + 3) * 136 + cc_] = f2bf(O[mt].w); } } while (0)
            f32x4 dA, dB, dC, dD;
            f32x4 O[4];
            if (GDN) {
#pragma unroll
                for (int mt = 0; mt < 4; ++mt) { const v2u uu = Ureg[mt];
                    VN[mt] = (f32x4){__uint_as_float(uu.x << 16), __uint_as_float(uu.x & 0xffff0000u), __uint_as_float(uu.y << 16), __uint_as_float(uu.y & 0xffff0000u)}; }
                SC3_LD8_K128(fa, SC_WV, 0); SCHED_FENCE();
                SC3_LD8_K128(fb, SC_WV, 2); SCHED_FENCE();
                SC3_LD8_K128(fc, SC_QG, 0); SCHED_FENCE();
#pragma unroll
                for (int mt = 0; mt < 4; ++mt) Ureg[mt] = *(const v2u*)(bU + (size_t)cn * 16384 + (size_t)(sl16 * 4 + mt) * 512 + lane * 8);
                f32x4 eS[4];
#pragma unroll
                for (int i = 0; i < 4; ++i) eS[i] = *(const LAS f32x4*)(vec + 64 + 16 * i + 4 * q);
                dA = SC3_DLOAD(0); dB = SC3_DLOAD(1); dC = SC3_DLOAD(2); dD = SC3_DLOAD(3);
                SCHED_FENCE();
                SC3_PACK_S(3); SC3_MM_K128(VN[0], VN[1], fa); S[0] = S[0] * dA; S[1] = S[1] * dB; S[2] = S[2] * dC; S[3] = S[3] * dD; SCHED_FENCE();
                SC3_LD8_K128(fa, SC_QG, 2); dA = SC3_DLOAD(4); dB = SC3_DLOAD(5); dC = SC3_DLOAD(6); dD = SC3_DLOAD(7); SCHED_FENCE();
                SC3_MM_K128(VN[2], VN[3], fb); S[4] = S[4] * dA; S[5] = S[5] * dB; S[6] = S[6] * dC; S[7] = S[7] * dD; SCHED_FENCE();
                SC3_LD8_K64(fb, SC_A, 0); dA = SC3_EGLOAD(0); dB = SC3_EGLOAD(1); SCHED_FENCE();
#pragma unroll
                for (int mt = 0; mt < 4; ++mt) O[mt] = (f32x4){0.f, 0.f, 0.f, 0.f};
                SC3_MM_K128(O[0], O[1], fc);
#pragma unroll
                for (int s2 = 0; s2 < 2; ++s2) { VNf[s2] = pack_frag(VN[2 * s2], VN[2 * s2 + 1]); VNSf[s2] = pack_frag(VN[2 * s2] * eS[2 * s2], VN[2 * s2 + 1] * eS[2 * s2 + 1]); }
                SCHED_FENCE();
                SC3_LD8_K64(fc, SC_KDT, 0); dC = SC3_EGLOAD(2); dD = SC3_EGLOAD(3); SCHED_FENCE();
                SC3_MM_K128(O[2], O[3], fa); O[0] = O[0] * dA; O[1] = O[1] * dB; SCHED_FENCE();
                SC3_LD8_K64(fa, SC_KDT, 4); SCHED_FENCE();
                O[2] = O[2] * dC; O[3] = O[3] * dD;
                SC3_MM_K64(O, 0, fb, VNf); SCHED_FENCE();
                SC3_MM_K64(S, 0, fc, VNSf); SC3_OT_WRITE(); SCHED_FENCE();
                SC3_MM_K64(S, 4, fa, VNSf); SC3_PACK_S(0); SC3_PACK_S(1); SCHED_FENCE();
            } else {
                SC3_LD8_K128(fa, SC_QG, 0); SCHED_FENCE();
                SC3_LD8_K128(fb, SC_QG, 2); SCHED_FENCE();
                SC3_LD8_K64(fc, SC_A, 0); SCHED_FENCE();
#pragma unroll
                for (int s2 = 0; s2 < 2; ++s2) { unsigned w[4];
#pragma unroll
                    for (int jj = 0; jj < 4; ++jj) { const int ja = 2 * jj, jb = 2 * jj + 1; const int cc = 16 * sl16 + n;
                        const int ta = 32 * s2 + ((ja < 4) ? 4 * q + ja : 16 + 4 * q + ja - 4), tb = 32 * s2 + ((jb < 4) ? 4 * q + jb : 16 + 4 * q + jb - 4);
                        const unsigned lo = *(const LAS bf16_t*)(buf + SC_WV + ta * 256 + (((cc >> 3) ^ (ta & 15)) * 16) + (cc & 7) * 2), hi = *(const LAS bf16_t*)(buf + SC_WV + tb * 256 + (((cc >> 3) ^ (tb & 15)) * 16) + (cc & 7) * 2);
                        w[jj] = lo | (hi << 16); }
                    v4u ww; ww.x = w[0]; ww.y = w[1]; ww.z = w[2]; ww.w = w[3];
                    VNf[s2] = __builtin_bit_cast(bf16x8, ww); VNSf[s2] = VNf[s2]; }
                dA = SC3_DLOAD(0); dB = SC3_DLOAD(1); dC = SC3_DLOAD(2); dD = SC3_DLOAD(3);
                SCHED_FENCE();
#pragma unroll
                for (int mt = 0; mt < 4; ++mt) O[mt] = (f32x4){0.f, 0.f, 0.f, 0.f};
                SC3_PACK_S(3); SC3_MM_K128(O[0], O[1], fa); S[0] = S[0] * dA; S[1] = S[1] * dB; S[2] = S[2] * dC; S[3] = S[3] * dD; SCHED_FENCE();
                SC3_LD8_K64(fa, SC_KDT, 0); dA = SC3_DLOAD(4); dB = SC3_DLOAD(5); dC = SC3_DLOAD(6); dD = SC3_DLOAD(7); SCHED_FENCE();
                SC3_MM_K128(O[2], O[3], fb); S[4] = S[4] * dA; S[5] = S[5] * dB; S[6] = S[6] * dC; S[7] = S[7] * dD; SCHED_FENCE();
                SC3_LD8_K64(fb, SC_KDT, 4); SCHED_FENCE();
                SC3_MM_K64(O, 0, fc, VNf); SCHED_FENCE();
                SC3_MM_K64(S, 0, fa, VNSf); SC3_OT_WRITE(); SCHED_FENCE();
                SC3_MM_K64(S, 4, fb, VNSf); SC3_PACK_S(0); SC3_PACK_S(1); SCHED_FENCE();
            }
            SC3_PACK_S(2);
            SCAN_BAR();
        }
    } else if (wave == CPW) {
        for (int c = 0; c < 128; ++c) {
            SCAN_BAR();
            int lane = tid & 63; asm volatile("" : "+v"(lane));
            const LAS bf16_t* OTn = (const LAS bf16_t*)(lds + SC_OT + (c & 1) * SC_OTB);
#pragma unroll
            for (int ps = 0; ps < 4; ++ps) { const int row = 16 * ps + (lane >> 2), pc = lane & 3, col = 32 * g + 8 * pc;
                    const v4u val = *(const LAS v4u*)(OTn + row * 136 + col);
                    *(v4u*)(mix + (size_t)(b * SEQ + c * 64 + row) * DM + mix_col + col) = val; }
        }
    } else if (hw >= 0) {
        v4u G0[15], G1[15];
#define HLP_LOAD(GX, cn_) do { const unsigned char* sQG = bQG + (size_t)(cn_) * 16384 + (size_t)hw * 4096; const unsigned char* sWV = bWV + (size_t)(cn_) * wv_chunk + (size_t)(16 * hw) * wv_row; \
            const unsigned char* sKDT = bKDT + (size_t)(cn_) * 16384 + (size_t)hw * 4096; const unsigned char* sA = bA + (size_t)(cn_) * 8192 + (size_t)hw * 2048; \
            const unsigned l16 = (unsigned)lane * 16u, offv = (unsigned)(lane >> 4) * (unsigned)wv_row + (unsigned)(lane & 15) * 16u; \
            _Pragma("unroll") for (int i = 0; i < 4; ++i) { GX[i] = *(const v4u*)(sQG + i * 1024 + l16); GX[4 + i] = *(const v4u*)(sWV + (size_t)(4 * i) * wv_row + offv); } \
            _Pragma("unroll") for (int i = 0; i < 4; ++i) GX[8 + i] = *(const v4u*)(sKDT + i * 1024 + l16); \
            _Pragma("unroll") for (int i = 0; i < 2; ++i) GX[12 + i] = *(const v4u*)(sA + i * 1024 + l16); \
            GX[14] = *(const v4u*)((const unsigned char*)(bvec + (size_t)(cn_) * 256) + l16); } while (0)
#define HLP_STORE(GX, bi_) do { LAS unsigned char* nb = lds + (bi_) * SC_BUF + hw * 4096; LAS unsigned char* nv = lds + SC_VEC + (bi_) * 1024; const int lq = lane >> 4; \
            _Pragma("unroll") for (int i = 0; i < 4; ++i) { const int d = lq * 256 + (((lane & 15) ^ (4 * i + lq)) * 16); \
                *(LAS v4u*)(nb + SC_QG + i * 1024 + d) = GX[i]; *(LAS v4u*)(nb + SC_WV + i * 1024 + d) = GX[4 + i]; } \
            _Pragma("unroll") for (int i = 0; i < 4; ++i) { const int d = (lane >> 3) * 128 + (((lane & 7) ^ (4 * (i & 1) + lq)) * 16); *(LAS v4u*)(nb + SC_KDT + i * 1024 + d) = GX[8 + i]; } \
            _Pragma("unroll") for (int i = 0; i < 2; ++i) { const int d = (lane >> 3) * 128 + (((lane & 7) ^ (4 * i + lq)) * 16); *(LAS v4u*)(nb - hw * 2048 + SC_A + i * 1024 + d) = GX[12 + i]; } \
            if (hw == 0) *(LAS v4u*)(nv + lane * 16) = GX[14]; } while (0)
#define HLP_ITER(c, GL, GW) do { \
            int lane = tid & 63; asm volatile("" : "+v"(lane)); \
            const int c2 = ((c) + 2 < 128) ? (c) + 2 : 127; \
            HLP_LOAD(GL, c2); \
            HLP_STORE(GW, ((c) + 1) & 1); \
            SCAN_BAR(); } while (0)
        { int lane = tid & 63; asm volatile("" : "+v"(lane)); HLP_LOAD(G1, 1); }
        for (int c = 0; c < 128; c += 2) { HLP_ITER(c, G0, G1); HLP_ITER(c + 1, G1, G0); }
    } else {
        for (int c = 0; c < 128; ++c) {
            if (c == CA - 3 && nfb > 0) {
                if ((tid & 63) == 0) { while (__hip_atomic_load(prog, __ATOMIC_RELAXED, __HIP_MEMORY_SCOPE_AGENT) < (unsigned)nfb) __builtin_amdgcn_s_sleep(8); }
                __builtin_amdgcn_fence(__ATOMIC_ACQUIRE, "agent");
                asm volatile("s_waitcnt vmcnt(0)" ::: "memory");
            }
            SCAN_BAR();
        }
    }
    __syncthreads();
}

__device__ __forceinline__ void mixnorm_row(bf16_t* mrow, const bf16_t* prow, const float (&gn)[2][8], int lane) {
    v4u o4[4], z4[4];
#pragma unroll
    for (int i = 0; i < 4; ++i) { const int c0 = 8 * (64 * i + lane);
        o4[i] = *(const v4u*)(mrow + c0); z4[i] = *(const v4u*)(prow + (i < 2 ? C_AG + c0 : C_BZ + c0 - 1024)); }
#pragma unroll
    for (int i = 0; i < 4; ++i) {
        float ss = 0.f;
#pragma unroll
        for (int w = 0; w < 4; ++w) { const unsigned a = (w == 0) ? o4[i].x : (w == 1) ? o4[i].y : (w == 2) ? o4[i].z : o4[i].w;
            const float lo = __uint_as_float(a << 16), hi = __uint_as_float(a & 0xffff0000u); ss += lo * lo + hi * hi; }
        ss += __shfl_xor(ss, 1); ss += __shfl_xor(ss, 2); ss += __shfl_xor(ss, 4); ss += __shfl_xor(ss, 8);
        const float rstd = rsqrtf(ss * (1.f / 128.f) + EPS);
        float yv[8];
#pragma unroll
        for (int w = 0; w < 4; ++w) { const unsigned a = (w == 0) ? o4[i].x : (w == 1) ? o4[i].y : (w == 2) ? o4[i].z : o4[i].w;
            const unsigned z = (w == 0) ? z4[i].x : (w == 1) ? z4[i].y : (w == 2) ? z4[i].z : z4[i].w;
            yv[2 * w] = __uint_as_float(a << 16) * rstd * gn[i >> 1][2 * w] * __uint_as_float(z << 16);
            yv[2 * w + 1] = __uint_as_float(a & 0xffff0000u) * rstd * gn[i >> 1][2 * w + 1] * __uint_as_float(z & 0xffff0000u); }
        v4u y4; y4.x = pk2(yv[0], yv[1]); y4.y = pk2(yv[2], yv[3]); y4.z = pk2(yv[4], yv[5]); y4.w = pk2(yv[6], yv[7]);
        *(v4u*)(mrow + 8 * (64 * i + lane)) = y4; }
}

struct EpiProj {
    static constexpr bool PERM = true, AFTER_DRAIN = false;
    bf16_t* O; int ldc;
    __device__ __forceinline__ void operator()(const pg8::f32x4 (&acc)[2][2][4][2], const pg8::Unit& u, int wr, int wc, int fr, int fq) const {
        const int row0 = u.pm * 256 + wr * 64 + fr, col0 = u.pn * 256 + wc * 32 + 8 * fq;
        const bool gate = (u.pn >= 12 && u.pn < 16) || (u.pn >= 24);
#pragma unroll
        for (int ai = 0; ai < 2; ++ai)
#pragma unroll
            for (int m = 0; m < 4; ++m) { bf16_t* rowp = O + (size_t)(row0 + ai * 128 + m * 16) * ldc + col0;
#pragma unroll
                for (int bj = 0; bj < 2; ++bj) { pg8::f32x4 v0 = acc[ai][bj][m][0], v1 = acc[ai][bj][m][1];
                    if (gate) {
#pragma unroll
                        for (int e = 0; e < 4; ++e) { v0[e] = v0[e] * __builtin_amdgcn_rcpf(1.f + __expf(-v0[e])); v1[e] = v1[e] * __builtin_amdgcn_rcpf(1.f + __expf(-v1[e])); } }
                    pg8::u32x4 w; w.x = pk2(v0[0], v0[1]); w.y = pk2(v0[2], v0[3]); w.z = pk2(v1[0], v1[1]); w.w = pk2(v1[2], v1[3]);
                    *(pg8::u32x4*)(rowp + bj * 128) = w; } }
    }
};
struct EpiResSS {
    static constexpr bool PERM = true, AFTER_DRAIN = false;
    const float* R; bf16_t* OB; unsigned long long* SS; int ldc;
    __device__ __forceinline__ void operator()(const pg8::f32x4 (&acc)[2][2][4][2], const pg8::Unit& u, int wr, int wc, int fr, int fq) const {
        const int row0 = u.pm * 256 + wr * 64 + fr, col0 = u.pn * 256 + wc * 32 + 8 * fq;
#pragma unroll
        for (int ai = 0; ai < 2; ++ai)
#pragma unroll
            for (int m = 0; m < 4; ++m) { const int row = row0 + ai * 128 + m * 16; const size_t off = (size_t)row * ldc + col0;
                float ssq = 0.f;
#pragma unroll
                for (int bj = 0; bj < 2; ++bj) { pg8::f32x4 v0 = acc[ai][bj][m][0], v1 = acc[ai][bj][m][1];
                    v0 = v0 + *(const pg8::f32x4*)(R + off + bj * 128); v1 = v1 + *(const pg8::f32x4*)(R + off + bj * 128 + 4);
                    pg8::u32x4 w; w.x = pk2(v0[0], v0[1]); w.y = pk2(v0[2], v0[3]); w.z = pk2(v1[0], v1[1]); w.w = pk2(v1[2], v1[3]);
                    *(pg8::u32x4*)(OB + off + bj * 128) = w;
                    ssq += (v0[0] * v0[0] + v0[1] * v0[1]) + (v0[2] * v0[2] + v0[3] * v0[3]) + (v1[0] * v1[0] + v1[1] * v1[1]) + (v1[2] * v1[2] + v1[3] * v1[3]); }
                ssq += __shfl_xor(ssq, 16); ssq += __shfl_xor(ssq, 32);
                if (fq == 0) atomicAdd(SS + row, (unsigned long long)(ssq * 4294967296.f + 0.5f)); }
    }
};
struct EpiRowScale {
    static constexpr bool PERM = true, AFTER_DRAIN = false;
    const unsigned long long* SS; _Float16* O; int ldc;
    __device__ __forceinline__ void operator()(const pg8::f32x4 (&acc)[2][2][4][2], const pg8::Unit& u, int wr, int wc, int fr, int fq) const {
        const int row0 = u.pm * 256 + wr * 64 + fr, col0 = u.pn * 256 + wc * 32 + 8 * fq;
#pragma unroll
        for (int ai = 0; ai < 2; ++ai)
#pragma unroll
            for (int m = 0; m < 4; ++m) { const int row = row0 + ai * 128 + m * 16; const size_t off = (size_t)row * ldc + col0;
                const float rstd = rsqrtf((float)SS[row] * (1.f / (4294967296.f * DM)) + EPS);
#pragma unroll
                for (int bj = 0; bj < 2; ++bj) { pg8::f32x4 a0 = acc[ai][bj][m][0] * rstd, a1 = acc[ai][bj][m][1] * rstd;
#pragma unroll
                    for (int e = 0; e < 4; ++e) { a0[e] = fminf(fmaxf(a0[e], -60000.f), 60000.f); a1[e] = fminf(fmaxf(a1[e], -60000.f), 60000.f); }
                    typedef _Float16 h8_t __attribute__((ext_vector_type(8))); typedef float f8_t __attribute__((ext_vector_type(8)));
                    const f8_t f8 = {a0[0], a0[1], a0[2], a0[3], a1[0], a1[1], a1[2], a1[3]};
                    *(h8_t*)(O + off + bj * 128) = __builtin_convertvector(f8, h8_t); } }
    }
};
struct EpiResF32 {
    static constexpr bool PERM = false, AFTER_DRAIN = false;
    const float* R; float* O; int ldc;
    __device__ __forceinline__ void operator()(const pg8::f32x4 (&acc)[2][2][4][2], const pg8::Unit& u, int wr, int wc, int fr, int fq) const {
        const int row0 = u.pm * 256 + wr * 64 + fr, col0 = u.pn * 256 + wc * 32 + 4 * fq;
#pragma unroll
        for (int ai = 0; ai < 2; ++ai)
#pragma unroll
            for (int m = 0; m < 4; ++m) { const size_t off = (size_t)(row0 + ai * 128 + m * 16) * ldc + col0;
#pragma unroll
                for (int bj = 0; bj < 2; ++bj)
#pragma unroll
                    for (int n = 0; n < 2; ++n) { pg8::f32x4 v = acc[ai][bj][m][n]; if (R) v = v + *(const pg8::f32x4*)(R + off + bj * 128 + n * 16); *(pg8::f32x4*)(O + off + bj * 128 + n * 16) = v; } }
    }
};

#define XB_TMO      128
#define XB_XCNT(j)  (256  + 64 * (j))
#define XB_XSUB(j)  (1280 + 64 * (j))
#define XB_XGEN(j)  (2304 + 64 * (j))
#define XB_TOP      3328
#define XB_TOPGEN   3392
#define XCD_BAR_WORDS 3456
#define XB_SPIN_CAP (1u << 18)

__device__ __forceinline__ unsigned xb_ld(unsigned* p)              { return __hip_atomic_load(p, __ATOMIC_RELAXED, __HIP_MEMORY_SCOPE_AGENT); }
__device__ __forceinline__ unsigned xb_add(unsigned* p, unsigned v) { return __hip_atomic_fetch_add(p, v, __ATOMIC_RELAXED, __HIP_MEMORY_SCOPE_AGENT); }
__device__ __forceinline__ unsigned xb_xcc_id() { return (unsigned)__builtin_amdgcn_s_getreg((3 << 11) | 20) & 0xFu; }
#define XB_SPIN(cond, bar) do { unsigned _sp = 0; while (cond) { __builtin_amdgcn_s_sleep(1); \
    if ((++_sp & 255u) == 0u) { if (xb_ld(&(bar)[XB_TMO])) break; if (_sp > XB_SPIN_CAP) { atomicAdd(&(bar)[XB_TMO], 1u); break; } } } } while (0)

struct XcdBarrier {
    unsigned* bar; unsigned x;
    volatile LAS unsigned* st;
};

__device__ __forceinline__ XcdBarrier xcd_barrier_post(unsigned* bar, volatile LAS unsigned* st) {
    XcdBarrier b; b.bar = bar; b.x = xb_xcc_id(); b.st = st;
    if (threadIdx.x == 0) (void)xb_add(&bar[XB_XCNT(b.x)], 1u);
    return b;
}
__device__ __forceinline__ void xcd_barrier_complete(unsigned* bar, unsigned x, unsigned& nloc, unsigned& nx) {
    const unsigned G = gridDim.x * gridDim.y * gridDim.z;
    unsigned sum, cnt, mine, sp = 0u;
    for (;;) {
        sum = 0u; cnt = 0u; mine = 0u;
#pragma unroll
        for (unsigned j = 0; j < 16; ++j) { const unsigned c = xb_ld(&bar[XB_XCNT(j)]); sum += c; cnt += (c > 0u) ? 1u : 0u; mine = (j == x) ? c : mine; }
        if (sum == G) break;
        __builtin_amdgcn_s_sleep(1);
        if ((++sp & 255u) == 0u) { if (xb_ld(&bar[XB_TMO])) break; if (sp > XB_SPIN_CAP) { atomicAdd(&bar[XB_TMO], 1u); break; } }
    }
    nloc = mine > 0u ? mine : 1u; nx = cnt > 0u ? cnt : 1u;
}

__device__ __forceinline__ void xcd_barrier(const XcdBarrier& b) {
    asm volatile("s_waitcnt vmcnt(0)" ::: "memory");
    __syncthreads();
    if (threadIdx.x == 0) {
        unsigned* bar = b.bar;
        __builtin_amdgcn_s_waitcnt(0);
        unsigned nloc = b.st[0], nx = b.st[1];
        if (nloc == 0u) { xcd_barrier_complete(bar, b.x, nloc, nx); b.st[0] = nloc; b.st[1] = nx; }
        const unsigned old = xb_add(&bar[XB_XSUB(b.x)], 1u);
        const unsigned gen = old / nloc;
        if (old + 1u == (gen + 1u) * nloc) {
            __builtin_amdgcn_fence(__ATOMIC_RELEASE, "agent");
            asm volatile("s_waitcnt vmcnt(0)" ::: "memory");
            const unsigned og = xb_add(&bar[XB_TOP], 1u);
            const unsigned tg = og / nx;
            if (og + 1u == (tg + 1u) * nx) xb_add(&bar[XB_TOPGEN], 1u);
            else XB_SPIN(xb_ld(&bar[XB_TOPGEN]) == tg, bar);
            __builtin_amdgcn_fence(__ATOMIC_ACQUIRE, "agent");
            xb_add(&bar[XB_XGEN(b.x)], 1u);
            asm volatile("s_waitcnt vmcnt(0)" ::: "memory");
        } else {
            XB_SPIN(xb_ld(&bar[XB_XGEN(b.x)]) == gen, bar);
            __builtin_amdgcn_fence(__ATOMIC_ACQUIRE, "agent");
            asm volatile("s_waitcnt vmcnt(0)" ::: "memory");
        }
    }
    __syncthreads();
}

__device__ __forceinline__ int get_lane() { int l = (int)__builtin_amdgcn_mbcnt_hi(~0u, __builtin_amdgcn_mbcnt_lo(~0u, 0u)); asm volatile("" : "+v"(l)); return l; }
__global__ void __launch_bounds__(NT, 2) mk_fwd(Args args) {
    extern __shared__ __attribute__((aligned(16))) unsigned char lds_raw[];
    LAS unsigned char* lds = (LAS unsigned char*)lds_raw;
    cg::grid_group grid = cg::this_grid();
    const int tid = threadIdx.x, wave = __builtin_amdgcn_readfirstlane(tid >> 6);

    const int G = gridDim.x, bx = blockIdx.x;
    const int vcu = (G % 8 == 0) ? (bx % 8) * (G / 8) + bx / 8 : bx;
    const int gw = vcu * NW + wave, NGW = G * NW;
    unsigned char* ws = args.ws;
    const float* x = args.in[0]; const float* attn_g = args.in[1]; const float* w_in = args.in[2];
    const float* w_out = args.in[9]; const float* ffn_g = args.in[10]; const float* w_query = args.in[11]; const float* sub_keys = args.in[12];
    bf16_t* WinT = (bf16_t*)(ws + OFF_D);
    bf16_t* WoutT = (bf16_t*)(ws + OFF_C);
    bf16_t* Wqk = (bf16_t*)(ws + OFF_C + 8 * MiB);
    bf16_t* xn = (bf16_t*)(ws + OFF_D + 28 * MiB);
    float* ba = (float*)(ws + OFF_S);
    bf16_t* proj = (bf16_t*)(ws + OFF_B);
    bf16_t* mix = (bf16_t*)args.out;
    unsigned char* pb = ws + OFF_D; float* vecs = (float*)(ws + OFF_S + 2 * MiB);
    float* hbuf = (float*)(ws + OFF_B);
    bf16_t* hn = (bf16_t*)(ws + OFF_D + 128 * MiB);
    unsigned long long* rowss = (unsigned long long*)(ws + 65536);
    _Float16* scores = (_Float16*)(ws + OFF_D);
    unsigned char* U8 = ws + OFF_TAB; unsigned char* V8 = ws + OFF_TAB + 16 * MiB;
    float* inv_su = (float*)(ws + OFF_S + 1 * MiB); float* inv_sv = inv_su + 16384;

    volatile LAS unsigned* xbst = (volatile LAS unsigned*)(lds + LDS_BYTES - 16);
    if (tid < 4) xbst[tid] = 0u;
    __syncthreads();
    XcdBarrier xbar = xcd_barrier_post((unsigned*)args.ws, xbst);
    const int lo = args.ph_lo, hi = args.ph_hi;
#define IN(k) (lo <= (k) && (k) < hi)
#define SYNC_AFTER(k) do { if (IN(k) && (k) + 1 < hi) { if ((k) == 0) grid.sync(); else xcd_barrier(xbar); } } while (0)
    {
        if (IN(0)) {
            const int lane = get_lane();
            LAS float* scr = (LAS float*)(lds + wave * 16384);
            constexpr int I_IN = (DM / 64) * (NPROJ / 32);
            for (int it = gw; it < I_IN; it += NGW) transpose_item(w_in, INW, DM, NPROJ, WinT, scr, it, lane);
            __syncthreads();
            {
                LAS float* wt = (LAS float*)lds;
#pragma unroll
                for (int k = 0; k < 4; ++k) { const int d = tid + 512 * k; const float* wr = w_in + (size_t)d * INW + NPROJ;
#pragma unroll
                    for (int q4 = 0; q4 < 4; ++q4) { const f32x4 w4 = *(const f32x4*)(wr + 4 * q4);
                        wt[(4 * q4 + 0) * 2048 + d] = w4.x; wt[(4 * q4 + 1) * 2048 + d] = w4.y; wt[(4 * q4 + 2) * 2048 + d] = w4.z; wt[(4 * q4 + 3) * 2048 + d] = w4.w; } }
            }
            __syncthreads();
            for (int m = gw; m < T; m += NGW) norm_row<true>(x + (size_t)m * DM, attn_g, (const LAS float*)lds, xn + (size_t)m * DM, ba + (size_t)m * 16, lane);
        }
        SYNC_AFTER(0);
        if (IN(1)) {
            pg8::Gemm g{xn, WinT, T, NPROJ, DM}; pg8::StaticOrder S; S.init(T, NPROJ, G, bx);
            EpiProj E{proj, NPROJ};
            pg8::gemm_phase<EpiProj, pg8::StaticOrder, true, true>(lds, g, S, E);
        }
        SYNC_AFTER(1);
        if (IN(2)) {
            const int CAe = (G > NSB) ? CA : 128;
            for (int it = bx; it < 16 * CAe; it += G) { int tt = threadIdx.x; asm volatile("" : "+v"(tt)); hgrn_prep_item((it / CAe) * 128 + (it % CAe), proj, args.in[3], pb, vecs, lds, tt); }
            for (int it = bx; it < 8 * CAe; it += G) { int tt = threadIdx.x; asm volatile("" : "+v"(tt)); gdn_prep_item((it / CAe) * 128 + (it % CAe), proj, ba, args.in[5], args.in[6], args.in[7], pb, vecs, lds, tt); }
        }
        SYNC_AFTER(2);
        if (IN(3)) {
            const int lane = get_lane();
            unsigned* ctl = (unsigned*)args.ws;
            if (bx < NSB) {
                const int sq = (bx & 7) + 8 * (bx >> 5), cgp = (bx >> 3) & 3;
                if (sq >= 16) scan_block<true>(sq, cgp, proj, pb, vecs, args.in[4], args.in[8], mix, ctl + PROG_WORD, G - NSB, lds, tid);
                else scan_block<false>(sq, cgp, proj, pb, vecs, args.in[4], args.in[8], mix, ctl + PROG_WORD, G - NSB, lds, tid);
            }
            else if (G > NSB) {
                int fb, FB;
                fb = bx - NSB; FB = G - NSB;
                {
                    constexpr int NBL = 128 - CA;
                    for (int it = fb; it < 16 * NBL; it += FB) { int tt = threadIdx.x; asm volatile("" : "+v"(tt)); hgrn_prep_item((it & 15) * 128 + CA + (it >> 4), proj, args.in[3], pb, vecs, lds, tt); }
                    for (int it = fb; it < 8 * NBL; it += FB) { int tt = threadIdx.x; asm volatile("" : "+v"(tt)); gdn_prep_item((it & 7) * 128 + CA + (it >> 3), proj, ba, args.in[5], args.in[6], args.in[7], pb, vecs, lds, tt); }
                    __syncthreads();
                    if (tid == 0) { __threadfence(); __hip_atomic_fetch_add(ctl + PROG_WORD, 1u, __ATOMIC_RELAXED, __HIP_MEMORY_SCOPE_AGENT); }
                    __syncthreads();
                }
                const int fw = fb * NW + wave, FW = FB * NW;
                for (int it = fb; it < 512; it += FB) wqk_item(w_query, sub_keys, ffn_g, Wqk, (LAS float*)lds, it, tid);
                LAS float* scr = (LAS float*)(lds + wave * 16384);
                constexpr int I_OUT = (DM / 64) * (DM / 32);
                for (int it = fw; it < I_OUT; it += FW) transpose_item(w_out, DM, DM, DM, WoutT, scr, it, lane);
                for (int e = 2 * fw; e < 32768; e += 2 * FW) { const bool isv = e >= 16384; const int r = e & 16383;
                    if (isv) table_row2(args.in[14] + (size_t)r * DM, (unsigned*)(V8 + (size_t)r * 1024), inv_sv + r, lane);
                    else table_row2_i4(args.in[13] + (size_t)r * DM, (unsigned*)(U8 + (size_t)r * 1024), inv_su + r, lane); }
            }
        }
        SYNC_AFTER(3);
        if (IN(4)) {
            {
                const int lane = get_lane();
                float gn[2][8];
#pragma unroll
                for (int mxr = 0; mxr < 2; ++mxr) { const float* gsrc = (mxr == 0 ? args.in[4] : args.in[8]) + 8 * (lane & 15);
                    const f32x4 ga = *(const f32x4*)gsrc, gb = *(const f32x4*)(gsrc + 4);
                    gn[mxr][0] = ga.x; gn[mxr][1] = ga.y; gn[mxr][2] = ga.z; gn[mxr][3] = ga.w; gn[mxr][4] = gb.x; gn[mxr][5] = gb.y; gn[mxr][6] = gb.z; gn[mxr][7] = gb.w; }
                for (int m = gw; m < T; m += NGW) mixnorm_row(mix + (size_t)m * DM, proj + (size_t)m * NPROJ, gn, lane);
                xcd_barrier(xbar);
            }
            pg8::Gemm g{mix, WoutT, T, DM, DM}; pg8::StaticOrder S; S.init(T, DM, G, bx);
            EpiResSS E{x, hn, rowss, DM};
            pg8::gemm_phase<EpiResSS, pg8::StaticOrder, true, true>(lds, g, S, E);
        }
        SYNC_AFTER(4);
        if (IN(6)) {
            pg8::Gemm g{hn, Wqk, T, DM, DM}; pg8::StaticOrder S; S.init(T, DM, G, bx);
            EpiRowScale E{rowss, scores, DM};
            pg8::gemm_phase<EpiRowScale, pg8::StaticOrder, true, true>(lds, g, S, E);
        }
        SYNC_AFTER(6);
        if (IN(7)) {
            const int lane = get_lane();
            LAS int* se = (LAS int*)(lds + wave * 4096); LAS float* sa = (LAS float*)(lds + wave * 4096 + 512); LAS float* sb = (LAS float*)(lds + wave * 4096 + 1024);
            for (int t = gw; t < T; t += NGW) { const int ln = get_lane(); peer_token(t, scores, hn, hbuf, U8, V8, inv_su, inv_sv, args.in[15], ffn_g, rowss, args.out, se, sa, sb, ln); }
        }
    }
}
}

extern "C" void kernel_launch(void* const* d_in, const int* in_sizes, int n_in, void* d_out, int out_size, void* d_ws, size_t ws_size, hipStream_t stream) {
    static int grid = 0;
    if (grid == 0) {
        int dev = 0, cus = 0, per_cu = 0;
        (void)hipGetDevice(&dev);
        (void)hipDeviceGetAttribute(&cus, hipDeviceAttributeMultiprocessorCount, dev);
        (void)hipFuncSetAttribute((const void*)mk::mk_fwd, hipFuncAttributeMaxDynamicSharedMemorySize, mk::LDS_BYTES);
        (void)hipOccupancyMaxActiveBlocksPerMultiprocessor(&per_cu, (const void*)mk::mk_fwd, mk::NT, mk::LDS_BYTES);
        if (per_cu < 1) { fprintf(stderr, "occupancy query says %d\n", per_cu); per_cu = 1; }
        grid = cus;
    }
    unsigned char* ws = (unsigned char*)d_ws;
    (void)hipMemsetAsync(d_ws, 0, 65536 + 131072, stream);
    mk::Args a{};
    for (int i = 0; i < 16; ++i) a.in[i] = (const float*)d_in[i];
    a.out = (float*)d_out; a.ws = ws;
    {
        a.ph_lo = 0; a.ph_hi = 8;
        void* kargs[] = {&a};
        hipError_t e = hipLaunchCooperativeKernel((const void*)mk::mk_fwd, dim3(grid), dim3(mk::NT), kargs, mk::LDS_BYTES, stream);
        if (e != hipSuccess) fprintf(stderr, "coop launch failed: %s\n", hipGetErrorString(e));
    }
}
```
